# Optimizing an MI355X kernel written in HIP

```python
import jax
import jax.numpy as jnp
from jax import lax
import numpy as np

D_MODEL = 1024
BATCH = 8
SEQ = 2048
DEPTH = 2

ATT_HEADS = 8
ATT_HEAD_DIM = 64
ATT_WIDTH = ATT_HEADS * ATT_HEAD_DIM
MOBA_BLOCK = 256
MOBA_TOPK = 3
MOBA_QCHUNK = 32
HGRN_HEADS = 4
HGRN_EXPAND = 128
HGRN_VDIM = 128
HGRN_KEY_WIDTH = HGRN_HEADS * HGRN_EXPAND
HGRN_WIDTH = HGRN_HEADS * HGRN_VDIM
HGRN_CHUNK = 64
CONV_CH = 512
CONV_WIDTH = 31
N_BRANCH = 3
IN_COLS = 3 * ATT_WIDTH + 2 * HGRN_KEY_WIDTH + 2 * HGRN_WIDTH + 2 * CONV_CH + N_BRANCH * D_MODEL
N_GROUPS = 4
EXPERTS_PER_GROUP = 8
N_EXPERTS = N_GROUPS * EXPERTS_PER_GROUP
EXPERT_TOPK = 2
EXPERT_FF = 512

RMS_EPS = 1e-6
LN_EPS = 1e-5
NEG_INF = -1e30

kernel_name = 'hybrid_moba_hgrn2_conformer_hmoe'


def rms_norm(x, gain):
    xf = x.astype(jnp.float32)
    y = xf * lax.rsqrt(jnp.mean(xf * xf, axis=-1, keepdims=True) + RMS_EPS)
    return (y * gain.astype(jnp.float32)).astype(x.dtype)


def moba_attention(q, k, v):
    B, S, H, dh = q.shape
    n_blk = -(-S // MOBA_BLOCK)
    s_pad = n_blk * MOBA_BLOCK
    n_sel = min(MOBA_TOPK, n_blk)
    n_qc = S // MOBA_QCHUNK
    scale = dh ** -0.5
    pad = ((0, 0), (0, s_pad - S), (0, 0), (0, 0))
    qh = q.transpose(0, 2, 1, 3)
    kb = jnp.pad(k, pad).transpose(0, 2, 1, 3).reshape(B, H, n_blk, MOBA_BLOCK, dh)
    vb = jnp.pad(v, pad).transpose(0, 2, 1, 3).reshape(B, H, n_blk, MOBA_BLOCK, dh)
    k_mean = jnp.mean(kb.astype(jnp.float32), axis=3)
    q_blk = jnp.arange(S) // MOBA_BLOCK
    gate = jnp.einsum('bhsd,bhnd->bhsn', qh.astype(jnp.float32), k_mean)
    fully_past = jnp.arange(n_blk)[None, :] < q_blk[:, None]
    gate = jnp.where(fully_past, gate, NEG_INF)
    _, sel = lax.top_k(gate, n_sel)
    sel_valid = jnp.arange(n_sel)[None, :] < jnp.minimum(n_sel, q_blk)[:, None]

    def to_chunks(a):
        a = a.reshape(B, H, n_qc, MOBA_QCHUNK, a.shape[-1])
        return jnp.moveaxis(a, 2, 0)

    b_idx = jnp.arange(B)[:, None, None, None]
    h_idx = jnp.arange(H)[None, :, None, None]

    def attend_chunk(args):
        c, qc, sc, vc = args
        blk = (c * MOBA_QCHUNK) // MOBA_BLOCK
        qp = c * MOBA_QCHUNK + jnp.arange(MOBA_QCHUNK)
        kp = blk * MOBA_BLOCK + jnp.arange(MOBA_BLOCK)
        k_own = lax.dynamic_index_in_dim(kb, blk, axis=2, keepdims=False)
        v_own = lax.dynamic_index_in_dim(vb, blk, axis=2, keepdims=False)
        s_own = jnp.einsum('bhqd,bhkd->bhqk', qc, k_own).astype(jnp.float32) * scale
        s_own = jnp.where(kp[None, :] <= qp[:, None], s_own, NEG_INF)
        k_sel = kb[b_idx, h_idx, sc].reshape(B, H, MOBA_QCHUNK, n_sel * MOBA_BLOCK, dh)
        v_sel = vb[b_idx, h_idx, sc].reshape(B, H, MOBA_QCHUNK, n_sel * MOBA_BLOCK, dh)
        s_sel = jnp.einsum('bhqd,bhqkd->bhqk', qc, k_sel).astype(jnp.float32) * scale
        s_sel = jnp.where(jnp.repeat(vc, MOBA_BLOCK, axis=-1), s_sel, NEG_INF)
        p = jax.nn.softmax(jnp.concatenate([s_own, s_sel], axis=-1), axis=-1).astype(v.dtype)
        return (jnp.einsum('bhqk,bhkd->bhqd', p[..., :MOBA_BLOCK], v_own)
                + jnp.einsum('bhqk,bhqkd->bhqd', p[..., MOBA_BLOCK:], v_sel))

    o = lax.map(attend_chunk, (jnp.arange(n_qc), to_chunks(qh), to_chunks(sel),
                               sel_valid.reshape(n_qc, MOBA_QCHUNK, n_sel)))
    return jnp.moveaxis(o, 0, 2).reshape(B, H, S, dh).transpose(0, 2, 1, 3).reshape(B, S, H * dh)


def hgrn2_recurrence(q, f_raw, i, lower_bound):
    B, S, H, dk = q.shape
    dv = i.shape[-1]
    C = HGRN_CHUNK
    n_c = S // C
    fr = f_raw.astype(jnp.float32)
    lb = lower_bound.astype(jnp.float32)
    sig = jax.nn.sigmoid(fr)
    log_f = jnp.log(lb + (1.0 - lb) * sig)
    k_in = (1.0 - lb) * (1.0 - sig)
    q_act = jax.nn.silu(q.astype(jnp.float32))

    def to_chunks(a):
        return a.reshape(B, n_c, C, H, a.shape[-1]).transpose(1, 0, 3, 2, 4)

    causal = jnp.tril(jnp.ones((C, C), dtype=bool))[:, :, None]

    def chunk_step(state, xs):
        qc, kc, vc, gc = xs
        b = jnp.cumsum(gc, axis=2)
        o_inter = jnp.einsum('bhtk,bhkv->bhtv', qc * jnp.exp(b), state)
        rel = jnp.where(causal, b[:, :, :, None, :] - b[:, :, None, :, :], 0.0)
        decay = jnp.where(causal, jnp.exp(rel), 0.0)
        scores = jnp.einsum('bhtk,bhtsk,bhsk->bhts', qc, decay, kc)
        o = o_inter + jnp.einsum('bhts,bhsv->bhtv', scores, vc)
        b_end = b[:, :, -1:, :]
        state = (jnp.exp(b_end[:, :, 0, :])[..., None] * state
                 + jnp.einsum('bhsk,bhsv->bhkv', kc * jnp.exp(b_end - b), vc))
        return state, o

    state0 = jnp.zeros((B, H, dk, dv), jnp.float32)
    _, o = lax.scan(chunk_step, state0, (to_chunks(q_act), to_chunks(k_in),
                                         to_chunks(i.astype(jnp.float32)), to_chunks(log_f)))
    return o.transpose(1, 0, 3, 2, 4).reshape(B, S, H, dv)


def conformer_conv(a, b, w_dw, b_dw, ln_g, ln_b):
    u = a * jax.nn.sigmoid(b)
    u = lax.conv_general_dilated(u, w_dw[:, None, :].astype(u.dtype), window_strides=(1,),
                                 padding=[(CONV_WIDTH - 1, 0)],
                                 dimension_numbers=('NWC', 'WIO', 'NWC'),
                                 feature_group_count=CONV_CH)
    uf = u.astype(jnp.float32) + b_dw.astype(jnp.float32)
    mu = jnp.mean(uf, axis=-1, keepdims=True)
    var = jnp.mean(jnp.square(uf - mu), axis=-1, keepdims=True)
    uf = (uf - mu) * lax.rsqrt(var + LN_EPS) * ln_g.astype(jnp.float32) + ln_b.astype(jnp.float32)
    return jax.nn.silu(uf).astype(a.dtype)


def hybrid_mixer(h, w_in, b_gate, q_norm_g, k_norm_g, lower_bound, hgrn_norm_g, conv_w, conv_b,
                 conv_ln_g, conv_ln_b, w_att_o, w_hgrn_o, w_conv_o, w_out):
    B, S, _ = h.shape
    widths = [ATT_WIDTH] * 3 + [HGRN_KEY_WIDTH] * 2 + [HGRN_WIDTH] * 2 + [CONV_CH] * 2
    offsets = np.cumsum(widths).tolist()
    proj = h @ w_in
    aq, ak, av, hq, hf, hi, hg, ca, cb, gl = jnp.split(proj, offsets, axis=-1)
    att_shape = (B, S, ATT_HEADS, ATT_HEAD_DIM)
    q = rms_norm(aq.reshape(att_shape), q_norm_g)
    k = rms_norm(ak.reshape(att_shape), k_norm_g)
    y_att = moba_attention(q, k, av.reshape(att_shape)) @ w_att_o
    o = hgrn2_recurrence(hq.reshape(B, S, HGRN_HEADS, HGRN_EXPAND),
                         hf.reshape(B, S, HGRN_HEADS, HGRN_EXPAND),
                         hi.reshape(B, S, HGRN_HEADS, HGRN_VDIM),
                         lower_bound.reshape(HGRN_HEADS, HGRN_EXPAND))
    o = rms_norm(o, hgrn_norm_g) * jax.nn.silu(hg.reshape(B, S, HGRN_HEADS, HGRN_VDIM).astype(jnp.float32))
    y_rec = o.reshape(B, S, HGRN_WIDTH).astype(h.dtype) @ w_hgrn_o
    y_conv = conformer_conv(ca, cb, conv_w, conv_b, conv_ln_g, conv_ln_b) @ w_conv_o
    gates = jax.nn.sigmoid(gl + b_gate).reshape(B, S, N_BRANCH, D_MODEL)
    merged = gates[:, :, 0] * y_att + gates[:, :, 1] * y_rec + gates[:, :, 2] * y_conv
    return merged @ w_out


def hierarchical_moe(h, w_coarse, b_coarse, w_fine, b_fine, w_exp_in, w_exp_out):
    B, S, D = h.shape
    t = h.reshape(-1, D)
    p_grp = jax.nn.softmax((t @ w_coarse + b_coarse).astype(jnp.float32), axis=-1)
    p_top, grp = lax.top_k(p_grp, 1)
    fine = (t @ w_fine + b_fine).astype(jnp.float32).reshape(-1, N_GROUPS, EXPERTS_PER_GROUP)
    fine_sel = jnp.take_along_axis(fine, grp[:, :, None], axis=1)[:, 0]
    top_logit, local = lax.top_k(fine_sel, EXPERT_TOPK)
    w = jax.nn.softmax(top_logit, axis=-1) * p_top
    expert_id = grp * EXPERTS_PER_GROUP + local
    combine = jnp.sum(jax.nn.one_hot(expert_id, N_EXPERTS, dtype=jnp.float32) * w[..., None], axis=1)
    y = jnp.zeros(t.shape, jnp.float32)
    for e in range(N_EXPERTS):
        gate, up = jnp.split(t @ w_exp_in[e], 2, axis=-1)
        y = y + combine[:, e:e + 1] * ((jax.nn.silu(gate) * up) @ w_exp_out[e]).astype(jnp.float32)
    return y.astype(h.dtype).reshape(B, S, D)


def setup_inputs(seed: int = 0) -> dict:
    key = jax.random.key(seed)
    ks = jax.random.split(key, 23)
    L, D = DEPTH, D_MODEL

    def nrm(k, shape, scale):
        return jax.random.normal(k, shape, jnp.float32) * scale

    return {
        'x': nrm(ks[0], (BATCH, SEQ, D), 1.0),
        'mix_norm_g': 1.0 + nrm(ks[1], (L, D), 0.02),
        'w_in': nrm(ks[2], (L, D, IN_COLS), D ** -0.5),
        'b_gate': nrm(ks[3], (L, N_BRANCH * D), 0.02),
        'q_norm_g': 1.0 + nrm(ks[4], (L, ATT_HEAD_DIM), 0.02),
        'k_norm_g': 1.0 + nrm(ks[5], (L, ATT_HEAD_DIM), 0.02),
        'lb_logits': nrm(ks[6], (L, HGRN_KEY_WIDTH), 0.1),
        'hgrn_norm_g': 1.0 + nrm(ks[7], (L, HGRN_VDIM), 0.02),
        'conv_w': nrm(ks[8], (L, CONV_WIDTH, CONV_CH), CONV_WIDTH ** -0.5),
        'conv_b': nrm(ks[9], (L, CONV_CH), 0.02),
        'conv_ln_g': 1.0 + nrm(ks[10], (L, CONV_CH), 0.02),
        'conv_ln_b': nrm(ks[11], (L, CONV_CH), 0.02),
        'w_att_o': nrm(ks[12], (L, ATT_WIDTH, D), ATT_WIDTH ** -0.5),
        'w_hgrn_o': nrm(ks[13], (L, HGRN_WIDTH, D), HGRN_WIDTH ** -0.5),
        'w_conv_o': nrm(ks[14], (L, CONV_CH, D), CONV_CH ** -0.5),
        'w_out': nrm(ks[15], (L, D, D), D ** -0.5),
        'ffn_norm_g': 1.0 + nrm(ks[16], (L, D), 0.02),
        'w_coarse': nrm(ks[17], (L, D, N_GROUPS), D ** -0.5),
        'b_coarse': nrm(ks[18], (L, N_GROUPS), 0.01),
        'w_fine': nrm(ks[19], (L, D, N_EXPERTS), D ** -0.5),
        'b_fine': nrm(ks[20], (L, N_EXPERTS), 0.01),
        'w_exp_in': nrm(ks[21], (L, N_EXPERTS, D, 2 * EXPERT_FF), D ** -0.5),
        'w_exp_out': nrm(ks[22], (L, N_EXPERTS, EXPERT_FF, D), EXPERT_FF ** -0.5),
    }


def reference(x, mix_norm_g, w_in, b_gate, q_norm_g, k_norm_g, lb_logits, hgrn_norm_g, conv_w,
              conv_b, conv_ln_g, conv_ln_b, w_att_o, w_hgrn_o, w_conv_o, w_out, ffn_norm_g,
              w_coarse, b_coarse, w_fine, b_fine, w_exp_in, w_exp_out):
    lb_p = jax.nn.softmax(lb_logits.astype(jnp.float32), axis=0)
    lb_all = jnp.maximum(jnp.cumsum(lb_p, axis=0) - lb_p[0:1], 0.0)
    for l in range(DEPTH):
        h = rms_norm(x, mix_norm_g[l])
        x = x + hybrid_mixer(h, w_in[l], b_gate[l], q_norm_g[l], k_norm_g[l], lb_all[l],
                             hgrn_norm_g[l], conv_w[l], conv_b[l], conv_ln_g[l], conv_ln_b[l],
                             w_att_o[l], w_hgrn_o[l], w_conv_o[l], w_out[l])
        h = rms_norm(x, ffn_norm_g[l])
        x = x + hierarchical_moe(h, w_coarse[l], b_coarse[l], w_fine[l], b_fine[l],
                                 w_exp_in[l], w_exp_out[l])
    return x
```

```cpp
#include <hip/hip_runtime.h>
#include <cstdio>
#include <cstdint>

#ifndef MK_SPLIT
#define MK_SPLIT 1
#endif
#ifndef DBG_MASK
#define DBG_MASK 0xFFFFu
#endif
#define PHON(j) (((DBG_MASK) >> (j)) & 1u)

constexpr int DM = 1024, NB = 8, SEQ = 2048, T = NB * SEQ, DEPTH = 2;
constexpr int NCOL = 7680;
constexpr int C_AQ = 0, C_AK = 512, C_AV = 1024, C_HQ = 1536, C_HF = 2048, C_HI = 2560, C_HG = 3072, C_CA = 3584, C_CB = 4096, C_GL = 4608;
constexpr int NEXP = 32, FF = 512;
constexpr int MOE_ROWS = 2 * T + NEXP * 256;
constexpr float RMS_EPS = 1e-6f, LN_EPS = 1e-5f;
constexpr float QSCALE = 0.125f * 1.4426950408889634f;

namespace pg8 {
#define PG8_LAS __attribute__((address_space(3)))
typedef unsigned short bf16_t;
typedef short bf16x8 __attribute__((ext_vector_type(8)));
typedef float f32x4 __attribute__((ext_vector_type(4)));
typedef unsigned u32x4 __attribute__((ext_vector_type(4)));
constexpr int BM = 256, BK = 64, HALF = 128, HTB = HALF * BK * 2, STAGE_BYTES = 8 * HTB, NXCD = 8, WGM = 8;

__host__ __device__ __forceinline__ int lds_byte(int r, int c) { const int st = (r >> 4) * 2 + (c >> 5), rr = r & 15, cc = c & 31, ob = rr * 64 + cc * 2; return st * 1024 + (ob ^ (((ob >> 9) & 1) << 5)); }
__host__ __device__ __forceinline__ void stage_rc(int b, int& R, int& C) { const int st = b / 1024, sb = b % 1024, swz = sb ^ (((sb >> 9) & 1) << 5); R = (st >> 1) * 16 + swz / 64; C = (st & 1) * 32 + (swz % 64) / 2; }
__host__ __device__ __forceinline__ int perm32(int rho) { const int n = rho >> 4, i = rho & 15; return 8 * (i >> 2) + 4 * n + (i & 3); }

struct Unit { int pm, pn, aux, pad; const char* a; const char* b; };
struct Gemm { int lda, ldb, K; };

__device__ __forceinline__ bool static_tile(int nM, int nN, long L, int& pm, int& pn) {
    const int nwg = nM * nN; if (L >= nwg) return false;
    int wgid = (int)L; { const int q = nwg / NXCD, r = nwg % NXCD, xcd = wgid % NXCD, off = wgid / NXCD; wgid = (xcd < r ? xcd * (q + 1) : r * (q + 1) + (xcd - r) * q) + off; }
    const int nig = WGM * nN, gid = wgid / nig, fm = gid * WGM, gsz = (nM - fm) < WGM ? (nM - fm) : WGM;
    pm = fm + ((wgid % nig) % gsz); pn = (wgid % nig) / gsz; return true;
}

__device__ __forceinline__ unsigned cvt_pk_bf16(float lo, float hi) { unsigned r; asm volatile("v_cvt_pk_bf16_f32 %0, %1, %2" : "=v"(r) : "v"(lo), "v"(hi)); return r; }

template <class Epi, class Sched, bool ALIGN_EPI = false, bool SP2 = false>
__device__ __forceinline__ void gemm_phase(PG8_LAS unsigned char* lds, const Gemm g, const Sched& S, const Epi& E) {
    int tid_ = threadIdx.x; asm volatile("" : "+v"(tid_));
    const int tid = tid_, wid = __builtin_amdgcn_readfirstlane(tid >> 6), lane = tid & 63, wr = wid >> 2, wc = wid & 3, fr = lane & 15, fq = lane >> 4;
    const int K = g.K, nt = K / BK;
    unsigned voffA[2], voffB[2];
#pragma unroll
    for (int i = 0; i < 2; ++i) { int R, C; stage_rc(tid * 16 + i * 8192, R, C); const int Rb = Epi::PERM ? ((R & ~31) + perm32(R & 31)) : R;
        voffA[i] = (unsigned)(R * g.lda + C) * 2u; voffB[i] = (unsigned)(Rb * g.ldb + C) * 2u; }
    const size_t kstep = (size_t)(BK * 2);
    const size_t hstepA = (size_t)HALF * g.lda * 2, hstepB = (size_t)HALF * g.ldb * 2;
    const unsigned ldsw = (unsigned)wid * 1024u;
    const int aoff = lds_byte(wr * 64 + fr, fq * 8), boff = lds_byte(wc * 32 + fr, fq * 8);
#define PG8_SA(b, h) (((b) * 2 + (h)) * HTB)
#define PG8_SB(b, h) ((4 + (b) * 2 + (h)) * HTB)
#define PG8_STAGE(bufoff, gbase, voff) do { _Pragma("unroll") for (int _i = 0; _i < 2; ++_i) \
        __builtin_amdgcn_global_load_lds((const unsigned*)((const char*)(gbase) + (voff)[_i]), (PG8_LAS unsigned*)(lds + (bufoff) + ldsw + _i * 8192), 16, 0, 0); } while (0)
#define PG8_LDA(dst, b, h) do { _Pragma("unroll") for (int m = 0; m < 4; ++m) _Pragma("unroll") for (int k = 0; k < 2; ++k) dst[m][k] = *(const PG8_LAS bf16x8*)(lds + PG8_SA(b, h) + aoff + m * 2048 + k * 1024); } while (0)
#define PG8_LDB(dst, b, h) do { _Pragma("unroll") for (int n = 0; n < 2; ++n) _Pragma("unroll") for (int k = 0; k < 2; ++k) dst[n][k] = *(const PG8_LAS bf16x8*)(lds + PG8_SB(b, h) + boff + n * 2048 + k * 1024); } while (0)
#define PG8_MMA(ai, bj, At, Bt) do { __builtin_amdgcn_s_setprio(1); _Pragma("unroll") for (int m = 0; m < 4; ++m) _Pragma("unroll") for (int n = 0; n < 2; ++n) _Pragma("unroll") for (int k = 0; k < 2; ++k) \
        acc[ai][bj][m][n] = __builtin_amdgcn_mfma_f32_16x16x32_bf16(Bt[n][k], At[m][k], acc[ai][bj][m][n], 0, 0, 0); __builtin_amdgcn_s_setprio(0); } while (0)
#define PG8_WAIT_V(n) asm volatile("s_waitcnt vmcnt(" #n ")" ::: "memory")
#define PG8_WAIT_L(n) asm volatile("s_waitcnt lgkmcnt(" #n ")" ::: "memory")
#define PG8_BAR __builtin_amdgcn_s_barrier()
#define PG8_SCHED __builtin_amdgcn_sched_barrier(0)
    Unit cur, nxt; int ui = 0;
    if (!S.next(0, cur)) return;
    f32x4 acc[2][2][4][2];
#pragma unroll
    for (int a = 0; a < 2; ++a)
#pragma unroll
        for (int b = 0; b < 2; ++b)
#pragma unroll
            for (int m = 0; m < 4; ++m)
#pragma unroll
                for (int n = 0; n < 2; ++n) acc[a][b][m][n] = (f32x4){0.f, 0.f, 0.f, 0.f};
    bf16x8 At[4][2], B0[2][2], B1[2][2];
    const char* cA = cur.a; const char* cB = cur.b;
    if constexpr (SP2) {
        PG8_STAGE(PG8_SB(0, 0), cB, voffB); PG8_STAGE(PG8_SB(0, 1), cB + hstepB, voffB); PG8_STAGE(PG8_SA(0, 0), cA, voffA); PG8_STAGE(PG8_SA(0, 1), cA + hstepA, voffA);
        if (wr == 1) PG8_BAR;
        PG8_WAIT_V(2); PG8_BAR;
        PG8_STAGE(PG8_SB(1, 0), cB + kstep, voffB); PG8_STAGE(PG8_SA(1, 0), cA + kstep, voffA); PG8_STAGE(PG8_SB(1, 1), cB + hstepB + kstep, voffB);
        PG8_WAIT_V(6); PG8_BAR;
    } else {
        PG8_STAGE(PG8_SB(0, 0), cB, voffB); PG8_STAGE(PG8_SA(0, 0), cA, voffA); PG8_STAGE(PG8_SB(0, 1), cB + hstepB, voffB); PG8_STAGE(PG8_SA(0, 1), cA + hstepA, voffA);
        if (wr == 1) PG8_BAR;
        PG8_WAIT_V(4); PG8_BAR;
        PG8_STAGE(PG8_SB(1, 0), cB + kstep, voffB); PG8_STAGE(PG8_SA(1, 0), cA + kstep, voffA); PG8_STAGE(PG8_SB(1, 1), cB + hstepB + kstep, voffB);
        PG8_WAIT_V(6); PG8_BAR;
    }
    for (;;) {
        const bool has_next = S.next(ui + 1, nxt);
        const char* nA = has_next ? nxt.a : cA; const char* nB = has_next ? nxt.b : cB;
        for (int t = 0; t < nt; t += 2) {
            const bool last = (t == nt - 2);
            const char* a1 = cA + (size_t)(t + 1) * kstep;
            const char* a2 = last ? nA : cA + (size_t)(t + 2) * kstep; const char* b2 = last ? nB : cB + (size_t)(t + 2) * kstep;
            const char* a3 = a2 + kstep; const char* b3 = b2 + kstep;
            if constexpr (SP2) {
            PG8_LDB(B0, 0, 0); PG8_LDB(B1, 0, 1); PG8_SCHED; PG8_LDA(At, 0, 0); PG8_STAGE(PG8_SA(1, 1), a1 + hstepA, voffA);
            PG8_WAIT_V(8); PG8_WAIT_L(0); PG8_BAR; PG8_MMA(0, 0, At, B0); PG8_MMA(0, 1, At, B1); PG8_BAR; PG8_SCHED;
            PG8_LDA(At, 0, 1); PG8_STAGE(PG8_SB(0, 0), b2, voffB); PG8_STAGE(PG8_SB(0, 1), b2 + hstepB, voffB); PG8_STAGE(PG8_SA(0, 0), a2, voffA);
            PG8_WAIT_V(8); PG8_WAIT_L(0); PG8_BAR; PG8_MMA(1, 0, At, B0); PG8_MMA(1, 1, At, B1); PG8_BAR; PG8_SCHED;
            PG8_LDB(B0, 1, 0); PG8_LDB(B1, 1, 1); PG8_SCHED; PG8_LDA(At, 1, 0); PG8_STAGE(PG8_SA(0, 1), a2 + hstepA, voffA);
            PG8_WAIT_V(8); PG8_WAIT_L(0); PG8_BAR; PG8_MMA(0, 0, At, B0); PG8_MMA(0, 1, At, B1); PG8_BAR; PG8_SCHED;
            PG8_LDA(At, 1, 1); PG8_STAGE(PG8_SB(1, 0), b3, voffB); PG8_STAGE(PG8_SB(1, 1), b3 + hstepB, voffB); PG8_STAGE(PG8_SA(1, 0), a3, voffA);
            PG8_WAIT_V(8); PG8_WAIT_L(0); PG8_BAR; PG8_MMA(1, 0, At, B0); PG8_MMA(1, 1, At, B1); PG8_BAR; PG8_SCHED;
            } else {
            PG8_LDB(B0, 0, 0); PG8_SCHED; PG8_LDA(At, 0, 0); PG8_STAGE(PG8_SA(1, 1), a1 + hstepA, voffA);
            PG8_WAIT_L(8); PG8_BAR; PG8_WAIT_L(0); PG8_MMA(0, 0, At, B0); PG8_BAR; PG8_SCHED;
            PG8_LDB(B1, 0, 1); PG8_STAGE(PG8_SB(0, 0), b2, voffB);
            PG8_BAR; PG8_WAIT_L(0); PG8_MMA(0, 1, At, B1); PG8_BAR;
            PG8_LDA(At, 0, 1); PG8_STAGE(PG8_SA(0, 0), a2, voffA);
            PG8_BAR; PG8_WAIT_L(0); PG8_MMA(1, 0, At, B0); PG8_BAR; PG8_SCHED;
            PG8_STAGE(PG8_SB(0, 1), b2 + hstepB, voffB);
            PG8_WAIT_V(6); PG8_BAR; PG8_MMA(1, 1, At, B1); PG8_BAR;
            PG8_LDB(B0, 1, 0); PG8_SCHED; PG8_LDA(At, 1, 0); PG8_STAGE(PG8_SA(0, 1), a2 + hstepA, voffA);
            PG8_WAIT_L(8); PG8_BAR; PG8_WAIT_L(0); PG8_MMA(0, 0, At, B0); PG8_BAR; PG8_SCHED;
            PG8_LDB(B1, 1, 1); PG8_STAGE(PG8_SB(1, 0), b3, voffB);
            PG8_BAR; PG8_WAIT_L(0); PG8_MMA(0, 1, At, B1); PG8_BAR;
            PG8_LDA(At, 1, 1); PG8_STAGE(PG8_SA(1, 0), a3, voffA);
            PG8_BAR; PG8_WAIT_L(0); PG8_MMA(1, 0, At, B0); PG8_BAR; PG8_SCHED;
            PG8_STAGE(PG8_SB(1, 1), b3 + hstepB, voffB);
            PG8_WAIT_V(6); PG8_BAR; PG8_MMA(1, 1, At, B1); PG8_BAR;
            }
        }
        if constexpr (ALIGN_EPI) { if (wr == 0) PG8_BAR; }
        E(acc, cur, wr, wc, fr, fq);
        if (!has_next) break;
#pragma unroll
        for (int a = 0; a < 2; ++a)
#pragma unroll
            for (int b = 0; b < 2; ++b)
#pragma unroll
                for (int m = 0; m < 4; ++m)
#pragma unroll
                    for (int n = 0; n < 2; ++n) acc[a][b][m][n] = (f32x4){0.f, 0.f, 0.f, 0.f};
        cur = nxt; cA = nA; cB = nB; ++ui;
        if constexpr (ALIGN_EPI) { if (wr == 1) PG8_BAR; }
    }
    PG8_WAIT_V(0);
    if constexpr (!ALIGN_EPI) { if (wr == 0) PG8_BAR; }
    PG8_BAR;
#undef PG8_SA
#undef PG8_SB
#undef PG8_STAGE
#undef PG8_LDA
#undef PG8_LDB
#undef PG8_MMA
#undef PG8_WAIT_V
#undef PG8_WAIT_L
#undef PG8_BAR
#undef PG8_SCHED
}
}

constexpr size_t MiB = 1u << 20;
constexpr size_t WS_CTL = 0, CTL_ZERO_BYTES = 1 * MiB;
constexpr size_t WS_WIN = 2 * MiB;
constexpr size_t WS_WCAT = WS_WIN + 30 * MiB;
constexpr size_t WS_WOUT = WS_WCAT + 6 * MiB;
constexpr size_t WS_WEI = WS_WOUT + 4 * MiB;
constexpr size_t WS_WEO = WS_WEI + 128 * MiB;
constexpr size_t WS_H = WS_WEO + 64 * MiB;
constexpr size_t WS_PROJ = WS_H + 32 * MiB;
constexpr size_t WS_Q = WS_PROJ + 240 * MiB;
constexpr size_t WS_K = WS_Q + 16 * MiB;
constexpr size_t WS_KMEAN = WS_K + 16 * MiB;
constexpr size_t WS_CAT = WS_KMEAN + 1 * MiB;
constexpr size_t WS_MERGED = WS_CAT + 48 * MiB;
constexpr size_t WS_ORAW = WS_MERGED + 32 * MiB;
constexpr size_t WS_ROUTE = WS_ORAW + 32 * MiB;
constexpr size_t WS_POS = WS_ROUTE + 1 * MiB;
constexpr size_t WS_HS = WS_POS + 1 * MiB;
constexpr size_t WS_ACT = WS_HS + 80 * MiB;
constexpr size_t WS_YS = WS_ACT + 40 * MiB;
constexpr size_t WS_END = WS_YS + 80 * MiB;
static_assert(WS_END <= 1000 * MiB, "workspace map");
constexpr int CW_BAR = 4096;
constexpr int CW_CNT = 16384;
constexpr int CW_NT = CW_CNT + 2 * 32 * 64;
constexpr int CW_TILE = CW_NT + 2 * 64;
static_assert((CW_TILE + 2 * 256) * 4 <= (int)CTL_ZERO_BYTES, "ctl");

constexpr int LDS_SCRATCH = 151552, LDSCTL_OFF = LDS_SCRATCH, LDS_BYTES = 155648;

#define GAS __attribute__((address_space(1)))
#define LAS __attribute__((address_space(3)))
typedef unsigned short bf16;
typedef unsigned v4u __attribute__((ext_vector_type(4)));
typedef unsigned v2u __attribute__((ext_vector_type(2)));
typedef float f32x4 __attribute__((ext_vector_type(4)));
typedef float f32x2 __attribute__((ext_vector_type(2)));
#define RLX_AGENT __ATOMIC_RELAXED, __HIP_MEMORY_SCOPE_AGENT
__device__ __forceinline__ unsigned f2bf(float f) { unsigned u = __builtin_bit_cast(unsigned, f); return (u + 0x7fffu + ((u >> 16) & 1u)) >> 16; }
__device__ __forceinline__ unsigned pk2(float lo, float hi) { return f2bf(lo) | (f2bf(hi) << 16); }
__device__ __forceinline__ float bflo(unsigned w) { return __uint_as_float(w << 16); }
__device__ __forceinline__ float bfhi(unsigned w) { return __uint_as_float(w & 0xffff0000u); }
__device__ __forceinline__ float bf2f(bf16 v) { return __uint_as_float((unsigned)v << 16); }
__device__ __forceinline__ float sigmoidf_(float x) { return 1.0f / (1.0f + __expf(-x)); }
__device__ __forceinline__ float wave_sum(float v) {
#pragma unroll
    for (int o = 1; o < 64; o <<= 1) v += __shfl_xor(v, o);
    return v;
}

#define XB_TMO      128
#define XB_XCNT(j)  (256  + 64 * (j))
#define XB_XSUB(j)  (1280 + 64 * (j))
#define XB_XGEN(j)  (2304 + 64 * (j))
#define XB_TOP      3328
#define XB_TOPGEN   3392
#define XCD_BAR_WORDS 3456
#define XB_SPIN_CAP (1u << 18)
__device__ __forceinline__ unsigned xb_ld(unsigned* p)              { return __hip_atomic_load(p, __ATOMIC_RELAXED, __HIP_MEMORY_SCOPE_AGENT); }
__device__ __forceinline__ unsigned xb_add(unsigned* p, unsigned v) { return __hip_atomic_fetch_add(p, v, __ATOMIC_RELAXED, __HIP_MEMORY_SCOPE_AGENT); }
__device__ __forceinline__ unsigned xb_xcc_id() { return (unsigned)__builtin_amdgcn_s_getreg((3 << 11) | 20) & 0xFu; }
#define XB_SPIN(cond, bar) do { unsigned _sp = 0; while (cond) { __builtin_amdgcn_s_sleep(1); \
    if ((++_sp & 255u) == 0u) { if (xb_ld(&(bar)[XB_TMO])) break; if (_sp > XB_SPIN_CAP) { atomicAdd(&(bar)[XB_TMO], 1u); break; } } } } while (0)
struct XcdBarrier { unsigned* bar; unsigned x; volatile LAS unsigned* st; };
__device__ __forceinline__ XcdBarrier xcd_barrier_post(unsigned* bar, volatile LAS unsigned* st) {
    XcdBarrier b; b.bar = bar; b.x = xb_xcc_id(); b.st = st;
    if (threadIdx.x == 0) (void)xb_add(&bar[XB_XCNT(b.x)], 1u);
    return b;
}
__device__ __forceinline__ void xcd_barrier_complete(unsigned* bar, unsigned x, unsigned& nloc, unsigned& nx) {
    const unsigned G = gridDim.x * gridDim.y * gridDim.z;
    unsigned sum, cnt, mine, sp = 0u;
    for (;;) {
        sum = 0u; cnt = 0u; mine = 0u;
#pragma unroll
        for (unsigned j = 0; j < 16; ++j) { const unsigned c = xb_ld(&bar[XB_XCNT(j)]); sum += c; cnt += (c > 0u) ? 1u : 0u; mine = (j == x) ? c : mine; }
        if (sum == G) break;
        __builtin_amdgcn_s_sleep(1);
        if ((++sp & 255u) == 0u) { if (xb_ld(&bar[XB_TMO])) break; if (sp > XB_SPIN_CAP) { atomicAdd(&bar[XB_TMO], 1u); break; } }
    }
    nloc = mine > 0u ? mine : 1u; nx = cnt > 0u ? cnt : 1u;
}
__device__ __forceinline__ void xcd_barrier(const XcdBarrier& b) {
    asm volatile("s_waitcnt vmcnt(0)" ::: "memory");
    __syncthreads();
    if (threadIdx.x == 0) {
        unsigned* bar = b.bar;
        __builtin_amdgcn_s_waitcnt(0);
        unsigned nloc = b.st[0], nx = b.st[1];
        if (nloc == 0u) { xcd_barrier_complete(bar, b.x, nloc, nx); b.st[0] = nloc; b.st[1] = nx; }
        const unsigned old = xb_add(&bar[XB_XSUB(b.x)], 1u);
        const unsigned gen = old / nloc;
        if (old + 1u == (gen + 1u) * nloc) {
            __builtin_amdgcn_fence(__ATOMIC_RELEASE, "agent");
            asm volatile("s_waitcnt vmcnt(0)" ::: "memory");
            const unsigned og = xb_add(&bar[XB_TOP], 1u);
            const unsigned tg = og / nx;
            if (og + 1u == (tg + 1u) * nx) xb_add(&bar[XB_TOPGEN], 1u);
            else XB_SPIN(xb_ld(&bar[XB_TOPGEN]) == tg, bar);
            __builtin_amdgcn_fence(__ATOMIC_ACQUIRE, "agent");
            xb_add(&bar[XB_XGEN(b.x)], 1u);
            asm volatile("s_waitcnt vmcnt(0)" ::: "memory");
        } else {
            XB_SPIN(xb_ld(&bar[XB_XGEN(b.x)]) == gen, bar);
            __builtin_amdgcn_fence(__ATOMIC_ACQUIRE, "agent");
            asm volatile("s_waitcnt vmcnt(0)" ::: "memory");
        }
    }
    __syncthreads();
}

struct Args { const float* in[23]; float* out; unsigned char* ws; int ph_lo, ph_hi; };
enum InIdx { I_X = 0, I_MIXG, I_WIN, I_BGATE, I_QG, I_KG, I_LBL, I_HGG, I_CONVW, I_CONVB, I_CLNG, I_CLNB, I_WATT, I_WHGRN, I_WCONV, I_WOUT, I_FFNG, I_WCO, I_BCO, I_WFI, I_BFI, I_WEI, I_WEO };

struct Frame {
    unsigned char* lds;
    int tid, lane, wave, G, bid;
    unsigned char* ws; unsigned* ctl;
};
__device__ __forceinline__ Frame fresh(Frame F) { asm volatile("" : "+v"(F.tid)); F.lane = F.tid & 63; F.wave = __builtin_amdgcn_readfirstlane(F.tid >> 6); return F; }

__device__ __forceinline__ void transpose_item(const float* W, int K, int N, bf16* WT, int k0, int n0, int drow0, float* scr, int lane) {
#pragma unroll 8
    for (int i = 0; i < 32; ++i) { const int kk = 2 * i + (lane >> 5); scr[kk * 33 + (lane & 31)] = W[(size_t)(k0 + kk) * N + n0 + (lane & 31)]; }
    asm volatile("s_waitcnt lgkmcnt(0)" ::: "memory");
    const int c = lane & 7;
#pragma unroll
    for (int j = 0; j < 4; ++j) { const int n = (lane >> 3) + 8 * j; const float* s = scr + (8 * c) * 33 + n;
        v4u o; o.x = pk2(s[0 * 33], s[1 * 33]); o.y = pk2(s[2 * 33], s[3 * 33]); o.z = pk2(s[4 * 33], s[5 * 33]); o.w = pk2(s[6 * 33], s[7 * 33]);
        *(v4u*)(WT + (size_t)(drow0 + n) * K + k0 + 8 * c) = o; }
    asm volatile("s_waitcnt lgkmcnt(0)" ::: "memory");
}

__device__ __forceinline__ void phase_prologue(const Frame& F0, const Args& A) {
    const Frame F = fresh(F0);
    float* scr = (float*)(F.lds + F.wave * 16384);
    const int gw = F.bid * 8 + F.wave, NGW = F.G * 8;
    constexpr int I_IN = (DM / 64) * (NCOL / 32);
    constexpr int I_BR = (512 / 64) * (DM / 32);
    constexpr int I_OUT = (DM / 64) * (DM / 32);
    constexpr int I_EI = (DM / 64) * (1024 / 32);
    constexpr int I_EO = (FF / 64) * (DM / 32);
    constexpr int PER_L = I_IN + 3 * I_BR + I_OUT + NEXP * I_EI + NEXP * I_EO;
    for (int it = gw; it < DEPTH * PER_L; it += NGW) {
        const int l = it / PER_L; int r = it % PER_L;
        if (r < I_IN) { const int nblk = NCOL / 32, kb = r / nblk, nb = r % nblk;
            transpose_item(A.in[I_WIN] + (size_t)l * DM * NCOL, DM, NCOL, (bf16*)(F.ws + WS_WIN) + (size_t)l * NCOL * DM, 64 * kb, 32 * nb, 32 * nb, scr, F.lane); continue; }
        r -= I_IN;
        if (r < 3 * I_BR) { const int br = r / I_BR, rr = r % I_BR, nblk = DM / 32, kb = rr / nblk, nb = rr % nblk;
            const float* W = A.in[br == 0 ? I_WATT : (br == 1 ? I_WHGRN : I_WCONV)] + (size_t)l * 512 * DM;
            transpose_item(W, 512, DM, (bf16*)(F.ws + WS_WCAT) + ((size_t)l * 3 + br) * DM * 512, 64 * kb, 32 * nb, 32 * nb, scr, F.lane); continue; }
        r -= 3 * I_BR;
        if (r < I_OUT) { const int nblk = DM / 32, kb = r / nblk, nb = r % nblk;
            transpose_item(A.in[I_WOUT] + (size_t)l * DM * DM, DM, DM, (bf16*)(F.ws + WS_WOUT) + (size_t)l * DM * DM, 64 * kb, 32 * nb, 32 * nb, scr, F.lane); continue; }
        r -= I_OUT;
        if (r < NEXP * I_EI) { const int e = r / I_EI, rr = r % I_EI, nblk = 1024 / 32, kb = rr / nblk, nb = rr % nblk, n0 = 32 * nb;
            const int nn = n0 & 511, drow0 = (nn >> 7) * 256 + (n0 >= 512 ? 128 : 0) + (nn & 127);
            transpose_item(A.in[I_WEI] + ((size_t)l * NEXP + e) * DM * 1024, DM, 1024, (bf16*)(F.ws + WS_WEI) + ((size_t)l * NEXP + e) * 1024 * DM, 64 * kb, n0, drow0, scr, F.lane); continue; }
        r -= NEXP * I_EI;
        { const int e = r / I_EO, rr = r % I_EO, nblk = DM / 32, kb = rr / nblk, nb = rr % nblk;
            transpose_item(A.in[I_WEO] + ((size_t)l * NEXP + e) * FF * DM, FF, DM, (bf16*)(F.ws + WS_WEO) + ((size_t)l * NEXP + e) * DM * FF, 64 * kb, 32 * nb, 32 * nb, scr, F.lane); }
    }
}

__device__ __forceinline__ void phase_norm(const Frame& F0, const float* x, const float* gain, bf16* out) {
    const Frame F = fresh(F0);
    const int gw = F.bid * 8 + F.wave, NGW = F.G * 8;
    f32x4 g[4];
#pragma unroll
    for (int j = 0; j < 4; ++j) g[j] = *(const f32x4*)(gain + 4 * F.lane + 256 * j);
    for (int m = gw; m < T; m += NGW) {
        const f32x4* xr = (const f32x4*)(x + (size_t)m * DM) + F.lane;
        f32x4 v[4]; float s = 0.f;
#pragma unroll
        for (int j = 0; j < 4; ++j) { v[j] = xr[64 * j]; s += (v[j].x * v[j].x + v[j].y * v[j].y) + (v[j].z * v[j].z + v[j].w * v[j].w); }
        const float r = rsqrtf(wave_sum(s) * (1.f / DM) + RMS_EPS);
        v2u* o8 = (v2u*)(out + (size_t)m * DM) + F.lane;
#pragma unroll
        for (int j = 0; j < 4; ++j) { v2u w; w.x = pk2(v[j].x * r * g[j].x, v[j].y * r * g[j].y); w.y = pk2(v[j].z * r * g[j].z, v[j].w * r * g[j].w); o8[64 * j] = w; }
    }
}

__device__ __forceinline__ void phase_qkprep(const Frame& F0, const bf16* proj, const float* qg, const float* kg, bf16* Q, bf16* Kb, float* kmean) {
    const Frame F = fresh(F0);
    float* red = (float*)F.lds;
    float* red2 = red + 256 * 65;
    const int tok = F.tid >> 1, hf = F.tid & 1;
    for (int u = F.bid; u < 512; u += F.G) {
        const int b = u >> 6, blk = (u >> 3) & 7, h = u & 7;
        const size_t row = (size_t)b * SEQ + blk * 256 + tok;
        const bf16* pq = proj + row * NCOL + C_AQ + h * 64 + hf * 32;
        const bf16* pk = proj + row * NCOL + C_AK + h * 64 + hf * 32;
        float qv[32], kv[32];
#pragma unroll
        for (int i = 0; i < 4; ++i) { const v4u a = *(const v4u*)(pq + 8 * i), c = *(const v4u*)(pk + 8 * i);
            qv[8 * i + 0] = bflo(a.x); qv[8 * i + 1] = bfhi(a.x); qv[8 * i + 2] = bflo(a.y); qv[8 * i + 3] = bfhi(a.y); qv[8 * i + 4] = bflo(a.z); qv[8 * i + 5] = bfhi(a.z); qv[8 * i + 6] = bflo(a.w); qv[8 * i + 7] = bfhi(a.w);
            kv[8 * i + 0] = bflo(c.x); kv[8 * i + 1] = bfhi(c.x); kv[8 * i + 2] = bflo(c.y); kv[8 * i + 3] = bfhi(c.y); kv[8 * i + 4] = bflo(c.z); kv[8 * i + 5] = bfhi(c.z); kv[8 * i + 6] = bflo(c.w); kv[8 * i + 7] = bfhi(c.w); }
        float sq = 0.f, sk = 0.f;
#pragma unroll
        for (int i = 0; i < 32; ++i) { sq += qv[i] * qv[i]; sk += kv[i] * kv[i]; }
        sq += __shfl_xor(sq, 1); sk += __shfl_xor(sk, 1);
        const float rq = rsqrtf(sq * (1.f / 64.f) + RMS_EPS) * QSCALE, rk = rsqrtf(sk * (1.f / 64.f) + RMS_EPS);
#pragma unroll
        for (int i = 0; i < 32; ++i) { qv[i] = qv[i] * rq * qg[hf * 32 + i]; kv[i] = kv[i] * rk * kg[hf * 32 + i]; }
        bf16* oq = Q + row * 512 + h * 64 + hf * 32; bf16* ok = Kb + row * 512 + h * 64 + hf * 32;
#pragma unroll
        for (int i = 0; i < 4; ++i) { v4u a, c;
            a.x = pk2(qv[8 * i], qv[8 * i + 1]); a.y = pk2(qv[8 * i + 2], qv[8 * i + 3]); a.z = pk2(qv[8 * i + 4], qv[8 * i + 5]); a.w = pk2(qv[8 * i + 6], qv[8 * i + 7]);
            c.x = pk2(kv[8 * i], kv[8 * i + 1]); c.y = pk2(kv[8 * i + 2], kv[8 * i + 3]); c.z = pk2(kv[8 * i + 4], kv[8 * i + 5]); c.w = pk2(kv[8 * i + 6], kv[8 * i + 7]);
            *(v4u*)(oq + 8 * i) = a; *(v4u*)(ok + 8 * i) = c; }
        __syncthreads();
#pragma unroll
        for (int i = 0; i < 32; ++i) red[tok * 65 + hf * 32 + i] = kv[i];
        __syncthreads();
        { const int d = F.tid & 63, part = F.tid >> 6; float s = 0.f;
            for (int tk = 0; tk < 32; ++tk) s += red[(part * 32 + tk) * 65 + d];
            red2[part * 64 + d] = s; }
        __syncthreads();
        if (F.tid < 64) { float s = 0.f;
#pragma unroll
            for (int p = 0; p < 8; ++p) s += red2[p * 64 + F.tid];
            kmean[(((size_t)b * 8 + h) * 8 + blk) * 64 + F.tid] = s * (1.f / 256.f); }
    }
    __syncthreads();
}

__device__ __forceinline__ void phase_conv(const Frame& F0, const bf16* proj, const float* cw, const float* cb, const float* lng, const float* lnb, bf16* cat) {
    const Frame F = fresh(F0);
    float* cv = (float*)F.lds;
    const int c = F.tid;
    float w[31];
#pragma unroll
    for (int j = 0; j < 31; ++j) w[j] = cw[j * 512 + c];
    const float bias = cb[c];
    for (int u = F.bid; u < 512; u += F.G) {
        const int b = u >> 6, t0 = (u & 63) * 32;
        float uu[62];
#pragma unroll
        for (int i = 0; i < 62; ++i) { const int t = t0 - 30 + i;
            if (t >= 0) { const size_t row = (size_t)b * SEQ + t; const float a = bf2f(proj[row * NCOL + C_CA + c]), g = bf2f(proj[row * NCOL + C_CB + c]); uu[i] = a * sigmoidf_(g); }
            else uu[i] = 0.f; }
        __syncthreads();
#pragma unroll
        for (int t = 0; t < 32; ++t) { float a = bias;
#pragma unroll
            for (int j = 0; j < 31; ++j) a += w[j] * uu[t + j];
            cv[t * 512 + c] = a; }
        __syncthreads();
#pragma unroll
        for (int q = 0; q < 4; ++q) { const int t = F.wave * 4 + q;
            const f32x4 v0 = *(const f32x4*)(cv + t * 512 + 8 * F.lane), v1 = *(const f32x4*)(cv + t * 512 + 8 * F.lane + 4);
            const float mu = wave_sum((v0.x + v0.y) + (v0.z + v0.w) + (v1.x + v1.y) + (v1.z + v1.w)) * (1.f / 512.f);
            const f32x4 d0 = v0 - mu, d1 = v1 - mu;
            const float var = wave_sum((d0.x * d0.x + d0.y * d0.y) + (d0.z * d0.z + d0.w * d0.w) + (d1.x * d1.x + d1.y * d1.y) + (d1.z * d1.z + d1.w * d1.w)) * (1.f / 512.f);
            const float rs = rsqrtf(var + LN_EPS);
            const f32x4 g0 = *(const f32x4*)(lng + 8 * F.lane), g1 = *(const f32x4*)(lng + 8 * F.lane + 4), b0 = *(const f32x4*)(lnb + 8 * F.lane), b1 = *(const f32x4*)(lnb + 8 * F.lane + 4);
            f32x4 y0 = d0 * rs * g0 + b0, y1 = d1 * rs * g1 + b1;
            y0.x *= sigmoidf_(y0.x); y0.y *= sigmoidf_(y0.y); y0.z *= sigmoidf_(y0.z); y0.w *= sigmoidf_(y0.w);
            y1.x *= sigmoidf_(y1.x); y1.y *= sigmoidf_(y1.y); y1.z *= sigmoidf_(y1.z); y1.w *= sigmoidf_(y1.w);
            v4u o; o.x = pk2(y0.x, y0.y); o.y = pk2(y0.z, y0.w); o.z = pk2(y1.x, y1.y); o.w = pk2(y1.z, y1.w);
            *(v4u*)(cat + ((size_t)b * SEQ + t0 + t) * 1536 + 1024 + 8 * F.lane) = o; }
    }
    __syncthreads();
}

__device__ __forceinline__ void phase_hgrn_naive(const Frame& F0, const bf16* proj, const float* lbl, int layer, float* oraw) {
    const Frame F = fresh(F0);
    float* part = (float*)F.lds;
    const int k = F.tid & 127, vq = F.tid >> 7;
    for (int u = F.bid; u < 256; u += F.G) {
        const int b = u >> 5, h = (u >> 3) & 3, vs = u & 7;
        float lb = 0.f;
        if (layer > 0) { const float l0 = lbl[h * 128 + k], l1 = lbl[512 + h * 128 + k]; lb = 1.f / (1.f + __expf(l0 - l1)); }
        const float omlb = 1.f - lb;
        float S0 = 0.f, S1 = 0.f, S2 = 0.f, S3 = 0.f;
        const bf16* pq = proj + (size_t)b * SEQ * NCOL + C_HQ + h * 128 + k;
        const bf16* pf = proj + (size_t)b * SEQ * NCOL + C_HF + h * 128 + k;
        const bf16* pv = proj + (size_t)b * SEQ * NCOL + C_HI + h * 128 + vs * 16 + vq * 4;
        for (int t0 = 0; t0 < SEQ; t0 += 32) {
#pragma unroll 4
            for (int tt = 0; tt < 32; ++tt) {
                const size_t ro = (size_t)(t0 + tt) * NCOL;
                const float qv = bf2f(pq[ro]), fr = bf2f(pf[ro]); const v2u vv = *(const v2u*)(pv + ro);
                const float sig = sigmoidf_(fr), f = lb + omlb * sig, kk = omlb * (1.f - sig), qa = qv * sigmoidf_(qv);
                S0 = f * S0 + kk * bflo(vv.x); S1 = f * S1 + kk * bfhi(vv.x); S2 = f * S2 + kk * bflo(vv.y); S3 = f * S3 + kk * bfhi(vv.y);
                const float p0 = wave_sum(qa * S0), p1 = wave_sum(qa * S1), p2 = wave_sum(qa * S2), p3 = wave_sum(qa * S3);
                if (F.lane == 0) *(f32x4*)(part + (tt * 8 + F.wave) * 4) = (f32x4){p0, p1, p2, p3};
            }
            __syncthreads();
            if (F.tid < 128) { const int tt = F.tid >> 2, v2 = F.tid & 3;
                const f32x4 a = *(const f32x4*)(part + (tt * 8 + v2 * 2) * 4), c = *(const f32x4*)(part + (tt * 8 + v2 * 2 + 1) * 4);
                *(f32x4*)(oraw + ((size_t)b * SEQ + t0 + tt) * 512 + h * 128 + vs * 16 + v2 * 4) = a + c; }
            __syncthreads();
        }
    }
}

__device__ __forceinline__ void phase_hgrn_post(const Frame& F0, const float* oraw, const bf16* proj, const float* hgg, bf16* cat) {
    const Frame F = fresh(F0);
    const int gw = F.bid * 8 + F.wave, NGW = F.G * 8;
    const f32x2 g = *(const f32x2*)(hgg + 2 * F.lane);
    for (int it = gw; it < T * 4; it += NGW) {
        const int row = it >> 2, h = it & 3;
        const f32x2 o = *(const f32x2*)(oraw + (size_t)row * 512 + h * 128 + 2 * F.lane);
        const unsigned hw = *(const unsigned*)(proj + (size_t)row * NCOL + C_HG + h * 128 + 2 * F.lane);
        const float r = rsqrtf(wave_sum(o.x * o.x + o.y * o.y) * (1.f / 128.f) + RMS_EPS);
        const float g0 = bflo(hw), g1 = bfhi(hw);
        const float y0 = o.x * r * g.x * (g0 * sigmoidf_(g0)), y1 = o.y * r * g.y * (g1 * sigmoidf_(g1));
        *(unsigned*)(cat + (size_t)row * 1536 + 512 + h * 128 + 2 * F.lane) = pk2(y0, y1);
    }
}

__device__ __forceinline__ void attn_naive_unit(const Frame& F, int b, int h, int qb, const bf16* Q, const bf16* Kb, const bf16* proj, const float* kmean, bf16* cat) {
    float* Ks = (float*)F.lds;
    float* Vs = Ks + 64 * 64;
    const int qi = F.tid >> 1, half = F.tid & 1;
    const size_t row0 = (size_t)b * SEQ + qb * 256;
    float q[32];
    { const bf16* pq = Q + (row0 + qi) * 512 + h * 64 + half * 32;
#pragma unroll
        for (int i = 0; i < 4; ++i) { const v4u a = *(const v4u*)(pq + 8 * i);
            q[8 * i + 0] = bflo(a.x); q[8 * i + 1] = bfhi(a.x); q[8 * i + 2] = bflo(a.y); q[8 * i + 3] = bfhi(a.y); q[8 * i + 4] = bflo(a.z); q[8 * i + 5] = bfhi(a.z); q[8 * i + 6] = bflo(a.w); q[8 * i + 7] = bfhi(a.w); } }
    unsigned selmask;
    if (qb <= 3) selmask = (1u << qb) - 1u;
    else {
        float gate[7];
#pragma unroll
        for (int j = 0; j < 7; ++j) { gate[j] = -3.0e38f;
            if (j < qb) { const float* km = kmean + (((size_t)b * 8 + h) * 8 + j) * 64 + half * 32; float s = 0.f;
#pragma unroll
                for (int d = 0; d < 32; ++d) s += q[d] * km[d];
                s += __shfl_xor(s, 1);
                gate[j] = s; } }
        selmask = 0u;
#pragma unroll
        for (int r = 0; r < 3; ++r) { float best = -3.0e38f; int bi = 0;
#pragma unroll
            for (int j = 0; j < 7; ++j) { const bool ok = (j < qb) && !((selmask >> j) & 1u) && (gate[j] > best); if (ok) { best = gate[j]; bi = j; } }
            selmask |= 1u << bi; }
    }
    float acc[32];
#pragma unroll
    for (int d = 0; d < 32; ++d) acc[d] = 0.f;
    float l = 0.f;
    const int skey = F.tid >> 3, sseg = F.tid & 7;
    for (int j = 0; j <= qb; ++j) {
        for (int kt = 0; kt < 4; ++kt) {
            __syncthreads();
            { const size_t krow = (size_t)b * SEQ + j * 256 + kt * 64 + skey;
                const v4u kk = *(const v4u*)(Kb + krow * 512 + h * 64 + sseg * 8), vv = *(const v4u*)(proj + krow * NCOL + C_AV + h * 64 + sseg * 8);
                *(f32x4*)(Ks + skey * 64 + sseg * 8) = (f32x4){bflo(kk.x), bfhi(kk.x), bflo(kk.y), bfhi(kk.y)}; *(f32x4*)(Ks + skey * 64 + sseg * 8 + 4) = (f32x4){bflo(kk.z), bfhi(kk.z), bflo(kk.w), bfhi(kk.w)};
                *(f32x4*)(Vs + skey * 64 + sseg * 8) = (f32x4){bflo(vv.x), bfhi(vv.x), bflo(vv.y), bfhi(vv.y)}; *(f32x4*)(Vs + skey * 64 + sseg * 8 + 4) = (f32x4){bflo(vv.z), bfhi(vv.z), bflo(vv.w), bfhi(vv.w)}; }
            __syncthreads();
            if (j == qb && kt > (F.wave >> 1)) continue;
#pragma unroll 2
            for (int key = 0; key < 64; ++key) {
                float s = 0.f;
#pragma unroll
                for (int d = 0; d < 32; d += 4) { const f32x4 kx = *(const f32x4*)(Ks + key * 64 + half * 32 + d); s += q[d] * kx.x + q[d + 1] * kx.y + q[d + 2] * kx.z + q[d + 3] * kx.w; }
                s += __shfl_xor(s, 1);
                const bool valid = (j == qb) ? (kt * 64 + key <= qi) : (((selmask >> j) & 1u) != 0u);
                const float p = valid ? exp2f(s) : 0.f;
                l += p;
#pragma unroll
                for (int d = 0; d < 32; d += 4) { const f32x4 vx = *(const f32x4*)(Vs + key * 64 + half * 32 + d); acc[d] += p * vx.x; acc[d + 1] += p * vx.y; acc[d + 2] += p * vx.z; acc[d + 3] += p * vx.w; }
            }
        }
    }
    { const float rl = 1.f / l;
        bf16* po = cat + (row0 + qi) * 1536 + h * 64 + half * 32;
#pragma unroll
        for (int i = 0; i < 4; ++i) { v4u o; o.x = pk2(acc[8 * i] * rl, acc[8 * i + 1] * rl); o.y = pk2(acc[8 * i + 2] * rl, acc[8 * i + 3] * rl); o.z = pk2(acc[8 * i + 4] * rl, acc[8 * i + 5] * rl); o.w = pk2(acc[8 * i + 6] * rl, acc[8 * i + 7] * rl); *(v4u*)(po + 8 * i) = o; }
    }
}
__device__ __forceinline__ void phase_attn_naive(const Frame& F0, const bf16* Q, const bf16* Kb, const bf16* proj, const float* kmean, bf16* cat) {
    const Frame F = fresh(F0);
    for (int p = F.bid; p < 256; p += F.G) {
        const int bh = p >> 2, s = p & 3;
#pragma unroll 1
        for (int i = 0; i < 2; ++i) attn_naive_unit(F, bh >> 3, bh & 7, i ? s : 7 - s, Q, Kb, proj, kmean, cat);
    }
    __syncthreads();
}

struct SchedDense {
    const char* A; const char* B; int nM, nN, G, c; size_t ta, tb;
    __device__ __forceinline__ bool next(int i, pg8::Unit& u) const {
        int pm, pn; if (!pg8::static_tile(nM, nN, (long)i * G + c, pm, pn)) return false;
        u.pm = pm; u.pn = pn; u.aux = 0; u.pad = 0; u.a = A + (size_t)pm * ta; u.b = B + (size_t)pn * tb; return true; }
};
struct SchedBranch {
    const char* A; const char* B; int G, c;
    __device__ __forceinline__ bool next(int i, pg8::Unit& u) const {
        int pm, pn; if (!pg8::static_tile(T / 256, DM / 256, (long)(i / 3) * G + c, pm, pn)) return false;
        const int seg = i % 3;
        u.pm = pm; u.pn = pn; u.aux = seg; u.pad = 0; u.a = A + ((size_t)pm * 256 * 1536 + seg * 512) * 2; u.b = B + ((size_t)seg * DM * 512 + (size_t)pn * 256 * 512) * 2; return true; }
};
struct SchedMoe {
    const char* A; const char* B; const unsigned* ntp; const unsigned* tile_e; int G, c; size_t ta, tb_e, tb_n;
    __device__ __forceinline__ bool next(int i, pg8::Unit& u) const {
        const int nt = (int)__builtin_amdgcn_readfirstlane(*ntp);
        const long L = (long)i * G + c; if (L >= (long)nt * 4) return false;
        const int tile = (int)(L >> 2), pn = (int)(L & 3); const int e = (int)__builtin_amdgcn_readfirstlane(tile_e[tile]);
        u.pm = tile; u.pn = pn; u.aux = e; u.pad = 0; u.a = A + (size_t)tile * ta; u.b = B + (size_t)e * tb_e + (size_t)pn * tb_n; return true; }
};

typedef pg8::f32x4 af4;
struct EpiStoreBf16 {
    static constexpr bool PERM = true;
    bf16* O; int ldc;
    __device__ __forceinline__ void operator()(af4 (&acc)[2][2][4][2], const pg8::Unit& u, int wr, int wc, int fr, int fq) const {
        const int row0 = u.pm * 256 + wr * 64 + fr, col0 = u.pn * 256 + wc * 32 + 8 * fq;
#pragma unroll
        for (int ai = 0; ai < 2; ++ai)
#pragma unroll
            for (int m = 0; m < 4; ++m) { bf16* rowp = O + (size_t)(row0 + ai * 128 + m * 16) * ldc + col0;
#pragma unroll
                for (int bj = 0; bj < 2; ++bj) { const af4 v0 = acc[ai][bj][m][0], v1 = acc[ai][bj][m][1]; v4u w;
                    w.x = pg8::cvt_pk_bf16(v0[0], v0[1]); w.y = pg8::cvt_pk_bf16(v0[2], v0[3]); w.z = pg8::cvt_pk_bf16(v1[0], v1[1]); w.w = pg8::cvt_pk_bf16(v1[2], v1[3]);
                    *(v4u*)(rowp + bj * 128) = w; } }
    }
};
struct EpiBranch {
    static constexpr bool PERM = true;
    const bf16* proj; const float* bgate; bf16* merged;
    __device__ __forceinline__ void operator()(af4 (&acc)[2][2][4][2], const pg8::Unit& u, int wr, int wc, int fr, int fq) const {
        const int seg = u.aux, row0 = u.pm * 256 + wr * 64 + fr, col0 = u.pn * 256 + wc * 32 + 8 * fq;
#pragma unroll
        for (int bj = 0; bj < 2; ++bj) { const int col = col0 + bj * 128;
            const af4 bg0 = *(const af4*)(bgate + seg * DM + col), bg1 = *(const af4*)(bgate + seg * DM + col + 4);
#pragma unroll
            for (int ai = 0; ai < 2; ++ai)
#pragma unroll
                for (int m = 0; m < 4; ++m) { const size_t row = (size_t)(row0 + ai * 128 + m * 16);
                    const v4u gl = *(const v4u*)(proj + row * NCOL + C_GL + seg * DM + col);
                    const af4 v0 = acc[ai][bj][m][0], v1 = acc[ai][bj][m][1];
                    float o[8];
                    o[0] = v0[0] * sigmoidf_(bflo(gl.x) + bg0[0]); o[1] = v0[1] * sigmoidf_(bfhi(gl.x) + bg0[1]); o[2] = v0[2] * sigmoidf_(bflo(gl.y) + bg0[2]); o[3] = v0[3] * sigmoidf_(bfhi(gl.y) + bg0[3]);
                    o[4] = v1[0] * sigmoidf_(bflo(gl.z) + bg1[0]); o[5] = v1[1] * sigmoidf_(bfhi(gl.z) + bg1[1]); o[6] = v1[2] * sigmoidf_(bflo(gl.w) + bg1[2]); o[7] = v1[3] * sigmoidf_(bfhi(gl.w) + bg1[3]);
                    bf16* mp = merged + row * DM + col;
                    if (seg > 0) { const v4u old = *(const v4u*)mp;
                        o[0] += bflo(old.x); o[1] += bfhi(old.x); o[2] += bflo(old.y); o[3] += bfhi(old.y); o[4] += bflo(old.z); o[5] += bfhi(old.z); o[6] += bflo(old.w); o[7] += bfhi(old.w); }
                    v4u w; w.x = pg8::cvt_pk_bf16(o[0], o[1]); w.y = pg8::cvt_pk_bf16(o[2], o[3]); w.z = pg8::cvt_pk_bf16(o[4], o[5]); w.w = pg8::cvt_pk_bf16(o[6], o[7]);
                    *(v4u*)mp = w; } }
    }
};
struct EpiResidual {
    static constexpr bool PERM = false;
    const float* xin; float* xout;
    __device__ __forceinline__ void operator()(af4 (&acc)[2][2][4][2], const pg8::Unit& u, int wr, int wc, int fr, int fq) const {
        const int row0 = u.pm * 256 + wr * 64 + fr, col0 = u.pn * 256 + wc * 32 + 4 * fq;
#pragma unroll
        for (int ai = 0; ai < 2; ++ai)
#pragma unroll
            for (int m = 0; m < 4; ++m) { const size_t off = (size_t)(row0 + ai * 128 + m * 16) * DM + col0;
#pragma unroll
                for (int bj = 0; bj < 2; ++bj)
#pragma unroll
                    for (int n = 0; n < 2; ++n) { const af4 r = *(const af4*)(xin + off + bj * 128 + n * 16); *(af4*)(xout + off + bj * 128 + n * 16) = r + acc[ai][bj][m][n]; } }
    }
};
struct EpiSwiglu {
    static constexpr bool PERM = true;
    bf16* act;
    __device__ __forceinline__ void operator()(af4 (&acc)[2][2][4][2], const pg8::Unit& u, int wr, int wc, int fr, int fq) const {
        const int row0 = u.pm * 256 + wr * 64 + fr, col0 = u.pn * 128 + wc * 32 + 8 * fq;
#pragma unroll
        for (int ai = 0; ai < 2; ++ai)
#pragma unroll
            for (int m = 0; m < 4; ++m) { const af4 g0 = acc[ai][0][m][0], g1 = acc[ai][0][m][1], u0 = acc[ai][1][m][0], u1 = acc[ai][1][m][1];
                float o[8];
#pragma unroll
                for (int i = 0; i < 4; ++i) { o[i] = g0[i] * sigmoidf_(g0[i]) * u0[i]; o[4 + i] = g1[i] * sigmoidf_(g1[i]) * u1[i]; }
                v4u w; w.x = pg8::cvt_pk_bf16(o[0], o[1]); w.y = pg8::cvt_pk_bf16(o[2], o[3]); w.z = pg8::cvt_pk_bf16(o[4], o[5]); w.w = pg8::cvt_pk_bf16(o[6], o[7]);
                *(v4u*)(act + (size_t)(row0 + ai * 128 + m * 16) * FF + col0) = w; }
    }
};
struct EpiScaleRows {
    static constexpr bool PERM = true;
    bf16* ys; const float* wrow;
    __device__ __forceinline__ void operator()(af4 (&acc)[2][2][4][2], const pg8::Unit& u, int wr, int wc, int fr, int fq) const {
        const int row0 = u.pm * 256 + wr * 64 + fr, col0 = u.pn * 256 + wc * 32 + 8 * fq;
#pragma unroll
        for (int ai = 0; ai < 2; ++ai)
#pragma unroll
            for (int m = 0; m < 4; ++m) { const int row = row0 + ai * 128 + m * 16; const float s = wrow[row]; bf16* rowp = ys + (size_t)row * DM + col0;
#pragma unroll
                for (int bj = 0; bj < 2; ++bj) { const af4 v0 = acc[ai][bj][m][0] * s, v1 = acc[ai][bj][m][1] * s; v4u w;
                    w.x = pg8::cvt_pk_bf16(v0[0], v0[1]); w.y = pg8::cvt_pk_bf16(v0[2], v0[3]); w.z = pg8::cvt_pk_bf16(v1[0], v1[1]); w.w = pg8::cvt_pk_bf16(v1[2], v1[3]);
                    *(v4u*)(rowp + bj * 128) = w; } }
    }
};

constexpr int RW_PITCH = 1028;
__device__ __forceinline__ void phase_router(const Frame& F0, const float* x, const float* gain, const float* wco, const float* bco, const float* wfi, const float* bfi,
                                             bf16* hout, unsigned* route, unsigned* cnt) {
    const Frame F = fresh(F0);
    float* WT = (float*)F.lds;
    for (int idx = F.tid; idx < DM * 4; idx += 512) { const int k = idx >> 2, j = idx & 3; WT[j * RW_PITCH + k] = wco[idx]; }
    for (int idx = F.tid; idx < DM * 32; idx += 512) { const int k = idx >> 5, e = idx & 31; WT[(4 + e) * RW_PITCH + k] = wfi[idx]; }
    __syncthreads();
    const int gw = F.bid * 8 + F.wave, NGW = F.G * 8;
    f32x4 g[4];
#pragma unroll
    for (int j = 0; j < 4; ++j) g[j] = *(const f32x4*)(gain + 4 * F.lane + 256 * j);
    for (int m = gw; m < T; m += NGW) {
        const f32x4* xr = (const f32x4*)(x + (size_t)m * DM) + F.lane;
        f32x4 v[4]; float s = 0.f;
#pragma unroll
        for (int j = 0; j < 4; ++j) { v[j] = xr[64 * j]; s += (v[j].x * v[j].x + v[j].y * v[j].y) + (v[j].z * v[j].z + v[j].w * v[j].w); }
        const float r = rsqrtf(wave_sum(s) * (1.f / DM) + RMS_EPS);
        v2u* o8 = (v2u*)(hout + (size_t)m * DM) + F.lane;
#pragma unroll
        for (int j = 0; j < 4; ++j) { v[j] = v[j] * r * g[j]; v2u w; w.x = pk2(v[j].x, v[j].y); w.y = pk2(v[j].z, v[j].w); o8[64 * j] = w; }
        float* lg = WT + 36 * RW_PITCH + F.wave * 40;
#pragma unroll 2
        for (int c = 0; c < 36; ++c) { float p = 0.f;
#pragma unroll
            for (int j = 0; j < 4; ++j) { const f32x4 w = *(const f32x4*)(WT + c * RW_PITCH + 4 * F.lane + 256 * j); p += (v[j].x * w.x + v[j].y * w.y) + (v[j].z * w.z + v[j].w * w.w); }
            p = wave_sum(p); if (F.lane == 0) lg[c] = p; }
        asm volatile("s_waitcnt lgkmcnt(0)" ::: "memory");
        float c0 = lg[0] + bco[0], c1 = lg[1] + bco[1], c2 = lg[2] + bco[2], c3 = lg[3] + bco[3];
        int grp = 0; float cm = c0;
        if (c1 > cm) { cm = c1; grp = 1; } if (c2 > cm) { cm = c2; grp = 2; } if (c3 > cm) { cm = c3; grp = 3; }
        const float ptop = 1.f / (__expf(c0 - cm) + __expf(c1 - cm) + __expf(c2 - cm) + __expf(c3 - cm));
        float fs[8];
#pragma unroll
        for (int i = 0; i < 8; ++i) { float a = lg[4 + i] + bfi[i], b = lg[12 + i] + bfi[8 + i], c = lg[20 + i] + bfi[16 + i], d = lg[28 + i] + bfi[24 + i]; fs[i] = grp == 0 ? a : (grp == 1 ? b : (grp == 2 ? c : d)); }
        int i1 = 0; float v1 = fs[0];
#pragma unroll
        for (int i = 1; i < 8; ++i) if (fs[i] > v1) { v1 = fs[i]; i1 = i; }
        int i2 = -1; float v2 = -3.0e38f;
#pragma unroll
        for (int i = 0; i < 8; ++i) if (i != i1 && fs[i] > v2) { v2 = fs[i]; i2 = i; }
        const float e2 = __expf(v2 - v1), w1 = ptop / (1.f + e2), w2 = ptop * e2 / (1.f + e2);
        if (F.lane == 0) {
            const int ea = grp * 8 + i1, eb = grp * 8 + i2;
            const unsigned ra = __hip_atomic_fetch_add(cnt + 64 * ea, 1u, RLX_AGENT), rb = __hip_atomic_fetch_add(cnt + 64 * eb, 1u, RLX_AGENT);
            v4u o; o.x = (unsigned)ea; o.y = (unsigned)eb; o.z = ra; o.w = rb; *(v4u*)(route + (size_t)m * 8) = o;
            *(f32x2*)(route + (size_t)m * 8 + 4) = (f32x2){w1, w2};
        }
    }
    __syncthreads();
}

__device__ __forceinline__ void phase_scatter(const Frame& F0, const bf16* hin, const unsigned* route, const unsigned* cnt, unsigned* ntp, unsigned* tile_e, bf16* hs, float* wrow, unsigned* pos) {
    const Frame F = fresh(F0);
    unsigned* off = (unsigned*)F.lds;
    if (F.tid == 0) { unsigned o = 0;
        for (int e = 0; e < NEXP; ++e) { off[e] = o; const unsigned c = __hip_atomic_load(cnt + 64 * e, RLX_AGENT); const unsigned p = (c + 255u) & ~255u;
            if (F.bid == 0) for (unsigned tI = o >> 8; tI < ((o + p) >> 8); ++tI) tile_e[tI] = (unsigned)e;
            o += p; }
        off[NEXP] = o; if (F.bid == 0) *ntp = o >> 8; }
    __syncthreads();
    const int gw = F.bid * 8 + F.wave, NGW = F.G * 8;
    for (int m = gw; m < T; m += NGW) {
        const v4u ri = *(const v4u*)(route + (size_t)m * 8); const f32x2 ww = *(const f32x2*)(route + (size_t)m * 8 + 4);
        const unsigned d0 = off[ri.x] + ri.z, d1 = off[ri.y] + ri.w;
        const v4u* src = (const v4u*)(hin + (size_t)m * DM) + F.lane;
        const v4u a = src[0], b = src[64];
        v4u* p0 = (v4u*)(hs + (size_t)d0 * DM) + F.lane; v4u* p1 = (v4u*)(hs + (size_t)d1 * DM) + F.lane;
        p0[0] = a; p0[64] = b; p1[0] = a; p1[64] = b;
        if (F.lane == 0) { wrow[d0] = ww.x; wrow[d1] = ww.y; *(v2u*)(pos + (size_t)m * 2) = (v2u){d0, d1}; }
    }
    __syncthreads();
}

__device__ __forceinline__ void phase_combine(const Frame& F0, float* x, const bf16* ys, const unsigned* pos, const float* ngain, bf16* hout) {
    const Frame F = fresh(F0);
    const int gw = F.bid * 8 + F.wave, NGW = F.G * 8;
    f32x4 g[4];
#pragma unroll
    for (int j = 0; j < 4; ++j) g[j] = ngain ? *(const f32x4*)(ngain + 4 * F.lane + 256 * j) : (f32x4){0.f, 0.f, 0.f, 0.f};
    for (int m = gw; m < T; m += NGW) {
        const v2u pp = *(const v2u*)(pos + (size_t)m * 2);
        f32x4* xr = (f32x4*)(x + (size_t)m * DM) + F.lane;
        const v2u* y0 = (const v2u*)(ys + (size_t)pp.x * DM) + F.lane; const v2u* y1 = (const v2u*)(ys + (size_t)pp.y * DM) + F.lane;
        f32x4 v[4]; float s = 0.f;
#pragma unroll
        for (int j = 0; j < 4; ++j) { const v2u a = y0[64 * j], b = y1[64 * j]; f32x4 t = xr[64 * j];
            t.x += bflo(a.x) + bflo(b.x); t.y += bfhi(a.x) + bfhi(b.x); t.z += bflo(a.y) + bflo(b.y); t.w += bfhi(a.y) + bfhi(b.y);
            v[j] = t; xr[64 * j] = t; s += (t.x * t.x + t.y * t.y) + (t.z * t.z + t.w * t.w); }
        if (ngain) {
            const float r = rsqrtf(wave_sum(s) * (1.f / DM) + RMS_EPS);
            v2u* o8 = (v2u*)(hout + (size_t)m * DM) + F.lane;
#pragma unroll
            for (int j = 0; j < 4; ++j) { v2u w; w.x = pk2(v[j].x * r * g[j].x, v[j].y * r * g[j].y); w.y = pk2(v[j].z * r * g[j].z, v[j].w * r * g[j].w); o8[64 * j] = w; }
        }
    }
}

constexpr int PH_PER_LAYER = 11, N_PHASES = 1 + DEPTH * PH_PER_LAYER;
__global__ void __launch_bounds__(512, 2) mk_fwd(Args args) {
    extern __shared__ __attribute__((aligned(16))) unsigned char lds[];
    Frame F;
    F.lds = lds; F.tid = threadIdx.x; F.lane = F.tid & 63; F.wave = __builtin_amdgcn_readfirstlane(F.tid >> 6); F.G = gridDim.x; F.bid = blockIdx.x;
    F.ws = args.ws; F.ctl = (unsigned*)(args.ws + WS_CTL);
    LAS unsigned char* lds3 = (LAS unsigned char*)lds;
    for (int u = F.tid; u < (LDS_BYTES - LDSCTL_OFF) / 4; u += 512) ((LAS unsigned*)(lds3 + LDSCTL_OFF))[u] = 0u;
    __syncthreads();
#if MK_SPLIT
#define GRID_BAR() do { } while (0)
#else
    XcdBarrier bar = xcd_barrier_post(F.ctl + CW_BAR, (volatile LAS unsigned*)(lds3 + LDSCTL_OFF));
#define GRID_BAR() xcd_barrier(bar)
#endif
    const int lo = args.ph_lo, hi = args.ph_hi;
#define IN(k) (lo <= (k) && (k) < hi)
#define SEAM(k) do { if (IN(k) && IN((k) + 1)) GRID_BAR(); } while (0)
    unsigned char* ws = args.ws;
    bf16* Hb = (bf16*)(ws + WS_H); bf16* PROJ = (bf16*)(ws + WS_PROJ); bf16* Qb = (bf16*)(ws + WS_Q); bf16* Kb = (bf16*)(ws + WS_K);
    float* KMEAN = (float*)(ws + WS_KMEAN); bf16* CAT = (bf16*)(ws + WS_CAT); bf16* MERGED = (bf16*)(ws + WS_MERGED); float* ORAW = (float*)(ws + WS_ORAW);
    unsigned* ROUTE = (unsigned*)(ws + WS_ROUTE); unsigned* POS = (unsigned*)(ws + WS_POS); float* WROW = (float*)(ws + WS_POS + 512 * 1024);
    bf16* HS = (bf16*)(ws + WS_HS); bf16* ACT = (bf16*)(ws + WS_ACT); bf16* YS = (bf16*)(ws + WS_YS);
    float* XO = args.out;

    if (IN(0) && PHON(11)) { phase_prologue(F, args); }
    SEAM(0);
    for (int l = 0; l < DEPTH; ++l) {
        const int p0 = 1 + l * PH_PER_LAYER;
        const float* xin = (l == 0) ? args.in[I_X] : XO;
        if (IN(p0) && l == 0 && PHON(0)) phase_norm(F, xin, args.in[I_MIXG], Hb);
        SEAM(p0);
        if (IN(p0 + 1) && PHON(1)) {
            pg8::Gemm g{DM, DM, DM};
            SchedDense S{(const char*)Hb, (const char*)(ws + WS_WIN) + (size_t)l * NCOL * DM * 2, T / 256, NCOL / 256, F.G, F.bid, (size_t)256 * DM * 2, (size_t)256 * DM * 2};
            EpiStoreBf16 E{PROJ, NCOL};
            pg8::gemm_phase<EpiStoreBf16, SchedDense, true, true>(lds3, g, S, E);
        }
        SEAM(p0 + 1);
        if (IN(p0 + 2) && PHON(2)) {
            phase_qkprep(F, PROJ, args.in[I_QG] + l * 64, args.in[I_KG] + l * 64, Qb, Kb, KMEAN);
            phase_conv(F, PROJ, args.in[I_CONVW] + (size_t)l * 31 * 512, args.in[I_CONVB] + l * 512, args.in[I_CLNG] + l * 512, args.in[I_CLNB] + l * 512, CAT);
            phase_hgrn_naive(F, PROJ, args.in[I_LBL], l, ORAW);
        }
        SEAM(p0 + 2);
        if (IN(p0 + 3) && PHON(3)) {
            phase_attn_naive(F, Qb, Kb, PROJ, KMEAN, CAT);
            phase_hgrn_post(F, ORAW, PROJ, args.in[I_HGG] + l * 128, CAT);
        }
        SEAM(p0 + 3);
        if (IN(p0 + 4) && PHON(4)) {
            pg8::Gemm g{1536, 512, 512};
            SchedBranch S{(const char*)CAT, (const char*)(ws + WS_WCAT) + (size_t)l * 3 * DM * 512 * 2, F.G, F.bid};
            EpiBranch E{PROJ, args.in[I_BGATE] + l * 3 * DM, MERGED};
            pg8::gemm_phase<EpiBranch, SchedBranch, true, true>(lds3, g, S, E);
        }
        SEAM(p0 + 4);
        if (IN(p0 + 5) && PHON(5)) {
            pg8::Gemm g{DM, DM, DM};
            SchedDense S{(const char*)MERGED, (const char*)(ws + WS_WOUT) + (size_t)l * DM * DM * 2, T / 256, DM / 256, F.G, F.bid, (size_t)256 * DM * 2, (size_t)256 * DM * 2};
            EpiResidual E{xin, XO};
            pg8::gemm_phase<EpiResidual, SchedDense, true, true>(lds3, g, S, E);
        }
        SEAM(p0 + 5);
        if (IN(p0 + 6) && PHON(6)) phase_router(F, XO, args.in[I_FFNG] + l * DM, args.in[I_WCO] + (size_t)l * DM * 4, args.in[I_BCO] + l * 4, args.in[I_WFI] + (size_t)l * DM * 32, args.in[I_BFI] + l * 32,
                                     Hb, ROUTE, F.ctl + CW_CNT + l * 32 * 64);
        SEAM(p0 + 6);
        if (IN(p0 + 7) && PHON(7)) phase_scatter(F, Hb, ROUTE, F.ctl + CW_CNT + l * 32 * 64, F.ctl + CW_NT + l * 64, F.ctl + CW_TILE + l * 256, HS, WROW, POS);
        SEAM(p0 + 7);
        if (IN(p0 + 8) && PHON(8)) {
            pg8::Gemm g{DM, DM, DM};
            SchedMoe S{(const char*)HS, (const char*)(ws + WS_WEI) + (size_t)l * NEXP * 1024 * DM * 2, F.ctl + CW_NT + l * 64, F.ctl + CW_TILE + l * 256, F.G, F.bid, (size_t)256 * DM * 2, (size_t)1024 * DM * 2, (size_t)256 * DM * 2};
            EpiSwiglu E{ACT};
            pg8::gemm_phase<EpiSwiglu, SchedMoe, true, true>(lds3, g, S, E);
        }
        SEAM(p0 + 8);
        if (IN(p0 + 9) && PHON(9)) {
            pg8::Gemm g{FF, FF, FF};
            SchedMoe S{(const char*)ACT, (const char*)(ws + WS_WEO) + (size_t)l * NEXP * DM * FF * 2, F.ctl + CW_NT + l * 64, F.ctl + CW_TILE + l * 256, F.G, F.bid, (size_t)256 * FF * 2, (size_t)DM * FF * 2, (size_t)256 * FF * 2};
            EpiScaleRows E{YS, WROW};
            pg8::gemm_phase<EpiScaleRows, SchedMoe, true, true>(lds3, g, S, E);
        }
        SEAM(p0 + 9);
        if (IN(p0 + 10) && PHON(10)) phase_combine(F, XO, YS, POS, (l + 1 < DEPTH) ? args.in[I_MIXG] + (l + 1) * DM : nullptr, Hb);
        SEAM(p0 + 10);
    }
#undef IN
#undef SEAM
}

extern "C" void kernel_launch(void* const* d_in, const int* in_sizes, int n_in, void* d_out, int out_size, void* d_ws, size_t ws_size, hipStream_t stream) {
    static int grid = 0;
    if (grid == 0) {
        if (n_in != 23 || out_size != T * DM || ws_size < WS_END) { fprintf(stderr, "kernel_launch: unexpected shapes (n_in %d out %d ws %zu)\n", n_in, out_size, ws_size); grid = -1; return; }
        int dev = 0, cus = 0, per_cu = 0;
        if (hipGetDevice(&dev) != hipSuccess || hipDeviceGetAttribute(&cus, hipDeviceAttributeMultiprocessorCount, dev) != hipSuccess) { grid = -1; return; }
        if (hipFuncSetAttribute((const void*)mk_fwd, hipFuncAttributeMaxDynamicSharedMemorySize, LDS_BYTES) != hipSuccess) { fprintf(stderr, "kernel_launch: hipFuncSetAttribute failed\n"); grid = -1; return; }
        if (hipOccupancyMaxActiveBlocksPerMultiprocessor(&per_cu, (const void*)mk_fwd, 512, LDS_BYTES) != hipSuccess || per_cu < 1) fprintf(stderr, "kernel_launch: occupancy query says %d\n", per_cu);
        (void)hipGetLastError();
        grid = cus;
    }
    if (grid < 0) return;
    (void)hipMemsetAsync((char*)d_ws + WS_CTL, 0, CTL_ZERO_BYTES, stream);
    Args a{};
    for (int i = 0; i < 23; ++i) a.in[i] = (const float*)d_in[i];
    a.out = (float*)d_out; a.ws = (unsigned char*)d_ws;
#if MK_SPLIT
    for (int p = 0; p < N_PHASES; ++p) {
        if (p == 1 + PH_PER_LAYER) continue;
        a.ph_lo = p; a.ph_hi = p + 1;
        hipLaunchKernelGGL(mk_fwd, dim3(grid), dim3(512), LDS_BYTES, stream, a);
    }
#else
    a.ph_lo = 0; a.ph_hi = N_PHASES;
    hipLaunchKernelGGL(mk_fwd, dim3(grid), dim3(512), LDS_BYTES, stream, a);
#endif
}
```

```cpp
#include <hip/hip_runtime.h>
#include <cstdio>
#include <cstdint>

#ifndef MK_SPLIT
#define MK_SPLIT 0
#endif
#ifndef DBG_MASK
#define DBG_MASK 0xFFFFu
#endif
#define PHON(j) (((DBG_MASK) >> (j)) & 1u)

constexpr int DM = 1024, NB = 8, SEQ = 2048, T = NB * SEQ, DEPTH = 2;
constexpr int NCOL = 7680;
constexpr int C_AQ = 0, C_AK = 512, C_AV = 1024, C_HQ = 1536, C_HF = 2048, C_HI = 2560, C_HG = 3072, C_CA = 3584, C_CB = 4096, C_GL = 4608;
constexpr int NEXP = 32, FF = 512;
constexpr int MOE_ROWS = 2 * T + NEXP * 256;
constexpr float RMS_EPS = 1e-6f, LN_EPS = 1e-5f;
constexpr float QSCALE = 0.125f * 1.4426950408889634f;

namespace pg8 {
#define PG8_LAS __attribute__((address_space(3)))
typedef unsigned short bf16_t;
typedef short bf16x8 __attribute__((ext_vector_type(8)));
typedef float f32x4 __attribute__((ext_vector_type(4)));
typedef unsigned u32x4 __attribute__((ext_vector_type(4)));
constexpr int BM = 256, BK = 64, HALF = 128, HTB = HALF * BK * 2, STAGE_BYTES = 8 * HTB, NXCD = 8, WGM = 8;

__host__ __device__ __forceinline__ int lds_byte(int r, int c) { const int st = (r >> 4) * 2 + (c >> 5), rr = r & 15, cc = c & 31, ob = rr * 64 + cc * 2; return st * 1024 + (ob ^ (((ob >> 9) & 1) << 5)); }
__host__ __device__ __forceinline__ void stage_rc(int b, int& R, int& C) { const int st = b / 1024, sb = b % 1024, swz = sb ^ (((sb >> 9) & 1) << 5); R = (st >> 1) * 16 + swz / 64; C = (st & 1) * 32 + (swz % 64) / 2; }
__host__ __device__ __forceinline__ int perm32(int rho) { const int n = rho >> 4, i = rho & 15; return 8 * (i >> 2) + 4 * n + (i & 3); }

struct Unit { int pm, pn, aux, pad; const char* a; const char* b; };
struct Gemm { int lda, ldb, K; };

__device__ __forceinline__ bool static_tile(int nM, int nN, long L, int& pm, int& pn) {
    const int nwg = nM * nN; if (L >= nwg) return false;
    int wgid = (int)L; { const int q = nwg / NXCD, r = nwg % NXCD, xcd = wgid % NXCD, off = wgid / NXCD; wgid = (xcd < r ? xcd * (q + 1) : r * (q + 1) + (xcd - r) * q) + off; }
    const int nig = WGM * nN, gid = wgid / nig, fm = gid * WGM, gsz = (nM - fm) < WGM ? (nM - fm) : WGM;
    pm = fm + ((wgid % nig) % gsz); pn = (wgid % nig) / gsz; return true;
}

__device__ __forceinline__ unsigned cvt_pk_bf16(float lo, float hi) { unsigned r; asm volatile("v_cvt_pk_bf16_f32 %0, %1, %2" : "=v"(r) : "v"(lo), "v"(hi)); return r; }

template <class Epi, class Sched, bool ALIGN_EPI = false, bool SP2 = false>
__device__ __forceinline__ void gemm_phase(PG8_LAS unsigned char* lds, const Gemm g, const Sched& S, const Epi& E, int tid_in) {
    int tid_ = tid_in; asm volatile("" : "+v"(tid_));
    const int tid = tid_, wid = __builtin_amdgcn_readfirstlane(tid >> 6), lane = tid & 63, wr = wid >> 2, wc = wid & 3, fr = lane & 15, fq = lane >> 4;
    const int K = g.K, nt = K / BK;
    unsigned voffA[2], voffB[2];
#pragma unroll
    for (int i = 0; i < 2; ++i) { int R, C; stage_rc(tid * 16 + i * 8192, R, C); const int Rb = Epi::PERM ? ((R & ~31) + perm32(R & 31)) : R;
        voffA[i] = (unsigned)(R * g.lda + C) * 2u; voffB[i] = (unsigned)(Rb * g.ldb + C) * 2u; }
    const size_t kstep = (size_t)(BK * 2);
    const size_t hstepA = (size_t)HALF * g.lda * 2, hstepB = (size_t)HALF * g.ldb * 2;
    const unsigned ldsw = (unsigned)wid * 1024u;
    const int aoff = lds_byte(wr * 64 + fr, fq * 8), boff = lds_byte(wc * 32 + fr, fq * 8);
#define PG8_SA(b, h) (((b) * 2 + (h)) * HTB)
#define PG8_SB(b, h) ((4 + (b) * 2 + (h)) * HTB)
#define PG8_STAGE(bufoff, gbase, voff) do { _Pragma("unroll") for (int _i = 0; _i < 2; ++_i) \
        __builtin_amdgcn_global_load_lds((const unsigned*)((const char*)(gbase) + (voff)[_i]), (PG8_LAS unsigned*)(lds + (bufoff) + ldsw + _i * 8192), 16, 0, 0); } while (0)
#define PG8_LDA(dst, b, h) do { _Pragma("unroll") for (int m = 0; m < 4; ++m) _Pragma("unroll") for (int k = 0; k < 2; ++k) dst[m][k] = *(const PG8_LAS bf16x8*)(lds + PG8_SA(b, h) + aoff + m * 2048 + k * 1024); } while (0)
#define PG8_LDB(dst, b, h) do { _Pragma("unroll") for (int n = 0; n < 2; ++n) _Pragma("unroll") for (int k = 0; k < 2; ++k) dst[n][k] = *(const PG8_LAS bf16x8*)(lds + PG8_SB(b, h) + boff + n * 2048 + k * 1024); } while (0)
#define PG8_MMA(ai, bj, At, Bt) do { __builtin_amdgcn_s_setprio(1); _Pragma("unroll") for (int m = 0; m < 4; ++m) _Pragma("unroll") for (int n = 0; n < 2; ++n) _Pragma("unroll") for (int k = 0; k < 2; ++k) \
        acc[ai][bj][m][n] = __builtin_amdgcn_mfma_f32_16x16x32_bf16(Bt[n][k], At[m][k], acc[ai][bj][m][n], 0, 0, 0); __builtin_amdgcn_s_setprio(0); } while (0)
#define PG8_WAIT_V(n) asm volatile("s_waitcnt vmcnt(" #n ")" ::: "memory")
#define PG8_WAIT_L(n) asm volatile("s_waitcnt lgkmcnt(" #n ")" ::: "memory")
#define PG8_BAR __builtin_amdgcn_s_barrier()
#define PG8_SCHED __builtin_amdgcn_sched_barrier(0)
    Unit cur, nxt; int ui = 0;
    if (!S.next(0, cur)) return;
    f32x4 acc[2][2][4][2];
#pragma unroll
    for (int a = 0; a < 2; ++a)
#pragma unroll
        for (int b = 0; b < 2; ++b)
#pragma unroll
            for (int m = 0; m < 4; ++m)
#pragma unroll
                for (int n = 0; n < 2; ++n) acc[a][b][m][n] = (f32x4){0.f, 0.f, 0.f, 0.f};
    bf16x8 At[4][2], B0[2][2], B1[2][2];
    const char* cA = cur.a; const char* cB = cur.b;
    if constexpr (SP2) {
        PG8_STAGE(PG8_SB(0, 0), cB, voffB); PG8_STAGE(PG8_SB(0, 1), cB + hstepB, voffB); PG8_STAGE(PG8_SA(0, 0), cA, voffA); PG8_STAGE(PG8_SA(0, 1), cA + hstepA, voffA);
        if (wr == 1) PG8_BAR;
        PG8_WAIT_V(2); PG8_BAR;
        PG8_STAGE(PG8_SB(1, 0), cB + kstep, voffB); PG8_STAGE(PG8_SA(1, 0), cA + kstep, voffA); PG8_STAGE(PG8_SB(1, 1), cB + hstepB + kstep, voffB);
        PG8_WAIT_V(6); PG8_BAR;
    } else {
        PG8_STAGE(PG8_SB(0, 0), cB, voffB); PG8_STAGE(PG8_SA(0, 0), cA, voffA); PG8_STAGE(PG8_SB(0, 1), cB + hstepB, voffB); PG8_STAGE(PG8_SA(0, 1), cA + hstepA, voffA);
        if (wr == 1) PG8_BAR;
        PG8_WAIT_V(4); PG8_BAR;
        PG8_STAGE(PG8_SB(1, 0), cB + kstep, voffB); PG8_STAGE(PG8_SA(1, 0), cA + kstep, voffA); PG8_STAGE(PG8_SB(1, 1), cB + hstepB + kstep, voffB);
        PG8_WAIT_V(6); PG8_BAR;
    }
    for (;;) {
        const bool has_next = S.next(ui + 1, nxt);
        const char* nA = has_next ? nxt.a : cA; const char* nB = has_next ? nxt.b : cB;
        for (int t = 0; t < nt; t += 2) {
            const bool last = (t == nt - 2);
            const char* a1 = cA + (size_t)(t + 1) * kstep;
            const char* a2 = last ? nA : cA + (size_t)(t + 2) * kstep; const char* b2 = last ? nB : cB + (size_t)(t + 2) * kstep;
            const char* a3 = a2 + kstep; const char* b3 = b2 + kstep;
            if constexpr (SP2) {
            PG8_LDB(B0, 0, 0); PG8_LDB(B1, 0, 1); PG8_SCHED; PG8_LDA(At, 0, 0); PG8_STAGE(PG8_SA(1, 1), a1 + hstepA, voffA);
            PG8_WAIT_V(8); PG8_WAIT_L(0); PG8_BAR; PG8_MMA(0, 0, At, B0); PG8_MMA(0, 1, At, B1); PG8_BAR; PG8_SCHED;
            PG8_LDA(At, 0, 1); PG8_STAGE(PG8_SB(0, 0), b2, voffB); PG8_STAGE(PG8_SB(0, 1), b2 + hstepB, voffB); PG8_STAGE(PG8_SA(0, 0), a2, voffA);
            PG8_WAIT_V(8); PG8_WAIT_L(0); PG8_BAR; PG8_MMA(1, 0, At, B0); PG8_MMA(1, 1, At, B1); PG8_BAR; PG8_SCHED;
            PG8_LDB(B0, 1, 0); PG8_LDB(B1, 1, 1); PG8_SCHED; PG8_LDA(At, 1, 0); PG8_STAGE(PG8_SA(0, 1), a2 + hstepA, voffA);
            PG8_WAIT_V(8); PG8_WAIT_L(0); PG8_BAR; PG8_MMA(0, 0, At, B0); PG8_MMA(0, 1, At, B1); PG8_BAR; PG8_SCHED;
            PG8_LDA(At, 1, 1); PG8_STAGE(PG8_SB(1, 0), b3, voffB); PG8_STAGE(PG8_SB(1, 1), b3 + hstepB, voffB); PG8_STAGE(PG8_SA(1, 0), a3, voffA);
            PG8_WAIT_V(8); PG8_WAIT_L(0); PG8_BAR; PG8_MMA(1, 0, At, B0); PG8_MMA(1, 1, At, B1); PG8_BAR; PG8_SCHED;
            } else {
            PG8_LDB(B0, 0, 0); PG8_SCHED; PG8_LDA(At, 0, 0); PG8_STAGE(PG8_SA(1, 1), a1 + hstepA, voffA);
            PG8_WAIT_L(8); PG8_BAR; PG8_WAIT_L(0); PG8_MMA(0, 0, At, B0); PG8_BAR; PG8_SCHED;
            PG8_LDB(B1, 0, 1); PG8_STAGE(PG8_SB(0, 0), b2, voffB);
            PG8_BAR; PG8_WAIT_L(0); PG8_MMA(0, 1, At, B1); PG8_BAR;
            PG8_LDA(At, 0, 1); PG8_STAGE(PG8_SA(0, 0), a2, voffA);
            PG8_BAR; PG8_WAIT_L(0); PG8_MMA(1, 0, At, B0); PG8_BAR; PG8_SCHED;
            PG8_STAGE(PG8_SB(0, 1), b2 + hstepB, voffB);
            PG8_WAIT_V(6); PG8_BAR; PG8_MMA(1, 1, At, B1); PG8_BAR;
            PG8_LDB(B0, 1, 0); PG8_SCHED; PG8_LDA(At, 1, 0); PG8_STAGE(PG8_SA(0, 1), a2 + hstepA, voffA);
            PG8_WAIT_L(8); PG8_BAR; PG8_WAIT_L(0); PG8_MMA(0, 0, At, B0); PG8_BAR; PG8_SCHED;
            PG8_LDB(B1, 1, 1); PG8_STAGE(PG8_SB(1, 0), b3, voffB);
            PG8_BAR; PG8_WAIT_L(0); PG8_MMA(0, 1, At, B1); PG8_BAR;
            PG8_LDA(At, 1, 1); PG8_STAGE(PG8_SA(1, 0), a3, voffA);
            PG8_BAR; PG8_WAIT_L(0); PG8_MMA(1, 0, At, B0); PG8_BAR; PG8_SCHED;
            PG8_STAGE(PG8_SB(1, 1), b3 + hstepB, voffB);
            PG8_WAIT_V(6); PG8_BAR; PG8_MMA(1, 1, At, B1); PG8_BAR;
            }
        }
        if constexpr (ALIGN_EPI) { if (wr == 0) PG8_BAR; }
        E(acc, cur, wr, wc, fr, fq);
        if (!has_next) break;
#pragma unroll
        for (int a = 0; a < 2; ++a)
#pragma unroll
            for (int b = 0; b < 2; ++b)
#pragma unroll
                for (int m = 0; m < 4; ++m)
#pragma unroll
                    for (int n = 0; n < 2; ++n) acc[a][b][m][n] = (f32x4){0.f, 0.f, 0.f, 0.f};
        cur = nxt; cA = nA; cB = nB; ++ui;
        if constexpr (ALIGN_EPI) { if (wr == 1) PG8_BAR; }
    }
    PG8_WAIT_V(0);
    if constexpr (!ALIGN_EPI) { if (wr == 0) PG8_BAR; }
    PG8_BAR;
#undef PG8_SA
#undef PG8_SB
#undef PG8_STAGE
#undef PG8_LDA
#undef PG8_LDB
#undef PG8_MMA
#undef PG8_WAIT_V
#undef PG8_WAIT_L
#undef PG8_BAR
#undef PG8_SCHED
}
}

constexpr size_t MiB = 1u << 20;
constexpr size_t WS_CTL = 0, CTL_ZERO_BYTES = 1 * MiB;
constexpr size_t WS_WIN = 2 * MiB;
constexpr size_t WS_WCAT = WS_WIN + 30 * MiB;
constexpr size_t WS_WOUT = WS_WCAT + 6 * MiB;
constexpr size_t WS_WEI = WS_WOUT + 4 * MiB;
constexpr size_t WS_WEO = WS_WEI + 128 * MiB;
constexpr size_t WS_H = WS_WEO + 64 * MiB;
constexpr size_t WS_PROJ = WS_H + 32 * MiB;
constexpr size_t WS_Q = WS_PROJ + 240 * MiB;
constexpr size_t WS_K = WS_Q + 16 * MiB;
constexpr size_t WS_KMEAN = WS_K + 16 * MiB;
constexpr size_t WS_CAT = WS_KMEAN + 1 * MiB;
constexpr size_t WS_MERGED = WS_CAT + 48 * MiB;
constexpr size_t WS_ORAW = WS_MERGED + 32 * MiB;
constexpr size_t WS_ROUTE = WS_ORAW + 32 * MiB;
constexpr size_t WS_POS = WS_ROUTE + 1 * MiB;
constexpr size_t WS_HS = WS_POS + 1 * MiB;
constexpr size_t WS_ACT = WS_HS + 80 * MiB;
constexpr size_t WS_YS = WS_ACT + 40 * MiB;
constexpr size_t WS_END = WS_YS + 80 * MiB;
static_assert(WS_END <= 1000 * MiB, "workspace map");
constexpr int CW_BAR = 4096;
constexpr int CW_CNT = 16384;
constexpr int CW_NT = CW_CNT + 2 * 32 * 64;
constexpr int CW_TILE = CW_NT + 2 * 64;
static_assert((CW_TILE + 2 * 256) * 4 <= (int)CTL_ZERO_BYTES, "ctl");

constexpr int LDS_SCRATCH = 151552, LDSCTL_OFF = LDS_SCRATCH, LDS_BYTES = 155648;

#define GAS __attribute__((address_space(1)))
#define LAS __attribute__((address_space(3)))
typedef unsigned short bf16;
typedef unsigned v4u __attribute__((ext_vector_type(4)));
typedef unsigned v2u __attribute__((ext_vector_type(2)));
typedef float f32x4 __attribute__((ext_vector_type(4)));
typedef float f32x2 __attribute__((ext_vector_type(2)));
#define RLX_AGENT __ATOMIC_RELAXED, __HIP_MEMORY_SCOPE_AGENT
__device__ __forceinline__ unsigned f2bf(float f) { unsigned u = __builtin_bit_cast(unsigned, f); return (u + 0x7fffu + ((u >> 16) & 1u)) >> 16; }
__device__ __forceinline__ unsigned pk2(float lo, float hi) { return f2bf(lo) | (f2bf(hi) << 16); }
__device__ __forceinline__ float bflo(unsigned w) { return __uint_as_float(w << 16); }
__device__ __forceinline__ float bfhi(unsigned w) { return __uint_as_float(w & 0xffff0000u); }
__device__ __forceinline__ float bf2f(bf16 v) { return __uint_as_float((unsigned)v << 16); }
__device__ __forceinline__ float sigmoidf_(float x) { return 1.0f / (1.0f + __expf(-x)); }
__device__ __forceinline__ float wave_sum(float v) {
#pragma unroll
    for (int o = 1; o < 64; o <<= 1) v += __shfl_xor(v, o);
    return v;
}

#define XB_TMO      128
#define XB_XCNT(j)  (256  + 64 * (j))
#define XB_XSUB(j)  (1280 + 64 * (j))
#define XB_XGEN(j)  (2304 + 64 * (j))
#define XB_TOP      3328
#define XB_TOPGEN   3392
#define XCD_BAR_WORDS 3456
#define XB_SPIN_CAP (1u << 18)
__device__ __forceinline__ unsigned xb_ld(unsigned* p)              { return __hip_atomic_load(p, __ATOMIC_RELAXED, __HIP_MEMORY_SCOPE_AGENT); }
__device__ __forceinline__ unsigned xb_add(unsigned* p, unsigned v) { return __hip_atomic_fetch_add(p, v, __ATOMIC_RELAXED, __HIP_MEMORY_SCOPE_AGENT); }
__device__ __forceinline__ unsigned xb_xcc_id() { return (unsigned)__builtin_amdgcn_s_getreg((3 << 11) | 20) & 0xFu; }
#define XB_SPIN(cond, bar) do { unsigned _sp = 0; while (cond) { __builtin_amdgcn_s_sleep(1); \
    if ((++_sp & 255u) == 0u) { if (xb_ld(&(bar)[XB_TMO])) break; if (_sp > XB_SPIN_CAP) { atomicAdd(&(bar)[XB_TMO], 1u); break; } } } } while (0)
struct XcdBarrier { unsigned* bar; unsigned x; volatile LAS unsigned* st; };
__device__ __forceinline__ XcdBarrier xcd_barrier_post(unsigned* bar, volatile LAS unsigned* st) {
    XcdBarrier b; b.bar = bar; b.x = xb_xcc_id(); b.st = st;
    if (threadIdx.x == 0) (void)xb_add(&bar[XB_XCNT(b.x)], 1u);
    return b;
}
__device__ __forceinline__ void xcd_barrier_complete(unsigned* bar, unsigned x, unsigned& nloc, unsigned& nx) {
    const unsigned G = gridDim.x * gridDim.y * gridDim.z;
    unsigned sum, cnt, mine, sp = 0u;
    for (;;) {
        sum = 0u; cnt = 0u; mine = 0u;
#pragma unroll
        for (unsigned j = 0; j < 16; ++j) { const unsigned c = xb_ld(&bar[XB_XCNT(j)]); sum += c; cnt += (c > 0u) ? 1u : 0u; mine = (j == x) ? c : mine; }
        if (sum == G) break;
        __builtin_amdgcn_s_sleep(1);
        if ((++sp & 255u) == 0u) { if (xb_ld(&bar[XB_TMO])) break; if (sp > XB_SPIN_CAP) { atomicAdd(&bar[XB_TMO], 1u); break; } }
    }
    nloc = mine > 0u ? mine : 1u; nx = cnt > 0u ? cnt : 1u;
}
__device__ __forceinline__ void xcd_barrier(const XcdBarrier& b) {
    asm volatile("s_waitcnt vmcnt(0)" ::: "memory");
    __syncthreads();
    if (threadIdx.x == 0) {
        unsigned* bar = b.bar;
        __builtin_amdgcn_s_waitcnt(0);
        unsigned nloc = b.st[0], nx = b.st[1];
        if (nloc == 0u) { xcd_barrier_complete(bar, b.x, nloc, nx); b.st[0] = nloc; b.st[1] = nx; }
        const unsigned old = xb_add(&bar[XB_XSUB(b.x)], 1u);
        const unsigned gen = old / nloc;
        if (old + 1u == (gen + 1u) * nloc) {
            __builtin_amdgcn_fence(__ATOMIC_RELEASE, "agent");
            asm volatile("s_waitcnt vmcnt(0)" ::: "memory");
            const unsigned og = xb_add(&bar[XB_TOP], 1u);
            const unsigned tg = og / nx;
            if (og + 1u == (tg + 1u) * nx) xb_add(&bar[XB_TOPGEN], 1u);
            else XB_SPIN(xb_ld(&bar[XB_TOPGEN]) == tg, bar);
            __builtin_amdgcn_fence(__ATOMIC_ACQUIRE, "agent");
            xb_add(&bar[XB_XGEN(b.x)], 1u);
            asm volatile("s_waitcnt vmcnt(0)" ::: "memory");
        } else {
            XB_SPIN(xb_ld(&bar[XB_XGEN(b.x)]) == gen, bar);
            __builtin_amdgcn_fence(__ATOMIC_ACQUIRE, "agent");
            asm volatile("s_waitcnt vmcnt(0)" ::: "memory");
        }
    }
    __syncthreads();
}

struct Args { const float* in[23]; float* out; unsigned char* ws; int ph_lo, ph_hi; };
typedef const Args __attribute__((address_space(4))) CArgs;
enum InIdx { I_X = 0, I_MIXG, I_WIN, I_BGATE, I_QG, I_KG, I_LBL, I_HGG, I_CONVW, I_CONVB, I_CLNG, I_CLNB, I_WATT, I_WHGRN, I_WCONV, I_WOUT, I_FFNG, I_WCO, I_BCO, I_WFI, I_BFI, I_WEI, I_WEO };

struct Frame {
    unsigned char* lds;
    int tid, lane, wave, G, bid;
    unsigned char* ws; unsigned* ctl;
};
__device__ __forceinline__ int lane_id_asm() { int l; asm volatile("v_mbcnt_lo_u32_b32 %0, -1, 0\n\tv_mbcnt_hi_u32_b32 %0, -1, %0" : "=v"(l)); return l; }
__device__ __forceinline__ Frame fresh(Frame F) { asm volatile("" : "+v"(F.tid)); F.lane = F.tid & 63; return F; }

__device__ __forceinline__ void transpose_item(const float* W, int K, int N, bf16* WT, int k0, int n0, int drow0, float* scr, int lane) {
#pragma unroll 8
    for (int i = 0; i < 32; ++i) { const int kk = 2 * i + (lane >> 5); scr[kk * 33 + (lane & 31)] = W[(size_t)(k0 + kk) * N + n0 + (lane & 31)]; }
    asm volatile("s_waitcnt lgkmcnt(0)" ::: "memory");
    const int c = lane & 7;
#pragma unroll
    for (int j = 0; j < 4; ++j) { const int n = (lane >> 3) + 8 * j; const float* s = scr + (8 * c) * 33 + n;
        v4u o; o.x = pk2(s[0 * 33], s[1 * 33]); o.y = pk2(s[2 * 33], s[3 * 33]); o.z = pk2(s[4 * 33], s[5 * 33]); o.w = pk2(s[6 * 33], s[7 * 33]);
        *(v4u*)(WT + (size_t)(drow0 + n) * K + k0 + 8 * c) = o; }
    asm volatile("s_waitcnt lgkmcnt(0)" ::: "memory");
}

__device__ __forceinline__ void phase_prologue(const Frame& F0, CArgs& A) {
    const Frame F = fresh(F0);
    float* scr = (float*)(F.lds + F.wave * 16384);
    const int gw = F.bid * 8 + F.wave, NGW = F.G * 8;
    constexpr int I_IN = (DM / 64) * (NCOL / 32);
    constexpr int I_BR = (512 / 64) * (DM / 32);
    constexpr int I_OUT = (DM / 64) * (DM / 32);
    constexpr int I_EI = (DM / 64) * (1024 / 32);
    constexpr int I_EO = (FF / 64) * (DM / 32);
    constexpr int PER_L = I_IN + 3 * I_BR + I_OUT + NEXP * I_EI + NEXP * I_EO;
    for (int it = gw; it < DEPTH * PER_L; it += NGW) {
        const int l = it / PER_L; int r = it % PER_L;
        if (r < I_IN) { const int nblk = NCOL / 32, kb = r / nblk, nb = r % nblk;
            transpose_item(A.in[I_WIN] + (size_t)l * DM * NCOL, DM, NCOL, (bf16*)(F.ws + WS_WIN) + (size_t)l * NCOL * DM, 64 * kb, 32 * nb, 32 * nb, scr, F.lane); continue; }
        r -= I_IN;
        if (r < 3 * I_BR) { const int br = r / I_BR, rr = r % I_BR, nblk = DM / 32, kb = rr / nblk, nb = rr % nblk;
            const float* W = A.in[br == 0 ? I_WATT : (br == 1 ? I_WHGRN : I_WCONV)] + (size_t)l * 512 * DM;
            transpose_item(W, 512, DM, (bf16*)(F.ws + WS_WCAT) + ((size_t)l * 3 + br) * DM * 512, 64 * kb, 32 * nb, 32 * nb, scr, F.lane); continue; }
        r -= 3 * I_BR;
        if (r < I_OUT) { const int nblk = DM / 32, kb = r / nblk, nb = r % nblk;
            transpose_item(A.in[I_WOUT] + (size_t)l * DM * DM, DM, DM, (bf16*)(F.ws + WS_WOUT) + (size_t)l * DM * DM, 64 * kb, 32 * nb, 32 * nb, scr, F.lane); continue; }
        r -= I_OUT;
        if (r < NEXP * I_EI) { const int e = r / I_EI, rr = r % I_EI, nblk = 1024 / 32, kb = rr / nblk, nb = rr % nblk, n0 = 32 * nb;
            const int nn = n0 & 511, drow0 = (nn >> 7) * 256 + (n0 >= 512 ? 128 : 0) + (nn & 127);
            transpose_item(A.in[I_WEI] + ((size_t)l * NEXP + e) * DM * 1024, DM, 1024, (bf16*)(F.ws + WS_WEI) + ((size_t)l * NEXP + e) * 1024 * DM, 64 * kb, n0, drow0, scr, F.lane); continue; }
        r -= NEXP * I_EI;
        { const int e = r / I_EO, rr = r % I_EO, nblk = DM / 32, kb = rr / nblk, nb = rr % nblk;
            transpose_item(A.in[I_WEO] + ((size_t)l * NEXP + e) * FF * DM, FF, DM, (bf16*)(F.ws + WS_WEO) + ((size_t)l * NEXP + e) * DM * FF, 64 * kb, 32 * nb, 32 * nb, scr, F.lane); }
    }
}

__device__ __forceinline__ void phase_norm(const Frame& F0, const float* x, const float* gain, bf16* out) {
    const Frame F = fresh(F0);
    const int gw = F.bid * 8 + F.wave, NGW = F.G * 8;
    f32x4 g[4];
#pragma unroll
    for (int j = 0; j < 4; ++j) g[j] = *(const f32x4*)(gain + 4 * F.lane + 256 * j);
    for (int m = gw; m < T; m += NGW) {
        const f32x4* xr = (const f32x4*)(x + (size_t)m * DM) + F.lane;
        f32x4 v[4]; float s = 0.f;
#pragma unroll
        for (int j = 0; j < 4; ++j) { v[j] = xr[64 * j]; s += (v[j].x * v[j].x + v[j].y * v[j].y) + (v[j].z * v[j].z + v[j].w * v[j].w); }
        const float r = rsqrtf(wave_sum(s) * (1.f / DM) + RMS_EPS);
        v2u* o8 = (v2u*)(out + (size_t)m * DM) + F.lane;
#pragma unroll
        for (int j = 0; j < 4; ++j) { v2u w; w.x = pk2(v[j].x * r * g[j].x, v[j].y * r * g[j].y); w.y = pk2(v[j].z * r * g[j].z, v[j].w * r * g[j].w); o8[64 * j] = w; }
    }
}

__device__ __forceinline__ void phase_qkprep(const Frame& F0, const bf16* proj, const float* qg, const float* kg, bf16* Q, bf16* Kb, float* kmean) {
    const Frame F = fresh(F0);
    float* red = (float*)F.lds;
    float* red2 = red + 256 * 65;
    const int tok = F.tid >> 1, hf = F.tid & 1;
    for (int u = F.bid; u < 512; u += F.G) {
        const int b = u >> 6, blk = (u >> 3) & 7, h = u & 7;
        const size_t row = (size_t)b * SEQ + blk * 256 + tok;
        const bf16* pq = proj + row * NCOL + C_AQ + h * 64 + hf * 32;
        const bf16* pk = proj + row * NCOL + C_AK + h * 64 + hf * 32;
        float qv[32], kv[32];
#pragma unroll
        for (int i = 0; i < 4; ++i) { const v4u a = *(const v4u*)(pq + 8 * i), c = *(const v4u*)(pk + 8 * i);
            qv[8 * i + 0] = bflo(a.x); qv[8 * i + 1] = bfhi(a.x); qv[8 * i + 2] = bflo(a.y); qv[8 * i + 3] = bfhi(a.y); qv[8 * i + 4] = bflo(a.z); qv[8 * i + 5] = bfhi(a.z); qv[8 * i + 6] = bflo(a.w); qv[8 * i + 7] = bfhi(a.w);
            kv[8 * i + 0] = bflo(c.x); kv[8 * i + 1] = bfhi(c.x); kv[8 * i + 2] = bflo(c.y); kv[8 * i + 3] = bfhi(c.y); kv[8 * i + 4] = bflo(c.z); kv[8 * i + 5] = bfhi(c.z); kv[8 * i + 6] = bflo(c.w); kv[8 * i + 7] = bfhi(c.w); }
        float sq = 0.f, sk = 0.f;
#pragma unroll
        for (int i = 0; i < 32; ++i) { sq += qv[i] * qv[i]; sk += kv[i] * kv[i]; }
        sq += __shfl_xor(sq, 1); sk += __shfl_xor(sk, 1);
        const float rq = rsqrtf(sq * (1.f / 64.f) + RMS_EPS) * QSCALE, rk = rsqrtf(sk * (1.f / 64.f) + RMS_EPS);
#pragma unroll
        for (int i = 0; i < 32; ++i) { qv[i] = qv[i] * rq * qg[hf * 32 + i]; kv[i] = kv[i] * rk * kg[hf * 32 + i]; }
        bf16* oq = Q + row * 512 + h * 64 + hf * 32; bf16* ok = Kb + row * 512 + h * 64 + hf * 32;
#pragma unroll
        for (int i = 0; i < 4; ++i) { v4u a, c;
            a.x = pk2(qv[8 * i], qv[8 * i + 1]); a.y = pk2(qv[8 * i + 2], qv[8 * i + 3]); a.z = pk2(qv[8 * i + 4], qv[8 * i + 5]); a.w = pk2(qv[8 * i + 6], qv[8 * i + 7]);
            c.x = pk2(kv[8 * i], kv[8 * i + 1]); c.y = pk2(kv[8 * i + 2], kv[8 * i + 3]); c.z = pk2(kv[8 * i + 4], kv[8 * i + 5]); c.w = pk2(kv[8 * i + 6], kv[8 * i + 7]);
            *(v4u*)(oq + 8 * i) = a; *(v4u*)(ok + 8 * i) = c; }
        __syncthreads();
#pragma unroll
        for (int i = 0; i < 32; ++i) red[tok * 65 + hf * 32 + i] = kv[i];
        __syncthreads();
        { const int d = F.tid & 63, part = F.tid >> 6; float s = 0.f;
            for (int tk = 0; tk < 32; ++tk) s += red[(part * 32 + tk) * 65 + d];
            red2[part * 64 + d] = s; }
        __syncthreads();
        if (F.tid < 64) { float s = 0.f;
#pragma unroll
            for (int p = 0; p < 8; ++p) s += red2[p * 64 + F.tid];
            kmean[(((size_t)b * 8 + h) * 8 + blk) * 64 + F.tid] = s * (1.f / 256.f); }
    }
    __syncthreads();
}

__device__ __forceinline__ void phase_conv(const Frame& F0, const bf16* proj, const float* cw, const float* cb, const float* lng, const float* lnb, bf16* cat) {
    const Frame F = fresh(F0);
    float* cv = (float*)F.lds;
    const int c = F.tid;
    float w[31];
#pragma unroll
    for (int j = 0; j < 31; ++j) w[j] = cw[j * 512 + c];
    const float bias = cb[c];
    for (int u = F.bid; u < 512; u += F.G) {
        const int b = u >> 6, t0 = (u & 63) * 32;
        float uu[62];
#pragma unroll
        for (int i = 0; i < 62; ++i) { const int t = t0 - 30 + i;
            if (t >= 0) { const size_t row = (size_t)b * SEQ + t; const float a = bf2f(proj[row * NCOL + C_CA + c]), g = bf2f(proj[row * NCOL + C_CB + c]); uu[i] = a * sigmoidf_(g); }
            else uu[i] = 0.f; }
        __syncthreads();
#pragma unroll
        for (int t = 0; t < 32; ++t) { float a = bias;
#pragma unroll
            for (int j = 0; j < 31; ++j) a += w[j] * uu[t + j];
            cv[t * 512 + c] = a; }
        __syncthreads();
#pragma unroll
        for (int q = 0; q < 4; ++q) { const int t = F.wave * 4 + q;
            const f32x4 v0 = *(const f32x4*)(cv + t * 512 + 8 * F.lane), v1 = *(const f32x4*)(cv + t * 512 + 8 * F.lane + 4);
            const float mu = wave_sum((v0.x + v0.y) + (v0.z + v0.w) + (v1.x + v1.y) + (v1.z + v1.w)) * (1.f / 512.f);
            const f32x4 d0 = v0 - mu, d1 = v1 - mu;
            const float var = wave_sum((d0.x * d0.x + d0.y * d0.y) + (d0.z * d0.z + d0.w * d0.w) + (d1.x * d1.x + d1.y * d1.y) + (d1.z * d1.z + d1.w * d1.w)) * (1.f / 512.f);
            const float rs = rsqrtf(var + LN_EPS);
            const f32x4 g0 = *(const f32x4*)(lng + 8 * F.lane), g1 = *(const f32x4*)(lng + 8 * F.lane + 4), b0 = *(const f32x4*)(lnb + 8 * F.lane), b1 = *(const f32x4*)(lnb + 8 * F.lane + 4);
            f32x4 y0 = d0 * rs * g0 + b0, y1 = d1 * rs * g1 + b1;
            y0.x *= sigmoidf_(y0.x); y0.y *= sigmoidf_(y0.y); y0.z *= sigmoidf_(y0.z); y0.w *= sigmoidf_(y0.w);
            y1.x *= sigmoidf_(y1.x); y1.y *= sigmoidf_(y1.y); y1.z *= sigmoidf_(y1.z); y1.w *= sigmoidf_(y1.w);
            v4u o; o.x = pk2(y0.x, y0.y); o.y = pk2(y0.z, y0.w); o.z = pk2(y1.x, y1.y); o.w = pk2(y1.z, y1.w);
            *(v4u*)(cat + ((size_t)b * SEQ + t0 + t) * 1536 + 1024 + 8 * F.lane) = o; }
    }
    __syncthreads();
}

__device__ __forceinline__ void phase_hgrn_naive(const Frame& F0, const bf16* proj, const float* lbl, int layer, float* oraw) {
    const Frame F = fresh(F0);
    float* part = (float*)F.lds;
    const int k = F.tid & 127, vq = F.tid >> 7;
    for (int u = F.bid; u < 256; u += F.G) {
        const int b = u >> 5, h = (u >> 3) & 3, vs = u & 7;
        float lb = 0.f;
        if (layer > 0) { const float l0 = lbl[h * 128 + k], l1 = lbl[512 + h * 128 + k]; lb = 1.f / (1.f + __expf(l0 - l1)); }
        const float omlb = 1.f - lb;
        float S0 = 0.f, S1 = 0.f, S2 = 0.f, S3 = 0.f;
        const bf16* pq = proj + (size_t)b * SEQ * NCOL + C_HQ + h * 128 + k;
        const bf16* pf = proj + (size_t)b * SEQ * NCOL + C_HF + h * 128 + k;
        const bf16* pv = proj + (size_t)b * SEQ * NCOL + C_HI + h * 128 + vs * 16 + vq * 4;
        for (int t0 = 0; t0 < SEQ; t0 += 32) {
#pragma unroll 4
            for (int tt = 0; tt < 32; ++tt) {
                const size_t ro = (size_t)(t0 + tt) * NCOL;
                const float qv = bf2f(pq[ro]), fr = bf2f(pf[ro]); const v2u vv = *(const v2u*)(pv + ro);
                const float sig = sigmoidf_(fr), f = lb + omlb * sig, kk = omlb * (1.f - sig), qa = qv * sigmoidf_(qv);
                S0 = f * S0 + kk * bflo(vv.x); S1 = f * S1 + kk * bfhi(vv.x); S2 = f * S2 + kk * bflo(vv.y); S3 = f * S3 + kk * bfhi(vv.y);
                const float p0 = wave_sum(qa * S0), p1 = wave_sum(qa * S1), p2 = wave_sum(qa * S2), p3 = wave_sum(qa * S3);
                if (F.lane == 0) *(f32x4*)(part + (tt * 8 + F.wave) * 4) = (f32x4){p0, p1, p2, p3};
            }
            __syncthreads();
            if (F.tid < 128) { const int tt = F.tid >> 2, v2 = F.tid & 3;
                const f32x4 a = *(const f32x4*)(part + (tt * 8 + v2 * 2) * 4), c = *(const f32x4*)(part + (tt * 8 + v2 * 2 + 1) * 4);
                *(f32x4*)(oraw + ((size_t)b * SEQ + t0 + tt) * 512 + h * 128 + vs * 16 + v2 * 4) = a + c; }
            __syncthreads();
        }
    }
}

__device__ __forceinline__ void phase_hgrn_post(const Frame& F0, const float* oraw, const bf16* proj, const float* hgg, bf16* cat) {
    const Frame F = fresh(F0);
    const int gw = F.bid * 8 + F.wave, NGW = F.G * 8;
    const f32x2 g = *(const f32x2*)(hgg + 2 * F.lane);
    for (int it = gw; it < T * 4; it += NGW) {
        const int row = it >> 2, h = it & 3;
        const f32x2 o = *(const f32x2*)(oraw + (size_t)row * 512 + h * 128 + 2 * F.lane);
        const unsigned hw = *(const unsigned*)(proj + (size_t)row * NCOL + C_HG + h * 128 + 2 * F.lane);
        const float r = rsqrtf(wave_sum(o.x * o.x + o.y * o.y) * (1.f / 128.f) + RMS_EPS);
        const float g0 = bflo(hw), g1 = bfhi(hw);
        const float y0 = o.x * r * g.x * (g0 * sigmoidf_(g0)), y1 = o.y * r * g.y * (g1 * sigmoidf_(g1));
        *(unsigned*)(cat + (size_t)row * 1536 + 512 + h * 128 + 2 * F.lane) = pk2(y0, y1);
    }
}

__device__ __forceinline__ void attn_naive_unit(const Frame& F, int b, int h, int qb, const bf16* Q, const bf16* Kb, const bf16* proj, const float* kmean, bf16* cat) {
    float* Ks = (float*)F.lds;
    float* Vs = Ks + 64 * 64;
    const int qi = F.tid >> 1, half = F.tid & 1;
    const size_t row0 = (size_t)b * SEQ + qb * 256;
    float q[32];
    { const bf16* pq = Q + (row0 + qi) * 512 + h * 64 + half * 32;
#pragma unroll
        for (int i = 0; i < 4; ++i) { const v4u a = *(const v4u*)(pq + 8 * i);
            q[8 * i + 0] = bflo(a.x); q[8 * i + 1] = bfhi(a.x); q[8 * i + 2] = bflo(a.y); q[8 * i + 3] = bfhi(a.y); q[8 * i + 4] = bflo(a.z); q[8 * i + 5] = bfhi(a.z); q[8 * i + 6] = bflo(a.w); q[8 * i + 7] = bfhi(a.w); } }
    unsigned selmask;
    if (qb <= 3) selmask = (1u << qb) - 1u;
    else {
        float gate[7];
#pragma unroll
        for (int j = 0; j < 7; ++j) { gate[j] = -3.0e38f;
            if (j < qb) { const float* km = kmean + (((size_t)b * 8 + h) * 8 + j) * 64 + half * 32; float s = 0.f;
#pragma unroll
                for (int d = 0; d < 32; ++d) s += q[d] * km[d];
                s += __shfl_xor(s, 1);
                gate[j] = s; } }
        selmask = 0u;
#pragma unroll
        for (int r = 0; r < 3; ++r) { float best = -3.0e38f; int bi = 0;
#pragma unroll
            for (int j = 0; j < 7; ++j) { const bool ok = (j < qb) && !((selmask >> j) & 1u) && (gate[j] > best); if (ok) { best = gate[j]; bi = j; } }
            selmask |= 1u << bi; }
    }
    float acc[32];
#pragma unroll
    for (int d = 0; d < 32; ++d) acc[d] = 0.f;
    float l = 0.f;
    const int skey = F.tid >> 3, sseg = F.tid & 7;
    for (int j = 0; j <= qb; ++j) {
        for (int kt = 0; kt < 4; ++kt) {
            __syncthreads();
            { const size_t krow = (size_t)b * SEQ + j * 256 + kt * 64 + skey;
                const v4u kk = *(const v4u*)(Kb + krow * 512 + h * 64 + sseg * 8), vv = *(const v4u*)(proj + krow * NCOL + C_AV + h * 64 + sseg * 8);
                *(f32x4*)(Ks + skey * 64 + sseg * 8) = (f32x4){bflo(kk.x), bfhi(kk.x), bflo(kk.y), bfhi(kk.y)}; *(f32x4*)(Ks + skey * 64 + sseg * 8 + 4) = (f32x4){bflo(kk.z), bfhi(kk.z), bflo(kk.w), bfhi(kk.w)};
                *(f32x4*)(Vs + skey * 64 + sseg * 8) = (f32x4){bflo(vv.x), bfhi(vv.x), bflo(vv.y), bfhi(vv.y)}; *(f32x4*)(Vs + skey * 64 + sseg * 8 + 4) = (f32x4){bflo(vv.z), bfhi(vv.z), bflo(vv.w), bfhi(vv.w)}; }
            __syncthreads();
            if (j == qb && kt > (F.wave >> 1)) continue;
#pragma unroll 2
            for (int key = 0; key < 64; ++key) {
                float s = 0.f;
#pragma unroll
                for (int d = 0; d < 32; d += 4) { const f32x4 kx = *(const f32x4*)(Ks + key * 64 + half * 32 + d); s += q[d] * kx.x + q[d + 1] * kx.y + q[d + 2] * kx.z + q[d + 3] * kx.w; }
                s += __shfl_xor(s, 1);
                const bool valid = (j == qb) ? (kt * 64 + key <= qi) : (((selmask >> j) & 1u) != 0u);
                const float p = valid ? exp2f(s) : 0.f;
                l += p;
#pragma unroll
                for (int d = 0; d < 32; d += 4) { const f32x4 vx = *(const f32x4*)(Vs + key * 64 + half * 32 + d); acc[d] += p * vx.x; acc[d + 1] += p * vx.y; acc[d + 2] += p * vx.z; acc[d + 3] += p * vx.w; }
            }
        }
    }
    { const float rl = 1.f / l;
        bf16* po = cat + (row0 + qi) * 1536 + h * 64 + half * 32;
#pragma unroll
        for (int i = 0; i < 4; ++i) { v4u o; o.x = pk2(acc[8 * i] * rl, acc[8 * i + 1] * rl); o.y = pk2(acc[8 * i + 2] * rl, acc[8 * i + 3] * rl); o.z = pk2(acc[8 * i + 4] * rl, acc[8 * i + 5] * rl); o.w = pk2(acc[8 * i + 6] * rl, acc[8 * i + 7] * rl); *(v4u*)(po + 8 * i) = o; }
    }
}
__device__ __forceinline__ void phase_attn_naive(const Frame& F0, const bf16* Q, const bf16* Kb, const bf16* proj, const float* kmean, bf16* cat) {
    const Frame F = fresh(F0);
    for (int p = F.bid; p < 256; p += F.G) {
        const int bh = p >> 2, s = p & 3;
#pragma unroll 1
        for (int i = 0; i < 2; ++i) attn_naive_unit(F, bh >> 3, bh & 7, i ? s : 7 - s, Q, Kb, proj, kmean, cat);
    }
    __syncthreads();
}

typedef float f32x16 __attribute__((ext_vector_type(16)));
typedef short bf16x8 __attribute__((ext_vector_type(8)));
typedef short v4i16_t __attribute__((ext_vector_type(4)));
constexpr int AT_KROW = 144, AT_VROW = 192, AT_KBUF = 64 * AT_KROW, AT_VBUF = 64 * AT_VROW, AT_BUF = AT_KBUF + AT_VBUF;
constexpr int AT_WSF = 2 * AT_BUF, AT_STG = AT_WSF + 8 * 256, AT_LDS = AT_STG + 8 * 4096;
__device__ __forceinline__ int crow16(int r, int hi) { return (r & 3) + 8 * (r >> 2) + 4 * hi; }
__device__ __forceinline__ void attn_mfma_unit(const Frame& F, LAS unsigned char* L, int b, int h, int qb, const bf16* Q, const bf16* Kb, const bf16* proj, const float* kmean, bf16* cat) {
    const int lane = F.lane, r32 = lane & 31, hi = lane >> 5, wid = F.wave;
    const size_t row0 = (size_t)b * SEQ + qb * 256;
    const int qi = wid * 32 + r32;
    bf16x8 qf[4];
    { const bf16* pq = Q + (row0 + qi) * 512 + h * 64 + hi * 8;
#pragma unroll
        for (int d0 = 0; d0 < 4; ++d0) qf[d0] = *(const bf16x8*)(pq + d0 * 16); }
    unsigned selmask;
    if (qb <= 3) selmask = (1u << qb) - 1u;
    else {
        float gate[7];
#pragma unroll
        for (int j = 0; j < 7; ++j) { gate[j] = -3.0e38f;
            if (j < qb) { const float* km = kmean + (((size_t)b * 8 + h) * 8 + j) * 64 + hi * 8; float sacc = 0.f;
#pragma unroll
                for (int d0 = 0; d0 < 4; ++d0) { const f32x4 k0 = *(const f32x4*)(km + d0 * 16), k1 = *(const f32x4*)(km + d0 * 16 + 4);
                    sacc += bf2f((bf16)qf[d0][0]) * k0.x + bf2f((bf16)qf[d0][1]) * k0.y + bf2f((bf16)qf[d0][2]) * k0.z + bf2f((bf16)qf[d0][3]) * k0.w
                          + bf2f((bf16)qf[d0][4]) * k1.x + bf2f((bf16)qf[d0][5]) * k1.y + bf2f((bf16)qf[d0][6]) * k1.z + bf2f((bf16)qf[d0][7]) * k1.w; }
                sacc += __shfl_xor(sacc, 32);
                gate[j] = sacc; } }
        selmask = 0u;
#pragma unroll
        for (int r = 0; r < 3; ++r) { float best = -3.0e38f; int bi = 0;
#pragma unroll
            for (int j = 0; j < 7; ++j) { const bool ok = (j < qb) && !((selmask >> j) & 1u) && (gate[j] > best); if (ok) { best = gate[j]; bi = j; } }
            selmask |= 1u << bi; }
    }
    const int srow = F.tid >> 3, sch = F.tid & 7;
    const bf16* kg = Kb + ((size_t)b * SEQ + srow) * 512 + h * 64 + sch * 8;
    const bf16* vg = proj + ((size_t)b * SEQ + srow) * NCOL + C_AV + h * 64 + sch * 8;
    const int kst = srow * AT_KROW + sch * 16, vst = AT_KBUF + srow * AT_VROW + sch * 16;
    const int kfo = r32 * AT_KROW + hi * 16;
    const int g16 = lane >> 4, idx = lane & 15;
    const int vfo = AT_KBUF + (4 * (g16 >> 1) + (idx >> 2)) * AT_VROW + ((g16 & 1) * 16 + 4 * (idx & 3)) * 2;
    const int NT = 4 * (qb + 1);
    f32x16 o0 = {}, o1 = {};
    float lsum = 0.f;
    { const v4u kk = *(const v4u*)kg, vv = *(const v4u*)vg;
        *(LAS v4u*)(L + kst) = kk; *(LAS v4u*)(L + vst) = vv; }
    __syncthreads();
    for (int t = 0; t < NT; ++t) {
        const int cb = (t & 1) * AT_BUF, nb = AT_BUF - cb;
        v4u kk, vv;
        if (t + 1 < NT) { kk = *(const v4u*)(kg + (size_t)(t + 1) * 64 * 512); vv = *(const v4u*)(vg + (size_t)(t + 1) * 64 * NCOL); }
        const int j = t >> 2, kt = t & 3; const bool own = (j == qb);
        const bool active = !own || (kt * 64 <= wid * 32 + 31);
        if (active) {
            f32x16 s0 = {}, s1 = {};
#pragma unroll
            for (int d0 = 0; d0 < 4; ++d0) {
                const bf16x8 k0 = *(const LAS bf16x8*)(L + cb + kfo + d0 * 32), k1 = *(const LAS bf16x8*)(L + cb + kfo + 32 * AT_KROW + d0 * 32);
                s0 = __builtin_amdgcn_mfma_f32_32x32x16_bf16(k0, qf[d0], s0, 0, 0, 0);
                s1 = __builtin_amdgcn_mfma_f32_32x32x16_bf16(k1, qf[d0], s1, 0, 0, 0); }
            const bool sel = own || (((selmask >> j) & 1u) != 0u);
            const int lim = own ? (qi - kt * 64) : 1000;
            float ps = 0.f;
#pragma unroll
            for (int r = 0; r < 16; ++r) { const int kv = crow16(r, hi);
                const float p0 = (sel && kv <= lim) ? __builtin_amdgcn_exp2f(s0[r]) : 0.f, p1 = (sel && kv + 32 <= lim) ? __builtin_amdgcn_exp2f(s1[r]) : 0.f;
                s0[r] = p0; s1[r] = p1; ps += p0 + p1; }
            lsum += ps;
            bf16x8 pa[4];
#pragma unroll
            for (int sI = 0; sI < 2; ++sI) { v4u w0, w1;
                w0.x = pg8::cvt_pk_bf16(s0[8 * sI + 0], s0[8 * sI + 1]); w0.y = pg8::cvt_pk_bf16(s0[8 * sI + 2], s0[8 * sI + 3]); w0.z = pg8::cvt_pk_bf16(s0[8 * sI + 4], s0[8 * sI + 5]); w0.w = pg8::cvt_pk_bf16(s0[8 * sI + 6], s0[8 * sI + 7]);
                w1.x = pg8::cvt_pk_bf16(s1[8 * sI + 0], s1[8 * sI + 1]); w1.y = pg8::cvt_pk_bf16(s1[8 * sI + 2], s1[8 * sI + 3]); w1.z = pg8::cvt_pk_bf16(s1[8 * sI + 4], s1[8 * sI + 5]); w1.w = pg8::cvt_pk_bf16(s1[8 * sI + 6], s1[8 * sI + 7]);
                pa[sI] = __builtin_bit_cast(bf16x8, w0); pa[2 + sI] = __builtin_bit_cast(bf16x8, w1); }
#pragma unroll
            for (int sub = 0; sub < 2; ++sub)
#pragma unroll
                for (int sI = 0; sI < 2; ++sI) {
                    const int vb = cb + vfo + (sub * 32 + 16 * sI) * AT_VROW;
                    const v4i16_t a0 = __builtin_amdgcn_ds_read_tr16_b64_v4i16((LAS v4i16_t*)(L + vb)), a1 = __builtin_amdgcn_ds_read_tr16_b64_v4i16((LAS v4i16_t*)(L + vb + 8 * AT_VROW));
                    const v4i16_t c0 = __builtin_amdgcn_ds_read_tr16_b64_v4i16((LAS v4i16_t*)(L + vb + 64)), c1 = __builtin_amdgcn_ds_read_tr16_b64_v4i16((LAS v4i16_t*)(L + vb + 8 * AT_VROW + 64));
                    const bf16x8 v0 = (bf16x8){a0[0], a0[1], a0[2], a0[3], a1[0], a1[1], a1[2], a1[3]}, v1 = (bf16x8){c0[0], c0[1], c0[2], c0[3], c1[0], c1[1], c1[2], c1[3]};
                    o0 = __builtin_amdgcn_mfma_f32_32x32x16_bf16(pa[sub * 2 + sI], v0, o0, 0, 0, 0);
                    o1 = __builtin_amdgcn_mfma_f32_32x32x16_bf16(pa[sub * 2 + sI], v1, o1, 0, 0, 0); }
        }
        if (t + 1 < NT) { *(LAS v4u*)(L + nb + kst) = kk; *(LAS v4u*)(L + nb + vst) = vv; }
        __syncthreads();
    }
    lsum += __shfl_xor(lsum, 32);
    LAS float* wsf = (LAS float*)(L + AT_WSF + wid * 256);
    if (hi == 0) wsf[r32] = lsum;
    asm volatile("s_waitcnt lgkmcnt(0)" ::: "memory");
    LAS bf16* stg = (LAS bf16*)(L + AT_STG + wid * 4096);
#pragma unroll
    for (int r = 0; r < 16; ++r) { const int orow = crow16(r, hi); const float rl = 1.f / wsf[orow];
        stg[orow * 64 + r32] = (bf16)f2bf(o0[r] * rl); stg[orow * 64 + 32 + r32] = (bf16)f2bf(o1[r] * rl); }
    asm volatile("s_waitcnt lgkmcnt(0)" ::: "memory");
    bf16* po = cat + (row0 + wid * 32) * 1536 + h * 64;
#pragma unroll
    for (int i = 0; i < 4; ++i) { const int row = i * 8 + (lane >> 3), ch = lane & 7; const v4u v = *(const LAS v4u*)(stg + row * 64 + ch * 8); *(v4u*)(po + (size_t)row * 1536 + ch * 8) = v; }
    __syncthreads();
}
__device__ __forceinline__ void phase_attn_mfma(const Frame& F0, const bf16* Q, const bf16* Kb, const bf16* proj, const float* kmean, bf16* cat) {
    const Frame F = fresh(F0);
    LAS unsigned char* L = (LAS unsigned char*)F.lds;
    for (int p = F.bid; p < 256; p += F.G) {
        const int bh = p >> 2, s = p & 3;
#pragma unroll 1
        for (int i = 0; i < 2; ++i) attn_mfma_unit(F, L, bh >> 3, bh & 7, i ? s : 7 - s, Q, Kb, proj, kmean, cat);
    }
}

constexpr int HG_G = 0, HG_QD = 16384, HG_KD = HG_QD + 32 * 272, HG_KE = HG_KD + 32 * 272, HG_VT = HG_KE + 32 * 320, HG_SP = HG_VT + 32 * 320, HG_END = HG_SP + 128 * 320;
static_assert(HG_END <= LDS_SCRATCH, "hgrn lds");
template <bool PERM> __device__ __forceinline__ bf16x8 tr_frag(LAS unsigned char* tile, int pitch, int rbase, int cbase, int lane) {
    const int g16 = lane >> 4, idx = lane & 15, h = g16 >> 1;
    LAS unsigned char* p = tile + (rbase + (PERM ? 4 : 8) * h + (idx >> 2)) * pitch + (cbase + (g16 & 1) * 16 + 4 * (idx & 3)) * 2;
    const v4i16_t a0 = __builtin_amdgcn_ds_read_tr16_b64_v4i16((LAS v4i16_t*)p), a1 = __builtin_amdgcn_ds_read_tr16_b64_v4i16((LAS v4i16_t*)(p + (PERM ? 8 : 4) * pitch));
    return (bf16x8){a0[0], a0[1], a0[2], a0[3], a1[0], a1[1], a1[2], a1[3]};
}
template <bool FULL>
__device__ __forceinline__ void hgrn_unit(const Frame& F, LAS unsigned char* L, int u, const bf16* proj, const float* lbl, int layer, const float* gnorm, float* Lg, float* Dg, bf16* cat) {
    const int b = u >> 5, h = (u >> 3) & 3, blk = u & 7;
    const int lane = F.lane, r32 = lane & 31, hi = lane >> 5, wid = F.wave, tid = F.tid;
    const int tt = tid >> 4, cg = tid & 15, ch = cg * 8;
    LAS float* G = (LAS float*)(L + HG_G);
    float lbv[8], omlb[8], gn[8];
#pragma unroll
    for (int i = 0; i < 8; ++i) { float lb = 0.f;
        if (layer > 0) { const float l0 = lbl[h * 128 + ch + i], l1 = lbl[512 + h * 128 + ch + i]; lb = 1.f / (1.f + __expf(l0 - l1)); }
        lbv[i] = lb; omlb[i] = 1.f - lb; gn[i] = FULL ? gnorm[ch + i] : 0.f; }
    f32x16 S[2];
#pragma unroll
    for (int i = 0; i < 2; ++i) { S[i] = (f32x16){};
        if (FULL) { const int id = 2 * wid + i, kt = id >> 2, vt = id & 3;
            for (int pb = 0; pb < blk; ++pb) { const float* Lp = Lg + (size_t)(u - blk + pb) * 16384; const float* Dp = Dg + (size_t)(u - blk + pb) * 128;
#pragma unroll
                for (int r = 0; r < 16; ++r) { const int k = kt * 32 + crow16(r, hi); S[i][r] = Dp[k] * S[i][r] + Lp[k * 128 + vt * 32 + r32]; } } } }
    float dsum = 0.f;
    const size_t rowb = (size_t)b * SEQ + blk * 256;
    for (int c = 0; c < 8; ++c) {
        const size_t row = rowb + c * 32 + tt;
        const v4u fq = *(const v4u*)(proj + row * NCOL + C_HF + h * 128 + ch), vq = *(const v4u*)(proj + row * NCOL + C_HI + h * 128 + ch);
        v4u qq = {}, gq = {};
        if (FULL) { qq = *(const v4u*)(proj + row * NCOL + C_HQ + h * 128 + ch); gq = *(const v4u*)(proj + row * NCOL + C_HG + h * 128 + ch); }
        float kk[8], qa[8], gl[8];
        { const unsigned fw[4] = {fq.x, fq.y, fq.z, fq.w}, qw[4] = {qq.x, qq.y, qq.z, qq.w};
#pragma unroll
            for (int i = 0; i < 8; ++i) { const float fr = (i & 1) ? bfhi(fw[i >> 1]) : bflo(fw[i >> 1]); const float sig = sigmoidf_(fr);
                gl[i] = __logf(lbv[i] + omlb[i] * sig); kk[i] = omlb[i] * (1.f - sig);
                const float qv = (i & 1) ? bfhi(qw[i >> 1]) : bflo(qw[i >> 1]); qa[i] = qv * sigmoidf_(qv); } }
        *(LAS f32x4*)(G + tt * 128 + ch) = (f32x4){gl[0], gl[1], gl[2], gl[3]}; *(LAS f32x4*)(G + tt * 128 + ch + 4) = (f32x4){gl[4], gl[5], gl[6], gl[7]};
        *(LAS v4u*)(L + HG_VT + tt * 320 + ch * 2) = vq;
        __syncthreads();
        if (tid < 128) { float a[32];
#pragma unroll
            for (int t = 0; t < 32; ++t) a[t] = G[t * 128 + tid];
#pragma unroll
            for (int t = 1; t < 32; ++t) a[t] += a[t - 1];
#pragma unroll
            for (int t = 0; t < 32; ++t) G[t * 128 + tid] = a[t];
            dsum += a[31]; }
        __syncthreads();
        { const f32x4 b0 = *(const LAS f32x4*)(G + tt * 128 + ch), b1 = *(const LAS f32x4*)(G + tt * 128 + ch + 4);
            const f32x4 m0 = *(const LAS f32x4*)(G + 15 * 128 + ch), m1 = *(const LAS f32x4*)(G + 15 * 128 + ch + 4);
            const f32x4 e0 = *(const LAS f32x4*)(G + 31 * 128 + ch), e1 = *(const LAS f32x4*)(G + 31 * 128 + ch + 4);
            const float bb[8] = {b0.x, b0.y, b0.z, b0.w, b1.x, b1.y, b1.z, b1.w}, bm[8] = {m0.x, m0.y, m0.z, m0.w, m1.x, m1.y, m1.z, m1.w}, be[8] = {e0.x, e0.y, e0.z, e0.w, e1.x, e1.y, e1.z, e1.w};
            float ke[8], kd[8], qd[8];
#pragma unroll
            for (int i = 0; i < 8; ++i) { ke[i] = kk[i] * __expf(be[i] - bb[i]); if (FULL) { const float ex = __expf(bb[i] - bm[i]); qd[i] = qa[i] * ex; kd[i] = kk[i] * __expf(bm[i] - bb[i]); } }
            v4u w; w.x = pk2(ke[0], ke[1]); w.y = pk2(ke[2], ke[3]); w.z = pk2(ke[4], ke[5]); w.w = pk2(ke[6], ke[7]);
            *(LAS v4u*)(L + HG_KE + tt * 320 + ch * 2) = w;
            if (FULL) {
                w.x = pk2(qd[0], qd[1]); w.y = pk2(qd[2], qd[3]); w.z = pk2(qd[4], qd[5]); w.w = pk2(qd[6], qd[7]); *(LAS v4u*)(L + HG_QD + tt * 272 + ch * 2) = w;
                w.x = pk2(kd[0], kd[1]); w.y = pk2(kd[2], kd[3]); w.z = pk2(kd[4], kd[5]); w.w = pk2(kd[6], kd[7]); *(LAS v4u*)(L + HG_KD + tt * 272 + ch * 2) = w;
#pragma unroll
                for (int i = 0; i < 2; ++i) { const int id = 2 * wid + i, kt = id >> 2, vt = id & 3;
#pragma unroll
                    for (int r = 0; r < 16; ++r) { const int k = kt * 32 + crow16(r, hi); *(LAS bf16*)(L + HG_SP + k * 320 + (vt * 32 + r32) * 2) = (bf16)f2bf(S[i][r] * __expf(G[15 * 128 + k])); } }
            }
        }
        __syncthreads();
        f32x16 o = {};
        if (FULL && wid < 4) {
            f32x16 sc = {};
            bf16x8 qf[8];
#pragma unroll
            for (int k0 = 0; k0 < 8; ++k0) { qf[k0] = *(const LAS bf16x8*)(L + HG_QD + r32 * 272 + (k0 * 16 + 8 * hi) * 2);
                const bf16x8 kf = *(const LAS bf16x8*)(L + HG_KD + r32 * 272 + (k0 * 16 + 8 * hi) * 2);
                sc = __builtin_amdgcn_mfma_f32_32x32x16_bf16(kf, qf[k0], sc, 0, 0, 0); }
#pragma unroll
            for (int r = 0; r < 16; ++r) sc[r] = (crow16(r, hi) <= r32) ? sc[r] : 0.f;
#pragma unroll
            for (int k0 = 0; k0 < 8; ++k0) o = __builtin_amdgcn_mfma_f32_32x32x16_bf16(qf[k0], tr_frag<false>(L + HG_SP, 320, k0 * 16, wid * 32, lane), o, 0, 0, 0);
#pragma unroll
            for (int sI = 0; sI < 2; ++sI) { v4u w; w.x = pg8::cvt_pk_bf16(sc[8 * sI + 0], sc[8 * sI + 1]); w.y = pg8::cvt_pk_bf16(sc[8 * sI + 2], sc[8 * sI + 3]); w.z = pg8::cvt_pk_bf16(sc[8 * sI + 4], sc[8 * sI + 5]); w.w = pg8::cvt_pk_bf16(sc[8 * sI + 6], sc[8 * sI + 7]);
                o = __builtin_amdgcn_mfma_f32_32x32x16_bf16(__builtin_bit_cast(bf16x8, w), tr_frag<true>(L + HG_VT, 320, 16 * sI, wid * 32, lane), o, 0, 0, 0); }
        }
#pragma unroll
        for (int i = 0; i < 2; ++i) { const int id = 2 * wid + i, kt = id >> 2, vt = id & 3;
#pragma unroll
            for (int r = 0; r < 16; ++r) S[i][r] *= __expf(G[31 * 128 + kt * 32 + crow16(r, hi)]);
#pragma unroll
            for (int sI = 0; sI < 2; ++sI) S[i] = __builtin_amdgcn_mfma_f32_32x32x16_bf16(tr_frag<true>(L + HG_KE, 320, 16 * sI, kt * 32, lane), tr_frag<true>(L + HG_VT, 320, 16 * sI, vt * 32, lane), S[i], 0, 0, 0); }
        __syncthreads();
        if (FULL) {
            if (wid < 4) {
#pragma unroll
                for (int r = 0; r < 16; ++r) G[crow16(r, hi) * 128 + wid * 32 + r32] = o[r]; }
            __syncthreads();
            const f32x4 o0 = *(const LAS f32x4*)(G + tt * 128 + ch), o1 = *(const LAS f32x4*)(G + tt * 128 + ch + 4);
            float ss = (o0.x * o0.x + o0.y * o0.y) + (o0.z * o0.z + o0.w * o0.w) + (o1.x * o1.x + o1.y * o1.y) + (o1.z * o1.z + o1.w * o1.w);
            ss += __shfl_xor(ss, 1); ss += __shfl_xor(ss, 2); ss += __shfl_xor(ss, 4); ss += __shfl_xor(ss, 8);
            const float rn = rsqrtf(ss * (1.f / 128.f) + RMS_EPS);
            const float ov[8] = {o0.x, o0.y, o0.z, o0.w, o1.x, o1.y, o1.z, o1.w}; const unsigned gw[4] = {gq.x, gq.y, gq.z, gq.w};
            float y[8];
#pragma unroll
            for (int i = 0; i < 8; ++i) { const float gv = (i & 1) ? bfhi(gw[i >> 1]) : bflo(gw[i >> 1]); y[i] = ov[i] * rn * gn[i] * (gv * sigmoidf_(gv)); }
            v4u w; w.x = pk2(y[0], y[1]); w.y = pk2(y[2], y[3]); w.z = pk2(y[4], y[5]); w.w = pk2(y[6], y[7]);
            *(v4u*)(cat + row * 1536 + 512 + h * 128 + ch) = w;
            __syncthreads();
        }
    }
    if (!FULL) {
#pragma unroll
        for (int i = 0; i < 2; ++i) { const int id = 2 * wid + i, kt = id >> 2, vt = id & 3;
#pragma unroll
            for (int r = 0; r < 16; ++r) Lg[(size_t)u * 16384 + (kt * 32 + crow16(r, hi)) * 128 + vt * 32 + r32] = S[i][r]; }
        if (tid < 128) Dg[(size_t)u * 128 + tid] = __expf(dsum);
    }
}
template <bool FULL>
__device__ __forceinline__ void phase_hgrn(const Frame& F0, const bf16* proj, const float* lbl, int layer, const float* gnorm, float* Lg, float* Dg, bf16* cat) {
    const Frame F = fresh(F0);
    LAS unsigned char* L = (LAS unsigned char*)F.lds;
    for (int u = F.bid; u < 256; u += F.G) { hgrn_unit<FULL>(F, L, u, proj, lbl, layer, gnorm, Lg, Dg, cat); __syncthreads(); }
}

struct SchedDense {
    const char* A; const char* B; int nM, nN, G, c; size_t ta, tb;
    __device__ __forceinline__ bool next(int i, pg8::Unit& u) const {
        int pm, pn; if (!pg8::static_tile(nM, nN, (long)i * G + c, pm, pn)) return false;
        u.pm = pm; u.pn = pn; u.aux = 0; u.pad = 0; u.a = A + (size_t)pm * ta; u.b = B + (size_t)pn * tb; return true; }
};
struct SchedBranch {
    const char* A; const char* B; int G, c;
    __device__ __forceinline__ bool next(int i, pg8::Unit& u) const {
        int pm, pn; if (!pg8::static_tile(T / 256, DM / 256, (long)(i / 3) * G + c, pm, pn)) return false;
        const int seg = i % 3;
        u.pm = pm; u.pn = pn; u.aux = seg; u.pad = 0; u.a = A + ((size_t)pm * 256 * 1536 + seg * 512) * 2; u.b = B + ((size_t)seg * DM * 512 + (size_t)pn * 256 * 512) * 2; return true; }
};
struct SchedMoe {
    const char* A; const char* B; const unsigned* ntp; const unsigned* tile_e; int G, c; size_t ta, tb_e, tb_n;
    __device__ __forceinline__ bool next(int i, pg8::Unit& u) const {
        const int nt = (int)__builtin_amdgcn_readfirstlane(*ntp);
        const long L = (long)i * G + c; if (L >= (long)nt * 4) return false;
        const int tile = (int)(L >> 2), pn = (int)(L & 3); const int e = (int)__builtin_amdgcn_readfirstlane(tile_e[tile]);
        u.pm = tile; u.pn = pn; u.aux = e; u.pad = 0; u.a = A + (size_t)tile * ta; u.b = B + (size_t)e * tb_e + (size_t)pn * tb_n; return true; }
};

typedef pg8::f32x4 af4;
struct EpiStoreBf16 {
    static constexpr bool PERM = true;
    bf16* O; int ldc;
    __device__ __forceinline__ void operator()(af4 (&acc)[2][2][4][2], const pg8::Unit& u, int wr, int wc, int fr, int fq) const {
        const int row0 = u.pm * 256 + wr * 64 + fr, col0 = u.pn * 256 + wc * 32 + 8 * fq;
#pragma unroll
        for (int ai = 0; ai < 2; ++ai)
#pragma unroll
            for (int m = 0; m < 4; ++m) { bf16* rowp = O + (size_t)(row0 + ai * 128 + m * 16) * ldc + col0;
#pragma unroll
                for (int bj = 0; bj < 2; ++bj) { const af4 v0 = acc[ai][bj][m][0], v1 = acc[ai][bj][m][1]; v4u w;
                    w.x = pg8::cvt_pk_bf16(v0[0], v0[1]); w.y = pg8::cvt_pk_bf16(v0[2], v0[3]); w.z = pg8::cvt_pk_bf16(v1[0], v1[1]); w.w = pg8::cvt_pk_bf16(v1[2], v1[3]);
                    *(v4u*)(rowp + bj * 128) = w; } }
    }
};
struct EpiBranch {
    static constexpr bool PERM = true;
    const bf16* proj; const float* bgate; bf16* merged;
    __device__ __forceinline__ void operator()(af4 (&acc)[2][2][4][2], const pg8::Unit& u, int wr, int wc, int fr, int fq) const {
        const int seg = u.aux, row0 = u.pm * 256 + wr * 64 + fr, col0 = u.pn * 256 + wc * 32 + 8 * fq;
#pragma unroll
        for (int bj = 0; bj < 2; ++bj) { const int col = col0 + bj * 128;
            const af4 bg0 = *(const af4*)(bgate + seg * DM + col), bg1 = *(const af4*)(bgate + seg * DM + col + 4);
#pragma unroll
            for (int ai = 0; ai < 2; ++ai)
#pragma unroll
                for (int m = 0; m < 4; ++m) { const size_t row = (size_t)(row0 + ai * 128 + m * 16);
                    const v4u gl = *(const v4u*)(proj + row * NCOL + C_GL + seg * DM + col);
                    const af4 v0 = acc[ai][bj][m][0], v1 = acc[ai][bj][m][1];
                    float o[8];
                    o[0] = v0[0] * sigmoidf_(bflo(gl.x) + bg0[0]); o[1] = v0[1] * sigmoidf_(bfhi(gl.x) + bg0[1]); o[2] = v0[2] * sigmoidf_(bflo(gl.y) + bg0[2]); o[3] = v0[3] * sigmoidf_(bfhi(gl.y) + bg0[3]);
                    o[4] = v1[0] * sigmoidf_(bflo(gl.z) + bg1[0]); o[5] = v1[1] * sigmoidf_(bfhi(gl.z) + bg1[1]); o[6] = v1[2] * sigmoidf_(bflo(gl.w) + bg1[2]); o[7] = v1[3] * sigmoidf_(bfhi(gl.w) + bg1[3]);
                    bf16* mp = merged + row * DM + col;
                    if (seg > 0) { const v4u old = *(const v4u*)mp;
                        o[0] += bflo(old.x); o[1] += bfhi(old.x); o[2] += bflo(old.y); o[3] += bfhi(old.y); o[4] += bflo(old.z); o[5] += bfhi(old.z); o[6] += bflo(old.w); o[7] += bfhi(old.w); }
                    v4u w; w.x = pg8::cvt_pk_bf16(o[0], o[1]); w.y = pg8::cvt_pk_bf16(o[2], o[3]); w.z = pg8::cvt_pk_bf16(o[4], o[5]); w.w = pg8::cvt_pk_bf16(o[6], o[7]);
                    *(v4u*)mp = w; } }
    }
};
struct EpiResidual {
    static constexpr bool PERM = false;
    const float* xin; float* xout;
    __device__ __forceinline__ void operator()(af4 (&acc)[2][2][4][2], const pg8::Unit& u, int wr, int wc, int fr, int fq) const {
        const int row0 = u.pm * 256 + wr * 64 + fr, col0 = u.pn * 256 + wc * 32 + 4 * fq;
#pragma unroll
        for (int ai = 0; ai < 2; ++ai)
#pragma unroll
            for (int m = 0; m < 4; ++m) { const size_t off = (size_t)(row0 + ai * 128 + m * 16) * DM + col0;
#pragma unroll
                for (int bj = 0; bj < 2; ++bj)
#pragma unroll
                    for (int n = 0; n < 2; ++n) { const af4 r = *(const af4*)(xin + off + bj * 128 + n * 16); *(af4*)(xout + off + bj * 128 + n * 16) = r + acc[ai][bj][m][n]; } }
    }
};
struct EpiSwiglu {
    static constexpr bool PERM = true;
    bf16* act;
    __device__ __forceinline__ void operator()(af4 (&acc)[2][2][4][2], const pg8::Unit& u, int wr, int wc, int fr, int fq) const {
        const int row0 = u.pm * 256 + wr * 64 + fr, col0 = u.pn * 128 + wc * 32 + 8 * fq;
#pragma unroll
        for (int ai = 0; ai < 2; ++ai)
#pragma unroll
            for (int m = 0; m < 4; ++m) { const af4 g0 = acc[ai][0][m][0], g1 = acc[ai][0][m][1], u0 = acc[ai][1][m][0], u1 = acc[ai][1][m][1];
                float o[8];
#pragma unroll
                for (int i = 0; i < 4; ++i) { o[i] = g0[i] * sigmoidf_(g0[i]) * u0[i]; o[4 + i] = g1[i] * sigmoidf_(g1[i]) * u1[i]; }
                v4u w; w.x = pg8::cvt_pk_bf16(o[0], o[1]); w.y = pg8::cvt_pk_bf16(o[2], o[3]); w.z = pg8::cvt_pk_bf16(o[4], o[5]); w.w = pg8::cvt_pk_bf16(o[6], o[7]);
                *(v4u*)(act + (size_t)(row0 + ai * 128 + m * 16) * FF + col0) = w; }
    }
};
struct EpiScaleRows {
    static constexpr bool PERM = true;
    bf16* ys; const float* wrow;
    __device__ __forceinline__ void operator()(af4 (&acc)[2][2][4][2], const pg8::Unit& u, int wr, int wc, int fr, int fq) const {
        const int row0 = u.pm * 256 + wr * 64 + fr, col0 = u.pn * 256 + wc * 32 + 8 * fq;
#pragma unroll
        for (int ai = 0; ai < 2; ++ai)
#pragma unroll
            for (int m = 0; m < 4; ++m) { const int row = row0 + ai * 128 + m * 16; const float s = wrow[row]; bf16* rowp = ys + (size_t)row * DM + col0;
#pragma unroll
                for (int bj = 0; bj < 2; ++bj) { const af4 v0 = acc[ai][bj][m][0] * s, v1 = acc[ai][bj][m][1] * s; v4u w;
                    w.x = pg8::cvt_pk_bf16(v0[0], v0[1]); w.y = pg8::cvt_pk_bf16(v0[2], v0[3]); w.z = pg8::cvt_pk_bf16(v1[0], v1[1]); w.w = pg8::cvt_pk_bf16(v1[2], v1[3]);
                    *(v4u*)(rowp + bj * 128) = w; } }
    }
};

constexpr int RW_PITCH = 1028;
__device__ __forceinline__ void phase_router(const Frame& F0, const float* x, const float* gain, const float* wco, const float* bco, const float* wfi, const float* bfi,
                                             bf16* hout, unsigned* route, unsigned* cnt) {
    const Frame F = fresh(F0);
    float* WT = (float*)F.lds;
    for (int idx = F.tid; idx < DM * 4; idx += 512) { const int k = idx >> 2, j = idx & 3; WT[j * RW_PITCH + k] = wco[idx]; }
    for (int idx = F.tid; idx < DM * 32; idx += 512) { const int k = idx >> 5, e = idx & 31; WT[(4 + e) * RW_PITCH + k] = wfi[idx]; }
    __syncthreads();
    const int gw = F.bid * 8 + F.wave, NGW = F.G * 8;
    f32x4 g[4];
#pragma unroll
    for (int j = 0; j < 4; ++j) g[j] = *(const f32x4*)(gain + 4 * F.lane + 256 * j);
    for (int m = gw; m < T; m += NGW) {
        const f32x4* xr = (const f32x4*)(x + (size_t)m * DM) + F.lane;
        f32x4 v[4]; float s = 0.f;
#pragma unroll
        for (int j = 0; j < 4; ++j) { v[j] = xr[64 * j]; s += (v[j].x * v[j].x + v[j].y * v[j].y) + (v[j].z * v[j].z + v[j].w * v[j].w); }
        const float r = rsqrtf(wave_sum(s) * (1.f / DM) + RMS_EPS);
        v2u* o8 = (v2u*)(hout + (size_t)m * DM) + F.lane;
#pragma unroll
        for (int j = 0; j < 4; ++j) { v[j] = v[j] * r * g[j]; v2u w; w.x = pk2(v[j].x, v[j].y); w.y = pk2(v[j].z, v[j].w); o8[64 * j] = w; }
        float* lg = WT + 36 * RW_PITCH + F.wave * 40;
#pragma unroll 2
        for (int c = 0; c < 36; ++c) { float p = 0.f;
#pragma unroll
            for (int j = 0; j < 4; ++j) { const f32x4 w = *(const f32x4*)(WT + c * RW_PITCH + 4 * F.lane + 256 * j); p += (v[j].x * w.x + v[j].y * w.y) + (v[j].z * w.z + v[j].w * w.w); }
            p = wave_sum(p); if (F.lane == 0) lg[c] = p; }
        asm volatile("s_waitcnt lgkmcnt(0)" ::: "memory");
        float c0 = lg[0] + bco[0], c1 = lg[1] + bco[1], c2 = lg[2] + bco[2], c3 = lg[3] + bco[3];
        int grp = 0; float cm = c0;
        if (c1 > cm) { cm = c1; grp = 1; } if (c2 > cm) { cm = c2; grp = 2; } if (c3 > cm) { cm = c3; grp = 3; }
        const float ptop = 1.f / (__expf(c0 - cm) + __expf(c1 - cm) + __expf(c2 - cm) + __expf(c3 - cm));
        float fs[8];
#pragma unroll
        for (int i = 0; i < 8; ++i) { float a = lg[4 + i] + bfi[i], b = lg[12 + i] + bfi[8 + i], c = lg[20 + i] + bfi[16 + i], d = lg[28 + i] + bfi[24 + i]; fs[i] = grp == 0 ? a : (grp == 1 ? b : (grp == 2 ? c : d)); }
        int i1 = 0; float v1 = fs[0];
#pragma unroll
        for (int i = 1; i < 8; ++i) if (fs[i] > v1) { v1 = fs[i]; i1 = i; }
        int i2 = -1; float v2 = -3.0e38f;
#pragma unroll
        for (int i = 0; i < 8; ++i) if (i != i1 && fs[i] > v2) { v2 = fs[i]; i2 = i; }
        const float e2 = __expf(v2 - v1), w1 = ptop / (1.f + e2), w2 = ptop * e2 / (1.f + e2);
        if (F.lane == 0) {
            const int ea = grp * 8 + i1, eb = grp * 8 + i2;
            const unsigned ra = __hip_atomic_fetch_add(cnt + 64 * ea, 1u, RLX_AGENT), rb = __hip_atomic_fetch_add(cnt + 64 * eb, 1u, RLX_AGENT);
            v4u o; o.x = (unsigned)ea; o.y = (unsigned)eb; o.z = ra; o.w = rb; *(v4u*)(route + (size_t)m * 8) = o;
            *(f32x2*)(route + (size_t)m * 8 + 4) = (f32x2){w1, w2};
        }
    }
    __syncthreads();
}

__device__ __forceinline__ void phase_scatter(const Frame& F0, const bf16* hin, const unsigned* route, const unsigned* cnt, unsigned* ntp, unsigned* tile_e, bf16* hs, float* wrow, unsigned* pos) {
    const Frame F = fresh(F0);
    unsigned* off = (unsigned*)F.lds;
    if (F.tid == 0) { unsigned o = 0;
        for (int e = 0; e < NEXP; ++e) { off[e] = o; const unsigned c = __hip_atomic_load(cnt + 64 * e, RLX_AGENT); const unsigned p = (c + 255u) & ~255u;
            if (F.bid == 0) for (unsigned tI = o >> 8; tI < ((o + p) >> 8); ++tI) tile_e[tI] = (unsigned)e;
            o += p; }
        off[NEXP] = o; if (F.bid == 0) *ntp = o >> 8; }
    __syncthreads();
    const int gw = F.bid * 8 + F.wave, NGW = F.G * 8;
    for (int m = gw; m < T; m += NGW) {
        const v4u ri = *(const v4u*)(route + (size_t)m * 8); const f32x2 ww = *(const f32x2*)(route + (size_t)m * 8 + 4);
        const unsigned d0 = off[ri.x] + ri.z, d1 = off[ri.y] + ri.w;
        const v4u* src = (const v4u*)(hin + (size_t)m * DM) + F.lane;
        const v4u a = src[0], b = src[64];
        v4u* p0 = (v4u*)(hs + (size_t)d0 * DM) + F.lane; v4u* p1 = (v4u*)(hs + (size_t)d1 * DM) + F.lane;
        p0[0] = a; p0[64] = b; p1[0] = a; p1[64] = b;
        if (F.lane == 0) { wrow[d0] = ww.x; wrow[d1] = ww.y; *(v2u*)(pos + (size_t)m * 2) = (v2u){d0, d1}; }
    }
    __syncthreads();
}

__device__ __forceinline__ void phase_combine(const Frame& F0, float* x, const bf16* ys, const unsigned* pos, const float* ngain, bf16* hout) {
    const Frame F = fresh(F0);
    const int gw = F.bid * 8 + F.wave, NGW = F.G * 8;
    f32x4 g[4];
#pragma unroll
    for (int j = 0; j < 4; ++j) g[j] = ngain ? *(const f32x4*)(ngain + 4 * F.lane + 256 * j) : (f32x4){0.f, 0.f, 0.f, 0.f};
    for (int m = gw; m < T; m += NGW) {
        const v2u pp = *(const v2u*)(pos + (size_t)m * 2);
        f32x4* xr = (f32x4*)(x + (size_t)m * DM) + F.lane;
        const v2u* y0 = (const v2u*)(ys + (size_t)pp.x * DM) + F.lane; const v2u* y1 = (const v2u*)(ys + (size_t)pp.y * DM) + F.lane;
        f32x4 v[4]; float s = 0.f;
#pragma unroll
        for (int j = 0; j < 4; ++j) { const v2u a = y0[64 * j], b = y1[64 * j]; f32x4 t = xr[64 * j];
            t.x += bflo(a.x) + bflo(b.x); t.y += bfhi(a.x) + bfhi(b.x); t.z += bflo(a.y) + bflo(b.y); t.w += bfhi(a.y) + bfhi(b.y);
            v[j] = t; xr[64 * j] = t; s += (t.x * t.x + t.y * t.y) + (t.z * t.z + t.w * t.w); }
        if (ngain) {
            const float r = rsqrtf(wave_sum(s) * (1.f / DM) + RMS_EPS);
            v2u* o8 = (v2u*)(hout + (size_t)m * DM) + F.lane;
#pragma unroll
            for (int j = 0; j < 4; ++j) { v2u w; w.x = pk2(v[j].x * r * g[j].x, v[j].y * r * g[j].y); w.y = pk2(v[j].z * r * g[j].z, v[j].w * r * g[j].w); o8[64 * j] = w; }
        }
    }
}

constexpr int PH_PER_LAYER = 11, N_PHASES = 1 + DEPTH * PH_PER_LAYER;
__device__ __forceinline__ CArgs& kargs() { CArgs* p = (CArgs*)__builtin_amdgcn_kernarg_segment_ptr(); asm volatile("" : "+s"(p)); return *p; }
__global__ void __launch_bounds__(512, 2) mk_fwd(Args args_unused) {
    extern __shared__ __attribute__((aligned(16))) unsigned char lds[];
    LAS unsigned char* lds3 = (LAS unsigned char*)lds;
    const int wave_s = __builtin_amdgcn_readfirstlane(threadIdx.x >> 6);
    for (int u = threadIdx.x; u < (LDS_BYTES - LDSCTL_OFF) / 4; u += 512) ((LAS unsigned*)(lds3 + LDSCTL_OFF))[u] = 0u;
    __syncthreads();
#if MK_SPLIT
#define GRID_BAR() do { } while (0)
#else
    (void)xcd_barrier_post((unsigned*)(kargs().ws + WS_CTL) + CW_BAR, (volatile LAS unsigned*)(lds3 + LDSCTL_OFF));
#define GRID_BAR() do { XcdBarrier b_; b_.bar = (unsigned*)(kargs().ws + WS_CTL) + CW_BAR; b_.x = xb_xcc_id(); b_.st = (volatile LAS unsigned*)(lds3 + LDSCTL_OFF); xcd_barrier(b_); } while (0)
#endif
    const int lo = kargs().ph_lo, hi = kargs().ph_hi;
#define IN(k) (lo <= (k) && (k) < hi)
#define SEAM(k) do { if (IN(k) && IN((k) + 1)) GRID_BAR(); } while (0)
#define FRAME() CArgs& A = kargs(); Frame F; F.lds = lds; F.lane = lane_id_asm(); F.wave = wave_s; F.tid = wave_s * 64 + F.lane; F.G = gridDim.x; F.bid = blockIdx.x; \
    unsigned char* ws = A.ws; F.ws = ws; F.ctl = (unsigned*)(ws + WS_CTL); (void)F;
#define WSP(T_, off) ((T_*)(ws + (off)))

    if (IN(0) && PHON(11)) { FRAME(); phase_prologue(F, A); }
    SEAM(0);
#pragma unroll 1
    for (int l = 0; l < DEPTH; ++l) {
        const int p0 = 1 + l * PH_PER_LAYER;
        if (IN(p0) && l == 0 && PHON(0)) { FRAME(); phase_norm(F, A.in[I_X], A.in[I_MIXG], WSP(bf16, WS_H)); }
        SEAM(p0);
        if (IN(p0 + 1) && PHON(1)) { FRAME();
            pg8::Gemm g{DM, DM, DM};
            SchedDense S{(const char*)(ws + WS_H), (const char*)(ws + WS_WIN) + (size_t)l * NCOL * DM * 2, T / 256, NCOL / 256, F.G, F.bid, (size_t)256 * DM * 2, (size_t)256 * DM * 2};
            EpiStoreBf16 E{WSP(bf16, WS_PROJ), NCOL};
            pg8::gemm_phase<EpiStoreBf16, SchedDense, true, true>(lds3, g, S, E, F.tid);
        }
        SEAM(p0 + 1);
        if (IN(p0 + 2) && PHON(2)) {
            { FRAME(); phase_qkprep(F, WSP(bf16, WS_PROJ), A.in[I_QG] + l * 64, A.in[I_KG] + l * 64, WSP(bf16, WS_Q), WSP(bf16, WS_K), WSP(float, WS_KMEAN)); }
            { FRAME(); phase_conv(F, WSP(bf16, WS_PROJ), A.in[I_CONVW] + (size_t)l * 31 * 512, A.in[I_CONVB] + l * 512, A.in[I_CLNG] + l * 512, A.in[I_CLNB] + l * 512, WSP(bf16, WS_CAT)); }
            { FRAME(); phase_hgrn<false>(F, WSP(bf16, WS_PROJ), A.in[I_LBL], l, nullptr, WSP(float, WS_ORAW), WSP(float, WS_ORAW + 16 * MiB), nullptr); }
        }
        SEAM(p0 + 2);
        if (IN(p0 + 3) && PHON(3)) {
            { FRAME(); phase_attn_mfma(F, WSP(bf16, WS_Q), WSP(bf16, WS_K), WSP(bf16, WS_PROJ), WSP(float, WS_KMEAN), WSP(bf16, WS_CAT)); }
            { FRAME(); phase_hgrn<true>(F, WSP(bf16, WS_PROJ), A.in[I_LBL], l, A.in[I_HGG] + l * 128, WSP(float, WS_ORAW), WSP(float, WS_ORAW + 16 * MiB), WSP(bf16, WS_CAT)); }
        }
        SEAM(p0 + 3);
        if (IN(p0 + 4) && PHON(4)) { FRAME();
            pg8::Gemm g{1536, 512, 512};
            SchedBranch S{(const char*)(ws + WS_CAT), (const char*)(ws + WS_WCAT) + (size_t)l * 3 * DM * 512 * 2, F.G, F.bid};
            EpiBranch E{WSP(bf16, WS_PROJ), A.in[I_BGATE] + l * 3 * DM, WSP(bf16, WS_MERGED)};
            pg8::gemm_phase<EpiBranch, SchedBranch, true, true>(lds3, g, S, E, F.tid);
        }
        SEAM(p0 + 4);
        if (IN(p0 + 5) && PHON(5)) { FRAME();
            pg8::Gemm g{DM, DM, DM};
            SchedDense S{(const char*)(ws + WS_MERGED), (const char*)(ws + WS_WOUT) + (size_t)l * DM * DM * 2, T / 256, DM / 256, F.G, F.bid, (size_t)256 * DM * 2, (size_t)256 * DM * 2};
            EpiResidual E{(l == 0) ? A.in[I_X] : (const float*)A.out, A.out};
            pg8::gemm_phase<EpiResidual, SchedDense, true, true>(lds3, g, S, E, F.tid);
        }
        SEAM(p0 + 5);
        if (IN(p0 + 6) && PHON(6)) { FRAME(); phase_router(F, A.out, A.in[I_FFNG] + l * DM, A.in[I_WCO] + (size_t)l * DM * 4, A.in[I_BCO] + l * 4, A.in[I_WFI] + (size_t)l * DM * 32, A.in[I_BFI] + l * 32,
                                     WSP(bf16, WS_H), WSP(unsigned, WS_ROUTE), F.ctl + CW_CNT + l * 32 * 64); }
        SEAM(p0 + 6);
        if (IN(p0 + 7) && PHON(7)) { FRAME(); phase_scatter(F, WSP(bf16, WS_H), WSP(unsigned, WS_ROUTE), F.ctl + CW_CNT + l * 32 * 64, F.ctl + CW_NT + l * 64, F.ctl + CW_TILE + l * 256, WSP(bf16, WS_HS), WSP(float, WS_POS + 512 * 1024), WSP(unsigned, WS_POS)); }
        SEAM(p0 + 7);
        if (IN(p0 + 8) && PHON(8)) { FRAME();
            pg8::Gemm g{DM, DM, DM};
            SchedMoe S{(const char*)(ws + WS_HS), (const char*)(ws + WS_WEI) + (size_t)l * NEXP * 1024 * DM * 2, F.ctl + CW_NT + l * 64, F.ctl + CW_TILE + l * 256, F.G, F.bid, (size_t)256 * DM * 2, (size_t)1024 * DM * 2, (size_t)256 * DM * 2};
            EpiSwiglu E{WSP(bf16, WS_ACT)};
            pg8::gemm_phase<EpiSwiglu, SchedMoe, true, true>(lds3, g, S, E, F.tid);
        }
        SEAM(p0 + 8);
        if (IN(p0 + 9) && PHON(9)) { FRAME();
            pg8::Gemm g{FF, FF, FF};
            SchedMoe S{(const char*)(ws + WS_ACT), (const char*)(ws + WS_WEO) + (size_t)l * NEXP * DM * FF * 2, F.ctl + CW_NT + l * 64, F.ctl + CW_TILE + l * 256, F.G, F.bid, (size_t)256 * FF * 2, (size_t)DM * FF * 2, (size_t)256 * FF * 2};
            EpiScaleRows E{WSP(bf16, WS_YS), WSP(float, WS_POS + 512 * 1024)};
            pg8::gemm_phase<EpiScaleRows, SchedMoe, true, true>(lds3, g, S, E, F.tid);
        }
        SEAM(p0 + 9);
        if (IN(p0 + 10) && PHON(10)) { FRAME(); phase_combine(F, A.out, WSP(bf16, WS_YS), WSP(unsigned, WS_POS), (l + 1 < DEPTH) ? A.in[I_MIXG] + (l + 1) * DM : nullptr, WSP(bf16, WS_H)); }
        SEAM(p0 + 10);
    }
#undef IN
#undef SEAM
#undef FRAME
#undef WSP
}

extern "C" void kernel_launch(void* const* d_in, const int* in_sizes, int n_in, void* d_out, int out_size, void* d_ws, size_t ws_size, hipStream_t stream) {
    static int grid = 0;
    if (grid == 0) {
        if (n_in != 23 || out_size != T * DM || ws_size < WS_END) { fprintf(stderr, "kernel_launch: unexpected shapes (n_in %d out %d ws %zu)\n", n_in, out_size, ws_size); grid = -1; return; }
        int dev = 0, cus = 0, per_cu = 0;
        if (hipGetDevice(&dev) != hipSuccess || hipDeviceGetAttribute(&cus, hipDeviceAttributeMultiprocessorCount, dev) != hipSuccess) { grid = -1; return; }
        if (hipFuncSetAttribute((const void*)mk_fwd, hipFuncAttributeMaxDynamicSharedMemorySize, LDS_BYTES) != hipSuccess) { fprintf(stderr, "kernel_launch: hipFuncSetAttribute failed\n"); grid = -1; return; }
        if (hipOccupancyMaxActiveBlocksPerMultiprocessor(&per_cu, (const void*)mk_fwd, 512, LDS_BYTES) != hipSuccess || per_cu < 1) fprintf(stderr, "kernel_launch: occupancy query says %d\n", per_cu);
        (void)hipGetLastError();
        grid = cus;
    }
    if (grid < 0) return;
    (void)hipMemsetAsync((char*)d_ws + WS_CTL, 0, CTL_ZERO_BYTES, stream);
    Args a{};
    for (int i = 0; i < 23; ++i) a.in[i] = (const float*)d_in[i];
    a.out = (float*)d_out; a.ws = (unsigned char*)d_ws;
#if MK_SPLIT
    for (int p = 0; p < N_PHASES; ++p) {
        if (p == 1 + PH_PER_LAYER) continue;
        a.ph_lo = p; a.ph_hi = p + 1;
        hipLaunchKernelGGL(mk_fwd, dim3(grid), dim3(512), LDS_BYTES, stream, a);
    }
#else
    a.ph_lo = 0; a.ph_hi = N_PHASES;
    hipLaunchKernelGGL(mk_fwd, dim3(grid), dim3(512), LDS_BYTES, stream, a);
#endif
}
```

```cpp
#include <hip/hip_runtime.h>
#include <cstdio>
#include <cstdint>

#ifndef MK_SPLIT
#define MK_SPLIT 0
#endif
#ifndef DBG_MASK
#define DBG_MASK 0xFFFFu
#endif
#define PHON(j) (((DBG_MASK) >> (j)) & 1u)
#ifndef REP_MASK
#define REP_MASK 0u
#endif
#ifndef REP_EXTRA
#define REP_EXTRA 1
#endif
#ifndef PROBE_DRY
#define PROBE_DRY 0
#endif
#define REPN(j) ((((REP_MASK) >> (j)) & 1u) ? (1 + REP_EXTRA) : 1)

constexpr int DM = 1024, NB = 8, SEQ = 2048, T = NB * SEQ, DEPTH = 2;
constexpr int NCOL = 7680;
constexpr int C_AQ = 0, C_AK = 512, C_AV = 1024, C_HQ = 1536, C_HF = 2048, C_HI = 2560, C_HG = 3072, C_CA = 3584, C_CB = 4096, C_GL = 4608;
constexpr int NEXP = 32, FF = 512;
constexpr int MOE_ROWS = 2 * T + NEXP * 256;
constexpr float RMS_EPS = 1e-6f, LN_EPS = 1e-5f;
constexpr float QSCALE = 0.125f * 1.4426950408889634f;

namespace pg8 {
#define PG8_LAS __attribute__((address_space(3)))
typedef unsigned short bf16_t;
typedef short bf16x8 __attribute__((ext_vector_type(8)));
typedef float f32x4 __attribute__((ext_vector_type(4)));
typedef unsigned u32x4 __attribute__((ext_vector_type(4)));
constexpr int BM = 256, BK = 64, HALF = 128, HTB = HALF * BK * 2, STAGE_BYTES = 8 * HTB, NXCD = 8, WGM = 8;

__host__ __device__ __forceinline__ int lds_byte(int r, int c) { const int st = (r >> 4) * 2 + (c >> 5), rr = r & 15, cc = c & 31, ob = rr * 64 + cc * 2; return st * 1024 + (ob ^ (((ob >> 9) & 1) << 5)); }
__host__ __device__ __forceinline__ void stage_rc(int b, int& R, int& C) { const int st = b / 1024, sb = b % 1024, swz = sb ^ (((sb >> 9) & 1) << 5); R = (st >> 1) * 16 + swz / 64; C = (st & 1) * 32 + (swz % 64) / 2; }
__host__ __device__ __forceinline__ int perm32(int rho) { const int n = rho >> 4, i = rho & 15; return 8 * (i >> 2) + 4 * n + (i & 3); }

struct Unit { int pm, pn, aux, pad; const char* a; const char* b; };
struct Gemm { int lda, ldb, K; };

__device__ __forceinline__ bool static_tile(int nM, int nN, long L, int& pm, int& pn) {
    const int nwg = nM * nN; if (L >= nwg) return false;
    int wgid = (int)L; { const int q = nwg / NXCD, r = nwg % NXCD, xcd = wgid % NXCD, off = wgid / NXCD; wgid = (xcd < r ? xcd * (q + 1) : r * (q + 1) + (xcd - r) * q) + off; }
    const int nig = WGM * nN, gid = wgid / nig, fm = gid * WGM, gsz = (nM - fm) < WGM ? (nM - fm) : WGM;
    pm = fm + ((wgid % nig) % gsz); pn = (wgid % nig) / gsz; return true;
}

__device__ __forceinline__ unsigned cvt_pk_bf16(float lo, float hi) { unsigned r; asm volatile("v_cvt_pk_bf16_f32 %0, %1, %2" : "=v"(r) : "v"(lo), "v"(hi)); return r; }

template <class Epi, class Sched, bool ALIGN_EPI = false, bool SP2 = false>
__device__ __forceinline__ void gemm_phase(PG8_LAS unsigned char* lds, const Gemm g, const Sched& S, const Epi& E, int tid_in) {
    int tid_ = tid_in; asm volatile("" : "+v"(tid_));
    const int tid = tid_, wid = __builtin_amdgcn_readfirstlane(tid >> 6), lane = tid & 63, wr = wid >> 2, wc = wid & 3, fr = lane & 15, fq = lane >> 4;
    const int K = g.K, nt = K / BK;
    unsigned voffA[2], voffB[2];
#pragma unroll
    for (int i = 0; i < 2; ++i) { int R, C; stage_rc(tid * 16 + i * 8192, R, C); const int Rb = Epi::PERM ? ((R & ~31) + perm32(R & 31)) : R;
        voffA[i] = (unsigned)(R * g.lda + C) * 2u; voffB[i] = (unsigned)(Rb * g.ldb + C) * 2u; }
    const size_t kstep = (size_t)(BK * 2);
    const size_t hstepA = (size_t)HALF * g.lda * 2, hstepB = (size_t)HALF * g.ldb * 2;
    const unsigned ldsw = (unsigned)wid * 1024u;
    const int aoff = lds_byte(wr * 64 + fr, fq * 8), boff = lds_byte(wc * 32 + fr, fq * 8);
#define PG8_SA(b, h) (((b) * 2 + (h)) * HTB)
#define PG8_SB(b, h) ((4 + (b) * 2 + (h)) * HTB)
#define PG8_STAGE(bufoff, gbase, voff) do { _Pragma("unroll") for (int _i = 0; _i < 2; ++_i) \
        __builtin_amdgcn_global_load_lds((const unsigned*)((const char*)(gbase) + (voff)[_i]), (PG8_LAS unsigned*)(lds + (bufoff) + ldsw + _i * 8192), 16, 0, 0); } while (0)
#define PG8_LDA(dst, b, h) do { _Pragma("unroll") for (int m = 0; m < 4; ++m) _Pragma("unroll") for (int k = 0; k < 2; ++k) dst[m][k] = *(const PG8_LAS bf16x8*)(lds + PG8_SA(b, h) + aoff + m * 2048 + k * 1024); } while (0)
#define PG8_LDB(dst, b, h) do { _Pragma("unroll") for (int n = 0; n < 2; ++n) _Pragma("unroll") for (int k = 0; k < 2; ++k) dst[n][k] = *(const PG8_LAS bf16x8*)(lds + PG8_SB(b, h) + boff + n * 2048 + k * 1024); } while (0)
#define PG8_MMA(ai, bj, At, Bt) do { __builtin_amdgcn_s_setprio(1); _Pragma("unroll") for (int m = 0; m < 4; ++m) _Pragma("unroll") for (int n = 0; n < 2; ++n) _Pragma("unroll") for (int k = 0; k < 2; ++k) \
        acc[ai][bj][m][n] = __builtin_amdgcn_mfma_f32_16x16x32_bf16(Bt[n][k], At[m][k], acc[ai][bj][m][n], 0, 0, 0); __builtin_amdgcn_s_setprio(0); } while (0)
#define PG8_WAIT_V(n) asm volatile("s_waitcnt vmcnt(" #n ")" ::: "memory")
#define PG8_WAIT_L(n) asm volatile("s_waitcnt lgkmcnt(" #n ")" ::: "memory")
#define PG8_BAR __builtin_amdgcn_s_barrier()
#define PG8_SCHED __builtin_amdgcn_sched_barrier(0)
    Unit cur, nxt; int ui = 0;
    if (!S.next(0, cur)) return;
    f32x4 acc[2][2][4][2];
#pragma unroll
    for (int a = 0; a < 2; ++a)
#pragma unroll
        for (int b = 0; b < 2; ++b)
#pragma unroll
            for (int m = 0; m < 4; ++m)
#pragma unroll
                for (int n = 0; n < 2; ++n) acc[a][b][m][n] = (f32x4){0.f, 0.f, 0.f, 0.f};
    bf16x8 At[4][2], B0[2][2], B1[2][2];
    const char* cA = cur.a; const char* cB = cur.b;
    if constexpr (SP2) {
        PG8_STAGE(PG8_SB(0, 0), cB, voffB); PG8_STAGE(PG8_SB(0, 1), cB + hstepB, voffB); PG8_STAGE(PG8_SA(0, 0), cA, voffA); PG8_STAGE(PG8_SA(0, 1), cA + hstepA, voffA);
        if (wr == 1) PG8_BAR;
        PG8_WAIT_V(2); PG8_BAR;
        PG8_STAGE(PG8_SB(1, 0), cB + kstep, voffB); PG8_STAGE(PG8_SA(1, 0), cA + kstep, voffA); PG8_STAGE(PG8_SB(1, 1), cB + hstepB + kstep, voffB);
        PG8_WAIT_V(6); PG8_BAR;
    } else {
        PG8_STAGE(PG8_SB(0, 0), cB, voffB); PG8_STAGE(PG8_SA(0, 0), cA, voffA); PG8_STAGE(PG8_SB(0, 1), cB + hstepB, voffB); PG8_STAGE(PG8_SA(0, 1), cA + hstepA, voffA);
        if (wr == 1) PG8_BAR;
        PG8_WAIT_V(4); PG8_BAR;
        PG8_STAGE(PG8_SB(1, 0), cB + kstep, voffB); PG8_STAGE(PG8_SA(1, 0), cA + kstep, voffA); PG8_STAGE(PG8_SB(1, 1), cB + hstepB + kstep, voffB);
        PG8_WAIT_V(6); PG8_BAR;
    }
    for (;;) {
        const bool has_next = S.next(ui + 1, nxt);
        const char* nA = has_next ? nxt.a : cA; const char* nB = has_next ? nxt.b : cB;
        for (int t = 0; t < nt; t += 2) {
            const bool last = (t == nt - 2);
            const char* a1 = cA + (size_t)(t + 1) * kstep;
            const char* a2 = last ? nA : cA + (size_t)(t + 2) * kstep; const char* b2 = last ? nB : cB + (size_t)(t + 2) * kstep;
            const char* a3 = a2 + kstep; const char* b3 = b2 + kstep;
            if constexpr (SP2) {
            PG8_LDB(B0, 0, 0); PG8_LDB(B1, 0, 1); PG8_SCHED; PG8_LDA(At, 0, 0); PG8_STAGE(PG8_SA(1, 1), a1 + hstepA, voffA);
            PG8_WAIT_V(8); PG8_WAIT_L(0); PG8_BAR; PG8_MMA(0, 0, At, B0); PG8_MMA(0, 1, At, B1); PG8_BAR; PG8_SCHED;
            PG8_LDA(At, 0, 1); PG8_STAGE(PG8_SB(0, 0), b2, voffB); PG8_STAGE(PG8_SB(0, 1), b2 + hstepB, voffB); PG8_STAGE(PG8_SA(0, 0), a2, voffA);
            PG8_WAIT_V(8); PG8_WAIT_L(0); PG8_BAR; PG8_MMA(1, 0, At, B0); PG8_MMA(1, 1, At, B1); PG8_BAR; PG8_SCHED;
            PG8_LDB(B0, 1, 0); PG8_LDB(B1, 1, 1); PG8_SCHED; PG8_LDA(At, 1, 0); PG8_STAGE(PG8_SA(0, 1), a2 + hstepA, voffA);
            PG8_WAIT_V(8); PG8_WAIT_L(0); PG8_BAR; PG8_MMA(0, 0, At, B0); PG8_MMA(0, 1, At, B1); PG8_BAR; PG8_SCHED;
            PG8_LDA(At, 1, 1); PG8_STAGE(PG8_SB(1, 0), b3, voffB); PG8_STAGE(PG8_SB(1, 1), b3 + hstepB, voffB); PG8_STAGE(PG8_SA(1, 0), a3, voffA);
            PG8_WAIT_V(8); PG8_WAIT_L(0); PG8_BAR; PG8_MMA(1, 0, At, B0); PG8_MMA(1, 1, At, B1); PG8_BAR; PG8_SCHED;
            } else {
            PG8_LDB(B0, 0, 0); PG8_SCHED; PG8_LDA(At, 0, 0); PG8_STAGE(PG8_SA(1, 1), a1 + hstepA, voffA);
            PG8_WAIT_L(8); PG8_BAR; PG8_WAIT_L(0); PG8_MMA(0, 0, At, B0); PG8_BAR; PG8_SCHED;
            PG8_LDB(B1, 0, 1); PG8_STAGE(PG8_SB(0, 0), b2, voffB);
            PG8_BAR; PG8_WAIT_L(0); PG8_MMA(0, 1, At, B1); PG8_BAR;
            PG8_LDA(At, 0, 1); PG8_STAGE(PG8_SA(0, 0), a2, voffA);
            PG8_BAR; PG8_WAIT_L(0); PG8_MMA(1, 0, At, B0); PG8_BAR; PG8_SCHED;
            PG8_STAGE(PG8_SB(0, 1), b2 + hstepB, voffB);
            PG8_WAIT_V(6); PG8_BAR; PG8_MMA(1, 1, At, B1); PG8_BAR;
            PG8_LDB(B0, 1, 0); PG8_SCHED; PG8_LDA(At, 1, 0); PG8_STAGE(PG8_SA(0, 1), a2 + hstepA, voffA);
            PG8_WAIT_L(8); PG8_BAR; PG8_WAIT_L(0); PG8_MMA(0, 0, At, B0); PG8_BAR; PG8_SCHED;
            PG8_LDB(B1, 1, 1); PG8_STAGE(PG8_SB(1, 0), b3, voffB);
            PG8_BAR; PG8_WAIT_L(0); PG8_MMA(0, 1, At, B1); PG8_BAR;
            PG8_LDA(At, 1, 1); PG8_STAGE(PG8_SA(1, 0), a3, voffA);
            PG8_BAR; PG8_WAIT_L(0); PG8_MMA(1, 0, At, B0); PG8_BAR; PG8_SCHED;
            PG8_STAGE(PG8_SB(1, 1), b3 + hstepB, voffB);
            PG8_WAIT_V(6); PG8_BAR; PG8_MMA(1, 1, At, B1); PG8_BAR;
            }
        }
        if constexpr (ALIGN_EPI) { if (wr == 0) PG8_BAR; }
        const bool reset_acc = E(acc, cur, wr, wc, fr, fq);
        if (!has_next) break;
        if (reset_acc) {
#pragma unroll
        for (int a = 0; a < 2; ++a)
#pragma unroll
            for (int b = 0; b < 2; ++b)
#pragma unroll
                for (int m = 0; m < 4; ++m)
#pragma unroll
                    for (int n = 0; n < 2; ++n) acc[a][b][m][n] = (f32x4){0.f, 0.f, 0.f, 0.f};
        }
        cur = nxt; cA = nA; cB = nB; ++ui;
        if constexpr (ALIGN_EPI) { if (wr == 1) PG8_BAR; }
    }
    PG8_WAIT_V(0);
    if constexpr (!ALIGN_EPI) { if (wr == 0) PG8_BAR; }
    PG8_BAR;
#undef PG8_SA
#undef PG8_SB
#undef PG8_STAGE
#undef PG8_LDA
#undef PG8_LDB
#undef PG8_MMA
#undef PG8_WAIT_V
#undef PG8_WAIT_L
#undef PG8_BAR
#undef PG8_SCHED
}
}

constexpr size_t MiB = 1u << 20;
constexpr size_t WS_CTL = 0, CTL_ZERO_BYTES = 1 * MiB;
constexpr size_t WS_WIN = 2 * MiB;
constexpr size_t WS_WCAT = WS_WIN + 30 * MiB;
constexpr size_t WS_WOUT = WS_WCAT + 6 * MiB;
constexpr size_t WS_WEI = WS_WOUT + 4 * MiB;
constexpr size_t WS_WEO = WS_WEI + 128 * MiB;
constexpr size_t WS_H = WS_WEO + 64 * MiB;
constexpr size_t WS_PROJ = WS_H + 32 * MiB;
constexpr size_t WS_Q = WS_PROJ + 240 * MiB;
constexpr size_t WS_K = WS_Q + 16 * MiB;
constexpr size_t WS_KMEAN = WS_K + 16 * MiB;
constexpr size_t WS_CAT = WS_KMEAN + 1 * MiB;
constexpr size_t WS_MERGED = WS_CAT + 48 * MiB;
constexpr size_t WS_ORAW = WS_MERGED + 32 * MiB;
constexpr size_t WS_ROUTE = WS_ORAW + 32 * MiB;
constexpr size_t WS_POS = WS_ROUTE + 1 * MiB;
constexpr size_t WS_HS = WS_POS + 1 * MiB;
constexpr size_t WS_ACT = WS_HS + 80 * MiB;
constexpr size_t WS_YS = WS_ACT + 40 * MiB;
constexpr size_t WS_END = WS_YS + 80 * MiB;
static_assert(WS_END <= 1000 * MiB, "workspace map");
constexpr int CW_BAR = 4096;
constexpr int CW_CNT = 16384;
constexpr int CW_NT = CW_CNT + 2 * 32 * 64;
constexpr int CW_TILE = CW_NT + 2 * 64;
static_assert((CW_TILE + 2 * 256) * 4 <= (int)CTL_ZERO_BYTES, "ctl");

constexpr int LDS_SCRATCH = 155136, LDSCTL_OFF = LDS_SCRATCH, LDS_BYTES = 155648;

#define GAS __attribute__((address_space(1)))
#define LAS __attribute__((address_space(3)))
typedef unsigned short bf16;
typedef unsigned v4u __attribute__((ext_vector_type(4)));
typedef unsigned v2u __attribute__((ext_vector_type(2)));
typedef float f32x4 __attribute__((ext_vector_type(4)));
typedef float f32x2 __attribute__((ext_vector_type(2)));
#define RLX_AGENT __ATOMIC_RELAXED, __HIP_MEMORY_SCOPE_AGENT
__device__ __forceinline__ unsigned f2bf(float f) { unsigned u = __builtin_bit_cast(unsigned, f); return (u + 0x7fffu + ((u >> 16) & 1u)) >> 16; }
__device__ __forceinline__ unsigned pk2(float lo, float hi) { return f2bf(lo) | (f2bf(hi) << 16); }
__device__ __forceinline__ float bflo(unsigned w) { return __uint_as_float(w << 16); }
__device__ __forceinline__ float bfhi(unsigned w) { return __uint_as_float(w & 0xffff0000u); }
__device__ __forceinline__ float bf2f(bf16 v) { return __uint_as_float((unsigned)v << 16); }
__device__ __forceinline__ float sigmoidf_(float x) { return 1.0f / (1.0f + __expf(-x)); }
__device__ __forceinline__ float wave_sum(float v) {
    v += __int_as_float(__builtin_amdgcn_update_dpp(0, __float_as_int(v), 0xB1, 0xf, 0xf, true));
    v += __int_as_float(__builtin_amdgcn_update_dpp(0, __float_as_int(v), 0x4E, 0xf, 0xf, true));
    v += __int_as_float(__builtin_amdgcn_update_dpp(0, __float_as_int(v), 0x141, 0xf, 0xf, true));
    v += __int_as_float(__builtin_amdgcn_update_dpp(0, __float_as_int(v), 0x140, 0xf, 0xf, true));
    { auto r = __builtin_amdgcn_permlane16_swap(__float_as_uint(v), __float_as_uint(v), false, false); v = __uint_as_float(r[0]) + __uint_as_float(r[1]); }
    { auto r = __builtin_amdgcn_permlane32_swap(__float_as_uint(v), __float_as_uint(v), false, false); v = __uint_as_float(r[0]) + __uint_as_float(r[1]); }
    return v;
}

#define XB_TMO      128
#define XB_XCNT(j)  (256  + 64 * (j))
#define XB_XSUB(j)  (1280 + 64 * (j))
#define XB_XGEN(j)  (2304 + 64 * (j))
#define XB_TOP      3328
#define XB_TOPGEN   3392
#define XCD_BAR_WORDS 3456
#define XB_SPIN_CAP (1u << 18)
__device__ __forceinline__ unsigned xb_ld(unsigned* p)              { return __hip_atomic_load(p, __ATOMIC_RELAXED, __HIP_MEMORY_SCOPE_AGENT); }
__device__ __forceinline__ unsigned xb_add(unsigned* p, unsigned v) { return __hip_atomic_fetch_add(p, v, __ATOMIC_RELAXED, __HIP_MEMORY_SCOPE_AGENT); }
__device__ __forceinline__ unsigned xb_xcc_id() { return (unsigned)__builtin_amdgcn_s_getreg((3 << 11) | 20) & 0xFu; }
#define XB_SPIN(cond, bar) do { unsigned _sp = 0; while (cond) { __builtin_amdgcn_s_sleep(1); \
    if ((++_sp & 255u) == 0u) { if (xb_ld(&(bar)[XB_TMO])) break; if (_sp > XB_SPIN_CAP) { atomicAdd(&(bar)[XB_TMO], 1u); break; } } } } while (0)
struct XcdBarrier { unsigned* bar; unsigned x; volatile LAS unsigned* st; };
__device__ __forceinline__ XcdBarrier xcd_barrier_post(unsigned* bar, volatile LAS unsigned* st) {
    XcdBarrier b; b.bar = bar; b.x = xb_xcc_id(); b.st = st;
    if (threadIdx.x == 0) (void)xb_add(&bar[XB_XCNT(b.x)], 1u);
    return b;
}
__device__ __forceinline__ void xcd_barrier_complete(unsigned* bar, unsigned x, unsigned& nloc, unsigned& nx) {
    const unsigned G = gridDim.x * gridDim.y * gridDim.z;
    unsigned sum, cnt, mine, sp = 0u;
    for (;;) {
        sum = 0u; cnt = 0u; mine = 0u;
#pragma unroll
        for (unsigned j = 0; j < 16; ++j) { const unsigned c = xb_ld(&bar[XB_XCNT(j)]); sum += c; cnt += (c > 0u) ? 1u : 0u; mine = (j == x) ? c : mine; }
        if (sum == G) break;
        __builtin_amdgcn_s_sleep(1);
        if ((++sp & 255u) == 0u) { if (xb_ld(&bar[XB_TMO])) break; if (sp > XB_SPIN_CAP) { atomicAdd(&bar[XB_TMO], 1u); break; } }
    }
    nloc = mine > 0u ? mine : 1u; nx = cnt > 0u ? cnt : 1u;
}
__device__ __forceinline__ void xcd_barrier(const XcdBarrier& b) {
    asm volatile("s_waitcnt vmcnt(0)" ::: "memory");
    __syncthreads();
    if (threadIdx.x == 0) {
        unsigned* bar = b.bar;
        __builtin_amdgcn_s_waitcnt(0);
        unsigned nloc = b.st[0], nx = b.st[1];
        if (nloc == 0u) { xcd_barrier_complete(bar, b.x, nloc, nx); b.st[0] = nloc; b.st[1] = nx; }
        const unsigned old = xb_add(&bar[XB_XSUB(b.x)], 1u);
        const unsigned gen = old / nloc;
        if (old + 1u == (gen + 1u) * nloc) {
            __builtin_amdgcn_fence(__ATOMIC_RELEASE, "agent");
            asm volatile("s_waitcnt vmcnt(0)" ::: "memory");
            const unsigned og = xb_add(&bar[XB_TOP], 1u);
            const unsigned tg = og / nx;
            if (og + 1u == (tg + 1u) * nx) xb_add(&bar[XB_TOPGEN], 1u);
            else XB_SPIN(xb_ld(&bar[XB_TOPGEN]) == tg, bar);
            __builtin_amdgcn_fence(__ATOMIC_ACQUIRE, "agent");
            xb_add(&bar[XB_XGEN(b.x)], 1u);
            asm volatile("s_waitcnt vmcnt(0)" ::: "memory");
        } else {
            XB_SPIN(xb_ld(&bar[XB_XGEN(b.x)]) == gen, bar);
            __builtin_amdgcn_fence(__ATOMIC_ACQUIRE, "agent");
            asm volatile("s_waitcnt vmcnt(0)" ::: "memory");
        }
    }
    __syncthreads();
}

struct Args { const float* in[23]; float* out; unsigned char* ws; int ph_lo, ph_hi; };
typedef const Args __attribute__((address_space(4))) CArgs;
enum InIdx { I_X = 0, I_MIXG, I_WIN, I_BGATE, I_QG, I_KG, I_LBL, I_HGG, I_CONVW, I_CONVB, I_CLNG, I_CLNB, I_WATT, I_WHGRN, I_WCONV, I_WOUT, I_FFNG, I_WCO, I_BCO, I_WFI, I_BFI, I_WEI, I_WEO };

struct Frame {
    unsigned char* lds;
    int tid, lane, wave, G, bid;
    unsigned char* ws; unsigned* ctl;
};
__device__ __forceinline__ int lane_id_asm() { int l; asm volatile("v_mbcnt_lo_u32_b32 %0, -1, 0\n\tv_mbcnt_hi_u32_b32 %0, -1, %0" : "=v"(l)); return l; }
__device__ __forceinline__ Frame fresh(Frame F) { asm volatile("" : "+v"(F.tid)); F.lane = F.tid & 63; return F; }

__device__ __forceinline__ void transpose_item(const float* W, int K, int N, bf16* WT, int k0, int n0, int drow0, float* scr, int lane) {
#pragma unroll 8
    for (int i = 0; i < 32; ++i) { const int kk = 2 * i + (lane >> 5); scr[kk * 33 + (lane & 31)] = W[(size_t)(k0 + kk) * N + n0 + (lane & 31)]; }
    asm volatile("s_waitcnt lgkmcnt(0)" ::: "memory");
    const int c = lane & 7;
#pragma unroll
    for (int j = 0; j < 4; ++j) { const int n = (lane >> 3) + 8 * j; const float* s = scr + (8 * c) * 33 + n;
        v4u o; o.x = pk2(s[0 * 33], s[1 * 33]); o.y = pk2(s[2 * 33], s[3 * 33]); o.z = pk2(s[4 * 33], s[5 * 33]); o.w = pk2(s[6 * 33], s[7 * 33]);
        *(v4u*)(WT + (size_t)(drow0 + n) * K + k0 + 8 * c) = o; }
    asm volatile("s_waitcnt lgkmcnt(0)" ::: "memory");
}

__device__ __forceinline__ void phase_prologue(const Frame& F0, CArgs& A) {
    const Frame F = fresh(F0);
    float* scr = (float*)(F.lds + F.wave * 16384);
    const int gw = F.bid * 8 + F.wave, NGW = F.G * 8;
    constexpr int I_IN = (DM / 64) * (NCOL / 32);
    constexpr int I_BR = (512 / 64) * (DM / 32);
    constexpr int I_OUT = (DM / 64) * (DM / 32);
    constexpr int I_EI = (DM / 64) * (1024 / 32);
    constexpr int I_EO = (FF / 64) * (DM / 32);
    constexpr int PER_L = I_IN + 3 * I_BR + I_OUT + NEXP * I_EI + NEXP * I_EO;
    for (int it = gw; it < DEPTH * PER_L; it += NGW) {
        const int l = it / PER_L; int r = it % PER_L;
        if (r < I_IN) { const int nblk = NCOL / 32, kb = r / nblk, nb = r % nblk;
            transpose_item(A.in[I_WIN] + (size_t)l * DM * NCOL, DM, NCOL, (bf16*)(F.ws + WS_WIN) + (size_t)l * NCOL * DM, 64 * kb, 32 * nb, 32 * nb, scr, F.lane); continue; }
        r -= I_IN;
        if (r < 3 * I_BR) { const int br = r / I_BR, rr = r % I_BR, nblk = DM / 32, kb = rr / nblk, nb = rr % nblk;
            const float* W = A.in[br == 0 ? I_WATT : (br == 1 ? I_WHGRN : I_WCONV)] + (size_t)l * 512 * DM;
            transpose_item(W, 512, DM, (bf16*)(F.ws + WS_WCAT) + ((size_t)l * 3 + br) * DM * 512, 64 * kb, 32 * nb, 32 * nb, scr, F.lane); continue; }
        r -= 3 * I_BR;
        if (r < I_OUT) { const int nblk = DM / 32, kb = r / nblk, nb = r % nblk;
            transpose_item(A.in[I_WOUT] + (size_t)l * DM * DM, DM, DM, (bf16*)(F.ws + WS_WOUT) + (size_t)l * DM * DM, 64 * kb, 32 * nb, 32 * nb, scr, F.lane); continue; }
        r -= I_OUT;
        if (r < NEXP * I_EI) { const int e = r / I_EI, rr = r % I_EI, nblk = 1024 / 32, kb = rr / nblk, nb = rr % nblk, n0 = 32 * nb;
            const int nn = n0 & 511, drow0 = (nn >> 7) * 256 + (n0 >= 512 ? 128 : 0) + (nn & 127);
            transpose_item(A.in[I_WEI] + ((size_t)l * NEXP + e) * DM * 1024, DM, 1024, (bf16*)(F.ws + WS_WEI) + ((size_t)l * NEXP + e) * 1024 * DM, 64 * kb, n0, drow0, scr, F.lane); continue; }
        r -= NEXP * I_EI;
        { const int e = r / I_EO, rr = r % I_EO, nblk = DM / 32, kb = rr / nblk, nb = rr % nblk;
            transpose_item(A.in[I_WEO] + ((size_t)l * NEXP + e) * FF * DM, FF, DM, (bf16*)(F.ws + WS_WEO) + ((size_t)l * NEXP + e) * DM * FF, 64 * kb, 32 * nb, 32 * nb, scr, F.lane); }
    }
}

__device__ __forceinline__ void phase_norm(const Frame& F0, const float* x, const float* gain, bf16* out) {
    const Frame F = fresh(F0);
    const int gw = F.bid * 8 + F.wave, NGW = F.G * 8;
    f32x4 g[4];
#pragma unroll
    for (int j = 0; j < 4; ++j) g[j] = *(const f32x4*)(gain + 4 * F.lane + 256 * j);
    for (int m0 = gw; m0 < T; m0 += 4 * NGW) {
        f32x4 v[4][4];
#pragma unroll
        for (int q = 0; q < 4; ++q) { const int m = m0 + q * NGW; if (m < T) { const f32x4* xr = (const f32x4*)(x + (size_t)m * DM) + F.lane;
#pragma unroll
                for (int j = 0; j < 4; ++j) v[q][j] = xr[64 * j]; } }
#pragma unroll
        for (int q = 0; q < 4; ++q) { const int m = m0 + q * NGW; if (m < T) { float s = 0.f;
#pragma unroll
                for (int j = 0; j < 4; ++j) s += (v[q][j].x * v[q][j].x + v[q][j].y * v[q][j].y) + (v[q][j].z * v[q][j].z + v[q][j].w * v[q][j].w);
                const float r = rsqrtf(wave_sum(s) * (1.f / DM) + RMS_EPS);
                v2u* o8 = (v2u*)(out + (size_t)m * DM) + F.lane;
#pragma unroll
                for (int j = 0; j < 4; ++j) { v2u w; w.x = pk2(v[q][j].x * r * g[j].x, v[q][j].y * r * g[j].y); w.y = pk2(v[q][j].z * r * g[j].z, v[q][j].w * r * g[j].w); o8[64 * j] = w; } } }
    }
}

__device__ __forceinline__ void phase_qkprep(const Frame& F0, const bf16* proj, const float* qg, const float* kg, bf16* Q, bf16* Kb, float* kmean) {
    const Frame F = fresh(F0);
    float* red = (float*)F.lds;
    float* red2 = red + 256 * 65;
    const int tok = F.tid >> 1, hf = F.tid & 1;
    for (int u = F.bid; u < 512; u += F.G) {
        const int b = u >> 6, blk = (u >> 3) & 7, h = u & 7;
        const size_t row = (size_t)b * SEQ + blk * 256 + tok;
        const bf16* pq = proj + row * NCOL + C_AQ + h * 64 + hf * 32;
        const bf16* pk = proj + row * NCOL + C_AK + h * 64 + hf * 32;
        float qv[32], kv[32];
#pragma unroll
        for (int i = 0; i < 4; ++i) { const v4u a = *(const v4u*)(pq + 8 * i), c = *(const v4u*)(pk + 8 * i);
            qv[8 * i + 0] = bflo(a.x); qv[8 * i + 1] = bfhi(a.x); qv[8 * i + 2] = bflo(a.y); qv[8 * i + 3] = bfhi(a.y); qv[8 * i + 4] = bflo(a.z); qv[8 * i + 5] = bfhi(a.z); qv[8 * i + 6] = bflo(a.w); qv[8 * i + 7] = bfhi(a.w);
            kv[8 * i + 0] = bflo(c.x); kv[8 * i + 1] = bfhi(c.x); kv[8 * i + 2] = bflo(c.y); kv[8 * i + 3] = bfhi(c.y); kv[8 * i + 4] = bflo(c.z); kv[8 * i + 5] = bfhi(c.z); kv[8 * i + 6] = bflo(c.w); kv[8 * i + 7] = bfhi(c.w); }
        float sq = 0.f, sk = 0.f;
#pragma unroll
        for (int i = 0; i < 32; ++i) { sq += qv[i] * qv[i]; sk += kv[i] * kv[i]; }
        sq += __shfl_xor(sq, 1); sk += __shfl_xor(sk, 1);
        const float rq = rsqrtf(sq * (1.f / 64.f) + RMS_EPS) * QSCALE, rk = rsqrtf(sk * (1.f / 64.f) + RMS_EPS);
#pragma unroll
        for (int i = 0; i < 32; ++i) { qv[i] = qv[i] * rq * qg[hf * 32 + i]; kv[i] = kv[i] * rk * kg[hf * 32 + i]; }
        bf16* oq = Q + row * 512 + h * 64 + hf * 32; bf16* ok = Kb + row * 512 + h * 64 + hf * 32;
#pragma unroll
        for (int i = 0; i < 4; ++i) { v4u a, c;
            a.x = pk2(qv[8 * i], qv[8 * i + 1]); a.y = pk2(qv[8 * i + 2], qv[8 * i + 3]); a.z = pk2(qv[8 * i + 4], qv[8 * i + 5]); a.w = pk2(qv[8 * i + 6], qv[8 * i + 7]);
            c.x = pk2(kv[8 * i], kv[8 * i + 1]); c.y = pk2(kv[8 * i + 2], kv[8 * i + 3]); c.z = pk2(kv[8 * i + 4], kv[8 * i + 5]); c.w = pk2(kv[8 * i + 6], kv[8 * i + 7]);
            *(v4u*)(oq + 8 * i) = a; *(v4u*)(ok + 8 * i) = c; }
        __syncthreads();
#pragma unroll
        for (int i = 0; i < 32; ++i) red[tok * 65 + hf * 32 + i] = kv[i];
        __syncthreads();
        { const int d = F.tid & 63, part = F.tid >> 6; float s = 0.f;
            for (int tk = 0; tk < 32; ++tk) s += red[(part * 32 + tk) * 65 + d];
            red2[part * 64 + d] = s; }
        __syncthreads();
        if (F.tid < 64) { float s = 0.f;
#pragma unroll
            for (int p = 0; p < 8; ++p) s += red2[p * 64 + F.tid];
            kmean[(((size_t)b * 8 + h) * 8 + blk) * 64 + F.tid] = s * (1.f / 256.f); }
    }
    __syncthreads();
}

__device__ __forceinline__ void phase_conv(const Frame& F0, const bf16* proj, const float* cw, const float* cb, const float* lng, const float* lnb, bf16* cat) {
    const Frame F = fresh(F0);
    float* ut = (float*)F.lds;
    const int c = F.tid;
    float w[31];
#pragma unroll
    for (int j = 0; j < 31; ++j) w[j] = cw[j * 512 + c];
    const float bias = cb[c];
    for (int u = F.bid; u < 512; u += F.G) {
        const int b = u >> 6, t0 = (u & 63) * 32;
        __syncthreads();
        {
            v4u av[8], gv[8];
#pragma unroll
            for (int i = 0; i < 8; ++i) { const int idx = F.tid + 512 * i, r = idx >> 6, ch = (idx & 63) * 8, t = t0 - 30 + r;
                if (r < 62 && t >= 0) { const bf16* p = proj + ((size_t)b * SEQ + t) * NCOL + ch; av[i] = *(const v4u*)(p + C_CA); gv[i] = *(const v4u*)(p + C_CB); }
                else { av[i] = (v4u){0u, 0u, 0u, 0u}; gv[i] = (v4u){0u, 0u, 0u, 0u}; } }
#pragma unroll
            for (int i = 0; i < 8; ++i) { const int idx = F.tid + 512 * i, r = idx >> 6, ch = (idx & 63) * 8;
                if (r < 62) {
                    f32x4 u0, u1;
                    u0.x = bflo(av[i].x) * sigmoidf_(bflo(gv[i].x)); u0.y = bfhi(av[i].x) * sigmoidf_(bfhi(gv[i].x)); u0.z = bflo(av[i].y) * sigmoidf_(bflo(gv[i].y)); u0.w = bfhi(av[i].y) * sigmoidf_(bfhi(gv[i].y));
                    u1.x = bflo(av[i].z) * sigmoidf_(bflo(gv[i].z)); u1.y = bfhi(av[i].z) * sigmoidf_(bfhi(gv[i].z)); u1.z = bflo(av[i].w) * sigmoidf_(bflo(gv[i].w)); u1.w = bfhi(av[i].w) * sigmoidf_(bfhi(gv[i].w));
                    *(f32x4*)(ut + r * 512 + ch) = u0; *(f32x4*)(ut + r * 512 + ch + 4) = u1; } }
        }
        __syncthreads();
        float uu[62];
#pragma unroll
        for (int i = 0; i < 62; ++i) uu[i] = ut[i * 512 + c];
#pragma unroll
        for (int t = 0; t < 32; ++t) { float a = bias;
#pragma unroll
            for (int j = 0; j < 31; ++j) a += w[j] * uu[t + j];
            ut[t * 512 + c] = a; }
        __syncthreads();
#pragma unroll
        for (int q = 0; q < 4; ++q) { const int t = F.wave * 4 + q;
            const f32x4 v0 = *(const f32x4*)(ut + t * 512 + 8 * F.lane), v1 = *(const f32x4*)(ut + t * 512 + 8 * F.lane + 4);
            const float mu = wave_sum((v0.x + v0.y) + (v0.z + v0.w) + (v1.x + v1.y) + (v1.z + v1.w)) * (1.f / 512.f);
            const f32x4 d0 = v0 - mu, d1 = v1 - mu;
            const float var = wave_sum((d0.x * d0.x + d0.y * d0.y) + (d0.z * d0.z + d0.w * d0.w) + (d1.x * d1.x + d1.y * d1.y) + (d1.z * d1.z + d1.w * d1.w)) * (1.f / 512.f);
            const float rs = rsqrtf(var + LN_EPS);
            const f32x4 g0 = *(const f32x4*)(lng + 8 * F.lane), g1 = *(const f32x4*)(lng + 8 * F.lane + 4), b0 = *(const f32x4*)(lnb + 8 * F.lane), b1 = *(const f32x4*)(lnb + 8 * F.lane + 4);
            f32x4 y0 = d0 * rs * g0 + b0, y1 = d1 * rs * g1 + b1;
            y0.x *= sigmoidf_(y0.x); y0.y *= sigmoidf_(y0.y); y0.z *= sigmoidf_(y0.z); y0.w *= sigmoidf_(y0.w);
            y1.x *= sigmoidf_(y1.x); y1.y *= sigmoidf_(y1.y); y1.z *= sigmoidf_(y1.z); y1.w *= sigmoidf_(y1.w);
            v4u o; o.x = pk2(y0.x, y0.y); o.y = pk2(y0.z, y0.w); o.z = pk2(y1.x, y1.y); o.w = pk2(y1.z, y1.w);
            *(v4u*)(cat + ((size_t)b * SEQ + t0 + t) * 1536 + 1024 + 8 * F.lane) = o; }
    }
    __syncthreads();
}

__device__ __forceinline__ void phase_hgrn_naive(const Frame& F0, const bf16* proj, const float* lbl, int layer, float* oraw) {
    const Frame F = fresh(F0);
    float* part = (float*)F.lds;
    const int k = F.tid & 127, vq = F.tid >> 7;
    for (int u = F.bid; u < 256; u += F.G) {
        const int b = u >> 5, h = (u >> 3) & 3, vs = u & 7;
        float lb = 0.f;
        if (layer > 0) { const float l0 = lbl[h * 128 + k], l1 = lbl[512 + h * 128 + k]; lb = 1.f / (1.f + __expf(l0 - l1)); }
        const float omlb = 1.f - lb;
        float S0 = 0.f, S1 = 0.f, S2 = 0.f, S3 = 0.f;
        const bf16* pq = proj + (size_t)b * SEQ * NCOL + C_HQ + h * 128 + k;
        const bf16* pf = proj + (size_t)b * SEQ * NCOL + C_HF + h * 128 + k;
        const bf16* pv = proj + (size_t)b * SEQ * NCOL + C_HI + h * 128 + vs * 16 + vq * 4;
        for (int t0 = 0; t0 < SEQ; t0 += 32) {
#pragma unroll 4
            for (int tt = 0; tt < 32; ++tt) {
                const size_t ro = (size_t)(t0 + tt) * NCOL;
                const float qv = bf2f(pq[ro]), fr = bf2f(pf[ro]); const v2u vv = *(const v2u*)(pv + ro);
                const float sig = sigmoidf_(fr), f = lb + omlb * sig, kk = omlb * (1.f - sig), qa = qv * sigmoidf_(qv);
                S0 = f * S0 + kk * bflo(vv.x); S1 = f * S1 + kk * bfhi(vv.x); S2 = f * S2 + kk * bflo(vv.y); S3 = f * S3 + kk * bfhi(vv.y);
                const float p0 = wave_sum(qa * S0), p1 = wave_sum(qa * S1), p2 = wave_sum(qa * S2), p3 = wave_sum(qa * S3);
                if (F.lane == 0) *(f32x4*)(part + (tt * 8 + F.wave) * 4) = (f32x4){p0, p1, p2, p3};
            }
            __syncthreads();
            if (F.tid < 128) { const int tt = F.tid >> 2, v2 = F.tid & 3;
                const f32x4 a = *(const f32x4*)(part + (tt * 8 + v2 * 2) * 4), c = *(const f32x4*)(part + (tt * 8 + v2 * 2 + 1) * 4);
                *(f32x4*)(oraw + ((size_t)b * SEQ + t0 + tt) * 512 + h * 128 + vs * 16 + v2 * 4) = a + c; }
            __syncthreads();
        }
    }
}

__device__ __forceinline__ void phase_hgrn_post(const Frame& F0, const float* oraw, const bf16* proj, const float* hgg, bf16* cat) {
    const Frame F = fresh(F0);
    const int gw = F.bid * 8 + F.wave, NGW = F.G * 8;
    const f32x2 g = *(const f32x2*)(hgg + 2 * F.lane);
    for (int it = gw; it < T * 4; it += NGW) {
        const int row = it >> 2, h = it & 3;
        const f32x2 o = *(const f32x2*)(oraw + (size_t)row * 512 + h * 128 + 2 * F.lane);
        const unsigned hw = *(const unsigned*)(proj + (size_t)row * NCOL + C_HG + h * 128 + 2 * F.lane);
        const float r = rsqrtf(wave_sum(o.x * o.x + o.y * o.y) * (1.f / 128.f) + RMS_EPS);
        const float g0 = bflo(hw), g1 = bfhi(hw);
        const float y0 = o.x * r * g.x * (g0 * sigmoidf_(g0)), y1 = o.y * r * g.y * (g1 * sigmoidf_(g1));
        *(unsigned*)(cat + (size_t)row * 1536 + 512 + h * 128 + 2 * F.lane) = pk2(y0, y1);
    }
}

__device__ __forceinline__ void attn_naive_unit(const Frame& F, int b, int h, int qb, const bf16* Q, const bf16* Kb, const bf16* proj, const float* kmean, bf16* cat) {
    float* Ks = (float*)F.lds;
    float* Vs = Ks + 64 * 64;
    const int qi = F.tid >> 1, half = F.tid & 1;
    const size_t row0 = (size_t)b * SEQ + qb * 256;
    float q[32];
    { const bf16* pq = Q + (row0 + qi) * 512 + h * 64 + half * 32;
#pragma unroll
        for (int i = 0; i < 4; ++i) { const v4u a = *(const v4u*)(pq + 8 * i);
            q[8 * i + 0] = bflo(a.x); q[8 * i + 1] = bfhi(a.x); q[8 * i + 2] = bflo(a.y); q[8 * i + 3] = bfhi(a.y); q[8 * i + 4] = bflo(a.z); q[8 * i + 5] = bfhi(a.z); q[8 * i + 6] = bflo(a.w); q[8 * i + 7] = bfhi(a.w); } }
    unsigned selmask;
    if (qb <= 3) selmask = (1u << qb) - 1u;
    else {
        float gate[7];
#pragma unroll
        for (int j = 0; j < 7; ++j) { gate[j] = -3.0e38f;
            if (j < qb) { const float* km = kmean + (((size_t)b * 8 + h) * 8 + j) * 64 + half * 32; float s = 0.f;
#pragma unroll
                for (int d = 0; d < 32; ++d) s += q[d] * km[d];
                s += __shfl_xor(s, 1);
                gate[j] = s; } }
        selmask = 0u;
#pragma unroll
        for (int r = 0; r < 3; ++r) { float best = -3.0e38f; int bi = 0;
#pragma unroll
            for (int j = 0; j < 7; ++j) { const bool ok = (j < qb) && !((selmask >> j) & 1u) && (gate[j] > best); if (ok) { best = gate[j]; bi = j; } }
            selmask |= 1u << bi; }
    }
    float acc[32];
#pragma unroll
    for (int d = 0; d < 32; ++d) acc[d] = 0.f;
    float l = 0.f;
    const int skey = F.tid >> 3, sseg = F.tid & 7;
    for (int j = 0; j <= qb; ++j) {
        for (int kt = 0; kt < 4; ++kt) {
            __syncthreads();
            { const size_t krow = (size_t)b * SEQ + j * 256 + kt * 64 + skey;
                const v4u kk = *(const v4u*)(Kb + krow * 512 + h * 64 + sseg * 8), vv = *(const v4u*)(proj + krow * NCOL + C_AV + h * 64 + sseg * 8);
                *(f32x4*)(Ks + skey * 64 + sseg * 8) = (f32x4){bflo(kk.x), bfhi(kk.x), bflo(kk.y), bfhi(kk.y)}; *(f32x4*)(Ks + skey * 64 + sseg * 8 + 4) = (f32x4){bflo(kk.z), bfhi(kk.z), bflo(kk.w), bfhi(kk.w)};
                *(f32x4*)(Vs + skey * 64 + sseg * 8) = (f32x4){bflo(vv.x), bfhi(vv.x), bflo(vv.y), bfhi(vv.y)}; *(f32x4*)(Vs + skey * 64 + sseg * 8 + 4) = (f32x4){bflo(vv.z), bfhi(vv.z), bflo(vv.w), bfhi(vv.w)}; }
            __syncthreads();
            if (j == qb && kt > (F.wave >> 1)) continue;
#pragma unroll 2
            for (int key = 0; key < 64; ++key) {
                float s = 0.f;
#pragma unroll
                for (int d = 0; d < 32; d += 4) { const f32x4 kx = *(const f32x4*)(Ks + key * 64 + half * 32 + d); s += q[d] * kx.x + q[d + 1] * kx.y + q[d + 2] * kx.z + q[d + 3] * kx.w; }
                s += __shfl_xor(s, 1);
                const bool valid = (j == qb) ? (kt * 64 + key <= qi) : (((selmask >> j) & 1u) != 0u);
                const float p = valid ? exp2f(s) : 0.f;
                l += p;
#pragma unroll
                for (int d = 0; d < 32; d += 4) { const f32x4 vx = *(const f32x4*)(Vs + key * 64 + half * 32 + d); acc[d] += p * vx.x; acc[d + 1] += p * vx.y; acc[d + 2] += p * vx.z; acc[d + 3] += p * vx.w; }
            }
        }
    }
    { const float rl = 1.f / l;
        bf16* po = cat + (row0 + qi) * 1536 + h * 64 + half * 32;
#pragma unroll
        for (int i = 0; i < 4; ++i) { v4u o; o.x = pk2(acc[8 * i] * rl, acc[8 * i + 1] * rl); o.y = pk2(acc[8 * i + 2] * rl, acc[8 * i + 3] * rl); o.z = pk2(acc[8 * i + 4] * rl, acc[8 * i + 5] * rl); o.w = pk2(acc[8 * i + 6] * rl, acc[8 * i + 7] * rl); *(v4u*)(po + 8 * i) = o; }
    }
}
__device__ __forceinline__ void phase_attn_naive(const Frame& F0, const bf16* Q, const bf16* Kb, const bf16* proj, const float* kmean, bf16* cat) {
    const Frame F = fresh(F0);
    for (int p = F.bid; p < 256; p += F.G) {
        const int bh = p >> 2, s = p & 3;
#pragma unroll 1
        for (int i = 0; i < 2; ++i) attn_naive_unit(F, bh >> 3, bh & 7, i ? s : 7 - s, Q, Kb, proj, kmean, cat);
    }
    __syncthreads();
}

typedef float f32x16 __attribute__((ext_vector_type(16)));
typedef short bf16x8 __attribute__((ext_vector_type(8)));
typedef short v4i16_t __attribute__((ext_vector_type(4)));
constexpr int AT_KROW = 144, AT_VROW = 192, AT_KBUF = 64 * AT_KROW, AT_VBUF = 64 * AT_VROW, AT_BUF = AT_KBUF + AT_VBUF;
constexpr int AT_WSF = 2 * AT_BUF, AT_STG = AT_WSF + 8 * 256, AT_LDS = AT_STG + 8 * 4096;
__device__ __forceinline__ int crow16(int r, int hi) { return (r & 3) + 8 * (r >> 2) + 4 * hi; }
__device__ __forceinline__ void attn_mfma_unit(const Frame& F, LAS unsigned char* L, int b, int h, int qb, const bf16* Q, const bf16* Kb, const bf16* proj, const float* kmean, bf16* cat) {
    const int lane = F.lane, r32 = lane & 31, hi = lane >> 5, wid = F.wave;
    const size_t row0 = (size_t)b * SEQ + qb * 256;
    const int qi = wid * 32 + r32;
    bf16x8 qf[4];
    { const bf16* pq = Q + (row0 + qi) * 512 + h * 64 + hi * 8;
#pragma unroll
        for (int d0 = 0; d0 < 4; ++d0) qf[d0] = *(const bf16x8*)(pq + d0 * 16); }
    unsigned selmask;
    if (qb <= 3) selmask = (1u << qb) - 1u;
    else {
        float gate[7];
#pragma unroll
        for (int j = 0; j < 7; ++j) { gate[j] = -3.0e38f;
            if (j < qb) { const float* km = kmean + (((size_t)b * 8 + h) * 8 + j) * 64 + hi * 8; float sacc = 0.f;
#pragma unroll
                for (int d0 = 0; d0 < 4; ++d0) { const f32x4 k0 = *(const f32x4*)(km + d0 * 16), k1 = *(const f32x4*)(km + d0 * 16 + 4);
                    sacc += bf2f((bf16)qf[d0][0]) * k0.x + bf2f((bf16)qf[d0][1]) * k0.y + bf2f((bf16)qf[d0][2]) * k0.z + bf2f((bf16)qf[d0][3]) * k0.w
                          + bf2f((bf16)qf[d0][4]) * k1.x + bf2f((bf16)qf[d0][5]) * k1.y + bf2f((bf16)qf[d0][6]) * k1.z + bf2f((bf16)qf[d0][7]) * k1.w; }
                sacc += __shfl_xor(sacc, 32);
                gate[j] = sacc; } }
        selmask = 0u;
#pragma unroll
        for (int r = 0; r < 3; ++r) { float best = -3.0e38f; int bi = 0;
#pragma unroll
            for (int j = 0; j < 7; ++j) { const bool ok = (j < qb) && !((selmask >> j) & 1u) && (gate[j] > best); if (ok) { best = gate[j]; bi = j; } }
            selmask |= 1u << bi; }
    }
    const int srow = F.tid >> 3, sch = F.tid & 7;
    const bf16* kg = Kb + ((size_t)b * SEQ + srow) * 512 + h * 64 + sch * 8;
    const bf16* vg = proj + ((size_t)b * SEQ + srow) * NCOL + C_AV + h * 64 + sch * 8;
    const int kst = srow * AT_KROW + sch * 16, vst = AT_KBUF + srow * AT_VROW + sch * 16;
    const int kfo = r32 * AT_KROW + hi * 16;
    const int g16 = lane >> 4, idx = lane & 15;
    const int vfo = AT_KBUF + (4 * (g16 >> 1) + (idx >> 2)) * AT_VROW + ((g16 & 1) * 16 + 4 * (idx & 3)) * 2;
    const int NT = 4 * (qb + 1);
    f32x16 o0 = {}, o1 = {};
    float lsum = 0.f;
    { const v4u kk = *(const v4u*)kg, vv = *(const v4u*)vg;
        *(LAS v4u*)(L + kst) = kk; *(LAS v4u*)(L + vst) = vv; }
    __syncthreads();
    for (int t = 0; t < NT; ++t) {
        const int cb = (t & 1) * AT_BUF, nb = AT_BUF - cb;
        v4u kk, vv;
        if (t + 1 < NT) { kk = *(const v4u*)(kg + (size_t)(t + 1) * 64 * 512); vv = *(const v4u*)(vg + (size_t)(t + 1) * 64 * NCOL); }
        const int j = t >> 2, kt = t & 3; const bool own = (j == qb);
        const bool active = !own || (kt * 64 <= wid * 32 + 31);
        if (active) {
            f32x16 s0 = {}, s1 = {};
            bf16x8 kf[8];
#pragma unroll
            for (int d0 = 0; d0 < 4; ++d0) { kf[d0] = *(const LAS bf16x8*)(L + cb + kfo + d0 * 32); kf[4 + d0] = *(const LAS bf16x8*)(L + cb + kfo + 32 * AT_KROW + d0 * 32); }
#pragma unroll
            for (int d0 = 0; d0 < 4; ++d0) {
                s0 = __builtin_amdgcn_mfma_f32_32x32x16_bf16(kf[d0], qf[d0], s0, 0, 0, 0);
                s1 = __builtin_amdgcn_mfma_f32_32x32x16_bf16(kf[4 + d0], qf[d0], s1, 0, 0, 0); }
            v4i16_t va[16];
#pragma unroll
            for (int sub = 0; sub < 2; ++sub)
#pragma unroll
                for (int sI = 0; sI < 2; ++sI) { const int vb = cb + vfo + (sub * 32 + 16 * sI) * AT_VROW, q4 = (sub * 2 + sI) * 4;
                    va[q4 + 0] = __builtin_amdgcn_ds_read_tr16_b64_v4i16((LAS v4i16_t*)(L + vb)); va[q4 + 1] = __builtin_amdgcn_ds_read_tr16_b64_v4i16((LAS v4i16_t*)(L + vb + 8 * AT_VROW));
                    va[q4 + 2] = __builtin_amdgcn_ds_read_tr16_b64_v4i16((LAS v4i16_t*)(L + vb + 64)); va[q4 + 3] = __builtin_amdgcn_ds_read_tr16_b64_v4i16((LAS v4i16_t*)(L + vb + 8 * AT_VROW + 64)); }
            __builtin_amdgcn_sched_barrier(0);
            const bool sel = own || (((selmask >> j) & 1u) != 0u);
            const int lim = sel ? (own ? (qi - kt * 64) : 1000) : -1;
            float ps = 0.f;
#pragma unroll
            for (int r = 0; r < 16; ++r) { const int kv = crow16(r, hi);
                const float p0 = (kv <= lim) ? __builtin_amdgcn_exp2f(s0[r]) : 0.f, p1 = (kv + 32 <= lim) ? __builtin_amdgcn_exp2f(s1[r]) : 0.f;
                s0[r] = p0; s1[r] = p1; ps += p0 + p1; }
            lsum += ps;
            bf16x8 pa[4];
#pragma unroll
            for (int sI = 0; sI < 2; ++sI) { v4u w0, w1;
                w0.x = pg8::cvt_pk_bf16(s0[8 * sI + 0], s0[8 * sI + 1]); w0.y = pg8::cvt_pk_bf16(s0[8 * sI + 2], s0[8 * sI + 3]); w0.z = pg8::cvt_pk_bf16(s0[8 * sI + 4], s0[8 * sI + 5]); w0.w = pg8::cvt_pk_bf16(s0[8 * sI + 6], s0[8 * sI + 7]);
                w1.x = pg8::cvt_pk_bf16(s1[8 * sI + 0], s1[8 * sI + 1]); w1.y = pg8::cvt_pk_bf16(s1[8 * sI + 2], s1[8 * sI + 3]); w1.z = pg8::cvt_pk_bf16(s1[8 * sI + 4], s1[8 * sI + 5]); w1.w = pg8::cvt_pk_bf16(s1[8 * sI + 6], s1[8 * sI + 7]);
                pa[sI] = __builtin_bit_cast(bf16x8, w0); pa[2 + sI] = __builtin_bit_cast(bf16x8, w1); }
#pragma unroll
            for (int q = 0; q < 4; ++q) {
                const bf16x8 v0 = (bf16x8){va[4 * q][0], va[4 * q][1], va[4 * q][2], va[4 * q][3], va[4 * q + 1][0], va[4 * q + 1][1], va[4 * q + 1][2], va[4 * q + 1][3]};
                const bf16x8 v1 = (bf16x8){va[4 * q + 2][0], va[4 * q + 2][1], va[4 * q + 2][2], va[4 * q + 2][3], va[4 * q + 3][0], va[4 * q + 3][1], va[4 * q + 3][2], va[4 * q + 3][3]};
                o0 = __builtin_amdgcn_mfma_f32_32x32x16_bf16(pa[q], v0, o0, 0, 0, 0);
                o1 = __builtin_amdgcn_mfma_f32_32x32x16_bf16(pa[q], v1, o1, 0, 0, 0); }
        }
        if (t + 1 < NT) { *(LAS v4u*)(L + nb + kst) = kk; *(LAS v4u*)(L + nb + vst) = vv; }
        __syncthreads();
    }
    lsum += __shfl_xor(lsum, 32);
    LAS float* wsf = (LAS float*)(L + AT_WSF + wid * 256);
    if (hi == 0) wsf[r32] = lsum;
    asm volatile("s_waitcnt lgkmcnt(0)" ::: "memory");
    LAS bf16* stg = (LAS bf16*)(L + AT_STG + wid * 4096);
#pragma unroll
    for (int r = 0; r < 16; ++r) { const int orow = crow16(r, hi); const float rl = 1.f / wsf[orow];
        stg[orow * 64 + r32] = (bf16)f2bf(o0[r] * rl); stg[orow * 64 + 32 + r32] = (bf16)f2bf(o1[r] * rl); }
    asm volatile("s_waitcnt lgkmcnt(0)" ::: "memory");
    bf16* po = cat + (row0 + wid * 32) * 1536 + h * 64;
#pragma unroll
    for (int i = 0; i < 4; ++i) { const int row = i * 8 + (lane >> 3), ch = lane & 7; const v4u v = *(const LAS v4u*)(stg + row * 64 + ch * 8); *(v4u*)(po + (size_t)row * 1536 + ch * 8) = v; }
    __syncthreads();
}
__device__ __forceinline__ void phase_attn_mfma(const Frame& F0, const bf16* Q, const bf16* Kb, const bf16* proj, const float* kmean, bf16* cat) {
    const Frame F = fresh(F0);
    LAS unsigned char* L = (LAS unsigned char*)F.lds;
    for (int p = F.bid; p < 256; p += F.G) {
        const int bh = p >> 2, s = p & 3;
#pragma unroll 1
        for (int i = 0; i < 2; ++i) attn_mfma_unit(F, L, bh >> 3, bh & 7, i ? s : 7 - s, Q, Kb, proj, kmean, cat);
    }
}

constexpr int HG_G = 0, HG_QD = 16384, HG_KD = HG_QD + 32 * 272, HG_KE = HG_KD + 32 * 272, HG_VT = HG_KE + 32 * 320, HG_SP = HG_VT + 32 * 320, HG_END = HG_SP + 128 * 320;
static_assert(HG_END <= LDS_SCRATCH, "hgrn lds");
template <bool PERM> __device__ __forceinline__ bf16x8 tr_frag(LAS unsigned char* tile, int pitch, int rbase, int cbase, int lane) {
    const int g16 = lane >> 4, idx = lane & 15, h = g16 >> 1;
    LAS unsigned char* p = tile + (rbase + (PERM ? 4 : 8) * h + (idx >> 2)) * pitch + (cbase + (g16 & 1) * 16 + 4 * (idx & 3)) * 2;
    const v4i16_t a0 = __builtin_amdgcn_ds_read_tr16_b64_v4i16((LAS v4i16_t*)p), a1 = __builtin_amdgcn_ds_read_tr16_b64_v4i16((LAS v4i16_t*)(p + (PERM ? 8 : 4) * pitch));
    return (bf16x8){a0[0], a0[1], a0[2], a0[3], a1[0], a1[1], a1[2], a1[3]};
}
template <bool FULL>
__device__ __forceinline__ void hgrn_unit(const Frame& F, LAS unsigned char* L, int u, const bf16* proj, const float* lbl, int layer, const float* gnorm, float* Lg, float* Dg, bf16* cat) {
    const int b = u >> 5, h = (u >> 3) & 3, blk = u & 7;
    const int lane = F.lane, r32 = lane & 31, hi = lane >> 5, wid = F.wave, tid = F.tid;
    const int tt = tid >> 4, cg = tid & 15, ch = cg * 8;
    LAS float* G = (LAS float*)(L + HG_G);
    float lbv[8], omlb[8], gn[8];
#pragma unroll
    for (int i = 0; i < 8; ++i) { float lb = 0.f;
        if (layer > 0) { const float l0 = lbl[h * 128 + ch + i], l1 = lbl[512 + h * 128 + ch + i]; lb = 1.f / (1.f + __expf(l0 - l1)); }
        lbv[i] = lb; omlb[i] = 1.f - lb; gn[i] = FULL ? gnorm[ch + i] : 0.f; }
    f32x16 S[2];
#pragma unroll
    for (int i = 0; i < 2; ++i) { S[i] = (f32x16){};
        if (FULL) { const int id = 2 * wid + i, kt = id >> 2, vt = id & 3;
            for (int pb = 0; pb < blk; ++pb) { const float* Lp = Lg + (size_t)(u - blk + pb) * 16384; const float* Dp = Dg + (size_t)(u - blk + pb) * 128;
#pragma unroll
                for (int r = 0; r < 16; ++r) { const int k = kt * 32 + crow16(r, hi); S[i][r] = Dp[k] * S[i][r] + Lp[k * 128 + vt * 32 + r32]; } } } }
    float dsum = 0.f;
    const size_t rowb = (size_t)b * SEQ + blk * 256;
    for (int c = 0; c < 8; ++c) {
        const size_t row = rowb + c * 32 + tt;
        const v4u fq = *(const v4u*)(proj + row * NCOL + C_HF + h * 128 + ch), vq = *(const v4u*)(proj + row * NCOL + C_HI + h * 128 + ch);
        v4u qq = {}, gq = {};
        if (FULL) { qq = *(const v4u*)(proj + row * NCOL + C_HQ + h * 128 + ch); gq = *(const v4u*)(proj + row * NCOL + C_HG + h * 128 + ch); }
        float kk[8], qa[8], gl[8];
        { const unsigned fw[4] = {fq.x, fq.y, fq.z, fq.w}, qw[4] = {qq.x, qq.y, qq.z, qq.w};
#pragma unroll
            for (int i = 0; i < 8; ++i) { const float fr = (i & 1) ? bfhi(fw[i >> 1]) : bflo(fw[i >> 1]); const float sig = sigmoidf_(fr);
                gl[i] = __logf(lbv[i] + omlb[i] * sig); kk[i] = omlb[i] * (1.f - sig);
                const float qv = (i & 1) ? bfhi(qw[i >> 1]) : bflo(qw[i >> 1]); qa[i] = qv * sigmoidf_(qv); } }
        *(LAS f32x4*)(G + tt * 128 + ch) = (f32x4){gl[0], gl[1], gl[2], gl[3]}; *(LAS f32x4*)(G + tt * 128 + ch + 4) = (f32x4){gl[4], gl[5], gl[6], gl[7]};
        *(LAS v4u*)(L + HG_VT + tt * 320 + ch * 2) = vq;
        __syncthreads();
        if (tid < 128) { float a[32];
#pragma unroll
            for (int t = 0; t < 32; ++t) a[t] = G[t * 128 + tid];
#pragma unroll
            for (int t = 1; t < 32; ++t) a[t] += a[t - 1];
#pragma unroll
            for (int t = 0; t < 32; ++t) G[t * 128 + tid] = a[t];
            dsum += a[31]; }
        __syncthreads();
        { const f32x4 b0 = *(const LAS f32x4*)(G + tt * 128 + ch), b1 = *(const LAS f32x4*)(G + tt * 128 + ch + 4);
            const f32x4 m0 = *(const LAS f32x4*)(G + 15 * 128 + ch), m1 = *(const LAS f32x4*)(G + 15 * 128 + ch + 4);
            const f32x4 e0 = *(const LAS f32x4*)(G + 31 * 128 + ch), e1 = *(const LAS f32x4*)(G + 31 * 128 + ch + 4);
            const float bb[8] = {b0.x, b0.y, b0.z, b0.w, b1.x, b1.y, b1.z, b1.w}, bm[8] = {m0.x, m0.y, m0.z, m0.w, m1.x, m1.y, m1.z, m1.w}, be[8] = {e0.x, e0.y, e0.z, e0.w, e1.x, e1.y, e1.z, e1.w};
            float ke[8], kd[8], qd[8];
#pragma unroll
            for (int i = 0; i < 8; ++i) { ke[i] = kk[i] * __expf(be[i] - bb[i]); if (FULL) { const float ex = __expf(bb[i] - bm[i]); qd[i] = qa[i] * ex; kd[i] = kk[i] * __expf(bm[i] - bb[i]); } }
            v4u w; w.x = pk2(ke[0], ke[1]); w.y = pk2(ke[2], ke[3]); w.z = pk2(ke[4], ke[5]); w.w = pk2(ke[6], ke[7]);
            *(LAS v4u*)(L + HG_KE + tt * 320 + ch * 2) = w;
            if (FULL) {
                w.x = pk2(qd[0], qd[1]); w.y = pk2(qd[2], qd[3]); w.z = pk2(qd[4], qd[5]); w.w = pk2(qd[6], qd[7]); *(LAS v4u*)(L + HG_QD + tt * 272 + ch * 2) = w;
                w.x = pk2(kd[0], kd[1]); w.y = pk2(kd[2], kd[3]); w.z = pk2(kd[4], kd[5]); w.w = pk2(kd[6], kd[7]); *(LAS v4u*)(L + HG_KD + tt * 272 + ch * 2) = w;
#pragma unroll
                for (int i = 0; i < 2; ++i) { const int id = 2 * wid + i, kt = id >> 2, vt = id & 3;
#pragma unroll
                    for (int r = 0; r < 16; ++r) { const int k = kt * 32 + crow16(r, hi); *(LAS bf16*)(L + HG_SP + k * 320 + (vt * 32 + r32) * 2) = (bf16)f2bf(S[i][r] * __expf(G[15 * 128 + k])); } }
            }
        }
        __syncthreads();
        f32x16 o = {};
        if (FULL && wid < 4) {
            f32x16 sc = {};
            bf16x8 qf[8];
#pragma unroll
            for (int k0 = 0; k0 < 8; ++k0) { qf[k0] = *(const LAS bf16x8*)(L + HG_QD + r32 * 272 + (k0 * 16 + 8 * hi) * 2);
                const bf16x8 kf = *(const LAS bf16x8*)(L + HG_KD + r32 * 272 + (k0 * 16 + 8 * hi) * 2);
                sc = __builtin_amdgcn_mfma_f32_32x32x16_bf16(kf, qf[k0], sc, 0, 0, 0); }
#pragma unroll
            for (int r = 0; r < 16; ++r) sc[r] = (crow16(r, hi) <= r32) ? sc[r] : 0.f;
#pragma unroll
            for (int k0 = 0; k0 < 8; ++k0) o = __builtin_amdgcn_mfma_f32_32x32x16_bf16(qf[k0], tr_frag<false>(L + HG_SP, 320, k0 * 16, wid * 32, lane), o, 0, 0, 0);
#pragma unroll
            for (int sI = 0; sI < 2; ++sI) { v4u w; w.x = pg8::cvt_pk_bf16(sc[8 * sI + 0], sc[8 * sI + 1]); w.y = pg8::cvt_pk_bf16(sc[8 * sI + 2], sc[8 * sI + 3]); w.z = pg8::cvt_pk_bf16(sc[8 * sI + 4], sc[8 * sI + 5]); w.w = pg8::cvt_pk_bf16(sc[8 * sI + 6], sc[8 * sI + 7]);
                o = __builtin_amdgcn_mfma_f32_32x32x16_bf16(__builtin_bit_cast(bf16x8, w), tr_frag<true>(L + HG_VT, 320, 16 * sI, wid * 32, lane), o, 0, 0, 0); }
        }
#pragma unroll
        for (int i = 0; i < 2; ++i) { const int id = 2 * wid + i, kt = id >> 2, vt = id & 3;
#pragma unroll
            for (int r = 0; r < 16; ++r) S[i][r] *= __expf(G[31 * 128 + kt * 32 + crow16(r, hi)]);
#pragma unroll
            for (int sI = 0; sI < 2; ++sI) S[i] = __builtin_amdgcn_mfma_f32_32x32x16_bf16(tr_frag<true>(L + HG_KE, 320, 16 * sI, kt * 32, lane), tr_frag<true>(L + HG_VT, 320, 16 * sI, vt * 32, lane), S[i], 0, 0, 0); }
        __syncthreads();
        if (FULL) {
            if (wid < 4) {
#pragma unroll
                for (int r = 0; r < 16; ++r) G[crow16(r, hi) * 128 + wid * 32 + r32] = o[r]; }
            __syncthreads();
            const f32x4 o0 = *(const LAS f32x4*)(G + tt * 128 + ch), o1 = *(const LAS f32x4*)(G + tt * 128 + ch + 4);
            float ss = (o0.x * o0.x + o0.y * o0.y) + (o0.z * o0.z + o0.w * o0.w) + (o1.x * o1.x + o1.y * o1.y) + (o1.z * o1.z + o1.w * o1.w);
            ss += __shfl_xor(ss, 1); ss += __shfl_xor(ss, 2); ss += __shfl_xor(ss, 4); ss += __shfl_xor(ss, 8);
            const float rn = rsqrtf(ss * (1.f / 128.f) + RMS_EPS);
            const float ov[8] = {o0.x, o0.y, o0.z, o0.w, o1.x, o1.y, o1.z, o1.w}; const unsigned gw[4] = {gq.x, gq.y, gq.z, gq.w};
            float y[8];
#pragma unroll
            for (int i = 0; i < 8; ++i) { const float gv = (i & 1) ? bfhi(gw[i >> 1]) : bflo(gw[i >> 1]); y[i] = ov[i] * rn * gn[i] * (gv * sigmoidf_(gv)); }
            v4u w; w.x = pk2(y[0], y[1]); w.y = pk2(y[2], y[3]); w.z = pk2(y[4], y[5]); w.w = pk2(y[6], y[7]);
            *(v4u*)(cat + row * 1536 + 512 + h * 128 + ch) = w;
            __syncthreads();
        }
    }
    if (!FULL) {
#pragma unroll
        for (int i = 0; i < 2; ++i) { const int id = 2 * wid + i, kt = id >> 2, vt = id & 3;
#pragma unroll
            for (int r = 0; r < 16; ++r) Lg[(size_t)u * 16384 + (kt * 32 + crow16(r, hi)) * 128 + vt * 32 + r32] = S[i][r]; }
        if (tid < 128) Dg[(size_t)u * 128 + tid] = __expf(dsum);
    }
}
template <bool FULL>
__device__ __forceinline__ void phase_hgrn(const Frame& F0, const bf16* proj, const float* lbl, int layer, const float* gnorm, float* Lg, float* Dg, bf16* cat) {
    const Frame F = fresh(F0);
    LAS unsigned char* L = (LAS unsigned char*)F.lds;
    for (int u = F.bid; u < 256; u += F.G) { hgrn_unit<FULL>(F, L, u, proj, lbl, layer, gnorm, Lg, Dg, cat); __syncthreads(); }
}

constexpr int H1_G = 0, H1_QD = 32768, H1_KD = H1_QD + 64 * 272, H1_KE = H1_KD + 64 * 272, H1_VT = H1_KE + 64 * 320, H1_SP = H1_VT + 64 * 320, H1_TOT = H1_SP + 128 * 320, H1_BO = H1_TOT + 2048, H1_LB = H1_BO + 512, H1_END = H1_LB + 512;
static_assert(H1_END <= LDS_SCRATCH, "hgrn pass 1 lds");
__device__ __forceinline__ void hgrn_pass1_unit(const Frame& F, LAS unsigned char* L, int u, const bf16* proj, const float* lbl, int layer, float* Lg, float* Dg, float* OL, bf16* Qb) {
    const int b = u >> 5, h = (u >> 3) & 3, blk = u & 7;
    const int lane = F.lane, r32 = lane & 31, hi = lane >> 5, wid = F.wave, tid = F.tid;
    const int tt = tid >> 3, cg = tid & 7, ch = cg * 16;
    LAS float* G = (LAS float*)(L + H1_G); LAS float* TOT = (LAS float*)(L + H1_TOT);
    LAS float* BO = (LAS float*)(L + H1_BO); LAS float* LB = (LAS float*)(L + H1_LB);
    if (tid < 128) { float lb = 0.f;
        if (layer > 0) { const float l0 = lbl[h * 128 + tid], l1 = lbl[512 + h * 128 + tid]; lb = 1.f / (1.f + __expf(l0 - l1)); }
        LB[tid] = lb; BO[tid] = 0.f; }
    __syncthreads();
    f32x16 S[2]; S[0] = (f32x16){}; S[1] = (f32x16){};
    const size_t rowb = (size_t)b * SEQ + blk * 256;
    const int tt2 = wid >> 2, vt = wid & 3;
    v4u nx[6];
    { const bf16* pr = proj + (rowb + tt) * NCOL + h * 128 + ch;
        nx[0] = *(const v4u*)(pr + C_HF); nx[1] = *(const v4u*)(pr + C_HF + 8); nx[2] = *(const v4u*)(pr + C_HQ); nx[3] = *(const v4u*)(pr + C_HQ + 8); nx[4] = *(const v4u*)(pr + C_HI); nx[5] = *(const v4u*)(pr + C_HI + 8); }
    for (int c = 0; c < 4; ++c) {
        const size_t row = rowb + c * 64 + tt;
        float kk[16], qa[16];
        {
            const v4u f0 = nx[0], f1 = nx[1], q0 = nx[2], q1 = nx[3], v0 = nx[4], v1 = nx[5];
            if (c < 3) { const bf16* pr = proj + (row + 64) * NCOL + h * 128 + ch;
                nx[0] = *(const v4u*)(pr + C_HF); nx[1] = *(const v4u*)(pr + C_HF + 8); nx[2] = *(const v4u*)(pr + C_HQ); nx[3] = *(const v4u*)(pr + C_HQ + 8); nx[4] = *(const v4u*)(pr + C_HI); nx[5] = *(const v4u*)(pr + C_HI + 8); }
            const unsigned fw[8] = {f0.x, f0.y, f0.z, f0.w, f1.x, f1.y, f1.z, f1.w}, qw[8] = {q0.x, q0.y, q0.z, q0.w, q1.x, q1.y, q1.z, q1.w};
            float gl[16], lbv[16];
#pragma unroll
            for (int i = 0; i < 4; ++i) { const f32x4 x = *(const LAS f32x4*)(LB + ch + 4 * i); lbv[4 * i] = x.x; lbv[4 * i + 1] = x.y; lbv[4 * i + 2] = x.z; lbv[4 * i + 3] = x.w; }
#pragma unroll
            for (int i = 0; i < 16; ++i) { const float fr = (i & 1) ? bfhi(fw[i >> 1]) : bflo(fw[i >> 1]); const float sig = sigmoidf_(fr);
                gl[i] = __logf(lbv[i] + (1.f - lbv[i]) * sig); kk[i] = (1.f - lbv[i]) * (1.f - sig);
                const float qv = (i & 1) ? bfhi(qw[i >> 1]) : bflo(qw[i >> 1]); qa[i] = qv * sigmoidf_(qv); }
#pragma unroll
            for (int i = 0; i < 4; ++i) *(LAS f32x4*)(G + tt * 128 + ch + 4 * i) = (f32x4){gl[4 * i], gl[4 * i + 1], gl[4 * i + 2], gl[4 * i + 3]};
            *(LAS v4u*)(L + H1_VT + tt * 320 + ch * 2) = v0; *(LAS v4u*)(L + H1_VT + tt * 320 + ch * 2 + 16) = v1;
        }
        __syncthreads();
        {
            const int k = tid & 127, part = tid >> 7; float a[16];
#pragma unroll
            for (int i = 0; i < 16; ++i) a[i] = G[(part * 16 + i) * 128 + k];
#pragma unroll
            for (int i = 1; i < 16; ++i) a[i] += a[i - 1];
            TOT[part * 128 + k] = a[15];
            __syncthreads();
            float pre = 0.f;
#pragma unroll
            for (int p = 0; p < 3; ++p) if (p < part) pre += TOT[p * 128 + k];
#pragma unroll
            for (int i = 0; i < 16; ++i) G[(part * 16 + i) * 128 + k] = a[i] + pre;
        }
        __syncthreads();
        {
#pragma unroll
            for (int hh = 0; hh < 2; ++hh) {
                float bb[8], bm[8], be[8], bo[8];
#pragma unroll
                for (int i = 0; i < 2; ++i) { const f32x4 x = *(const LAS f32x4*)(G + tt * 128 + ch + 8 * hh + 4 * i), y = *(const LAS f32x4*)(G + 31 * 128 + ch + 8 * hh + 4 * i), z = *(const LAS f32x4*)(G + 63 * 128 + ch + 8 * hh + 4 * i), o4 = *(const LAS f32x4*)(BO + ch + 8 * hh + 4 * i);
                    bb[4 * i] = x.x; bb[4 * i + 1] = x.y; bb[4 * i + 2] = x.z; bb[4 * i + 3] = x.w; bm[4 * i] = y.x; bm[4 * i + 1] = y.y; bm[4 * i + 2] = y.z; bm[4 * i + 3] = y.w; be[4 * i] = z.x; be[4 * i + 1] = z.y; be[4 * i + 2] = z.z; be[4 * i + 3] = z.w;
                    bo[4 * i] = o4.x; bo[4 * i + 1] = o4.y; bo[4 * i + 2] = o4.z; bo[4 * i + 3] = o4.w; }
                float t8[8]; v4u w;
#pragma unroll
                for (int i = 0; i < 8; ++i) t8[i] = kk[8 * hh + i] * __expf(be[i] - bb[i]);
                w.x = pk2(t8[0], t8[1]); w.y = pk2(t8[2], t8[3]); w.z = pk2(t8[4], t8[5]); w.w = pk2(t8[6], t8[7]); *(LAS v4u*)(L + H1_KE + tt * 320 + ch * 2 + 16 * hh) = w;
#pragma unroll
                for (int i = 0; i < 8; ++i) t8[i] = qa[8 * hh + i] * __expf(bb[i] - bm[i]);
                w.x = pk2(t8[0], t8[1]); w.y = pk2(t8[2], t8[3]); w.z = pk2(t8[4], t8[5]); w.w = pk2(t8[6], t8[7]); *(LAS v4u*)(L + H1_QD + tt * 272 + ch * 2 + 16 * hh) = w;
#pragma unroll
                for (int i = 0; i < 8; ++i) t8[i] = kk[8 * hh + i] * __expf(bm[i] - bb[i]);
                w.x = pk2(t8[0], t8[1]); w.y = pk2(t8[2], t8[3]); w.z = pk2(t8[4], t8[5]); w.w = pk2(t8[6], t8[7]); *(LAS v4u*)(L + H1_KD + tt * 272 + ch * 2 + 16 * hh) = w;
#pragma unroll
                for (int i = 0; i < 8; ++i) t8[i] = qa[8 * hh + i] * __expf(bo[i] + bb[i]);
                w.x = pk2(t8[0], t8[1]); w.y = pk2(t8[2], t8[3]); w.z = pk2(t8[4], t8[5]); w.w = pk2(t8[6], t8[7]); *(v4u*)(Qb + row * 512 + h * 128 + ch + 8 * hh) = w;
                __builtin_amdgcn_sched_barrier(0);
            }
#pragma unroll
            for (int i = 0; i < 2; ++i) { const int id = 2 * wid + i, kt = id >> 2, v2 = id & 3;
#pragma unroll
                for (int r = 0; r < 16; ++r) { const int k = kt * 32 + crow16(r, hi); *(LAS bf16*)(L + H1_SP + k * 320 + (v2 * 32 + r32) * 2) = (bf16)f2bf(S[i][r] * __expf(G[31 * 128 + k])); } }
        }
        __syncthreads();
        {
            if (tid < 128) BO[tid] += G[63 * 128 + tid];
            f32x16 o = {};
            bf16x8 qf[8];
#pragma unroll
            for (int k0 = 0; k0 < 8; ++k0) qf[k0] = *(const LAS bf16x8*)(L + H1_QD + (tt2 * 32 + r32) * 272 + (k0 * 16 + 8 * hi) * 2);
#pragma unroll
            for (int k0 = 0; k0 < 8; ++k0) o = __builtin_amdgcn_mfma_f32_32x32x16_bf16(qf[k0], tr_frag<false>(L + H1_SP, 320, k0 * 16, vt * 32, lane), o, 0, 0, 0);
#pragma unroll
            for (int sg = 0; sg < 2; ++sg) if (sg <= tt2) {
                f32x16 sc = {};
#pragma unroll
                for (int k0 = 0; k0 < 8; ++k0) { const bf16x8 kf = *(const LAS bf16x8*)(L + H1_KD + (sg * 32 + r32) * 272 + (k0 * 16 + 8 * hi) * 2); sc = __builtin_amdgcn_mfma_f32_32x32x16_bf16(kf, qf[k0], sc, 0, 0, 0); }
                if (sg == tt2) {
#pragma unroll
                    for (int r = 0; r < 16; ++r) sc[r] = (crow16(r, hi) <= r32) ? sc[r] : 0.f; }
#pragma unroll
                for (int sI = 0; sI < 2; ++sI) { v4u w; w.x = pg8::cvt_pk_bf16(sc[8 * sI + 0], sc[8 * sI + 1]); w.y = pg8::cvt_pk_bf16(sc[8 * sI + 2], sc[8 * sI + 3]); w.z = pg8::cvt_pk_bf16(sc[8 * sI + 4], sc[8 * sI + 5]); w.w = pg8::cvt_pk_bf16(sc[8 * sI + 6], sc[8 * sI + 7]);
                    o = __builtin_amdgcn_mfma_f32_32x32x16_bf16(__builtin_bit_cast(bf16x8, w), tr_frag<true>(L + H1_VT, 320, sg * 32 + 16 * sI, vt * 32, lane), o, 0, 0, 0); }
            }
            float* po = OL + (rowb + c * 64 + tt2 * 32) * 512 + h * 128 + vt * 32 + r32;
#pragma unroll
            for (int r = 0; r < 16; ++r) po[(size_t)crow16(r, hi) * 512] = o[r];
#pragma unroll
            for (int i = 0; i < 2; ++i) { const int id = 2 * wid + i, kt = id >> 2, v2 = id & 3;
#pragma unroll
                for (int r = 0; r < 16; ++r) S[i][r] *= __expf(G[63 * 128 + kt * 32 + crow16(r, hi)]);
#pragma unroll
                for (int s4 = 0; s4 < 4; ++s4) S[i] = __builtin_amdgcn_mfma_f32_32x32x16_bf16(tr_frag<true>(L + H1_KE, 320, 16 * s4, kt * 32, lane), tr_frag<true>(L + H1_VT, 320, 16 * s4, v2 * 32, lane), S[i], 0, 0, 0); }
        }
        __syncthreads();
    }
#pragma unroll
    for (int i = 0; i < 2; ++i) { const int id = 2 * wid + i, kt = id >> 2, v2 = id & 3;
#pragma unroll
        for (int r = 0; r < 16; ++r) Lg[(size_t)u * 16384 + (kt * 32 + crow16(r, hi)) * 128 + v2 * 32 + r32] = S[i][r]; }
    if (tid < 128) Dg[(size_t)u * 128 + tid] = __expf(BO[tid]);
}
constexpr int H2_SL = 0, H2_OB = 128 * 320, H2_END = H2_OB + 128 * 128 * 4;
__device__ __forceinline__ void hgrn_pass2_unit(const Frame& F, LAS unsigned char* L, int u, const bf16* proj, const float* gnorm, const float* Lg, const float* Dg, const float* OL, const bf16* Qb, bf16* cat, int dry) {
    const int b = u >> 5, h = (u >> 3) & 3, blk = u & 7;
    const int lane = F.lane, r32 = lane & 31, hi = lane >> 5, wid = F.wave, tid = F.tid;
    const size_t rowb = (size_t)b * SEQ + blk * 256;
    LAS float* OB = (LAS float*)(L + H2_OB);
    if (blk > 0 && dry != 1) {
#pragma unroll 1
        for (int jh = 0; jh < 4; ++jh) {
            f32x4 l4[7][2]; float dd[7][2];
#pragma unroll
            for (int pb = 0; pb < 7; ++pb)
#pragma unroll
                for (int j = 0; j < 2; ++j) { const int e4 = tid + 512 * (2 * jh + j), k = e4 >> 5;
                    if (pb < blk) { dd[pb][j] = *(const float*)((const char*)(Dg + (size_t)(u - blk + pb) * 128) + (unsigned)k * 4u); l4[pb][j] = *(const f32x4*)((const char*)(Lg + (size_t)(u - blk + pb) * 16384) + (unsigned)e4 * 16u); }
                    else { dd[pb][j] = 0.f; l4[pb][j] = (f32x4){0.f, 0.f, 0.f, 0.f}; } }
#pragma unroll
            for (int j = 0; j < 2; ++j) { const int e4 = tid + 512 * (2 * jh + j), k = e4 >> 5, v4 = (e4 & 31) * 4; f32x4 S = {0.f, 0.f, 0.f, 0.f};
#pragma unroll
                for (int pb = 0; pb < 7; ++pb) if (pb < blk) S = S * dd[pb][j] + l4[pb][j];
                v2u w; w.x = pk2(S.x, S.y); w.y = pk2(S.z, S.w); *(LAS v2u*)(L + H2_SL + k * 320 + v4 * 2) = w; } } }
    __syncthreads();
    const int ttp = tid >> 2, cq = tid & 3, vt = wid & 3;
    float gn[32];
#pragma unroll
    for (int i = 0; i < 8; ++i) { const f32x4 g = *(const f32x4*)(gnorm + cq * 32 + 4 * i); gn[4 * i] = g.x; gn[4 * i + 1] = g.y; gn[4 * i + 2] = g.z; gn[4 * i + 3] = g.w; }
    for (int hf = 0; hf < 2; ++hf) {
        const size_t rowp = rowb + hf * 128 + ttp;
        v4u hg[4];
#pragma unroll
        for (int i = 0; i < 4; ++i) hg[i] = *(const v4u*)(proj + rowp * NCOL + C_HG + h * 128 + cq * 32 + 8 * i);
#pragma unroll
        for (int j = 0; j < 2; ++j) { const int tl = (wid >> 2) + 2 * j;
            const size_t trow = rowb + hf * 128 + tl * 32;
            f32x16 o = {};
            if (blk > 0 && dry != 2) {
#pragma unroll
                for (int k0 = 0; k0 < 8; ++k0) { const bf16x8 a = *(const bf16x8*)(Qb + (trow + r32) * 512 + h * 128 + k0 * 16 + 8 * hi);
                    o = __builtin_amdgcn_mfma_f32_32x32x16_bf16(a, tr_frag<false>(L + H2_SL, 320, k0 * 16, vt * 32, lane), o, 0, 0, 0); } }
            const float* pl = OL + trow * 512 + h * 128 + vt * 32 + r32;
#pragma unroll
            for (int r = 0; r < 16; ++r) { const int t = crow16(r, hi); OB[(tl * 32 + t) * 128 + vt * 32 + r32] = o[r] + pl[(size_t)t * 512]; } }
        __syncthreads();
        {
            float ov[32]; float ss = 0.f;
#pragma unroll
            for (int i = 0; i < 8; ++i) { const f32x4 x = *(const LAS f32x4*)(OB + ttp * 128 + cq * 32 + 4 * i); ov[4 * i] = x.x; ov[4 * i + 1] = x.y; ov[4 * i + 2] = x.z; ov[4 * i + 3] = x.w; ss += (x.x * x.x + x.y * x.y) + (x.z * x.z + x.w * x.w); }
            ss += __shfl_xor(ss, 1); ss += __shfl_xor(ss, 2);
            const float rn = rsqrtf(ss * (1.f / 128.f) + RMS_EPS);
#pragma unroll
            for (int i = 0; i < 4; ++i) { const unsigned gw[4] = {hg[i].x, hg[i].y, hg[i].z, hg[i].w}; float y[8];
#pragma unroll
                for (int e = 0; e < 8; ++e) { const float gv = (e & 1) ? bfhi(gw[e >> 1]) : bflo(gw[e >> 1]); y[e] = ov[8 * i + e] * rn * gn[8 * i + e] * (gv * sigmoidf_(gv)); }
                v4u w; w.x = pk2(y[0], y[1]); w.y = pk2(y[2], y[3]); w.z = pk2(y[4], y[5]); w.w = pk2(y[6], y[7]);
                *(v4u*)(cat + rowp * 1536 + 512 + h * 128 + cq * 32 + 8 * i) = w; }
        }
        __syncthreads();
    }
}
__device__ __forceinline__ void phase_hgrn1(const Frame& F0, const bf16* proj, const float* lbl, int layer, float* Lg, float* Dg, float* OL, bf16* Qb) {
    const Frame F = fresh(F0);
    LAS unsigned char* L = (LAS unsigned char*)F.lds;
    for (int u = F.bid; u < 256; u += F.G) { hgrn_pass1_unit(F, L, u, proj, lbl, layer, Lg, Dg, OL, Qb); __syncthreads(); }
}
__device__ __forceinline__ void phase_hgrn2(const Frame& F0, const bf16* proj, const float* gnorm, const float* Lg, const float* Dg, const float* OL, const bf16* Qb, bf16* cat, int dry) {
    const Frame F = fresh(F0);
    LAS unsigned char* L = (LAS unsigned char*)F.lds;
    for (int u = F.bid; u < 256; u += F.G) { hgrn_pass2_unit(F, L, u, proj, gnorm, Lg, Dg, OL, Qb, cat, dry); __syncthreads(); }
}

struct SchedDense {
    const char* A; const char* B; int nM, nN, G, c; size_t ta, tb;
    __device__ __forceinline__ bool next(int i, pg8::Unit& u) const {
        int pm, pn; if (!pg8::static_tile(nM, nN, (long)i * G + c, pm, pn)) return false;
        u.pm = pm; u.pn = pn; u.aux = 0; u.pad = 0; u.a = A + (size_t)pm * ta; u.b = B + (size_t)pn * tb; return true; }
};
struct SchedBranch {
    const char* A; const char* B; int G, c;
    __device__ __forceinline__ bool next(int i, pg8::Unit& u) const {
        int pm, pn; if (!pg8::static_tile(T / 256, DM / 256, (long)(i / 3) * G + c, pm, pn)) return false;
        const int seg = i % 3;
        u.pm = pm; u.pn = pn; u.aux = seg; u.pad = 0; u.a = A + ((size_t)pm * 256 * 1536 + seg * 512) * 2; u.b = B + ((size_t)seg * DM * 512 + (size_t)pn * 256 * 512) * 2; return true; }
};
struct SchedMoe {
    const char* A; const char* B; const unsigned* ntp; const unsigned* tile_e; int G, c; size_t ta, tb_e, tb_n;
    __device__ __forceinline__ bool next(int i, pg8::Unit& u) const {
        const int nt = (int)__builtin_amdgcn_readfirstlane(*ntp);
        const long L = (long)i * G + c; if (L >= (long)nt * 4) return false;
        const int tile = (int)(L >> 2), pn = (int)(L & 3); const int e = (int)__builtin_amdgcn_readfirstlane(tile_e[tile]);
        u.pm = tile; u.pn = pn; u.aux = e; u.pad = 0; u.a = A + (size_t)tile * ta; u.b = B + (size_t)e * tb_e + (size_t)pn * tb_n; return true; }
};

typedef pg8::f32x4 af4;
struct EpiStoreBf16 {
    static constexpr bool PERM = true;
    bf16* O; int ldc;
    __device__ __forceinline__ bool operator()(af4 (&acc)[2][2][4][2], const pg8::Unit& u, int wr, int wc, int fr, int fq) const {
        const int row0 = u.pm * 256 + wr * 64 + fr, col0 = u.pn * 256 + wc * 32 + 8 * fq;
#pragma unroll
        for (int ai = 0; ai < 2; ++ai)
#pragma unroll
            for (int m = 0; m < 4; ++m) { bf16* rowp = O + (size_t)(row0 + ai * 128 + m * 16) * ldc + col0;
#pragma unroll
                for (int bj = 0; bj < 2; ++bj) { const af4 v0 = acc[ai][bj][m][0], v1 = acc[ai][bj][m][1]; v4u w;
                    w.x = pg8::cvt_pk_bf16(v0[0], v0[1]); w.y = pg8::cvt_pk_bf16(v0[2], v0[3]); w.z = pg8::cvt_pk_bf16(v1[0], v1[1]); w.w = pg8::cvt_pk_bf16(v1[2], v1[3]);
                    *(v4u*)(rowp + bj * 128) = w; } }
        return true;
    }
};
struct EpiBranch {
    static constexpr bool PERM = true;
    const bf16* proj; const float* bgate; bf16* merged;
    __device__ __forceinline__ bool operator()(af4 (&acc)[2][2][4][2], const pg8::Unit& u, int wr, int wc, int fr, int fq) const {
        const int seg = u.aux, row0 = u.pm * 256 + wr * 64 + fr, col0 = u.pn * 256 + wc * 32 + 8 * fq;
        const bool last = (seg == 2); const int sn = last ? seg : seg + 1;
#pragma unroll
        for (int bj = 0; bj < 2; ++bj) { const int col = col0 + bj * 128;
            const af4 bc0 = *(const af4*)(bgate + seg * DM + col), bc1 = *(const af4*)(bgate + seg * DM + col + 4);
            const af4 bn0 = *(const af4*)(bgate + sn * DM + col), bn1 = *(const af4*)(bgate + sn * DM + col + 4);
            const float bcur[8] = {bc0[0], bc0[1], bc0[2], bc0[3], bc1[0], bc1[1], bc1[2], bc1[3]}, bnxt[8] = {bn0[0], bn0[1], bn0[2], bn0[3], bn1[0], bn1[1], bn1[2], bn1[3]};
#pragma unroll
            for (int ai = 0; ai < 2; ++ai)
#pragma unroll
                for (int m = 0; m < 4; ++m) { const size_t row = (size_t)(row0 + ai * 128 + m * 16);
                    const v4u gc = *(const v4u*)(proj + row * NCOL + C_GL + seg * DM + col), gn = *(const v4u*)(proj + row * NCOL + C_GL + sn * DM + col);
                    const unsigned gcw[4] = {gc.x, gc.y, gc.z, gc.w}, gnw[4] = {gn.x, gn.y, gn.z, gn.w};
                    float f[8];
#pragma unroll
                    for (int i = 0; i < 8; ++i) { const float ac = fminf(fmaxf(((i & 1) ? bfhi(gcw[i >> 1]) : bflo(gcw[i >> 1])) + bcur[i], -30.f), 30.f), an = fminf(fmaxf(((i & 1) ? bfhi(gnw[i >> 1]) : bflo(gnw[i >> 1])) + bnxt[i], -30.f), 30.f);
                        const float ec = __expf(-ac), en = __expf(-an); f[i] = (last ? 1.f : (1.f + en)) / (1.f + ec); }
                    af4& v0 = acc[ai][bj][m][0]; af4& v1 = acc[ai][bj][m][1];
                    v0[0] *= f[0]; v0[1] *= f[1]; v0[2] *= f[2]; v0[3] *= f[3]; v1[0] *= f[4]; v1[1] *= f[5]; v1[2] *= f[6]; v1[3] *= f[7];
                    if (last) { v4u w; w.x = pg8::cvt_pk_bf16(v0[0], v0[1]); w.y = pg8::cvt_pk_bf16(v0[2], v0[3]); w.z = pg8::cvt_pk_bf16(v1[0], v1[1]); w.w = pg8::cvt_pk_bf16(v1[2], v1[3]);
                        *(v4u*)(merged + row * DM + col) = w; } } }
        return last;
    }
};
struct EpiResidual {
    static constexpr bool PERM = false;
    const float* xin; float* xout;
    __device__ __forceinline__ bool operator()(af4 (&acc)[2][2][4][2], const pg8::Unit& u, int wr, int wc, int fr, int fq) const {
        const int row0 = u.pm * 256 + wr * 64 + fr, col0 = u.pn * 256 + wc * 32 + 4 * fq;
#pragma unroll
        for (int ai = 0; ai < 2; ++ai)
#pragma unroll
            for (int m = 0; m < 4; ++m) { const size_t off = (size_t)(row0 + ai * 128 + m * 16) * DM + col0;
#pragma unroll
                for (int bj = 0; bj < 2; ++bj)
#pragma unroll
                    for (int n = 0; n < 2; ++n) { const af4 r = *(const af4*)(xin + off + bj * 128 + n * 16); *(af4*)(xout + off + bj * 128 + n * 16) = r + acc[ai][bj][m][n]; } }
        return true;
    }
};
struct EpiSwiglu {
    static constexpr bool PERM = true;
    bf16* act; const float* rrow;
    __device__ __forceinline__ bool operator()(af4 (&acc)[2][2][4][2], const pg8::Unit& u, int wr, int wc, int fr, int fq) const {
        const int row0 = u.pm * 256 + wr * 64 + fr, col0 = u.pn * 128 + wc * 32 + 8 * fq;
#pragma unroll
        for (int ai = 0; ai < 2; ++ai)
#pragma unroll
            for (int m = 0; m < 4; ++m) { const float rr = rrow[row0 + ai * 128 + m * 16]; const af4 g0 = acc[ai][0][m][0] * rr, g1 = acc[ai][0][m][1] * rr, u0 = acc[ai][1][m][0] * rr, u1 = acc[ai][1][m][1] * rr;
                float o[8];
#pragma unroll
                for (int i = 0; i < 4; ++i) { o[i] = g0[i] * sigmoidf_(g0[i]) * u0[i]; o[4 + i] = g1[i] * sigmoidf_(g1[i]) * u1[i]; }
                v4u w; w.x = pg8::cvt_pk_bf16(o[0], o[1]); w.y = pg8::cvt_pk_bf16(o[2], o[3]); w.z = pg8::cvt_pk_bf16(o[4], o[5]); w.w = pg8::cvt_pk_bf16(o[6], o[7]);
                *(v4u*)(act + (size_t)(row0 + ai * 128 + m * 16) * FF + col0) = w; }
        return true;
    }
};
struct EpiScaleRows {
    static constexpr bool PERM = true;
    bf16* ys; const float* wrow;
    __device__ __forceinline__ bool operator()(af4 (&acc)[2][2][4][2], const pg8::Unit& u, int wr, int wc, int fr, int fq) const {
        const int row0 = u.pm * 256 + wr * 64 + fr, col0 = u.pn * 256 + wc * 32 + 8 * fq;
#pragma unroll
        for (int ai = 0; ai < 2; ++ai)
#pragma unroll
            for (int m = 0; m < 4; ++m) { const int row = row0 + ai * 128 + m * 16; const float s = wrow[row]; bf16* rowp = ys + (size_t)row * DM + col0;
#pragma unroll
                for (int bj = 0; bj < 2; ++bj) { const af4 v0 = acc[ai][bj][m][0] * s, v1 = acc[ai][bj][m][1] * s; v4u w;
                    w.x = pg8::cvt_pk_bf16(v0[0], v0[1]); w.y = pg8::cvt_pk_bf16(v0[2], v0[3]); w.z = pg8::cvt_pk_bf16(v1[0], v1[1]); w.w = pg8::cvt_pk_bf16(v1[2], v1[3]);
                    *(v4u*)(rowp + bj * 128) = w; } }
        return true;
    }
};

constexpr int RW_PITCH = 1028;
__device__ __forceinline__ void phase_router(const Frame& F0, const float* x, const float* gain, const float* wco, const float* bco, const float* wfi, const float* bfi,
                                             bf16* hout, unsigned* route, unsigned* cnt, bool commit) {
    const Frame F = fresh(F0);
    float* WT = (float*)F.lds;
    { f32x4 wv[18];
#pragma unroll
        for (int i = 0; i < 2; ++i) wv[i] = *(const f32x4*)(wco + 4 * (F.tid + 512 * i));
#pragma unroll
        for (int i = 0; i < 16; ++i) wv[2 + i] = *(const f32x4*)(wfi + 4 * (F.tid + 512 * i));
#pragma unroll
        for (int i = 0; i < 2; ++i) { const int k = F.tid + 512 * i; WT[0 * RW_PITCH + k] = wv[i].x; WT[1 * RW_PITCH + k] = wv[i].y; WT[2 * RW_PITCH + k] = wv[i].z; WT[3 * RW_PITCH + k] = wv[i].w; }
#pragma unroll
        for (int i = 0; i < 16; ++i) { const int f = F.tid + 512 * i, k = f >> 3, e = (f & 7) * 4;
            WT[(4 + e) * RW_PITCH + k] = wv[2 + i].x; WT[(5 + e) * RW_PITCH + k] = wv[2 + i].y; WT[(6 + e) * RW_PITCH + k] = wv[2 + i].z; WT[(7 + e) * RW_PITCH + k] = wv[2 + i].w; } }
    __syncthreads();
    const int gw = F.bid * 8 + F.wave, NGW = F.G * 8;
    f32x4 g[4];
#pragma unroll
    for (int j = 0; j < 4; ++j) g[j] = *(const f32x4*)(gain + 4 * F.lane + 256 * j);
    f32x4 nv[2][4];
#pragma unroll
    for (int q = 0; q < 2; ++q) { const int m = gw + q * NGW; if (m < T) { const f32x4* xr = (const f32x4*)(x + (size_t)m * DM) + F.lane;
#pragma unroll
            for (int j = 0; j < 4; ++j) nv[q][j] = xr[64 * j]; } }
    for (int m0 = gw; m0 < T; m0 += 2 * NGW) {
        f32x4 v[2][4];
#pragma unroll
        for (int q = 0; q < 2; ++q)
#pragma unroll
            for (int j = 0; j < 4; ++j) v[q][j] = nv[q][j];
#pragma unroll
        for (int q = 0; q < 2; ++q) { const int m = m0 + 2 * NGW + q * NGW; if (m < T) { const f32x4* xr = (const f32x4*)(x + (size_t)m * DM) + F.lane;
#pragma unroll
                for (int j = 0; j < 4; ++j) nv[q][j] = xr[64 * j]; } }
#pragma unroll
        for (int q = 0; q < 2; ++q) { const int m = m0 + q * NGW; float s = 0.f;
#pragma unroll
            for (int j = 0; j < 4; ++j) s += (v[q][j].x * v[q][j].x + v[q][j].y * v[q][j].y) + (v[q][j].z * v[q][j].z + v[q][j].w * v[q][j].w);
            const float r = rsqrtf(wave_sum(s) * (1.f / DM) + RMS_EPS);
#pragma unroll
            for (int j = 0; j < 4; ++j) v[q][j] = v[q][j] * r * g[j];
            if (m < T) { v2u* o8 = (v2u*)(hout + (size_t)m * DM) + F.lane;
#pragma unroll
                for (int j = 0; j < 4; ++j) { v2u w; w.x = pk2(v[q][j].x, v[q][j].y); w.y = pk2(v[q][j].z, v[q][j].w); o8[64 * j] = w; } } }
        float lg[2][36];
#pragma unroll
        for (int c = 0; c < 36; ++c) { float pa = 0.f, pb = 0.f;
#pragma unroll
            for (int j = 0; j < 4; ++j) { const f32x4 w = *(const f32x4*)(WT + c * RW_PITCH + 4 * F.lane + 256 * j);
                pa += (v[0][j].x * w.x + v[0][j].y * w.y) + (v[0][j].z * w.z + v[0][j].w * w.w); pb += (v[1][j].x * w.x + v[1][j].y * w.y) + (v[1][j].z * w.z + v[1][j].w * w.w); }
            lg[0][c] = pa; lg[1][c] = pb; if ((c & 3) == 3) __builtin_amdgcn_sched_barrier(0); }
#pragma unroll
        for (int c = 0; c < 36; ++c) { lg[0][c] = wave_sum(lg[0][c]); lg[1][c] = wave_sum(lg[1][c]); }
#pragma unroll
        for (int q = 0; q < 2; ++q) { const int m = m0 + q * NGW;
            float c0 = lg[q][0] + bco[0], c1 = lg[q][1] + bco[1], c2 = lg[q][2] + bco[2], c3 = lg[q][3] + bco[3];
            int grp = 0; float cm = c0;
            if (c1 > cm) { cm = c1; grp = 1; } if (c2 > cm) { cm = c2; grp = 2; } if (c3 > cm) { cm = c3; grp = 3; }
            const float ptop = 1.f / (__expf(c0 - cm) + __expf(c1 - cm) + __expf(c2 - cm) + __expf(c3 - cm));
            float fs[8];
#pragma unroll
            for (int i = 0; i < 8; ++i) { float a = lg[q][4 + i] + bfi[i], b = lg[q][12 + i] + bfi[8 + i], c = lg[q][20 + i] + bfi[16 + i], d = lg[q][28 + i] + bfi[24 + i]; fs[i] = grp == 0 ? a : (grp == 1 ? b : (grp == 2 ? c : d)); }
            int i1 = 0; float v1 = fs[0];
#pragma unroll
            for (int i = 1; i < 8; ++i) if (fs[i] > v1) { v1 = fs[i]; i1 = i; }
            int i2 = -1; float v2 = -3.0e38f;
#pragma unroll
            for (int i = 0; i < 8; ++i) if (i != i1 && fs[i] > v2) { v2 = fs[i]; i2 = i; }
            const float e2 = __expf(v2 - v1), w1 = ptop / (1.f + e2), w2 = ptop * e2 / (1.f + e2);
            if (F.lane == 0 && commit && m < T) {
                const int ea = grp * 8 + i1, eb = grp * 8 + i2;
                const unsigned ra = __hip_atomic_fetch_add(cnt + 64 * ea, 1u, RLX_AGENT), rb = __hip_atomic_fetch_add(cnt + 64 * eb, 1u, RLX_AGENT);
                v4u o; o.x = (unsigned)ea; o.y = (unsigned)eb; o.z = ra; o.w = rb; *(v4u*)(route + (size_t)m * 8) = o;
                *(f32x2*)(route + (size_t)m * 8 + 4) = (f32x2){w1, w2};
            }
        }
    }
    __syncthreads();
}

constexpr int RT_PITCH = 2064, RT_HI = 0, RT_LO = 36 * RT_PITCH, RT_END = 72 * RT_PITCH;
static_assert(RT_END <= LDS_SCRATCH, "router lds");
__device__ __forceinline__ void phase_router2(const Frame& F0, const float* x, const float* gain, const float* wco, const float* bco, const float* wfi, const float* bfi,
                                              bf16* hout, unsigned* route, unsigned* cnt, float* LG, bool commit) {
    const Frame F = fresh(F0);
    LAS unsigned char* L = (LAS unsigned char*)F.lds;
    {
        f32x4 wv[18];
#pragma unroll
        for (int i = 0; i < 2; ++i) wv[i] = *(const f32x4*)(wco + 4 * (F.tid + 512 * i));
#pragma unroll
        for (int i = 0; i < 16; ++i) wv[2 + i] = *(const f32x4*)(wfi + 4 * (F.tid + 512 * i));
#pragma unroll
        for (int i = 0; i < 18; ++i) { int k, c0; if (i < 2) { k = F.tid + 512 * i; c0 = 32; } else { const int f = F.tid + 512 * (i - 2); k = f >> 3; c0 = (f & 7) * 4; }
            const float w4[4] = {wv[i].x, wv[i].y, wv[i].z, wv[i].w};
#pragma unroll
            for (int e = 0; e < 4; ++e) { const unsigned hi = f2bf(w4[e]); const unsigned lo = f2bf(w4[e] - __uint_as_float(hi << 16));
                *(LAS bf16*)(L + RT_HI + (c0 + e) * RT_PITCH + k * 2) = (bf16)hi; *(LAS bf16*)(L + RT_LO + (c0 + e) * RT_PITCH + k * 2) = (bf16)lo; } }
    }
    __syncthreads();
    if (F.wave < 4) {
        const int lane = F.lane, rl = lane & 15, kg = lane >> 4;
        for (int tile = F.wave * F.G + F.bid; tile < T / 16; tile += 4 * F.G) {
            const size_t row = (size_t)tile * 16 + rl;
            const float* xr = x + row * DM + 8 * kg;
            pg8::f32x4 acc[3]; acc[0] = (pg8::f32x4){0.f, 0.f, 0.f, 0.f}; acc[1] = acc[0]; acc[2] = acc[0];
            float ss = 0.f;
            const int bro[3] = {rl * RT_PITCH + 16 * kg, (16 + rl) * RT_PITCH + 16 * kg, (32 + (rl & 3)) * RT_PITCH + 16 * kg};
            f32x4 xa[8];
#pragma unroll
            for (int q = 0; q < 4; ++q) { xa[2 * q] = *(const f32x4*)(xr + 32 * q); xa[2 * q + 1] = *(const f32x4*)(xr + 32 * q + 4); }
            for (int s0 = 0; s0 < 32; s0 += 4) {
                f32x4 xn[8];
                if (s0 + 4 < 32) {
#pragma unroll
                    for (int q = 0; q < 4; ++q) { xn[2 * q] = *(const f32x4*)(xr + 32 * (s0 + 4 + q)); xn[2 * q + 1] = *(const f32x4*)(xr + 32 * (s0 + 4 + q) + 4); } }
#pragma unroll
                for (int q = 0; q < 4; ++q) { const int s = s0 + q;
                    const f32x4 g0 = *(const f32x4*)(gain + 32 * s + 8 * kg), g1 = *(const f32x4*)(gain + 32 * s + 8 * kg + 4);
                    const f32x4 x0 = xa[2 * q], x1 = xa[2 * q + 1];
                    ss += (x0.x * x0.x + x0.y * x0.y) + (x0.z * x0.z + x0.w * x0.w) + (x1.x * x1.x + x1.y * x1.y) + (x1.z * x1.z + x1.w * x1.w);
                    const float y[8] = {x0.x * g0.x, x0.y * g0.y, x0.z * g0.z, x0.w * g0.w, x1.x * g1.x, x1.y * g1.y, x1.z * g1.z, x1.w * g1.w};
                    unsigned hb[8], lb[8];
#pragma unroll
                    for (int e = 0; e < 8; ++e) { hb[e] = f2bf(y[e]); lb[e] = f2bf(y[e] - __uint_as_float(hb[e] << 16)); }
                    v4u ah, al; ah.x = hb[0] | (hb[1] << 16); ah.y = hb[2] | (hb[3] << 16); ah.z = hb[4] | (hb[5] << 16); ah.w = hb[6] | (hb[7] << 16);
                    al.x = lb[0] | (lb[1] << 16); al.y = lb[2] | (lb[3] << 16); al.z = lb[4] | (lb[5] << 16); al.w = lb[6] | (lb[7] << 16);
                    *(v4u*)(hout + row * DM + 32 * s + 8 * kg) = ah;
                    const bf16x8 Ah = __builtin_bit_cast(bf16x8, ah), Al = __builtin_bit_cast(bf16x8, al);
#pragma unroll
                    for (int ct = 0; ct < 3; ++ct) { const bf16x8 Bh = *(const LAS bf16x8*)(L + RT_HI + bro[ct] + 64 * s), Bl = *(const LAS bf16x8*)(L + RT_LO + bro[ct] + 64 * s);
                        acc[ct] = __builtin_amdgcn_mfma_f32_16x16x32_bf16(Ah, Bh, acc[ct], 0, 0, 0);
                        acc[ct] = __builtin_amdgcn_mfma_f32_16x16x32_bf16(Ah, Bl, acc[ct], 0, 0, 0);
                        acc[ct] = __builtin_amdgcn_mfma_f32_16x16x32_bf16(Al, Bh, acc[ct], 0, 0, 0); } }
#pragma unroll
                for (int q = 0; q < 8; ++q) xa[q] = xn[q];
            }
            ss += __shfl_xor(ss, 16); ss += __shfl_xor(ss, 32);
            const float r = rsqrtf(ss * (1.f / DM) + RMS_EPS);
#pragma unroll
            for (int ct = 0; ct < 3; ++ct)
#pragma unroll
                for (int rg = 0; rg < 4; ++rg) LG[((size_t)tile * 16 + 4 * kg + rg) * 48 + ct * 16 + rl] = acc[ct][rg];
            asm volatile("s_waitcnt vmcnt(0)" ::: "memory");
            if (lane < 16) {
                const size_t m = (size_t)tile * 16 + lane;
                float lg[36];
#pragma unroll
                for (int c = 0; c < 36; ++c) lg[c] = r * __uint_as_float(__hip_atomic_load((const unsigned*)(LG + m * 48 + c), RLX_AGENT));
                float c0 = lg[32] + bco[0], c1 = lg[33] + bco[1], c2 = lg[34] + bco[2], c3 = lg[35] + bco[3];
                int grp = 0; float cm = c0;
                if (c1 > cm) { cm = c1; grp = 1; } if (c2 > cm) { cm = c2; grp = 2; } if (c3 > cm) { cm = c3; grp = 3; }
                const float ptop = 1.f / (__expf(c0 - cm) + __expf(c1 - cm) + __expf(c2 - cm) + __expf(c3 - cm));
                float fs[8];
#pragma unroll
                for (int i = 0; i < 8; ++i) { float a = lg[i] + bfi[i], b = lg[8 + i] + bfi[8 + i], c = lg[16 + i] + bfi[16 + i], d = lg[24 + i] + bfi[24 + i]; fs[i] = grp == 0 ? a : (grp == 1 ? b : (grp == 2 ? c : d)); }
                int i1 = 0; float v1 = fs[0];
#pragma unroll
                for (int i = 1; i < 8; ++i) if (fs[i] > v1) { v1 = fs[i]; i1 = i; }
                int i2 = -1; float v2 = -3.0e38f;
#pragma unroll
                for (int i = 0; i < 8; ++i) if (i != i1 && fs[i] > v2) { v2 = fs[i]; i2 = i; }
                const float e2 = __expf(v2 - v1), w1 = ptop / (1.f + e2), w2 = ptop * e2 / (1.f + e2);
                if (commit) {
                    const int ea = grp * 8 + i1, eb = grp * 8 + i2;
                    const unsigned ra = __hip_atomic_fetch_add(cnt + 64 * ea, 1u, RLX_AGENT), rb = __hip_atomic_fetch_add(cnt + 64 * eb, 1u, RLX_AGENT);
                    v4u o; o.x = (unsigned)ea; o.y = (unsigned)eb; o.z = ra; o.w = rb; *(v4u*)(route + m * 8) = o;
                    *(f32x4*)(route + m * 8 + 4) = (f32x4){w1, w2, r, 0.f};
                }
            }
        }
    }
    __syncthreads();
}

__device__ __forceinline__ void phase_scatter(const Frame& F0, const bf16* hin, const unsigned* route, const unsigned* cnt, unsigned* ntp, unsigned* tile_e, bf16* hs, float* wrow, float* rrow, unsigned* pos) {
    const Frame F = fresh(F0);
    unsigned* off = (unsigned*)F.lds;
    if (F.tid == 0) { unsigned o = 0;
        for (int e = 0; e < NEXP; ++e) { off[e] = o; const unsigned c = __hip_atomic_load(cnt + 64 * e, RLX_AGENT); const unsigned p = (c + 255u) & ~255u;
            if (F.bid == 0) for (unsigned tI = o >> 8; tI < ((o + p) >> 8); ++tI) tile_e[tI] = (unsigned)e;
            o += p; }
        off[NEXP] = o; if (F.bid == 0) *ntp = o >> 8; }
    __syncthreads();
    const int gw = F.bid * 8 + F.wave, NGW = F.G * 8;
    for (int m0 = gw; m0 < T; m0 += 4 * NGW) {
        v4u ri[4], a[4], b[4]; f32x4 ww[4];
#pragma unroll
        for (int q = 0; q < 4; ++q) { const int m = m0 + q * NGW; if (m < T) { ri[q] = *(const v4u*)(route + (size_t)m * 8); ww[q] = *(const f32x4*)(route + (size_t)m * 8 + 4);
                const v4u* src = (const v4u*)(hin + (size_t)m * DM) + F.lane; a[q] = src[0]; b[q] = src[64]; } }
#pragma unroll
        for (int q = 0; q < 4; ++q) { const int m = m0 + q * NGW; if (m < T) {
                const unsigned d0 = off[ri[q].x] + ri[q].z, d1 = off[ri[q].y] + ri[q].w;
                v4u* p0 = (v4u*)(hs + (size_t)d0 * DM) + F.lane; v4u* p1 = (v4u*)(hs + (size_t)d1 * DM) + F.lane;
                p0[0] = a[q]; p0[64] = b[q]; p1[0] = a[q]; p1[64] = b[q];
                if (F.lane == 0) { wrow[d0] = ww[q].x; wrow[d1] = ww[q].y; rrow[d0] = ww[q].z; rrow[d1] = ww[q].z; *(v2u*)(pos + (size_t)m * 2) = (v2u){d0, d1}; } } }
    }
    __syncthreads();
}

__device__ __forceinline__ void phase_combine(const Frame& F0, float* x, float* xdst, const bf16* ys, const unsigned* pos, const float* ngain, bf16* hout) {
    const Frame F = fresh(F0);
    const int gw = F.bid * 8 + F.wave, NGW = F.G * 8;
    f32x4 g[4];
#pragma unroll
    for (int j = 0; j < 4; ++j) g[j] = ngain ? *(const f32x4*)(ngain + 4 * F.lane + 256 * j) : (f32x4){0.f, 0.f, 0.f, 0.f};
    for (int m0 = gw; m0 < T; m0 += 2 * NGW) {
        v2u pp[2];
#pragma unroll
        for (int q = 0; q < 2; ++q) { const int m = m0 + q * NGW; pp[q] = (m < T) ? *(const v2u*)(pos + (size_t)m * 2) : (v2u){0u, 0u}; }
        f32x4 xv[2][4]; v2u ya[2][4], yb[2][4];
#pragma unroll
        for (int q = 0; q < 2; ++q) { const int m = m0 + q * NGW; if (m < T) {
                const f32x4* xr = (const f32x4*)(x + (size_t)m * DM) + F.lane; const v2u* y0 = (const v2u*)(ys + (size_t)pp[q].x * DM) + F.lane; const v2u* y1 = (const v2u*)(ys + (size_t)pp[q].y * DM) + F.lane;
#pragma unroll
                for (int j = 0; j < 4; ++j) { xv[q][j] = xr[64 * j]; ya[q][j] = y0[64 * j]; yb[q][j] = y1[64 * j]; } } }
#pragma unroll
        for (int q = 0; q < 2; ++q) { const int m = m0 + q * NGW; if (m < T) {
                f32x4* xw = (f32x4*)(xdst + (size_t)m * DM) + F.lane; float s = 0.f; f32x4 v[4];
#pragma unroll
                for (int j = 0; j < 4; ++j) { f32x4 t = xv[q][j]; const v2u a = ya[q][j], b = yb[q][j];
                    t.x += bflo(a.x) + bflo(b.x); t.y += bfhi(a.x) + bfhi(b.x); t.z += bflo(a.y) + bflo(b.y); t.w += bfhi(a.y) + bfhi(b.y);
                    v[j] = t; xw[64 * j] = t; s += (t.x * t.x + t.y * t.y) + (t.z * t.z + t.w * t.w); }
                if (ngain) {
                    const float r = rsqrtf(wave_sum(s) * (1.f / DM) + RMS_EPS);
                    v2u* o8 = (v2u*)(hout + (size_t)m * DM) + F.lane;
#pragma unroll
                    for (int j = 0; j < 4; ++j) { v2u w; w.x = pk2(v[j].x * r * g[j].x, v[j].y * r * g[j].y); w.y = pk2(v[j].z * r * g[j].z, v[j].w * r * g[j].w); o8[64 * j] = w; }
                } } }
    }
}

constexpr int PH_PER_LAYER = 11, N_PHASES = 1 + DEPTH * PH_PER_LAYER;
__device__ __forceinline__ CArgs& kargs() { CArgs* p = (CArgs*)__builtin_amdgcn_kernarg_segment_ptr(); asm volatile("" : "+s"(p)); return *p; }
__global__ void __launch_bounds__(512, 2) mk_fwd(Args args_unused) {
    extern __shared__ __attribute__((aligned(16))) unsigned char lds[];
    LAS unsigned char* lds3 = (LAS unsigned char*)lds;
    const int wave_s = __builtin_amdgcn_readfirstlane(threadIdx.x >> 6);
    for (int u = threadIdx.x; u < (LDS_BYTES - LDSCTL_OFF) / 4; u += 512) ((LAS unsigned*)(lds3 + LDSCTL_OFF))[u] = 0u;
    __syncthreads();
#if MK_SPLIT
#define GRID_BAR() do { } while (0)
#else
    (void)xcd_barrier_post((unsigned*)(kargs().ws + WS_CTL) + CW_BAR, (volatile LAS unsigned*)(lds3 + LDSCTL_OFF));
#define GRID_BAR() do { XcdBarrier b_; b_.bar = (unsigned*)(kargs().ws + WS_CTL) + CW_BAR; b_.x = xb_xcc_id(); b_.st = (volatile LAS unsigned*)(lds3 + LDSCTL_OFF); xcd_barrier(b_); } while (0)
#endif
    const int lo = kargs().ph_lo, hi = kargs().ph_hi;
#define IN(k) (lo <= (k) && (k) < hi)
#define SEAM(k) do { if (IN(k) && IN((k) + 1)) GRID_BAR(); } while (0)
#define FRAME() CArgs& A = kargs(); Frame F; F.lds = lds; F.lane = lane_id_asm(); F.wave = wave_s; F.tid = wave_s * 64 + F.lane; F.G = gridDim.x; F.bid = blockIdx.x; \
    unsigned char* ws = A.ws; F.ws = ws; F.ctl = (unsigned*)(ws + WS_CTL); (void)F;
#define WSP(T_, off) ((T_*)(ws + (off)))

#ifdef EXTRA_BARS
    for (int eb_ = 0; eb_ < EXTRA_BARS; ++eb_) GRID_BAR();
#endif
    if (IN(0) && PHON(11)) { for (int rep_ = 0; rep_ < REPN(11); ++rep_) { if (rep_) GRID_BAR(); { FRAME(); phase_prologue(F, A); }
        { FRAME(); phase_norm(F, A.in[I_X], A.in[I_MIXG], WSP(bf16, WS_H)); } } }
    SEAM(0);
#pragma unroll 1
    for (int l = 0; l < DEPTH; ++l) {
        const int p0 = 1 + l * PH_PER_LAYER;
        if (IN(p0 + 1) && PHON(1)) { for (int rep_ = 0; rep_ < REPN(1); ++rep_) { if (rep_) GRID_BAR(); { FRAME();
            pg8::Gemm g{DM, DM, DM};
            SchedDense S{(const char*)(ws + WS_H), (const char*)(ws + WS_WIN) + (size_t)l * NCOL * DM * 2, T / 256, NCOL / 256, F.G, F.bid, (size_t)256 * DM * 2, (size_t)256 * DM * 2};
            EpiStoreBf16 E{WSP(bf16, WS_PROJ), NCOL};
            pg8::gemm_phase<EpiStoreBf16, SchedDense, true, true>(lds3, g, S, E, F.tid);
        } } }
        SEAM(p0 + 1);
        if (IN(p0 + 2) && PHON(2)) { for (int rep_ = 0; rep_ < REPN(2); ++rep_) { if (rep_) GRID_BAR(); {
            for (int r2_ = 0; r2_ < REPN(14); ++r2_) { FRAME(); phase_qkprep(F, WSP(bf16, WS_PROJ), A.in[I_QG] + l * 64, A.in[I_KG] + l * 64, WSP(bf16, WS_Q), WSP(bf16, WS_K), WSP(float, WS_KMEAN)); }
            for (int r2_ = 0; r2_ < REPN(15); ++r2_) { FRAME(); phase_conv(F, WSP(bf16, WS_PROJ), A.in[I_CONVW] + (size_t)l * 31 * 512, A.in[I_CONVB] + l * 512, A.in[I_CLNG] + l * 512, A.in[I_CLNB] + l * 512, WSP(bf16, WS_CAT)); }
            for (int r2_ = 0; r2_ < REPN(16); ++r2_) { FRAME(); phase_hgrn1(F, WSP(bf16, WS_PROJ), A.in[I_LBL], l, WSP(float, WS_HS), WSP(float, WS_HS + 16 * MiB), WSP(float, WS_ORAW), WSP(bf16, WS_HS + 17 * MiB)); }
        } } }
        SEAM(p0 + 2);
        if (IN(p0 + 3) && PHON(3)) { for (int rep_ = 0; rep_ < REPN(3); ++rep_) { if (rep_) GRID_BAR(); {
            for (int r2_ = 0; r2_ < REPN(12); ++r2_) { FRAME(); phase_attn_mfma(F, WSP(bf16, WS_Q), WSP(bf16, WS_K), WSP(bf16, WS_PROJ), WSP(float, WS_KMEAN), WSP(bf16, WS_CAT)); }
            for (int r2_ = 0; r2_ < REPN(13); ++r2_) { FRAME(); phase_hgrn2(F, WSP(bf16, WS_PROJ), A.in[I_HGG] + l * 128, WSP(float, WS_HS), WSP(float, WS_HS + 16 * MiB), WSP(float, WS_ORAW), WSP(bf16, WS_HS + 17 * MiB), WSP(bf16, WS_CAT), (r2_ + 1 < REPN(13)) ? PROBE_DRY : 0); }
        } } }
        SEAM(p0 + 3);
        if (IN(p0 + 4) && PHON(4)) { for (int rep_ = 0; rep_ < REPN(4); ++rep_) { if (rep_) GRID_BAR(); { FRAME();
            pg8::Gemm g{1536, 512, 512};
            SchedBranch S{(const char*)(ws + WS_CAT), (const char*)(ws + WS_WCAT) + (size_t)l * 3 * DM * 512 * 2, F.G, F.bid};
            EpiBranch E{WSP(bf16, WS_PROJ), A.in[I_BGATE] + l * 3 * DM, WSP(bf16, WS_MERGED)};
            pg8::gemm_phase<EpiBranch, SchedBranch, true, true>(lds3, g, S, E, F.tid);
        } } }
        SEAM(p0 + 4);
        if (IN(p0 + 5) && PHON(5)) { for (int rep_ = 0; rep_ < REPN(5); ++rep_) { if (rep_) GRID_BAR(); { FRAME();
            pg8::Gemm g{DM, DM, DM};
            SchedDense S{(const char*)(ws + WS_MERGED), (const char*)(ws + WS_WOUT) + (size_t)l * DM * DM * 2, T / 256, DM / 256, F.G, F.bid, (size_t)256 * DM * 2, (size_t)256 * DM * 2};
            EpiResidual E{(l == 0) ? A.in[I_X] : (const float*)A.out, (rep_ + 1 >= REPN(5)) ? A.out : WSP(float, WS_HS)};
            pg8::gemm_phase<EpiResidual, SchedDense, true, true>(lds3, g, S, E, F.tid);
        } } }
        SEAM(p0 + 5);
        if (IN(p0 + 6) && PHON(6)) { for (int rep_ = 0; rep_ < REPN(6); ++rep_) { if (rep_) GRID_BAR(); { FRAME(); phase_router2(F, A.out, A.in[I_FFNG] + l * DM, A.in[I_WCO] + (size_t)l * DM * 4, A.in[I_BCO] + l * 4, A.in[I_WFI] + (size_t)l * DM * 32, A.in[I_BFI] + l * 32, WSP(bf16, WS_H), WSP(unsigned, WS_ROUTE), F.ctl + CW_CNT + l * 32 * 64, WSP(float, WS_Q), rep_ + 1 >= REPN(6)); } } }
        SEAM(p0 + 6);
        if (IN(p0 + 7) && PHON(7)) { for (int rep_ = 0; rep_ < REPN(7); ++rep_) { if (rep_) GRID_BAR(); { FRAME(); phase_scatter(F, WSP(bf16, WS_H), WSP(unsigned, WS_ROUTE), F.ctl + CW_CNT + l * 32 * 64, F.ctl + CW_NT + l * 64, F.ctl + CW_TILE + l * 256, WSP(bf16, WS_HS), WSP(float, WS_POS + 512 * 1024), WSP(float, WS_POS + 768 * 1024), WSP(unsigned, WS_POS)); } } }
        SEAM(p0 + 7);
        if (IN(p0 + 8) && PHON(8)) { for (int rep_ = 0; rep_ < REPN(8); ++rep_) { if (rep_) GRID_BAR(); { FRAME();
            pg8::Gemm g{DM, DM, DM};
            SchedMoe S{(const char*)(ws + WS_HS), (const char*)(ws + WS_WEI) + (size_t)l * NEXP * 1024 * DM * 2, F.ctl + CW_NT + l * 64, F.ctl + CW_TILE + l * 256, F.G, F.bid, (size_t)256 * DM * 2, (size_t)1024 * DM * 2, (size_t)256 * DM * 2};
            EpiSwiglu E{WSP(bf16, WS_ACT), WSP(float, WS_POS + 768 * 1024)};
            pg8::gemm_phase<EpiSwiglu, SchedMoe, true, true>(lds3, g, S, E, F.tid);
        } } }
        SEAM(p0 + 8);
        if (IN(p0 + 9) && PHON(9)) { for (int rep_ = 0; rep_ < REPN(9); ++rep_) { if (rep_) GRID_BAR(); { FRAME();
            pg8::Gemm g{FF, FF, FF};
            SchedMoe S{(const char*)(ws + WS_ACT), (const char*)(ws + WS_WEO) + (size_t)l * NEXP * DM * FF * 2, F.ctl + CW_NT + l * 64, F.ctl + CW_TILE + l * 256, F.G, F.bid, (size_t)256 * FF * 2, (size_t)DM * FF * 2, (size_t)256 * FF * 2};
            EpiScaleRows E{WSP(bf16, WS_YS), WSP(float, WS_POS + 512 * 1024)};
            pg8::gemm_phase<EpiScaleRows, SchedMoe, true, true>(lds3, g, S, E, F.tid);
        } } }
        SEAM(p0 + 9);
        if (IN(p0 + 10) && PHON(10)) { for (int rep_ = 0; rep_ < REPN(10); ++rep_) { if (rep_) GRID_BAR(); { FRAME(); phase_combine(F, A.out, (rep_ + 1 >= REPN(10)) ? A.out : WSP(float, WS_HS), WSP(bf16, WS_YS), WSP(unsigned, WS_POS), (l + 1 < DEPTH) ? A.in[I_MIXG] + (l + 1) * DM : nullptr, WSP(bf16, WS_H)); } } }
        SEAM(p0 + 10);
    }
#undef IN
#undef SEAM
#undef FRAME
#undef WSP
}

extern "C" void kernel_launch(void* const* d_in, const int* in_sizes, int n_in, void* d_out, int out_size, void* d_ws, size_t ws_size, hipStream_t stream) {
    static int grid = 0;
    if (grid == 0) {
        if (n_in != 23 || out_size != T * DM || ws_size < WS_END) { fprintf(stderr, "kernel_launch: unexpected shapes (n_in %d out %d ws %zu)\n", n_in, out_size, ws_size); grid = -1; return; }
        int dev = 0, cus = 0, per_cu = 0;
        if (hipGetDevice(&dev) != hipSuccess || hipDeviceGetAttribute(&cus, hipDeviceAttributeMultiprocessorCount, dev) != hipSuccess) { grid = -1; return; }
        if (hipFuncSetAttribute((const void*)mk_fwd, hipFuncAttributeMaxDynamicSharedMemorySize, LDS_BYTES) != hipSuccess) { fprintf(stderr, "kernel_launch: hipFuncSetAttribute failed\n"); grid = -1; return; }
        if (hipOccupancyMaxActiveBlocksPerMultiprocessor(&per_cu, (const void*)mk_fwd, 512, LDS_BYTES) != hipSuccess || per_cu < 1) fprintf(stderr, "kernel_launch: occupancy query says %d\n", per_cu);
        (void)hipGetLastError();
        grid = cus;
    }
    if (grid < 0) return;
    (void)hipMemsetAsync((char*)d_ws + WS_CTL, 0, CTL_ZERO_BYTES, stream);
    Args a{};
    for (int i = 0; i < 23; ++i) a.in[i] = (const float*)d_in[i];
    a.out = (float*)d_out; a.ws = (unsigned char*)d_ws;
#if MK_SPLIT
    for (int p = 0; p < N_PHASES; ++p) {
        if (p == 1 + PH_PER_LAYER) continue;
        a.ph_lo = p; a.ph_hi = p + 1;
        hipLaunchKernelGGL(mk_fwd, dim3(grid), dim3(512), LDS_BYTES, stream, a);
    }
#else
    a.ph_lo = 0; a.ph_hi = N_PHASES;
    hipLaunchKernelGGL(mk_fwd, dim3(grid), dim3(512), LDS_BYTES, stream, a);
#endif
}
```

```cpp
#include <hip/hip_runtime.h>
#include <cstdio>
#include <cstdint>

#ifndef MK_SPLIT
#define MK_SPLIT 0
#endif
#ifndef DBG_MASK
#define DBG_MASK 0xFFFFu
#endif
#define PHON(j) (((DBG_MASK) >> (j)) & 1u)
#ifndef REP_MASK
#define REP_MASK 0u
#endif
#ifndef REP_EXTRA
#define REP_EXTRA 1
#endif
#ifndef PROBE_DRY
#define PROBE_DRY 0
#endif
#define REPN(j) ((((REP_MASK) >> (j)) & 1u) ? (1 + REP_EXTRA) : 1)

constexpr int DM = 1024, NB = 8, SEQ = 2048, T = NB * SEQ, DEPTH = 2;
constexpr int NCOL = 7680;
constexpr int C_AQ = 0, C_AK = 512, C_AV = 1024, C_HQ = 1536, C_HF = 2048, C_HI = 2560, C_HG = 3072, C_CA = 3584, C_CB = 4096, C_GL = 4608;
constexpr int NEXP = 32, FF = 512;
constexpr int MOE_ROWS = 2 * T + NEXP * 256;
constexpr float RMS_EPS = 1e-6f, LN_EPS = 1e-5f;
constexpr float QSCALE = 0.125f * 1.4426950408889634f;

namespace pg8 {
#define PG8_LAS __attribute__((address_space(3)))
typedef unsigned short bf16_t;
typedef short bf16x8 __attribute__((ext_vector_type(8)));
typedef float f32x4 __attribute__((ext_vector_type(4)));
typedef unsigned u32x4 __attribute__((ext_vector_type(4)));
constexpr int BM = 256, BK = 64, HALF = 128, HTB = HALF * BK * 2, STAGE_BYTES = 8 * HTB, NXCD = 8, WGM = 8;

__host__ __device__ __forceinline__ int lds_byte(int r, int c) { const int st = (r >> 4) * 2 + (c >> 5), rr = r & 15, cc = c & 31, ob = rr * 64 + cc * 2; return st * 1024 + (ob ^ (((ob >> 9) & 1) << 5)); }
__host__ __device__ __forceinline__ void stage_rc(int b, int& R, int& C) { const int st = b / 1024, sb = b % 1024, swz = sb ^ (((sb >> 9) & 1) << 5); R = (st >> 1) * 16 + swz / 64; C = (st & 1) * 32 + (swz % 64) / 2; }
__host__ __device__ __forceinline__ int perm32(int rho) { const int n = rho >> 4, i = rho & 15; return 8 * (i >> 2) + 4 * n + (i & 3); }

struct Unit { int pm, pn, aux, pad; const char* a; const char* b; };
struct Gemm { int lda, ldb, K; };

__device__ __forceinline__ bool static_tile(int nM, int nN, long L, int& pm, int& pn) {
    const int nwg = nM * nN; if (L >= nwg) return false;
    int wgid = (int)L; { const int q = nwg / NXCD, r = nwg % NXCD, xcd = wgid % NXCD, off = wgid / NXCD; wgid = (xcd < r ? xcd * (q + 1) : r * (q + 1) + (xcd - r) * q) + off; }
    const int nig = WGM * nN, gid = wgid / nig, fm = gid * WGM, gsz = (nM - fm) < WGM ? (nM - fm) : WGM;
    pm = fm + ((wgid % nig) % gsz); pn = (wgid % nig) / gsz; return true;
}

__device__ __forceinline__ unsigned cvt_pk_bf16(float lo, float hi) { unsigned r; asm volatile("v_cvt_pk_bf16_f32 %0, %1, %2" : "=v"(r) : "v"(lo), "v"(hi)); return r; }

template <class Epi, class Sched, bool ALIGN_EPI = false, bool SP2 = false>
__device__ __forceinline__ void gemm_phase(PG8_LAS unsigned char* lds, const Gemm g, const Sched& S, const Epi& E, int tid_in) {
    int tid_ = tid_in; asm volatile("" : "+v"(tid_));
    const int tid = tid_, wid = __builtin_amdgcn_readfirstlane(tid >> 6), lane = tid & 63, wr = wid >> 2, wc = wid & 3, fr = lane & 15, fq = lane >> 4;
    const int K = g.K, nt = K / BK;
    unsigned voffA[2], voffB[2];
#pragma unroll
    for (int i = 0; i < 2; ++i) { int R, C; stage_rc(tid * 16 + i * 8192, R, C); const int Rb = Epi::PERM ? ((R & ~31) + perm32(R & 31)) : R;
        voffA[i] = (unsigned)(R * g.lda + C) * 2u; voffB[i] = (unsigned)(Rb * g.ldb + C) * 2u; }
    const size_t kstep = (size_t)(BK * 2);
    const size_t hstepA = (size_t)HALF * g.lda * 2, hstepB = (size_t)HALF * g.ldb * 2;
    const unsigned ldsw = (unsigned)wid * 1024u;
    const int aoff = lds_byte(wr * 64 + fr, fq * 8), boff = lds_byte(wc * 32 + fr, fq * 8);
#define PG8_SA(b, h) (((b) * 2 + (h)) * HTB)
#define PG8_SB(b, h) ((4 + (b) * 2 + (h)) * HTB)
#define PG8_STAGE(bufoff, gbase, voff) do { _Pragma("unroll") for (int _i = 0; _i < 2; ++_i) \
        __builtin_amdgcn_global_load_lds((const unsigned*)((const char*)(gbase) + (voff)[_i]), (PG8_LAS unsigned*)(lds + (bufoff) + ldsw + _i * 8192), 16, 0, 0); } while (0)
#define PG8_LDA(dst, b, h) do { _Pragma("unroll") for (int m = 0; m < 4; ++m) _Pragma("unroll") for (int k = 0; k < 2; ++k) dst[m][k] = *(const PG8_LAS bf16x8*)(lds + PG8_SA(b, h) + aoff + m * 2048 + k * 1024); } while (0)
#define PG8_LDB(dst, b, h) do { _Pragma("unroll") for (int n = 0; n < 2; ++n) _Pragma("unroll") for (int k = 0; k < 2; ++k) dst[n][k] = *(const PG8_LAS bf16x8*)(lds + PG8_SB(b, h) + boff + n * 2048 + k * 1024); } while (0)
#define PG8_MMA(ai, bj, At, Bt) do { __builtin_amdgcn_s_setprio(1); _Pragma("unroll") for (int m = 0; m < 4; ++m) _Pragma("unroll") for (int n = 0; n < 2; ++n) _Pragma("unroll") for (int k = 0; k < 2; ++k) \
        acc[ai][bj][m][n] = __builtin_amdgcn_mfma_f32_16x16x32_bf16(Bt[n][k], At[m][k], acc[ai][bj][m][n], 0, 0, 0); __builtin_amdgcn_s_setprio(0); } while (0)
#define PG8_WAIT_V(n) asm volatile("s_waitcnt vmcnt(" #n ")" ::: "memory")
#define PG8_WAIT_L(n) asm volatile("s_waitcnt lgkmcnt(" #n ")" ::: "memory")
#define PG8_BAR __builtin_amdgcn_s_barrier()
#define PG8_SCHED __builtin_amdgcn_sched_barrier(0)
    Unit cur, nxt; int ui = 0;
    if (!S.next(0, cur)) return;
    f32x4 acc[2][2][4][2];
#pragma unroll
    for (int a = 0; a < 2; ++a)
#pragma unroll
        for (int b = 0; b < 2; ++b)
#pragma unroll
            for (int m = 0; m < 4; ++m)
#pragma unroll
                for (int n = 0; n < 2; ++n) acc[a][b][m][n] = (f32x4){0.f, 0.f, 0.f, 0.f};
    bf16x8 At[4][2], B0[2][2], B1[2][2];
    const char* cA = cur.a; const char* cB = cur.b;
    if constexpr (SP2) {
        PG8_STAGE(PG8_SB(0, 0), cB, voffB); PG8_STAGE(PG8_SB(0, 1), cB + hstepB, voffB); PG8_STAGE(PG8_SA(0, 0), cA, voffA); PG8_STAGE(PG8_SA(0, 1), cA + hstepA, voffA);
        if (wr == 1) PG8_BAR;
        PG8_WAIT_V(2); PG8_BAR;
        PG8_STAGE(PG8_SB(1, 0), cB + kstep, voffB); PG8_STAGE(PG8_SA(1, 0), cA + kstep, voffA); PG8_STAGE(PG8_SB(1, 1), cB + hstepB + kstep, voffB);
        PG8_WAIT_V(6); PG8_BAR;
    } else {
        PG8_STAGE(PG8_SB(0, 0), cB, voffB); PG8_STAGE(PG8_SA(0, 0), cA, voffA); PG8_STAGE(PG8_SB(0, 1), cB + hstepB, voffB); PG8_STAGE(PG8_SA(0, 1), cA + hstepA, voffA);
        if (wr == 1) PG8_BAR;
        PG8_WAIT_V(4); PG8_BAR;
        PG8_STAGE(PG8_SB(1, 0), cB + kstep, voffB); PG8_STAGE(PG8_SA(1, 0), cA + kstep, voffA); PG8_STAGE(PG8_SB(1, 1), cB + hstepB + kstep, voffB);
        PG8_WAIT_V(6); PG8_BAR;
    }
    for (;;) {
        const bool has_next = S.next(ui + 1, nxt);
        const char* nA = has_next ? nxt.a : cA; const char* nB = has_next ? nxt.b : cB;
        for (int t = 0; t < nt; t += 2) {
            const bool last = (t == nt - 2);
            const char* a1 = cA + (size_t)(t + 1) * kstep;
            const char* a2 = last ? nA : cA + (size_t)(t + 2) * kstep; const char* b2 = last ? nB : cB + (size_t)(t + 2) * kstep;
            const char* a3 = a2 + kstep; const char* b3 = b2 + kstep;
            if constexpr (SP2) {
            PG8_LDB(B0, 0, 0); PG8_LDB(B1, 0, 1); PG8_SCHED; PG8_LDA(At, 0, 0); PG8_STAGE(PG8_SA(1, 1), a1 + hstepA, voffA);
            PG8_WAIT_V(8); PG8_WAIT_L(0); PG8_BAR; PG8_MMA(0, 0, At, B0); PG8_MMA(0, 1, At, B1); PG8_BAR; PG8_SCHED;
            PG8_LDA(At, 0, 1); PG8_STAGE(PG8_SB(0, 0), b2, voffB); PG8_STAGE(PG8_SB(0, 1), b2 + hstepB, voffB); PG8_STAGE(PG8_SA(0, 0), a2, voffA);
            PG8_WAIT_V(8); PG8_WAIT_L(0); PG8_BAR; PG8_MMA(1, 0, At, B0); PG8_MMA(1, 1, At, B1); PG8_BAR; PG8_SCHED;
            PG8_LDB(B0, 1, 0); PG8_LDB(B1, 1, 1); PG8_SCHED; PG8_LDA(At, 1, 0); PG8_STAGE(PG8_SA(0, 1), a2 + hstepA, voffA);
            PG8_WAIT_V(8); PG8_WAIT_L(0); PG8_BAR; PG8_MMA(0, 0, At, B0); PG8_MMA(0, 1, At, B1); PG8_BAR; PG8_SCHED;
            PG8_LDA(At, 1, 1); PG8_STAGE(PG8_SB(1, 0), b3, voffB); PG8_STAGE(PG8_SB(1, 1), b3 + hstepB, voffB); PG8_STAGE(PG8_SA(1, 0), a3, voffA);
            PG8_WAIT_V(8); PG8_WAIT_L(0); PG8_BAR; PG8_MMA(1, 0, At, B0); PG8_MMA(1, 1, At, B1); PG8_BAR; PG8_SCHED;
            } else {
            PG8_LDB(B0, 0, 0); PG8_SCHED; PG8_LDA(At, 0, 0); PG8_STAGE(PG8_SA(1, 1), a1 + hstepA, voffA);
            PG8_WAIT_L(8); PG8_BAR; PG8_WAIT_L(0); PG8_MMA(0, 0, At, B0); PG8_BAR; PG8_SCHED;
            PG8_LDB(B1, 0, 1); PG8_STAGE(PG8_SB(0, 0), b2, voffB);
            PG8_BAR; PG8_WAIT_L(0); PG8_MMA(0, 1, At, B1); PG8_BAR;
            PG8_LDA(At, 0, 1); PG8_STAGE(PG8_SA(0, 0), a2, voffA);
            PG8_BAR; PG8_WAIT_L(0); PG8_MMA(1, 0, At, B0); PG8_BAR; PG8_SCHED;
            PG8_STAGE(PG8_SB(0, 1), b2 + hstepB, voffB);
            PG8_WAIT_V(6); PG8_BAR; PG8_MMA(1, 1, At, B1); PG8_BAR;
            PG8_LDB(B0, 1, 0); PG8_SCHED; PG8_LDA(At, 1, 0); PG8_STAGE(PG8_SA(0, 1), a2 + hstepA, voffA);
            PG8_WAIT_L(8); PG8_BAR; PG8_WAIT_L(0); PG8_MMA(0, 0, At, B0); PG8_BAR; PG8_SCHED;
            PG8_LDB(B1, 1, 1); PG8_STAGE(PG8_SB(1, 0), b3, voffB);
            PG8_BAR; PG8_WAIT_L(0); PG8_MMA(0, 1, At, B1); PG8_BAR;
            PG8_LDA(At, 1, 1); PG8_STAGE(PG8_SA(1, 0), a3, voffA);
            PG8_BAR; PG8_WAIT_L(0); PG8_MMA(1, 0, At, B0); PG8_BAR; PG8_SCHED;
            PG8_STAGE(PG8_SB(1, 1), b3 + hstepB, voffB);
            PG8_WAIT_V(6); PG8_BAR; PG8_MMA(1, 1, At, B1); PG8_BAR;
            }
        }
        if constexpr (ALIGN_EPI) { if (wr == 0) PG8_BAR; }
        const bool reset_acc = E(acc, cur, wr, wc, fr, fq);
        if (!has_next) break;
        if (reset_acc) {
#pragma unroll
        for (int a = 0; a < 2; ++a)
#pragma unroll
            for (int b = 0; b < 2; ++b)
#pragma unroll
                for (int m = 0; m < 4; ++m)
#pragma unroll
                    for (int n = 0; n < 2; ++n) acc[a][b][m][n] = (f32x4){0.f, 0.f, 0.f, 0.f};
        }
        cur = nxt; cA = nA; cB = nB; ++ui;
        if constexpr (ALIGN_EPI) { if (wr == 1) PG8_BAR; }
    }
    PG8_WAIT_V(0);
    if constexpr (!ALIGN_EPI) { if (wr == 0) PG8_BAR; }
    PG8_BAR;
#undef PG8_SA
#undef PG8_SB
#undef PG8_STAGE
#undef PG8_LDA
#undef PG8_LDB
#undef PG8_MMA
#undef PG8_WAIT_V
#undef PG8_WAIT_L
#undef PG8_BAR
#undef PG8_SCHED
}
}

constexpr size_t MiB = 1u << 20;
constexpr size_t WS_CTL = 0, CTL_ZERO_BYTES = 1 * MiB;
constexpr size_t WS_WIN = 2 * MiB;
constexpr size_t WS_WCAT = WS_WIN + 30 * MiB;
constexpr size_t WS_WOUT = WS_WCAT + 6 * MiB;
constexpr size_t WS_WEI = WS_WOUT + 4 * MiB;
constexpr size_t WS_WEO = WS_WEI + 128 * MiB;
constexpr size_t WS_H = WS_WEO + 64 * MiB;
constexpr size_t WS_PROJ = WS_H + 32 * MiB;
constexpr size_t WS_Q = WS_PROJ + 240 * MiB;
constexpr size_t WS_K = WS_Q + 16 * MiB;
constexpr size_t WS_KMEAN = WS_K + 16 * MiB;
constexpr size_t WS_CAT = WS_KMEAN + 1 * MiB;
constexpr size_t WS_MERGED = WS_CAT + 48 * MiB;
constexpr size_t WS_ORAW = WS_MERGED + 32 * MiB;
constexpr size_t WS_ROUTE = WS_ORAW + 32 * MiB;
constexpr size_t WS_POS = WS_ROUTE + 1 * MiB;
constexpr size_t WS_HS = WS_POS + 1 * MiB;
constexpr size_t WS_ACT = WS_HS + 80 * MiB;
constexpr size_t WS_YS = WS_ACT + 40 * MiB;
constexpr size_t WS_XB = WS_YS + 80 * MiB;
constexpr size_t WS_GT = WS_XB + 32 * MiB;
constexpr size_t WS_END = WS_GT + 96 * MiB;
static_assert(WS_END <= 1000 * MiB, "workspace map");
constexpr int CW_BAR = 4096;
constexpr int CW_CNT = 16384;
constexpr int CW_NT = CW_CNT + 2 * 32 * 64;
constexpr int CW_TILE = CW_NT + 2 * 64;
static_assert((CW_TILE + 2 * 256) * 4 <= (int)CTL_ZERO_BYTES, "ctl");

constexpr int LDS_SCRATCH = 155136, LDSCTL_OFF = LDS_SCRATCH, LDS_BYTES = 155648;

#define GAS __attribute__((address_space(1)))
#define LAS __attribute__((address_space(3)))
typedef unsigned short bf16;
typedef unsigned v4u __attribute__((ext_vector_type(4)));
typedef unsigned v2u __attribute__((ext_vector_type(2)));
typedef float f32x4 __attribute__((ext_vector_type(4)));
typedef float f32x2 __attribute__((ext_vector_type(2)));
#define RLX_AGENT __ATOMIC_RELAXED, __HIP_MEMORY_SCOPE_AGENT
__device__ __forceinline__ unsigned f2bf(float f) { unsigned u = __builtin_bit_cast(unsigned, f); return (u + 0x7fffu + ((u >> 16) & 1u)) >> 16; }
__device__ __forceinline__ unsigned pk2(float lo, float hi) { return f2bf(lo) | (f2bf(hi) << 16); }
__device__ __forceinline__ float bflo(unsigned w) { return __uint_as_float(w << 16); }
__device__ __forceinline__ float bfhi(unsigned w) { return __uint_as_float(w & 0xffff0000u); }
__device__ __forceinline__ float bf2f(bf16 v) { return __uint_as_float((unsigned)v << 16); }
__device__ __forceinline__ float sigmoidf_(float x) { return 1.0f / (1.0f + __expf(-x)); }
__device__ __forceinline__ float wave_sum(float v) {
    v += __int_as_float(__builtin_amdgcn_update_dpp(0, __float_as_int(v), 0xB1, 0xf, 0xf, true));
    v += __int_as_float(__builtin_amdgcn_update_dpp(0, __float_as_int(v), 0x4E, 0xf, 0xf, true));
    v += __int_as_float(__builtin_amdgcn_update_dpp(0, __float_as_int(v), 0x141, 0xf, 0xf, true));
    v += __int_as_float(__builtin_amdgcn_update_dpp(0, __float_as_int(v), 0x140, 0xf, 0xf, true));
    { auto r = __builtin_amdgcn_permlane16_swap(__float_as_uint(v), __float_as_uint(v), false, false); v = __uint_as_float(r[0]) + __uint_as_float(r[1]); }
    { auto r = __builtin_amdgcn_permlane32_swap(__float_as_uint(v), __float_as_uint(v), false, false); v = __uint_as_float(r[0]) + __uint_as_float(r[1]); }
    return v;
}

#define XB_TMO      128
#define XB_XCNT(j)  (256  + 64 * (j))
#define XB_XSUB(j)  (1280 + 64 * (j))
#define XB_XGEN(j)  (2304 + 64 * (j))
#define XB_TOP      3328
#define XB_TOPGEN   3392
#define XCD_BAR_WORDS 3456
#define XB_SPIN_CAP (1u << 18)
__device__ __forceinline__ unsigned xb_ld(unsigned* p)              { return __hip_atomic_load(p, __ATOMIC_RELAXED, __HIP_MEMORY_SCOPE_AGENT); }
__device__ __forceinline__ unsigned xb_add(unsigned* p, unsigned v) { return __hip_atomic_fetch_add(p, v, __ATOMIC_RELAXED, __HIP_MEMORY_SCOPE_AGENT); }
__device__ __forceinline__ unsigned xb_xcc_id() { return (unsigned)__builtin_amdgcn_s_getreg((3 << 11) | 20) & 0xFu; }
#define XB_SPIN(cond, bar) do { unsigned _sp = 0; while (cond) { __builtin_amdgcn_s_sleep(1); \
    if ((++_sp & 255u) == 0u) { if (xb_ld(&(bar)[XB_TMO])) break; if (_sp > XB_SPIN_CAP) { atomicAdd(&(bar)[XB_TMO], 1u); break; } } } } while (0)
struct XcdBarrier { unsigned* bar; unsigned x; volatile LAS unsigned* st; };
__device__ __forceinline__ XcdBarrier xcd_barrier_post(unsigned* bar, volatile LAS unsigned* st) {
    XcdBarrier b; b.bar = bar; b.x = xb_xcc_id(); b.st = st;
    if (threadIdx.x == 0) (void)xb_add(&bar[XB_XCNT(b.x)], 1u);
    return b;
}
__device__ __forceinline__ void xcd_barrier_complete(unsigned* bar, unsigned x, unsigned& nloc, unsigned& nx) {
    const unsigned G = gridDim.x * gridDim.y * gridDim.z;
    unsigned sum, cnt, mine, sp = 0u;
    for (;;) {
        sum = 0u; cnt = 0u; mine = 0u;
#pragma unroll
        for (unsigned j = 0; j < 16; ++j) { const unsigned c = xb_ld(&bar[XB_XCNT(j)]); sum += c; cnt += (c > 0u) ? 1u : 0u; mine = (j == x) ? c : mine; }
        if (sum == G) break;
        __builtin_amdgcn_s_sleep(1);
        if ((++sp & 255u) == 0u) { if (xb_ld(&bar[XB_TMO])) break; if (sp > XB_SPIN_CAP) { atomicAdd(&bar[XB_TMO], 1u); break; } }
    }
    nloc = mine > 0u ? mine : 1u; nx = cnt > 0u ? cnt : 1u;
}
__device__ __forceinline__ void xcd_barrier(const XcdBarrier& b) {
    asm volatile("s_waitcnt vmcnt(0)" ::: "memory");
    __syncthreads();
    if (threadIdx.x == 0) {
        unsigned* bar = b.bar;
        __builtin_amdgcn_s_waitcnt(0);
        unsigned nloc = b.st[0], nx = b.st[1];
        if (nloc == 0u) { xcd_barrier_complete(bar, b.x, nloc, nx); b.st[0] = nloc; b.st[1] = nx; }
        const unsigned old = xb_add(&bar[XB_XSUB(b.x)], 1u);
        const unsigned gen = old / nloc;
        if (old + 1u == (gen + 1u) * nloc) {
            __builtin_amdgcn_fence(__ATOMIC_RELEASE, "agent");
            asm volatile("s_waitcnt vmcnt(0)" ::: "memory");
            const unsigned og = xb_add(&bar[XB_TOP], 1u);
            const unsigned tg = og / nx;
            if (og + 1u == (tg + 1u) * nx) xb_add(&bar[XB_TOPGEN], 1u);
            else XB_SPIN(xb_ld(&bar[XB_TOPGEN]) == tg, bar);
            __builtin_amdgcn_fence(__ATOMIC_ACQUIRE, "agent");
            xb_add(&bar[XB_XGEN(b.x)], 1u);
            asm volatile("s_waitcnt vmcnt(0)" ::: "memory");
        } else {
            XB_SPIN(xb_ld(&bar[XB_XGEN(b.x)]) == gen, bar);
            __builtin_amdgcn_fence(__ATOMIC_ACQUIRE, "agent");
            asm volatile("s_waitcnt vmcnt(0)" ::: "memory");
        }
    }
    __syncthreads();
}

struct Args { const float* in[23]; float* out; unsigned char* ws; int ph_lo, ph_hi; };
typedef const Args __attribute__((address_space(4))) CArgs;
enum InIdx { I_X = 0, I_MIXG, I_WIN, I_BGATE, I_QG, I_KG, I_LBL, I_HGG, I_CONVW, I_CONVB, I_CLNG, I_CLNB, I_WATT, I_WHGRN, I_WCONV, I_WOUT, I_FFNG, I_WCO, I_BCO, I_WFI, I_BFI, I_WEI, I_WEO };

struct Frame {
    unsigned char* lds;
    int tid, lane, wave, G, bid;
    unsigned char* ws; unsigned* ctl;
};
__device__ __forceinline__ int lane_id_asm() { int l; asm volatile("v_mbcnt_lo_u32_b32 %0, -1, 0\n\tv_mbcnt_hi_u32_b32 %0, -1, %0" : "=v"(l)); return l; }
__device__ __forceinline__ Frame fresh(Frame F) { asm volatile("" : "+v"(F.tid)); F.lane = F.tid & 63; return F; }

struct TItem { const float* W; bf16* WT; int K, N, k0, n0, drow0; };
__device__ __forceinline__ void titem_load(const TItem& t, int lane, float (&v)[32]) {
#pragma unroll
    for (int i = 0; i < 32; ++i) { const int kk = 2 * i + (lane >> 5); v[i] = t.W[(size_t)(t.k0 + kk) * t.N + t.n0 + (lane & 31)]; }
}
__device__ __forceinline__ void titem_emit(const TItem& t, int lane, const float (&v)[32], float* scr) {
#pragma unroll
    for (int i = 0; i < 32; ++i) { const int kk = 2 * i + (lane >> 5); scr[kk * 33 + (lane & 31)] = v[i]; }
    asm volatile("s_waitcnt lgkmcnt(0)" ::: "memory");
    const int c = lane & 7;
#pragma unroll
    for (int j = 0; j < 4; ++j) { const int n = (lane >> 3) + 8 * j; const float* s = scr + (8 * c) * 33 + n;
        v4u o; o.x = pk2(s[0 * 33], s[1 * 33]); o.y = pk2(s[2 * 33], s[3 * 33]); o.z = pk2(s[4 * 33], s[5 * 33]); o.w = pk2(s[6 * 33], s[7 * 33]);
        *(v4u*)(t.WT + (size_t)(t.drow0 + n) * t.K + t.k0 + 8 * c) = o; }
    asm volatile("s_waitcnt lgkmcnt(0)" ::: "memory");
}
__device__ __forceinline__ TItem titem_decode(CArgs& A, unsigned char* ws, int it) {
    constexpr int I_IN = (DM / 64) * (NCOL / 32), I_BR = (512 / 64) * (DM / 32), I_OUT = (DM / 64) * (DM / 32), I_EI = (DM / 64) * (1024 / 32), I_EO = (FF / 64) * (DM / 32);
    constexpr int PER_L = I_IN + 3 * I_BR + I_OUT + NEXP * I_EI + NEXP * I_EO;
    TItem t; const int l = it / PER_L; int r = it % PER_L;
    if (r < I_IN) { const int nblk = NCOL / 32, kb = r / nblk, nb = r % nblk;
        t.W = A.in[I_WIN] + (size_t)l * DM * NCOL; t.K = DM; t.N = NCOL; t.WT = (bf16*)(ws + WS_WIN) + (size_t)l * NCOL * DM; t.k0 = 64 * kb; t.n0 = 32 * nb; t.drow0 = 32 * nb; return t; }
    r -= I_IN;
    if (r < 3 * I_BR) { const int br = r / I_BR, rr = r % I_BR, nblk = DM / 32, kb = rr / nblk, nb = rr % nblk;
        t.W = A.in[br == 0 ? I_WATT : (br == 1 ? I_WHGRN : I_WCONV)] + (size_t)l * 512 * DM; t.K = 512; t.N = DM; t.WT = (bf16*)(ws + WS_WCAT) + ((size_t)l * 3 + br) * DM * 512; t.k0 = 64 * kb; t.n0 = 32 * nb; t.drow0 = 32 * nb; return t; }
    r -= 3 * I_BR;
    if (r < I_OUT) { const int nblk = DM / 32, kb = r / nblk, nb = r % nblk;
        t.W = A.in[I_WOUT] + (size_t)l * DM * DM; t.K = DM; t.N = DM; t.WT = (bf16*)(ws + WS_WOUT) + (size_t)l * DM * DM; t.k0 = 64 * kb; t.n0 = 32 * nb; t.drow0 = 32 * nb; return t; }
    r -= I_OUT;
    if (r < NEXP * I_EI) { const int e = r / I_EI, rr = r % I_EI, nblk = 1024 / 32, kb = rr / nblk, nb = rr % nblk, n0 = 32 * nb;
        const int nn = n0 & 511;
        t.W = A.in[I_WEI] + ((size_t)l * NEXP + e) * DM * 1024; t.K = DM; t.N = 1024; t.WT = (bf16*)(ws + WS_WEI) + ((size_t)l * NEXP + e) * 1024 * DM; t.k0 = 64 * kb; t.n0 = n0; t.drow0 = (nn >> 7) * 256 + (n0 >= 512 ? 128 : 0) + (nn & 127); return t; }
    r -= NEXP * I_EI;
    { const int e = r / I_EO, rr = r % I_EO, nblk = DM / 32, kb = rr / nblk, nb = rr % nblk;
        t.W = A.in[I_WEO] + ((size_t)l * NEXP + e) * FF * DM; t.K = FF; t.N = DM; t.WT = (bf16*)(ws + WS_WEO) + ((size_t)l * NEXP + e) * DM * FF; t.k0 = 64 * kb; t.n0 = 32 * nb; t.drow0 = 32 * nb; return t; }
}
__device__ __forceinline__ void phase_prologue(const Frame& F0, CArgs& A) {
    const Frame F = fresh(F0);
    float* scr = (float*)(F.lds + F.wave * 16384);
    const int gw = F.bid * 8 + F.wave, NGW = F.G * 8;
    constexpr int I_IN = (DM / 64) * (NCOL / 32), I_BR = (512 / 64) * (DM / 32), I_OUT = (DM / 64) * (DM / 32), I_EI = (DM / 64) * (1024 / 32), I_EO = (FF / 64) * (DM / 32);
    constexpr int NIT = DEPTH * (I_IN + 3 * I_BR + I_OUT + NEXP * I_EI + NEXP * I_EO);
    if (gw >= NIT) return;
    float cur[32], nxt[32];
    TItem tc = titem_decode(A, F.ws, gw);
    titem_load(tc, F.lane, cur);
    for (int it = gw; it < NIT; it += NGW) {
        TItem tn = tc; const bool more = (it + NGW < NIT);
        if (more) { tn = titem_decode(A, F.ws, it + NGW); titem_load(tn, F.lane, nxt); }
        titem_emit(tc, F.lane, cur, scr);
        if (more) {
#pragma unroll
            for (int i = 0; i < 32; ++i) cur[i] = nxt[i];
            tc = tn; }
    }
}

__device__ __forceinline__ void phase_norm(const Frame& F0, const float* x, const float* gain, bf16* out) {
    const Frame F = fresh(F0);
    const int gw = F.bid * 8 + F.wave, NGW = F.G * 8;
    f32x4 g[4];
#pragma unroll
    for (int j = 0; j < 4; ++j) g[j] = *(const f32x4*)(gain + 4 * F.lane + 256 * j);
    for (int m0 = gw; m0 < T; m0 += 4 * NGW) {
        f32x4 v[4][4];
#pragma unroll
        for (int q = 0; q < 4; ++q) { const int m = m0 + q * NGW; if (m < T) { const f32x4* xr = (const f32x4*)(x + (size_t)m * DM) + F.lane;
#pragma unroll
                for (int j = 0; j < 4; ++j) v[q][j] = xr[64 * j]; } }
#pragma unroll
        for (int q = 0; q < 4; ++q) { const int m = m0 + q * NGW; if (m < T) { float s = 0.f;
#pragma unroll
                for (int j = 0; j < 4; ++j) s += (v[q][j].x * v[q][j].x + v[q][j].y * v[q][j].y) + (v[q][j].z * v[q][j].z + v[q][j].w * v[q][j].w);
                const float r = rsqrtf(wave_sum(s) * (1.f / DM) + RMS_EPS);
                v2u* o8 = (v2u*)(out + (size_t)m * DM) + F.lane;
#pragma unroll
                for (int j = 0; j < 4; ++j) { v2u w; w.x = pk2(v[q][j].x * r * g[j].x, v[q][j].y * r * g[j].y); w.y = pk2(v[q][j].z * r * g[j].z, v[q][j].w * r * g[j].w); o8[64 * j] = w; } } }
    }
}

__device__ __forceinline__ void phase_qkprep(const Frame& F0, const bf16* proj, const float* qg, const float* kg, bf16* Q, bf16* Kb, float* kmean) {
    const Frame F = fresh(F0);
    float* red = (float*)F.lds;
    float* red2 = red + 256 * 65;
    const int tok = F.tid >> 1, hf = F.tid & 1;
    float qgv[32], kgv[32];
#pragma unroll
    for (int i = 0; i < 8; ++i) { const f32x4 a = *(const f32x4*)(qg + hf * 32 + 4 * i), c = *(const f32x4*)(kg + hf * 32 + 4 * i);
        qgv[4 * i] = a.x; qgv[4 * i + 1] = a.y; qgv[4 * i + 2] = a.z; qgv[4 * i + 3] = a.w; kgv[4 * i] = c.x; kgv[4 * i + 1] = c.y; kgv[4 * i + 2] = c.z; kgv[4 * i + 3] = c.w; }
    for (int u = F.bid; u < 512; u += F.G) {
        const int b = u >> 6, blk = (u >> 3) & 7, h = u & 7;
        const size_t row = (size_t)b * SEQ + blk * 256 + tok;
        const bf16* pq = proj + row * NCOL + C_AQ + h * 64 + hf * 32;
        const bf16* pk = proj + row * NCOL + C_AK + h * 64 + hf * 32;
        float qv[32], kv[32];
#pragma unroll
        for (int i = 0; i < 4; ++i) { const v4u a = *(const v4u*)(pq + 8 * i), c = *(const v4u*)(pk + 8 * i);
            qv[8 * i + 0] = bflo(a.x); qv[8 * i + 1] = bfhi(a.x); qv[8 * i + 2] = bflo(a.y); qv[8 * i + 3] = bfhi(a.y); qv[8 * i + 4] = bflo(a.z); qv[8 * i + 5] = bfhi(a.z); qv[8 * i + 6] = bflo(a.w); qv[8 * i + 7] = bfhi(a.w);
            kv[8 * i + 0] = bflo(c.x); kv[8 * i + 1] = bfhi(c.x); kv[8 * i + 2] = bflo(c.y); kv[8 * i + 3] = bfhi(c.y); kv[8 * i + 4] = bflo(c.z); kv[8 * i + 5] = bfhi(c.z); kv[8 * i + 6] = bflo(c.w); kv[8 * i + 7] = bfhi(c.w); }
        float sq = 0.f, sk = 0.f;
#pragma unroll
        for (int i = 0; i < 32; ++i) { sq += qv[i] * qv[i]; sk += kv[i] * kv[i]; }
        sq += __shfl_xor(sq, 1); sk += __shfl_xor(sk, 1);
        const float rq = rsqrtf(sq * (1.f / 64.f) + RMS_EPS) * QSCALE, rk = rsqrtf(sk * (1.f / 64.f) + RMS_EPS);
#pragma unroll
        for (int i = 0; i < 32; ++i) { qv[i] = qv[i] * rq * qgv[i]; kv[i] = kv[i] * rk * kgv[i]; }
        bf16* oq = Q + row * 512 + h * 64 + hf * 32; bf16* ok = Kb + row * 512 + h * 64 + hf * 32;
#pragma unroll
        for (int i = 0; i < 4; ++i) { v4u a, c;
            a.x = pk2(qv[8 * i], qv[8 * i + 1]); a.y = pk2(qv[8 * i + 2], qv[8 * i + 3]); a.z = pk2(qv[8 * i + 4], qv[8 * i + 5]); a.w = pk2(qv[8 * i + 6], qv[8 * i + 7]);
            c.x = pk2(kv[8 * i], kv[8 * i + 1]); c.y = pk2(kv[8 * i + 2], kv[8 * i + 3]); c.z = pk2(kv[8 * i + 4], kv[8 * i + 5]); c.w = pk2(kv[8 * i + 6], kv[8 * i + 7]);
            *(v4u*)(oq + 8 * i) = a; *(v4u*)(ok + 8 * i) = c; }
        __syncthreads();
#pragma unroll
        for (int i = 0; i < 32; ++i) red[tok * 65 + hf * 32 + i] = kv[i];
        __syncthreads();
        { const int d = F.tid & 63, part = F.tid >> 6; float s = 0.f;
            for (int tk = 0; tk < 32; ++tk) s += red[(part * 32 + tk) * 65 + d];
            red2[part * 64 + d] = s; }
        __syncthreads();
        if (F.tid < 64) { float s = 0.f;
#pragma unroll
            for (int p = 0; p < 8; ++p) s += red2[p * 64 + F.tid];
            kmean[(((size_t)b * 8 + h) * 8 + blk) * 64 + F.tid] = s * (1.f / 256.f); }
    }
    __syncthreads();
}

__device__ __forceinline__ void phase_conv(const Frame& F0, const bf16* proj, const float* cw, const float* cb, const float* lng, const float* lnb, bf16* cat) {
    const Frame F = fresh(F0);
    float* ut = (float*)F.lds;
    const int c = F.tid;
    float w[31];
#pragma unroll
    for (int j = 0; j < 31; ++j) w[j] = cw[j * 512 + c];
    const float bias = cb[c];
    const f32x4 g0 = *(const f32x4*)(lng + 8 * F.lane), g1 = *(const f32x4*)(lng + 8 * F.lane + 4), b0 = *(const f32x4*)(lnb + 8 * F.lane), b1 = *(const f32x4*)(lnb + 8 * F.lane + 4);
    for (int u = F.bid; u < 512; u += F.G) {
        const int b = u >> 6, t0 = (u & 63) * 32;
        __syncthreads();
        {
            v4u av[8], gv[8];
#pragma unroll
            for (int i = 0; i < 8; ++i) { const int idx = F.tid + 512 * i, r = idx >> 6, ch = (idx & 63) * 8, t = t0 - 30 + r;
                if (r < 62 && t >= 0) { const bf16* p = proj + ((size_t)b * SEQ + t) * NCOL + ch; av[i] = *(const v4u*)(p + C_CA); gv[i] = *(const v4u*)(p + C_CB); }
                else { av[i] = (v4u){0u, 0u, 0u, 0u}; gv[i] = (v4u){0u, 0u, 0u, 0u}; } }
#pragma unroll
            for (int i = 0; i < 8; ++i) { const int idx = F.tid + 512 * i, r = idx >> 6, ch = (idx & 63) * 8;
                if (r < 62) {
                    f32x4 u0, u1;
                    u0.x = bflo(av[i].x) * sigmoidf_(bflo(gv[i].x)); u0.y = bfhi(av[i].x) * sigmoidf_(bfhi(gv[i].x)); u0.z = bflo(av[i].y) * sigmoidf_(bflo(gv[i].y)); u0.w = bfhi(av[i].y) * sigmoidf_(bfhi(gv[i].y));
                    u1.x = bflo(av[i].z) * sigmoidf_(bflo(gv[i].z)); u1.y = bfhi(av[i].z) * sigmoidf_(bfhi(gv[i].z)); u1.z = bflo(av[i].w) * sigmoidf_(bflo(gv[i].w)); u1.w = bfhi(av[i].w) * sigmoidf_(bfhi(gv[i].w));
                    *(f32x4*)(ut + r * 512 + ch) = u0; *(f32x4*)(ut + r * 512 + ch + 4) = u1; } }
        }
        __syncthreads();
        float uu[62];
#pragma unroll
        for (int i = 0; i < 62; ++i) uu[i] = ut[i * 512 + c];
#pragma unroll
        for (int t = 0; t < 32; ++t) { float a = bias;
#pragma unroll
            for (int j = 0; j < 31; ++j) a += w[j] * uu[t + j];
            ut[t * 512 + c] = a; }
        __syncthreads();
#pragma unroll
        for (int q = 0; q < 4; ++q) { const int t = F.wave * 4 + q;
            const f32x4 v0 = *(const f32x4*)(ut + t * 512 + 8 * F.lane), v1 = *(const f32x4*)(ut + t * 512 + 8 * F.lane + 4);
            const float mu = wave_sum((v0.x + v0.y) + (v0.z + v0.w) + (v1.x + v1.y) + (v1.z + v1.w)) * (1.f / 512.f);
            const f32x4 d0 = v0 - mu, d1 = v1 - mu;
            const float var = wave_sum((d0.x * d0.x + d0.y * d0.y) + (d0.z * d0.z + d0.w * d0.w) + (d1.x * d1.x + d1.y * d1.y) + (d1.z * d1.z + d1.w * d1.w)) * (1.f / 512.f);
            const float rs = rsqrtf(var + LN_EPS);
            f32x4 y0 = d0 * rs * g0 + b0, y1 = d1 * rs * g1 + b1;
            y0.x *= sigmoidf_(y0.x); y0.y *= sigmoidf_(y0.y); y0.z *= sigmoidf_(y0.z); y0.w *= sigmoidf_(y0.w);
            y1.x *= sigmoidf_(y1.x); y1.y *= sigmoidf_(y1.y); y1.z *= sigmoidf_(y1.z); y1.w *= sigmoidf_(y1.w);
            v4u o; o.x = pk2(y0.x, y0.y); o.y = pk2(y0.z, y0.w); o.z = pk2(y1.x, y1.y); o.w = pk2(y1.z, y1.w);
            *(v4u*)(cat + ((size_t)b * SEQ + t0 + t) * 1536 + 1024 + 8 * F.lane) = o; }
    }
    __syncthreads();
}

__device__ __forceinline__ void phase_hgrn_naive(const Frame& F0, const bf16* proj, const float* lbl, int layer, float* oraw) {
    const Frame F = fresh(F0);
    float* part = (float*)F.lds;
    const int k = F.tid & 127, vq = F.tid >> 7;
    for (int u = F.bid; u < 256; u += F.G) {
        const int b = u >> 5, h = (u >> 3) & 3, vs = u & 7;
        float lb = 0.f;
        if (layer > 0) { const float l0 = lbl[h * 128 + k], l1 = lbl[512 + h * 128 + k]; lb = 1.f / (1.f + __expf(l0 - l1)); }
        const float omlb = 1.f - lb;
        float S0 = 0.f, S1 = 0.f, S2 = 0.f, S3 = 0.f;
        const bf16* pq = proj + (size_t)b * SEQ * NCOL + C_HQ + h * 128 + k;
        const bf16* pf = proj + (size_t)b * SEQ * NCOL + C_HF + h * 128 + k;
        const bf16* pv = proj + (size_t)b * SEQ * NCOL + C_HI + h * 128 + vs * 16 + vq * 4;
        for (int t0 = 0; t0 < SEQ; t0 += 32) {
#pragma unroll 4
            for (int tt = 0; tt < 32; ++tt) {
                const size_t ro = (size_t)(t0 + tt) * NCOL;
                const float qv = bf2f(pq[ro]), fr = bf2f(pf[ro]); const v2u vv = *(const v2u*)(pv + ro);
                const float sig = sigmoidf_(fr), f = lb + omlb * sig, kk = omlb * (1.f - sig), qa = qv * sigmoidf_(qv);
                S0 = f * S0 + kk * bflo(vv.x); S1 = f * S1 + kk * bfhi(vv.x); S2 = f * S2 + kk * bflo(vv.y); S3 = f * S3 + kk * bfhi(vv.y);
                const float p0 = wave_sum(qa * S0), p1 = wave_sum(qa * S1), p2 = wave_sum(qa * S2), p3 = wave_sum(qa * S3);
                if (F.lane == 0) *(f32x4*)(part + (tt * 8 + F.wave) * 4) = (f32x4){p0, p1, p2, p3};
            }
            __syncthreads();
            if (F.tid < 128) { const int tt = F.tid >> 2, v2 = F.tid & 3;
                const f32x4 a = *(const f32x4*)(part + (tt * 8 + v2 * 2) * 4), c = *(const f32x4*)(part + (tt * 8 + v2 * 2 + 1) * 4);
                *(f32x4*)(oraw + ((size_t)b * SEQ + t0 + tt) * 512 + h * 128 + vs * 16 + v2 * 4) = a + c; }
            __syncthreads();
        }
    }
}

__device__ __forceinline__ void phase_hgrn_post(const Frame& F0, const float* oraw, const bf16* proj, const float* hgg, bf16* cat) {
    const Frame F = fresh(F0);
    const int gw = F.bid * 8 + F.wave, NGW = F.G * 8;
    const f32x2 g = *(const f32x2*)(hgg + 2 * F.lane);
    for (int it = gw; it < T * 4; it += NGW) {
        const int row = it >> 2, h = it & 3;
        const f32x2 o = *(const f32x2*)(oraw + (size_t)row * 512 + h * 128 + 2 * F.lane);
        const unsigned hw = *(const unsigned*)(proj + (size_t)row * NCOL + C_HG + h * 128 + 2 * F.lane);
        const float r = rsqrtf(wave_sum(o.x * o.x + o.y * o.y) * (1.f / 128.f) + RMS_EPS);
        const float g0 = bflo(hw), g1 = bfhi(hw);
        const float y0 = o.x * r * g.x * (g0 * sigmoidf_(g0)), y1 = o.y * r * g.y * (g1 * sigmoidf_(g1));
        *(unsigned*)(cat + (size_t)row * 1536 + 512 + h * 128 + 2 * F.lane) = pk2(y0, y1);
    }
}

__device__ __forceinline__ void attn_naive_unit(const Frame& F, int b, int h, int qb, const bf16* Q, const bf16* Kb, const bf16* proj, const float* kmean, bf16* cat) {
    float* Ks = (float*)F.lds;
    float* Vs = Ks + 64 * 64;
    const int qi = F.tid >> 1, half = F.tid & 1;
    const size_t row0 = (size_t)b * SEQ + qb * 256;
    float q[32];
    { const bf16* pq = Q + (row0 + qi) * 512 + h * 64 + half * 32;
#pragma unroll
        for (int i = 0; i < 4; ++i) { const v4u a = *(const v4u*)(pq + 8 * i);
            q[8 * i + 0] = bflo(a.x); q[8 * i + 1] = bfhi(a.x); q[8 * i + 2] = bflo(a.y); q[8 * i + 3] = bfhi(a.y); q[8 * i + 4] = bflo(a.z); q[8 * i + 5] = bfhi(a.z); q[8 * i + 6] = bflo(a.w); q[8 * i + 7] = bfhi(a.w); } }
    unsigned selmask;
    if (qb <= 3) selmask = (1u << qb) - 1u;
    else {
        float gate[7];
#pragma unroll
        for (int j = 0; j < 7; ++j) { gate[j] = -3.0e38f;
            if (j < qb) { const float* km = kmean + (((size_t)b * 8 + h) * 8 + j) * 64 + half * 32; float s = 0.f;
#pragma unroll
                for (int d = 0; d < 32; ++d) s += q[d] * km[d];
                s += __shfl_xor(s, 1);
                gate[j] = s; } }
        selmask = 0u;
#pragma unroll
        for (int r = 0; r < 3; ++r) { float best = -3.0e38f; int bi = 0;
#pragma unroll
            for (int j = 0; j < 7; ++j) { const bool ok = (j < qb) && !((selmask >> j) & 1u) && (gate[j] > best); if (ok) { best = gate[j]; bi = j; } }
            selmask |= 1u << bi; }
    }
    float acc[32];
#pragma unroll
    for (int d = 0; d < 32; ++d) acc[d] = 0.f;
    float l = 0.f;
    const int skey = F.tid >> 3, sseg = F.tid & 7;
    for (int j = 0; j <= qb; ++j) {
        for (int kt = 0; kt < 4; ++kt) {
            __syncthreads();
            { const size_t krow = (size_t)b * SEQ + j * 256 + kt * 64 + skey;
                const v4u kk = *(const v4u*)(Kb + krow * 512 + h * 64 + sseg * 8), vv = *(const v4u*)(proj + krow * NCOL + C_AV + h * 64 + sseg * 8);
                *(f32x4*)(Ks + skey * 64 + sseg * 8) = (f32x4){bflo(kk.x), bfhi(kk.x), bflo(kk.y), bfhi(kk.y)}; *(f32x4*)(Ks + skey * 64 + sseg * 8 + 4) = (f32x4){bflo(kk.z), bfhi(kk.z), bflo(kk.w), bfhi(kk.w)};
                *(f32x4*)(Vs + skey * 64 + sseg * 8) = (f32x4){bflo(vv.x), bfhi(vv.x), bflo(vv.y), bfhi(vv.y)}; *(f32x4*)(Vs + skey * 64 + sseg * 8 + 4) = (f32x4){bflo(vv.z), bfhi(vv.z), bflo(vv.w), bfhi(vv.w)}; }
            __syncthreads();
            if (j == qb && kt > (F.wave >> 1)) continue;
#pragma unroll 2
            for (int key = 0; key < 64; ++key) {
                float s = 0.f;
#pragma unroll
                for (int d = 0; d < 32; d += 4) { const f32x4 kx = *(const f32x4*)(Ks + key * 64 + half * 32 + d); s += q[d] * kx.x + q[d + 1] * kx.y + q[d + 2] * kx.z + q[d + 3] * kx.w; }
                s += __shfl_xor(s, 1);
                const bool valid = (j == qb) ? (kt * 64 + key <= qi) : (((selmask >> j) & 1u) != 0u);
                const float p = valid ? exp2f(s) : 0.f;
                l += p;
#pragma unroll
                for (int d = 0; d < 32; d += 4) { const f32x4 vx = *(const f32x4*)(Vs + key * 64 + half * 32 + d); acc[d] += p * vx.x; acc[d + 1] += p * vx.y; acc[d + 2] += p * vx.z; acc[d + 3] += p * vx.w; }
            }
        }
    }
    { const float rl = 1.f / l;
        bf16* po = cat + (row0 + qi) * 1536 + h * 64 + half * 32;
#pragma unroll
        for (int i = 0; i < 4; ++i) { v4u o; o.x = pk2(acc[8 * i] * rl, acc[8 * i + 1] * rl); o.y = pk2(acc[8 * i + 2] * rl, acc[8 * i + 3] * rl); o.z = pk2(acc[8 * i + 4] * rl, acc[8 * i + 5] * rl); o.w = pk2(acc[8 * i + 6] * rl, acc[8 * i + 7] * rl); *(v4u*)(po + 8 * i) = o; }
    }
}
__device__ __forceinline__ void phase_attn_naive(const Frame& F0, const bf16* Q, const bf16* Kb, const bf16* proj, const float* kmean, bf16* cat) {
    const Frame F = fresh(F0);
    for (int p = F.bid; p < 256; p += F.G) {
        const int bh = p >> 2, s = p & 3;
#pragma unroll 1
        for (int i = 0; i < 2; ++i) attn_naive_unit(F, bh >> 3, bh & 7, i ? s : 7 - s, Q, Kb, proj, kmean, cat);
    }
    __syncthreads();
}

typedef float f32x16 __attribute__((ext_vector_type(16)));
typedef short bf16x8 __attribute__((ext_vector_type(8)));
typedef short v4i16_t __attribute__((ext_vector_type(4)));
constexpr int AT_KROW = 144, AT_VROW = 192, AT_KBUF = 64 * AT_KROW, AT_VBUF = 64 * AT_VROW, AT_BUF = AT_KBUF + AT_VBUF;
constexpr int AT_WSF = 2 * AT_BUF, AT_STG = AT_WSF + 8 * 256, AT_LDS = AT_STG + 8 * 4096;
__device__ __forceinline__ int crow16(int r, int hi) { return (r & 3) + 8 * (r >> 2) + 4 * hi; }
__device__ __forceinline__ void attn_mfma_unit(const Frame& F, LAS unsigned char* L, int b, int h, int qb, const bf16* Q, const bf16* Kb, const bf16* proj, const float* kmean, bf16* cat) {
    const int lane = F.lane, r32 = lane & 31, hi = lane >> 5, wid = F.wave;
    const size_t row0 = (size_t)b * SEQ + qb * 256;
    const int qi = wid * 32 + r32;
    bf16x8 qf[4];
    { const bf16* pq = Q + (row0 + qi) * 512 + h * 64 + hi * 8;
#pragma unroll
        for (int d0 = 0; d0 < 4; ++d0) qf[d0] = *(const bf16x8*)(pq + d0 * 16); }
    unsigned selmask;
    if (qb <= 3) selmask = (1u << qb) - 1u;
    else {
        float gate[7];
#pragma unroll
        for (int j = 0; j < 7; ++j) { gate[j] = -3.0e38f;
            if (j < qb) { const float* km = kmean + (((size_t)b * 8 + h) * 8 + j) * 64 + hi * 8; float sacc = 0.f;
#pragma unroll
                for (int d0 = 0; d0 < 4; ++d0) { const f32x4 k0 = *(const f32x4*)(km + d0 * 16), k1 = *(const f32x4*)(km + d0 * 16 + 4);
                    sacc += bf2f((bf16)qf[d0][0]) * k0.x + bf2f((bf16)qf[d0][1]) * k0.y + bf2f((bf16)qf[d0][2]) * k0.z + bf2f((bf16)qf[d0][3]) * k0.w
                          + bf2f((bf16)qf[d0][4]) * k1.x + bf2f((bf16)qf[d0][5]) * k1.y + bf2f((bf16)qf[d0][6]) * k1.z + bf2f((bf16)qf[d0][7]) * k1.w; }
                sacc += __shfl_xor(sacc, 32);
                gate[j] = sacc; } }
        selmask = 0u;
#pragma unroll
        for (int r = 0; r < 3; ++r) { float best = -3.0e38f; int bi = 0;
#pragma unroll
            for (int j = 0; j < 7; ++j) { const bool ok = (j < qb) && !((selmask >> j) & 1u) && (gate[j] > best); if (ok) { best = gate[j]; bi = j; } }
            selmask |= 1u << bi; }
    }
    const int srow = F.tid >> 3, sch = F.tid & 7;
    const bf16* kg = Kb + ((size_t)b * SEQ + srow) * 512 + h * 64 + sch * 8;
    const bf16* vg = proj + ((size_t)b * SEQ + srow) * NCOL + C_AV + h * 64 + sch * 8;
    const int kst = srow * AT_KROW + sch * 16, vst = AT_KBUF + srow * AT_VROW + sch * 16;
    const int kfo = r32 * AT_KROW + hi * 16;
    const int g16 = lane >> 4, idx = lane & 15;
    const int vfo = AT_KBUF + (4 * (g16 >> 1) + (idx >> 2)) * AT_VROW + ((g16 & 1) * 16 + 4 * (idx & 3)) * 2;
    const int NT = 4 * (qb + 1);
    f32x16 o0 = {}, o1 = {};
    float lsum = 0.f;
    { const v4u kk = *(const v4u*)kg, vv = *(const v4u*)vg;
        *(LAS v4u*)(L + kst) = kk; *(LAS v4u*)(L + vst) = vv; }
    __syncthreads();
#define AT_TILE(OWN) do { \
        const int cb = (t & 1) * AT_BUF, nb = AT_BUF - cb; \
        v4u kk, vv; \
        if (t + 1 < NT) { kk = *(const v4u*)(kg + (size_t)(t + 1) * 64 * 512); vv = *(const v4u*)(vg + (size_t)(t + 1) * 64 * NCOL); } \
        const int j = t >> 2, kt = t & 3; \
        const bool active = !(OWN) || (kt * 64 <= wid * 32 + 31); \
        if (active) { \
            f32x16 s0, s1; \
            { const float bias = ((OWN) || (((selmask >> j) & 1u) != 0u)) ? 0.f : -1.0e30f; \
                _Pragma("unroll") for (int r = 0; r < 16; ++r) { s0[r] = bias; s1[r] = bias; } } \
            bf16x8 kf[8]; \
            _Pragma("unroll") for (int d0 = 0; d0 < 4; ++d0) { kf[d0] = *(const LAS bf16x8*)(L + cb + kfo + d0 * 32); kf[4 + d0] = *(const LAS bf16x8*)(L + cb + kfo + 32 * AT_KROW + d0 * 32); } \
            _Pragma("unroll") for (int d0 = 0; d0 < 4; ++d0) { \
                s0 = __builtin_amdgcn_mfma_f32_32x32x16_bf16(kf[d0], qf[d0], s0, 0, 0, 0); \
                s1 = __builtin_amdgcn_mfma_f32_32x32x16_bf16(kf[4 + d0], qf[d0], s1, 0, 0, 0); } \
            v4i16_t va[16]; \
            _Pragma("unroll") for (int sub = 0; sub < 2; ++sub) \
                _Pragma("unroll") for (int sI = 0; sI < 2; ++sI) { const int vb = cb + vfo + (sub * 32 + 16 * sI) * AT_VROW, q4 = (sub * 2 + sI) * 4; \
                    va[q4 + 0] = __builtin_amdgcn_ds_read_tr16_b64_v4i16((LAS v4i16_t*)(L + vb)); va[q4 + 1] = __builtin_amdgcn_ds_read_tr16_b64_v4i16((LAS v4i16_t*)(L + vb + 8 * AT_VROW)); \
                    va[q4 + 2] = __builtin_amdgcn_ds_read_tr16_b64_v4i16((LAS v4i16_t*)(L + vb + 64)); va[q4 + 3] = __builtin_amdgcn_ds_read_tr16_b64_v4i16((LAS v4i16_t*)(L + vb + 8 * AT_VROW + 64)); } \
            __builtin_amdgcn_sched_barrier(0); \
            float ps = 0.f; \
            if (OWN) { const int lim = qi - kt * 64; \
                _Pragma("unroll") for (int r = 0; r < 16; ++r) { const int kv = crow16(r, hi); \
                    const float p0 = (kv <= lim) ? __builtin_amdgcn_exp2f(s0[r]) : 0.f, p1 = (kv + 32 <= lim) ? __builtin_amdgcn_exp2f(s1[r]) : 0.f; \
                    s0[r] = p0; s1[r] = p1; ps += p0 + p1; } \
            } else { \
                _Pragma("unroll") for (int r = 0; r < 16; ++r) { const float p0 = __builtin_amdgcn_exp2f(s0[r]), p1 = __builtin_amdgcn_exp2f(s1[r]); s0[r] = p0; s1[r] = p1; ps += p0 + p1; } } \
            lsum += ps; \
            bf16x8 pa[4]; \
            _Pragma("unroll") for (int sI = 0; sI < 2; ++sI) { v4u w0, w1; \
                w0.x = pg8::cvt_pk_bf16(s0[8 * sI + 0], s0[8 * sI + 1]); w0.y = pg8::cvt_pk_bf16(s0[8 * sI + 2], s0[8 * sI + 3]); w0.z = pg8::cvt_pk_bf16(s0[8 * sI + 4], s0[8 * sI + 5]); w0.w = pg8::cvt_pk_bf16(s0[8 * sI + 6], s0[8 * sI + 7]); \
                w1.x = pg8::cvt_pk_bf16(s1[8 * sI + 0], s1[8 * sI + 1]); w1.y = pg8::cvt_pk_bf16(s1[8 * sI + 2], s1[8 * sI + 3]); w1.z = pg8::cvt_pk_bf16(s1[8 * sI + 4], s1[8 * sI + 5]); w1.w = pg8::cvt_pk_bf16(s1[8 * sI + 6], s1[8 * sI + 7]); \
                pa[sI] = __builtin_bit_cast(bf16x8, w0); pa[2 + sI] = __builtin_bit_cast(bf16x8, w1); } \
            _Pragma("unroll") for (int q = 0; q < 4; ++q) { \
                const bf16x8 v0 = (bf16x8){va[4 * q][0], va[4 * q][1], va[4 * q][2], va[4 * q][3], va[4 * q + 1][0], va[4 * q + 1][1], va[4 * q + 1][2], va[4 * q + 1][3]}; \
                const bf16x8 v1 = (bf16x8){va[4 * q + 2][0], va[4 * q + 2][1], va[4 * q + 2][2], va[4 * q + 2][3], va[4 * q + 3][0], va[4 * q + 3][1], va[4 * q + 3][2], va[4 * q + 3][3]}; \
                o0 = __builtin_amdgcn_mfma_f32_32x32x16_bf16(pa[q], v0, o0, 0, 0, 0); \
                o1 = __builtin_amdgcn_mfma_f32_32x32x16_bf16(pa[q], v1, o1, 0, 0, 0); } \
        } \
        if (t + 1 < NT) { *(LAS v4u*)(L + nb + kst) = kk; *(LAS v4u*)(L + nb + vst) = vv; } \
        __syncthreads(); \
    } while (0)
    int t = 0;
#pragma unroll 1
    for (; t < NT - 4; ++t) AT_TILE(false);
#pragma unroll 1
    for (; t < NT; ++t) AT_TILE(true);
#undef AT_TILE
    lsum += __shfl_xor(lsum, 32);
    LAS float* wsf = (LAS float*)(L + AT_WSF + wid * 256);
    if (hi == 0) wsf[r32] = lsum;
    asm volatile("s_waitcnt lgkmcnt(0)" ::: "memory");
    LAS bf16* stg = (LAS bf16*)(L + AT_STG + wid * 4096);
#pragma unroll
    for (int r = 0; r < 16; ++r) { const int orow = crow16(r, hi); const float rl = 1.f / wsf[orow];
        stg[orow * 64 + r32] = (bf16)f2bf(o0[r] * rl); stg[orow * 64 + 32 + r32] = (bf16)f2bf(o1[r] * rl); }
    asm volatile("s_waitcnt lgkmcnt(0)" ::: "memory");
    bf16* po = cat + (row0 + wid * 32) * 1536 + h * 64;
#pragma unroll
    for (int i = 0; i < 4; ++i) { const int row = i * 8 + (lane >> 3), ch = lane & 7; const v4u v = *(const LAS v4u*)(stg + row * 64 + ch * 8); *(v4u*)(po + (size_t)row * 1536 + ch * 8) = v; }
    __syncthreads();
}
__device__ __forceinline__ void phase_attn_mfma(const Frame& F0, const bf16* Q, const bf16* Kb, const bf16* proj, const float* kmean, bf16* cat) {
    const Frame F = fresh(F0);
    LAS unsigned char* L = (LAS unsigned char*)F.lds;
    for (int p = F.bid; p < 256; p += F.G) {
        const int bh = p >> 2, s = p & 3;
#pragma unroll 1
        for (int i = 0; i < 2; ++i) attn_mfma_unit(F, L, bh >> 3, bh & 7, i ? s : 7 - s, Q, Kb, proj, kmean, cat);
    }
}

constexpr int HG_G = 0, HG_QD = 16384, HG_KD = HG_QD + 32 * 272, HG_KE = HG_KD + 32 * 272, HG_VT = HG_KE + 32 * 320, HG_SP = HG_VT + 32 * 320, HG_END = HG_SP + 128 * 320;
static_assert(HG_END <= LDS_SCRATCH, "hgrn lds");
template <bool PERM> __device__ __forceinline__ bf16x8 tr_frag(LAS unsigned char* tile, int pitch, int rbase, int cbase, int lane) {
    const int g16 = lane >> 4, idx = lane & 15, h = g16 >> 1;
    LAS unsigned char* p = tile + (rbase + (PERM ? 4 : 8) * h + (idx >> 2)) * pitch + (cbase + (g16 & 1) * 16 + 4 * (idx & 3)) * 2;
    const v4i16_t a0 = __builtin_amdgcn_ds_read_tr16_b64_v4i16((LAS v4i16_t*)p), a1 = __builtin_amdgcn_ds_read_tr16_b64_v4i16((LAS v4i16_t*)(p + (PERM ? 8 : 4) * pitch));
    return (bf16x8){a0[0], a0[1], a0[2], a0[3], a1[0], a1[1], a1[2], a1[3]};
}
template <bool FULL>
__device__ __forceinline__ void hgrn_unit(const Frame& F, LAS unsigned char* L, int u, const bf16* proj, const float* lbl, int layer, const float* gnorm, float* Lg, float* Dg, bf16* cat) {
    const int b = u >> 5, h = (u >> 3) & 3, blk = u & 7;
    const int lane = F.lane, r32 = lane & 31, hi = lane >> 5, wid = F.wave, tid = F.tid;
    const int tt = tid >> 4, cg = tid & 15, ch = cg * 8;
    LAS float* G = (LAS float*)(L + HG_G);
    float lbv[8], omlb[8], gn[8];
#pragma unroll
    for (int i = 0; i < 8; ++i) { float lb = 0.f;
        if (layer > 0) { const float l0 = lbl[h * 128 + ch + i], l1 = lbl[512 + h * 128 + ch + i]; lb = 1.f / (1.f + __expf(l0 - l1)); }
        lbv[i] = lb; omlb[i] = 1.f - lb; gn[i] = FULL ? gnorm[ch + i] : 0.f; }
    f32x16 S[2];
#pragma unroll
    for (int i = 0; i < 2; ++i) { S[i] = (f32x16){};
        if (FULL) { const int id = 2 * wid + i, kt = id >> 2, vt = id & 3;
            for (int pb = 0; pb < blk; ++pb) { const float* Lp = Lg + (size_t)(u - blk + pb) * 16384; const float* Dp = Dg + (size_t)(u - blk + pb) * 128;
#pragma unroll
                for (int r = 0; r < 16; ++r) { const int k = kt * 32 + crow16(r, hi); S[i][r] = Dp[k] * S[i][r] + Lp[k * 128 + vt * 32 + r32]; } } } }
    float dsum = 0.f;
    const size_t rowb = (size_t)b * SEQ + blk * 256;
    for (int c = 0; c < 8; ++c) {
        const size_t row = rowb + c * 32 + tt;
        const v4u fq = *(const v4u*)(proj + row * NCOL + C_HF + h * 128 + ch), vq = *(const v4u*)(proj + row * NCOL + C_HI + h * 128 + ch);
        v4u qq = {}, gq = {};
        if (FULL) { qq = *(const v4u*)(proj + row * NCOL + C_HQ + h * 128 + ch); gq = *(const v4u*)(proj + row * NCOL + C_HG + h * 128 + ch); }
        float kk[8], qa[8], gl[8];
        { const unsigned fw[4] = {fq.x, fq.y, fq.z, fq.w}, qw[4] = {qq.x, qq.y, qq.z, qq.w};
#pragma unroll
            for (int i = 0; i < 8; ++i) { const float fr = (i & 1) ? bfhi(fw[i >> 1]) : bflo(fw[i >> 1]); const float sig = sigmoidf_(fr);
                gl[i] = __logf(lbv[i] + omlb[i] * sig); kk[i] = omlb[i] * (1.f - sig);
                const float qv = (i & 1) ? bfhi(qw[i >> 1]) : bflo(qw[i >> 1]); qa[i] = qv * sigmoidf_(qv); } }
        *(LAS f32x4*)(G + tt * 128 + ch) = (f32x4){gl[0], gl[1], gl[2], gl[3]}; *(LAS f32x4*)(G + tt * 128 + ch + 4) = (f32x4){gl[4], gl[5], gl[6], gl[7]};
        *(LAS v4u*)(L + HG_VT + tt * 320 + ch * 2) = vq;
        __syncthreads();
        if (tid < 128) { float a[32];
#pragma unroll
            for (int t = 0; t < 32; ++t) a[t] = G[t * 128 + tid];
#pragma unroll
            for (int t = 1; t < 32; ++t) a[t] += a[t - 1];
#pragma unroll
            for (int t = 0; t < 32; ++t) G[t * 128 + tid] = a[t];
            dsum += a[31]; }
        __syncthreads();
        { const f32x4 b0 = *(const LAS f32x4*)(G + tt * 128 + ch), b1 = *(const LAS f32x4*)(G + tt * 128 + ch + 4);
            const f32x4 m0 = *(const LAS f32x4*)(G + 15 * 128 + ch), m1 = *(const LAS f32x4*)(G + 15 * 128 + ch + 4);
            const f32x4 e0 = *(const LAS f32x4*)(G + 31 * 128 + ch), e1 = *(const LAS f32x4*)(G + 31 * 128 + ch + 4);
            const float bb[8] = {b0.x, b0.y, b0.z, b0.w, b1.x, b1.y, b1.z, b1.w}, bm[8] = {m0.x, m0.y, m0.z, m0.w, m1.x, m1.y, m1.z, m1.w}, be[8] = {e0.x, e0.y, e0.z, e0.w, e1.x, e1.y, e1.z, e1.w};
            float ke[8], kd[8], qd[8];
#pragma unroll
            for (int i = 0; i < 8; ++i) { ke[i] = kk[i] * __expf(be[i] - bb[i]); if (FULL) { const float ex = __expf(bb[i] - bm[i]); qd[i] = qa[i] * ex; kd[i] = kk[i] * __expf(bm[i] - bb[i]); } }
            v4u w; w.x = pk2(ke[0], ke[1]); w.y = pk2(ke[2], ke[3]); w.z = pk2(ke[4], ke[5]); w.w = pk2(ke[6], ke[7]);
            *(LAS v4u*)(L + HG_KE + tt * 320 + ch * 2) = w;
            if (FULL) {
                w.x = pk2(qd[0], qd[1]); w.y = pk2(qd[2], qd[3]); w.z = pk2(qd[4], qd[5]); w.w = pk2(qd[6], qd[7]); *(LAS v4u*)(L + HG_QD + tt * 272 + ch * 2) = w;
                w.x = pk2(kd[0], kd[1]); w.y = pk2(kd[2], kd[3]); w.z = pk2(kd[4], kd[5]); w.w = pk2(kd[6], kd[7]); *(LAS v4u*)(L + HG_KD + tt * 272 + ch * 2) = w;
#pragma unroll
                for (int i = 0; i < 2; ++i) { const int id = 2 * wid + i, kt = id >> 2, vt = id & 3;
#pragma unroll
                    for (int r = 0; r < 16; ++r) { const int k = kt * 32 + crow16(r, hi); *(LAS bf16*)(L + HG_SP + k * 320 + (vt * 32 + r32) * 2) = (bf16)f2bf(S[i][r] * __expf(G[15 * 128 + k])); } }
            }
        }
        __syncthreads();
        f32x16 o = {};
        if (FULL && wid < 4) {
            f32x16 sc = {};
            bf16x8 qf[8];
#pragma unroll
            for (int k0 = 0; k0 < 8; ++k0) { qf[k0] = *(const LAS bf16x8*)(L + HG_QD + r32 * 272 + (k0 * 16 + 8 * hi) * 2);
                const bf16x8 kf = *(const LAS bf16x8*)(L + HG_KD + r32 * 272 + (k0 * 16 + 8 * hi) * 2);
                sc = __builtin_amdgcn_mfma_f32_32x32x16_bf16(kf, qf[k0], sc, 0, 0, 0); }
#pragma unroll
            for (int r = 0; r < 16; ++r) sc[r] = (crow16(r, hi) <= r32) ? sc[r] : 0.f;
#pragma unroll
            for (int k0 = 0; k0 < 8; ++k0) o = __builtin_amdgcn_mfma_f32_32x32x16_bf16(qf[k0], tr_frag<false>(L + HG_SP, 320, k0 * 16, wid * 32, lane), o, 0, 0, 0);
#pragma unroll
            for (int sI = 0; sI < 2; ++sI) { v4u w; w.x = pg8::cvt_pk_bf16(sc[8 * sI + 0], sc[8 * sI + 1]); w.y = pg8::cvt_pk_bf16(sc[8 * sI + 2], sc[8 * sI + 3]); w.z = pg8::cvt_pk_bf16(sc[8 * sI + 4], sc[8 * sI + 5]); w.w = pg8::cvt_pk_bf16(sc[8 * sI + 6], sc[8 * sI + 7]);
                o = __builtin_amdgcn_mfma_f32_32x32x16_bf16(__builtin_bit_cast(bf16x8, w), tr_frag<true>(L + HG_VT, 320, 16 * sI, wid * 32, lane), o, 0, 0, 0); }
        }
#pragma unroll
        for (int i = 0; i < 2; ++i) { const int id = 2 * wid + i, kt = id >> 2, vt = id & 3;
#pragma unroll
            for (int r = 0; r < 16; ++r) S[i][r] *= __expf(G[31 * 128 + kt * 32 + crow16(r, hi)]);
#pragma unroll
            for (int sI = 0; sI < 2; ++sI) S[i] = __builtin_amdgcn_mfma_f32_32x32x16_bf16(tr_frag<true>(L + HG_KE, 320, 16 * sI, kt * 32, lane), tr_frag<true>(L + HG_VT, 320, 16 * sI, vt * 32, lane), S[i], 0, 0, 0); }
        __syncthreads();
        if (FULL) {
            if (wid < 4) {
#pragma unroll
                for (int r = 0; r < 16; ++r) G[crow16(r, hi) * 128 + wid * 32 + r32] = o[r]; }
            __syncthreads();
            const f32x4 o0 = *(const LAS f32x4*)(G + tt * 128 + ch), o1 = *(const LAS f32x4*)(G + tt * 128 + ch + 4);
            float ss = (o0.x * o0.x + o0.y * o0.y) + (o0.z * o0.z + o0.w * o0.w) + (o1.x * o1.x + o1.y * o1.y) + (o1.z * o1.z + o1.w * o1.w);
            ss += __shfl_xor(ss, 1); ss += __shfl_xor(ss, 2); ss += __shfl_xor(ss, 4); ss += __shfl_xor(ss, 8);
            const float rn = rsqrtf(ss * (1.f / 128.f) + RMS_EPS);
            const float ov[8] = {o0.x, o0.y, o0.z, o0.w, o1.x, o1.y, o1.z, o1.w}; const unsigned gw[4] = {gq.x, gq.y, gq.z, gq.w};
            float y[8];
#pragma unroll
            for (int i = 0; i < 8; ++i) { const float gv = (i & 1) ? bfhi(gw[i >> 1]) : bflo(gw[i >> 1]); y[i] = ov[i] * rn * gn[i] * (gv * sigmoidf_(gv)); }
            v4u w; w.x = pk2(y[0], y[1]); w.y = pk2(y[2], y[3]); w.z = pk2(y[4], y[5]); w.w = pk2(y[6], y[7]);
            *(v4u*)(cat + row * 1536 + 512 + h * 128 + ch) = w;
            __syncthreads();
        }
    }
    if (!FULL) {
#pragma unroll
        for (int i = 0; i < 2; ++i) { const int id = 2 * wid + i, kt = id >> 2, vt = id & 3;
#pragma unroll
            for (int r = 0; r < 16; ++r) Lg[(size_t)u * 16384 + (kt * 32 + crow16(r, hi)) * 128 + vt * 32 + r32] = S[i][r]; }
        if (tid < 128) Dg[(size_t)u * 128 + tid] = __expf(dsum);
    }
}
template <bool FULL>
__device__ __forceinline__ void phase_hgrn(const Frame& F0, const bf16* proj, const float* lbl, int layer, const float* gnorm, float* Lg, float* Dg, bf16* cat) {
    const Frame F = fresh(F0);
    LAS unsigned char* L = (LAS unsigned char*)F.lds;
    for (int u = F.bid; u < 256; u += F.G) { hgrn_unit<FULL>(F, L, u, proj, lbl, layer, gnorm, Lg, Dg, cat); __syncthreads(); }
}

constexpr int H1_G = 0, H1_QD = 32768, H1_KD = H1_QD + 64 * 272, H1_KE = H1_KD + 64 * 272, H1_VT = H1_KE + 64 * 320, H1_SP = H1_VT + 64 * 320, H1_TOT = H1_SP + 128 * 320, H1_BO = H1_TOT + 2048, H1_LB = H1_BO + 512, H1_END = H1_LB + 512;
static_assert(H1_END <= LDS_SCRATCH, "hgrn pass 1 lds");
__device__ __forceinline__ void hgrn_pass1_unit(const Frame& F, LAS unsigned char* L, int u, const bf16* proj, const float* lbl, int layer, float* Lg, float* Dg, float* OL, bf16* Qb) {
    const int b = u >> 5, h = (u >> 3) & 3, blk = u & 7;
    const int lane = F.lane, r32 = lane & 31, hi = lane >> 5, wid = F.wave, tid = F.tid;
    const int tt = tid >> 3, cg = tid & 7, ch = cg * 16;
    LAS float* G = (LAS float*)(L + H1_G); LAS float* TOT = (LAS float*)(L + H1_TOT);
    LAS float* BO = (LAS float*)(L + H1_BO); LAS float* LB = (LAS float*)(L + H1_LB);
    if (tid < 128) { float lb = 0.f;
        if (layer > 0) { const float l0 = lbl[h * 128 + tid], l1 = lbl[512 + h * 128 + tid]; lb = 1.f / (1.f + __expf(l0 - l1)); }
        LB[tid] = lb; BO[tid] = 0.f; }
    __syncthreads();
    f32x16 S[2]; S[0] = (f32x16){}; S[1] = (f32x16){};
    const size_t rowb = (size_t)b * SEQ + blk * 256;
    const int tt2 = wid >> 2, vt = wid & 3;
    v4u nx[6];
    { const bf16* pr = proj + (rowb + tt) * NCOL + h * 128 + ch;
        nx[0] = *(const v4u*)(pr + C_HF); nx[1] = *(const v4u*)(pr + C_HF + 8); nx[2] = *(const v4u*)(pr + C_HQ); nx[3] = *(const v4u*)(pr + C_HQ + 8); nx[4] = *(const v4u*)(pr + C_HI); nx[5] = *(const v4u*)(pr + C_HI + 8); }
    for (int c = 0; c < 4; ++c) {
        const size_t row = rowb + c * 64 + tt;
        float kk[16], qa[16];
        {
            const v4u f0 = nx[0], f1 = nx[1], q0 = nx[2], q1 = nx[3], v0 = nx[4], v1 = nx[5];
            if (c < 3) { const bf16* pr = proj + (row + 64) * NCOL + h * 128 + ch;
                nx[0] = *(const v4u*)(pr + C_HF); nx[1] = *(const v4u*)(pr + C_HF + 8); nx[2] = *(const v4u*)(pr + C_HQ); nx[3] = *(const v4u*)(pr + C_HQ + 8); nx[4] = *(const v4u*)(pr + C_HI); nx[5] = *(const v4u*)(pr + C_HI + 8); }
            const unsigned fw[8] = {f0.x, f0.y, f0.z, f0.w, f1.x, f1.y, f1.z, f1.w}, qw[8] = {q0.x, q0.y, q0.z, q0.w, q1.x, q1.y, q1.z, q1.w};
            float gl[16], lbv[16];
#pragma unroll
            for (int i = 0; i < 4; ++i) { const f32x4 x = *(const LAS f32x4*)(LB + ch + 4 * i); lbv[4 * i] = x.x; lbv[4 * i + 1] = x.y; lbv[4 * i + 2] = x.z; lbv[4 * i + 3] = x.w; }
#pragma unroll
            for (int i = 0; i < 16; ++i) { const float fr = (i & 1) ? bfhi(fw[i >> 1]) : bflo(fw[i >> 1]); const float sig = sigmoidf_(fr);
                gl[i] = __logf(lbv[i] + (1.f - lbv[i]) * sig); kk[i] = (1.f - lbv[i]) * (1.f - sig);
                const float qv = (i & 1) ? bfhi(qw[i >> 1]) : bflo(qw[i >> 1]); qa[i] = qv * sigmoidf_(qv); }
#pragma unroll
            for (int i = 0; i < 4; ++i) *(LAS f32x4*)(G + tt * 128 + ch + 4 * i) = (f32x4){gl[4 * i], gl[4 * i + 1], gl[4 * i + 2], gl[4 * i + 3]};
            *(LAS v4u*)(L + H1_VT + tt * 320 + ch * 2) = v0; *(LAS v4u*)(L + H1_VT + tt * 320 + ch * 2 + 16) = v1;
        }
        __syncthreads();
        {
            const int k = tid & 127, part = tid >> 7; float a[16];
#pragma unroll
            for (int i = 0; i < 16; ++i) a[i] = G[(part * 16 + i) * 128 + k];
#pragma unroll
            for (int i = 1; i < 16; ++i) a[i] += a[i - 1];
            TOT[part * 128 + k] = a[15];
            __syncthreads();
            float pre = 0.f;
#pragma unroll
            for (int p = 0; p < 3; ++p) if (p < part) pre += TOT[p * 128 + k];
#pragma unroll
            for (int i = 0; i < 16; ++i) G[(part * 16 + i) * 128 + k] = a[i] + pre;
        }
        __syncthreads();
        {
#pragma unroll
            for (int hh = 0; hh < 2; ++hh) {
                float bb[8], bm[8], be[8], bo[8];
#pragma unroll
                for (int i = 0; i < 2; ++i) { const f32x4 x = *(const LAS f32x4*)(G + tt * 128 + ch + 8 * hh + 4 * i), y = *(const LAS f32x4*)(G + 31 * 128 + ch + 8 * hh + 4 * i), z = *(const LAS f32x4*)(G + 63 * 128 + ch + 8 * hh + 4 * i), o4 = *(const LAS f32x4*)(BO + ch + 8 * hh + 4 * i);
                    bb[4 * i] = x.x; bb[4 * i + 1] = x.y; bb[4 * i + 2] = x.z; bb[4 * i + 3] = x.w; bm[4 * i] = y.x; bm[4 * i + 1] = y.y; bm[4 * i + 2] = y.z; bm[4 * i + 3] = y.w; be[4 * i] = z.x; be[4 * i + 1] = z.y; be[4 * i + 2] = z.z; be[4 * i + 3] = z.w;
                    bo[4 * i] = o4.x; bo[4 * i + 1] = o4.y; bo[4 * i + 2] = o4.z; bo[4 * i + 3] = o4.w; }
                float t8[8]; v4u w;
#pragma unroll
                for (int i = 0; i < 8; ++i) t8[i] = kk[8 * hh + i] * __expf(be[i] - bb[i]);
                w.x = pk2(t8[0], t8[1]); w.y = pk2(t8[2], t8[3]); w.z = pk2(t8[4], t8[5]); w.w = pk2(t8[6], t8[7]); *(LAS v4u*)(L + H1_KE + tt * 320 + ch * 2 + 16 * hh) = w;
#pragma unroll
                for (int i = 0; i < 8; ++i) t8[i] = qa[8 * hh + i] * __expf(bb[i] - bm[i]);
                w.x = pk2(t8[0], t8[1]); w.y = pk2(t8[2], t8[3]); w.z = pk2(t8[4], t8[5]); w.w = pk2(t8[6], t8[7]); *(LAS v4u*)(L + H1_QD + tt * 272 + ch * 2 + 16 * hh) = w;
#pragma unroll
                for (int i = 0; i < 8; ++i) t8[i] = kk[8 * hh + i] * __expf(bm[i] - bb[i]);
                w.x = pk2(t8[0], t8[1]); w.y = pk2(t8[2], t8[3]); w.z = pk2(t8[4], t8[5]); w.w = pk2(t8[6], t8[7]); *(LAS v4u*)(L + H1_KD + tt * 272 + ch * 2 + 16 * hh) = w;
#pragma unroll
                for (int i = 0; i < 8; ++i) t8[i] = qa[8 * hh + i] * __expf(bo[i] + bb[i]);
                w.x = pk2(t8[0], t8[1]); w.y = pk2(t8[2], t8[3]); w.z = pk2(t8[4], t8[5]); w.w = pk2(t8[6], t8[7]); *(v4u*)(Qb + row * 512 + h * 128 + ch + 8 * hh) = w;
                __builtin_amdgcn_sched_barrier(0);
            }
#pragma unroll
            for (int i = 0; i < 2; ++i) { const int id = 2 * wid + i, kt = id >> 2, v2 = id & 3;
#pragma unroll
                for (int r = 0; r < 16; ++r) { const int k = kt * 32 + crow16(r, hi); *(LAS bf16*)(L + H1_SP + k * 320 + (v2 * 32 + r32) * 2) = (bf16)f2bf(S[i][r] * __expf(G[31 * 128 + k])); } }
        }
        __syncthreads();
        {
            if (tid < 128) BO[tid] += G[63 * 128 + tid];
            f32x16 o = {};
            bf16x8 qf[8];
#pragma unroll
            for (int k0 = 0; k0 < 8; ++k0) qf[k0] = *(const LAS bf16x8*)(L + H1_QD + (tt2 * 32 + r32) * 272 + (k0 * 16 + 8 * hi) * 2);
#pragma unroll
            for (int k0 = 0; k0 < 8; ++k0) o = __builtin_amdgcn_mfma_f32_32x32x16_bf16(qf[k0], tr_frag<false>(L + H1_SP, 320, k0 * 16, vt * 32, lane), o, 0, 0, 0);
#pragma unroll
            for (int sg = 0; sg < 2; ++sg) if (sg <= tt2) {
                f32x16 sc = {};
#pragma unroll
                for (int k0 = 0; k0 < 8; ++k0) { const bf16x8 kf = *(const LAS bf16x8*)(L + H1_KD + (sg * 32 + r32) * 272 + (k0 * 16 + 8 * hi) * 2); sc = __builtin_amdgcn_mfma_f32_32x32x16_bf16(kf, qf[k0], sc, 0, 0, 0); }
                if (sg == tt2) {
#pragma unroll
                    for (int r = 0; r < 16; ++r) sc[r] = (crow16(r, hi) <= r32) ? sc[r] : 0.f; }
#pragma unroll
                for (int sI = 0; sI < 2; ++sI) { v4u w; w.x = pg8::cvt_pk_bf16(sc[8 * sI + 0], sc[8 * sI + 1]); w.y = pg8::cvt_pk_bf16(sc[8 * sI + 2], sc[8 * sI + 3]); w.z = pg8::cvt_pk_bf16(sc[8 * sI + 4], sc[8 * sI + 5]); w.w = pg8::cvt_pk_bf16(sc[8 * sI + 6], sc[8 * sI + 7]);
                    o = __builtin_amdgcn_mfma_f32_32x32x16_bf16(__builtin_bit_cast(bf16x8, w), tr_frag<true>(L + H1_VT, 320, sg * 32 + 16 * sI, vt * 32, lane), o, 0, 0, 0); }
            }
            float* po = OL + (rowb + c * 64 + tt2 * 32) * 512 + h * 128 + vt * 32 + r32;
#pragma unroll
            for (int r = 0; r < 16; ++r) po[(size_t)crow16(r, hi) * 512] = o[r];
#pragma unroll
            for (int i = 0; i < 2; ++i) { const int id = 2 * wid + i, kt = id >> 2, v2 = id & 3;
#pragma unroll
                for (int r = 0; r < 16; ++r) S[i][r] *= __expf(G[63 * 128 + kt * 32 + crow16(r, hi)]);
#pragma unroll
                for (int s4 = 0; s4 < 4; ++s4) S[i] = __builtin_amdgcn_mfma_f32_32x32x16_bf16(tr_frag<true>(L + H1_KE, 320, 16 * s4, kt * 32, lane), tr_frag<true>(L + H1_VT, 320, 16 * s4, v2 * 32, lane), S[i], 0, 0, 0); }
        }
        __syncthreads();
    }
#pragma unroll
    for (int i = 0; i < 2; ++i) { const int id = 2 * wid + i, kt = id >> 2, v2 = id & 3;
#pragma unroll
        for (int r = 0; r < 16; ++r) Lg[(size_t)u * 16384 + (kt * 32 + crow16(r, hi)) * 128 + v2 * 32 + r32] = S[i][r]; }
    if (tid < 128) Dg[(size_t)u * 128 + tid] = __expf(BO[tid]);
}
constexpr int H2_SL = 0, H2_OB = 128 * 320, H2_END = H2_OB + 128 * 128 * 4;
__device__ __forceinline__ void hgrn_pass2_unit(const Frame& F, LAS unsigned char* L, int u, const bf16* proj, const float* gnorm, const float* Lg, const float* Dg, const float* OL, const bf16* Qb, bf16* cat, int dry) {
    const int b = u >> 5, h = (u >> 3) & 3, blk = u & 7;
    const int lane = F.lane, r32 = lane & 31, hi = lane >> 5, wid = F.wave, tid = F.tid;
    const size_t rowb = (size_t)b * SEQ + blk * 256;
    LAS float* OB = (LAS float*)(L + H2_OB);
    if (blk > 0 && dry != 1) {
#pragma unroll 1
        for (int jh = 0; jh < 4; ++jh) {
            f32x4 l4[7][2]; float dd[7][2];
#pragma unroll
            for (int pb = 0; pb < 7; ++pb)
#pragma unroll
                for (int j = 0; j < 2; ++j) { const int e4 = tid + 512 * (2 * jh + j), k = e4 >> 5;
                    if (pb < blk) { dd[pb][j] = *(const float*)((const char*)(Dg + (size_t)(u - blk + pb) * 128) + (unsigned)k * 4u); l4[pb][j] = *(const f32x4*)((const char*)(Lg + (size_t)(u - blk + pb) * 16384) + (unsigned)e4 * 16u); }
                    else { dd[pb][j] = 0.f; l4[pb][j] = (f32x4){0.f, 0.f, 0.f, 0.f}; } }
#pragma unroll
            for (int j = 0; j < 2; ++j) { const int e4 = tid + 512 * (2 * jh + j), k = e4 >> 5, v4 = (e4 & 31) * 4; f32x4 S = {0.f, 0.f, 0.f, 0.f};
#pragma unroll
                for (int pb = 0; pb < 7; ++pb) if (pb < blk) S = S * dd[pb][j] + l4[pb][j];
                v2u w; w.x = pk2(S.x, S.y); w.y = pk2(S.z, S.w); *(LAS v2u*)(L + H2_SL + k * 320 + v4 * 2) = w; } } }
    __syncthreads();
    const int ttp = tid >> 2, cq = tid & 3, vt = wid & 3;
    float gn[32];
#pragma unroll
    for (int i = 0; i < 8; ++i) { const f32x4 g = *(const f32x4*)(gnorm + cq * 32 + 4 * i); gn[4 * i] = g.x; gn[4 * i + 1] = g.y; gn[4 * i + 2] = g.z; gn[4 * i + 3] = g.w; }
    for (int hf = 0; hf < 2; ++hf) {
        const size_t rowp = rowb + hf * 128 + ttp;
        v4u hg[4];
#pragma unroll
        for (int i = 0; i < 4; ++i) hg[i] = *(const v4u*)(proj + rowp * NCOL + C_HG + h * 128 + cq * 32 + 8 * i);
#pragma unroll
        for (int j = 0; j < 2; ++j) { const int tl = (wid >> 2) + 2 * j;
            const size_t trow = rowb + hf * 128 + tl * 32;
            f32x16 o = {};
            bf16x8 af[8]; float olv[16];
            const float* pl = OL + trow * 512 + h * 128 + vt * 32 + r32;
            if (blk > 0) {
#pragma unroll
                for (int k0 = 0; k0 < 8; ++k0) af[k0] = *(const bf16x8*)(Qb + (trow + r32) * 512 + h * 128 + k0 * 16 + 8 * hi); }
#pragma unroll
            for (int r = 0; r < 16; ++r) olv[r] = pl[(size_t)crow16(r, hi) * 512];
            __builtin_amdgcn_sched_barrier(0);
            if (blk > 0 && dry != 2) {
#pragma unroll
                for (int k0 = 0; k0 < 8; ++k0) o = __builtin_amdgcn_mfma_f32_32x32x16_bf16(af[k0], tr_frag<false>(L + H2_SL, 320, k0 * 16, vt * 32, lane), o, 0, 0, 0); }
#pragma unroll
            for (int r = 0; r < 16; ++r) { const int t = crow16(r, hi); OB[(tl * 32 + t) * 128 + vt * 32 + r32] = o[r] + olv[r]; } }
        __syncthreads();
        {
            float ov[32]; float ss = 0.f;
#pragma unroll
            for (int i = 0; i < 8; ++i) { const f32x4 x = *(const LAS f32x4*)(OB + ttp * 128 + cq * 32 + 4 * i); ov[4 * i] = x.x; ov[4 * i + 1] = x.y; ov[4 * i + 2] = x.z; ov[4 * i + 3] = x.w; ss += (x.x * x.x + x.y * x.y) + (x.z * x.z + x.w * x.w); }
            ss += __shfl_xor(ss, 1); ss += __shfl_xor(ss, 2);
            const float rn = rsqrtf(ss * (1.f / 128.f) + RMS_EPS);
#pragma unroll
            for (int i = 0; i < 4; ++i) { const unsigned gw[4] = {hg[i].x, hg[i].y, hg[i].z, hg[i].w}; float y[8];
#pragma unroll
                for (int e = 0; e < 8; ++e) { const float gv = (e & 1) ? bfhi(gw[e >> 1]) : bflo(gw[e >> 1]); y[e] = ov[8 * i + e] * rn * gn[8 * i + e] * (gv * sigmoidf_(gv)); }
                v4u w; w.x = pk2(y[0], y[1]); w.y = pk2(y[2], y[3]); w.z = pk2(y[4], y[5]); w.w = pk2(y[6], y[7]);
                *(v4u*)(cat + rowp * 1536 + 512 + h * 128 + cq * 32 + 8 * i) = w; }
        }
        __syncthreads();
    }
}
__device__ __forceinline__ void phase_hgrn1(const Frame& F0, const bf16* proj, const float* lbl, int layer, float* Lg, float* Dg, float* OL, bf16* Qb) {
    const Frame F = fresh(F0);
    LAS unsigned char* L = (LAS unsigned char*)F.lds;
    for (int u = F.bid; u < 256; u += F.G) { hgrn_pass1_unit(F, L, u, proj, lbl, layer, Lg, Dg, OL, Qb); __syncthreads(); }
}
__device__ __forceinline__ void phase_hgrn2(const Frame& F0, const bf16* proj, const float* gnorm, const float* Lg, const float* Dg, const float* OL, const bf16* Qb, bf16* cat, int dry) {
    const Frame F = fresh(F0);
    LAS unsigned char* L = (LAS unsigned char*)F.lds;
    for (int u = F.bid; u < 256; u += F.G) { hgrn_pass2_unit(F, L, u, proj, gnorm, Lg, Dg, OL, Qb, cat, dry); __syncthreads(); }
}

struct SchedDense {
    const char* A; const char* B; int nM, nN, G, c; size_t ta, tb;
    __device__ __forceinline__ bool next(int i, pg8::Unit& u) const {
        int pm, pn; if (!pg8::static_tile(nM, nN, (long)i * G + c, pm, pn)) return false;
        u.pm = pm; u.pn = pn; u.aux = 0; u.pad = 0; u.a = A + (size_t)pm * ta; u.b = B + (size_t)pn * tb; return true; }
};
struct SchedBranch {
    const char* A; const char* B; int G, c;
    __device__ __forceinline__ bool next(int i, pg8::Unit& u) const {
        int pm, pn; if (!pg8::static_tile(T / 256, DM / 256, (long)(i / 3) * G + c, pm, pn)) return false;
        const int seg = i % 3;
        u.pm = pm; u.pn = pn; u.aux = seg; u.pad = 0; u.a = A + ((size_t)pm * 256 * 1536 + seg * 512) * 2; u.b = B + ((size_t)seg * DM * 512 + (size_t)pn * 256 * 512) * 2; return true; }
};
struct SchedMoe {
    const char* A; const char* B; const unsigned* ntp; const unsigned* tile_e; int G, c; size_t ta, tb_e, tb_n;
    __device__ __forceinline__ bool next(int i, pg8::Unit& u) const {
        const int nt = (int)__builtin_amdgcn_readfirstlane(*ntp);
        const long L = (long)i * G + c; if (L >= (long)nt * 4) return false;
        const int tile = (int)(L >> 2), pn = (int)(L & 3); const int e = (int)__builtin_amdgcn_readfirstlane(tile_e[tile]);
        u.pm = tile; u.pn = pn; u.aux = e; u.pad = 0; u.a = A + (size_t)tile * ta; u.b = B + (size_t)e * tb_e + (size_t)pn * tb_n; return true; }
};

typedef pg8::f32x4 af4;
struct EpiStoreBf16 {
    static constexpr bool PERM = true;
    bf16* O; int ldc; int gate_col0; const float* bgate; v4u* GT;
    __device__ __forceinline__ bool operator()(af4 (&acc)[2][2][4][2], const pg8::Unit& u, int wr, int wc, int fr, int fq) const {
        const int row0 = u.pm * 256 + wr * 64 + fr, col0 = u.pn * 256 + wc * 32 + 8 * fq;
        const bool gate = (u.pn * 256 >= gate_col0);
#pragma unroll
        for (int bj = 0; bj < 2; ++bj) {
            af4 b0 = {0.f, 0.f, 0.f, 0.f}, b1 = {0.f, 0.f, 0.f, 0.f};
            if (gate) { b0 = *(const af4*)(bgate + col0 + bj * 128 - gate_col0); b1 = *(const af4*)(bgate + col0 + bj * 128 - gate_col0 + 4); }
#pragma unroll
            for (int ai = 0; ai < 2; ++ai)
#pragma unroll
                for (int m = 0; m < 4; ++m) { af4 v0 = acc[ai][bj][m][0], v1 = acc[ai][bj][m][1];
                    if (gate) {
#pragma unroll
                        for (int i = 0; i < 4; ++i) { v0[i] = __builtin_amdgcn_rcpf(1.f + __expf(-fminf(fmaxf(v0[i] + b0[i], -30.f), 30.f))); v1[i] = __builtin_amdgcn_rcpf(1.f + __expf(-fminf(fmaxf(v1[i] + b1[i], -30.f), 30.f))); } }
                    v4u w; w.x = pg8::cvt_pk_bf16(v0[0], v0[1]); w.y = pg8::cvt_pk_bf16(v0[2], v0[3]); w.z = pg8::cvt_pk_bf16(v1[0], v1[1]); w.w = pg8::cvt_pk_bf16(v1[2], v1[3]);
                    if (gate) { const int gt = u.pn - gate_col0 / 256;
                        GT[((((size_t)((gt >> 2) * 64 + u.pm) * 4 + (gt & 3)) * 8 + (wr * 4 + wc)) * 16 + (ai * 4 + m) * 2 + bj) * 64 + (fq * 16 + fr)] = w; }
                    else *(v4u*)(O + (size_t)(row0 + ai * 128 + m * 16) * ldc + col0 + bj * 128) = w; } }
        return true;
    }
};
struct EpiBranch {
    static constexpr bool PERM = true;
    const v4u* GT; bf16* merged;
    __device__ __forceinline__ bool operator()(af4 (&acc)[2][2][4][2], const pg8::Unit& u, int wr, int wc, int fr, int fq) const {
        const int seg = u.aux, row0 = u.pm * 256 + wr * 64 + fr, col0 = u.pn * 256 + wc * 32 + 8 * fq;
        const bool last = (seg == 2); const int sn = last ? seg : seg + 1;
#pragma unroll
        for (int bj = 0; bj < 2; ++bj) { const int col = col0 + bj * 128;
#pragma unroll
            for (int ai = 0; ai < 2; ++ai) { v4u gcv[4], gnv[4];
#pragma unroll
                for (int m = 0; m < 4; ++m) { const size_t row = (size_t)(row0 + ai * 128 + m * 16);
                    gcv[m] = GT[((((size_t)(seg * 64 + u.pm) * 4 + u.pn) * 8 + (wr * 4 + wc)) * 16 + (ai * 4 + m) * 2 + bj) * 64 + (fq * 16 + fr)];
                    gnv[m] = GT[((((size_t)(sn * 64 + u.pm) * 4 + u.pn) * 8 + (wr * 4 + wc)) * 16 + (ai * 4 + m) * 2 + bj) * 64 + (fq * 16 + fr)]; }
#pragma unroll
                for (int m = 0; m < 4; ++m) { const size_t row = (size_t)(row0 + ai * 128 + m * 16);
                    const unsigned gcw[4] = {gcv[m].x, gcv[m].y, gcv[m].z, gcv[m].w}, gnw[4] = {gnv[m].x, gnv[m].y, gnv[m].z, gnv[m].w};
                    float f[8];
#pragma unroll
                    for (int i = 0; i < 8; ++i) { const float gc = (i & 1) ? bfhi(gcw[i >> 1]) : bflo(gcw[i >> 1]), gn = (i & 1) ? bfhi(gnw[i >> 1]) : bflo(gnw[i >> 1]);
                        f[i] = last ? gc : gc * __builtin_amdgcn_rcpf(gn); }
                    af4& v0 = acc[ai][bj][m][0]; af4& v1 = acc[ai][bj][m][1];
                    v0[0] *= f[0]; v0[1] *= f[1]; v0[2] *= f[2]; v0[3] *= f[3]; v1[0] *= f[4]; v1[1] *= f[5]; v1[2] *= f[6]; v1[3] *= f[7];
                    if (last) { v4u w; w.x = pg8::cvt_pk_bf16(v0[0], v0[1]); w.y = pg8::cvt_pk_bf16(v0[2], v0[3]); w.z = pg8::cvt_pk_bf16(v1[0], v1[1]); w.w = pg8::cvt_pk_bf16(v1[2], v1[3]);
                        *(v4u*)(merged + row * DM + col) = w; } } } }
        return last;
    }
};
struct EpiResidual {
    static constexpr bool PERM = true;
    const float* xin32; const bf16* xin16; bf16* xout;
    __device__ __forceinline__ bool operator()(af4 (&acc)[2][2][4][2], const pg8::Unit& u, int wr, int wc, int fr, int fq) const {
        const int row0 = u.pm * 256 + wr * 64 + fr, col0 = u.pn * 256 + wc * 32 + 8 * fq;
#pragma unroll
        for (int ai = 0; ai < 2; ++ai)
#pragma unroll
            for (int mh = 0; mh < 2; ++mh) { af4 r[2][2][2];
#pragma unroll
                for (int mm = 0; mm < 2; ++mm) { const size_t off = (size_t)(row0 + ai * 128 + (mh * 2 + mm) * 16) * DM + col0;
#pragma unroll
                    for (int bj = 0; bj < 2; ++bj) {
                        if (xin32) { r[mm][bj][0] = *(const af4*)(xin32 + off + bj * 128); r[mm][bj][1] = *(const af4*)(xin32 + off + bj * 128 + 4); }
                        else { const v4u w = *(const v4u*)(xin16 + off + bj * 128); r[mm][bj][0] = (af4){bflo(w.x), bfhi(w.x), bflo(w.y), bfhi(w.y)}; r[mm][bj][1] = (af4){bflo(w.z), bfhi(w.z), bflo(w.w), bfhi(w.w)}; } } }
#pragma unroll
                for (int mm = 0; mm < 2; ++mm) { const size_t off = (size_t)(row0 + ai * 128 + (mh * 2 + mm) * 16) * DM + col0;
#pragma unroll
                    for (int bj = 0; bj < 2; ++bj) { const af4 v0 = r[mm][bj][0] + acc[ai][bj][mh * 2 + mm][0], v1 = r[mm][bj][1] + acc[ai][bj][mh * 2 + mm][1]; v4u w;
                        w.x = pg8::cvt_pk_bf16(v0[0], v0[1]); w.y = pg8::cvt_pk_bf16(v0[2], v0[3]); w.z = pg8::cvt_pk_bf16(v1[0], v1[1]); w.w = pg8::cvt_pk_bf16(v1[2], v1[3]);
                        *(v4u*)(xout + off + bj * 128) = w; } } }
        return true;
    }
};
struct EpiSwiglu {
    static constexpr bool PERM = true;
    bf16* act; const float* rrow;
    __device__ __forceinline__ bool operator()(af4 (&acc)[2][2][4][2], const pg8::Unit& u, int wr, int wc, int fr, int fq) const {
        const int row0 = u.pm * 256 + wr * 64 + fr, col0 = u.pn * 128 + wc * 32 + 8 * fq;
        float rs[2][4];
#pragma unroll
        for (int ai = 0; ai < 2; ++ai)
#pragma unroll
            for (int m = 0; m < 4; ++m) rs[ai][m] = rrow[row0 + ai * 128 + m * 16];
#pragma unroll
        for (int ai = 0; ai < 2; ++ai)
#pragma unroll
            for (int m = 0; m < 4; ++m) { const float rr = rs[ai][m]; const af4 g0 = acc[ai][0][m][0] * rr, g1 = acc[ai][0][m][1] * rr, u0 = acc[ai][1][m][0] * rr, u1 = acc[ai][1][m][1] * rr;
                float o[8];
#pragma unroll
                for (int i = 0; i < 4; ++i) { o[i] = g0[i] * sigmoidf_(g0[i]) * u0[i]; o[4 + i] = g1[i] * sigmoidf_(g1[i]) * u1[i]; }
                v4u w; w.x = pg8::cvt_pk_bf16(o[0], o[1]); w.y = pg8::cvt_pk_bf16(o[2], o[3]); w.z = pg8::cvt_pk_bf16(o[4], o[5]); w.w = pg8::cvt_pk_bf16(o[6], o[7]);
                *(v4u*)(act + (size_t)(row0 + ai * 128 + m * 16) * FF + col0) = w; }
        return true;
    }
};
struct EpiScaleRows {
    static constexpr bool PERM = true;
    bf16* ys; const float* wrow;
    __device__ __forceinline__ bool operator()(af4 (&acc)[2][2][4][2], const pg8::Unit& u, int wr, int wc, int fr, int fq) const {
        const int row0 = u.pm * 256 + wr * 64 + fr, col0 = u.pn * 256 + wc * 32 + 8 * fq;
        float sc[2][4];
#pragma unroll
        for (int ai = 0; ai < 2; ++ai)
#pragma unroll
            for (int m = 0; m < 4; ++m) sc[ai][m] = wrow[row0 + ai * 128 + m * 16];
#pragma unroll
        for (int ai = 0; ai < 2; ++ai)
#pragma unroll
            for (int m = 0; m < 4; ++m) { const int row = row0 + ai * 128 + m * 16; const float s = sc[ai][m]; bf16* rowp = ys + (size_t)row * DM + col0;
#pragma unroll
                for (int bj = 0; bj < 2; ++bj) { const af4 v0 = acc[ai][bj][m][0] * s, v1 = acc[ai][bj][m][1] * s; v4u w;
                    w.x = pg8::cvt_pk_bf16(v0[0], v0[1]); w.y = pg8::cvt_pk_bf16(v0[2], v0[3]); w.z = pg8::cvt_pk_bf16(v1[0], v1[1]); w.w = pg8::cvt_pk_bf16(v1[2], v1[3]);
                    *(v4u*)(rowp + bj * 128) = w; } }
        return true;
    }
};

constexpr int RW_PITCH = 1028;
__device__ __forceinline__ void phase_router(const Frame& F0, const float* x, const float* gain, const float* wco, const float* bco, const float* wfi, const float* bfi,
                                             bf16* hout, unsigned* route, unsigned* cnt, bool commit) {
    const Frame F = fresh(F0);
    float* WT = (float*)F.lds;
    { f32x4 wv[18];
#pragma unroll
        for (int i = 0; i < 2; ++i) wv[i] = *(const f32x4*)(wco + 4 * (F.tid + 512 * i));
#pragma unroll
        for (int i = 0; i < 16; ++i) wv[2 + i] = *(const f32x4*)(wfi + 4 * (F.tid + 512 * i));
#pragma unroll
        for (int i = 0; i < 2; ++i) { const int k = F.tid + 512 * i; WT[0 * RW_PITCH + k] = wv[i].x; WT[1 * RW_PITCH + k] = wv[i].y; WT[2 * RW_PITCH + k] = wv[i].z; WT[3 * RW_PITCH + k] = wv[i].w; }
#pragma unroll
        for (int i = 0; i < 16; ++i) { const int f = F.tid + 512 * i, k = f >> 3, e = (f & 7) * 4;
            WT[(4 + e) * RW_PITCH + k] = wv[2 + i].x; WT[(5 + e) * RW_PITCH + k] = wv[2 + i].y; WT[(6 + e) * RW_PITCH + k] = wv[2 + i].z; WT[(7 + e) * RW_PITCH + k] = wv[2 + i].w; } }
    __syncthreads();
    const int gw = F.bid * 8 + F.wave, NGW = F.G * 8;
    f32x4 g[4];
#pragma unroll
    for (int j = 0; j < 4; ++j) g[j] = *(const f32x4*)(gain + 4 * F.lane + 256 * j);
    f32x4 nv[2][4];
#pragma unroll
    for (int q = 0; q < 2; ++q) { const int m = gw + q * NGW; if (m < T) { const f32x4* xr = (const f32x4*)(x + (size_t)m * DM) + F.lane;
#pragma unroll
            for (int j = 0; j < 4; ++j) nv[q][j] = xr[64 * j]; } }
    for (int m0 = gw; m0 < T; m0 += 2 * NGW) {
        f32x4 v[2][4];
#pragma unroll
        for (int q = 0; q < 2; ++q)
#pragma unroll
            for (int j = 0; j < 4; ++j) v[q][j] = nv[q][j];
#pragma unroll
        for (int q = 0; q < 2; ++q) { const int m = m0 + 2 * NGW + q * NGW; if (m < T) { const f32x4* xr = (const f32x4*)(x + (size_t)m * DM) + F.lane;
#pragma unroll
                for (int j = 0; j < 4; ++j) nv[q][j] = xr[64 * j]; } }
#pragma unroll
        for (int q = 0; q < 2; ++q) { const int m = m0 + q * NGW; float s = 0.f;
#pragma unroll
            for (int j = 0; j < 4; ++j) s += (v[q][j].x * v[q][j].x + v[q][j].y * v[q][j].y) + (v[q][j].z * v[q][j].z + v[q][j].w * v[q][j].w);
            const float r = rsqrtf(wave_sum(s) * (1.f / DM) + RMS_EPS);
#pragma unroll
            for (int j = 0; j < 4; ++j) v[q][j] = v[q][j] * r * g[j];
            if (m < T) { v2u* o8 = (v2u*)(hout + (size_t)m * DM) + F.lane;
#pragma unroll
                for (int j = 0; j < 4; ++j) { v2u w; w.x = pk2(v[q][j].x, v[q][j].y); w.y = pk2(v[q][j].z, v[q][j].w); o8[64 * j] = w; } } }
        float lg[2][36];
#pragma unroll
        for (int c = 0; c < 36; ++c) { float pa = 0.f, pb = 0.f;
#pragma unroll
            for (int j = 0; j < 4; ++j) { const f32x4 w = *(const f32x4*)(WT + c * RW_PITCH + 4 * F.lane + 256 * j);
                pa += (v[0][j].x * w.x + v[0][j].y * w.y) + (v[0][j].z * w.z + v[0][j].w * w.w); pb += (v[1][j].x * w.x + v[1][j].y * w.y) + (v[1][j].z * w.z + v[1][j].w * w.w); }
            lg[0][c] = pa; lg[1][c] = pb; if ((c & 3) == 3) __builtin_amdgcn_sched_barrier(0); }
#pragma unroll
        for (int c = 0; c < 36; ++c) { lg[0][c] = wave_sum(lg[0][c]); lg[1][c] = wave_sum(lg[1][c]); }
#pragma unroll
        for (int q = 0; q < 2; ++q) { const int m = m0 + q * NGW;
            float c0 = lg[q][0] + bco[0], c1 = lg[q][1] + bco[1], c2 = lg[q][2] + bco[2], c3 = lg[q][3] + bco[3];
            int grp = 0; float cm = c0;
            if (c1 > cm) { cm = c1; grp = 1; } if (c2 > cm) { cm = c2; grp = 2; } if (c3 > cm) { cm = c3; grp = 3; }
            const float ptop = 1.f / (__expf(c0 - cm) + __expf(c1 - cm) + __expf(c2 - cm) + __expf(c3 - cm));
            float fs[8];
#pragma unroll
            for (int i = 0; i < 8; ++i) { float a = lg[q][4 + i] + bfi[i], b = lg[q][12 + i] + bfi[8 + i], c = lg[q][20 + i] + bfi[16 + i], d = lg[q][28 + i] + bfi[24 + i]; fs[i] = grp == 0 ? a : (grp == 1 ? b : (grp == 2 ? c : d)); }
            int i1 = 0; float v1 = fs[0];
#pragma unroll
            for (int i = 1; i < 8; ++i) if (fs[i] > v1) { v1 = fs[i]; i1 = i; }
            int i2 = -1; float v2 = -3.0e38f;
#pragma unroll
            for (int i = 0; i < 8; ++i) if (i != i1 && fs[i] > v2) { v2 = fs[i]; i2 = i; }
            const float e2 = __expf(v2 - v1), w1 = ptop / (1.f + e2), w2 = ptop * e2 / (1.f + e2);
            if (F.lane == 0 && commit && m < T) {
                const int ea = grp * 8 + i1, eb = grp * 8 + i2;
                const unsigned ra = __hip_atomic_fetch_add(cnt + 64 * ea, 1u, RLX_AGENT), rb = __hip_atomic_fetch_add(cnt + 64 * eb, 1u, RLX_AGENT);
                v4u o; o.x = (unsigned)ea; o.y = (unsigned)eb; o.z = ra; o.w = rb; *(v4u*)(route + (size_t)m * 8) = o;
                *(f32x2*)(route + (size_t)m * 8 + 4) = (f32x2){w1, w2};
            }
        }
    }
    __syncthreads();
}

constexpr int RT_PITCH = 2064, RT_HI = 0, RT_LO = 36 * RT_PITCH, RT_END = 72 * RT_PITCH;
static_assert(RT_END + 4096 <= LDS_SCRATCH, "router lds");
__device__ __forceinline__ void phase_router2(const Frame& F0, const bf16* x, const float* gain, const float* wco, const float* bco, const float* wfi, const float* bfi,
                                              bf16* hout, unsigned* route, unsigned* cnt, float* LG, bool commit) {
    const Frame F = fresh(F0);
    LAS unsigned char* L = (LAS unsigned char*)F.lds;
    {
        f32x4 wv[18];
#pragma unroll
        for (int i = 0; i < 2; ++i) wv[i] = *(const f32x4*)(wco + 4 * (F.tid + 512 * i));
#pragma unroll
        for (int i = 0; i < 16; ++i) wv[2 + i] = *(const f32x4*)(wfi + 4 * (F.tid + 512 * i));
#pragma unroll
        for (int i = 0; i < 18; ++i) { int k, c0; if (i < 2) { k = F.tid + 512 * i; c0 = 32; } else { const int f = F.tid + 512 * (i - 2); k = f >> 3; c0 = (f & 7) * 4; }
            const float w4[4] = {wv[i].x, wv[i].y, wv[i].z, wv[i].w};
#pragma unroll
            for (int e = 0; e < 4; ++e) { const unsigned hi = f2bf(w4[e]); const unsigned lo = f2bf(w4[e] - __uint_as_float(hi << 16));
                *(LAS bf16*)(L + RT_HI + (c0 + e) * RT_PITCH + k * 2) = (bf16)hi; *(LAS bf16*)(L + RT_LO + (c0 + e) * RT_PITCH + k * 2) = (bf16)lo; } }
    }
    LAS float* GL = (LAS float*)(L + RT_END);
    GL[F.tid] = gain[F.tid]; GL[F.tid + 512] = gain[F.tid + 512];
    __syncthreads();
    if (F.wave < 4) {
        const int lane = F.lane, rl = lane & 15, kg = lane >> 4;
        for (int tile = F.wave * F.G + F.bid; tile < T / 16; tile += 4 * F.G) {
            const size_t row = (size_t)tile * 16 + rl;
            const bf16* xr = x + row * DM + 8 * kg;
            pg8::f32x4 acc[3]; acc[0] = (pg8::f32x4){0.f, 0.f, 0.f, 0.f}; acc[1] = acc[0]; acc[2] = acc[0];
            float ss = 0.f;
            const int bro[3] = {rl * RT_PITCH + 16 * kg, (16 + rl) * RT_PITCH + 16 * kg, (32 + (rl & 3)) * RT_PITCH + 16 * kg};
            v4u xa[8];
#pragma unroll
            for (int q = 0; q < 8; ++q) xa[q] = *(const v4u*)(xr + 32 * q);
            for (int s0 = 0; s0 < 32; s0 += 8) {
                v4u xn[8];
                if (s0 + 8 < 32) {
#pragma unroll
                    for (int q = 0; q < 8; ++q) xn[q] = *(const v4u*)(xr + 32 * (s0 + 8 + q)); }
#pragma unroll
                for (int q = 0; q < 8; ++q) { const int s = s0 + q;
                    const f32x4 g0 = *(const LAS f32x4*)(GL + 32 * s + 8 * kg), g1 = *(const LAS f32x4*)(GL + 32 * s + 8 * kg + 4);
                    const float xv[8] = {bflo(xa[q].x), bfhi(xa[q].x), bflo(xa[q].y), bfhi(xa[q].y), bflo(xa[q].z), bfhi(xa[q].z), bflo(xa[q].w), bfhi(xa[q].w)};
                    ss += (xv[0] * xv[0] + xv[1] * xv[1]) + (xv[2] * xv[2] + xv[3] * xv[3]) + (xv[4] * xv[4] + xv[5] * xv[5]) + (xv[6] * xv[6] + xv[7] * xv[7]);
                    const float y[8] = {xv[0] * g0.x, xv[1] * g0.y, xv[2] * g0.z, xv[3] * g0.w, xv[4] * g1.x, xv[5] * g1.y, xv[6] * g1.z, xv[7] * g1.w};
                    unsigned hb[8], lb[8];
#pragma unroll
                    for (int e = 0; e < 8; ++e) { hb[e] = f2bf(y[e]); lb[e] = f2bf(y[e] - __uint_as_float(hb[e] << 16)); }
                    v4u ah, al; ah.x = hb[0] | (hb[1] << 16); ah.y = hb[2] | (hb[3] << 16); ah.z = hb[4] | (hb[5] << 16); ah.w = hb[6] | (hb[7] << 16);
                    al.x = lb[0] | (lb[1] << 16); al.y = lb[2] | (lb[3] << 16); al.z = lb[4] | (lb[5] << 16); al.w = lb[6] | (lb[7] << 16);
                    *(v4u*)(hout + row * DM + 32 * s + 8 * kg) = ah;
                    const bf16x8 Ah = __builtin_bit_cast(bf16x8, ah), Al = __builtin_bit_cast(bf16x8, al);
#pragma unroll
                    for (int ct = 0; ct < 3; ++ct) { const bf16x8 Bh = *(const LAS bf16x8*)(L + RT_HI + bro[ct] + 64 * s), Bl = *(const LAS bf16x8*)(L + RT_LO + bro[ct] + 64 * s);
                        acc[ct] = __builtin_amdgcn_mfma_f32_16x16x32_bf16(Ah, Bh, acc[ct], 0, 0, 0);
                        acc[ct] = __builtin_amdgcn_mfma_f32_16x16x32_bf16(Ah, Bl, acc[ct], 0, 0, 0);
                        acc[ct] = __builtin_amdgcn_mfma_f32_16x16x32_bf16(Al, Bh, acc[ct], 0, 0, 0); } }
#pragma unroll
                for (int q = 0; q < 8; ++q) xa[q] = xn[q];
            }
            ss += __shfl_xor(ss, 16); ss += __shfl_xor(ss, 32);
            const float r = rsqrtf(ss * (1.f / DM) + RMS_EPS);
#pragma unroll
            for (int ct = 0; ct < 3; ++ct)
#pragma unroll
                for (int rg = 0; rg < 4; ++rg) LG[((size_t)tile * 16 + 4 * kg + rg) * 48 + ct * 16 + rl] = acc[ct][rg];
            asm volatile("s_waitcnt vmcnt(0)" ::: "memory");
            if (lane < 16) {
                const size_t m = (size_t)tile * 16 + lane;
                float lg[36];
#pragma unroll
                for (int c = 0; c < 36; ++c) lg[c] = r * __uint_as_float(__hip_atomic_load((const unsigned*)(LG + m * 48 + c), RLX_AGENT));
                float c0 = lg[32] + bco[0], c1 = lg[33] + bco[1], c2 = lg[34] + bco[2], c3 = lg[35] + bco[3];
                int grp = 0; float cm = c0;
                if (c1 > cm) { cm = c1; grp = 1; } if (c2 > cm) { cm = c2; grp = 2; } if (c3 > cm) { cm = c3; grp = 3; }
                const float ptop = 1.f / (__expf(c0 - cm) + __expf(c1 - cm) + __expf(c2 - cm) + __expf(c3 - cm));
                float fs[8];
#pragma unroll
                for (int i = 0; i < 8; ++i) { float a = lg[i] + bfi[i], b = lg[8 + i] + bfi[8 + i], c = lg[16 + i] + bfi[16 + i], d = lg[24 + i] + bfi[24 + i]; fs[i] = grp == 0 ? a : (grp == 1 ? b : (grp == 2 ? c : d)); }
                int i1 = 0; float v1 = fs[0];
#pragma unroll
                for (int i = 1; i < 8; ++i) if (fs[i] > v1) { v1 = fs[i]; i1 = i; }
                int i2 = -1; float v2 = -3.0e38f;
#pragma unroll
                for (int i = 0; i < 8; ++i) if (i != i1 && fs[i] > v2) { v2 = fs[i]; i2 = i; }
                const float e2 = __expf(v2 - v1), w1 = ptop / (1.f + e2), w2 = ptop * e2 / (1.f + e2);
                if (commit) {
                    const int ea = grp * 8 + i1, eb = grp * 8 + i2;
                    const unsigned ra = __hip_atomic_fetch_add(cnt + 64 * ea, 1u, RLX_AGENT), rb = __hip_atomic_fetch_add(cnt + 64 * eb, 1u, RLX_AGENT);
                    v4u o; o.x = (unsigned)ea; o.y = (unsigned)eb; o.z = ra; o.w = rb; *(v4u*)(route + m * 8) = o;
                    *(f32x4*)(route + m * 8 + 4) = (f32x4){w1, w2, r, 0.f};
                }
            }
        }
    }
    __syncthreads();
}

__device__ __forceinline__ void phase_scatter(const Frame& F0, const bf16* hin, const unsigned* route, const unsigned* cnt, unsigned* ntp, unsigned* tile_e, bf16* hs, float* wrow, float* rrow, unsigned* pos) {
    const Frame F = fresh(F0);
    unsigned* off = (unsigned*)F.lds;
    if (F.tid == 0) { unsigned o = 0;
        for (int e = 0; e < NEXP; ++e) { off[e] = o; const unsigned c = __hip_atomic_load(cnt + 64 * e, RLX_AGENT); const unsigned p = (c + 255u) & ~255u;
            if (F.bid == 0) for (unsigned tI = o >> 8; tI < ((o + p) >> 8); ++tI) tile_e[tI] = (unsigned)e;
            o += p; }
        off[NEXP] = o; if (F.bid == 0) *ntp = o >> 8; }
    __syncthreads();
    const int gw = F.bid * 8 + F.wave, NGW = F.G * 8;
    for (int m0 = gw; m0 < T; m0 += 4 * NGW) {
        v4u ri[4], a[4], b[4]; f32x4 ww[4];
#pragma unroll
        for (int q = 0; q < 4; ++q) { const int m = m0 + q * NGW; if (m < T) { ri[q] = *(const v4u*)(route + (size_t)m * 8); ww[q] = *(const f32x4*)(route + (size_t)m * 8 + 4);
                const v4u* src = (const v4u*)(hin + (size_t)m * DM) + F.lane; a[q] = src[0]; b[q] = src[64]; } }
#pragma unroll
        for (int q = 0; q < 4; ++q) { const int m = m0 + q * NGW; if (m < T) {
                const unsigned d0 = off[ri[q].x] + ri[q].z, d1 = off[ri[q].y] + ri[q].w;
                v4u* p0 = (v4u*)(hs + (size_t)d0 * DM) + F.lane; v4u* p1 = (v4u*)(hs + (size_t)d1 * DM) + F.lane;
                p0[0] = a[q]; p0[64] = b[q]; p1[0] = a[q]; p1[64] = b[q];
                if (F.lane == 0) { wrow[d0] = ww[q].x; wrow[d1] = ww[q].y; rrow[d0] = ww[q].z; rrow[d1] = ww[q].z; *(v2u*)(pos + (size_t)m * 2) = (v2u){d0, d1}; } } }
    }
    __syncthreads();
}

__device__ __forceinline__ void phase_combine(const Frame& F0, const bf16* x, bf16* xdst16, float* xdst32, const bf16* ys, const unsigned* pos, const float* ngain, bf16* hout) {
    const Frame F = fresh(F0);
    const int gw = F.bid * 8 + F.wave, NGW = F.G * 8;
    f32x4 g[4];
#pragma unroll
    for (int j = 0; j < 4; ++j) g[j] = ngain ? *(const f32x4*)(ngain + 4 * F.lane + 256 * j) : (f32x4){0.f, 0.f, 0.f, 0.f};
    for (int m0 = gw; m0 < T; m0 += 2 * NGW) {
        v2u pp[2];
#pragma unroll
        for (int q = 0; q < 2; ++q) { const int m = m0 + q * NGW; pp[q] = (m < T) ? *(const v2u*)(pos + (size_t)m * 2) : (v2u){0u, 0u}; }
        v2u xv[2][4], ya[2][4], yb[2][4];
#pragma unroll
        for (int q = 0; q < 2; ++q) { const int m = m0 + q * NGW; if (m < T) {
                const v2u* xr = (const v2u*)(x + (size_t)m * DM) + F.lane; const v2u* y0 = (const v2u*)(ys + (size_t)pp[q].x * DM) + F.lane; const v2u* y1 = (const v2u*)(ys + (size_t)pp[q].y * DM) + F.lane;
#pragma unroll
                for (int j = 0; j < 4; ++j) { xv[q][j] = xr[64 * j]; ya[q][j] = y0[64 * j]; yb[q][j] = y1[64 * j]; } } }
#pragma unroll
        for (int q = 0; q < 2; ++q) { const int m = m0 + q * NGW; if (m < T) {
                float s = 0.f; f32x4 v[4];
#pragma unroll
                for (int j = 0; j < 4; ++j) { const v2u c = xv[q][j], a = ya[q][j], b = yb[q][j]; f32x4 t;
                    t.x = bflo(c.x) + bflo(a.x) + bflo(b.x); t.y = bfhi(c.x) + bfhi(a.x) + bfhi(b.x); t.z = bflo(c.y) + bflo(a.y) + bflo(b.y); t.w = bfhi(c.y) + bfhi(a.y) + bfhi(b.y);
                    v[j] = t; s += (t.x * t.x + t.y * t.y) + (t.z * t.z + t.w * t.w); }
                if (xdst32) { f32x4* xw = (f32x4*)(xdst32 + (size_t)m * DM) + F.lane;
#pragma unroll
                    for (int j = 0; j < 4; ++j) xw[64 * j] = v[j]; }
                else { v2u* xw = (v2u*)(xdst16 + (size_t)m * DM) + F.lane;
#pragma unroll
                    for (int j = 0; j < 4; ++j) { v2u w; w.x = pk2(v[j].x, v[j].y); w.y = pk2(v[j].z, v[j].w); xw[64 * j] = w; } }
                if (ngain) {
                    const float r = rsqrtf(wave_sum(s) * (1.f / DM) + RMS_EPS);
                    v2u* o8 = (v2u*)(hout + (size_t)m * DM) + F.lane;
#pragma unroll
                    for (int j = 0; j < 4; ++j) { v2u w; w.x = pk2(v[j].x * r * g[j].x, v[j].y * r * g[j].y); w.y = pk2(v[j].z * r * g[j].z, v[j].w * r * g[j].w); o8[64 * j] = w; }
                } } }
    }
}

constexpr int PH_PER_LAYER = 11, N_PHASES = 1 + DEPTH * PH_PER_LAYER;
__device__ __forceinline__ CArgs& kargs() { CArgs* p = (CArgs*)__builtin_amdgcn_kernarg_segment_ptr(); asm volatile("" : "+s"(p)); return *p; }
__global__ void __launch_bounds__(512, 2) mk_fwd(Args args_unused) {
    extern __shared__ __attribute__((aligned(16))) unsigned char lds[];
    LAS unsigned char* lds3 = (LAS unsigned char*)lds;
    const int wave_s = __builtin_amdgcn_readfirstlane(threadIdx.x >> 6);
    for (int u = threadIdx.x; u < (LDS_BYTES - LDSCTL_OFF) / 4; u += 512) ((LAS unsigned*)(lds3 + LDSCTL_OFF))[u] = 0u;
    __syncthreads();
#if MK_SPLIT
#define GRID_BAR() do { } while (0)
#else
    (void)xcd_barrier_post((unsigned*)(kargs().ws + WS_CTL) + CW_BAR, (volatile LAS unsigned*)(lds3 + LDSCTL_OFF));
#define GRID_BAR() do { XcdBarrier b_; b_.bar = (unsigned*)(kargs().ws + WS_CTL) + CW_BAR; b_.x = xb_xcc_id(); b_.st = (volatile LAS unsigned*)(lds3 + LDSCTL_OFF); xcd_barrier(b_); } while (0)
#endif
#define IN(k) (kargs().ph_lo <= (k) && (k) < kargs().ph_hi)
#define SEAM(k) do { if (IN(k) && IN((k) + 1)) GRID_BAR(); } while (0)
#define FRAME() CArgs& A = kargs(); Frame F; F.lds = lds; F.lane = lane_id_asm(); { int w_ = wave_s; asm volatile("" : "+s"(w_)); F.wave = w_; } F.tid = F.wave * 64 + F.lane; { int g_ = gridDim.x, b_ = blockIdx.x; asm volatile("" : "+s"(g_), "+s"(b_)); F.G = g_; F.bid = b_; } \
    unsigned char* ws = A.ws; F.ws = ws; F.ctl = (unsigned*)(ws + WS_CTL); (void)F;
#define WSP(T_, off) ((T_*)(ws + (off)))

#ifdef EXTRA_BARS
    for (int eb_ = 0; eb_ < EXTRA_BARS; ++eb_) GRID_BAR();
#endif
    if (IN(0) && PHON(11)) { for (int rep_ = 0; rep_ < REPN(11); ++rep_) { if (rep_) GRID_BAR(); { FRAME(); phase_prologue(F, A); }
        { FRAME(); phase_norm(F, A.in[I_X], A.in[I_MIXG], WSP(bf16, WS_H)); } } }
    SEAM(0);
#pragma unroll 1
    for (int l = 0; l < DEPTH; ++l) {
        const int p0 = 1 + l * PH_PER_LAYER;
        if (IN(p0 + 1) && PHON(1)) { for (int rep_ = 0; rep_ < REPN(1); ++rep_) { if (rep_) GRID_BAR(); { FRAME();
            pg8::Gemm g{DM, DM, DM};
            SchedDense S{(const char*)(ws + WS_H), (const char*)(ws + WS_WIN) + (size_t)l * NCOL * DM * 2, T / 256, NCOL / 256, F.G, F.bid, (size_t)256 * DM * 2, (size_t)256 * DM * 2};
            EpiStoreBf16 E{WSP(bf16, WS_PROJ), NCOL, C_GL, A.in[I_BGATE] + l * 3 * DM, WSP(v4u, WS_GT)};
            pg8::gemm_phase<EpiStoreBf16, SchedDense, true, true>(lds3, g, S, E, F.tid);
        } } }
        SEAM(p0 + 1);
        if (IN(p0 + 2) && PHON(2)) { for (int rep_ = 0; rep_ < REPN(2); ++rep_) { if (rep_) GRID_BAR(); {
            for (int r2_ = 0; r2_ < REPN(14); ++r2_) { FRAME(); phase_qkprep(F, WSP(bf16, WS_PROJ), A.in[I_QG] + l * 64, A.in[I_KG] + l * 64, WSP(bf16, WS_Q), WSP(bf16, WS_K), WSP(float, WS_KMEAN)); }
            for (int r2_ = 0; r2_ < REPN(15); ++r2_) { FRAME(); phase_conv(F, WSP(bf16, WS_PROJ), A.in[I_CONVW] + (size_t)l * 31 * 512, A.in[I_CONVB] + l * 512, A.in[I_CLNG] + l * 512, A.in[I_CLNB] + l * 512, WSP(bf16, WS_CAT)); }
            for (int r2_ = 0; r2_ < REPN(16); ++r2_) { FRAME(); phase_hgrn1(F, WSP(bf16, WS_PROJ), A.in[I_LBL], l, WSP(float, WS_HS), WSP(float, WS_HS + 16 * MiB), WSP(float, WS_ORAW), WSP(bf16, WS_HS + 17 * MiB)); }
        } } }
        SEAM(p0 + 2);
        if (IN(p0 + 3) && PHON(3)) { for (int rep_ = 0; rep_ < REPN(3); ++rep_) { if (rep_) GRID_BAR(); {
            for (int r2_ = 0; r2_ < REPN(12); ++r2_) { FRAME(); phase_attn_mfma(F, WSP(bf16, WS_Q), WSP(bf16, WS_K), WSP(bf16, WS_PROJ), WSP(float, WS_KMEAN), WSP(bf16, WS_CAT)); }
            for (int r2_ = 0; r2_ < REPN(13); ++r2_) { FRAME(); phase_hgrn2(F, WSP(bf16, WS_PROJ), A.in[I_HGG] + l * 128, WSP(float, WS_HS), WSP(float, WS_HS + 16 * MiB), WSP(float, WS_ORAW), WSP(bf16, WS_HS + 17 * MiB), WSP(bf16, WS_CAT), (r2_ + 1 < REPN(13)) ? PROBE_DRY : 0); }
        } } }
        SEAM(p0 + 3);
        if (IN(p0 + 4) && PHON(4)) { for (int rep_ = 0; rep_ < REPN(4); ++rep_) { if (rep_) GRID_BAR(); { FRAME();
            pg8::Gemm g{1536, 512, 512};
            SchedBranch S{(const char*)(ws + WS_CAT), (const char*)(ws + WS_WCAT) + (size_t)l * 3 * DM * 512 * 2, F.G, F.bid};
            EpiBranch E{WSP(const v4u, WS_GT), WSP(bf16, WS_MERGED)};
            pg8::gemm_phase<EpiBranch, SchedBranch, true, true>(lds3, g, S, E, F.tid);
        } } }
        SEAM(p0 + 4);
        if (IN(p0 + 5) && PHON(5)) { for (int rep_ = 0; rep_ < REPN(5); ++rep_) { if (rep_) GRID_BAR(); { FRAME();
            pg8::Gemm g{DM, DM, DM};
            SchedDense S{(const char*)(ws + WS_MERGED), (const char*)(ws + WS_WOUT) + (size_t)l * DM * DM * 2, T / 256, DM / 256, F.G, F.bid, (size_t)256 * DM * 2, (size_t)256 * DM * 2};
            EpiResidual E{(l == 0) ? A.in[I_X] : (const float*)nullptr, (l == 0) ? (const bf16*)nullptr : WSP(const bf16, WS_XB), (rep_ + 1 >= REPN(5)) ? WSP(bf16, WS_XB) : WSP(bf16, WS_HS)};
            pg8::gemm_phase<EpiResidual, SchedDense, true, true>(lds3, g, S, E, F.tid);
        } } }
        SEAM(p0 + 5);
        if (IN(p0 + 6) && PHON(6)) { for (int rep_ = 0; rep_ < REPN(6); ++rep_) { if (rep_) GRID_BAR(); { FRAME(); phase_router2(F, WSP(const bf16, WS_XB), A.in[I_FFNG] + l * DM, A.in[I_WCO] + (size_t)l * DM * 4, A.in[I_BCO] + l * 4, A.in[I_WFI] + (size_t)l * DM * 32, A.in[I_BFI] + l * 32, WSP(bf16, WS_H), WSP(unsigned, WS_ROUTE), F.ctl + CW_CNT + l * 32 * 64, WSP(float, WS_Q), rep_ + 1 >= REPN(6)); } } }
        SEAM(p0 + 6);
        if (IN(p0 + 7) && PHON(7)) { for (int rep_ = 0; rep_ < REPN(7); ++rep_) { if (rep_) GRID_BAR(); { FRAME(); phase_scatter(F, WSP(bf16, WS_H), WSP(unsigned, WS_ROUTE), F.ctl + CW_CNT + l * 32 * 64, F.ctl + CW_NT + l * 64, F.ctl + CW_TILE + l * 256, WSP(bf16, WS_HS), WSP(float, WS_POS + 512 * 1024), WSP(float, WS_POS + 768 * 1024), WSP(unsigned, WS_POS)); } } }
        SEAM(p0 + 7);
        if (IN(p0 + 8) && PHON(8)) { for (int rep_ = 0; rep_ < REPN(8); ++rep_) { if (rep_) GRID_BAR(); { FRAME();
            pg8::Gemm g{DM, DM, DM};
            SchedMoe S{(const char*)(ws + WS_HS), (const char*)(ws + WS_WEI) + (size_t)l * NEXP * 1024 * DM * 2, F.ctl + CW_NT + l * 64, F.ctl + CW_TILE + l * 256, F.G, F.bid, (size_t)256 * DM * 2, (size_t)1024 * DM * 2, (size_t)256 * DM * 2};
            EpiSwiglu E{WSP(bf16, WS_ACT), WSP(float, WS_POS + 768 * 1024)};
            pg8::gemm_phase<EpiSwiglu, SchedMoe, true, true>(lds3, g, S, E, F.tid);
        } } }
        SEAM(p0 + 8);
        if (IN(p0 + 9) && PHON(9)) { for (int rep_ = 0; rep_ < REPN(9); ++rep_) { if (rep_) GRID_BAR(); { FRAME();
            pg8::Gemm g{FF, FF, FF};
            SchedMoe S{(const char*)(ws + WS_ACT), (const char*)(ws + WS_WEO) + (size_t)l * NEXP * DM * FF * 2, F.ctl + CW_NT + l * 64, F.ctl + CW_TILE + l * 256, F.G, F.bid, (size_t)256 * FF * 2, (size_t)DM * FF * 2, (size_t)256 * FF * 2};
            EpiScaleRows E{WSP(bf16, WS_YS), WSP(float, WS_POS + 512 * 1024)};
            pg8::gemm_phase<EpiScaleRows, SchedMoe, true, true>(lds3, g, S, E, F.tid);
        } } }
        SEAM(p0 + 9);
        if (IN(p0 + 10) && PHON(10)) { for (int rep_ = 0; rep_ < REPN(10); ++rep_) { if (rep_) GRID_BAR(); { FRAME(); const bool real_ = (rep_ + 1 >= REPN(10)), lastl_ = (l + 1 >= DEPTH); phase_combine(F, WSP(const bf16, WS_XB), (real_ && !lastl_) ? WSP(bf16, WS_XB) : WSP(bf16, WS_HS), (real_ && lastl_) ? A.out : (float*)nullptr, WSP(bf16, WS_YS), WSP(unsigned, WS_POS), lastl_ ? (const float*)nullptr : A.in[I_MIXG] + (l + 1) * DM, WSP(bf16, WS_H)); } } }
        SEAM(p0 + 10);
    }
#undef IN
#undef SEAM
#undef FRAME
#undef WSP
}

extern "C" void kernel_launch(void* const* d_in, const int* in_sizes, int n_in, void* d_out, int out_size, void* d_ws, size_t ws_size, hipStream_t stream) {
    static int grid = 0;
    if (grid == 0) {
        if (n_in != 23 || out_size != T * DM || ws_size < WS_END) { fprintf(stderr, "kernel_launch: unexpected shapes (n_in %d out %d ws %zu)\n", n_in, out_size, ws_size); grid = -1; return; }
        int dev = 0, cus = 0, per_cu = 0;
        if (hipGetDevice(&dev) != hipSuccess || hipDeviceGetAttribute(&cus, hipDeviceAttributeMultiprocessorCount, dev) != hipSuccess) { grid = -1; return; }
        if (hipFuncSetAttribute((const void*)mk_fwd, hipFuncAttributeMaxDynamicSharedMemorySize, LDS_BYTES) != hipSuccess) { fprintf(stderr, "kernel_launch: hipFuncSetAttribute failed\n"); grid = -1; return; }
        if (hipOccupancyMaxActiveBlocksPerMultiprocessor(&per_cu, (const void*)mk_fwd, 512, LDS_BYTES) != hipSuccess || per_cu < 1) fprintf(stderr, "kernel_launch: occupancy query says %d\n", per_cu);
        (void)hipGetLastError();
        grid = cus;
    }
    if (grid < 0) return;
    (void)hipMemsetAsync((char*)d_ws + WS_CTL, 0, CTL_ZERO_BYTES, stream);
    Args a{};
    for (int i = 0; i < 23; ++i) a.in[i] = (const float*)d_in[i];
    a.out = (float*)d_out; a.ws = (unsigned char*)d_ws;
#if MK_SPLIT
    for (int p = 0; p < N_PHASES; ++p) {
        if (p == 1 + PH_PER_LAYER) continue;
        a.ph_lo = p; a.ph_hi = p + 1;
        hipLaunchKernelGGL(mk_fwd, dim3(grid), dim3(512), LDS_BYTES, stream, a);
    }
#else
    a.ph_lo = 0; a.ph_hi = N_PHASES;
    hipLaunchKernelGGL(mk_fwd, dim3(grid), dim3(512), LDS_BYTES, stream, a);
#endif
}
```

```cpp
#include <hip/hip_runtime.h>
#include <cstdio>
#include <cstdint>

#ifndef MK_SPLIT
#define MK_SPLIT 0
#endif
#ifndef DBG_MASK
#define DBG_MASK 0xFFFFu
#endif
#define PHON(j) (((DBG_MASK) >> (j)) & 1u)
#ifndef REP_MASK
#define REP_MASK 0u
#endif
#ifndef REP_EXTRA
#define REP_EXTRA 1
#endif
#ifndef PROBE_DRY
#define PROBE_DRY 0
#endif
#define REPN(j) ((((REP_MASK) >> (j)) & 1u) ? (1 + REP_EXTRA) : 1)

constexpr int DM = 1024, NB = 8, SEQ = 2048, T = NB * SEQ, DEPTH = 2;
constexpr int NCOL = 7680;
constexpr int C_AQ = 0, C_AK = 512, C_AV = 1024, C_HQ = 1536, C_HF = 2048, C_HI = 2560, C_HG = 3072, C_CA = 3584, C_CB = 4096, C_GL = 4608;
constexpr int NEXP = 32, FF = 512;
constexpr int MOE_ROWS = 2 * T + NEXP * 256;
constexpr float RMS_EPS = 1e-6f, LN_EPS = 1e-5f;
constexpr float QSCALE = 0.125f * 1.4426950408889634f;

namespace pg8 {
#define PG8_LAS __attribute__((address_space(3)))
typedef unsigned short bf16_t;
typedef short bf16x8 __attribute__((ext_vector_type(8)));
typedef float f32x4 __attribute__((ext_vector_type(4)));
typedef unsigned u32x4 __attribute__((ext_vector_type(4)));
constexpr int BM = 256, BK = 64, HALF = 128, HTB = HALF * BK * 2, STAGE_BYTES = 8 * HTB, NXCD = 8, WGM = 8;

__host__ __device__ __forceinline__ int lds_byte(int r, int c) { const int st = (r >> 4) * 2 + (c >> 5), rr = r & 15, cc = c & 31, ob = rr * 64 + cc * 2; return st * 1024 + (ob ^ (((ob >> 9) & 1) << 5)); }
__host__ __device__ __forceinline__ void stage_rc(int b, int& R, int& C) { const int st = b / 1024, sb = b % 1024, swz = sb ^ (((sb >> 9) & 1) << 5); R = (st >> 1) * 16 + swz / 64; C = (st & 1) * 32 + (swz % 64) / 2; }
__host__ __device__ __forceinline__ int perm32(int rho) { const int n = rho >> 4, i = rho & 15; return 8 * (i >> 2) + 4 * n + (i & 3); }

struct Unit { int pm, pn, aux, pad; const char* a; const char* b; };
struct Gemm { int lda, ldb, K; };

__device__ __forceinline__ bool static_tile(int nM, int nN, long L, int& pm, int& pn) {
    const int nwg = nM * nN; if (L >= nwg) return false;
    int wgid = (int)L; { const int q = nwg / NXCD, r = nwg % NXCD, xcd = wgid % NXCD, off = wgid / NXCD; wgid = (xcd < r ? xcd * (q + 1) : r * (q + 1) + (xcd - r) * q) + off; }
    const int nig = WGM * nN, gid = wgid / nig, fm = gid * WGM, gsz = (nM - fm) < WGM ? (nM - fm) : WGM;
    pm = fm + ((wgid % nig) % gsz); pn = (wgid % nig) / gsz; return true;
}

__device__ __forceinline__ unsigned cvt_pk_bf16(float lo, float hi) { unsigned r; asm volatile("v_cvt_pk_bf16_f32 %0, %1, %2" : "=v"(r) : "v"(lo), "v"(hi)); return r; }

template <class Epi, class Sched, bool ALIGN_EPI = false, bool SP2 = false>
__device__ __forceinline__ void gemm_phase(PG8_LAS unsigned char* lds, const Gemm g, const Sched& S, const Epi& E, int tid_in) {
    int tid_ = tid_in; asm volatile("" : "+v"(tid_));
    const int tid = tid_, wid = __builtin_amdgcn_readfirstlane(tid >> 6), lane = tid & 63, wr = wid >> 2, wc = wid & 3, fr = lane & 15, fq = lane >> 4;
    const int K = g.K, nt = K / BK;
    unsigned voffA[2], voffB[2];
#pragma unroll
    for (int i = 0; i < 2; ++i) { int R, C; stage_rc(tid * 16 + i * 8192, R, C); const int Rb = Epi::PERM ? ((R & ~31) + perm32(R & 31)) : R;
        voffA[i] = (unsigned)(R * g.lda + C) * 2u; voffB[i] = (unsigned)(Rb * g.ldb + C) * 2u; }
    const size_t kstep = (size_t)(BK * 2);
    const size_t hstepA = (size_t)HALF * g.lda * 2, hstepB = (size_t)HALF * g.ldb * 2;
    const unsigned ldsw = (unsigned)wid * 1024u;
    const int aoff = lds_byte(wr * 64 + fr, fq * 8), boff = lds_byte(wc * 32 + fr, fq * 8);
#define PG8_SA(b, h) (((b) * 2 + (h)) * HTB)
#define PG8_SB(b, h) ((4 + (b) * 2 + (h)) * HTB)
#define PG8_STAGE(bufoff, gbase, voff) do { _Pragma("unroll") for (int _i = 0; _i < 2; ++_i) \
        __builtin_amdgcn_global_load_lds((const unsigned*)((const char*)(gbase) + (voff)[_i]), (PG8_LAS unsigned*)(lds + (bufoff) + ldsw + _i * 8192), 16, 0, 0); } while (0)
#define PG8_LDA(dst, b, h) do { _Pragma("unroll") for (int m = 0; m < 4; ++m) _Pragma("unroll") for (int k = 0; k < 2; ++k) dst[m][k] = *(const PG8_LAS bf16x8*)(lds + PG8_SA(b, h) + aoff + m * 2048 + k * 1024); } while (0)
#define PG8_LDB(dst, b, h) do { _Pragma("unroll") for (int n = 0; n < 2; ++n) _Pragma("unroll") for (int k = 0; k < 2; ++k) dst[n][k] = *(const PG8_LAS bf16x8*)(lds + PG8_SB(b, h) + boff + n * 2048 + k * 1024); } while (0)
#define PG8_MMA(ai, bj, At, Bt) do { __builtin_amdgcn_s_setprio(1); _Pragma("unroll") for (int m = 0; m < 4; ++m) _Pragma("unroll") for (int n = 0; n < 2; ++n) _Pragma("unroll") for (int k = 0; k < 2; ++k) \
        acc[ai][bj][m][n] = __builtin_amdgcn_mfma_f32_16x16x32_bf16(Bt[n][k], At[m][k], acc[ai][bj][m][n], 0, 0, 0); __builtin_amdgcn_s_setprio(0); } while (0)
#define PG8_WAIT_V(n) asm volatile("s_waitcnt vmcnt(" #n ")" ::: "memory")
#define PG8_WAIT_L(n) asm volatile("s_waitcnt lgkmcnt(" #n ")" ::: "memory")
#define PG8_BAR __builtin_amdgcn_s_barrier()
#define PG8_SCHED __builtin_amdgcn_sched_barrier(0)
    Unit cur, nxt; int ui = 0;
    if (!S.next(0, cur)) return;
    f32x4 acc[2][2][4][2];
#pragma unroll
    for (int a = 0; a < 2; ++a)
#pragma unroll
        for (int b = 0; b < 2; ++b)
#pragma unroll
            for (int m = 0; m < 4; ++m)
#pragma unroll
                for (int n = 0; n < 2; ++n) acc[a][b][m][n] = (f32x4){0.f, 0.f, 0.f, 0.f};
    bf16x8 At[4][2], B0[2][2], B1[2][2];
    const char* cA = cur.a; const char* cB = cur.b;
    if constexpr (SP2) {
        PG8_STAGE(PG8_SB(0, 0), cB, voffB); PG8_STAGE(PG8_SB(0, 1), cB + hstepB, voffB); PG8_STAGE(PG8_SA(0, 0), cA, voffA); PG8_STAGE(PG8_SA(0, 1), cA + hstepA, voffA);
        if (wr == 1) PG8_BAR;
        PG8_WAIT_V(2); PG8_BAR;
        PG8_STAGE(PG8_SB(1, 0), cB + kstep, voffB); PG8_STAGE(PG8_SA(1, 0), cA + kstep, voffA); PG8_STAGE(PG8_SB(1, 1), cB + hstepB + kstep, voffB);
        PG8_WAIT_V(6); PG8_BAR;
    } else {
        PG8_STAGE(PG8_SB(0, 0), cB, voffB); PG8_STAGE(PG8_SA(0, 0), cA, voffA); PG8_STAGE(PG8_SB(0, 1), cB + hstepB, voffB); PG8_STAGE(PG8_SA(0, 1), cA + hstepA, voffA);
        if (wr == 1) PG8_BAR;
        PG8_WAIT_V(4); PG8_BAR;
        PG8_STAGE(PG8_SB(1, 0), cB + kstep, voffB); PG8_STAGE(PG8_SA(1, 0), cA + kstep, voffA); PG8_STAGE(PG8_SB(1, 1), cB + hstepB + kstep, voffB);
        PG8_WAIT_V(6); PG8_BAR;
    }
    for (;;) {
        const bool has_next = S.next(ui + 1, nxt);
        const char* nA = has_next ? nxt.a : cA; const char* nB = has_next ? nxt.b : cB;
        for (int t = 0; t < nt; t += 2) {
            const bool last = (t == nt - 2);
            const char* a1 = cA + (size_t)(t + 1) * kstep;
            const char* a2 = last ? nA : cA + (size_t)(t + 2) * kstep; const char* b2 = last ? nB : cB + (size_t)(t + 2) * kstep;
            const char* a3 = a2 + kstep; const char* b3 = b2 + kstep;
            if constexpr (SP2) {
            PG8_LDB(B0, 0, 0); PG8_LDB(B1, 0, 1); PG8_SCHED; PG8_LDA(At, 0, 0); PG8_STAGE(PG8_SA(1, 1), a1 + hstepA, voffA);
            PG8_WAIT_V(8); PG8_WAIT_L(0); PG8_BAR; PG8_MMA(0, 0, At, B0); PG8_MMA(0, 1, At, B1); PG8_BAR; PG8_SCHED;
            PG8_LDA(At, 0, 1); PG8_STAGE(PG8_SB(0, 0), b2, voffB); PG8_STAGE(PG8_SB(0, 1), b2 + hstepB, voffB); PG8_STAGE(PG8_SA(0, 0), a2, voffA);
            PG8_WAIT_V(8); PG8_WAIT_L(0); PG8_BAR; PG8_MMA(1, 0, At, B0); PG8_MMA(1, 1, At, B1); PG8_BAR; PG8_SCHED;
            PG8_LDB(B0, 1, 0); PG8_LDB(B1, 1, 1); PG8_SCHED; PG8_LDA(At, 1, 0); PG8_STAGE(PG8_SA(0, 1), a2 + hstepA, voffA);
            PG8_WAIT_V(8); PG8_WAIT_L(0); PG8_BAR; PG8_MMA(0, 0, At, B0); PG8_MMA(0, 1, At, B1); PG8_BAR; PG8_SCHED;
            PG8_LDA(At, 1, 1); PG8_STAGE(PG8_SB(1, 0), b3, voffB); PG8_STAGE(PG8_SB(1, 1), b3 + hstepB, voffB); PG8_STAGE(PG8_SA(1, 0), a3, voffA);
            PG8_WAIT_V(8); PG8_WAIT_L(0); PG8_BAR; PG8_MMA(1, 0, At, B0); PG8_MMA(1, 1, At, B1); PG8_BAR; PG8_SCHED;
            } else {
            PG8_LDB(B0, 0, 0); PG8_SCHED; PG8_LDA(At, 0, 0); PG8_STAGE(PG8_SA(1, 1), a1 + hstepA, voffA);
            PG8_WAIT_L(8); PG8_BAR; PG8_WAIT_L(0); PG8_MMA(0, 0, At, B0); PG8_BAR; PG8_SCHED;
            PG8_LDB(B1, 0, 1); PG8_STAGE(PG8_SB(0, 0), b2, voffB);
            PG8_BAR; PG8_WAIT_L(0); PG8_MMA(0, 1, At, B1); PG8_BAR;
            PG8_LDA(At, 0, 1); PG8_STAGE(PG8_SA(0, 0), a2, voffA);
            PG8_BAR; PG8_WAIT_L(0); PG8_MMA(1, 0, At, B0); PG8_BAR; PG8_SCHED;
            PG8_STAGE(PG8_SB(0, 1), b2 + hstepB, voffB);
            PG8_WAIT_V(6); PG8_BAR; PG8_MMA(1, 1, At, B1); PG8_BAR;
            PG8_LDB(B0, 1, 0); PG8_SCHED; PG8_LDA(At, 1, 0); PG8_STAGE(PG8_SA(0, 1), a2 + hstepA, voffA);
            PG8_WAIT_L(8); PG8_BAR; PG8_WAIT_L(0); PG8_MMA(0, 0, At, B0); PG8_BAR; PG8_SCHED;
            PG8_LDB(B1, 1, 1); PG8_STAGE(PG8_SB(1, 0), b3, voffB);
            PG8_BAR; PG8_WAIT_L(0); PG8_MMA(0, 1, At, B1); PG8_BAR;
            PG8_LDA(At, 1, 1); PG8_STAGE(PG8_SA(1, 0), a3, voffA);
            PG8_BAR; PG8_WAIT_L(0); PG8_MMA(1, 0, At, B0); PG8_BAR; PG8_SCHED;
            PG8_STAGE(PG8_SB(1, 1), b3 + hstepB, voffB);
            PG8_WAIT_V(6); PG8_BAR; PG8_MMA(1, 1, At, B1); PG8_BAR;
            }
        }
        if constexpr (ALIGN_EPI) { if (wr == 0) PG8_BAR; }
        const bool reset_acc = E(acc, cur, wr, wc, fr, fq);
        if (!has_next) break;
        if (reset_acc) {
#pragma unroll
        for (int a = 0; a < 2; ++a)
#pragma unroll
            for (int b = 0; b < 2; ++b)
#pragma unroll
                for (int m = 0; m < 4; ++m)
#pragma unroll
                    for (int n = 0; n < 2; ++n) acc[a][b][m][n] = (f32x4){0.f, 0.f, 0.f, 0.f};
        }
        cur = nxt; cA = nA; cB = nB; ++ui;
        if constexpr (ALIGN_EPI) { if (wr == 1) PG8_BAR; }
    }
    PG8_WAIT_V(0);
    if constexpr (!ALIGN_EPI) { if (wr == 0) PG8_BAR; }
    PG8_BAR;
#undef PG8_SA
#undef PG8_SB
#undef PG8_STAGE
#undef PG8_LDA
#undef PG8_LDB
#undef PG8_MMA
#undef PG8_WAIT_V
#undef PG8_WAIT_L
#undef PG8_BAR
#undef PG8_SCHED
}
}

constexpr size_t MiB = 1u << 20;
constexpr size_t WS_CTL = 0, CTL_ZERO_BYTES = 1 * MiB;
constexpr size_t WS_WIN = 2 * MiB;
constexpr size_t WS_WCAT = WS_WIN + 30 * MiB;
constexpr size_t WS_WOUT = WS_WCAT + 6 * MiB;
constexpr size_t WS_WEI = WS_WOUT + 4 * MiB;
constexpr size_t WS_WEO = WS_WEI + 128 * MiB;
constexpr size_t WS_H = WS_WEO + 64 * MiB;
constexpr size_t WS_PROJ = WS_H + 32 * MiB;
constexpr size_t WS_Q = WS_PROJ + 240 * MiB;
constexpr size_t WS_K = WS_Q + 16 * MiB;
constexpr size_t WS_KMEAN = WS_K + 16 * MiB;
constexpr size_t WS_CAT = WS_KMEAN + 1 * MiB;
constexpr size_t WS_MERGED = WS_CAT + 48 * MiB;
constexpr size_t WS_ORAW = WS_MERGED + 32 * MiB;
constexpr size_t WS_ROUTE = WS_ORAW + 32 * MiB;
constexpr size_t WS_POS = WS_ROUTE + 1 * MiB;
constexpr size_t WS_HS = WS_POS + 1 * MiB;
constexpr size_t WS_ACT = WS_HS + 80 * MiB;
constexpr size_t WS_YS = WS_ACT + 40 * MiB;
constexpr size_t WS_XB = WS_YS + 80 * MiB;
constexpr size_t WS_GT = WS_XB + 32 * MiB;
constexpr size_t WS_END = WS_GT + 96 * MiB;
static_assert(WS_END <= 1000 * MiB, "workspace map");
constexpr int CW_BAR = 4096;
constexpr int CW_CNT = 16384;
constexpr int CW_NT = CW_CNT + 2 * 32 * 64;
constexpr int CW_TILE = CW_NT + 2 * 64;
static_assert((CW_TILE + 2 * 256) * 4 <= (int)CTL_ZERO_BYTES, "ctl");

constexpr int LDS_SCRATCH = 155136, LDSCTL_OFF = LDS_SCRATCH, LDS_BYTES = 155648;

#define GAS __attribute__((address_space(1)))
#define LAS __attribute__((address_space(3)))
typedef unsigned short bf16;
typedef unsigned v4u __attribute__((ext_vector_type(4)));
typedef unsigned v2u __attribute__((ext_vector_type(2)));
typedef float f32x4 __attribute__((ext_vector_type(4)));
typedef float f32x2 __attribute__((ext_vector_type(2)));
#define RLX_AGENT __ATOMIC_RELAXED, __HIP_MEMORY_SCOPE_AGENT
__device__ __forceinline__ unsigned f2bf(float f) { unsigned u = __builtin_bit_cast(unsigned, f); return (u + 0x7fffu + ((u >> 16) & 1u)) >> 16; }
__device__ __forceinline__ unsigned pk2(float lo, float hi) { unsigned r; asm("v_cvt_pk_bf16_f32 %0, %1, %2" : "=v"(r) : "v"(lo), "v"(hi)); return r; }
__device__ __forceinline__ float bflo(unsigned w) { return __uint_as_float(w << 16); }
__device__ __forceinline__ float bfhi(unsigned w) { return __uint_as_float(w & 0xffff0000u); }
__device__ __forceinline__ float bf2f(bf16 v) { return __uint_as_float((unsigned)v << 16); }
__device__ __forceinline__ float sigmoidf_(float x) { return __builtin_amdgcn_rcpf(1.0f + __expf(-x)); }
__device__ __forceinline__ float wave_sum(float v) {
    v += __int_as_float(__builtin_amdgcn_update_dpp(0, __float_as_int(v), 0xB1, 0xf, 0xf, true));
    v += __int_as_float(__builtin_amdgcn_update_dpp(0, __float_as_int(v), 0x4E, 0xf, 0xf, true));
    v += __int_as_float(__builtin_amdgcn_update_dpp(0, __float_as_int(v), 0x141, 0xf, 0xf, true));
    v += __int_as_float(__builtin_amdgcn_update_dpp(0, __float_as_int(v), 0x140, 0xf, 0xf, true));
    { auto r = __builtin_amdgcn_permlane16_swap(__float_as_uint(v), __float_as_uint(v), false, false); v = __uint_as_float(r[0]) + __uint_as_float(r[1]); }
    { auto r = __builtin_amdgcn_permlane32_swap(__float_as_uint(v), __float_as_uint(v), false, false); v = __uint_as_float(r[0]) + __uint_as_float(r[1]); }
    return v;
}

__device__ __forceinline__ void lds_barrier() { asm volatile("s_waitcnt lgkmcnt(0)\n\ts_barrier" ::: "memory"); }

#define XB_TMO      128
#define XB_XCNT(j)  (256  + 64 * (j))
#define XB_XSUB(j)  (1280 + 64 * (j))
#define XB_XGEN(j)  (2304 + 64 * (j))
#define XB_TOP      3328
#define XB_TOPGEN   3392
#define XCD_BAR_WORDS 3456
#define XB_SPIN_CAP (1u << 18)
__device__ __forceinline__ unsigned xb_ld(unsigned* p)              { return __hip_atomic_load(p, __ATOMIC_RELAXED, __HIP_MEMORY_SCOPE_AGENT); }
__device__ __forceinline__ unsigned xb_add(unsigned* p, unsigned v) { return __hip_atomic_fetch_add(p, v, __ATOMIC_RELAXED, __HIP_MEMORY_SCOPE_AGENT); }
__device__ __forceinline__ unsigned xb_xcc_id() { return (unsigned)__builtin_amdgcn_s_getreg((3 << 11) | 20) & 0xFu; }
#define XB_SPIN(cond, bar) do { unsigned _sp = 0; while (cond) { __builtin_amdgcn_s_sleep(1); \
    if ((++_sp & 255u) == 0u) { if (xb_ld(&(bar)[XB_TMO])) break; if (_sp > XB_SPIN_CAP) { atomicAdd(&(bar)[XB_TMO], 1u); break; } } } } while (0)
struct XcdBarrier { unsigned* bar; unsigned x; volatile LAS unsigned* st; };
__device__ __forceinline__ XcdBarrier xcd_barrier_post(unsigned* bar, volatile LAS unsigned* st) {
    XcdBarrier b; b.bar = bar; b.x = xb_xcc_id(); b.st = st;
    if (threadIdx.x == 0) (void)xb_add(&bar[XB_XCNT(b.x)], 1u);
    return b;
}
__device__ __forceinline__ void xcd_barrier_complete(unsigned* bar, unsigned x, unsigned& nloc, unsigned& nx) {
    const unsigned G = gridDim.x * gridDim.y * gridDim.z;
    unsigned sum, cnt, mine, sp = 0u;
    for (;;) {
        sum = 0u; cnt = 0u; mine = 0u;
#pragma unroll
        for (unsigned j = 0; j < 16; ++j) { const unsigned c = xb_ld(&bar[XB_XCNT(j)]); sum += c; cnt += (c > 0u) ? 1u : 0u; mine = (j == x) ? c : mine; }
        if (sum == G) break;
        __builtin_amdgcn_s_sleep(1);
        if ((++sp & 255u) == 0u) { if (xb_ld(&bar[XB_TMO])) break; if (sp > XB_SPIN_CAP) { atomicAdd(&bar[XB_TMO], 1u); break; } }
    }
    nloc = mine > 0u ? mine : 1u; nx = cnt > 0u ? cnt : 1u;
}
__device__ __forceinline__ void xcd_barrier(const XcdBarrier& b) {
    asm volatile("s_waitcnt vmcnt(0)" ::: "memory");
    __syncthreads();
    if (threadIdx.x == 0) {
        unsigned* bar = b.bar;
        __builtin_amdgcn_s_waitcnt(0);
        unsigned nloc = b.st[0], nx = b.st[1];
        if (nloc == 0u) { xcd_barrier_complete(bar, b.x, nloc, nx); b.st[0] = nloc; b.st[1] = nx; }
        const unsigned old = xb_add(&bar[XB_XSUB(b.x)], 1u);
        const unsigned gen = old / nloc;
        if (old + 1u == (gen + 1u) * nloc) {
            __builtin_amdgcn_fence(__ATOMIC_RELEASE, "agent");
            asm volatile("s_waitcnt vmcnt(0)" ::: "memory");
            const unsigned og = xb_add(&bar[XB_TOP], 1u);
            const unsigned tg = og / nx;
            if (og + 1u == (tg + 1u) * nx) xb_add(&bar[XB_TOPGEN], 1u);
            else XB_SPIN(xb_ld(&bar[XB_TOPGEN]) == tg, bar);
            __builtin_amdgcn_fence(__ATOMIC_ACQUIRE, "agent");
            xb_add(&bar[XB_XGEN(b.x)], 1u);
            asm volatile("s_waitcnt vmcnt(0)" ::: "memory");
        } else {
            XB_SPIN(xb_ld(&bar[XB_XGEN(b.x)]) == gen, bar);
            __builtin_amdgcn_fence(__ATOMIC_ACQUIRE, "agent");
            asm volatile("s_waitcnt vmcnt(0)" ::: "memory");
        }
    }
    __syncthreads();
}

struct Args { const float* in[23]; float* out; unsigned char* ws; int ph_lo, ph_hi; };
typedef const Args __attribute__((address_space(4))) CArgs;
enum InIdx { I_X = 0, I_MIXG, I_WIN, I_BGATE, I_QG, I_KG, I_LBL, I_HGG, I_CONVW, I_CONVB, I_CLNG, I_CLNB, I_WATT, I_WHGRN, I_WCONV, I_WOUT, I_FFNG, I_WCO, I_BCO, I_WFI, I_BFI, I_WEI, I_WEO };

struct Frame {
    unsigned char* lds;
    int tid, lane, wave, G, bid;
    unsigned char* ws; unsigned* ctl;
};
__device__ __forceinline__ int lane_id_asm() { int l; asm volatile("v_mbcnt_lo_u32_b32 %0, -1, 0\n\tv_mbcnt_hi_u32_b32 %0, -1, %0" : "=v"(l)); return l; }
__device__ __forceinline__ Frame fresh(Frame F) { asm volatile("" : "+v"(F.tid)); F.lane = F.tid & 63; return F; }

struct TItem { const float* W; bf16* WT; int K, N, k0, n0, drow0; };
__device__ __forceinline__ void titem_load(const TItem& t, int lane, float (&v)[32]) {
#pragma unroll
    for (int i = 0; i < 32; ++i) { const int kk = 2 * i + (lane >> 5); v[i] = t.W[(size_t)(t.k0 + kk) * t.N + t.n0 + (lane & 31)]; }
}
__device__ __forceinline__ void titem_emit(const TItem& t, int lane, const float (&v)[32], float* scr) {
#pragma unroll
    for (int i = 0; i < 32; ++i) { const int kk = 2 * i + (lane >> 5); scr[kk * 33 + (lane & 31)] = v[i]; }
    asm volatile("s_waitcnt lgkmcnt(0)" ::: "memory");
    const int c = lane & 7;
#pragma unroll
    for (int j = 0; j < 4; ++j) { const int n = (lane >> 3) + 8 * j; const float* s = scr + (8 * c) * 33 + n;
        v4u o; o.x = pk2(s[0 * 33], s[1 * 33]); o.y = pk2(s[2 * 33], s[3 * 33]); o.z = pk2(s[4 * 33], s[5 * 33]); o.w = pk2(s[6 * 33], s[7 * 33]);
        *(v4u*)(t.WT + (size_t)(t.drow0 + n) * t.K + t.k0 + 8 * c) = o; }
    asm volatile("s_waitcnt lgkmcnt(0)" ::: "memory");
}
__device__ __forceinline__ TItem titem_decode(CArgs& A, unsigned char* ws, int it) {
    constexpr int I_IN = (DM / 64) * (NCOL / 32), I_BR = (512 / 64) * (DM / 32), I_OUT = (DM / 64) * (DM / 32), I_EI = (DM / 64) * (1024 / 32), I_EO = (FF / 64) * (DM / 32);
    constexpr int PER_L = I_IN + 3 * I_BR + I_OUT + NEXP * I_EI + NEXP * I_EO;
    TItem t; const int l = it / PER_L; int r = it % PER_L;
    if (r < I_IN) { const int nblk = NCOL / 32, kb = r / nblk, nb = r % nblk;
        t.W = A.in[I_WIN] + (size_t)l * DM * NCOL; t.K = DM; t.N = NCOL; t.WT = (bf16*)(ws + WS_WIN) + (size_t)l * NCOL * DM; t.k0 = 64 * kb; t.n0 = 32 * nb; t.drow0 = 32 * nb; return t; }
    r -= I_IN;
    if (r < 3 * I_BR) { const int br = r / I_BR, rr = r % I_BR, nblk = DM / 32, kb = rr / nblk, nb = rr % nblk;
        t.W = A.in[br == 0 ? I_WATT : (br == 1 ? I_WHGRN : I_WCONV)] + (size_t)l * 512 * DM; t.K = 512; t.N = DM; t.WT = (bf16*)(ws + WS_WCAT) + ((size_t)l * 3 + br) * DM * 512; t.k0 = 64 * kb; t.n0 = 32 * nb; t.drow0 = 32 * nb; return t; }
    r -= 3 * I_BR;
    if (r < I_OUT) { const int nblk = DM / 32, kb = r / nblk, nb = r % nblk;
        t.W = A.in[I_WOUT] + (size_t)l * DM * DM; t.K = DM; t.N = DM; t.WT = (bf16*)(ws + WS_WOUT) + (size_t)l * DM * DM; t.k0 = 64 * kb; t.n0 = 32 * nb; t.drow0 = 32 * nb; return t; }
    r -= I_OUT;
    if (r < NEXP * I_EI) { const int e = r / I_EI, rr = r % I_EI, nblk = 1024 / 32, kb = rr / nblk, nb = rr % nblk, n0 = 32 * nb;
        const int nn = n0 & 511;
        t.W = A.in[I_WEI] + ((size_t)l * NEXP + e) * DM * 1024; t.K = DM; t.N = 1024; t.WT = (bf16*)(ws + WS_WEI) + ((size_t)l * NEXP + e) * 1024 * DM; t.k0 = 64 * kb; t.n0 = n0; t.drow0 = (nn >> 7) * 256 + (n0 >= 512 ? 128 : 0) + (nn & 127); return t; }
    r -= NEXP * I_EI;
    { const int e = r / I_EO, rr = r % I_EO, nblk = DM / 32, kb = rr / nblk, nb = rr % nblk;
        t.W = A.in[I_WEO] + ((size_t)l * NEXP + e) * FF * DM; t.K = FF; t.N = DM; t.WT = (bf16*)(ws + WS_WEO) + ((size_t)l * NEXP + e) * DM * FF; t.k0 = 64 * kb; t.n0 = 32 * nb; t.drow0 = 32 * nb; return t; }
}
__device__ __forceinline__ void phase_prologue(const Frame& F0, CArgs& A) {
    const Frame F = fresh(F0);
    float* scr = (float*)(F.lds + F.wave * 16384);
    const int gw = F.bid * 8 + F.wave, NGW = F.G * 8;
    constexpr int I_IN = (DM / 64) * (NCOL / 32), I_BR = (512 / 64) * (DM / 32), I_OUT = (DM / 64) * (DM / 32), I_EI = (DM / 64) * (1024 / 32), I_EO = (FF / 64) * (DM / 32);
    constexpr int NIT = DEPTH * (I_IN + 3 * I_BR + I_OUT + NEXP * I_EI + NEXP * I_EO);
    if (gw >= NIT) return;
    float cur[32], nxt[32];
    TItem tc = titem_decode(A, F.ws, gw);
    titem_load(tc, F.lane, cur);
    for (int it = gw; it < NIT; it += NGW) {
        TItem tn = tc; const bool more = (it + NGW < NIT);
        if (more) { tn = titem_decode(A, F.ws, it + NGW); titem_load(tn, F.lane, nxt); }
        titem_emit(tc, F.lane, cur, scr);
        if (more) {
#pragma unroll
            for (int i = 0; i < 32; ++i) cur[i] = nxt[i];
            tc = tn; }
    }
}

__device__ __forceinline__ void phase_norm(const Frame& F0, const float* x, const float* gain, bf16* out) {
    const Frame F = fresh(F0);
    const int gw = F.bid * 8 + F.wave, NGW = F.G * 8;
    f32x4 g[4];
#pragma unroll
    for (int j = 0; j < 4; ++j) g[j] = *(const f32x4*)(gain + 4 * F.lane + 256 * j);
    for (int m0 = gw; m0 < T; m0 += 4 * NGW) {
        f32x4 v[4][4];
#pragma unroll
        for (int q = 0; q < 4; ++q) { const int m = m0 + q * NGW; if (m < T) { const f32x4* xr = (const f32x4*)(x + (size_t)m * DM) + F.lane;
#pragma unroll
                for (int j = 0; j < 4; ++j) v[q][j] = xr[64 * j]; } }
#pragma unroll
        for (int q = 0; q < 4; ++q) { const int m = m0 + q * NGW; if (m < T) { float s = 0.f;
#pragma unroll
                for (int j = 0; j < 4; ++j) s += (v[q][j].x * v[q][j].x + v[q][j].y * v[q][j].y) + (v[q][j].z * v[q][j].z + v[q][j].w * v[q][j].w);
                const float r = rsqrtf(wave_sum(s) * (1.f / DM) + RMS_EPS);
                v2u* o8 = (v2u*)(out + (size_t)m * DM) + F.lane;
#pragma unroll
                for (int j = 0; j < 4; ++j) { v2u w; w.x = pk2(v[q][j].x * r * g[j].x, v[q][j].y * r * g[j].y); w.y = pk2(v[q][j].z * r * g[j].z, v[q][j].w * r * g[j].w); o8[64 * j] = w; } } }
    }
}

__device__ __forceinline__ void phase_qkprep(const Frame& F0, const bf16* proj, const float* qg, const float* kg, bf16* Q, bf16* Kb, float* kmean) {
    const Frame F = fresh(F0);
    float* red = (float*)F.lds;
    float* red2 = red + 256 * 65;
    const int tok = F.tid >> 1, hf = F.tid & 1;
    float qgv[32], kgv[32];
#pragma unroll
    for (int i = 0; i < 8; ++i) { const f32x4 a = *(const f32x4*)(qg + hf * 32 + 4 * i), c = *(const f32x4*)(kg + hf * 32 + 4 * i);
        qgv[4 * i] = a.x; qgv[4 * i + 1] = a.y; qgv[4 * i + 2] = a.z; qgv[4 * i + 3] = a.w; kgv[4 * i] = c.x; kgv[4 * i + 1] = c.y; kgv[4 * i + 2] = c.z; kgv[4 * i + 3] = c.w; }
    for (int u = F.bid; u < 512; u += F.G) {
        const int b = u >> 6, blk = (u >> 3) & 7, h = u & 7;
        const size_t row = (size_t)b * SEQ + blk * 256 + tok;
        const bf16* pq = proj + row * NCOL + C_AQ + h * 64 + hf * 32;
        const bf16* pk = proj + row * NCOL + C_AK + h * 64 + hf * 32;
        float qv[32], kv[32];
#pragma unroll
        for (int i = 0; i < 4; ++i) { const v4u a = *(const v4u*)(pq + 8 * i), c = *(const v4u*)(pk + 8 * i);
            qv[8 * i + 0] = bflo(a.x); qv[8 * i + 1] = bfhi(a.x); qv[8 * i + 2] = bflo(a.y); qv[8 * i + 3] = bfhi(a.y); qv[8 * i + 4] = bflo(a.z); qv[8 * i + 5] = bfhi(a.z); qv[8 * i + 6] = bflo(a.w); qv[8 * i + 7] = bfhi(a.w);
            kv[8 * i + 0] = bflo(c.x); kv[8 * i + 1] = bfhi(c.x); kv[8 * i + 2] = bflo(c.y); kv[8 * i + 3] = bfhi(c.y); kv[8 * i + 4] = bflo(c.z); kv[8 * i + 5] = bfhi(c.z); kv[8 * i + 6] = bflo(c.w); kv[8 * i + 7] = bfhi(c.w); }
        float sq = 0.f, sk = 0.f;
#pragma unroll
        for (int i = 0; i < 32; ++i) { sq += qv[i] * qv[i]; sk += kv[i] * kv[i]; }
        sq += __shfl_xor(sq, 1); sk += __shfl_xor(sk, 1);
        const float rq = rsqrtf(sq * (1.f / 64.f) + RMS_EPS) * QSCALE, rk = rsqrtf(sk * (1.f / 64.f) + RMS_EPS);
#pragma unroll
        for (int i = 0; i < 32; ++i) { qv[i] = qv[i] * rq * qgv[i]; kv[i] = kv[i] * rk * kgv[i]; }
        bf16* oq = Q + row * 512 + h * 64 + hf * 32; bf16* ok = Kb + row * 512 + h * 64 + hf * 32;
#pragma unroll
        for (int i = 0; i < 4; ++i) { v4u a, c;
            a.x = pk2(qv[8 * i], qv[8 * i + 1]); a.y = pk2(qv[8 * i + 2], qv[8 * i + 3]); a.z = pk2(qv[8 * i + 4], qv[8 * i + 5]); a.w = pk2(qv[8 * i + 6], qv[8 * i + 7]);
            c.x = pk2(kv[8 * i], kv[8 * i + 1]); c.y = pk2(kv[8 * i + 2], kv[8 * i + 3]); c.z = pk2(kv[8 * i + 4], kv[8 * i + 5]); c.w = pk2(kv[8 * i + 6], kv[8 * i + 7]);
            *(v4u*)(oq + 8 * i) = a; *(v4u*)(ok + 8 * i) = c; }
        __syncthreads();
#pragma unroll
        for (int i = 0; i < 32; ++i) red[tok * 65 + hf * 32 + i] = kv[i];
        __syncthreads();
        { const int d = F.tid & 63, part = F.tid >> 6; float s = 0.f;
            for (int tk = 0; tk < 32; ++tk) s += red[(part * 32 + tk) * 65 + d];
            red2[part * 64 + d] = s; }
        __syncthreads();
        if (F.tid < 64) { float s = 0.f;
#pragma unroll
            for (int p = 0; p < 8; ++p) s += red2[p * 64 + F.tid];
            kmean[(((size_t)b * 8 + h) * 8 + blk) * 64 + F.tid] = s * (1.f / 256.f); }
    }
    __syncthreads();
}

__device__ __forceinline__ void phase_conv(const Frame& F0, const bf16* proj, const float* cw, const float* cb, const float* lng, const float* lnb, bf16* cat) {
    const Frame F = fresh(F0);
    float* ut = (float*)F.lds;
    const int c = F.tid;
    float w[31];
#pragma unroll
    for (int j = 0; j < 31; ++j) w[j] = cw[j * 512 + c];
    const float bias = cb[c];
    const f32x4 g0 = *(const f32x4*)(lng + 8 * F.lane), g1 = *(const f32x4*)(lng + 8 * F.lane + 4), b0 = *(const f32x4*)(lnb + 8 * F.lane), b1 = *(const f32x4*)(lnb + 8 * F.lane + 4);
    for (int u = F.bid; u < 512; u += F.G) {
        const int b = u >> 6, t0 = (u & 63) * 32;
        __syncthreads();
        {
            v4u av[8], gv[8];
#pragma unroll
            for (int i = 0; i < 8; ++i) { const int idx = F.tid + 512 * i, r = idx >> 6, ch = (idx & 63) * 8, t = t0 - 30 + r;
                if (r < 62 && t >= 0) { const bf16* p = proj + ((size_t)b * SEQ + t) * NCOL + ch; av[i] = *(const v4u*)(p + C_CA); gv[i] = *(const v4u*)(p + C_CB); }
                else { av[i] = (v4u){0u, 0u, 0u, 0u}; gv[i] = (v4u){0u, 0u, 0u, 0u}; } }
#pragma unroll
            for (int i = 0; i < 8; ++i) { const int idx = F.tid + 512 * i, r = idx >> 6, ch = (idx & 63) * 8;
                if (r < 62) {
                    f32x4 u0, u1;
                    u0.x = bflo(av[i].x) * sigmoidf_(bflo(gv[i].x)); u0.y = bfhi(av[i].x) * sigmoidf_(bfhi(gv[i].x)); u0.z = bflo(av[i].y) * sigmoidf_(bflo(gv[i].y)); u0.w = bfhi(av[i].y) * sigmoidf_(bfhi(gv[i].y));
                    u1.x = bflo(av[i].z) * sigmoidf_(bflo(gv[i].z)); u1.y = bfhi(av[i].z) * sigmoidf_(bfhi(gv[i].z)); u1.z = bflo(av[i].w) * sigmoidf_(bflo(gv[i].w)); u1.w = bfhi(av[i].w) * sigmoidf_(bfhi(gv[i].w));
                    *(f32x4*)(ut + r * 512 + ch) = u0; *(f32x4*)(ut + r * 512 + ch + 4) = u1; } }
        }
        __syncthreads();
        float uu[62];
#pragma unroll
        for (int i = 0; i < 62; ++i) uu[i] = ut[i * 512 + c];
#pragma unroll
        for (int t = 0; t < 32; ++t) { float a = bias;
#pragma unroll
            for (int j = 0; j < 31; ++j) a += w[j] * uu[t + j];
            ut[t * 512 + c] = a; }
        __syncthreads();
#pragma unroll
        for (int q = 0; q < 4; ++q) { const int t = F.wave * 4 + q;
            const f32x4 v0 = *(const f32x4*)(ut + t * 512 + 8 * F.lane), v1 = *(const f32x4*)(ut + t * 512 + 8 * F.lane + 4);
            const float mu = wave_sum((v0.x + v0.y) + (v0.z + v0.w) + (v1.x + v1.y) + (v1.z + v1.w)) * (1.f / 512.f);
            const f32x4 d0 = v0 - mu, d1 = v1 - mu;
            const float var = wave_sum((d0.x * d0.x + d0.y * d0.y) + (d0.z * d0.z + d0.w * d0.w) + (d1.x * d1.x + d1.y * d1.y) + (d1.z * d1.z + d1.w * d1.w)) * (1.f / 512.f);
            const float rs = rsqrtf(var + LN_EPS);
            f32x4 y0 = d0 * rs * g0 + b0, y1 = d1 * rs * g1 + b1;
            y0.x *= sigmoidf_(y0.x); y0.y *= sigmoidf_(y0.y); y0.z *= sigmoidf_(y0.z); y0.w *= sigmoidf_(y0.w);
            y1.x *= sigmoidf_(y1.x); y1.y *= sigmoidf_(y1.y); y1.z *= sigmoidf_(y1.z); y1.w *= sigmoidf_(y1.w);
            v4u o; o.x = pk2(y0.x, y0.y); o.y = pk2(y0.z, y0.w); o.z = pk2(y1.x, y1.y); o.w = pk2(y1.z, y1.w);
            *(v4u*)(cat + ((size_t)b * SEQ + t0 + t) * 1536 + 1024 + 8 * F.lane) = o; }
    }
    __syncthreads();
}

__device__ __forceinline__ void phase_hgrn_naive(const Frame& F0, const bf16* proj, const float* lbl, int layer, float* oraw) {
    const Frame F = fresh(F0);
    float* part = (float*)F.lds;
    const int k = F.tid & 127, vq = F.tid >> 7;
    for (int u = F.bid; u < 256; u += F.G) {
        const int b = u >> 5, h = (u >> 3) & 3, vs = u & 7;
        float lb = 0.f;
        if (layer > 0) { const float l0 = lbl[h * 128 + k], l1 = lbl[512 + h * 128 + k]; lb = 1.f / (1.f + __expf(l0 - l1)); }
        const float omlb = 1.f - lb;
        float S0 = 0.f, S1 = 0.f, S2 = 0.f, S3 = 0.f;
        const bf16* pq = proj + (size_t)b * SEQ * NCOL + C_HQ + h * 128 + k;
        const bf16* pf = proj + (size_t)b * SEQ * NCOL + C_HF + h * 128 + k;
        const bf16* pv = proj + (size_t)b * SEQ * NCOL + C_HI + h * 128 + vs * 16 + vq * 4;
        for (int t0 = 0; t0 < SEQ; t0 += 32) {
#pragma unroll 4
            for (int tt = 0; tt < 32; ++tt) {
                const size_t ro = (size_t)(t0 + tt) * NCOL;
                const float qv = bf2f(pq[ro]), fr = bf2f(pf[ro]); const v2u vv = *(const v2u*)(pv + ro);
                const float sig = sigmoidf_(fr), f = lb + omlb * sig, kk = omlb * (1.f - sig), qa = qv * sigmoidf_(qv);
                S0 = f * S0 + kk * bflo(vv.x); S1 = f * S1 + kk * bfhi(vv.x); S2 = f * S2 + kk * bflo(vv.y); S3 = f * S3 + kk * bfhi(vv.y);
                const float p0 = wave_sum(qa * S0), p1 = wave_sum(qa * S1), p2 = wave_sum(qa * S2), p3 = wave_sum(qa * S3);
                if (F.lane == 0) *(f32x4*)(part + (tt * 8 + F.wave) * 4) = (f32x4){p0, p1, p2, p3};
            }
            __syncthreads();
            if (F.tid < 128) { const int tt = F.tid >> 2, v2 = F.tid & 3;
                const f32x4 a = *(const f32x4*)(part + (tt * 8 + v2 * 2) * 4), c = *(const f32x4*)(part + (tt * 8 + v2 * 2 + 1) * 4);
                *(f32x4*)(oraw + ((size_t)b * SEQ + t0 + tt) * 512 + h * 128 + vs * 16 + v2 * 4) = a + c; }
            __syncthreads();
        }
    }
}

__device__ __forceinline__ void phase_hgrn_post(const Frame& F0, const float* oraw, const bf16* proj, const float* hgg, bf16* cat) {
    const Frame F = fresh(F0);
    const int gw = F.bid * 8 + F.wave, NGW = F.G * 8;
    const f32x2 g = *(const f32x2*)(hgg + 2 * F.lane);
    for (int it = gw; it < T * 4; it += NGW) {
        const int row = it >> 2, h = it & 3;
        const f32x2 o = *(const f32x2*)(oraw + (size_t)row * 512 + h * 128 + 2 * F.lane);
        const unsigned hw = *(const unsigned*)(proj + (size_t)row * NCOL + C_HG + h * 128 + 2 * F.lane);
        const float r = rsqrtf(wave_sum(o.x * o.x + o.y * o.y) * (1.f / 128.f) + RMS_EPS);
        const float g0 = bflo(hw), g1 = bfhi(hw);
        const float y0 = o.x * r * g.x * (g0 * sigmoidf_(g0)), y1 = o.y * r * g.y * (g1 * sigmoidf_(g1));
        *(unsigned*)(cat + (size_t)row * 1536 + 512 + h * 128 + 2 * F.lane) = pk2(y0, y1);
    }
}

__device__ __forceinline__ void attn_naive_unit(const Frame& F, int b, int h, int qb, const bf16* Q, const bf16* Kb, const bf16* proj, const float* kmean, bf16* cat) {
    float* Ks = (float*)F.lds;
    float* Vs = Ks + 64 * 64;
    const int qi = F.tid >> 1, half = F.tid & 1;
    const size_t row0 = (size_t)b * SEQ + qb * 256;
    float q[32];
    { const bf16* pq = Q + (row0 + qi) * 512 + h * 64 + half * 32;
#pragma unroll
        for (int i = 0; i < 4; ++i) { const v4u a = *(const v4u*)(pq + 8 * i);
            q[8 * i + 0] = bflo(a.x); q[8 * i + 1] = bfhi(a.x); q[8 * i + 2] = bflo(a.y); q[8 * i + 3] = bfhi(a.y); q[8 * i + 4] = bflo(a.z); q[8 * i + 5] = bfhi(a.z); q[8 * i + 6] = bflo(a.w); q[8 * i + 7] = bfhi(a.w); } }
    unsigned selmask;
    if (qb <= 3) selmask = (1u << qb) - 1u;
    else {
        float gate[7];
#pragma unroll
        for (int j = 0; j < 7; ++j) { gate[j] = -3.0e38f;
            if (j < qb) { const float* km = kmean + (((size_t)b * 8 + h) * 8 + j) * 64 + half * 32; float s = 0.f;
#pragma unroll
                for (int d = 0; d < 32; ++d) s += q[d] * km[d];
                s += __shfl_xor(s, 1);
                gate[j] = s; } }
        selmask = 0u;
#pragma unroll
        for (int r = 0; r < 3; ++r) { float best = -3.0e38f; int bi = 0;
#pragma unroll
            for (int j = 0; j < 7; ++j) { const bool ok = (j < qb) && !((selmask >> j) & 1u) && (gate[j] > best); if (ok) { best = gate[j]; bi = j; } }
            selmask |= 1u << bi; }
    }
    float acc[32];
#pragma unroll
    for (int d = 0; d < 32; ++d) acc[d] = 0.f;
    float l = 0.f;
    const int skey = F.tid >> 3, sseg = F.tid & 7;
    for (int j = 0; j <= qb; ++j) {
        for (int kt = 0; kt < 4; ++kt) {
            __syncthreads();
            { const size_t krow = (size_t)b * SEQ + j * 256 + kt * 64 + skey;
                const v4u kk = *(const v4u*)(Kb + krow * 512 + h * 64 + sseg * 8), vv = *(const v4u*)(proj + krow * NCOL + C_AV + h * 64 + sseg * 8);
                *(f32x4*)(Ks + skey * 64 + sseg * 8) = (f32x4){bflo(kk.x), bfhi(kk.x), bflo(kk.y), bfhi(kk.y)}; *(f32x4*)(Ks + skey * 64 + sseg * 8 + 4) = (f32x4){bflo(kk.z), bfhi(kk.z), bflo(kk.w), bfhi(kk.w)};
                *(f32x4*)(Vs + skey * 64 + sseg * 8) = (f32x4){bflo(vv.x), bfhi(vv.x), bflo(vv.y), bfhi(vv.y)}; *(f32x4*)(Vs + skey * 64 + sseg * 8 + 4) = (f32x4){bflo(vv.z), bfhi(vv.z), bflo(vv.w), bfhi(vv.w)}; }
            __syncthreads();
            if (j == qb && kt > (F.wave >> 1)) continue;
#pragma unroll 2
            for (int key = 0; key < 64; ++key) {
                float s = 0.f;
#pragma unroll
                for (int d = 0; d < 32; d += 4) { const f32x4 kx = *(const f32x4*)(Ks + key * 64 + half * 32 + d); s += q[d] * kx.x + q[d + 1] * kx.y + q[d + 2] * kx.z + q[d + 3] * kx.w; }
                s += __shfl_xor(s, 1);
                const bool valid = (j == qb) ? (kt * 64 + key <= qi) : (((selmask >> j) & 1u) != 0u);
                const float p = valid ? exp2f(s) : 0.f;
                l += p;
#pragma unroll
                for (int d = 0; d < 32; d += 4) { const f32x4 vx = *(const f32x4*)(Vs + key * 64 + half * 32 + d); acc[d] += p * vx.x; acc[d + 1] += p * vx.y; acc[d + 2] += p * vx.z; acc[d + 3] += p * vx.w; }
            }
        }
    }
    { const float rl = 1.f / l;
        bf16* po = cat + (row0 + qi) * 1536 + h * 64 + half * 32;
#pragma unroll
        for (int i = 0; i < 4; ++i) { v4u o; o.x = pk2(acc[8 * i] * rl, acc[8 * i + 1] * rl); o.y = pk2(acc[8 * i + 2] * rl, acc[8 * i + 3] * rl); o.z = pk2(acc[8 * i + 4] * rl, acc[8 * i + 5] * rl); o.w = pk2(acc[8 * i + 6] * rl, acc[8 * i + 7] * rl); *(v4u*)(po + 8 * i) = o; }
    }
}
__device__ __forceinline__ void phase_attn_naive(const Frame& F0, const bf16* Q, const bf16* Kb, const bf16* proj, const float* kmean, bf16* cat) {
    const Frame F = fresh(F0);
    for (int p = F.bid; p < 256; p += F.G) {
        const int bh = p >> 2, s = p & 3;
#pragma unroll 1
        for (int i = 0; i < 2; ++i) attn_naive_unit(F, bh >> 3, bh & 7, i ? s : 7 - s, Q, Kb, proj, kmean, cat);
    }
    __syncthreads();
}

typedef float f32x16 __attribute__((ext_vector_type(16)));
typedef short bf16x8 __attribute__((ext_vector_type(8)));
typedef short v4i16_t __attribute__((ext_vector_type(4)));
constexpr int AT_KROW = 144, AT_VROW = 192, AT_KBUF = 64 * AT_KROW, AT_VBUF = 64 * AT_VROW, AT_BUF = AT_KBUF + AT_VBUF;
constexpr int AT_WSF = 2 * AT_BUF, AT_STG = AT_WSF + 8 * 256, AT_LDS = AT_STG + 8 * 4096;
__device__ __forceinline__ int crow16(int r, int hi) { return (r & 3) + 8 * (r >> 2) + 4 * hi; }
__device__ __forceinline__ void attn_mfma_unit(const Frame& F, LAS unsigned char* L, int b, int h, int qb, const bf16* Q, const bf16* Kb, const bf16* proj, const float* kmean, bf16* cat) {
    int lane_ = F.lane; asm volatile("" : "+v"(lane_));
    const int lane = lane_, r32 = lane & 31, hi = lane >> 5, wid = F.wave;
    const size_t row0 = (size_t)b * SEQ + qb * 256;
    const int qi = wid * 32 + r32;
    bf16x8 qf[4];
    { const bf16* pq = Q + (row0 + qi) * 512 + h * 64 + hi * 8;
#pragma unroll
        for (int d0 = 0; d0 < 4; ++d0) qf[d0] = *(const bf16x8*)(pq + d0 * 16); }
    unsigned selmask;
    if (qb <= 3) selmask = (1u << qb) - 1u;
    else {
        float b0 = -3.0e38f, b1 = -3.0e38f, b2 = -3.0e38f; int i0 = 0, i1 = 0, i2 = 0;
        float qv[32];
#pragma unroll
        for (int d0 = 0; d0 < 4; ++d0)
#pragma unroll
            for (int e = 0; e < 8; ++e) qv[d0 * 8 + e] = bf2f((bf16)qf[d0][e]);
#pragma unroll 1
        for (int j = 0; j < qb; ++j) { const float* km = kmean + (((size_t)b * 8 + h) * 8 + j) * 64 + hi * 8; float sacc = 0.f;
#pragma unroll
            for (int d0 = 0; d0 < 4; ++d0) { const f32x4 k0 = *(const f32x4*)(km + d0 * 16), k1 = *(const f32x4*)(km + d0 * 16 + 4);
                sacc += qv[d0 * 8 + 0] * k0.x + qv[d0 * 8 + 1] * k0.y + qv[d0 * 8 + 2] * k0.z + qv[d0 * 8 + 3] * k0.w + qv[d0 * 8 + 4] * k1.x + qv[d0 * 8 + 5] * k1.y + qv[d0 * 8 + 6] * k1.z + qv[d0 * 8 + 7] * k1.w; }
            sacc += __shfl_xor(sacc, 32);
            if (sacc > b0) { b2 = b1; i2 = i1; b1 = b0; i1 = i0; b0 = sacc; i0 = j; }
            else if (sacc > b1) { b2 = b1; i2 = i1; b1 = sacc; i1 = j; }
            else if (sacc > b2) { b2 = sacc; i2 = j; } }
        selmask = (1u << i0) | (1u << i1) | (1u << i2);
    }
    const int tid_l = wid * 64 + lane, srow = tid_l >> 3, sch = tid_l & 7;
    const bf16* kg = Kb + ((size_t)b * SEQ + srow) * 512 + h * 64 + sch * 8;
    const bf16* vg = proj + ((size_t)b * SEQ + srow) * NCOL + C_AV + h * 64 + sch * 8;
    const int kst = srow * AT_KROW + sch * 16, vst = AT_KBUF + srow * AT_VROW + sch * 16;
    const int kfo = r32 * AT_KROW + hi * 16;
    const int g16 = lane >> 4, idx = lane & 15;
    const int vfo = AT_KBUF + (4 * (g16 >> 1) + (idx >> 2)) * AT_VROW + ((g16 & 1) * 16 + 4 * (idx & 3)) * 2;
    const int NT = 4 * (qb + 1);
    f32x16 o0 = {}, o1 = {};
    float lsum = 0.f;
    v4u kA = {}, vA = {}, kB, vB;
    { const v4u kk = *(const v4u*)kg, vv = *(const v4u*)vg;
        kB = *(const v4u*)(kg + (size_t)64 * 512); vB = *(const v4u*)(vg + (size_t)64 * NCOL);
        *(LAS v4u*)(L + kst) = kk; *(LAS v4u*)(L + vst) = vv; }
    lds_barrier();
#define AT_TILE(OWN, TT, PAR, KL, VL, KW, VW) do { \
        const int t_ = (TT); constexpr int cb = (PAR) * AT_BUF, nb = AT_BUF - cb;        \
        if (t_ + 2 < NT) { KL = *(const v4u*)(kg + (size_t)(t_ + 2) * 64 * 512); VL = *(const v4u*)(vg + (size_t)(t_ + 2) * 64 * NCOL); } \
        const int j = t_ >> 2, kt = t_ & 3; \
        const bool active = !(OWN) || (kt * 64 <= wid * 32 + 31); \
        if (active) { \
            f32x16 s0, s1; \
            { const float bias = ((OWN) || (((selmask >> j) & 1u) != 0u)) ? 0.f : -1.0e30f; \
                _Pragma("unroll") for (int r = 0; r < 16; ++r) { s0[r] = bias; s1[r] = bias; } } \
            bf16x8 kf[8]; \
            _Pragma("unroll") for (int d0 = 0; d0 < 4; ++d0) { kf[d0] = *(const LAS bf16x8*)(L + cb + kfo + d0 * 32); kf[4 + d0] = *(const LAS bf16x8*)(L + cb + kfo + 32 * AT_KROW + d0 * 32); } \
            _Pragma("unroll") for (int d0 = 0; d0 < 4; ++d0) { \
                s0 = __builtin_amdgcn_mfma_f32_32x32x16_bf16(kf[d0], qf[d0], s0, 0, 0, 0); \
                s1 = __builtin_amdgcn_mfma_f32_32x32x16_bf16(kf[4 + d0], qf[d0], s1, 0, 0, 0); } \
            v4i16_t va[16]; \
            _Pragma("unroll") for (int sub = 0; sub < 2; ++sub) \
                _Pragma("unroll") for (int sI = 0; sI < 2; ++sI) { const int vb = cb + vfo + (sub * 32 + 16 * sI) * AT_VROW, q4 = (sub * 2 + sI) * 4; \
                    va[q4 + 0] = __builtin_amdgcn_ds_read_tr16_b64_v4i16((LAS v4i16_t*)(L + vb)); va[q4 + 1] = __builtin_amdgcn_ds_read_tr16_b64_v4i16((LAS v4i16_t*)(L + vb + 8 * AT_VROW)); \
                    va[q4 + 2] = __builtin_amdgcn_ds_read_tr16_b64_v4i16((LAS v4i16_t*)(L + vb + 64)); va[q4 + 3] = __builtin_amdgcn_ds_read_tr16_b64_v4i16((LAS v4i16_t*)(L + vb + 8 * AT_VROW + 64)); } \
            __builtin_amdgcn_sched_barrier(0); \
            float ps = 0.f; \
            if (OWN) { const int lim = qi - kt * 64; \
                _Pragma("unroll") for (int r = 0; r < 16; ++r) { const int kv = crow16(r, hi); \
                    const float p0 = (kv <= lim) ? __builtin_amdgcn_exp2f(s0[r]) : 0.f, p1 = (kv + 32 <= lim) ? __builtin_amdgcn_exp2f(s1[r]) : 0.f; \
                    s0[r] = p0; s1[r] = p1; ps += p0 + p1; } \
            } else { \
                _Pragma("unroll") for (int r = 0; r < 16; ++r) { const float p0 = __builtin_amdgcn_exp2f(s0[r]), p1 = __builtin_amdgcn_exp2f(s1[r]); s0[r] = p0; s1[r] = p1; ps += p0 + p1; } } \
            lsum += ps; \
            bf16x8 pa[4]; \
            _Pragma("unroll") for (int sI = 0; sI < 2; ++sI) { v4u w0, w1; \
                w0.x = pg8::cvt_pk_bf16(s0[8 * sI + 0], s0[8 * sI + 1]); w0.y = pg8::cvt_pk_bf16(s0[8 * sI + 2], s0[8 * sI + 3]); w0.z = pg8::cvt_pk_bf16(s0[8 * sI + 4], s0[8 * sI + 5]); w0.w = pg8::cvt_pk_bf16(s0[8 * sI + 6], s0[8 * sI + 7]); \
                w1.x = pg8::cvt_pk_bf16(s1[8 * sI + 0], s1[8 * sI + 1]); w1.y = pg8::cvt_pk_bf16(s1[8 * sI + 2], s1[8 * sI + 3]); w1.z = pg8::cvt_pk_bf16(s1[8 * sI + 4], s1[8 * sI + 5]); w1.w = pg8::cvt_pk_bf16(s1[8 * sI + 6], s1[8 * sI + 7]); \
                pa[sI] = __builtin_bit_cast(bf16x8, w0); pa[2 + sI] = __builtin_bit_cast(bf16x8, w1); } \
            _Pragma("unroll") for (int q = 0; q < 4; ++q) { \
                const bf16x8 v0 = (bf16x8){va[4 * q][0], va[4 * q][1], va[4 * q][2], va[4 * q][3], va[4 * q + 1][0], va[4 * q + 1][1], va[4 * q + 1][2], va[4 * q + 1][3]}; \
                const bf16x8 v1 = (bf16x8){va[4 * q + 2][0], va[4 * q + 2][1], va[4 * q + 2][2], va[4 * q + 2][3], va[4 * q + 3][0], va[4 * q + 3][1], va[4 * q + 3][2], va[4 * q + 3][3]}; \
                o0 = __builtin_amdgcn_mfma_f32_32x32x16_bf16(pa[q], v0, o0, 0, 0, 0); \
                o1 = __builtin_amdgcn_mfma_f32_32x32x16_bf16(pa[q], v1, o1, 0, 0, 0); } \
        } \
        if (t_ + 1 < NT) { *(LAS v4u*)(L + nb + kst) = KW; *(LAS v4u*)(L + nb + vst) = VW; } \
        lds_barrier(); \
    } while (0)
    int t = 0;
#pragma unroll 1
    for (; t < NT - 4; t += 2) { AT_TILE(false, t, 0, kA, vA, kB, vB); AT_TILE(false, t + 1, 1, kB, vB, kA, vA); }
#pragma unroll 1
    for (; t < NT; t += 2) { AT_TILE(true, t, 0, kA, vA, kB, vB); AT_TILE(true, t + 1, 1, kB, vB, kA, vA); }
#undef AT_TILE
    lsum += __shfl_xor(lsum, 32);
    LAS float* wsf = (LAS float*)(L + AT_WSF + wid * 256);
    if (hi == 0) wsf[r32] = lsum;
    asm volatile("s_waitcnt lgkmcnt(0)" ::: "memory");
    LAS bf16* stg = (LAS bf16*)(L + AT_STG + wid * 4096);
#pragma unroll
    for (int r = 0; r < 16; ++r) { const int orow = crow16(r, hi); const float rl = 1.f / wsf[orow];
        stg[orow * 64 + r32] = (bf16)f2bf(o0[r] * rl); stg[orow * 64 + 32 + r32] = (bf16)f2bf(o1[r] * rl); }
    asm volatile("s_waitcnt lgkmcnt(0)" ::: "memory");
    bf16* po = cat + (row0 + wid * 32) * 1536 + h * 64;
#pragma unroll
    for (int i = 0; i < 4; ++i) { const int row = i * 8 + (lane >> 3), ch = lane & 7; const v4u v = *(const LAS v4u*)(stg + row * 64 + ch * 8); *(v4u*)(po + (size_t)row * 1536 + ch * 8) = v; }
    lds_barrier();
}
__device__ __forceinline__ void phase_attn_mfma(const Frame& F0, const bf16* Q, const bf16* Kb, const bf16* proj, const float* kmean, bf16* cat) {
    const Frame F = fresh(F0);
    LAS unsigned char* L = (LAS unsigned char*)F.lds;
    for (int p = F.bid; p < 256; p += F.G) {
        const int bh = p >> 2, s = p & 3;
#pragma unroll 1
        for (int i = 0; i < 2; ++i) attn_mfma_unit(F, L, bh >> 3, bh & 7, i ? s : 7 - s, Q, Kb, proj, kmean, cat);
    }
}

constexpr int HG_G = 0, HG_QD = 16384, HG_KD = HG_QD + 32 * 272, HG_KE = HG_KD + 32 * 272, HG_VT = HG_KE + 32 * 320, HG_SP = HG_VT + 32 * 320, HG_END = HG_SP + 128 * 320;
static_assert(HG_END <= LDS_SCRATCH, "hgrn lds");
template <bool PERM> __device__ __forceinline__ bf16x8 tr_frag(LAS unsigned char* tile, int pitch, int rbase, int cbase, int lane) {
    const int g16 = lane >> 4, idx = lane & 15, h = g16 >> 1;
    LAS unsigned char* p = tile + (rbase + (PERM ? 4 : 8) * h + (idx >> 2)) * pitch + (cbase + (g16 & 1) * 16 + 4 * (idx & 3)) * 2;
    const v4i16_t a0 = __builtin_amdgcn_ds_read_tr16_b64_v4i16((LAS v4i16_t*)p), a1 = __builtin_amdgcn_ds_read_tr16_b64_v4i16((LAS v4i16_t*)(p + (PERM ? 8 : 4) * pitch));
    return (bf16x8){a0[0], a0[1], a0[2], a0[3], a1[0], a1[1], a1[2], a1[3]};
}
template <bool FULL>
__device__ __forceinline__ void hgrn_unit(const Frame& F, LAS unsigned char* L, int u, const bf16* proj, const float* lbl, int layer, const float* gnorm, float* Lg, float* Dg, bf16* cat) {
    const int b = u >> 5, h = (u >> 3) & 3, blk = u & 7;
    const int lane = F.lane, r32 = lane & 31, hi = lane >> 5, wid = F.wave, tid = F.tid;
    const int tt = tid >> 4, cg = tid & 15, ch = cg * 8;
    LAS float* G = (LAS float*)(L + HG_G);
    float lbv[8], omlb[8], gn[8];
#pragma unroll
    for (int i = 0; i < 8; ++i) { float lb = 0.f;
        if (layer > 0) { const float l0 = lbl[h * 128 + ch + i], l1 = lbl[512 + h * 128 + ch + i]; lb = 1.f / (1.f + __expf(l0 - l1)); }
        lbv[i] = lb; omlb[i] = 1.f - lb; gn[i] = FULL ? gnorm[ch + i] : 0.f; }
    f32x16 S[2];
#pragma unroll
    for (int i = 0; i < 2; ++i) { S[i] = (f32x16){};
        if (FULL) { const int id = 2 * wid + i, kt = id >> 2, vt = id & 3;
            for (int pb = 0; pb < blk; ++pb) { const float* Lp = Lg + (size_t)(u - blk + pb) * 16384; const float* Dp = Dg + (size_t)(u - blk + pb) * 128;
#pragma unroll
                for (int r = 0; r < 16; ++r) { const int k = kt * 32 + crow16(r, hi); S[i][r] = Dp[k] * S[i][r] + Lp[k * 128 + vt * 32 + r32]; } } } }
    float dsum = 0.f;
    const size_t rowb = (size_t)b * SEQ + blk * 256;
    for (int c = 0; c < 8; ++c) {
        const size_t row = rowb + c * 32 + tt;
        const v4u fq = *(const v4u*)(proj + row * NCOL + C_HF + h * 128 + ch), vq = *(const v4u*)(proj + row * NCOL + C_HI + h * 128 + ch);
        v4u qq = {}, gq = {};
        if (FULL) { qq = *(const v4u*)(proj + row * NCOL + C_HQ + h * 128 + ch); gq = *(const v4u*)(proj + row * NCOL + C_HG + h * 128 + ch); }
        float kk[8], qa[8], gl[8];
        { const unsigned fw[4] = {fq.x, fq.y, fq.z, fq.w}, qw[4] = {qq.x, qq.y, qq.z, qq.w};
#pragma unroll
            for (int i = 0; i < 8; ++i) { const float fr = (i & 1) ? bfhi(fw[i >> 1]) : bflo(fw[i >> 1]); const float sig = sigmoidf_(fr);
                gl[i] = __logf(lbv[i] + omlb[i] * sig); kk[i] = omlb[i] * (1.f - sig);
                const float qv = (i & 1) ? bfhi(qw[i >> 1]) : bflo(qw[i >> 1]); qa[i] = qv * sigmoidf_(qv); } }
        *(LAS f32x4*)(G + tt * 128 + ch) = (f32x4){gl[0], gl[1], gl[2], gl[3]}; *(LAS f32x4*)(G + tt * 128 + ch + 4) = (f32x4){gl[4], gl[5], gl[6], gl[7]};
        *(LAS v4u*)(L + HG_VT + tt * 320 + ch * 2) = vq;
        __syncthreads();
        if (tid < 128) { float a[32];
#pragma unroll
            for (int t = 0; t < 32; ++t) a[t] = G[t * 128 + tid];
#pragma unroll
            for (int t = 1; t < 32; ++t) a[t] += a[t - 1];
#pragma unroll
            for (int t = 0; t < 32; ++t) G[t * 128 + tid] = a[t];
            dsum += a[31]; }
        __syncthreads();
        { const f32x4 b0 = *(const LAS f32x4*)(G + tt * 128 + ch), b1 = *(const LAS f32x4*)(G + tt * 128 + ch + 4);
            const f32x4 m0 = *(const LAS f32x4*)(G + 15 * 128 + ch), m1 = *(const LAS f32x4*)(G + 15 * 128 + ch + 4);
            const f32x4 e0 = *(const LAS f32x4*)(G + 31 * 128 + ch), e1 = *(const LAS f32x4*)(G + 31 * 128 + ch + 4);
            const float bb[8] = {b0.x, b0.y, b0.z, b0.w, b1.x, b1.y, b1.z, b1.w}, bm[8] = {m0.x, m0.y, m0.z, m0.w, m1.x, m1.y, m1.z, m1.w}, be[8] = {e0.x, e0.y, e0.z, e0.w, e1.x, e1.y, e1.z, e1.w};
            float ke[8], kd[8], qd[8];
#pragma unroll
            for (int i = 0; i < 8; ++i) { ke[i] = kk[i] * __expf(be[i] - bb[i]); if (FULL) { const float ex = __expf(bb[i] - bm[i]); qd[i] = qa[i] * ex; kd[i] = kk[i] * __expf(bm[i] - bb[i]); } }
            v4u w; w.x = pk2(ke[0], ke[1]); w.y = pk2(ke[2], ke[3]); w.z = pk2(ke[4], ke[5]); w.w = pk2(ke[6], ke[7]);
            *(LAS v4u*)(L + HG_KE + tt * 320 + ch * 2) = w;
            if (FULL) {
                w.x = pk2(qd[0], qd[1]); w.y = pk2(qd[2], qd[3]); w.z = pk2(qd[4], qd[5]); w.w = pk2(qd[6], qd[7]); *(LAS v4u*)(L + HG_QD + tt * 272 + ch * 2) = w;
                w.x = pk2(kd[0], kd[1]); w.y = pk2(kd[2], kd[3]); w.z = pk2(kd[4], kd[5]); w.w = pk2(kd[6], kd[7]); *(LAS v4u*)(L + HG_KD + tt * 272 + ch * 2) = w;
#pragma unroll
                for (int i = 0; i < 2; ++i) { const int id = 2 * wid + i, kt = id >> 2, vt = id & 3;
#pragma unroll
                    for (int r = 0; r < 16; ++r) { const int k = kt * 32 + crow16(r, hi); *(LAS bf16*)(L + HG_SP + k * 320 + (vt * 32 + r32) * 2) = (bf16)f2bf(S[i][r] * __expf(G[15 * 128 + k])); } }
            }
        }
        __syncthreads();
        f32x16 o = {};
        if (FULL && wid < 4) {
            f32x16 sc = {};
            bf16x8 qf[8];
#pragma unroll
            for (int k0 = 0; k0 < 8; ++k0) { qf[k0] = *(const LAS bf16x8*)(L + HG_QD + r32 * 272 + (k0 * 16 + 8 * hi) * 2);
                const bf16x8 kf = *(const LAS bf16x8*)(L + HG_KD + r32 * 272 + (k0 * 16 + 8 * hi) * 2);
                sc = __builtin_amdgcn_mfma_f32_32x32x16_bf16(kf, qf[k0], sc, 0, 0, 0); }
#pragma unroll
            for (int r = 0; r < 16; ++r) sc[r] = (crow16(r, hi) <= r32) ? sc[r] : 0.f;
#pragma unroll
            for (int k0 = 0; k0 < 8; ++k0) o = __builtin_amdgcn_mfma_f32_32x32x16_bf16(qf[k0], tr_frag<false>(L + HG_SP, 320, k0 * 16, wid * 32, lane), o, 0, 0, 0);
#pragma unroll
            for (int sI = 0; sI < 2; ++sI) { v4u w; w.x = pg8::cvt_pk_bf16(sc[8 * sI + 0], sc[8 * sI + 1]); w.y = pg8::cvt_pk_bf16(sc[8 * sI + 2], sc[8 * sI + 3]); w.z = pg8::cvt_pk_bf16(sc[8 * sI + 4], sc[8 * sI + 5]); w.w = pg8::cvt_pk_bf16(sc[8 * sI + 6], sc[8 * sI + 7]);
                o = __builtin_amdgcn_mfma_f32_32x32x16_bf16(__builtin_bit_cast(bf16x8, w), tr_frag<true>(L + HG_VT, 320, 16 * sI, wid * 32, lane), o, 0, 0, 0); }
        }
#pragma unroll
        for (int i = 0; i < 2; ++i) { const int id = 2 * wid + i, kt = id >> 2, vt = id & 3;
#pragma unroll
            for (int r = 0; r < 16; ++r) S[i][r] *= __expf(G[31 * 128 + kt * 32 + crow16(r, hi)]);
#pragma unroll
            for (int sI = 0; sI < 2; ++sI) S[i] = __builtin_amdgcn_mfma_f32_32x32x16_bf16(tr_frag<true>(L + HG_KE, 320, 16 * sI, kt * 32, lane), tr_frag<true>(L + HG_VT, 320, 16 * sI, vt * 32, lane), S[i], 0, 0, 0); }
        __syncthreads();
        if (FULL) {
            if (wid < 4) {
#pragma unroll
                for (int r = 0; r < 16; ++r) G[crow16(r, hi) * 128 + wid * 32 + r32] = o[r]; }
            __syncthreads();
            const f32x4 o0 = *(const LAS f32x4*)(G + tt * 128 + ch), o1 = *(const LAS f32x4*)(G + tt * 128 + ch + 4);
            float ss = (o0.x * o0.x + o0.y * o0.y) + (o0.z * o0.z + o0.w * o0.w) + (o1.x * o1.x + o1.y * o1.y) + (o1.z * o1.z + o1.w * o1.w);
            ss += __shfl_xor(ss, 1); ss += __shfl_xor(ss, 2); ss += __shfl_xor(ss, 4); ss += __shfl_xor(ss, 8);
            const float rn = rsqrtf(ss * (1.f / 128.f) + RMS_EPS);
            const float ov[8] = {o0.x, o0.y, o0.z, o0.w, o1.x, o1.y, o1.z, o1.w}; const unsigned gw[4] = {gq.x, gq.y, gq.z, gq.w};
            float y[8];
#pragma unroll
            for (int i = 0; i < 8; ++i) { const float gv = (i & 1) ? bfhi(gw[i >> 1]) : bflo(gw[i >> 1]); y[i] = ov[i] * rn * gn[i] * (gv * sigmoidf_(gv)); }
            v4u w; w.x = pk2(y[0], y[1]); w.y = pk2(y[2], y[3]); w.z = pk2(y[4], y[5]); w.w = pk2(y[6], y[7]);
            *(v4u*)(cat + row * 1536 + 512 + h * 128 + ch) = w;
            __syncthreads();
        }
    }
    if (!FULL) {
#pragma unroll
        for (int i = 0; i < 2; ++i) { const int id = 2 * wid + i, kt = id >> 2, vt = id & 3;
#pragma unroll
            for (int r = 0; r < 16; ++r) Lg[(size_t)u * 16384 + (kt * 32 + crow16(r, hi)) * 128 + vt * 32 + r32] = S[i][r]; }
        if (tid < 128) Dg[(size_t)u * 128 + tid] = __expf(dsum);
    }
}
template <bool FULL>
__device__ __forceinline__ void phase_hgrn(const Frame& F0, const bf16* proj, const float* lbl, int layer, const float* gnorm, float* Lg, float* Dg, bf16* cat) {
    const Frame F = fresh(F0);
    LAS unsigned char* L = (LAS unsigned char*)F.lds;
    for (int u = F.bid; u < 256; u += F.G) { hgrn_unit<FULL>(F, L, u, proj, lbl, layer, gnorm, Lg, Dg, cat); __syncthreads(); }
}

constexpr int H1_G = 0, H1_QD = 32768, H1_KD = H1_QD + 64 * 272, H1_KE = H1_KD + 64 * 272, H1_VT = H1_KE + 64 * 320, H1_SP = H1_VT + 64 * 320, H1_TOT = H1_SP + 128 * 320, H1_BO = H1_TOT + 2048, H1_LB = H1_BO + 512, H1_CK = H1_LB + 512, H1_END = H1_CK + 2048;
static_assert(H1_END <= LDS_SCRATCH, "hgrn pass 1 lds");
__device__ __forceinline__ void hgrn_pass1_unit(const Frame& F, LAS unsigned char* L, int u, const bf16* proj, const float* lbl, int layer, float* Lg, float* Dg, float* OL, bf16* Qb) {
    const int b = u >> 5, h = (u >> 3) & 3, blk = u & 7;
    const int lane = F.lane, r32 = lane & 31, hi = lane >> 5, wid = F.wave, tid = F.tid;
    const int tt = tid >> 3, cg = tid & 7, ch = cg * 16;
    LAS float* G = (LAS float*)(L + H1_G); LAS float* TOT = (LAS float*)(L + H1_TOT);
    LAS float* BO = (LAS float*)(L + H1_BO); LAS float* LB = (LAS float*)(L + H1_LB); LAS float* CK = (LAS float*)(L + H1_CK);
    if (tid < 128) { float lb = 0.f;
        if (layer > 0) { const float l0 = lbl[h * 128 + tid], l1 = lbl[512 + h * 128 + tid]; lb = 1.f / (1.f + __expf(l0 - l1)); }
        LB[tid] = lb; BO[tid] = 0.f; }
    lds_barrier();
    f32x16 S[2]; S[0] = (f32x16){}; S[1] = (f32x16){};
    const size_t rowb = (size_t)b * SEQ + blk * 256;
    const int tt2 = wid >> 2, vt = wid & 3;
    v4u nx[6];
    { const bf16* pr = proj + (rowb + tt) * NCOL + h * 128 + ch;
        nx[0] = *(const v4u*)(pr + C_HF); nx[1] = *(const v4u*)(pr + C_HF + 8); nx[2] = *(const v4u*)(pr + C_HQ); nx[3] = *(const v4u*)(pr + C_HQ + 8); nx[4] = *(const v4u*)(pr + C_HI); nx[5] = *(const v4u*)(pr + C_HI + 8); }
    for (int c = 0; c < 4; ++c) {
        const size_t row = rowb + c * 64 + tt;
        float kk[16], qa[16];
        {
            const v4u f0 = nx[0], f1 = nx[1], q0 = nx[2], q1 = nx[3], v0 = nx[4], v1 = nx[5];
            if (c < 3) { const bf16* pr = proj + (row + 64) * NCOL + h * 128 + ch;
                nx[0] = *(const v4u*)(pr + C_HF); nx[1] = *(const v4u*)(pr + C_HF + 8); nx[2] = *(const v4u*)(pr + C_HQ); nx[3] = *(const v4u*)(pr + C_HQ + 8); nx[4] = *(const v4u*)(pr + C_HI); nx[5] = *(const v4u*)(pr + C_HI + 8); }
            const unsigned fw[8] = {f0.x, f0.y, f0.z, f0.w, f1.x, f1.y, f1.z, f1.w}, qw[8] = {q0.x, q0.y, q0.z, q0.w, q1.x, q1.y, q1.z, q1.w};
            float gl[16], lbv[16];
#pragma unroll
            for (int i = 0; i < 4; ++i) { const f32x4 x = *(const LAS f32x4*)(LB + ch + 4 * i); lbv[4 * i] = x.x; lbv[4 * i + 1] = x.y; lbv[4 * i + 2] = x.z; lbv[4 * i + 3] = x.w; }
#pragma unroll
            for (int i = 0; i < 16; ++i) { const float fr = (i & 1) ? bfhi(fw[i >> 1]) : bflo(fw[i >> 1]); const float sig = sigmoidf_(fr);
                gl[i] = __logf(lbv[i] + (1.f - lbv[i]) * sig); kk[i] = (1.f - lbv[i]) * (1.f - sig);
                const float qv = (i & 1) ? bfhi(qw[i >> 1]) : bflo(qw[i >> 1]); qa[i] = qv * sigmoidf_(qv); }
#pragma unroll
            for (int i = 0; i < 4; ++i) *(LAS f32x4*)(G + tt * 128 + ch + 4 * i) = (f32x4){gl[4 * i], gl[4 * i + 1], gl[4 * i + 2], gl[4 * i + 3]};
            *(LAS v4u*)(L + H1_VT + tt * 320 + ch * 2) = v0; *(LAS v4u*)(L + H1_VT + tt * 320 + ch * 2 + 16) = v1;
        }
        lds_barrier();
        {
            const int k = tid & 127, part = tid >> 7; float a[16];
#pragma unroll
            for (int i = 0; i < 16; ++i) a[i] = G[(part * 16 + i) * 128 + k];
#pragma unroll
            for (int i = 1; i < 16; ++i) a[i] += a[i - 1];
            TOT[part * 128 + k] = a[15];
            lds_barrier();
            float pre = 0.f;
#pragma unroll
            for (int p = 0; p < 3; ++p) if (p < part) pre += TOT[p * 128 + k];
#pragma unroll
            for (int i = 0; i < 16; ++i) G[(part * 16 + i) * 128 + k] = a[i] + pre;
            if (part == 3) {
                const float bmk = TOT[k] + TOT[128 + k], bek = pre + a[15];
                CK[k] = __expf(bmk); CK[128 + k] = __expf(bek); CK[256 + k] = __expf(bek - bmk); CK[384 + k] = __expf(BO[k] + bmk); }
        }
        lds_barrier();
        {
#pragma unroll
            for (int hh = 0; hh < 2; ++hh) {
                float bb[8], bm[8], cem[8], com[8];
#pragma unroll
                for (int i = 0; i < 2; ++i) { const f32x4 x = *(const LAS f32x4*)(G + tt * 128 + ch + 8 * hh + 4 * i), y = *(const LAS f32x4*)(G + 31 * 128 + ch + 8 * hh + 4 * i), z = *(const LAS f32x4*)(CK + 256 + ch + 8 * hh + 4 * i), o4 = *(const LAS f32x4*)(CK + 384 + ch + 8 * hh + 4 * i);
                    bb[4 * i] = x.x; bb[4 * i + 1] = x.y; bb[4 * i + 2] = x.z; bb[4 * i + 3] = x.w; bm[4 * i] = y.x; bm[4 * i + 1] = y.y; bm[4 * i + 2] = y.z; bm[4 * i + 3] = y.w;
                    cem[4 * i] = z.x; cem[4 * i + 1] = z.y; cem[4 * i + 2] = z.z; cem[4 * i + 3] = z.w; com[4 * i] = o4.x; com[4 * i + 1] = o4.y; com[4 * i + 2] = o4.z; com[4 * i + 3] = o4.w; }
                float ex[8], rex[8], t8[8]; v4u w;
#pragma unroll
                for (int i = 0; i < 8; ++i) { ex[i] = __expf(bb[i] - bm[i]); rex[i] = __builtin_amdgcn_rcpf(ex[i]); }
#pragma unroll
                for (int i = 0; i < 8; ++i) t8[i] = kk[8 * hh + i] * rex[i] * cem[i];
                w.x = pk2(t8[0], t8[1]); w.y = pk2(t8[2], t8[3]); w.z = pk2(t8[4], t8[5]); w.w = pk2(t8[6], t8[7]); *(LAS v4u*)(L + H1_KE + tt * 320 + ch * 2 + 16 * hh) = w;
#pragma unroll
                for (int i = 0; i < 8; ++i) t8[i] = qa[8 * hh + i] * ex[i];
                w.x = pk2(t8[0], t8[1]); w.y = pk2(t8[2], t8[3]); w.z = pk2(t8[4], t8[5]); w.w = pk2(t8[6], t8[7]); *(LAS v4u*)(L + H1_QD + tt * 272 + ch * 2 + 16 * hh) = w;
#pragma unroll
                for (int i = 0; i < 8; ++i) t8[i] = kk[8 * hh + i] * rex[i];
                w.x = pk2(t8[0], t8[1]); w.y = pk2(t8[2], t8[3]); w.z = pk2(t8[4], t8[5]); w.w = pk2(t8[6], t8[7]); *(LAS v4u*)(L + H1_KD + tt * 272 + ch * 2 + 16 * hh) = w;
#pragma unroll
                for (int i = 0; i < 8; ++i) t8[i] = qa[8 * hh + i] * ex[i] * com[i];
                w.x = pk2(t8[0], t8[1]); w.y = pk2(t8[2], t8[3]); w.z = pk2(t8[4], t8[5]); w.w = pk2(t8[6], t8[7]); *(v4u*)(Qb + row * 512 + h * 128 + ch + 8 * hh) = w;
                __builtin_amdgcn_sched_barrier(0);
            }
#pragma unroll
            for (int i = 0; i < 2; ++i) { const int id = 2 * wid + i, kt = id >> 2, v2 = id & 3;
#pragma unroll
                for (int r = 0; r < 16; ++r) { const int k = kt * 32 + crow16(r, hi); *(LAS bf16*)(L + H1_SP + k * 320 + (v2 * 32 + r32) * 2) = (bf16)f2bf(S[i][r] * CK[k]); } }
        }
        lds_barrier();
        {
            if (tid < 128) BO[tid] += G[63 * 128 + tid];
            f32x16 o = {};
            bf16x8 qf[8];
#pragma unroll
            for (int k0 = 0; k0 < 8; ++k0) qf[k0] = *(const LAS bf16x8*)(L + H1_QD + (tt2 * 32 + r32) * 272 + (k0 * 16 + 8 * hi) * 2);
#pragma unroll
            for (int k0 = 0; k0 < 8; ++k0) o = __builtin_amdgcn_mfma_f32_32x32x16_bf16(qf[k0], tr_frag<false>(L + H1_SP, 320, k0 * 16, vt * 32, lane), o, 0, 0, 0);
#pragma unroll
            for (int sg = 0; sg < 2; ++sg) if (sg <= tt2) {
                f32x16 sc = {};
#pragma unroll
                for (int k0 = 0; k0 < 8; ++k0) { const bf16x8 kf = *(const LAS bf16x8*)(L + H1_KD + (sg * 32 + r32) * 272 + (k0 * 16 + 8 * hi) * 2); sc = __builtin_amdgcn_mfma_f32_32x32x16_bf16(kf, qf[k0], sc, 0, 0, 0); }
                if (sg == tt2) {
#pragma unroll
                    for (int r = 0; r < 16; ++r) sc[r] = (crow16(r, hi) <= r32) ? sc[r] : 0.f; }
#pragma unroll
                for (int sI = 0; sI < 2; ++sI) { v4u w; w.x = pg8::cvt_pk_bf16(sc[8 * sI + 0], sc[8 * sI + 1]); w.y = pg8::cvt_pk_bf16(sc[8 * sI + 2], sc[8 * sI + 3]); w.z = pg8::cvt_pk_bf16(sc[8 * sI + 4], sc[8 * sI + 5]); w.w = pg8::cvt_pk_bf16(sc[8 * sI + 6], sc[8 * sI + 7]);
                    o = __builtin_amdgcn_mfma_f32_32x32x16_bf16(__builtin_bit_cast(bf16x8, w), tr_frag<true>(L + H1_VT, 320, sg * 32 + 16 * sI, vt * 32, lane), o, 0, 0, 0); }
            }
            float* po = OL + (rowb + c * 64 + tt2 * 32) * 512 + h * 128 + vt * 32 + r32;
#pragma unroll
            for (int r = 0; r < 16; ++r) po[(size_t)crow16(r, hi) * 512] = o[r];
#pragma unroll
            for (int i = 0; i < 2; ++i) { const int id = 2 * wid + i, kt = id >> 2, v2 = id & 3;
#pragma unroll
                for (int r = 0; r < 16; ++r) S[i][r] *= CK[128 + kt * 32 + crow16(r, hi)];
#pragma unroll
                for (int s4 = 0; s4 < 4; ++s4) S[i] = __builtin_amdgcn_mfma_f32_32x32x16_bf16(tr_frag<true>(L + H1_KE, 320, 16 * s4, kt * 32, lane), tr_frag<true>(L + H1_VT, 320, 16 * s4, v2 * 32, lane), S[i], 0, 0, 0); }
        }
        lds_barrier();
    }
#pragma unroll
    for (int i = 0; i < 2; ++i) { const int id = 2 * wid + i, kt = id >> 2, v2 = id & 3;
#pragma unroll
        for (int r = 0; r < 16; ++r) Lg[(size_t)u * 16384 + (kt * 32 + crow16(r, hi)) * 128 + v2 * 32 + r32] = S[i][r]; }
    if (tid < 128) Dg[(size_t)u * 128 + tid] = __expf(BO[tid]);
}
constexpr int H2_SL = 0, H2_OB = 128 * 320, H2_END = H2_OB + 128 * 128 * 4;
__device__ __forceinline__ void hgrn_pass2_unit(const Frame& F, LAS unsigned char* L, int u, const bf16* proj, const float* gnorm, const float* Lg, const float* Dg, const float* OL, const bf16* Qb, bf16* cat, int dry) {
    const int b = u >> 5, h = (u >> 3) & 3, blk = u & 7;
    const int lane = F.lane, r32 = lane & 31, hi = lane >> 5, wid = F.wave, tid = F.tid;
    const size_t rowb = (size_t)b * SEQ + blk * 256;
    LAS float* OB = (LAS float*)(L + H2_OB);
    if (blk > 0 && dry != 1) {
#pragma unroll 1
        for (int jh = 0; jh < 4; ++jh) {
            f32x4 l4[7][2]; float dd[7][2];
#pragma unroll
            for (int pb = 0; pb < 7; ++pb)
#pragma unroll
                for (int j = 0; j < 2; ++j) { const int e4 = tid + 512 * (2 * jh + j), k = e4 >> 5;
                    if (pb < blk) { dd[pb][j] = *(const float*)((const char*)(Dg + (size_t)(u - blk + pb) * 128) + (unsigned)k * 4u); l4[pb][j] = *(const f32x4*)((const char*)(Lg + (size_t)(u - blk + pb) * 16384) + (unsigned)e4 * 16u); }
                    else { dd[pb][j] = 0.f; l4[pb][j] = (f32x4){0.f, 0.f, 0.f, 0.f}; } }
#pragma unroll
            for (int j = 0; j < 2; ++j) { const int e4 = tid + 512 * (2 * jh + j), k = e4 >> 5, v4 = (e4 & 31) * 4; f32x4 S = {0.f, 0.f, 0.f, 0.f};
#pragma unroll
                for (int pb = 0; pb < 7; ++pb) if (pb < blk) S = S * dd[pb][j] + l4[pb][j];
                v2u w; w.x = pk2(S.x, S.y); w.y = pk2(S.z, S.w); *(LAS v2u*)(L + H2_SL + k * 320 + v4 * 2) = w; } } }
    lds_barrier();
    const int ttp = tid >> 2, cq = tid & 3, vt = wid & 3;
    float gn[32];
#pragma unroll
    for (int i = 0; i < 8; ++i) { const f32x4 g = *(const f32x4*)(gnorm + cq * 32 + 4 * i); gn[4 * i] = g.x; gn[4 * i + 1] = g.y; gn[4 * i + 2] = g.z; gn[4 * i + 3] = g.w; }
    for (int hf = 0; hf < 2; ++hf) {
        const size_t rowp = rowb + hf * 128 + ttp;
        v4u hg[4];
#pragma unroll
        for (int i = 0; i < 4; ++i) hg[i] = *(const v4u*)(proj + rowp * NCOL + C_HG + h * 128 + cq * 32 + 8 * i);
#pragma unroll
        for (int j = 0; j < 2; ++j) { const int tl = (wid >> 2) + 2 * j;
            const size_t trow = rowb + hf * 128 + tl * 32;
            f32x16 o = {};
            bf16x8 af[8]; float olv[16];
            const float* pl = OL + trow * 512 + h * 128 + vt * 32 + r32;
            if (blk > 0) {
#pragma unroll
                for (int k0 = 0; k0 < 8; ++k0) af[k0] = *(const bf16x8*)(Qb + (trow + r32) * 512 + h * 128 + k0 * 16 + 8 * hi); }
#pragma unroll
            for (int r = 0; r < 16; ++r) olv[r] = pl[(size_t)crow16(r, hi) * 512];
            __builtin_amdgcn_sched_barrier(0);
            if (blk > 0 && dry != 2) {
#pragma unroll
                for (int k0 = 0; k0 < 8; ++k0) o = __builtin_amdgcn_mfma_f32_32x32x16_bf16(af[k0], tr_frag<false>(L + H2_SL, 320, k0 * 16, vt * 32, lane), o, 0, 0, 0); }
#pragma unroll
            for (int r = 0; r < 16; ++r) { const int t = crow16(r, hi); OB[(tl * 32 + t) * 128 + vt * 32 + r32] = o[r] + olv[r]; } }
        lds_barrier();
        {
            float ov[32]; float ss = 0.f;
#pragma unroll
            for (int i = 0; i < 8; ++i) { const f32x4 x = *(const LAS f32x4*)(OB + ttp * 128 + cq * 32 + 4 * i); ov[4 * i] = x.x; ov[4 * i + 1] = x.y; ov[4 * i + 2] = x.z; ov[4 * i + 3] = x.w; ss += (x.x * x.x + x.y * x.y) + (x.z * x.z + x.w * x.w); }
            ss += __shfl_xor(ss, 1); ss += __shfl_xor(ss, 2);
            const float rn = rsqrtf(ss * (1.f / 128.f) + RMS_EPS);
#pragma unroll
            for (int i = 0; i < 4; ++i) { const unsigned gw[4] = {hg[i].x, hg[i].y, hg[i].z, hg[i].w}; float y[8];
#pragma unroll
                for (int e = 0; e < 8; ++e) { const float gv = (e & 1) ? bfhi(gw[e >> 1]) : bflo(gw[e >> 1]); y[e] = ov[8 * i + e] * rn * gn[8 * i + e] * (gv * sigmoidf_(gv)); }
                v4u w; w.x = pk2(y[0], y[1]); w.y = pk2(y[2], y[3]); w.z = pk2(y[4], y[5]); w.w = pk2(y[6], y[7]);
                *(v4u*)(cat + rowp * 1536 + 512 + h * 128 + cq * 32 + 8 * i) = w; }
        }
        lds_barrier();
    }
}
__device__ __forceinline__ void phase_hgrn1(const Frame& F0, const bf16* proj, const float* lbl, int layer, float* Lg, float* Dg, float* OL, bf16* Qb) {
    const Frame F = fresh(F0);
    LAS unsigned char* L = (LAS unsigned char*)F.lds;
    for (int u = F.bid; u < 256; u += F.G) { hgrn_pass1_unit(F, L, u, proj, lbl, layer, Lg, Dg, OL, Qb); __syncthreads(); }
}
__device__ __forceinline__ void phase_hgrn2(const Frame& F0, const bf16* proj, const float* gnorm, const float* Lg, const float* Dg, const float* OL, const bf16* Qb, bf16* cat, int dry) {
    const Frame F = fresh(F0);
    LAS unsigned char* L = (LAS unsigned char*)F.lds;
    for (int u = F.bid; u < 256; u += F.G) { hgrn_pass2_unit(F, L, u, proj, gnorm, Lg, Dg, OL, Qb, cat, dry); __syncthreads(); }
}

struct SchedDense {
    const char* A; const char* B; int nM, nN, G, c; size_t ta, tb;
    __device__ __forceinline__ bool next(int i, pg8::Unit& u) const {
        int pm, pn; if (!pg8::static_tile(nM, nN, (long)i * G + c, pm, pn)) return false;
        u.pm = pm; u.pn = pn; u.aux = 0; u.pad = 0; u.a = A + (size_t)pm * ta; u.b = B + (size_t)pn * tb; return true; }
};
struct SchedBranch {
    const char* A; const char* B; int G, c;
    __device__ __forceinline__ bool next(int i, pg8::Unit& u) const {
        int pm, pn; if (!pg8::static_tile(T / 256, DM / 256, (long)(i / 3) * G + c, pm, pn)) return false;
        const int seg = i % 3;
        u.pm = pm; u.pn = pn; u.aux = seg; u.pad = 0; u.a = A + ((size_t)pm * 256 * 1536 + seg * 512) * 2; u.b = B + ((size_t)seg * DM * 512 + (size_t)pn * 256 * 512) * 2; return true; }
};
struct SchedMoe {
    const char* A; const char* B; const unsigned* ntp; const unsigned* tile_e; int G, c; size_t ta, tb_e, tb_n;
    __device__ __forceinline__ bool next(int i, pg8::Unit& u) const {
        const int nt = (int)__builtin_amdgcn_readfirstlane(*ntp);
        const long L = (long)i * G + c; if (L >= (long)nt * 4) return false;
        const int tile = (int)(L >> 2), pn = (int)(L & 3); const int e = (int)__builtin_amdgcn_readfirstlane(tile_e[tile]);
        u.pm = tile; u.pn = pn; u.aux = e; u.pad = 0; u.a = A + (size_t)tile * ta; u.b = B + (size_t)e * tb_e + (size_t)pn * tb_n; return true; }
};

typedef pg8::f32x4 af4;
struct EpiStoreBf16 {
    static constexpr bool PERM = true;
    bf16* O; int ldc; int gate_col0; const float* bgate; v4u* GT;
    __device__ __forceinline__ bool operator()(af4 (&acc)[2][2][4][2], const pg8::Unit& u, int wr, int wc, int fr, int fq) const {
        const int row0 = u.pm * 256 + wr * 64 + fr, col0 = u.pn * 256 + wc * 32 + 8 * fq;
        const bool gate = (u.pn * 256 >= gate_col0);
#pragma unroll
        for (int bj = 0; bj < 2; ++bj) {
            af4 b0 = {0.f, 0.f, 0.f, 0.f}, b1 = {0.f, 0.f, 0.f, 0.f};
            if (gate) { b0 = *(const af4*)(bgate + col0 + bj * 128 - gate_col0); b1 = *(const af4*)(bgate + col0 + bj * 128 - gate_col0 + 4); }
#pragma unroll
            for (int ai = 0; ai < 2; ++ai)
#pragma unroll
                for (int m = 0; m < 4; ++m) { af4 v0 = acc[ai][bj][m][0], v1 = acc[ai][bj][m][1];
                    if (gate) {
#pragma unroll
                        for (int i = 0; i < 4; ++i) { v0[i] = __builtin_amdgcn_rcpf(1.f + __expf(-fminf(fmaxf(v0[i] + b0[i], -30.f), 30.f))); v1[i] = __builtin_amdgcn_rcpf(1.f + __expf(-fminf(fmaxf(v1[i] + b1[i], -30.f), 30.f))); } }
                    v4u w; w.x = pg8::cvt_pk_bf16(v0[0], v0[1]); w.y = pg8::cvt_pk_bf16(v0[2], v0[3]); w.z = pg8::cvt_pk_bf16(v1[0], v1[1]); w.w = pg8::cvt_pk_bf16(v1[2], v1[3]);
                    if (gate) { const int gt = u.pn - gate_col0 / 256;
                        GT[((((size_t)((gt >> 2) * 64 + u.pm) * 4 + (gt & 3)) * 8 + (wr * 4 + wc)) * 16 + (ai * 4 + m) * 2 + bj) * 64 + (fq * 16 + fr)] = w; }
                    else *(v4u*)(O + (size_t)(row0 + ai * 128 + m * 16) * ldc + col0 + bj * 128) = w; } }
        return true;
    }
};
struct EpiBranch {
    static constexpr bool PERM = true;
    const v4u* GT; bf16* merged;
    __device__ __forceinline__ bool operator()(af4 (&acc)[2][2][4][2], const pg8::Unit& u, int wr, int wc, int fr, int fq) const {
        const int seg = u.aux, row0 = u.pm * 256 + wr * 64 + fr, col0 = u.pn * 256 + wc * 32 + 8 * fq;
        const bool last = (seg == 2); const int sn = last ? seg : seg + 1;
#pragma unroll
        for (int bj = 0; bj < 2; ++bj) { const int col = col0 + bj * 128;
#pragma unroll
            for (int ai = 0; ai < 2; ++ai) { v4u gcv[4], gnv[4];
#pragma unroll
                for (int m = 0; m < 4; ++m) { const size_t row = (size_t)(row0 + ai * 128 + m * 16);
                    gcv[m] = GT[((((size_t)(seg * 64 + u.pm) * 4 + u.pn) * 8 + (wr * 4 + wc)) * 16 + (ai * 4 + m) * 2 + bj) * 64 + (fq * 16 + fr)];
                    gnv[m] = GT[((((size_t)(sn * 64 + u.pm) * 4 + u.pn) * 8 + (wr * 4 + wc)) * 16 + (ai * 4 + m) * 2 + bj) * 64 + (fq * 16 + fr)]; }
#pragma unroll
                for (int m = 0; m < 4; ++m) { const size_t row = (size_t)(row0 + ai * 128 + m * 16);
                    const unsigned gcw[4] = {gcv[m].x, gcv[m].y, gcv[m].z, gcv[m].w}, gnw[4] = {gnv[m].x, gnv[m].y, gnv[m].z, gnv[m].w};
                    float f[8];
#pragma unroll
                    for (int i = 0; i < 8; ++i) { const float gc = (i & 1) ? bfhi(gcw[i >> 1]) : bflo(gcw[i >> 1]), gn = (i & 1) ? bfhi(gnw[i >> 1]) : bflo(gnw[i >> 1]);
                        f[i] = last ? gc : gc * __builtin_amdgcn_rcpf(gn); }
                    af4& v0 = acc[ai][bj][m][0]; af4& v1 = acc[ai][bj][m][1];
                    v0[0] *= f[0]; v0[1] *= f[1]; v0[2] *= f[2]; v0[3] *= f[3]; v1[0] *= f[4]; v1[1] *= f[5]; v1[2] *= f[6]; v1[3] *= f[7];
                    if (last) { v4u w; w.x = pg8::cvt_pk_bf16(v0[0], v0[1]); w.y = pg8::cvt_pk_bf16(v0[2], v0[3]); w.z = pg8::cvt_pk_bf16(v1[0], v1[1]); w.w = pg8::cvt_pk_bf16(v1[2], v1[3]);
                        *(v4u*)(merged + row * DM + col) = w; } } } }
        return last;
    }
};
struct EpiResidual {
    static constexpr bool PERM = true;
    const float* xin32; const bf16* xin16; bf16* xout;
    __device__ __forceinline__ bool operator()(af4 (&acc)[2][2][4][2], const pg8::Unit& u, int wr, int wc, int fr, int fq) const {
        const int row0 = u.pm * 256 + wr * 64 + fr, col0 = u.pn * 256 + wc * 32 + 8 * fq;
#pragma unroll
        for (int ai = 0; ai < 2; ++ai)
#pragma unroll
            for (int mh = 0; mh < 2; ++mh) { af4 r[2][2][2];
#pragma unroll
                for (int mm = 0; mm < 2; ++mm) { const size_t off = (size_t)(row0 + ai * 128 + (mh * 2 + mm) * 16) * DM + col0;
#pragma unroll
                    for (int bj = 0; bj < 2; ++bj) {
                        if (xin32) { r[mm][bj][0] = *(const af4*)(xin32 + off + bj * 128); r[mm][bj][1] = *(const af4*)(xin32 + off + bj * 128 + 4); }
                        else { const v4u w = *(const v4u*)(xin16 + off + bj * 128); r[mm][bj][0] = (af4){bflo(w.x), bfhi(w.x), bflo(w.y), bfhi(w.y)}; r[mm][bj][1] = (af4){bflo(w.z), bfhi(w.z), bflo(w.w), bfhi(w.w)}; } } }
#pragma unroll
                for (int mm = 0; mm < 2; ++mm) { const size_t off = (size_t)(row0 + ai * 128 + (mh * 2 + mm) * 16) * DM + col0;
#pragma unroll
                    for (int bj = 0; bj < 2; ++bj) { const af4 v0 = r[mm][bj][0] + acc[ai][bj][mh * 2 + mm][0], v1 = r[mm][bj][1] + acc[ai][bj][mh * 2 + mm][1]; v4u w;
                        w.x = pg8::cvt_pk_bf16(v0[0], v0[1]); w.y = pg8::cvt_pk_bf16(v0[2], v0[3]); w.z = pg8::cvt_pk_bf16(v1[0], v1[1]); w.w = pg8::cvt_pk_bf16(v1[2], v1[3]);
                        *(v4u*)(xout + off + bj * 128) = w; } } }
        return true;
    }
};
struct EpiSwiglu {
    static constexpr bool PERM = true;
    bf16* act; const float* rrow;
    __device__ __forceinline__ bool operator()(af4 (&acc)[2][2][4][2], const pg8::Unit& u, int wr, int wc, int fr, int fq) const {
        const int row0 = u.pm * 256 + wr * 64 + fr, col0 = u.pn * 128 + wc * 32 + 8 * fq;
        float rs[2][4];
#pragma unroll
        for (int ai = 0; ai < 2; ++ai)
#pragma unroll
            for (int m = 0; m < 4; ++m) rs[ai][m] = rrow[row0 + ai * 128 + m * 16];
#pragma unroll
        for (int ai = 0; ai < 2; ++ai)
#pragma unroll
            for (int m = 0; m < 4; ++m) { const float rr = rs[ai][m]; const af4 g0 = acc[ai][0][m][0] * rr, g1 = acc[ai][0][m][1] * rr, u0 = acc[ai][1][m][0] * rr, u1 = acc[ai][1][m][1] * rr;
                float o[8];
#pragma unroll
                for (int i = 0; i < 4; ++i) { o[i] = g0[i] * sigmoidf_(g0[i]) * u0[i]; o[4 + i] = g1[i] * sigmoidf_(g1[i]) * u1[i]; }
                v4u w; w.x = pg8::cvt_pk_bf16(o[0], o[1]); w.y = pg8::cvt_pk_bf16(o[2], o[3]); w.z = pg8::cvt_pk_bf16(o[4], o[5]); w.w = pg8::cvt_pk_bf16(o[6], o[7]);
                *(v4u*)(act + (size_t)(row0 + ai * 128 + m * 16) * FF + col0) = w; }
        return true;
    }
};
struct EpiScaleRows {
    static constexpr bool PERM = true;
    bf16* ys; const float* wrow;
    __device__ __forceinline__ bool operator()(af4 (&acc)[2][2][4][2], const pg8::Unit& u, int wr, int wc, int fr, int fq) const {
        const int row0 = u.pm * 256 + wr * 64 + fr, col0 = u.pn * 256 + wc * 32 + 8 * fq;
        float sc[2][4];
#pragma unroll
        for (int ai = 0; ai < 2; ++ai)
#pragma unroll
            for (int m = 0; m < 4; ++m) sc[ai][m] = wrow[row0 + ai * 128 + m * 16];
#pragma unroll
        for (int ai = 0; ai < 2; ++ai)
#pragma unroll
            for (int m = 0; m < 4; ++m) { const int row = row0 + ai * 128 + m * 16; const float s = sc[ai][m]; bf16* rowp = ys + (size_t)row * DM + col0;
#pragma unroll
                for (int bj = 0; bj < 2; ++bj) { const af4 v0 = acc[ai][bj][m][0] * s, v1 = acc[ai][bj][m][1] * s; v4u w;
                    w.x = pg8::cvt_pk_bf16(v0[0], v0[1]); w.y = pg8::cvt_pk_bf16(v0[2], v0[3]); w.z = pg8::cvt_pk_bf16(v1[0], v1[1]); w.w = pg8::cvt_pk_bf16(v1[2], v1[3]);
                    *(v4u*)(rowp + bj * 128) = w; } }
        return true;
    }
};

constexpr int RW_PITCH = 1028;
__device__ __forceinline__ void phase_router(const Frame& F0, const float* x, const float* gain, const float* wco, const float* bco, const float* wfi, const float* bfi,
                                             bf16* hout, unsigned* route, unsigned* cnt, bool commit) {
    const Frame F = fresh(F0);
    float* WT = (float*)F.lds;
    { f32x4 wv[18];
#pragma unroll
        for (int i = 0; i < 2; ++i) wv[i] = *(const f32x4*)(wco + 4 * (F.tid + 512 * i));
#pragma unroll
        for (int i = 0; i < 16; ++i) wv[2 + i] = *(const f32x4*)(wfi + 4 * (F.tid + 512 * i));
#pragma unroll
        for (int i = 0; i < 2; ++i) { const int k = F.tid + 512 * i; WT[0 * RW_PITCH + k] = wv[i].x; WT[1 * RW_PITCH + k] = wv[i].y; WT[2 * RW_PITCH + k] = wv[i].z; WT[3 * RW_PITCH + k] = wv[i].w; }
#pragma unroll
        for (int i = 0; i < 16; ++i) { const int f = F.tid + 512 * i, k = f >> 3, e = (f & 7) * 4;
            WT[(4 + e) * RW_PITCH + k] = wv[2 + i].x; WT[(5 + e) * RW_PITCH + k] = wv[2 + i].y; WT[(6 + e) * RW_PITCH + k] = wv[2 + i].z; WT[(7 + e) * RW_PITCH + k] = wv[2 + i].w; } }
    __syncthreads();
    const int gw = F.bid * 8 + F.wave, NGW = F.G * 8;
    f32x4 g[4];
#pragma unroll
    for (int j = 0; j < 4; ++j) g[j] = *(const f32x4*)(gain + 4 * F.lane + 256 * j);
    f32x4 nv[2][4];
#pragma unroll
    for (int q = 0; q < 2; ++q) { const int m = gw + q * NGW; if (m < T) { const f32x4* xr = (const f32x4*)(x + (size_t)m * DM) + F.lane;
#pragma unroll
            for (int j = 0; j < 4; ++j) nv[q][j] = xr[64 * j]; } }
    for (int m0 = gw; m0 < T; m0 += 2 * NGW) {
        f32x4 v[2][4];
#pragma unroll
        for (int q = 0; q < 2; ++q)
#pragma unroll
            for (int j = 0; j < 4; ++j) v[q][j] = nv[q][j];
#pragma unroll
        for (int q = 0; q < 2; ++q) { const int m = m0 + 2 * NGW + q * NGW; if (m < T) { const f32x4* xr = (const f32x4*)(x + (size_t)m * DM) + F.lane;
#pragma unroll
                for (int j = 0; j < 4; ++j) nv[q][j] = xr[64 * j]; } }
#pragma unroll
        for (int q = 0; q < 2; ++q) { const int m = m0 + q * NGW; float s = 0.f;
#pragma unroll
            for (int j = 0; j < 4; ++j) s += (v[q][j].x * v[q][j].x + v[q][j].y * v[q][j].y) + (v[q][j].z * v[q][j].z + v[q][j].w * v[q][j].w);
            const float r = rsqrtf(wave_sum(s) * (1.f / DM) + RMS_EPS);
#pragma unroll
            for (int j = 0; j < 4; ++j) v[q][j] = v[q][j] * r * g[j];
            if (m < T) { v2u* o8 = (v2u*)(hout + (size_t)m * DM) + F.lane;
#pragma unroll
                for (int j = 0; j < 4; ++j) { v2u w; w.x = pk2(v[q][j].x, v[q][j].y); w.y = pk2(v[q][j].z, v[q][j].w); o8[64 * j] = w; } } }
        float lg[2][36];
#pragma unroll
        for (int c = 0; c < 36; ++c) { float pa = 0.f, pb = 0.f;
#pragma unroll
            for (int j = 0; j < 4; ++j) { const f32x4 w = *(const f32x4*)(WT + c * RW_PITCH + 4 * F.lane + 256 * j);
                pa += (v[0][j].x * w.x + v[0][j].y * w.y) + (v[0][j].z * w.z + v[0][j].w * w.w); pb += (v[1][j].x * w.x + v[1][j].y * w.y) + (v[1][j].z * w.z + v[1][j].w * w.w); }
            lg[0][c] = pa; lg[1][c] = pb; if ((c & 3) == 3) __builtin_amdgcn_sched_barrier(0); }
#pragma unroll
        for (int c = 0; c < 36; ++c) { lg[0][c] = wave_sum(lg[0][c]); lg[1][c] = wave_sum(lg[1][c]); }
#pragma unroll
        for (int q = 0; q < 2; ++q) { const int m = m0 + q * NGW;
            float c0 = lg[q][0] + bco[0], c1 = lg[q][1] + bco[1], c2 = lg[q][2] + bco[2], c3 = lg[q][3] + bco[3];
            int grp = 0; float cm = c0;
            if (c1 > cm) { cm = c1; grp = 1; } if (c2 > cm) { cm = c2; grp = 2; } if (c3 > cm) { cm = c3; grp = 3; }
            const float ptop = 1.f / (__expf(c0 - cm) + __expf(c1 - cm) + __expf(c2 - cm) + __expf(c3 - cm));
            float fs[8];
#pragma unroll
            for (int i = 0; i < 8; ++i) { float a = lg[q][4 + i] + bfi[i], b = lg[q][12 + i] + bfi[8 + i], c = lg[q][20 + i] + bfi[16 + i], d = lg[q][28 + i] + bfi[24 + i]; fs[i] = grp == 0 ? a : (grp == 1 ? b : (grp == 2 ? c : d)); }
            int i1 = 0; float v1 = fs[0];
#pragma unroll
            for (int i = 1; i < 8; ++i) if (fs[i] > v1) { v1 = fs[i]; i1 = i; }
            int i2 = -1; float v2 = -3.0e38f;
#pragma unroll
            for (int i = 0; i < 8; ++i) if (i != i1 && fs[i] > v2) { v2 = fs[i]; i2 = i; }
            const float e2 = __expf(v2 - v1), w1 = ptop / (1.f + e2), w2 = ptop * e2 / (1.f + e2);
            if (F.lane == 0 && commit && m < T) {
                const int ea = grp * 8 + i1, eb = grp * 8 + i2;
                const unsigned ra = __hip_atomic_fetch_add(cnt + 64 * ea, 1u, RLX_AGENT), rb = __hip_atomic_fetch_add(cnt + 64 * eb, 1u, RLX_AGENT);
                v4u o; o.x = (unsigned)ea; o.y = (unsigned)eb; o.z = ra; o.w = rb; *(v4u*)(route + (size_t)m * 8) = o;
                *(f32x2*)(route + (size_t)m * 8 + 4) = (f32x2){w1, w2};
            }
        }
    }
    __syncthreads();
}

constexpr int RT_PITCH = 2064, RT_HI = 0, RT_LO = 36 * RT_PITCH, RT_END = 72 * RT_PITCH;
static_assert(RT_END + 4096 <= LDS_SCRATCH, "router lds");
__device__ __forceinline__ void phase_router2(const Frame& F0, const bf16* x, const float* gain, const float* wco, const float* bco, const float* wfi, const float* bfi,
                                              bf16* hout, unsigned* route, unsigned* cnt, float* LG, bool commit) {
    const Frame F = fresh(F0);
    LAS unsigned char* L = (LAS unsigned char*)F.lds;
    {
        f32x4 wv[18];
#pragma unroll
        for (int i = 0; i < 2; ++i) wv[i] = *(const f32x4*)(wco + 4 * (F.tid + 512 * i));
#pragma unroll
        for (int i = 0; i < 16; ++i) wv[2 + i] = *(const f32x4*)(wfi + 4 * (F.tid + 512 * i));
#pragma unroll
        for (int i = 0; i < 18; ++i) { int k, c0; if (i < 2) { k = F.tid + 512 * i; c0 = 32; } else { const int f = F.tid + 512 * (i - 2); k = f >> 3; c0 = (f & 7) * 4; }
            const float w4[4] = {wv[i].x, wv[i].y, wv[i].z, wv[i].w};
#pragma unroll
            for (int e = 0; e < 4; ++e) { const unsigned hi = f2bf(w4[e]); const unsigned lo = f2bf(w4[e] - __uint_as_float(hi << 16));
                *(LAS bf16*)(L + RT_HI + (c0 + e) * RT_PITCH + k * 2) = (bf16)hi; *(LAS bf16*)(L + RT_LO + (c0 + e) * RT_PITCH + k * 2) = (bf16)lo; } }
    }
    LAS float* GL = (LAS float*)(L + RT_END);
    GL[F.tid] = gain[F.tid]; GL[F.tid + 512] = gain[F.tid + 512];
    __syncthreads();
    if (F.wave < 4) {
        const int lane = F.lane, rl = lane & 15, kg = lane >> 4;
        for (int tile = F.wave * F.G + F.bid; tile < T / 16; tile += 4 * F.G) {
            const size_t row = (size_t)tile * 16 + rl;
            const bf16* xr = x + row * DM + 8 * kg;
            pg8::f32x4 acc[3]; acc[0] = (pg8::f32x4){0.f, 0.f, 0.f, 0.f}; acc[1] = acc[0]; acc[2] = acc[0];
            float ss = 0.f;
            const int bro[3] = {rl * RT_PITCH + 16 * kg, (16 + rl) * RT_PITCH + 16 * kg, (32 + (rl & 3)) * RT_PITCH + 16 * kg};
            v4u xa[8];
#pragma unroll
            for (int q = 0; q < 8; ++q) xa[q] = *(const v4u*)(xr + 32 * q);
            for (int s0 = 0; s0 < 32; s0 += 8) {
                v4u xn[8];
                if (s0 + 8 < 32) {
#pragma unroll
                    for (int q = 0; q < 8; ++q) xn[q] = *(const v4u*)(xr + 32 * (s0 + 8 + q)); }
#pragma unroll
                for (int q = 0; q < 8; ++q) { const int s = s0 + q;
                    const f32x4 g0 = *(const LAS f32x4*)(GL + 32 * s + 8 * kg), g1 = *(const LAS f32x4*)(GL + 32 * s + 8 * kg + 4);
                    const float xv[8] = {bflo(xa[q].x), bfhi(xa[q].x), bflo(xa[q].y), bfhi(xa[q].y), bflo(xa[q].z), bfhi(xa[q].z), bflo(xa[q].w), bfhi(xa[q].w)};
                    ss += (xv[0] * xv[0] + xv[1] * xv[1]) + (xv[2] * xv[2] + xv[3] * xv[3]) + (xv[4] * xv[4] + xv[5] * xv[5]) + (xv[6] * xv[6] + xv[7] * xv[7]);
                    const float y[8] = {xv[0] * g0.x, xv[1] * g0.y, xv[2] * g0.z, xv[3] * g0.w, xv[4] * g1.x, xv[5] * g1.y, xv[6] * g1.z, xv[7] * g1.w};
                    v4u ah, al; ah.x = pk2(y[0], y[1]); ah.y = pk2(y[2], y[3]); ah.z = pk2(y[4], y[5]); ah.w = pk2(y[6], y[7]);
                    al.x = pk2(y[0] - bflo(ah.x), y[1] - bfhi(ah.x)); al.y = pk2(y[2] - bflo(ah.y), y[3] - bfhi(ah.y)); al.z = pk2(y[4] - bflo(ah.z), y[5] - bfhi(ah.z)); al.w = pk2(y[6] - bflo(ah.w), y[7] - bfhi(ah.w));
                    *(v4u*)(hout + row * DM + 32 * s + 8 * kg) = ah;
                    const bf16x8 Ah = __builtin_bit_cast(bf16x8, ah), Al = __builtin_bit_cast(bf16x8, al);
#pragma unroll
                    for (int ct = 0; ct < 3; ++ct) { const bf16x8 Bh = *(const LAS bf16x8*)(L + RT_HI + bro[ct] + 64 * s), Bl = *(const LAS bf16x8*)(L + RT_LO + bro[ct] + 64 * s);
                        acc[ct] = __builtin_amdgcn_mfma_f32_16x16x32_bf16(Ah, Bh, acc[ct], 0, 0, 0);
                        acc[ct] = __builtin_amdgcn_mfma_f32_16x16x32_bf16(Ah, Bl, acc[ct], 0, 0, 0);
                        acc[ct] = __builtin_amdgcn_mfma_f32_16x16x32_bf16(Al, Bh, acc[ct], 0, 0, 0); } }
#pragma unroll
                for (int q = 0; q < 8; ++q) xa[q] = xn[q];
            }
            ss += __shfl_xor(ss, 16); ss += __shfl_xor(ss, 32);
            const float r = rsqrtf(ss * (1.f / DM) + RMS_EPS);
#pragma unroll
            for (int ct = 0; ct < 3; ++ct)
#pragma unroll
                for (int rg = 0; rg < 4; ++rg) LG[((size_t)tile * 16 + 4 * kg + rg) * 48 + ct * 16 + rl] = acc[ct][rg];
            asm volatile("s_waitcnt vmcnt(0)" ::: "memory");
            if (lane < 16) {
                const size_t m = (size_t)tile * 16 + lane;
                float lg[36];
#pragma unroll
                for (int c = 0; c < 36; ++c) lg[c] = r * __uint_as_float(__hip_atomic_load((const unsigned*)(LG + m * 48 + c), RLX_AGENT));
                float c0 = lg[32] + bco[0], c1 = lg[33] + bco[1], c2 = lg[34] + bco[2], c3 = lg[35] + bco[3];
                int grp = 0; float cm = c0;
                if (c1 > cm) { cm = c1; grp = 1; } if (c2 > cm) { cm = c2; grp = 2; } if (c3 > cm) { cm = c3; grp = 3; }
                const float ptop = 1.f / (__expf(c0 - cm) + __expf(c1 - cm) + __expf(c2 - cm) + __expf(c3 - cm));
                float fs[8];
#pragma unroll
                for (int i = 0; i < 8; ++i) { float a = lg[i] + bfi[i], b = lg[8 + i] + bfi[8 + i], c = lg[16 + i] + bfi[16 + i], d = lg[24 + i] + bfi[24 + i]; fs[i] = grp == 0 ? a : (grp == 1 ? b : (grp == 2 ? c : d)); }
                int i1 = 0; float v1 = fs[0];
#pragma unroll
                for (int i = 1; i < 8; ++i) if (fs[i] > v1) { v1 = fs[i]; i1 = i; }
                int i2 = -1; float v2 = -3.0e38f;
#pragma unroll
                for (int i = 0; i < 8; ++i) if (i != i1 && fs[i] > v2) { v2 = fs[i]; i2 = i; }
                const float e2 = __expf(v2 - v1), w1 = ptop / (1.f + e2), w2 = ptop * e2 / (1.f + e2);
                if (commit) {
                    const int ea = grp * 8 + i1, eb = grp * 8 + i2;
                    const unsigned ra = __hip_atomic_fetch_add(cnt + 64 * ea, 1u, RLX_AGENT), rb = __hip_atomic_fetch_add(cnt + 64 * eb, 1u, RLX_AGENT);
                    v4u o; o.x = (unsigned)ea; o.y = (unsigned)eb; o.z = ra; o.w = rb; *(v4u*)(route + m * 8) = o;
                    *(f32x4*)(route + m * 8 + 4) = (f32x4){w1, w2, r, 0.f};
                }
            }
        }
    }
    __syncthreads();
}

__device__ __forceinline__ void phase_scatter(const Frame& F0, const bf16* hin, const unsigned* route, const unsigned* cnt, unsigned* ntp, unsigned* tile_e, bf16* hs, float* wrow, float* rrow, unsigned* pos) {
    const Frame F = fresh(F0);
    unsigned* off = (unsigned*)F.lds;
    if (F.tid == 0) { unsigned o = 0;
        for (int e = 0; e < NEXP; ++e) { off[e] = o; const unsigned c = __hip_atomic_load(cnt + 64 * e, RLX_AGENT); const unsigned p = (c + 255u) & ~255u;
            if (F.bid == 0) for (unsigned tI = o >> 8; tI < ((o + p) >> 8); ++tI) tile_e[tI] = (unsigned)e;
            o += p; }
        off[NEXP] = o; if (F.bid == 0) *ntp = o >> 8; }
    __syncthreads();
    const int gw = F.bid * 8 + F.wave, NGW = F.G * 8;
    for (int m0 = gw; m0 < T; m0 += 4 * NGW) {
        v4u ri[4], a[4], b[4]; f32x4 ww[4];
#pragma unroll
        for (int q = 0; q < 4; ++q) { const int m = m0 + q * NGW; if (m < T) { ri[q] = *(const v4u*)(route + (size_t)m * 8); ww[q] = *(const f32x4*)(route + (size_t)m * 8 + 4);
                const v4u* src = (const v4u*)(hin + (size_t)m * DM) + F.lane; a[q] = src[0]; b[q] = src[64]; } }
#pragma unroll
        for (int q = 0; q < 4; ++q) { const int m = m0 + q * NGW; if (m < T) {
                const unsigned d0 = off[ri[q].x] + ri[q].z, d1 = off[ri[q].y] + ri[q].w;
                v4u* p0 = (v4u*)(hs + (size_t)d0 * DM) + F.lane; v4u* p1 = (v4u*)(hs + (size_t)d1 * DM) + F.lane;
                p0[0] = a[q]; p0[64] = b[q]; p1[0] = a[q]; p1[64] = b[q];
                if (F.lane == 0) { wrow[d0] = ww[q].x; wrow[d1] = ww[q].y; rrow[d0] = ww[q].z; rrow[d1] = ww[q].z; *(v2u*)(pos + (size_t)m * 2) = (v2u){d0, d1}; } } }
    }
    __syncthreads();
}

__device__ __forceinline__ void phase_combine(const Frame& F0, const bf16* x, bf16* xdst16, float* xdst32, const bf16* ys, const unsigned* pos, const float* ngain, bf16* hout) {
    const Frame F = fresh(F0);
    const int gw = F.bid * 8 + F.wave, NGW = F.G * 8;
    f32x4 g[4];
#pragma unroll
    for (int j = 0; j < 4; ++j) g[j] = ngain ? *(const f32x4*)(ngain + 4 * F.lane + 256 * j) : (f32x4){0.f, 0.f, 0.f, 0.f};
    for (int m0 = gw; m0 < T; m0 += 2 * NGW) {
        v2u pp[2];
#pragma unroll
        for (int q = 0; q < 2; ++q) { const int m = m0 + q * NGW; pp[q] = (m < T) ? *(const v2u*)(pos + (size_t)m * 2) : (v2u){0u, 0u}; }
        v2u xv[2][4], ya[2][4], yb[2][4];
#pragma unroll
        for (int q = 0; q < 2; ++q) { const int m = m0 + q * NGW; if (m < T) {
                const v2u* xr = (const v2u*)(x + (size_t)m * DM) + F.lane; const v2u* y0 = (const v2u*)(ys + (size_t)pp[q].x * DM) + F.lane; const v2u* y1 = (const v2u*)(ys + (size_t)pp[q].y * DM) + F.lane;
#pragma unroll
                for (int j = 0; j < 4; ++j) { xv[q][j] = xr[64 * j]; ya[q][j] = y0[64 * j]; yb[q][j] = y1[64 * j]; } } }
#pragma unroll
        for (int q = 0; q < 2; ++q) { const int m = m0 + q * NGW; if (m < T) {
                float s = 0.f; f32x4 v[4];
#pragma unroll
                for (int j = 0; j < 4; ++j) { const v2u c = xv[q][j], a = ya[q][j], b = yb[q][j]; f32x4 t;
                    t.x = bflo(c.x) + bflo(a.x) + bflo(b.x); t.y = bfhi(c.x) + bfhi(a.x) + bfhi(b.x); t.z = bflo(c.y) + bflo(a.y) + bflo(b.y); t.w = bfhi(c.y) + bfhi(a.y) + bfhi(b.y);
                    v[j] = t; s += (t.x * t.x + t.y * t.y) + (t.z * t.z + t.w * t.w); }
                if (xdst32) { f32x4* xw = (f32x4*)(xdst32 + (size_t)m * DM) + F.lane;
#pragma unroll
                    for (int j = 0; j < 4; ++j) xw[64 * j] = v[j]; }
                else { v2u* xw = (v2u*)(xdst16 + (size_t)m * DM) + F.lane;
#pragma unroll
                    for (int j = 0; j < 4; ++j) { v2u w; w.x = pk2(v[j].x, v[j].y); w.y = pk2(v[j].z, v[j].w); xw[64 * j] = w; } }
                if (ngain) {
                    const float r = rsqrtf(wave_sum(s) * (1.f / DM) + RMS_EPS);
                    v2u* o8 = (v2u*)(hout + (size_t)m * DM) + F.lane;
#pragma unroll
                    for (int j = 0; j < 4; ++j) { v2u w; w.x = pk2(v[j].x * r * g[j].x, v[j].y * r * g[j].y); w.y = pk2(v[j].z * r * g[j].z, v[j].w * r * g[j].w); o8[64 * j] = w; }
                } } }
    }
}

constexpr int PH_PER_LAYER = 11, N_PHASES = 1 + DEPTH * PH_PER_LAYER;
__device__ __forceinline__ CArgs& kargs() { CArgs* p = (CArgs*)__builtin_amdgcn_kernarg_segment_ptr(); asm volatile("" : "+s"(p)); return *p; }
__global__ void __launch_bounds__(512, 2) mk_fwd(Args args_unused) {
    extern __shared__ __attribute__((aligned(16))) unsigned char lds[];
    LAS unsigned char* lds3 = (LAS unsigned char*)lds;
    const int wave_s = __builtin_amdgcn_readfirstlane(threadIdx.x >> 6);
    for (int u = threadIdx.x; u < (LDS_BYTES - LDSCTL_OFF) / 4; u += 512) ((LAS unsigned*)(lds3 + LDSCTL_OFF))[u] = 0u;
    __syncthreads();
#if MK_SPLIT
#define GRID_BAR() do { } while (0)
#else
    (void)xcd_barrier_post((unsigned*)(kargs().ws + WS_CTL) + CW_BAR, (volatile LAS unsigned*)(lds3 + LDSCTL_OFF));
#define GRID_BAR() do { XcdBarrier b_; b_.bar = (unsigned*)(kargs().ws + WS_CTL) + CW_BAR; b_.x = xb_xcc_id(); b_.st = (volatile LAS unsigned*)(lds3 + LDSCTL_OFF); xcd_barrier(b_); } while (0)
#endif
#define IN(k) (kargs().ph_lo <= (k) && (k) < kargs().ph_hi)
#define SEAM(k) do { if (IN(k) && IN((k) + 1)) GRID_BAR(); } while (0)
#define FRAME() CArgs& A = kargs(); Frame F; F.lds = lds; F.lane = lane_id_asm(); { int w_ = wave_s; asm volatile("" : "+s"(w_)); F.wave = w_; } F.tid = F.wave * 64 + F.lane; { int g_ = gridDim.x, b_ = blockIdx.x; asm volatile("" : "+s"(g_), "+s"(b_)); F.G = g_; F.bid = b_; } \
    unsigned char* ws = A.ws; F.ws = ws; F.ctl = (unsigned*)(ws + WS_CTL); (void)F;
#define WSP(T_, off) ((T_*)(ws + (off)))

#ifdef EXTRA_BARS
    for (int eb_ = 0; eb_ < EXTRA_BARS; ++eb_) GRID_BAR();
#endif
    if (IN(0) && PHON(11)) { for (int rep_ = 0; rep_ < REPN(11); ++rep_) { if (rep_) GRID_BAR(); { FRAME(); phase_prologue(F, A); }
        { FRAME(); phase_norm(F, A.in[I_X], A.in[I_MIXG], WSP(bf16, WS_H)); } } }
    SEAM(0);
#pragma unroll 1
    for (int l = 0; l < DEPTH; ++l) {
        const int p0 = 1 + l * PH_PER_LAYER;
        if (IN(p0 + 1) && PHON(1)) { for (int rep_ = 0; rep_ < REPN(1); ++rep_) { if (rep_) GRID_BAR(); { FRAME();
            pg8::Gemm g{DM, DM, DM};
            SchedDense S{(const char*)(ws + WS_H), (const char*)(ws + WS_WIN) + (size_t)l * NCOL * DM * 2, T / 256, NCOL / 256, F.G, F.bid, (size_t)256 * DM * 2, (size_t)256 * DM * 2};
            EpiStoreBf16 E{WSP(bf16, WS_PROJ), NCOL, C_GL, A.in[I_BGATE] + l * 3 * DM, WSP(v4u, WS_GT)};
            pg8::gemm_phase<EpiStoreBf16, SchedDense, true, true>(lds3, g, S, E, F.tid);
        } } }
        SEAM(p0 + 1);
        if (IN(p0 + 2) && PHON(2)) { for (int rep_ = 0; rep_ < REPN(2); ++rep_) { if (rep_) GRID_BAR(); {
            for (int r2_ = 0; r2_ < REPN(14); ++r2_) { FRAME(); phase_qkprep(F, WSP(bf16, WS_PROJ), A.in[I_QG] + l * 64, A.in[I_KG] + l * 64, WSP(bf16, WS_Q), WSP(bf16, WS_K), WSP(float, WS_KMEAN)); }
            for (int r2_ = 0; r2_ < REPN(15); ++r2_) { FRAME(); phase_conv(F, WSP(bf16, WS_PROJ), A.in[I_CONVW] + (size_t)l * 31 * 512, A.in[I_CONVB] + l * 512, A.in[I_CLNG] + l * 512, A.in[I_CLNB] + l * 512, WSP(bf16, WS_CAT)); }
            for (int r2_ = 0; r2_ < REPN(16); ++r2_) { FRAME(); phase_hgrn1(F, WSP(bf16, WS_PROJ), A.in[I_LBL], l, WSP(float, WS_HS), WSP(float, WS_HS + 16 * MiB), WSP(float, WS_ORAW), WSP(bf16, WS_HS + 17 * MiB)); }
        } } }
        SEAM(p0 + 2);
        if (IN(p0 + 3) && PHON(3)) { for (int rep_ = 0; rep_ < REPN(3); ++rep_) { if (rep_) GRID_BAR(); {
            for (int r2_ = 0; r2_ < REPN(12); ++r2_) { FRAME(); phase_attn_mfma(F, WSP(bf16, WS_Q), WSP(bf16, WS_K), WSP(bf16, WS_PROJ), WSP(float, WS_KMEAN), WSP(bf16, WS_CAT)); }
            for (int r2_ = 0; r2_ < REPN(13); ++r2_) { FRAME(); phase_hgrn2(F, WSP(bf16, WS_PROJ), A.in[I_HGG] + l * 128, WSP(float, WS_HS), WSP(float, WS_HS + 16 * MiB), WSP(float, WS_ORAW), WSP(bf16, WS_HS + 17 * MiB), WSP(bf16, WS_CAT), (r2_ + 1 < REPN(13)) ? PROBE_DRY : 0); }
        } } }
        SEAM(p0 + 3);
        if (IN(p0 + 4) && PHON(4)) { for (int rep_ = 0; rep_ < REPN(4); ++rep_) { if (rep_) GRID_BAR(); { FRAME();
            pg8::Gemm g{1536, 512, 512};
            SchedBranch S{(const char*)(ws + WS_CAT), (const char*)(ws + WS_WCAT) + (size_t)l * 3 * DM * 512 * 2, F.G, F.bid};
            EpiBranch E{WSP(const v4u, WS_GT), WSP(bf16, WS_MERGED)};
            pg8::gemm_phase<EpiBranch, SchedBranch, true, true>(lds3, g, S, E, F.tid);
        } } }
        SEAM(p0 + 4);
        if (IN(p0 + 5) && PHON(5)) { for (int rep_ = 0; rep_ < REPN(5); ++rep_) { if (rep_) GRID_BAR(); { FRAME();
            pg8::Gemm g{DM, DM, DM};
            SchedDense S{(const char*)(ws + WS_MERGED), (const char*)(ws + WS_WOUT) + (size_t)l * DM * DM * 2, T / 256, DM / 256, F.G, F.bid, (size_t)256 * DM * 2, (size_t)256 * DM * 2};
            EpiResidual E{(l == 0) ? A.in[I_X] : (const float*)nullptr, (l == 0) ? (const bf16*)nullptr : WSP(const bf16, WS_XB), (rep_ + 1 >= REPN(5)) ? WSP(bf16, WS_XB) : WSP(bf16, WS_HS)};
            pg8::gemm_phase<EpiResidual, SchedDense, true, true>(lds3, g, S, E, F.tid);
        } } }
        SEAM(p0 + 5);
        if (IN(p0 + 6) && PHON(6)) { for (int rep_ = 0; rep_ < REPN(6); ++rep_) { if (rep_) GRID_BAR(); { FRAME(); phase_router2(F, WSP(const bf16, WS_XB), A.in[I_FFNG] + l * DM, A.in[I_WCO] + (size_t)l * DM * 4, A.in[I_BCO] + l * 4, A.in[I_WFI] + (size_t)l * DM * 32, A.in[I_BFI] + l * 32, WSP(bf16, WS_H), WSP(unsigned, WS_ROUTE), F.ctl + CW_CNT + l * 32 * 64, WSP(float, WS_Q), rep_ + 1 >= REPN(6)); } } }
        SEAM(p0 + 6);
        if (IN(p0 + 7) && PHON(7)) { for (int rep_ = 0; rep_ < REPN(7); ++rep_) { if (rep_) GRID_BAR(); { FRAME(); phase_scatter(F, WSP(bf16, WS_H), WSP(unsigned, WS_ROUTE), F.ctl + CW_CNT + l * 32 * 64, F.ctl + CW_NT + l * 64, F.ctl + CW_TILE + l * 256, WSP(bf16, WS_HS), WSP(float, WS_POS + 512 * 1024), WSP(float, WS_POS + 768 * 1024), WSP(unsigned, WS_POS)); } } }
        SEAM(p0 + 7);
        if (IN(p0 + 8) && PHON(8)) { for (int rep_ = 0; rep_ < REPN(8); ++rep_) { if (rep_) GRID_BAR(); { FRAME();
            pg8::Gemm g{DM, DM, DM};
            SchedMoe S{(const char*)(ws + WS_HS), (const char*)(ws + WS_WEI) + (size_t)l * NEXP * 1024 * DM * 2, F.ctl + CW_NT + l * 64, F.ctl + CW_TILE + l * 256, F.G, F.bid, (size_t)256 * DM * 2, (size_t)1024 * DM * 2, (size_t)256 * DM * 2};
            EpiSwiglu E{WSP(bf16, WS_ACT), WSP(float, WS_POS + 768 * 1024)};
            pg8::gemm_phase<EpiSwiglu, SchedMoe, true, true>(lds3, g, S, E, F.tid);
        } } }
        SEAM(p0 + 8);
        if (IN(p0 + 9) && PHON(9)) { for (int rep_ = 0; rep_ < REPN(9); ++rep_) { if (rep_) GRID_BAR(); { FRAME();
            pg8::Gemm g{FF, FF, FF};
            SchedMoe S{(const char*)(ws + WS_ACT), (const char*)(ws + WS_WEO) + (size_t)l * NEXP * DM * FF * 2, F.ctl + CW_NT + l * 64, F.ctl + CW_TILE + l * 256, F.G, F.bid, (size_t)256 * FF * 2, (size_t)DM * FF * 2, (size_t)256 * FF * 2};
            EpiScaleRows E{WSP(bf16, WS_YS), WSP(float, WS_POS + 512 * 1024)};
            pg8::gemm_phase<EpiScaleRows, SchedMoe, true, true>(lds3, g, S, E, F.tid);
        } } }
        SEAM(p0 + 9);
        if (IN(p0 + 10) && PHON(10)) { for (int rep_ = 0; rep_ < REPN(10); ++rep_) { if (rep_) GRID_BAR(); { FRAME(); const bool real_ = (rep_ + 1 >= REPN(10)), lastl_ = (l + 1 >= DEPTH); phase_combine(F, WSP(const bf16, WS_XB), (real_ && !lastl_) ? WSP(bf16, WS_XB) : WSP(bf16, WS_HS), (real_ && lastl_) ? A.out : (float*)nullptr, WSP(bf16, WS_YS), WSP(unsigned, WS_POS), lastl_ ? (const float*)nullptr : A.in[I_MIXG] + (l + 1) * DM, WSP(bf16, WS_H)); } } }
        SEAM(p0 + 10);
    }
#undef IN
#undef SEAM
#undef FRAME
#undef WSP
}

extern "C" void kernel_launch(void* const* d_in, const int* in_sizes, int n_in, void* d_out, int out_size, void* d_ws, size_t ws_size, hipStream_t stream) {
    static int grid = 0;
    if (grid == 0) {
        if (n_in != 23 || out_size != T * DM || ws_size < WS_END) { fprintf(stderr, "kernel_launch: unexpected shapes (n_in %d out %d ws %zu)\n", n_in, out_size, ws_size); grid = -1; return; }
        int dev = 0, cus = 0, per_cu = 0;
        if (hipGetDevice(&dev) != hipSuccess || hipDeviceGetAttribute(&cus, hipDeviceAttributeMultiprocessorCount, dev) != hipSuccess) { grid = -1; return; }
        if (hipFuncSetAttribute((const void*)mk_fwd, hipFuncAttributeMaxDynamicSharedMemorySize, LDS_BYTES) != hipSuccess) { fprintf(stderr, "kernel_launch: hipFuncSetAttribute failed\n"); grid = -1; return; }
        if (hipOccupancyMaxActiveBlocksPerMultiprocessor(&per_cu, (const void*)mk_fwd, 512, LDS_BYTES) != hipSuccess || per_cu < 1) fprintf(stderr, "kernel_launch: occupancy query says %d\n", per_cu);
        (void)hipGetLastError();
        grid = cus;
    }
    if (grid < 0) return;
    (void)hipMemsetAsync((char*)d_ws + WS_CTL, 0, CTL_ZERO_BYTES, stream);
    Args a{};
    for (int i = 0; i < 23; ++i) a.in[i] = (const float*)d_in[i];
    a.out = (float*)d_out; a.ws = (unsigned char*)d_ws;
#if MK_SPLIT
    for (int p = 0; p < N_PHASES; ++p) {
        if (p == 1 + PH_PER_LAYER) continue;
        a.ph_lo = p; a.ph_hi = p + 1;
        hipLaunchKernelGGL(mk_fwd, dim3(grid), dim3(512), LDS_BYTES, stream, a);
    }
#else
    a.ph_lo = 0; a.ph_hi = N_PHASES;
    hipLaunchKernelGGL(mk_fwd, dim3(grid), dim3(512), LDS_BYTES, stream, a);
#endif
}
```

```cpp
#include <hip/hip_runtime.h>
#include <cstdio>
#include <cstdint>

#ifndef MK_SPLIT
#define MK_SPLIT 0
#endif
#ifndef DBG_MASK
#define DBG_MASK 0xFFFFu
#endif
#define PHON(j) (((DBG_MASK) >> (j)) & 1u)
#ifndef REP_MASK
#define REP_MASK 0u
#endif
#ifndef REP_EXTRA
#define REP_EXTRA 1
#endif
#ifndef PROBE_DRY
#define PROBE_DRY 0
#endif
#define REPN(j) ((((REP_MASK) >> (j)) & 1u) ? (1 + REP_EXTRA) : 1)

constexpr int DM = 1024, NB = 8, SEQ = 2048, T = NB * SEQ, DEPTH = 2;
constexpr int NCOL = 7680;
constexpr int C_AQ = 0, C_AK = 512, C_AV = 1024, C_HQ = 1536, C_HF = 2048, C_HI = 2560, C_HG = 3072, C_CA = 3584, C_CB = 4096, C_GL = 4608;
constexpr int NEXP = 32, FF = 512;
constexpr int MOE_ROWS = 2 * T + NEXP * 256;
constexpr float RMS_EPS = 1e-6f, LN_EPS = 1e-5f;
constexpr float QSCALE = 0.125f * 1.4426950408889634f;

namespace pg8 {
#define PG8_LAS __attribute__((address_space(3)))
typedef unsigned short bf16_t;
typedef short bf16x8 __attribute__((ext_vector_type(8)));
typedef float f32x4 __attribute__((ext_vector_type(4)));
typedef unsigned u32x4 __attribute__((ext_vector_type(4)));
constexpr int BM = 256, BK = 64, HALF = 128, HTB = HALF * BK * 2, STAGE_BYTES = 8 * HTB, NXCD = 8, WGM = 8;

__host__ __device__ __forceinline__ int lds_byte(int r, int c) { const int st = (r >> 4) * 2 + (c >> 5), rr = r & 15, cc = c & 31, ob = rr * 64 + cc * 2; return st * 1024 + (ob ^ (((ob >> 9) & 1) << 5)); }
__host__ __device__ __forceinline__ void stage_rc(int b, int& R, int& C) { const int st = b / 1024, sb = b % 1024, swz = sb ^ (((sb >> 9) & 1) << 5); R = (st >> 1) * 16 + swz / 64; C = (st & 1) * 32 + (swz % 64) / 2; }
__host__ __device__ __forceinline__ int perm32(int rho) { const int n = rho >> 4, i = rho & 15; return 8 * (i >> 2) + 4 * n + (i & 3); }

struct Unit { int pm, pn, aux, pad; const char* a; const char* b; };
struct Gemm { int lda, ldb, K; };

__device__ __forceinline__ bool static_tile(int nM, int nN, long L, int& pm, int& pn) {
    const int nwg = nM * nN; if (L >= nwg) return false;
    int wgid = (int)L; { const int q = nwg / NXCD, r = nwg % NXCD, xcd = wgid % NXCD, off = wgid / NXCD; wgid = (xcd < r ? xcd * (q + 1) : r * (q + 1) + (xcd - r) * q) + off; }
    const int nig = WGM * nN, gid = wgid / nig, fm = gid * WGM, gsz = (nM - fm) < WGM ? (nM - fm) : WGM;
    pm = fm + ((wgid % nig) % gsz); pn = (wgid % nig) / gsz; return true;
}

__device__ __forceinline__ unsigned cvt_pk_bf16(float lo, float hi) { unsigned r; asm volatile("v_cvt_pk_bf16_f32 %0, %1, %2" : "=v"(r) : "v"(lo), "v"(hi)); return r; }

template <class Epi, class Sched, bool ALIGN_EPI = false, bool SP2 = false>
__device__ __forceinline__ void gemm_phase(PG8_LAS unsigned char* lds, const Gemm g, const Sched& S, const Epi& E, int tid_in) {
    int tid_ = tid_in; asm volatile("" : "+v"(tid_));
    const int tid = tid_, wid = __builtin_amdgcn_readfirstlane(tid >> 6), lane = tid & 63, wr = wid >> 2, wc = wid & 3, fr = lane & 15, fq = lane >> 4;
    const int K = g.K, nt = K / BK;
    unsigned voffA[2], voffB[2];
#pragma unroll
    for (int i = 0; i < 2; ++i) { int R, C; stage_rc(tid * 16 + i * 8192, R, C); const int Rb = Epi::PERM ? ((R & ~31) + perm32(R & 31)) : R;
        voffA[i] = (unsigned)(R * g.lda + C) * 2u; voffB[i] = (unsigned)(Rb * g.ldb + C) * 2u; }
    const size_t kstep = (size_t)(BK * 2);
    const size_t hstepA = (size_t)HALF * g.lda * 2, hstepB = (size_t)HALF * g.ldb * 2;
    const unsigned ldsw = (unsigned)wid * 1024u;
    const int aoff = lds_byte(wr * 64 + fr, fq * 8), boff = lds_byte(wc * 32 + fr, fq * 8);
#define PG8_SA(b, h) (((b) * 2 + (h)) * HTB)
#define PG8_SB(b, h) ((4 + (b) * 2 + (h)) * HTB)
#define PG8_STAGE(bufoff, gbase, voff) do { _Pragma("unroll") for (int _i = 0; _i < 2; ++_i) \
        __builtin_amdgcn_global_load_lds((const unsigned*)((const char*)(gbase) + (voff)[_i]), (PG8_LAS unsigned*)(lds + (bufoff) + ldsw + _i * 8192), 16, 0, 0); } while (0)
#define PG8_LDA(dst, b, h) do { _Pragma("unroll") for (int m = 0; m < 4; ++m) _Pragma("unroll") for (int k = 0; k < 2; ++k) dst[m][k] = *(const PG8_LAS bf16x8*)(lds + PG8_SA(b, h) + aoff + m * 2048 + k * 1024); } while (0)
#define PG8_LDB(dst, b, h) do { _Pragma("unroll") for (int n = 0; n < 2; ++n) _Pragma("unroll") for (int k = 0; k < 2; ++k) dst[n][k] = *(const PG8_LAS bf16x8*)(lds + PG8_SB(b, h) + boff + n * 2048 + k * 1024); } while (0)
#define PG8_MMA(ai, bj, At, Bt) do { __builtin_amdgcn_s_setprio(1); _Pragma("unroll") for (int m = 0; m < 4; ++m) _Pragma("unroll") for (int n = 0; n < 2; ++n) _Pragma("unroll") for (int k = 0; k < 2; ++k) \
        acc[ai][bj][m][n] = __builtin_amdgcn_mfma_f32_16x16x32_bf16(Bt[n][k], At[m][k], acc[ai][bj][m][n], 0, 0, 0); __builtin_amdgcn_s_setprio(0); } while (0)
#define PG8_WAIT_V(n) asm volatile("s_waitcnt vmcnt(" #n ")" ::: "memory")
#define PG8_WAIT_L(n) asm volatile("s_waitcnt lgkmcnt(" #n ")" ::: "memory")
#define PG8_BAR __builtin_amdgcn_s_barrier()
#define PG8_SCHED __builtin_amdgcn_sched_barrier(0)
    Unit cur, nxt; int ui = 0;
    if (!S.next(0, cur)) return;
    f32x4 acc[2][2][4][2];
#pragma unroll
    for (int a = 0; a < 2; ++a)
#pragma unroll
        for (int b = 0; b < 2; ++b)
#pragma unroll
            for (int m = 0; m < 4; ++m)
#pragma unroll
                for (int n = 0; n < 2; ++n) acc[a][b][m][n] = (f32x4){0.f, 0.f, 0.f, 0.f};
    bf16x8 At[4][2], B0[2][2], B1[2][2];
    const char* cA = cur.a; const char* cB = cur.b;
    if constexpr (SP2) {
        PG8_STAGE(PG8_SB(0, 0), cB, voffB); PG8_STAGE(PG8_SB(0, 1), cB + hstepB, voffB); PG8_STAGE(PG8_SA(0, 0), cA, voffA); PG8_STAGE(PG8_SA(0, 1), cA + hstepA, voffA);
        if (wr == 1) PG8_BAR;
        PG8_WAIT_V(2); PG8_BAR;
        PG8_STAGE(PG8_SB(1, 0), cB + kstep, voffB); PG8_STAGE(PG8_SA(1, 0), cA + kstep, voffA); PG8_STAGE(PG8_SB(1, 1), cB + hstepB + kstep, voffB);
        PG8_WAIT_V(6); PG8_BAR;
    } else {
        PG8_STAGE(PG8_SB(0, 0), cB, voffB); PG8_STAGE(PG8_SA(0, 0), cA, voffA); PG8_STAGE(PG8_SB(0, 1), cB + hstepB, voffB); PG8_STAGE(PG8_SA(0, 1), cA + hstepA, voffA);
        if (wr == 1) PG8_BAR;
        PG8_WAIT_V(4); PG8_BAR;
        PG8_STAGE(PG8_SB(1, 0), cB + kstep, voffB); PG8_STAGE(PG8_SA(1, 0), cA + kstep, voffA); PG8_STAGE(PG8_SB(1, 1), cB + hstepB + kstep, voffB);
        PG8_WAIT_V(6); PG8_BAR;
    }
    for (;;) {
        const bool has_next = S.next(ui + 1, nxt);
        const char* nA = has_next ? nxt.a : cA; const char* nB = has_next ? nxt.b : cB;
        for (int t = 0; t < nt; t += 2) {
            const bool last = (t == nt - 2);
            const char* a1 = cA + (size_t)(t + 1) * kstep;
            const char* a2 = last ? nA : cA + (size_t)(t + 2) * kstep; const char* b2 = last ? nB : cB + (size_t)(t + 2) * kstep;
            const char* a3 = a2 + kstep; const char* b3 = b2 + kstep;
            if constexpr (SP2) {
            PG8_LDB(B0, 0, 0); PG8_LDB(B1, 0, 1); PG8_SCHED; PG8_LDA(At, 0, 0); PG8_STAGE(PG8_SA(1, 1), a1 + hstepA, voffA);
            PG8_WAIT_V(8); PG8_WAIT_L(0); PG8_BAR; PG8_MMA(0, 0, At, B0); PG8_MMA(0, 1, At, B1); PG8_BAR; PG8_SCHED;
            PG8_LDA(At, 0, 1); PG8_STAGE(PG8_SB(0, 0), b2, voffB); PG8_STAGE(PG8_SB(0, 1), b2 + hstepB, voffB); PG8_STAGE(PG8_SA(0, 0), a2, voffA);
            PG8_WAIT_V(8); PG8_WAIT_L(0); PG8_BAR; PG8_MMA(1, 0, At, B0); PG8_MMA(1, 1, At, B1); PG8_BAR; PG8_SCHED;
            PG8_LDB(B0, 1, 0); PG8_LDB(B1, 1, 1); PG8_SCHED; PG8_LDA(At, 1, 0); PG8_STAGE(PG8_SA(0, 1), a2 + hstepA, voffA);
            PG8_WAIT_V(8); PG8_WAIT_L(0); PG8_BAR; PG8_MMA(0, 0, At, B0); PG8_MMA(0, 1, At, B1); PG8_BAR; PG8_SCHED;
            PG8_LDA(At, 1, 1); PG8_STAGE(PG8_SB(1, 0), b3, voffB); PG8_STAGE(PG8_SB(1, 1), b3 + hstepB, voffB); PG8_STAGE(PG8_SA(1, 0), a3, voffA);
            PG8_WAIT_V(8); PG8_WAIT_L(0); PG8_BAR; PG8_MMA(1, 0, At, B0); PG8_MMA(1, 1, At, B1); PG8_BAR; PG8_SCHED;
            } else {
            PG8_LDB(B0, 0, 0); PG8_SCHED; PG8_LDA(At, 0, 0); PG8_STAGE(PG8_SA(1, 1), a1 + hstepA, voffA);
            PG8_WAIT_L(8); PG8_BAR; PG8_WAIT_L(0); PG8_MMA(0, 0, At, B0); PG8_BAR; PG8_SCHED;
            PG8_LDB(B1, 0, 1); PG8_STAGE(PG8_SB(0, 0), b2, voffB);
            PG8_BAR; PG8_WAIT_L(0); PG8_MMA(0, 1, At, B1); PG8_BAR;
            PG8_LDA(At, 0, 1); PG8_STAGE(PG8_SA(0, 0), a2, voffA);
            PG8_BAR; PG8_WAIT_L(0); PG8_MMA(1, 0, At, B0); PG8_BAR; PG8_SCHED;
            PG8_STAGE(PG8_SB(0, 1), b2 + hstepB, voffB);
            PG8_WAIT_V(6); PG8_BAR; PG8_MMA(1, 1, At, B1); PG8_BAR;
            PG8_LDB(B0, 1, 0); PG8_SCHED; PG8_LDA(At, 1, 0); PG8_STAGE(PG8_SA(0, 1), a2 + hstepA, voffA);
            PG8_WAIT_L(8); PG8_BAR; PG8_WAIT_L(0); PG8_MMA(0, 0, At, B0); PG8_BAR; PG8_SCHED;
            PG8_LDB(B1, 1, 1); PG8_STAGE(PG8_SB(1, 0), b3, voffB);
            PG8_BAR; PG8_WAIT_L(0); PG8_MMA(0, 1, At, B1); PG8_BAR;
            PG8_LDA(At, 1, 1); PG8_STAGE(PG8_SA(1, 0), a3, voffA);
            PG8_BAR; PG8_WAIT_L(0); PG8_MMA(1, 0, At, B0); PG8_BAR; PG8_SCHED;
            PG8_STAGE(PG8_SB(1, 1), b3 + hstepB, voffB);
            PG8_WAIT_V(6); PG8_BAR; PG8_MMA(1, 1, At, B1); PG8_BAR;
            }
        }
        if constexpr (ALIGN_EPI) { if (wr == 0) PG8_BAR; }
        const bool reset_acc = E(acc, cur, wr, wc, fr, fq);
        if (!has_next) break;
        if (reset_acc) {
#pragma unroll
        for (int a = 0; a < 2; ++a)
#pragma unroll
            for (int b = 0; b < 2; ++b)
#pragma unroll
                for (int m = 0; m < 4; ++m)
#pragma unroll
                    for (int n = 0; n < 2; ++n) acc[a][b][m][n] = (f32x4){0.f, 0.f, 0.f, 0.f};
        }
        cur = nxt; cA = nA; cB = nB; ++ui;
        if constexpr (ALIGN_EPI) { if (wr == 1) PG8_BAR; }
    }
    PG8_WAIT_V(0);
    if constexpr (!ALIGN_EPI) { if (wr == 0) PG8_BAR; }
    PG8_BAR;
#undef PG8_SA
#undef PG8_SB
#undef PG8_STAGE
#undef PG8_LDA
#undef PG8_LDB
#undef PG8_MMA
#undef PG8_WAIT_V
#undef PG8_WAIT_L
#undef PG8_BAR
#undef PG8_SCHED
}
}

constexpr size_t MiB = 1u << 20;
constexpr size_t WS_CTL = 0, CTL_ZERO_BYTES = 1 * MiB;
constexpr size_t WS_WIN = 2 * MiB;
constexpr size_t WS_WCAT = WS_WIN + 30 * MiB;
constexpr size_t WS_WOUT = WS_WCAT + 6 * MiB;
constexpr size_t WS_WEI = WS_WOUT + 4 * MiB;
constexpr size_t WS_WEO = WS_WEI + 128 * MiB;
constexpr size_t WS_H = WS_WEO + 64 * MiB;
constexpr size_t WS_PROJ = WS_H + 32 * MiB;
constexpr size_t WS_Q = WS_PROJ + 240 * MiB;
constexpr size_t WS_K = WS_Q + 16 * MiB;
constexpr size_t WS_KMEAN = WS_K + 16 * MiB;
constexpr size_t WS_CAT = WS_KMEAN + 1 * MiB;
constexpr size_t WS_MERGED = WS_CAT + 48 * MiB;
constexpr size_t WS_ORAW = WS_MERGED + 32 * MiB;
constexpr size_t WS_ROUTE = WS_ORAW + 32 * MiB;
constexpr size_t WS_POS = WS_ROUTE + 1 * MiB;
constexpr size_t WS_HS = WS_POS + 1 * MiB;
constexpr size_t WS_ACT = WS_HS + 80 * MiB;
constexpr size_t WS_YS = WS_ACT + 40 * MiB;
constexpr size_t WS_XB = WS_YS + 80 * MiB;
constexpr size_t WS_GT = WS_XB + 32 * MiB;
constexpr size_t WS_END = WS_GT + 96 * MiB;
static_assert(WS_END <= 1000 * MiB, "workspace map");
constexpr int CW_BAR = 4096;
constexpr int CW_CNT = 16384;
constexpr int CW_NT = CW_CNT + 2 * 32 * 64;
constexpr int CW_TILE = CW_NT + 2 * 64;
static_assert((CW_TILE + 2 * 256) * 4 <= (int)CTL_ZERO_BYTES, "ctl");

constexpr int LDS_SCRATCH = 155136, LDSCTL_OFF = LDS_SCRATCH, LDS_BYTES = 155648;

#define GAS __attribute__((address_space(1)))
#define LAS __attribute__((address_space(3)))
typedef unsigned short bf16;
typedef unsigned v4u __attribute__((ext_vector_type(4)));
typedef unsigned v2u __attribute__((ext_vector_type(2)));
typedef float f32x4 __attribute__((ext_vector_type(4)));
typedef float f32x2 __attribute__((ext_vector_type(2)));
#define RLX_AGENT __ATOMIC_RELAXED, __HIP_MEMORY_SCOPE_AGENT
__device__ __forceinline__ unsigned f2bf(float f) { unsigned u = __builtin_bit_cast(unsigned, f); return (u + 0x7fffu + ((u >> 16) & 1u)) >> 16; }
__device__ __forceinline__ unsigned pk2(float lo, float hi) { unsigned r; asm("v_cvt_pk_bf16_f32 %0, %1, %2" : "=v"(r) : "v"(lo), "v"(hi)); return r; }
__device__ __forceinline__ float bflo(unsigned w) { return __uint_as_float(w << 16); }
__device__ __forceinline__ float bfhi(unsigned w) { return __uint_as_float(w & 0xffff0000u); }
__device__ __forceinline__ float bf2f(bf16 v) { return __uint_as_float((unsigned)v << 16); }
__device__ __forceinline__ float sigmoidf_(float x) { return __builtin_amdgcn_rcpf(1.0f + __expf(-x)); }
__device__ __forceinline__ float wave_sum(float v) {
    v += __int_as_float(__builtin_amdgcn_update_dpp(0, __float_as_int(v), 0xB1, 0xf, 0xf, true));
    v += __int_as_float(__builtin_amdgcn_update_dpp(0, __float_as_int(v), 0x4E, 0xf, 0xf, true));
    v += __int_as_float(__builtin_amdgcn_update_dpp(0, __float_as_int(v), 0x141, 0xf, 0xf, true));
    v += __int_as_float(__builtin_amdgcn_update_dpp(0, __float_as_int(v), 0x140, 0xf, 0xf, true));
    { auto r = __builtin_amdgcn_permlane16_swap(__float_as_uint(v), __float_as_uint(v), false, false); v = __uint_as_float(r[0]) + __uint_as_float(r[1]); }
    { auto r = __builtin_amdgcn_permlane32_swap(__float_as_uint(v), __float_as_uint(v), false, false); v = __uint_as_float(r[0]) + __uint_as_float(r[1]); }
    return v;
}

__device__ __forceinline__ void lds_barrier() { asm volatile("s_waitcnt lgkmcnt(0)\n\ts_barrier" ::: "memory"); }

#define XB_TMO      128
#define XB_XCNT(j)  (256  + 64 * (j))
#define XB_XSUB(j)  (1280 + 64 * (j))
#define XB_XGEN(j)  (2304 + 64 * (j))
#define XB_TOP      3328
#define XB_TOPGEN   3392
#define XCD_BAR_WORDS 3456
#define XB_SPIN_CAP (1u << 18)
__device__ __forceinline__ unsigned xb_ld(unsigned* p)              { return __hip_atomic_load(p, __ATOMIC_RELAXED, __HIP_MEMORY_SCOPE_AGENT); }
__device__ __forceinline__ unsigned xb_add(unsigned* p, unsigned v) { return __hip_atomic_fetch_add(p, v, __ATOMIC_RELAXED, __HIP_MEMORY_SCOPE_AGENT); }
__device__ __forceinline__ unsigned xb_xcc_id() { return (unsigned)__builtin_amdgcn_s_getreg((3 << 11) | 20) & 0xFu; }
#define XB_SPIN(cond, bar) do { unsigned _sp = 0; while (cond) { __builtin_amdgcn_s_sleep(1); \
    if ((++_sp & 255u) == 0u) { if (xb_ld(&(bar)[XB_TMO])) break; if (_sp > XB_SPIN_CAP) { atomicAdd(&(bar)[XB_TMO], 1u); break; } } } } while (0)
struct XcdBarrier { unsigned* bar; unsigned x; volatile LAS unsigned* st; };
__device__ __forceinline__ XcdBarrier xcd_barrier_post(unsigned* bar, volatile LAS unsigned* st) {
    XcdBarrier b; b.bar = bar; b.x = xb_xcc_id(); b.st = st;
    if (threadIdx.x == 0) (void)xb_add(&bar[XB_XCNT(b.x)], 1u);
    return b;
}
__device__ __forceinline__ void xcd_barrier_complete(unsigned* bar, unsigned x, unsigned& nloc, unsigned& nx) {
    const unsigned G = gridDim.x * gridDim.y * gridDim.z;
    unsigned sum, cnt, mine, sp = 0u;
    for (;;) {
        sum = 0u; cnt = 0u; mine = 0u;
#pragma unroll
        for (unsigned j = 0; j < 16; ++j) { const unsigned c = xb_ld(&bar[XB_XCNT(j)]); sum += c; cnt += (c > 0u) ? 1u : 0u; mine = (j == x) ? c : mine; }
        if (sum == G) break;
        __builtin_amdgcn_s_sleep(1);
        if ((++sp & 255u) == 0u) { if (xb_ld(&bar[XB_TMO])) break; if (sp > XB_SPIN_CAP) { atomicAdd(&bar[XB_TMO], 1u); break; } }
    }
    nloc = mine > 0u ? mine : 1u; nx = cnt > 0u ? cnt : 1u;
}
__device__ __forceinline__ void xcd_barrier(const XcdBarrier& b) {
    asm volatile("s_waitcnt vmcnt(0)" ::: "memory");
    __syncthreads();
    if (threadIdx.x == 0) {
        unsigned* bar = b.bar;
        __builtin_amdgcn_s_waitcnt(0);
        unsigned nloc = b.st[0], nx = b.st[1];
        if (nloc == 0u) { xcd_barrier_complete(bar, b.x, nloc, nx); b.st[0] = nloc; b.st[1] = nx; }
        const unsigned old = xb_add(&bar[XB_XSUB(b.x)], 1u);
        const unsigned gen = old / nloc;
        if (old + 1u == (gen + 1u) * nloc) {
            __builtin_amdgcn_fence(__ATOMIC_RELEASE, "agent");
            asm volatile("s_waitcnt vmcnt(0)" ::: "memory");
            const unsigned og = xb_add(&bar[XB_TOP], 1u);
            const unsigned tg = og / nx;
            if (og + 1u == (tg + 1u) * nx) xb_add(&bar[XB_TOPGEN], 1u);
            else XB_SPIN(xb_ld(&bar[XB_TOPGEN]) == tg, bar);
            __builtin_amdgcn_fence(__ATOMIC_ACQUIRE, "agent");
            xb_add(&bar[XB_XGEN(b.x)], 1u);
            asm volatile("s_waitcnt vmcnt(0)" ::: "memory");
        } else {
            XB_SPIN(xb_ld(&bar[XB_XGEN(b.x)]) == gen, bar);
            __builtin_amdgcn_fence(__ATOMIC_ACQUIRE, "agent");
            asm volatile("s_waitcnt vmcnt(0)" ::: "memory");
        }
    }
    __syncthreads();
}

struct Args { const float* in[23]; float* out; unsigned char* ws; int ph_lo, ph_hi; };
typedef const Args __attribute__((address_space(4))) CArgs;
enum InIdx { I_X = 0, I_MIXG, I_WIN, I_BGATE, I_QG, I_KG, I_LBL, I_HGG, I_CONVW, I_CONVB, I_CLNG, I_CLNB, I_WATT, I_WHGRN, I_WCONV, I_WOUT, I_FFNG, I_WCO, I_BCO, I_WFI, I_BFI, I_WEI, I_WEO };

struct Frame {
    unsigned char* lds;
    int tid, lane, wave, G, bid;
    unsigned char* ws; unsigned* ctl;
};
__device__ __forceinline__ int lane_id_asm() { int l; asm volatile("v_mbcnt_lo_u32_b32 %0, -1, 0\n\tv_mbcnt_hi_u32_b32 %0, -1, %0" : "=v"(l)); return l; }
__device__ __forceinline__ Frame fresh(Frame F) { asm volatile("" : "+v"(F.tid)); F.lane = F.tid & 63; return F; }

struct TItem { const float* W; bf16* WT; int K, N, k0, n0, drow0; };
__device__ __forceinline__ void titem_load(const TItem& t, int lane, float (&v)[32]) {
#pragma unroll
    for (int i = 0; i < 32; ++i) { const int kk = 2 * i + (lane >> 5); v[i] = __builtin_nontemporal_load(t.W + (size_t)(t.k0 + kk) * t.N + t.n0 + (lane & 31)); }
}
__device__ __forceinline__ void titem_emit(const TItem& t, int lane, const float (&v)[32], float* scr) {
#pragma unroll
    for (int i = 0; i < 32; ++i) { const int kk = 2 * i + (lane >> 5); scr[kk * 33 + (lane & 31)] = v[i]; }
    asm volatile("s_waitcnt lgkmcnt(0)" ::: "memory");
    const int c = lane & 7;
#pragma unroll
    for (int j = 0; j < 4; ++j) { const int n = (lane >> 3) + 8 * j; const float* s = scr + (8 * c) * 33 + n;
        v4u o; o.x = pk2(s[0 * 33], s[1 * 33]); o.y = pk2(s[2 * 33], s[3 * 33]); o.z = pk2(s[4 * 33], s[5 * 33]); o.w = pk2(s[6 * 33], s[7 * 33]);
        *(v4u*)(t.WT + (size_t)(t.drow0 + n) * t.K + t.k0 + 8 * c) = o; }
    asm volatile("s_waitcnt lgkmcnt(0)" ::: "memory");
}
__device__ __forceinline__ TItem titem_decode(CArgs& A, unsigned char* ws, int it) {
    constexpr int I_IN = (DM / 64) * (NCOL / 32), I_BR = (512 / 64) * (DM / 32), I_OUT = (DM / 64) * (DM / 32), I_EI = (DM / 64) * (1024 / 32), I_EO = (FF / 64) * (DM / 32);
    constexpr int PER_L = I_IN + 3 * I_BR + I_OUT + NEXP * I_EI + NEXP * I_EO;
    TItem t; const int l = it / PER_L; int r = it % PER_L;
    if (r < I_IN) { const int nblk = NCOL / 32, kb = r / nblk, nb = r % nblk;
        t.W = A.in[I_WIN] + (size_t)l * DM * NCOL; t.K = DM; t.N = NCOL; t.WT = (bf16*)(ws + WS_WIN) + (size_t)l * NCOL * DM; t.k0 = 64 * kb; t.n0 = 32 * nb; t.drow0 = 32 * nb; return t; }
    r -= I_IN;
    if (r < 3 * I_BR) { const int br = r / I_BR, rr = r % I_BR, nblk = DM / 32, kb = rr / nblk, nb = rr % nblk;
        t.W = A.in[br == 0 ? I_WATT : (br == 1 ? I_WHGRN : I_WCONV)] + (size_t)l * 512 * DM; t.K = 512; t.N = DM; t.WT = (bf16*)(ws + WS_WCAT) + ((size_t)l * 3 + br) * DM * 512; t.k0 = 64 * kb; t.n0 = 32 * nb; t.drow0 = 32 * nb; return t; }
    r -= 3 * I_BR;
    if (r < I_OUT) { const int nblk = DM / 32, kb = r / nblk, nb = r % nblk;
        t.W = A.in[I_WOUT] + (size_t)l * DM * DM; t.K = DM; t.N = DM; t.WT = (bf16*)(ws + WS_WOUT) + (size_t)l * DM * DM; t.k0 = 64 * kb; t.n0 = 32 * nb; t.drow0 = 32 * nb; return t; }
    r -= I_OUT;
    if (r < NEXP * I_EI) { const int e = r / I_EI, rr = r % I_EI, nblk = 1024 / 32, kb = rr / nblk, nb = rr % nblk, n0 = 32 * nb;
        const int nn = n0 & 511;
        t.W = A.in[I_WEI] + ((size_t)l * NEXP + e) * DM * 1024; t.K = DM; t.N = 1024; t.WT = (bf16*)(ws + WS_WEI) + ((size_t)l * NEXP + e) * 1024 * DM; t.k0 = 64 * kb; t.n0 = n0; t.drow0 = (nn >> 7) * 256 + (n0 >= 512 ? 128 : 0) + (nn & 127); return t; }
    r -= NEXP * I_EI;
    { const int e = r / I_EO, rr = r % I_EO, nblk = DM / 32, kb = rr / nblk, nb = rr % nblk;
        t.W = A.in[I_WEO] + ((size_t)l * NEXP + e) * FF * DM; t.K = FF; t.N = DM; t.WT = (bf16*)(ws + WS_WEO) + ((size_t)l * NEXP + e) * DM * FF; t.k0 = 64 * kb; t.n0 = 32 * nb; t.drow0 = 32 * nb; return t; }
}
__device__ __forceinline__ void phase_prologue(const Frame& F0, CArgs& A) {
    const Frame F = fresh(F0);
    float* scr = (float*)(F.lds + F.wave * 16384);
    const int gw = F.bid * 8 + F.wave, NGW = F.G * 8;
    constexpr int I_IN = (DM / 64) * (NCOL / 32), I_BR = (512 / 64) * (DM / 32), I_OUT = (DM / 64) * (DM / 32), I_EI = (DM / 64) * (1024 / 32), I_EO = (FF / 64) * (DM / 32);
    constexpr int NIT = DEPTH * (I_IN + 3 * I_BR + I_OUT + NEXP * I_EI + NEXP * I_EO);
    if (gw >= NIT) return;
    float cur[32], nxt[32];
    TItem tc = titem_decode(A, F.ws, gw);
    titem_load(tc, F.lane, cur);
    for (int it = gw; it < NIT; it += NGW) {
        TItem tn = tc; const bool more = (it + NGW < NIT);
        if (more) { tn = titem_decode(A, F.ws, it + NGW); titem_load(tn, F.lane, nxt); }
        titem_emit(tc, F.lane, cur, scr);
        if (more) {
#pragma unroll
            for (int i = 0; i < 32; ++i) cur[i] = nxt[i];
            tc = tn; }
    }
}

__device__ __forceinline__ void phase_norm(const Frame& F0, const float* x, const float* gain, bf16* out) {
    const Frame F = fresh(F0);
    const int gw = F.bid * 8 + F.wave, NGW = F.G * 8;
    f32x4 g[4];
#pragma unroll
    for (int j = 0; j < 4; ++j) g[j] = *(const f32x4*)(gain + 4 * F.lane + 256 * j);
    for (int m0 = gw; m0 < T; m0 += 4 * NGW) {
        f32x4 v[4][4];
#pragma unroll
        for (int q = 0; q < 4; ++q) { const int m = m0 + q * NGW; if (m < T) { const f32x4* xr = (const f32x4*)(x + (size_t)m * DM) + F.lane;
#pragma unroll
                for (int j = 0; j < 4; ++j) v[q][j] = xr[64 * j]; } }
#pragma unroll
        for (int q = 0; q < 4; ++q) { const int m = m0 + q * NGW; if (m < T) { float s = 0.f;
#pragma unroll
                for (int j = 0; j < 4; ++j) s += (v[q][j].x * v[q][j].x + v[q][j].y * v[q][j].y) + (v[q][j].z * v[q][j].z + v[q][j].w * v[q][j].w);
                const float r = rsqrtf(wave_sum(s) * (1.f / DM) + RMS_EPS);
                v2u* o8 = (v2u*)(out + (size_t)m * DM) + F.lane;
#pragma unroll
                for (int j = 0; j < 4; ++j) { v2u w; w.x = pk2(v[q][j].x * r * g[j].x, v[q][j].y * r * g[j].y); w.y = pk2(v[q][j].z * r * g[j].z, v[q][j].w * r * g[j].w); o8[64 * j] = w; } } }
    }
}

__device__ __forceinline__ void phase_qkprep(const Frame& F0, const bf16* proj, const float* qg, const float* kg, bf16* Q, bf16* Kb, float* kmean) {
    const Frame F = fresh(F0);
    float* red = (float*)F.lds;
    float* red2 = red + 256 * 65;
    const int tok = F.tid >> 1, hf = F.tid & 1;
    float qgv[32], kgv[32];
#pragma unroll
    for (int i = 0; i < 8; ++i) { const f32x4 a = *(const f32x4*)(qg + hf * 32 + 4 * i), c = *(const f32x4*)(kg + hf * 32 + 4 * i);
        qgv[4 * i] = a.x; qgv[4 * i + 1] = a.y; qgv[4 * i + 2] = a.z; qgv[4 * i + 3] = a.w; kgv[4 * i] = c.x; kgv[4 * i + 1] = c.y; kgv[4 * i + 2] = c.z; kgv[4 * i + 3] = c.w; }
    for (int u = F.bid; u < 512; u += F.G) {
        const int b = u >> 6, blk = (u >> 3) & 7, h = u & 7;
        const size_t row = (size_t)b * SEQ + blk * 256 + tok;
        const bf16* pq = proj + row * NCOL + C_AQ + h * 64 + hf * 32;
        const bf16* pk = proj + row * NCOL + C_AK + h * 64 + hf * 32;
        float qv[32], kv[32];
#pragma unroll
        for (int i = 0; i < 4; ++i) { const v4u a = *(const v4u*)(pq + 8 * i), c = *(const v4u*)(pk + 8 * i);
            qv[8 * i + 0] = bflo(a.x); qv[8 * i + 1] = bfhi(a.x); qv[8 * i + 2] = bflo(a.y); qv[8 * i + 3] = bfhi(a.y); qv[8 * i + 4] = bflo(a.z); qv[8 * i + 5] = bfhi(a.z); qv[8 * i + 6] = bflo(a.w); qv[8 * i + 7] = bfhi(a.w);
            kv[8 * i + 0] = bflo(c.x); kv[8 * i + 1] = bfhi(c.x); kv[8 * i + 2] = bflo(c.y); kv[8 * i + 3] = bfhi(c.y); kv[8 * i + 4] = bflo(c.z); kv[8 * i + 5] = bfhi(c.z); kv[8 * i + 6] = bflo(c.w); kv[8 * i + 7] = bfhi(c.w); }
        float sq = 0.f, sk = 0.f;
#pragma unroll
        for (int i = 0; i < 32; ++i) { sq += qv[i] * qv[i]; sk += kv[i] * kv[i]; }
        sq += __shfl_xor(sq, 1); sk += __shfl_xor(sk, 1);
        const float rq = rsqrtf(sq * (1.f / 64.f) + RMS_EPS) * QSCALE, rk = rsqrtf(sk * (1.f / 64.f) + RMS_EPS);
#pragma unroll
        for (int i = 0; i < 32; ++i) { qv[i] = qv[i] * rq * qgv[i]; kv[i] = kv[i] * rk * kgv[i]; }
        bf16* oq = Q + row * 512 + h * 64 + hf * 32; bf16* ok = Kb + row * 512 + h * 64 + hf * 32;
#pragma unroll
        for (int i = 0; i < 4; ++i) { v4u a, c;
            a.x = pk2(qv[8 * i], qv[8 * i + 1]); a.y = pk2(qv[8 * i + 2], qv[8 * i + 3]); a.z = pk2(qv[8 * i + 4], qv[8 * i + 5]); a.w = pk2(qv[8 * i + 6], qv[8 * i + 7]);
            c.x = pk2(kv[8 * i], kv[8 * i + 1]); c.y = pk2(kv[8 * i + 2], kv[8 * i + 3]); c.z = pk2(kv[8 * i + 4], kv[8 * i + 5]); c.w = pk2(kv[8 * i + 6], kv[8 * i + 7]);
            *(v4u*)(oq + 8 * i) = a; *(v4u*)(ok + 8 * i) = c; }
        __syncthreads();
#pragma unroll
        for (int i = 0; i < 32; ++i) red[tok * 65 + hf * 32 + i] = kv[i];
        __syncthreads();
        { const int d = F.tid & 63, part = F.tid >> 6; float s = 0.f;
            for (int tk = 0; tk < 32; ++tk) s += red[(part * 32 + tk) * 65 + d];
            red2[part * 64 + d] = s; }
        __syncthreads();
        if (F.tid < 64) { float s = 0.f;
#pragma unroll
            for (int p = 0; p < 8; ++p) s += red2[p * 64 + F.tid];
            kmean[(((size_t)b * 8 + h) * 8 + blk) * 64 + F.tid] = s * (1.f / 256.f); }
    }
    __syncthreads();
}

__device__ __forceinline__ void phase_conv(const Frame& F0, const bf16* proj, const float* cw, const float* cb, const float* lng, const float* lnb, bf16* cat) {
    const Frame F = fresh(F0);
    float* ut = (float*)F.lds;
    const int c = F.tid;
    float w[31];
#pragma unroll
    for (int j = 0; j < 31; ++j) w[j] = cw[j * 512 + c];
    const float bias = cb[c];
    const f32x4 g0 = *(const f32x4*)(lng + 8 * F.lane), g1 = *(const f32x4*)(lng + 8 * F.lane + 4), b0 = *(const f32x4*)(lnb + 8 * F.lane), b1 = *(const f32x4*)(lnb + 8 * F.lane + 4);
    for (int u = F.bid; u < 512; u += F.G) {
        const int b = u >> 6, t0 = (u & 63) * 32;
        __syncthreads();
        {
            v4u av[8], gv[8];
#pragma unroll
            for (int i = 0; i < 8; ++i) { const int idx = F.tid + 512 * i, r = idx >> 6, ch = (idx & 63) * 8, t = t0 - 30 + r;
                if (r < 62 && t >= 0) { const bf16* p = proj + ((size_t)b * SEQ + t) * NCOL + ch; av[i] = *(const v4u*)(p + C_CA); gv[i] = *(const v4u*)(p + C_CB); }
                else { av[i] = (v4u){0u, 0u, 0u, 0u}; gv[i] = (v4u){0u, 0u, 0u, 0u}; } }
#pragma unroll
            for (int i = 0; i < 8; ++i) { const int idx = F.tid + 512 * i, r = idx >> 6, ch = (idx & 63) * 8;
                if (r < 62) {
                    f32x4 u0, u1;
                    u0.x = bflo(av[i].x) * sigmoidf_(bflo(gv[i].x)); u0.y = bfhi(av[i].x) * sigmoidf_(bfhi(gv[i].x)); u0.z = bflo(av[i].y) * sigmoidf_(bflo(gv[i].y)); u0.w = bfhi(av[i].y) * sigmoidf_(bfhi(gv[i].y));
                    u1.x = bflo(av[i].z) * sigmoidf_(bflo(gv[i].z)); u1.y = bfhi(av[i].z) * sigmoidf_(bfhi(gv[i].z)); u1.z = bflo(av[i].w) * sigmoidf_(bflo(gv[i].w)); u1.w = bfhi(av[i].w) * sigmoidf_(bfhi(gv[i].w));
                    *(f32x4*)(ut + r * 512 + ch) = u0; *(f32x4*)(ut + r * 512 + ch + 4) = u1; } }
        }
        __syncthreads();
        float uu[62];
#pragma unroll
        for (int i = 0; i < 62; ++i) uu[i] = ut[i * 512 + c];
#pragma unroll
        for (int t = 0; t < 32; ++t) { float a = bias;
#pragma unroll
            for (int j = 0; j < 31; ++j) a += w[j] * uu[t + j];
            ut[t * 512 + c] = a; }
        __syncthreads();
#pragma unroll
        for (int q = 0; q < 4; ++q) { const int t = F.wave * 4 + q;
            const f32x4 v0 = *(const f32x4*)(ut + t * 512 + 8 * F.lane), v1 = *(const f32x4*)(ut + t * 512 + 8 * F.lane + 4);
            const float mu = wave_sum((v0.x + v0.y) + (v0.z + v0.w) + (v1.x + v1.y) + (v1.z + v1.w)) * (1.f / 512.f);
            const f32x4 d0 = v0 - mu, d1 = v1 - mu;
            const float var = wave_sum((d0.x * d0.x + d0.y * d0.y) + (d0.z * d0.z + d0.w * d0.w) + (d1.x * d1.x + d1.y * d1.y) + (d1.z * d1.z + d1.w * d1.w)) * (1.f / 512.f);
            const float rs = rsqrtf(var + LN_EPS);
            f32x4 y0 = d0 * rs * g0 + b0, y1 = d1 * rs * g1 + b1;
            y0.x *= sigmoidf_(y0.x); y0.y *= sigmoidf_(y0.y); y0.z *= sigmoidf_(y0.z); y0.w *= sigmoidf_(y0.w);
            y1.x *= sigmoidf_(y1.x); y1.y *= sigmoidf_(y1.y); y1.z *= sigmoidf_(y1.z); y1.w *= sigmoidf_(y1.w);
            v4u o; o.x = pk2(y0.x, y0.y); o.y = pk2(y0.z, y0.w); o.z = pk2(y1.x, y1.y); o.w = pk2(y1.z, y1.w);
            *(v4u*)(cat + ((size_t)b * SEQ + t0 + t) * 1536 + 1024 + 8 * F.lane) = o; }
    }
    __syncthreads();
}

typedef float f32x16 __attribute__((ext_vector_type(16)));
typedef short bf16x8 __attribute__((ext_vector_type(8)));
typedef short v4i16_t __attribute__((ext_vector_type(4)));
constexpr int AT_KROW = 144, AT_VROW = 192, AT_KBUF = 64 * AT_KROW, AT_VBUF = 64 * AT_VROW, AT_BUF = AT_KBUF + AT_VBUF;
constexpr int AT_WSF = 2 * AT_BUF, AT_STG = AT_WSF + 8 * 256, AT_LDS = AT_STG + 8 * 4096;
__device__ __forceinline__ int crow16(int r, int hi) { return (r & 3) + 8 * (r >> 2) + 4 * hi; }
__device__ __forceinline__ void attn_mfma_unit(const Frame& F, LAS unsigned char* L, int b, int h, int qb, const bf16* Q, const bf16* Kb, const bf16* proj, const float* kmean, bf16* cat) {
    int lane_ = F.lane; asm volatile("" : "+v"(lane_));
    const int lane = lane_, r32 = lane & 31, hi = lane >> 5, wid = F.wave;
    const size_t row0 = (size_t)b * SEQ + qb * 256;
    const int qi = wid * 32 + r32;
    bf16x8 qf[4];
    { const bf16* pq = Q + (row0 + qi) * 512 + h * 64 + hi * 8;
#pragma unroll
        for (int d0 = 0; d0 < 4; ++d0) qf[d0] = *(const bf16x8*)(pq + d0 * 16); }
    unsigned selmask;
    if (qb <= 3) selmask = (1u << qb) - 1u;
    else {
        float b0 = -3.0e38f, b1 = -3.0e38f, b2 = -3.0e38f; int i0 = 0, i1 = 0, i2 = 0;
        float qv[32];
#pragma unroll
        for (int d0 = 0; d0 < 4; ++d0)
#pragma unroll
            for (int e = 0; e < 8; ++e) qv[d0 * 8 + e] = bf2f((bf16)qf[d0][e]);
#pragma unroll 1
        for (int j = 0; j < qb; ++j) { const float* km = kmean + (((size_t)b * 8 + h) * 8 + j) * 64 + hi * 8; float sacc = 0.f;
#pragma unroll
            for (int d0 = 0; d0 < 4; ++d0) { const f32x4 k0 = *(const f32x4*)(km + d0 * 16), k1 = *(const f32x4*)(km + d0 * 16 + 4);
                sacc += qv[d0 * 8 + 0] * k0.x + qv[d0 * 8 + 1] * k0.y + qv[d0 * 8 + 2] * k0.z + qv[d0 * 8 + 3] * k0.w + qv[d0 * 8 + 4] * k1.x + qv[d0 * 8 + 5] * k1.y + qv[d0 * 8 + 6] * k1.z + qv[d0 * 8 + 7] * k1.w; }
            sacc += __shfl_xor(sacc, 32);
            if (sacc > b0) { b2 = b1; i2 = i1; b1 = b0; i1 = i0; b0 = sacc; i0 = j; }
            else if (sacc > b1) { b2 = b1; i2 = i1; b1 = sacc; i1 = j; }
            else if (sacc > b2) { b2 = sacc; i2 = j; } }
        selmask = (1u << i0) | (1u << i1) | (1u << i2);
    }
    const int tid_l = wid * 64 + lane, srow = tid_l >> 3, sch = tid_l & 7;
    const bf16* kg = Kb + ((size_t)b * SEQ + srow) * 512 + h * 64 + sch * 8;
    const bf16* vg = proj + ((size_t)b * SEQ + srow) * NCOL + C_AV + h * 64 + sch * 8;
    const int kst = srow * AT_KROW + sch * 16, vst = AT_KBUF + srow * AT_VROW + sch * 16;
    const int kfo = r32 * AT_KROW + hi * 16;
    const int g16 = lane >> 4, idx = lane & 15;
    const int vfo = AT_KBUF + (4 * (g16 >> 1) + (idx >> 2)) * AT_VROW + ((g16 & 1) * 16 + 4 * (idx & 3)) * 2;
    const int NT = 4 * (qb + 1);
    f32x16 o0 = {}, o1 = {};
    float lsum = 0.f;
    v4u kA = {}, vA = {}, kB, vB;
    { const v4u kk = *(const v4u*)kg, vv = *(const v4u*)vg;
        kB = *(const v4u*)(kg + (size_t)64 * 512); vB = *(const v4u*)(vg + (size_t)64 * NCOL);
        *(LAS v4u*)(L + kst) = kk; *(LAS v4u*)(L + vst) = vv; }
    lds_barrier();
#define AT_TILE(OWN, TT, PAR, KL, VL, KW, VW) do { \
        const int t_ = (TT); constexpr int cb = (PAR) * AT_BUF, nb = AT_BUF - cb;        \
        if (t_ + 2 < NT) { KL = *(const v4u*)(kg + (size_t)(t_ + 2) * 64 * 512); VL = *(const v4u*)(vg + (size_t)(t_ + 2) * 64 * NCOL); } \
        const int j = t_ >> 2, kt = t_ & 3; \
        const bool active = !(OWN) || (kt * 64 <= wid * 32 + 31); \
        if (active) { \
            f32x16 s0, s1; \
            { const float bias = ((OWN) || (((selmask >> j) & 1u) != 0u)) ? 0.f : -1.0e30f; \
                _Pragma("unroll") for (int r = 0; r < 16; ++r) { s0[r] = bias; s1[r] = bias; } } \
            bf16x8 kf[8]; \
            _Pragma("unroll") for (int d0 = 0; d0 < 4; ++d0) { kf[d0] = *(const LAS bf16x8*)(L + cb + kfo + d0 * 32); kf[4 + d0] = *(const LAS bf16x8*)(L + cb + kfo + 32 * AT_KROW + d0 * 32); } \
            _Pragma("unroll") for (int d0 = 0; d0 < 4; ++d0) { \
                s0 = __builtin_amdgcn_mfma_f32_32x32x16_bf16(kf[d0], qf[d0], s0, 0, 0, 0); \
                s1 = __builtin_amdgcn_mfma_f32_32x32x16_bf16(kf[4 + d0], qf[d0], s1, 0, 0, 0); } \
            v4i16_t va[16]; \
            _Pragma("unroll") for (int sub = 0; sub < 2; ++sub) \
                _Pragma("unroll") for (int sI = 0; sI < 2; ++sI) { const int vb = cb + vfo + (sub * 32 + 16 * sI) * AT_VROW, q4 = (sub * 2 + sI) * 4; \
                    va[q4 + 0] = __builtin_amdgcn_ds_read_tr16_b64_v4i16((LAS v4i16_t*)(L + vb)); va[q4 + 1] = __builtin_amdgcn_ds_read_tr16_b64_v4i16((LAS v4i16_t*)(L + vb + 8 * AT_VROW)); \
                    va[q4 + 2] = __builtin_amdgcn_ds_read_tr16_b64_v4i16((LAS v4i16_t*)(L + vb + 64)); va[q4 + 3] = __builtin_amdgcn_ds_read_tr16_b64_v4i16((LAS v4i16_t*)(L + vb + 8 * AT_VROW + 64)); } \
            __builtin_amdgcn_sched_barrier(0); \
            float ps = 0.f; \
            if (OWN) { const int lim = qi - kt * 64; \
                _Pragma("unroll") for (int r = 0; r < 16; ++r) { const int kv = crow16(r, hi); \
                    const float p0 = (kv <= lim) ? __builtin_amdgcn_exp2f(s0[r]) : 0.f, p1 = (kv + 32 <= lim) ? __builtin_amdgcn_exp2f(s1[r]) : 0.f; \
                    s0[r] = p0; s1[r] = p1; ps += p0 + p1; } \
            } else { \
                _Pragma("unroll") for (int r = 0; r < 16; ++r) { const float p0 = __builtin_amdgcn_exp2f(s0[r]), p1 = __builtin_amdgcn_exp2f(s1[r]); s0[r] = p0; s1[r] = p1; ps += p0 + p1; } } \
            lsum += ps; \
            bf16x8 pa[4]; \
            _Pragma("unroll") for (int sI = 0; sI < 2; ++sI) { v4u w0, w1; \
                w0.x = pg8::cvt_pk_bf16(s0[8 * sI + 0], s0[8 * sI + 1]); w0.y = pg8::cvt_pk_bf16(s0[8 * sI + 2], s0[8 * sI + 3]); w0.z = pg8::cvt_pk_bf16(s0[8 * sI + 4], s0[8 * sI + 5]); w0.w = pg8::cvt_pk_bf16(s0[8 * sI + 6], s0[8 * sI + 7]); \
                w1.x = pg8::cvt_pk_bf16(s1[8 * sI + 0], s1[8 * sI + 1]); w1.y = pg8::cvt_pk_bf16(s1[8 * sI + 2], s1[8 * sI + 3]); w1.z = pg8::cvt_pk_bf16(s1[8 * sI + 4], s1[8 * sI + 5]); w1.w = pg8::cvt_pk_bf16(s1[8 * sI + 6], s1[8 * sI + 7]); \
                pa[sI] = __builtin_bit_cast(bf16x8, w0); pa[2 + sI] = __builtin_bit_cast(bf16x8, w1); } \
            _Pragma("unroll") for (int q = 0; q < 4; ++q) { \
                const bf16x8 v0 = (bf16x8){va[4 * q][0], va[4 * q][1], va[4 * q][2], va[4 * q][3], va[4 * q + 1][0], va[4 * q + 1][1], va[4 * q + 1][2], va[4 * q + 1][3]}; \
                const bf16x8 v1 = (bf16x8){va[4 * q + 2][0], va[4 * q + 2][1], va[4 * q + 2][2], va[4 * q + 2][3], va[4 * q + 3][0], va[4 * q + 3][1], va[4 * q + 3][2], va[4 * q + 3][3]}; \
                o0 = __builtin_amdgcn_mfma_f32_32x32x16_bf16(pa[q], v0, o0, 0, 0, 0); \
                o1 = __builtin_amdgcn_mfma_f32_32x32x16_bf16(pa[q], v1, o1, 0, 0, 0); } \
        } \
        if (t_ + 1 < NT) { *(LAS v4u*)(L + nb + kst) = KW; *(LAS v4u*)(L + nb + vst) = VW; } \
        lds_barrier(); \
    } while (0)
    int t = 0;
#pragma unroll 1
    for (; t < NT - 4; t += 2) { AT_TILE(false, t, 0, kA, vA, kB, vB); AT_TILE(false, t + 1, 1, kB, vB, kA, vA); }
#pragma unroll 1
    for (; t < NT; t += 2) { AT_TILE(true, t, 0, kA, vA, kB, vB); AT_TILE(true, t + 1, 1, kB, vB, kA, vA); }
#undef AT_TILE
    lsum += __shfl_xor(lsum, 32);
    LAS float* wsf = (LAS float*)(L + AT_WSF + wid * 256);
    if (hi == 0) wsf[r32] = lsum;
    asm volatile("s_waitcnt lgkmcnt(0)" ::: "memory");
    LAS bf16* stg = (LAS bf16*)(L + AT_STG + wid * 4096);
#pragma unroll
    for (int r = 0; r < 16; ++r) { const int orow = crow16(r, hi); const float rl = 1.f / wsf[orow];
        stg[orow * 64 + r32] = (bf16)f2bf(o0[r] * rl); stg[orow * 64 + 32 + r32] = (bf16)f2bf(o1[r] * rl); }
    asm volatile("s_waitcnt lgkmcnt(0)" ::: "memory");
    bf16* po = cat + (row0 + wid * 32) * 1536 + h * 64;
#pragma unroll
    for (int i = 0; i < 4; ++i) { const int row = i * 8 + (lane >> 3), ch = lane & 7; const v4u v = *(const LAS v4u*)(stg + row * 64 + ch * 8); *(v4u*)(po + (size_t)row * 1536 + ch * 8) = v; }
    lds_barrier();
}
__device__ __forceinline__ void phase_attn_mfma(const Frame& F0, const bf16* Q, const bf16* Kb, const bf16* proj, const float* kmean, bf16* cat) {
    const Frame F = fresh(F0);
    LAS unsigned char* L = (LAS unsigned char*)F.lds;
    for (int p = F.bid; p < 256; p += F.G) {
        const int bh = p >> 2, s = p & 3;
#pragma unroll 1
        for (int i = 0; i < 2; ++i) attn_mfma_unit(F, L, bh >> 3, bh & 7, i ? s : 7 - s, Q, Kb, proj, kmean, cat);
    }
}

template <bool PERM> __device__ __forceinline__ bf16x8 tr_frag(LAS unsigned char* tile, int pitch, int rbase, int cbase, int lane) {
    const int g16 = lane >> 4, idx = lane & 15, h = g16 >> 1;
    LAS unsigned char* p = tile + (rbase + (PERM ? 4 : 8) * h + (idx >> 2)) * pitch + (cbase + (g16 & 1) * 16 + 4 * (idx & 3)) * 2;
    const v4i16_t a0 = __builtin_amdgcn_ds_read_tr16_b64_v4i16((LAS v4i16_t*)p), a1 = __builtin_amdgcn_ds_read_tr16_b64_v4i16((LAS v4i16_t*)(p + (PERM ? 8 : 4) * pitch));
    return (bf16x8){a0[0], a0[1], a0[2], a0[3], a1[0], a1[1], a1[2], a1[3]};
}
constexpr int H1_G = 0, H1_QD = 32768, H1_KD = H1_QD + 64 * 272, H1_KE = H1_KD + 64 * 272, H1_VT = H1_KE + 64 * 320, H1_SP = H1_VT + 64 * 320, H1_TOT = H1_SP + 128 * 320, H1_BO = H1_TOT + 2048, H1_LB = H1_BO + 512, H1_CK = H1_LB + 512, H1_END = H1_CK + 2048;
static_assert(H1_END <= LDS_SCRATCH, "hgrn pass 1 lds");
__device__ __forceinline__ void hgrn_pass1_unit(const Frame& F, LAS unsigned char* L, int u, const bf16* proj, const float* lbl, int layer, float* Lg, float* Dg, float* OL, bf16* Qb) {
    const int b = u >> 5, h = (u >> 3) & 3, blk = u & 7;
    const int lane = F.lane, r32 = lane & 31, hi = lane >> 5, wid = F.wave, tid = F.tid;
    const int tt = tid >> 3, cg = tid & 7, ch = cg * 16;
    LAS float* G = (LAS float*)(L + H1_G); LAS float* TOT = (LAS float*)(L + H1_TOT);
    LAS float* BO = (LAS float*)(L + H1_BO); LAS float* LB = (LAS float*)(L + H1_LB); LAS float* CK = (LAS float*)(L + H1_CK);
    if (tid < 128) { float lb = 0.f;
        if (layer > 0) { const float l0 = lbl[h * 128 + tid], l1 = lbl[512 + h * 128 + tid]; lb = 1.f / (1.f + __expf(l0 - l1)); }
        LB[tid] = lb; BO[tid] = 0.f; }
    lds_barrier();
    f32x16 S[2]; S[0] = (f32x16){}; S[1] = (f32x16){};
    const size_t rowb = (size_t)b * SEQ + blk * 256;
    const int tt2 = wid >> 2, vt = wid & 3;
    v4u nx[6];
    { const bf16* pr = proj + (rowb + tt) * NCOL + h * 128 + ch;
        nx[0] = *(const v4u*)(pr + C_HF); nx[1] = *(const v4u*)(pr + C_HF + 8); nx[2] = *(const v4u*)(pr + C_HQ); nx[3] = *(const v4u*)(pr + C_HQ + 8); nx[4] = *(const v4u*)(pr + C_HI); nx[5] = *(const v4u*)(pr + C_HI + 8); }
    for (int c = 0; c < 4; ++c) {
        const size_t row = rowb + c * 64 + tt;
        float kk[16], qa[16];
        {
            const v4u f0 = nx[0], f1 = nx[1], q0 = nx[2], q1 = nx[3], v0 = nx[4], v1 = nx[5];
            if (c < 3) { const bf16* pr = proj + (row + 64) * NCOL + h * 128 + ch;
                nx[0] = *(const v4u*)(pr + C_HF); nx[1] = *(const v4u*)(pr + C_HF + 8); nx[2] = *(const v4u*)(pr + C_HQ); nx[3] = *(const v4u*)(pr + C_HQ + 8); nx[4] = *(const v4u*)(pr + C_HI); nx[5] = *(const v4u*)(pr + C_HI + 8); }
            const unsigned fw[8] = {f0.x, f0.y, f0.z, f0.w, f1.x, f1.y, f1.z, f1.w}, qw[8] = {q0.x, q0.y, q0.z, q0.w, q1.x, q1.y, q1.z, q1.w};
            float gl[16], lbv[16];
#pragma unroll
            for (int i = 0; i < 4; ++i) { const f32x4 x = *(const LAS f32x4*)(LB + ch + 4 * i); lbv[4 * i] = x.x; lbv[4 * i + 1] = x.y; lbv[4 * i + 2] = x.z; lbv[4 * i + 3] = x.w; }
#pragma unroll
            for (int i = 0; i < 16; ++i) { const float fr = (i & 1) ? bfhi(fw[i >> 1]) : bflo(fw[i >> 1]); const float sig = sigmoidf_(fr);
                gl[i] = __logf(lbv[i] + (1.f - lbv[i]) * sig); kk[i] = (1.f - lbv[i]) * (1.f - sig);
                const float qv = (i & 1) ? bfhi(qw[i >> 1]) : bflo(qw[i >> 1]); qa[i] = qv * sigmoidf_(qv); }
#pragma unroll
            for (int i = 0; i < 4; ++i) *(LAS f32x4*)(G + tt * 128 + ch + 4 * i) = (f32x4){gl[4 * i], gl[4 * i + 1], gl[4 * i + 2], gl[4 * i + 3]};
            *(LAS v4u*)(L + H1_VT + tt * 320 + ch * 2) = v0; *(LAS v4u*)(L + H1_VT + tt * 320 + ch * 2 + 16) = v1;
        }
        lds_barrier();
        {
            const int k = tid & 127, part = tid >> 7; float a[16];
#pragma unroll
            for (int i = 0; i < 16; ++i) a[i] = G[(part * 16 + i) * 128 + k];
#pragma unroll
            for (int i = 1; i < 16; ++i) a[i] += a[i - 1];
            TOT[part * 128 + k] = a[15];
            lds_barrier();
            float pre = 0.f;
#pragma unroll
            for (int p = 0; p < 3; ++p) if (p < part) pre += TOT[p * 128 + k];
#pragma unroll
            for (int i = 0; i < 16; ++i) G[(part * 16 + i) * 128 + k] = a[i] + pre;
            if (part == 3) {
                const float bmk = TOT[k] + TOT[128 + k], bek = pre + a[15];
                CK[k] = __expf(bmk); CK[128 + k] = __expf(bek); CK[256 + k] = __expf(bek - bmk); CK[384 + k] = __expf(BO[k] + bmk); }
        }
        lds_barrier();
        {
#pragma unroll
            for (int hh = 0; hh < 2; ++hh) {
                float bb[8], bm[8], cem[8], com[8];
#pragma unroll
                for (int i = 0; i < 2; ++i) { const f32x4 x = *(const LAS f32x4*)(G + tt * 128 + ch + 8 * hh + 4 * i), y = *(const LAS f32x4*)(G + 31 * 128 + ch + 8 * hh + 4 * i), z = *(const LAS f32x4*)(CK + 256 + ch + 8 * hh + 4 * i), o4 = *(const LAS f32x4*)(CK + 384 + ch + 8 * hh + 4 * i);
                    bb[4 * i] = x.x; bb[4 * i + 1] = x.y; bb[4 * i + 2] = x.z; bb[4 * i + 3] = x.w; bm[4 * i] = y.x; bm[4 * i + 1] = y.y; bm[4 * i + 2] = y.z; bm[4 * i + 3] = y.w;
                    cem[4 * i] = z.x; cem[4 * i + 1] = z.y; cem[4 * i + 2] = z.z; cem[4 * i + 3] = z.w; com[4 * i] = o4.x; com[4 * i + 1] = o4.y; com[4 * i + 2] = o4.z; com[4 * i + 3] = o4.w; }
                float ex[8], rex[8], t8[8]; v4u w;
#pragma unroll
                for (int i = 0; i < 8; ++i) { ex[i] = __expf(bb[i] - bm[i]); rex[i] = __builtin_amdgcn_rcpf(ex[i]); }
#pragma unroll
                for (int i = 0; i < 8; ++i) t8[i] = kk[8 * hh + i] * rex[i] * cem[i];
                w.x = pk2(t8[0], t8[1]); w.y = pk2(t8[2], t8[3]); w.z = pk2(t8[4], t8[5]); w.w = pk2(t8[6], t8[7]); *(LAS v4u*)(L + H1_KE + tt * 320 + ch * 2 + 16 * hh) = w;
#pragma unroll
                for (int i = 0; i < 8; ++i) t8[i] = qa[8 * hh + i] * ex[i];
                w.x = pk2(t8[0], t8[1]); w.y = pk2(t8[2], t8[3]); w.z = pk2(t8[4], t8[5]); w.w = pk2(t8[6], t8[7]); *(LAS v4u*)(L + H1_QD + tt * 272 + ch * 2 + 16 * hh) = w;
#pragma unroll
                for (int i = 0; i < 8; ++i) t8[i] = kk[8 * hh + i] * rex[i];
                w.x = pk2(t8[0], t8[1]); w.y = pk2(t8[2], t8[3]); w.z = pk2(t8[4], t8[5]); w.w = pk2(t8[6], t8[7]); *(LAS v4u*)(L + H1_KD + tt * 272 + ch * 2 + 16 * hh) = w;
#pragma unroll
                for (int i = 0; i < 8; ++i) t8[i] = qa[8 * hh + i] * ex[i] * com[i];
                w.x = pk2(t8[0], t8[1]); w.y = pk2(t8[2], t8[3]); w.z = pk2(t8[4], t8[5]); w.w = pk2(t8[6], t8[7]); *(v4u*)(Qb + row * 512 + h * 128 + ch + 8 * hh) = w;
                __builtin_amdgcn_sched_barrier(0);
            }
#pragma unroll
            for (int i = 0; i < 2; ++i) { const int id = 2 * wid + i, kt = id >> 2, v2 = id & 3;
#pragma unroll
                for (int r = 0; r < 16; ++r) { const int k = kt * 32 + crow16(r, hi); *(LAS bf16*)(L + H1_SP + k * 320 + (v2 * 32 + r32) * 2) = (bf16)(pk2(S[i][r] * CK[k], 0.f) & 0xffffu); } }
        }
        lds_barrier();
        {
            if (tid < 128) BO[tid] += G[63 * 128 + tid];
            f32x16 o = {};
            bf16x8 qf[8];
#pragma unroll
            for (int k0 = 0; k0 < 8; ++k0) qf[k0] = *(const LAS bf16x8*)(L + H1_QD + (tt2 * 32 + r32) * 272 + (k0 * 16 + 8 * hi) * 2);
#pragma unroll
            for (int k0 = 0; k0 < 8; ++k0) o = __builtin_amdgcn_mfma_f32_32x32x16_bf16(qf[k0], tr_frag<false>(L + H1_SP, 320, k0 * 16, vt * 32, lane), o, 0, 0, 0);
#pragma unroll
            for (int sg = 0; sg < 2; ++sg) if (sg <= tt2) {
                f32x16 sc = {};
#pragma unroll
                for (int k0 = 0; k0 < 8; ++k0) { const bf16x8 kf = *(const LAS bf16x8*)(L + H1_KD + (sg * 32 + r32) * 272 + (k0 * 16 + 8 * hi) * 2); sc = __builtin_amdgcn_mfma_f32_32x32x16_bf16(kf, qf[k0], sc, 0, 0, 0); }
                if (sg == tt2) {
#pragma unroll
                    for (int r = 0; r < 16; ++r) sc[r] = (crow16(r, hi) <= r32) ? sc[r] : 0.f; }
#pragma unroll
                for (int sI = 0; sI < 2; ++sI) { v4u w; w.x = pg8::cvt_pk_bf16(sc[8 * sI + 0], sc[8 * sI + 1]); w.y = pg8::cvt_pk_bf16(sc[8 * sI + 2], sc[8 * sI + 3]); w.z = pg8::cvt_pk_bf16(sc[8 * sI + 4], sc[8 * sI + 5]); w.w = pg8::cvt_pk_bf16(sc[8 * sI + 6], sc[8 * sI + 7]);
                    o = __builtin_amdgcn_mfma_f32_32x32x16_bf16(__builtin_bit_cast(bf16x8, w), tr_frag<true>(L + H1_VT, 320, sg * 32 + 16 * sI, vt * 32, lane), o, 0, 0, 0); }
            }
            float* po = OL + (rowb + c * 64 + tt2 * 32) * 512 + h * 128 + vt * 32 + r32;
#pragma unroll
            for (int r = 0; r < 16; ++r) po[(size_t)crow16(r, hi) * 512] = o[r];
#pragma unroll
            for (int i = 0; i < 2; ++i) { const int id = 2 * wid + i, kt = id >> 2, v2 = id & 3;
#pragma unroll
                for (int r = 0; r < 16; ++r) S[i][r] *= CK[128 + kt * 32 + crow16(r, hi)];
#pragma unroll
                for (int s4 = 0; s4 < 4; ++s4) S[i] = __builtin_amdgcn_mfma_f32_32x32x16_bf16(tr_frag<true>(L + H1_KE, 320, 16 * s4, kt * 32, lane), tr_frag<true>(L + H1_VT, 320, 16 * s4, v2 * 32, lane), S[i], 0, 0, 0); }
        }
        lds_barrier();
    }
#pragma unroll
    for (int i = 0; i < 2; ++i) { const int id = 2 * wid + i, kt = id >> 2, v2 = id & 3;
#pragma unroll
        for (int r = 0; r < 16; ++r) Lg[(size_t)u * 16384 + (kt * 32 + crow16(r, hi)) * 128 + v2 * 32 + r32] = S[i][r]; }
    if (tid < 128) Dg[(size_t)u * 128 + tid] = __expf(BO[tid]);
}
constexpr int H2_SL = 0, H2_OB = 128 * 320, H2_END = H2_OB + 128 * 128 * 4;
__device__ __forceinline__ void hgrn_pass2_unit(const Frame& F, LAS unsigned char* L, int u, const bf16* proj, const float* gnorm, const float* Lg, const float* Dg, const float* OL, const bf16* Qb, bf16* cat, int dry) {
    const int b = u >> 5, h = (u >> 3) & 3, blk = u & 7;
    const int lane = F.lane, r32 = lane & 31, hi = lane >> 5, wid = F.wave, tid = F.tid;
    const size_t rowb = (size_t)b * SEQ + blk * 256;
    LAS float* OB = (LAS float*)(L + H2_OB);
    if (blk > 0 && dry != 1) {
#pragma unroll 1
        for (int jh = 0; jh < 4; ++jh) {
            f32x4 l4[7][2]; float dd[7][2];
#pragma unroll
            for (int pb = 0; pb < 7; ++pb)
#pragma unroll
                for (int j = 0; j < 2; ++j) { const int e4 = tid + 512 * (2 * jh + j), k = e4 >> 5;
                    if (pb < blk) { dd[pb][j] = *(const float*)((const char*)(Dg + (size_t)(u - blk + pb) * 128) + (unsigned)k * 4u); l4[pb][j] = *(const f32x4*)((const char*)(Lg + (size_t)(u - blk + pb) * 16384) + (unsigned)e4 * 16u); }
                    else { dd[pb][j] = 0.f; l4[pb][j] = (f32x4){0.f, 0.f, 0.f, 0.f}; } }
#pragma unroll
            for (int j = 0; j < 2; ++j) { const int e4 = tid + 512 * (2 * jh + j), k = e4 >> 5, v4 = (e4 & 31) * 4; f32x4 S = {0.f, 0.f, 0.f, 0.f};
#pragma unroll
                for (int pb = 0; pb < 7; ++pb) if (pb < blk) S = S * dd[pb][j] + l4[pb][j];
                v2u w; w.x = pk2(S.x, S.y); w.y = pk2(S.z, S.w); *(LAS v2u*)(L + H2_SL + k * 320 + v4 * 2) = w; } } }
    lds_barrier();
    const int ttp = tid >> 2, cq = tid & 3, vt = wid & 3;
    float gn[32];
#pragma unroll
    for (int i = 0; i < 8; ++i) { const f32x4 g = *(const f32x4*)(gnorm + cq * 32 + 4 * i); gn[4 * i] = g.x; gn[4 * i + 1] = g.y; gn[4 * i + 2] = g.z; gn[4 * i + 3] = g.w; }
    for (int hf = 0; hf < 2; ++hf) {
        const size_t rowp = rowb + hf * 128 + ttp;
        v4u hg[4];
#pragma unroll
        for (int i = 0; i < 4; ++i) hg[i] = *(const v4u*)(proj + rowp * NCOL + C_HG + h * 128 + cq * 32 + 8 * i);
#pragma unroll
        for (int j = 0; j < 2; ++j) { const int tl = (wid >> 2) + 2 * j;
            const size_t trow = rowb + hf * 128 + tl * 32;
            f32x16 o = {};
            bf16x8 af[8]; float olv[16];
            const float* pl = OL + trow * 512 + h * 128 + vt * 32 + r32;
            if (blk > 0) {
#pragma unroll
                for (int k0 = 0; k0 < 8; ++k0) af[k0] = *(const bf16x8*)(Qb + (trow + r32) * 512 + h * 128 + k0 * 16 + 8 * hi); }
#pragma unroll
            for (int r = 0; r < 16; ++r) olv[r] = pl[(size_t)crow16(r, hi) * 512];
            __builtin_amdgcn_sched_barrier(0);
            if (blk > 0 && dry != 2) {
#pragma unroll
                for (int k0 = 0; k0 < 8; ++k0) o = __builtin_amdgcn_mfma_f32_32x32x16_bf16(af[k0], tr_frag<false>(L + H2_SL, 320, k0 * 16, vt * 32, lane), o, 0, 0, 0); }
#pragma unroll
            for (int r = 0; r < 16; ++r) { const int t = crow16(r, hi); OB[(tl * 32 + t) * 128 + vt * 32 + r32] = o[r] + olv[r]; } }
        lds_barrier();
        {
            float ov[32]; float ss = 0.f;
#pragma unroll
            for (int i = 0; i < 8; ++i) { const f32x4 x = *(const LAS f32x4*)(OB + ttp * 128 + cq * 32 + 4 * i); ov[4 * i] = x.x; ov[4 * i + 1] = x.y; ov[4 * i + 2] = x.z; ov[4 * i + 3] = x.w; ss += (x.x * x.x + x.y * x.y) + (x.z * x.z + x.w * x.w); }
            ss += __shfl_xor(ss, 1); ss += __shfl_xor(ss, 2);
            const float rn = rsqrtf(ss * (1.f / 128.f) + RMS_EPS);
#pragma unroll
            for (int i = 0; i < 4; ++i) { const unsigned gw[4] = {hg[i].x, hg[i].y, hg[i].z, hg[i].w}; float y[8];
#pragma unroll
                for (int e = 0; e < 8; ++e) { const float gv = (e & 1) ? bfhi(gw[e >> 1]) : bflo(gw[e >> 1]); y[e] = ov[8 * i + e] * rn * gn[8 * i + e] * (gv * sigmoidf_(gv)); }
                v4u w; w.x = pk2(y[0], y[1]); w.y = pk2(y[2], y[3]); w.z = pk2(y[4], y[5]); w.w = pk2(y[6], y[7]);
                *(v4u*)(cat + rowp * 1536 + 512 + h * 128 + cq * 32 + 8 * i) = w; }
        }
        lds_barrier();
    }
}
__device__ __forceinline__ void phase_hgrn1(const Frame& F0, const bf16* proj, const float* lbl, int layer, float* Lg, float* Dg, float* OL, bf16* Qb) {
    const Frame F = fresh(F0);
    LAS unsigned char* L = (LAS unsigned char*)F.lds;
    for (int u = F.bid; u < 256; u += F.G) { hgrn_pass1_unit(F, L, u, proj, lbl, layer, Lg, Dg, OL, Qb); __syncthreads(); }
}
__device__ __forceinline__ void phase_hgrn2(const Frame& F0, const bf16* proj, const float* gnorm, const float* Lg, const float* Dg, const float* OL, const bf16* Qb, bf16* cat, int dry) {
    const Frame F = fresh(F0);
    LAS unsigned char* L = (LAS unsigned char*)F.lds;
    for (int u = F.bid; u < 256; u += F.G) { hgrn_pass2_unit(F, L, u, proj, gnorm, Lg, Dg, OL, Qb, cat, dry); __syncthreads(); }
}

struct SchedDense {
    const char* A; const char* B; int nM, nN, G, c; size_t ta, tb;
    __device__ __forceinline__ bool next(int i, pg8::Unit& u) const {
        int pm, pn; if (!pg8::static_tile(nM, nN, (long)i * G + c, pm, pn)) return false;
        u.pm = pm; u.pn = pn; u.aux = 0; u.pad = 0; u.a = A + (size_t)pm * ta; u.b = B + (size_t)pn * tb; return true; }
};
struct SchedBranch {
    const char* A; const char* B; int G, c;
    __device__ __forceinline__ bool next(int i, pg8::Unit& u) const {
        int pm, pn; if (!pg8::static_tile(T / 256, DM / 256, (long)(i / 3) * G + c, pm, pn)) return false;
        const int seg = i % 3;
        u.pm = pm; u.pn = pn; u.aux = seg; u.pad = 0; u.a = A + ((size_t)pm * 256 * 1536 + seg * 512) * 2; u.b = B + ((size_t)seg * DM * 512 + (size_t)pn * 256 * 512) * 2; return true; }
};
struct SchedMoe {
    const char* A; const char* B; const unsigned* ntp; const unsigned* tile_e; int G, c; size_t ta, tb_e, tb_n;
    __device__ __forceinline__ bool next(int i, pg8::Unit& u) const {
        const int nt = (int)__builtin_amdgcn_readfirstlane(*ntp);
        const long L = (long)i * G + c; if (L >= (long)nt * 4) return false;
        const int tile = (int)(L >> 2), pn = (int)(L & 3); const int e = (int)__builtin_amdgcn_readfirstlane(tile_e[tile]);
        u.pm = tile; u.pn = pn; u.aux = e; u.pad = 0; u.a = A + (size_t)tile * ta; u.b = B + (size_t)e * tb_e + (size_t)pn * tb_n; return true; }
};

typedef pg8::f32x4 af4;
struct EpiStoreBf16 {
    static constexpr bool PERM = true;
    bf16* O; int ldc; int gate_col0; const float* bgate; v4u* GT;
    __device__ __forceinline__ bool operator()(af4 (&acc)[2][2][4][2], const pg8::Unit& u, int wr, int wc, int fr, int fq) const {
        const int row0 = u.pm * 256 + wr * 64 + fr, col0 = u.pn * 256 + wc * 32 + 8 * fq;
        const bool gate = (u.pn * 256 >= gate_col0);
#pragma unroll
        for (int bj = 0; bj < 2; ++bj) {
            af4 b0 = {0.f, 0.f, 0.f, 0.f}, b1 = {0.f, 0.f, 0.f, 0.f};
            if (gate) { b0 = *(const af4*)(bgate + col0 + bj * 128 - gate_col0); b1 = *(const af4*)(bgate + col0 + bj * 128 - gate_col0 + 4); }
#pragma unroll
            for (int ai = 0; ai < 2; ++ai)
#pragma unroll
                for (int m = 0; m < 4; ++m) { af4 v0 = acc[ai][bj][m][0], v1 = acc[ai][bj][m][1];
                    if (gate) {
#pragma unroll
                        for (int i = 0; i < 4; ++i) { v0[i] = __builtin_amdgcn_rcpf(1.f + __expf(-fminf(fmaxf(v0[i] + b0[i], -30.f), 30.f))); v1[i] = __builtin_amdgcn_rcpf(1.f + __expf(-fminf(fmaxf(v1[i] + b1[i], -30.f), 30.f))); } }
                    v4u w; w.x = pg8::cvt_pk_bf16(v0[0], v0[1]); w.y = pg8::cvt_pk_bf16(v0[2], v0[3]); w.z = pg8::cvt_pk_bf16(v1[0], v1[1]); w.w = pg8::cvt_pk_bf16(v1[2], v1[3]);
                    if (gate) { const int gt = u.pn - gate_col0 / 256;
                        GT[((((size_t)((gt >> 2) * 64 + u.pm) * 4 + (gt & 3)) * 8 + (wr * 4 + wc)) * 16 + (ai * 4 + m) * 2 + bj) * 64 + (fq * 16 + fr)] = w; }
                    else *(v4u*)(O + (size_t)(row0 + ai * 128 + m * 16) * ldc + col0 + bj * 128) = w; } }
        return true;
    }
};
struct EpiBranch {
    static constexpr bool PERM = true;
    const v4u* GT; bf16* merged;
    __device__ __forceinline__ bool operator()(af4 (&acc)[2][2][4][2], const pg8::Unit& u, int wr, int wc, int fr, int fq) const {
        const int seg = u.aux, row0 = u.pm * 256 + wr * 64 + fr, col0 = u.pn * 256 + wc * 32 + 8 * fq;
        const bool last = (seg == 2); const int sn = last ? seg : seg + 1;
#pragma unroll
        for (int bj = 0; bj < 2; ++bj) { const int col = col0 + bj * 128;
#pragma unroll
            for (int ai = 0; ai < 2; ++ai) { v4u gcv[4], gnv[4];
#pragma unroll
                for (int m = 0; m < 4; ++m) { const size_t row = (size_t)(row0 + ai * 128 + m * 16);
                    gcv[m] = GT[((((size_t)(seg * 64 + u.pm) * 4 + u.pn) * 8 + (wr * 4 + wc)) * 16 + (ai * 4 + m) * 2 + bj) * 64 + (fq * 16 + fr)];
                    gnv[m] = GT[((((size_t)(sn * 64 + u.pm) * 4 + u.pn) * 8 + (wr * 4 + wc)) * 16 + (ai * 4 + m) * 2 + bj) * 64 + (fq * 16 + fr)]; }
#pragma unroll
                for (int m = 0; m < 4; ++m) { const size_t row = (size_t)(row0 + ai * 128 + m * 16);
                    const unsigned gcw[4] = {gcv[m].x, gcv[m].y, gcv[m].z, gcv[m].w}, gnw[4] = {gnv[m].x, gnv[m].y, gnv[m].z, gnv[m].w};
                    float f[8];
#pragma unroll
                    for (int i = 0; i < 8; ++i) { const float gc = (i & 1) ? bfhi(gcw[i >> 1]) : bflo(gcw[i >> 1]), gn = (i & 1) ? bfhi(gnw[i >> 1]) : bflo(gnw[i >> 1]);
                        f[i] = last ? gc : gc * __builtin_amdgcn_rcpf(gn); }
                    af4& v0 = acc[ai][bj][m][0]; af4& v1 = acc[ai][bj][m][1];
                    v0[0] *= f[0]; v0[1] *= f[1]; v0[2] *= f[2]; v0[3] *= f[3]; v1[0] *= f[4]; v1[1] *= f[5]; v1[2] *= f[6]; v1[3] *= f[7];
                    if (last) { v4u w; w.x = pg8::cvt_pk_bf16(v0[0], v0[1]); w.y = pg8::cvt_pk_bf16(v0[2], v0[3]); w.z = pg8::cvt_pk_bf16(v1[0], v1[1]); w.w = pg8::cvt_pk_bf16(v1[2], v1[3]);
                        *(v4u*)(merged + row * DM + col) = w; } } } }
        return last;
    }
};
struct EpiResidual {
    static constexpr bool PERM = true;
    const float* xin32; const bf16* xin16; bf16* xout;
    __device__ __forceinline__ bool operator()(af4 (&acc)[2][2][4][2], const pg8::Unit& u, int wr, int wc, int fr, int fq) const {
        const int row0 = u.pm * 256 + wr * 64 + fr, col0 = u.pn * 256 + wc * 32 + 8 * fq;
#pragma unroll
        for (int ai = 0; ai < 2; ++ai)
#pragma unroll
            for (int mh = 0; mh < 2; ++mh) { af4 r[2][2][2];
#pragma unroll
                for (int mm = 0; mm < 2; ++mm) { const size_t off = (size_t)(row0 + ai * 128 + (mh * 2 + mm) * 16) * DM + col0;
#pragma unroll
                    for (int bj = 0; bj < 2; ++bj) {
                        if (xin32) { r[mm][bj][0] = *(const af4*)(xin32 + off + bj * 128); r[mm][bj][1] = *(const af4*)(xin32 + off + bj * 128 + 4); }
                        else { const v4u w = *(const v4u*)(xin16 + off + bj * 128); r[mm][bj][0] = (af4){bflo(w.x), bfhi(w.x), bflo(w.y), bfhi(w.y)}; r[mm][bj][1] = (af4){bflo(w.z), bfhi(w.z), bflo(w.w), bfhi(w.w)}; } } }
#pragma unroll
                for (int mm = 0; mm < 2; ++mm) { const size_t off = (size_t)(row0 + ai * 128 + (mh * 2 + mm) * 16) * DM + col0;
#pragma unroll
                    for (int bj = 0; bj < 2; ++bj) { const af4 v0 = r[mm][bj][0] + acc[ai][bj][mh * 2 + mm][0], v1 = r[mm][bj][1] + acc[ai][bj][mh * 2 + mm][1]; v4u w;
                        w.x = pg8::cvt_pk_bf16(v0[0], v0[1]); w.y = pg8::cvt_pk_bf16(v0[2], v0[3]); w.z = pg8::cvt_pk_bf16(v1[0], v1[1]); w.w = pg8::cvt_pk_bf16(v1[2], v1[3]);
                        *(v4u*)(xout + off + bj * 128) = w; } } }
        return true;
    }
};
struct EpiSwiglu {
    static constexpr bool PERM = true;
    bf16* act; const float* rrow;
    __device__ __forceinline__ bool operator()(af4 (&acc)[2][2][4][2], const pg8::Unit& u, int wr, int wc, int fr, int fq) const {
        const int row0 = u.pm * 256 + wr * 64 + fr, col0 = u.pn * 128 + wc * 32 + 8 * fq;
        float rs[2][4];
#pragma unroll
        for (int ai = 0; ai < 2; ++ai)
#pragma unroll
            for (int m = 0; m < 4; ++m) rs[ai][m] = rrow[row0 + ai * 128 + m * 16];
#pragma unroll
        for (int ai = 0; ai < 2; ++ai)
#pragma unroll
            for (int m = 0; m < 4; ++m) { const float rr = rs[ai][m]; const af4 g0 = acc[ai][0][m][0] * rr, g1 = acc[ai][0][m][1] * rr, u0 = acc[ai][1][m][0] * rr, u1 = acc[ai][1][m][1] * rr;
                float o[8];
#pragma unroll
                for (int i = 0; i < 4; ++i) { o[i] = g0[i] * sigmoidf_(g0[i]) * u0[i]; o[4 + i] = g1[i] * sigmoidf_(g1[i]) * u1[i]; }
                v4u w; w.x = pg8::cvt_pk_bf16(o[0], o[1]); w.y = pg8::cvt_pk_bf16(o[2], o[3]); w.z = pg8::cvt_pk_bf16(o[4], o[5]); w.w = pg8::cvt_pk_bf16(o[6], o[7]);
                *(v4u*)(act + (size_t)(row0 + ai * 128 + m * 16) * FF + col0) = w; }
        return true;
    }
};
struct EpiScaleRows {
    static constexpr bool PERM = true;
    bf16* ys; const float* wrow;
    __device__ __forceinline__ bool operator()(af4 (&acc)[2][2][4][2], const pg8::Unit& u, int wr, int wc, int fr, int fq) const {
        const int row0 = u.pm * 256 + wr * 64 + fr, col0 = u.pn * 256 + wc * 32 + 8 * fq;
        float sc[2][4];
#pragma unroll
        for (int ai = 0; ai < 2; ++ai)
#pragma unroll
            for (int m = 0; m < 4; ++m) sc[ai][m] = wrow[row0 + ai * 128 + m * 16];
#pragma unroll
        for (int ai = 0; ai < 2; ++ai)
#pragma unroll
            for (int m = 0; m < 4; ++m) { const int row = row0 + ai * 128 + m * 16; const float s = sc[ai][m]; bf16* rowp = ys + (size_t)row * DM + col0;
#pragma unroll
                for (int bj = 0; bj < 2; ++bj) { const af4 v0 = acc[ai][bj][m][0] * s, v1 = acc[ai][bj][m][1] * s; v4u w;
                    w.x = pg8::cvt_pk_bf16(v0[0], v0[1]); w.y = pg8::cvt_pk_bf16(v0[2], v0[3]); w.z = pg8::cvt_pk_bf16(v1[0], v1[1]); w.w = pg8::cvt_pk_bf16(v1[2], v1[3]);
                    *(v4u*)(rowp + bj * 128) = w; } }
        return true;
    }
};

constexpr int RT_PITCH = 2064, RT_HI = 0, RT_LO = 36 * RT_PITCH, RT_END = 72 * RT_PITCH;
static_assert(RT_END + 4096 <= LDS_SCRATCH, "router lds");
__device__ __forceinline__ void phase_router2(const Frame& F0, const bf16* x, const float* gain, const float* wco, const float* bco, const float* wfi, const float* bfi,
                                              bf16* hout, unsigned* route, unsigned* cnt, float* LG, bool commit) {
    const Frame F = fresh(F0);
    LAS unsigned char* L = (LAS unsigned char*)F.lds;
    {
        f32x4 wv[18];
#pragma unroll
        for (int i = 0; i < 2; ++i) wv[i] = *(const f32x4*)(wco + 4 * (F.tid + 512 * i));
#pragma unroll
        for (int i = 0; i < 16; ++i) wv[2 + i] = *(const f32x4*)(wfi + 4 * (F.tid + 512 * i));
#pragma unroll
        for (int i = 0; i < 18; ++i) { int k, c0; if (i < 2) { k = F.tid + 512 * i; c0 = 32; } else { const int f = F.tid + 512 * (i - 2); k = f >> 3; c0 = (f & 7) * 4; }
            const float w4[4] = {wv[i].x, wv[i].y, wv[i].z, wv[i].w};
#pragma unroll
            for (int e = 0; e < 4; ++e) { const unsigned hi = f2bf(w4[e]); const unsigned lo = f2bf(w4[e] - __uint_as_float(hi << 16));
                *(LAS bf16*)(L + RT_HI + (c0 + e) * RT_PITCH + k * 2) = (bf16)hi; *(LAS bf16*)(L + RT_LO + (c0 + e) * RT_PITCH + k * 2) = (bf16)lo; } }
    }
    LAS float* GL = (LAS float*)(L + RT_END);
    GL[F.tid] = gain[F.tid]; GL[F.tid + 512] = gain[F.tid + 512];
    __syncthreads();
    {
        const int lane = F.lane, rl = lane & 15, kg = lane >> 4, kh = F.wave >> 2;
        const int NITER = (T / 16 + 4 * F.G - 1) / (4 * F.G);
        for (int it = 0; it < NITER; ++it) {
            const int tile = it * 4 * F.G + (F.wave & 3) * F.G + F.bid; const bool tvalid = tile < T / 16;
            const size_t row = (size_t)(tvalid ? tile : 0) * 16 + rl;
            const bf16* xr = x + row * DM + 8 * kg + 512 * kh;
            pg8::f32x4 acc[3]; acc[0] = (pg8::f32x4){0.f, 0.f, 0.f, 0.f}; acc[1] = acc[0]; acc[2] = acc[0];
            float ss = 0.f;
            const int bro[3] = {rl * RT_PITCH + 16 * kg + 1024 * kh, (16 + rl) * RT_PITCH + 16 * kg + 1024 * kh, (32 + (rl & 3)) * RT_PITCH + 16 * kg + 1024 * kh};
            v4u xa[8];
#pragma unroll
            for (int q = 0; q < 8; ++q) xa[q] = *(const v4u*)(xr + 32 * q);
            for (int s0 = 0; s0 < 16; s0 += 8) {
                v4u xn[8];
                if (s0 + 8 < 16) {
#pragma unroll
                    for (int q = 0; q < 8; ++q) xn[q] = *(const v4u*)(xr + 32 * (s0 + 8 + q)); }
#pragma unroll
                for (int q = 0; q < 8; ++q) { const int s = s0 + q;
                    const f32x4 g0 = *(const LAS f32x4*)(GL + 512 * kh + 32 * s + 8 * kg), g1 = *(const LAS f32x4*)(GL + 512 * kh + 32 * s + 8 * kg + 4);
                    const float xv[8] = {bflo(xa[q].x), bfhi(xa[q].x), bflo(xa[q].y), bfhi(xa[q].y), bflo(xa[q].z), bfhi(xa[q].z), bflo(xa[q].w), bfhi(xa[q].w)};
                    ss += (xv[0] * xv[0] + xv[1] * xv[1]) + (xv[2] * xv[2] + xv[3] * xv[3]) + (xv[4] * xv[4] + xv[5] * xv[5]) + (xv[6] * xv[6] + xv[7] * xv[7]);
                    const float y[8] = {xv[0] * g0.x, xv[1] * g0.y, xv[2] * g0.z, xv[3] * g0.w, xv[4] * g1.x, xv[5] * g1.y, xv[6] * g1.z, xv[7] * g1.w};
                    v4u ah, al; ah.x = pk2(y[0], y[1]); ah.y = pk2(y[2], y[3]); ah.z = pk2(y[4], y[5]); ah.w = pk2(y[6], y[7]);
                    al.x = pk2(y[0] - bflo(ah.x), y[1] - bfhi(ah.x)); al.y = pk2(y[2] - bflo(ah.y), y[3] - bfhi(ah.y)); al.z = pk2(y[4] - bflo(ah.z), y[5] - bfhi(ah.z)); al.w = pk2(y[6] - bflo(ah.w), y[7] - bfhi(ah.w));
                    if (tvalid) *(v4u*)(hout + row * DM + 512 * kh + 32 * s + 8 * kg) = ah;
                    const bf16x8 Ah = __builtin_bit_cast(bf16x8, ah), Al = __builtin_bit_cast(bf16x8, al);
#pragma unroll
                    for (int ct = 0; ct < 3; ++ct) { const bf16x8 Bh = *(const LAS bf16x8*)(L + RT_HI + bro[ct] + 64 * s), Bl = *(const LAS bf16x8*)(L + RT_LO + bro[ct] + 64 * s);
                        acc[ct] = __builtin_amdgcn_mfma_f32_16x16x32_bf16(Ah, Bh, acc[ct], 0, 0, 0);
                        acc[ct] = __builtin_amdgcn_mfma_f32_16x16x32_bf16(Ah, Bl, acc[ct], 0, 0, 0);
                        acc[ct] = __builtin_amdgcn_mfma_f32_16x16x32_bf16(Al, Bh, acc[ct], 0, 0, 0); } }
#pragma unroll
                for (int q = 0; q < 8; ++q) xa[q] = xn[q];
            }
            ss += __shfl_xor(ss, 16); ss += __shfl_xor(ss, 32);
            float* LGh = LG + (size_t)kh * T * 48;
            if (tvalid) {
#pragma unroll
                for (int ct = 0; ct < 3; ++ct)
#pragma unroll
                    for (int rg = 0; rg < 4; ++rg) if (ct < 2 || rl < 4) LGh[((size_t)tile * 16 + 4 * kg + rg) * 48 + ct * 16 + rl] = acc[ct][rg];
                if (lane < 16) LGh[((size_t)tile * 16 + lane) * 48 + 47] = ss; }
            asm volatile("s_waitcnt vmcnt(0)" ::: "memory");
            __syncthreads();
            if (kh == 0 && lane < 16 && tvalid) {
                const size_t m = (size_t)tile * 16 + lane;
                const float* l0 = LG + m * 48; const float* l1 = LG + (size_t)T * 48 + m * 48;
                const float sst = __uint_as_float(__hip_atomic_load((const unsigned*)(l0 + 47), RLX_AGENT)) + __uint_as_float(__hip_atomic_load((const unsigned*)(l1 + 47), RLX_AGENT));
                const float r = rsqrtf(sst * (1.f / DM) + RMS_EPS);
                float lg[36];
#pragma unroll
                for (int c = 0; c < 36; ++c) lg[c] = r * (__uint_as_float(__hip_atomic_load((const unsigned*)(l0 + c), RLX_AGENT)) + __uint_as_float(__hip_atomic_load((const unsigned*)(l1 + c), RLX_AGENT)));
                float c0 = lg[32] + bco[0], c1 = lg[33] + bco[1], c2 = lg[34] + bco[2], c3 = lg[35] + bco[3];
                int grp = 0; float cm = c0;
                if (c1 > cm) { cm = c1; grp = 1; } if (c2 > cm) { cm = c2; grp = 2; } if (c3 > cm) { cm = c3; grp = 3; }
                const float ptop = 1.f / (__expf(c0 - cm) + __expf(c1 - cm) + __expf(c2 - cm) + __expf(c3 - cm));
                float fs[8];
#pragma unroll
                for (int i = 0; i < 8; ++i) { float a = lg[i] + bfi[i], b = lg[8 + i] + bfi[8 + i], c = lg[16 + i] + bfi[16 + i], d = lg[24 + i] + bfi[24 + i]; fs[i] = grp == 0 ? a : (grp == 1 ? b : (grp == 2 ? c : d)); }
                int i1 = 0; float v1 = fs[0];
#pragma unroll
                for (int i = 1; i < 8; ++i) if (fs[i] > v1) { v1 = fs[i]; i1 = i; }
                int i2 = -1; float v2 = -3.0e38f;
#pragma unroll
                for (int i = 0; i < 8; ++i) if (i != i1 && fs[i] > v2) { v2 = fs[i]; i2 = i; }
                const float e2 = __expf(v2 - v1), w1 = ptop / (1.f + e2), w2 = ptop * e2 / (1.f + e2);
                if (commit) {
                    const int ea = grp * 8 + i1, eb = grp * 8 + i2;
                    const unsigned ra = __hip_atomic_fetch_add(cnt + 64 * ea, 1u, RLX_AGENT), rb = __hip_atomic_fetch_add(cnt + 64 * eb, 1u, RLX_AGENT);
                    v4u o; o.x = (unsigned)ea; o.y = (unsigned)eb; o.z = ra; o.w = rb; *(v4u*)(route + m * 8) = o;
                    *(f32x4*)(route + m * 8 + 4) = (f32x4){w1, w2, r, 0.f};
                }
            }
        }
    }
    __syncthreads();
}

__device__ __forceinline__ void phase_scatter(const Frame& F0, const bf16* hin, const unsigned* route, const unsigned* cnt, unsigned* ntp, unsigned* tile_e, bf16* hs, float* wrow, float* rrow, unsigned* pos) {
    const Frame F = fresh(F0);
    unsigned* off = (unsigned*)F.lds;
    if (F.tid == 0) { unsigned o = 0;
        for (int e = 0; e < NEXP; ++e) { off[e] = o; const unsigned c = __hip_atomic_load(cnt + 64 * e, RLX_AGENT); const unsigned p = (c + 255u) & ~255u;
            if (F.bid == 0) for (unsigned tI = o >> 8; tI < ((o + p) >> 8); ++tI) tile_e[tI] = (unsigned)e;
            o += p; }
        off[NEXP] = o; if (F.bid == 0) *ntp = o >> 8; }
    __syncthreads();
    const int gw = F.bid * 8 + F.wave, NGW = F.G * 8;
    for (int m0 = gw; m0 < T; m0 += 4 * NGW) {
        v4u ri[4], a[4], b[4]; f32x4 ww[4];
#pragma unroll
        for (int q = 0; q < 4; ++q) { const int m = m0 + q * NGW; if (m < T) { ri[q] = *(const v4u*)(route + (size_t)m * 8); ww[q] = *(const f32x4*)(route + (size_t)m * 8 + 4);
                const v4u* src = (const v4u*)(hin + (size_t)m * DM) + F.lane; a[q] = src[0]; b[q] = src[64]; } }
#pragma unroll
        for (int q = 0; q < 4; ++q) { const int m = m0 + q * NGW; if (m < T) {
                const unsigned d0 = off[ri[q].x] + ri[q].z, d1 = off[ri[q].y] + ri[q].w;
                v4u* p0 = (v4u*)(hs + (size_t)d0 * DM) + F.lane; v4u* p1 = (v4u*)(hs + (size_t)d1 * DM) + F.lane;
                p0[0] = a[q]; p0[64] = b[q]; p1[0] = a[q]; p1[64] = b[q];
                if (F.lane == 0) { wrow[d0] = ww[q].x; wrow[d1] = ww[q].y; rrow[d0] = ww[q].z; rrow[d1] = ww[q].z; *(v2u*)(pos + (size_t)m * 2) = (v2u){d0, d1}; } } }
    }
    __syncthreads();
}

__device__ __forceinline__ void phase_combine(const Frame& F0, const bf16* x, bf16* xdst16, float* xdst32, const bf16* ys, const unsigned* pos, const float* ngain, bf16* hout) {
    const Frame F = fresh(F0);
    const int gw = F.bid * 8 + F.wave, NGW = F.G * 8;
    f32x4 g[4];
#pragma unroll
    for (int j = 0; j < 4; ++j) g[j] = ngain ? *(const f32x4*)(ngain + 4 * F.lane + 256 * j) : (f32x4){0.f, 0.f, 0.f, 0.f};
    for (int m0 = gw; m0 < T; m0 += 2 * NGW) {
        v2u pp[2];
#pragma unroll
        for (int q = 0; q < 2; ++q) { const int m = m0 + q * NGW; pp[q] = (m < T) ? *(const v2u*)(pos + (size_t)m * 2) : (v2u){0u, 0u}; }
        v2u xv[2][4], ya[2][4], yb[2][4];
#pragma unroll
        for (int q = 0; q < 2; ++q) { const int m = m0 + q * NGW; if (m < T) {
                const v2u* xr = (const v2u*)(x + (size_t)m * DM) + F.lane; const v2u* y0 = (const v2u*)(ys + (size_t)pp[q].x * DM) + F.lane; const v2u* y1 = (const v2u*)(ys + (size_t)pp[q].y * DM) + F.lane;
#pragma unroll
                for (int j = 0; j < 4; ++j) { xv[q][j] = xr[64 * j]; ya[q][j] = y0[64 * j]; yb[q][j] = y1[64 * j]; } } }
#pragma unroll
        for (int q = 0; q < 2; ++q) { const int m = m0 + q * NGW; if (m < T) {
                float s = 0.f; f32x4 v[4];
#pragma unroll
                for (int j = 0; j < 4; ++j) { const v2u c = xv[q][j], a = ya[q][j], b = yb[q][j]; f32x4 t;
                    t.x = bflo(c.x) + bflo(a.x) + bflo(b.x); t.y = bfhi(c.x) + bfhi(a.x) + bfhi(b.x); t.z = bflo(c.y) + bflo(a.y) + bflo(b.y); t.w = bfhi(c.y) + bfhi(a.y) + bfhi(b.y);
                    v[j] = t; s += (t.x * t.x + t.y * t.y) + (t.z * t.z + t.w * t.w); }
                if (xdst32) { f32x4* xw = (f32x4*)(xdst32 + (size_t)m * DM) + F.lane;
#pragma unroll
                    for (int j = 0; j < 4; ++j) xw[64 * j] = v[j]; }
                else { v2u* xw = (v2u*)(xdst16 + (size_t)m * DM) + F.lane;
#pragma unroll
                    for (int j = 0; j < 4; ++j) { v2u w; w.x = pk2(v[j].x, v[j].y); w.y = pk2(v[j].z, v[j].w); xw[64 * j] = w; } }
                if (ngain) {
                    const float r = rsqrtf(wave_sum(s) * (1.f / DM) + RMS_EPS);
                    v2u* o8 = (v2u*)(hout + (size_t)m * DM) + F.lane;
#pragma unroll
                    for (int j = 0; j < 4; ++j) { v2u w; w.x = pk2(v[j].x * r * g[j].x, v[j].y * r * g[j].y); w.y = pk2(v[j].z * r * g[j].z, v[j].w * r * g[j].w); o8[64 * j] = w; }
                } } }
    }
}

constexpr int PH_PER_LAYER = 11, N_PHASES = 1 + DEPTH * PH_PER_LAYER;
__device__ __forceinline__ CArgs& kargs() { CArgs* p = (CArgs*)__builtin_amdgcn_kernarg_segment_ptr(); asm volatile("" : "+s"(p)); return *p; }
__global__ void __launch_bounds__(512, 2) mk_fwd(Args args_unused) {
    extern __shared__ __attribute__((aligned(16))) unsigned char lds[];
    LAS unsigned char* lds3 = (LAS unsigned char*)lds;
    const int wave_s = __builtin_amdgcn_readfirstlane(threadIdx.x >> 6);
    for (int u = threadIdx.x; u < (LDS_BYTES - LDSCTL_OFF) / 4; u += 512) ((LAS unsigned*)(lds3 + LDSCTL_OFF))[u] = 0u;
    __syncthreads();
#if MK_SPLIT
#define GRID_BAR() do { } while (0)
#else
    (void)xcd_barrier_post((unsigned*)(kargs().ws + WS_CTL) + CW_BAR, (volatile LAS unsigned*)(lds3 + LDSCTL_OFF));
#define GRID_BAR() do { XcdBarrier b_; b_.bar = (unsigned*)(kargs().ws + WS_CTL) + CW_BAR; b_.x = xb_xcc_id(); b_.st = (volatile LAS unsigned*)(lds3 + LDSCTL_OFF); xcd_barrier(b_); } while (0)
#endif
#define IN(k) (kargs().ph_lo <= (k) && (k) < kargs().ph_hi)
#define SEAM(k) do { if (IN(k) && IN((k) + 1)) GRID_BAR(); } while (0)
#define FRAME() CArgs& A = kargs(); Frame F; F.lds = lds; F.lane = lane_id_asm(); { int w_ = wave_s; asm volatile("" : "+s"(w_)); F.wave = w_; } F.tid = F.wave * 64 + F.lane; { int g_ = gridDim.x, b_ = blockIdx.x; asm volatile("" : "+s"(g_), "+s"(b_)); F.G = g_; F.bid = b_; } \
    unsigned char* ws = A.ws; F.ws = ws; F.ctl = (unsigned*)(ws + WS_CTL); (void)F;
#define WSP(T_, off) ((T_*)(ws + (off)))

#ifdef EXTRA_BARS
    for (int eb_ = 0; eb_ < EXTRA_BARS; ++eb_) GRID_BAR();
#endif
    if (IN(0) && PHON(11)) { for (int rep_ = 0; rep_ < REPN(11); ++rep_) { if (rep_) GRID_BAR(); { FRAME(); phase_prologue(F, A); }
        { FRAME(); phase_norm(F, A.in[I_X], A.in[I_MIXG], WSP(bf16, WS_H)); } } }
    SEAM(0);
#pragma unroll 1
    for (int l = 0; l < DEPTH; ++l) {
        const int p0 = 1 + l * PH_PER_LAYER;
        if (IN(p0 + 1) && PHON(1)) { for (int rep_ = 0; rep_ < REPN(1); ++rep_) { if (rep_) GRID_BAR(); { FRAME();
            pg8::Gemm g{DM, DM, DM};
            SchedDense S{(const char*)(ws + WS_H), (const char*)(ws + WS_WIN) + (size_t)l * NCOL * DM * 2, T / 256, NCOL / 256, F.G, F.bid, (size_t)256 * DM * 2, (size_t)256 * DM * 2};
            EpiStoreBf16 E{WSP(bf16, WS_PROJ), NCOL, C_GL, A.in[I_BGATE] + l * 3 * DM, WSP(v4u, WS_GT)};
            pg8::gemm_phase<EpiStoreBf16, SchedDense, true, true>(lds3, g, S, E, F.tid);
        } } }
        SEAM(p0 + 1);
        if (IN(p0 + 2) && PHON(2)) { for (int rep_ = 0; rep_ < REPN(2); ++rep_) { if (rep_) GRID_BAR(); {
            for (int r2_ = 0; r2_ < REPN(14); ++r2_) { FRAME(); phase_qkprep(F, WSP(bf16, WS_PROJ), A.in[I_QG] + l * 64, A.in[I_KG] + l * 64, WSP(bf16, WS_Q), WSP(bf16, WS_K), WSP(float, WS_KMEAN)); }
            for (int r2_ = 0; r2_ < REPN(15); ++r2_) { FRAME(); phase_conv(F, WSP(bf16, WS_PROJ), A.in[I_CONVW] + (size_t)l * 31 * 512, A.in[I_CONVB] + l * 512, A.in[I_CLNG] + l * 512, A.in[I_CLNB] + l * 512, WSP(bf16, WS_CAT)); }
            for (int r2_ = 0; r2_ < REPN(16); ++r2_) { FRAME(); phase_hgrn1(F, WSP(bf16, WS_PROJ), A.in[I_LBL], l, WSP(float, WS_HS), WSP(float, WS_HS + 16 * MiB), WSP(float, WS_ORAW), WSP(bf16, WS_HS + 17 * MiB)); }
        } } }
        SEAM(p0 + 2);
        if (IN(p0 + 3) && PHON(3)) { for (int rep_ = 0; rep_ < REPN(3); ++rep_) { if (rep_) GRID_BAR(); {
            for (int r2_ = 0; r2_ < REPN(12); ++r2_) { FRAME(); phase_attn_mfma(F, WSP(bf16, WS_Q), WSP(bf16, WS_K), WSP(bf16, WS_PROJ), WSP(float, WS_KMEAN), WSP(bf16, WS_CAT)); }
            for (int r2_ = 0; r2_ < REPN(13); ++r2_) { FRAME(); phase_hgrn2(F, WSP(bf16, WS_PROJ), A.in[I_HGG] + l * 128, WSP(float, WS_HS), WSP(float, WS_HS + 16 * MiB), WSP(float, WS_ORAW), WSP(bf16, WS_HS + 17 * MiB), WSP(bf16, WS_CAT), (r2_ + 1 < REPN(13)) ? PROBE_DRY : 0); }
        } } }
        SEAM(p0 + 3);
        if (IN(p0 + 4) && PHON(4)) { for (int rep_ = 0; rep_ < REPN(4); ++rep_) { if (rep_) GRID_BAR(); { FRAME();
            pg8::Gemm g{1536, 512, 512};
            SchedBranch S{(const char*)(ws + WS_CAT), (const char*)(ws + WS_WCAT) + (size_t)l * 3 * DM * 512 * 2, F.G, F.bid};
            EpiBranch E{WSP(const v4u, WS_GT), WSP(bf16, WS_MERGED)};
            pg8::gemm_phase<EpiBranch, SchedBranch, true, true>(lds3, g, S, E, F.tid);
        } } }
        SEAM(p0 + 4);
        if (IN(p0 + 5) && PHON(5)) { for (int rep_ = 0; rep_ < REPN(5); ++rep_) { if (rep_) GRID_BAR(); { FRAME();
            pg8::Gemm g{DM, DM, DM};
            SchedDense S{(const char*)(ws + WS_MERGED), (const char*)(ws + WS_WOUT) + (size_t)l * DM * DM * 2, T / 256, DM / 256, F.G, F.bid, (size_t)256 * DM * 2, (size_t)256 * DM * 2};
            EpiResidual E{(l == 0) ? A.in[I_X] : (const float*)nullptr, (l == 0) ? (const bf16*)nullptr : WSP(const bf16, WS_XB), (rep_ + 1 >= REPN(5)) ? WSP(bf16, WS_XB) : WSP(bf16, WS_HS)};
            pg8::gemm_phase<EpiResidual, SchedDense, true, true>(lds3, g, S, E, F.tid);
        } } }
        SEAM(p0 + 5);
        if (IN(p0 + 6) && PHON(6)) { for (int rep_ = 0; rep_ < REPN(6); ++rep_) { if (rep_) GRID_BAR(); { FRAME(); phase_router2(F, WSP(const bf16, WS_XB), A.in[I_FFNG] + l * DM, A.in[I_WCO] + (size_t)l * DM * 4, A.in[I_BCO] + l * 4, A.in[I_WFI] + (size_t)l * DM * 32, A.in[I_BFI] + l * 32, WSP(bf16, WS_H), WSP(unsigned, WS_ROUTE), F.ctl + CW_CNT + l * 32 * 64, WSP(float, WS_Q), rep_ + 1 >= REPN(6)); } } }
        SEAM(p0 + 6);
        if (IN(p0 + 7) && PHON(7)) { for (int rep_ = 0; rep_ < REPN(7); ++rep_) { if (rep_) GRID_BAR(); { FRAME(); phase_scatter(F, WSP(bf16, WS_H), WSP(unsigned, WS_ROUTE), F.ctl + CW_CNT + l * 32 * 64, F.ctl + CW_NT + l * 64, F.ctl + CW_TILE + l * 256, WSP(bf16, WS_HS), WSP(float, WS_POS + 512 * 1024), WSP(float, WS_POS + 768 * 1024), WSP(unsigned, WS_POS)); } } }
        SEAM(p0 + 7);
        if (IN(p0 + 8) && PHON(8)) { for (int rep_ = 0; rep_ < REPN(8); ++rep_) { if (rep_) GRID_BAR(); { FRAME();
            pg8::Gemm g{DM, DM, DM};
            SchedMoe S{(const char*)(ws + WS_HS), (const char*)(ws + WS_WEI) + (size_t)l * NEXP * 1024 * DM * 2, F.ctl + CW_NT + l * 64, F.ctl + CW_TILE + l * 256, F.G, F.bid, (size_t)256 * DM * 2, (size_t)1024 * DM * 2, (size_t)256 * DM * 2};
            EpiSwiglu E{WSP(bf16, WS_ACT), WSP(float, WS_POS + 768 * 1024)};
            pg8::gemm_phase<EpiSwiglu, SchedMoe, true, true>(lds3, g, S, E, F.tid);
        } } }
        SEAM(p0 + 8);
        if (IN(p0 + 9) && PHON(9)) { for (int rep_ = 0; rep_ < REPN(9); ++rep_) { if (rep_) GRID_BAR(); { FRAME();
            pg8::Gemm g{FF, FF, FF};
            SchedMoe S{(const char*)(ws + WS_ACT), (const char*)(ws + WS_WEO) + (size_t)l * NEXP * DM * FF * 2, F.ctl + CW_NT + l * 64, F.ctl + CW_TILE + l * 256, F.G, F.bid, (size_t)256 * FF * 2, (size_t)DM * FF * 2, (size_t)256 * FF * 2};
            EpiScaleRows E{WSP(bf16, WS_YS), WSP(float, WS_POS + 512 * 1024)};
            pg8::gemm_phase<EpiScaleRows, SchedMoe, true, true>(lds3, g, S, E, F.tid);
        } } }
        SEAM(p0 + 9);
        if (IN(p0 + 10) && PHON(10)) { for (int rep_ = 0; rep_ < REPN(10); ++rep_) { if (rep_) GRID_BAR(); { FRAME(); const bool real_ = (rep_ + 1 >= REPN(10)), lastl_ = (l + 1 >= DEPTH); phase_combine(F, WSP(const bf16, WS_XB), (real_ && !lastl_) ? WSP(bf16, WS_XB) : WSP(bf16, WS_HS), (real_ && lastl_) ? A.out : (float*)nullptr, WSP(bf16, WS_YS), WSP(unsigned, WS_POS), lastl_ ? (const float*)nullptr : A.in[I_MIXG] + (l + 1) * DM, WSP(bf16, WS_H)); } } }
        SEAM(p0 + 10);
    }
#undef IN
#undef SEAM
#undef FRAME
#undef WSP
}

extern "C" void kernel_launch(void* const* d_in, const int* in_sizes, int n_in, void* d_out, int out_size, void* d_ws, size_t ws_size, hipStream_t stream) {
    static int grid = 0;
    if (grid == 0) {
        if (n_in != 23 || out_size != T * DM || ws_size < WS_END) { fprintf(stderr, "kernel_launch: unexpected shapes (n_in %d out %d ws %zu)\n", n_in, out_size, ws_size); grid = -1; return; }
        int dev = 0, cus = 0, per_cu = 0;
        if (hipGetDevice(&dev) != hipSuccess || hipDeviceGetAttribute(&cus, hipDeviceAttributeMultiprocessorCount, dev) != hipSuccess) { grid = -1; return; }
        if (hipFuncSetAttribute((const void*)mk_fwd, hipFuncAttributeMaxDynamicSharedMemorySize, LDS_BYTES) != hipSuccess) { fprintf(stderr, "kernel_launch: hipFuncSetAttribute failed\n"); grid = -1; return; }
        if (hipOccupancyMaxActiveBlocksPerMultiprocessor(&per_cu, (const void*)mk_fwd, 512, LDS_BYTES) != hipSuccess || per_cu < 1) fprintf(stderr, "kernel_launch: occupancy query says %d\n", per_cu);
        (void)hipGetLastError();
        grid = cus;
    }
    if (grid < 0) return;
    (void)hipMemsetAsync((char*)d_ws + WS_CTL, 0, CTL_ZERO_BYTES, stream);
    Args a{};
    for (int i = 0; i < 23; ++i) a.in[i] = (const float*)d_in[i];
    a.out = (float*)d_out; a.ws = (unsigned char*)d_ws;
#if MK_SPLIT
    for (int p = 0; p < N_PHASES; ++p) {
        if (p == 1 + PH_PER_LAYER) continue;
        a.ph_lo = p; a.ph_hi = p + 1;
        hipLaunchKernelGGL(mk_fwd, dim3(grid), dim3(512), LDS_BYTES, stream, a);
    }
#else
    a.ph_lo = 0; a.ph_hi = N_PHASES;
    hipLaunchKernelGGL(mk_fwd, dim3(grid), dim3(512), LDS_BYTES, stream, a);
#endif
}
```

```cpp
#include <hip/hip_runtime.h>
#include <cstdio>
#include <cstdint>

#ifndef MK_SPLIT
#define MK_SPLIT 0
#endif
#ifndef DBG_MASK
#define DBG_MASK 0xFFFFu
#endif
#define PHON(j) (((DBG_MASK) >> (j)) & 1u)
#ifndef REP_MASK
#define REP_MASK 0u
#endif
#ifndef REP_EXTRA
#define REP_EXTRA 1
#endif
#ifndef PROBE_DRY
#define PROBE_DRY 0
#endif
#define REPN(j) ((((REP_MASK) >> (j)) & 1u) ? (1 + REP_EXTRA) : 1)

constexpr int DM = 1024, NB = 8, SEQ = 2048, T = NB * SEQ, DEPTH = 2;
constexpr int NCOL = 7680;
constexpr int C_AQ = 0, C_AK = 512, C_AV = 1024, C_HQ = 1536, C_HF = 2048, C_HI = 2560, C_HG = 3072, C_CA = 3584, C_CB = 4096, C_GL = 4608;
constexpr int NEXP = 32, FF = 512;
constexpr int MOE_ROWS = 2 * T + NEXP * 256;
constexpr float RMS_EPS = 1e-6f, LN_EPS = 1e-5f;
constexpr float QSCALE = 0.125f * 1.4426950408889634f;

namespace pg8 {
#define PG8_LAS __attribute__((address_space(3)))
typedef unsigned short bf16_t;
typedef short bf16x8 __attribute__((ext_vector_type(8)));
typedef float f32x4 __attribute__((ext_vector_type(4)));
typedef unsigned u32x4 __attribute__((ext_vector_type(4)));
constexpr int BM = 256, BK = 64, HALF = 128, HTB = HALF * BK * 2, STAGE_BYTES = 8 * HTB, NXCD = 8, WGM = 8;

__host__ __device__ __forceinline__ int lds_byte(int r, int c) { const int st = (r >> 4) * 2 + (c >> 5), rr = r & 15, cc = c & 31, ob = rr * 64 + cc * 2; return st * 1024 + (ob ^ (((ob >> 9) & 1) << 5)); }
__host__ __device__ __forceinline__ void stage_rc(int b, int& R, int& C) { const int st = b / 1024, sb = b % 1024, swz = sb ^ (((sb >> 9) & 1) << 5); R = (st >> 1) * 16 + swz / 64; C = (st & 1) * 32 + (swz % 64) / 2; }
__host__ __device__ __forceinline__ int perm32(int rho) { const int n = rho >> 4, i = rho & 15; return 8 * (i >> 2) + 4 * n + (i & 3); }

struct Unit { int pm, pn, aux, pad; const char* a; const char* b; };
struct Gemm { int lda, ldb, K; };

__device__ __forceinline__ bool static_tile(int nM, int nN, long L, int& pm, int& pn) {
    const int nwg = nM * nN; if (L >= nwg) return false;
    int wgid = (int)L; { const int q = nwg / NXCD, r = nwg % NXCD, xcd = wgid % NXCD, off = wgid / NXCD; wgid = (xcd < r ? xcd * (q + 1) : r * (q + 1) + (xcd - r) * q) + off; }
    const int nig = WGM * nN, gid = wgid / nig, fm = gid * WGM, gsz = (nM - fm) < WGM ? (nM - fm) : WGM;
    pm = fm + ((wgid % nig) % gsz); pn = (wgid % nig) / gsz; return true;
}

__device__ __forceinline__ unsigned cvt_pk_bf16(float lo, float hi) { unsigned r; asm volatile("v_cvt_pk_bf16_f32 %0, %1, %2" : "=v"(r) : "v"(lo), "v"(hi)); return r; }

template <class Epi, class Sched, bool ALIGN_EPI = false, bool SP2 = false>
__device__ __forceinline__ void gemm_phase(PG8_LAS unsigned char* lds, const Gemm g, const Sched& S, const Epi& E, int tid_in) {
    int tid_ = tid_in; asm volatile("" : "+v"(tid_));
    const int tid = tid_, wid = __builtin_amdgcn_readfirstlane(tid >> 6), lane = tid & 63, wr = wid >> 2, wc = wid & 3, fr = lane & 15, fq = lane >> 4;
    const int K = g.K, nt = K / BK;
    unsigned voffA[2], voffB[2];
#pragma unroll
    for (int i = 0; i < 2; ++i) { int R, C; stage_rc(tid * 16 + i * 8192, R, C); const int Rb = Epi::PERM ? ((R & ~31) + perm32(R & 31)) : R;
        voffA[i] = (unsigned)(R * g.lda + C) * 2u; voffB[i] = (unsigned)(Rb * g.ldb + C) * 2u; }
    const size_t kstep = (size_t)(BK * 2);
    const size_t hstepA = (size_t)HALF * g.lda * 2, hstepB = (size_t)HALF * g.ldb * 2;
    const unsigned ldsw = (unsigned)wid * 1024u;
    const int aoff = lds_byte(wr * 64 + fr, fq * 8), boff = lds_byte(wc * 32 + fr, fq * 8);
#define PG8_SA(b, h) (((b) * 2 + (h)) * HTB)
#define PG8_SB(b, h) ((4 + (b) * 2 + (h)) * HTB)
#define PG8_STAGE(bufoff, gbase, voff) do { _Pragma("unroll") for (int _i = 0; _i < 2; ++_i) \
        __builtin_amdgcn_global_load_lds((const unsigned*)((const char*)(gbase) + (voff)[_i]), (PG8_LAS unsigned*)(lds + (bufoff) + ldsw + _i * 8192), 16, 0, 0); } while (0)
#define PG8_LDA(dst, b, h) do { _Pragma("unroll") for (int m = 0; m < 4; ++m) _Pragma("unroll") for (int k = 0; k < 2; ++k) dst[m][k] = *(const PG8_LAS bf16x8*)(lds + PG8_SA(b, h) + aoff + m * 2048 + k * 1024); } while (0)
#define PG8_LDB(dst, b, h) do { _Pragma("unroll") for (int n = 0; n < 2; ++n) _Pragma("unroll") for (int k = 0; k < 2; ++k) dst[n][k] = *(const PG8_LAS bf16x8*)(lds + PG8_SB(b, h) + boff + n * 2048 + k * 1024); } while (0)
#define PG8_MMA(ai, bj, At, Bt) do { __builtin_amdgcn_s_setprio(1); _Pragma("unroll") for (int m = 0; m < 4; ++m) _Pragma("unroll") for (int n = 0; n < 2; ++n) _Pragma("unroll") for (int k = 0; k < 2; ++k) \
        acc[ai][bj][m][n] = __builtin_amdgcn_mfma_f32_16x16x32_bf16(Bt[n][k], At[m][k], acc[ai][bj][m][n], 0, 0, 0); __builtin_amdgcn_s_setprio(0); } while (0)
#define PG8_WAIT_V(n) asm volatile("s_waitcnt vmcnt(" #n ")" ::: "memory")
#define PG8_WAIT_L(n) asm volatile("s_waitcnt lgkmcnt(" #n ")" ::: "memory")
#define PG8_BAR __builtin_amdgcn_s_barrier()
#define PG8_SCHED __builtin_amdgcn_sched_barrier(0)
    Unit cur, nxt; int ui = 0;
    if (!S.next(0, cur)) return;
    f32x4 acc[2][2][4][2];
#pragma unroll
    for (int a = 0; a < 2; ++a)
#pragma unroll
        for (int b = 0; b < 2; ++b)
#pragma unroll
            for (int m = 0; m < 4; ++m)
#pragma unroll
                for (int n = 0; n < 2; ++n) acc[a][b][m][n] = (f32x4){0.f, 0.f, 0.f, 0.f};
    bf16x8 At[4][2], B0[2][2], B1[2][2];
    const char* cA = cur.a; const char* cB = cur.b;
    if constexpr (SP2) {
        PG8_STAGE(PG8_SB(0, 0), cB, voffB); PG8_STAGE(PG8_SB(0, 1), cB + hstepB, voffB); PG8_STAGE(PG8_SA(0, 0), cA, voffA); PG8_STAGE(PG8_SA(0, 1), cA + hstepA, voffA);
        if (wr == 1) PG8_BAR;
        PG8_WAIT_V(2); PG8_BAR;
        PG8_STAGE(PG8_SB(1, 0), cB + kstep, voffB); PG8_STAGE(PG8_SA(1, 0), cA + kstep, voffA); PG8_STAGE(PG8_SB(1, 1), cB + hstepB + kstep, voffB);
        PG8_WAIT_V(6); PG8_BAR;
    } else {
        PG8_STAGE(PG8_SB(0, 0), cB, voffB); PG8_STAGE(PG8_SA(0, 0), cA, voffA); PG8_STAGE(PG8_SB(0, 1), cB + hstepB, voffB); PG8_STAGE(PG8_SA(0, 1), cA + hstepA, voffA);
        if (wr == 1) PG8_BAR;
        PG8_WAIT_V(4); PG8_BAR;
        PG8_STAGE(PG8_SB(1, 0), cB + kstep, voffB); PG8_STAGE(PG8_SA(1, 0), cA + kstep, voffA); PG8_STAGE(PG8_SB(1, 1), cB + hstepB + kstep, voffB);
        PG8_WAIT_V(6); PG8_BAR;
    }
    for (;;) {
        const bool has_next = S.next(ui + 1, nxt);
        const char* nA = has_next ? nxt.a : cA; const char* nB = has_next ? nxt.b : cB;
        for (int t = 0; t < nt; t += 2) {
            const bool last = (t == nt - 2);
            const char* a1 = cA + (size_t)(t + 1) * kstep;
            const char* a2 = last ? nA : cA + (size_t)(t + 2) * kstep; const char* b2 = last ? nB : cB + (size_t)(t + 2) * kstep;
            const char* a3 = a2 + kstep; const char* b3 = b2 + kstep;
            if constexpr (SP2) {
            PG8_LDB(B0, 0, 0); PG8_LDB(B1, 0, 1); PG8_SCHED; PG8_LDA(At, 0, 0); PG8_STAGE(PG8_SA(1, 1), a1 + hstepA, voffA);
            PG8_WAIT_V(8); PG8_WAIT_L(0); PG8_BAR; PG8_MMA(0, 0, At, B0); PG8_MMA(0, 1, At, B1); PG8_BAR; PG8_SCHED;
            PG8_LDA(At, 0, 1); PG8_STAGE(PG8_SB(0, 0), b2, voffB); PG8_STAGE(PG8_SB(0, 1), b2 + hstepB, voffB); PG8_STAGE(PG8_SA(0, 0), a2, voffA);
            PG8_WAIT_V(8); PG8_WAIT_L(0); PG8_BAR; PG8_MMA(1, 0, At, B0); PG8_MMA(1, 1, At, B1); PG8_BAR; PG8_SCHED;
            PG8_LDB(B0, 1, 0); PG8_LDB(B1, 1, 1); PG8_SCHED; PG8_LDA(At, 1, 0); PG8_STAGE(PG8_SA(0, 1), a2 + hstepA, voffA);
            PG8_WAIT_V(8); PG8_WAIT_L(0); PG8_BAR; PG8_MMA(0, 0, At, B0); PG8_MMA(0, 1, At, B1); PG8_BAR; PG8_SCHED;
            PG8_LDA(At, 1, 1); PG8_STAGE(PG8_SB(1, 0), b3, voffB); PG8_STAGE(PG8_SB(1, 1), b3 + hstepB, voffB); PG8_STAGE(PG8_SA(1, 0), a3, voffA);
            PG8_WAIT_V(8); PG8_WAIT_L(0); PG8_BAR; PG8_MMA(1, 0, At, B0); PG8_MMA(1, 1, At, B1); PG8_BAR; PG8_SCHED;
            } else {
            PG8_LDB(B0, 0, 0); PG8_SCHED; PG8_LDA(At, 0, 0); PG8_STAGE(PG8_SA(1, 1), a1 + hstepA, voffA);
            PG8_WAIT_L(8); PG8_BAR; PG8_WAIT_L(0); PG8_MMA(0, 0, At, B0); PG8_BAR; PG8_SCHED;
            PG8_LDB(B1, 0, 1); PG8_STAGE(PG8_SB(0, 0), b2, voffB);
            PG8_BAR; PG8_WAIT_L(0); PG8_MMA(0, 1, At, B1); PG8_BAR;
            PG8_LDA(At, 0, 1); PG8_STAGE(PG8_SA(0, 0), a2, voffA);
            PG8_BAR; PG8_WAIT_L(0); PG8_MMA(1, 0, At, B0); PG8_BAR; PG8_SCHED;
            PG8_STAGE(PG8_SB(0, 1), b2 + hstepB, voffB);
            PG8_WAIT_V(6); PG8_BAR; PG8_MMA(1, 1, At, B1); PG8_BAR;
            PG8_LDB(B0, 1, 0); PG8_SCHED; PG8_LDA(At, 1, 0); PG8_STAGE(PG8_SA(0, 1), a2 + hstepA, voffA);
            PG8_WAIT_L(8); PG8_BAR; PG8_WAIT_L(0); PG8_MMA(0, 0, At, B0); PG8_BAR; PG8_SCHED;
            PG8_LDB(B1, 1, 1); PG8_STAGE(PG8_SB(1, 0), b3, voffB);
            PG8_BAR; PG8_WAIT_L(0); PG8_MMA(0, 1, At, B1); PG8_BAR;
            PG8_LDA(At, 1, 1); PG8_STAGE(PG8_SA(1, 0), a3, voffA);
            PG8_BAR; PG8_WAIT_L(0); PG8_MMA(1, 0, At, B0); PG8_BAR; PG8_SCHED;
            PG8_STAGE(PG8_SB(1, 1), b3 + hstepB, voffB);
            PG8_WAIT_V(6); PG8_BAR; PG8_MMA(1, 1, At, B1); PG8_BAR;
            }
        }
        if constexpr (ALIGN_EPI) { if (wr == 0) PG8_BAR; }
        const bool reset_acc = E(acc, cur, wr, wc, fr, fq);
        if (!has_next) break;
        if (reset_acc) {
#pragma unroll
        for (int a = 0; a < 2; ++a)
#pragma unroll
            for (int b = 0; b < 2; ++b)
#pragma unroll
                for (int m = 0; m < 4; ++m)
#pragma unroll
                    for (int n = 0; n < 2; ++n) acc[a][b][m][n] = (f32x4){0.f, 0.f, 0.f, 0.f};
        }
        cur = nxt; cA = nA; cB = nB; ++ui;
        if constexpr (ALIGN_EPI) { if (wr == 1) PG8_BAR; }
    }
    PG8_WAIT_V(0);
    if constexpr (!ALIGN_EPI) { if (wr == 0) PG8_BAR; }
    PG8_BAR;
#undef PG8_SA
#undef PG8_SB
#undef PG8_STAGE
#undef PG8_LDA
#undef PG8_LDB
#undef PG8_MMA
#undef PG8_WAIT_V
#undef PG8_WAIT_L
#undef PG8_BAR
#undef PG8_SCHED
}
}

constexpr size_t MiB = 1u << 20;
constexpr size_t WS_CTL = 0, CTL_ZERO_BYTES = 1 * MiB;
constexpr size_t WS_WIN = 2 * MiB;
constexpr size_t WS_WCAT = WS_WIN + 30 * MiB;
constexpr size_t WS_WOUT = WS_WCAT + 6 * MiB;
constexpr size_t WS_WEI = WS_WOUT + 4 * MiB;
constexpr size_t WS_WEO = WS_WEI + 128 * MiB;
constexpr size_t WS_H = WS_WEO + 64 * MiB;
constexpr size_t WS_PROJ = WS_H + 32 * MiB;
constexpr size_t WS_Q = WS_PROJ + 240 * MiB;
constexpr size_t WS_K = WS_Q + 16 * MiB;
constexpr size_t WS_KMEAN = WS_K + 16 * MiB;
constexpr size_t WS_CAT = WS_KMEAN + 1 * MiB;
constexpr size_t WS_MERGED = WS_CAT + 48 * MiB;
constexpr size_t WS_ORAW = WS_MERGED + 32 * MiB;
constexpr size_t WS_ROUTE = WS_ORAW + 32 * MiB;
constexpr size_t WS_POS = WS_ROUTE + 1 * MiB;
constexpr size_t WS_HS = WS_POS + 1 * MiB;
constexpr size_t WS_ACT = WS_HS + 80 * MiB;
constexpr size_t WS_YS = WS_ACT + 40 * MiB;
constexpr size_t WS_XB = WS_YS + 80 * MiB;
constexpr size_t WS_GT = WS_XB + 32 * MiB;
constexpr size_t WS_END = WS_GT + 96 * MiB;
static_assert(WS_END <= 1000 * MiB, "workspace map");
constexpr int CW_BAR = 4096;
constexpr int CW_CNT = 16384;
constexpr int CW_NT = CW_CNT + 2 * 32 * 64;
constexpr int CW_TILE = CW_NT + 2 * 64;
static_assert((CW_TILE + 2 * 256) * 4 <= (int)CTL_ZERO_BYTES, "ctl");

constexpr int LDS_SCRATCH = 155136, LDSCTL_OFF = LDS_SCRATCH, LDS_BYTES = 155648;

#define GAS __attribute__((address_space(1)))
#define LAS __attribute__((address_space(3)))
typedef unsigned short bf16;
typedef unsigned v4u __attribute__((ext_vector_type(4)));
typedef unsigned v2u __attribute__((ext_vector_type(2)));
typedef float f32x4 __attribute__((ext_vector_type(4)));
typedef float f32x2 __attribute__((ext_vector_type(2)));
#define RLX_AGENT __ATOMIC_RELAXED, __HIP_MEMORY_SCOPE_AGENT
__device__ __forceinline__ unsigned f2bf(float f) { unsigned u = __builtin_bit_cast(unsigned, f); return (u + 0x7fffu + ((u >> 16) & 1u)) >> 16; }
__device__ __forceinline__ unsigned pk2(float lo, float hi) { unsigned r; asm("v_cvt_pk_bf16_f32 %0, %1, %2" : "=v"(r) : "v"(lo), "v"(hi)); return r; }
__device__ __forceinline__ float bflo(unsigned w) { return __uint_as_float(w << 16); }
__device__ __forceinline__ float bfhi(unsigned w) { return __uint_as_float(w & 0xffff0000u); }
__device__ __forceinline__ float bf2f(bf16 v) { return __uint_as_float((unsigned)v << 16); }
__device__ __forceinline__ float sigmoidf_(float x) { return __builtin_amdgcn_rcpf(1.0f + __expf(-x)); }
__device__ __forceinline__ float wave_sum(float v) {
    v += __int_as_float(__builtin_amdgcn_update_dpp(0, __float_as_int(v), 0xB1, 0xf, 0xf, true));
    v += __int_as_float(__builtin_amdgcn_update_dpp(0, __float_as_int(v), 0x4E, 0xf, 0xf, true));
    v += __int_as_float(__builtin_amdgcn_update_dpp(0, __float_as_int(v), 0x141, 0xf, 0xf, true));
    v += __int_as_float(__builtin_amdgcn_update_dpp(0, __float_as_int(v), 0x140, 0xf, 0xf, true));
    { auto r = __builtin_amdgcn_permlane16_swap(__float_as_uint(v), __float_as_uint(v), false, false); v = __uint_as_float(r[0]) + __uint_as_float(r[1]); }
    { auto r = __builtin_amdgcn_permlane32_swap(__float_as_uint(v), __float_as_uint(v), false, false); v = __uint_as_float(r[0]) + __uint_as_float(r[1]); }
    return v;
}

__device__ __forceinline__ void lds_barrier() { asm volatile("s_waitcnt lgkmcnt(0)\n\ts_barrier" ::: "memory"); }

#define XB_TMO      128
#define XB_XCNT(j)  (256  + 64 * (j))
#define XB_XSUB(j)  (1280 + 64 * (j))
#define XB_XGEN(j)  (2304 + 64 * (j))
#define XB_TOP      3328
#define XB_TOPGEN   3392
#define XCD_BAR_WORDS 3456
#define XB_SPIN_CAP (1u << 18)
__device__ __forceinline__ unsigned xb_ld(unsigned* p)              { return __hip_atomic_load(p, __ATOMIC_RELAXED, __HIP_MEMORY_SCOPE_AGENT); }
__device__ __forceinline__ unsigned xb_add(unsigned* p, unsigned v) { return __hip_atomic_fetch_add(p, v, __ATOMIC_RELAXED, __HIP_MEMORY_SCOPE_AGENT); }
__device__ __forceinline__ unsigned xb_xcc_id() { return (unsigned)__builtin_amdgcn_s_getreg((3 << 11) | 20) & 0xFu; }
#define XB_SPIN(cond, bar) do { unsigned _sp = 0; while (cond) { __builtin_amdgcn_s_sleep(1); \
    if ((++_sp & 255u) == 0u) { if (xb_ld(&(bar)[XB_TMO])) break; if (_sp > XB_SPIN_CAP) { atomicAdd(&(bar)[XB_TMO], 1u); break; } } } } while (0)
struct XcdBarrier { unsigned* bar; unsigned x; volatile LAS unsigned* st; };
__device__ __forceinline__ XcdBarrier xcd_barrier_post(unsigned* bar, volatile LAS unsigned* st) {
    XcdBarrier b; b.bar = bar; b.x = xb_xcc_id(); b.st = st;
    if (threadIdx.x == 0) (void)xb_add(&bar[XB_XCNT(b.x)], 1u);
    return b;
}
__device__ __forceinline__ void xcd_barrier_complete(unsigned* bar, unsigned x, unsigned& nloc, unsigned& nx) {
    const unsigned G = gridDim.x * gridDim.y * gridDim.z;
    unsigned sum, cnt, mine, sp = 0u;
    for (;;) {
        sum = 0u; cnt = 0u; mine = 0u;
#pragma unroll
        for (unsigned j = 0; j < 16; ++j) { const unsigned c = xb_ld(&bar[XB_XCNT(j)]); sum += c; cnt += (c > 0u) ? 1u : 0u; mine = (j == x) ? c : mine; }
        if (sum == G) break;
        __builtin_amdgcn_s_sleep(1);
        if ((++sp & 255u) == 0u) { if (xb_ld(&bar[XB_TMO])) break; if (sp > XB_SPIN_CAP) { atomicAdd(&bar[XB_TMO], 1u); break; } }
    }
    nloc = mine > 0u ? mine : 1u; nx = cnt > 0u ? cnt : 1u;
}
__device__ __forceinline__ void xcd_barrier(const XcdBarrier& b) {
    asm volatile("s_waitcnt vmcnt(0)" ::: "memory");
    __syncthreads();
    if (threadIdx.x == 0) {
        unsigned* bar = b.bar;
        __builtin_amdgcn_s_waitcnt(0);
        unsigned nloc = b.st[0], nx = b.st[1];
        if (nloc == 0u) { xcd_barrier_complete(bar, b.x, nloc, nx); b.st[0] = nloc; b.st[1] = nx; }
        const unsigned old = xb_add(&bar[XB_XSUB(b.x)], 1u);
        const unsigned gen = old / nloc;
        if (old + 1u == (gen + 1u) * nloc) {
            __builtin_amdgcn_fence(__ATOMIC_RELEASE, "agent");
            asm volatile("s_waitcnt vmcnt(0)" ::: "memory");
            const unsigned og = xb_add(&bar[XB_TOP], 1u);
            const unsigned tg = og / nx;
            if (og + 1u == (tg + 1u) * nx) xb_add(&bar[XB_TOPGEN], 1u);
            else XB_SPIN(xb_ld(&bar[XB_TOPGEN]) == tg, bar);
            __builtin_amdgcn_fence(__ATOMIC_ACQUIRE, "agent");
            xb_add(&bar[XB_XGEN(b.x)], 1u);
            asm volatile("s_waitcnt vmcnt(0)" ::: "memory");
        } else {
            XB_SPIN(xb_ld(&bar[XB_XGEN(b.x)]) == gen, bar);
            __builtin_amdgcn_fence(__ATOMIC_ACQUIRE, "agent");
            asm volatile("s_waitcnt vmcnt(0)" ::: "memory");
        }
    }
    __syncthreads();
}

struct Args { const float* in[23]; float* out; unsigned char* ws; int ph_lo, ph_hi; };
typedef const Args __attribute__((address_space(4))) CArgs;
enum InIdx { I_X = 0, I_MIXG, I_WIN, I_BGATE, I_QG, I_KG, I_LBL, I_HGG, I_CONVW, I_CONVB, I_CLNG, I_CLNB, I_WATT, I_WHGRN, I_WCONV, I_WOUT, I_FFNG, I_WCO, I_BCO, I_WFI, I_BFI, I_WEI, I_WEO };

struct Frame {
    unsigned char* lds;
    int tid, lane, wave, G, bid;
    unsigned char* ws; unsigned* ctl;
};
__device__ __forceinline__ int xcd_order(int bid, int G) { return (G % 8 == 0) ? (bid % 8) * (G / 8) + bid / 8 : bid; }
__device__ __forceinline__ int lane_id_asm() { int l; asm volatile("v_mbcnt_lo_u32_b32 %0, -1, 0\n\tv_mbcnt_hi_u32_b32 %0, -1, %0" : "=v"(l)); return l; }
__device__ __forceinline__ Frame fresh(Frame F) { asm volatile("" : "+v"(F.tid)); F.lane = F.tid & 63; return F; }

struct TItem { const float* W; bf16* WT; int K, N, k0, n0, drow0; };
__device__ __forceinline__ void titem_load(const TItem& t, int lane, float (&v)[32]) {
#pragma unroll
    for (int i = 0; i < 32; ++i) { const int kk = 2 * i + (lane >> 5); v[i] = __builtin_nontemporal_load(t.W + (size_t)(t.k0 + kk) * t.N + t.n0 + (lane & 31)); }
}
__device__ __forceinline__ void titem_emit(const TItem& t, int lane, const float (&v)[32], float* scr) {
#pragma unroll
    for (int i = 0; i < 32; ++i) { const int kk = 2 * i + (lane >> 5); scr[kk * 33 + (lane & 31)] = v[i]; }
    asm volatile("s_waitcnt lgkmcnt(0)" ::: "memory");
    const int c = lane & 7;
#pragma unroll
    for (int j = 0; j < 4; ++j) { const int n = (lane >> 3) + 8 * j; const float* s = scr + (8 * c) * 33 + n;
        v4u o; o.x = pk2(s[0 * 33], s[1 * 33]); o.y = pk2(s[2 * 33], s[3 * 33]); o.z = pk2(s[4 * 33], s[5 * 33]); o.w = pk2(s[6 * 33], s[7 * 33]);
        *(v4u*)(t.WT + (size_t)(t.drow0 + n) * t.K + t.k0 + 8 * c) = o; }
    asm volatile("s_waitcnt lgkmcnt(0)" ::: "memory");
}
__device__ __forceinline__ TItem titem_decode(CArgs& A, unsigned char* ws, int it) {
    constexpr int I_IN = (DM / 64) * (NCOL / 32), I_BR = (512 / 64) * (DM / 32), I_OUT = (DM / 64) * (DM / 32), I_EI = (DM / 64) * (1024 / 32), I_EO = (FF / 64) * (DM / 32);
    constexpr int PER_L = I_IN + 3 * I_BR + I_OUT + NEXP * I_EI + NEXP * I_EO;
    TItem t; const int l = it / PER_L; int r = it % PER_L;
    if (r < I_IN) { const int nblk = NCOL / 32, kb = r / nblk, nb = r % nblk;
        t.W = A.in[I_WIN] + (size_t)l * DM * NCOL; t.K = DM; t.N = NCOL; t.WT = (bf16*)(ws + WS_WIN) + (size_t)l * NCOL * DM; t.k0 = 64 * kb; t.n0 = 32 * nb; t.drow0 = 32 * nb; return t; }
    r -= I_IN;
    if (r < 3 * I_BR) { const int br = r / I_BR, rr = r % I_BR, nblk = DM / 32, kb = rr / nblk, nb = rr % nblk;
        t.W = A.in[br == 0 ? I_WATT : (br == 1 ? I_WHGRN : I_WCONV)] + (size_t)l * 512 * DM; t.K = 512; t.N = DM; t.WT = (bf16*)(ws + WS_WCAT) + ((size_t)l * 3 + br) * DM * 512; t.k0 = 64 * kb; t.n0 = 32 * nb; t.drow0 = 32 * nb; return t; }
    r -= 3 * I_BR;
    if (r < I_OUT) { const int nblk = DM / 32, kb = r / nblk, nb = r % nblk;
        t.W = A.in[I_WOUT] + (size_t)l * DM * DM; t.K = DM; t.N = DM; t.WT = (bf16*)(ws + WS_WOUT) + (size_t)l * DM * DM; t.k0 = 64 * kb; t.n0 = 32 * nb; t.drow0 = 32 * nb; return t; }
    r -= I_OUT;
    if (r < NEXP * I_EI) { const int e = r / I_EI, rr = r % I_EI, nblk = 1024 / 32, kb = rr / nblk, nb = rr % nblk, n0 = 32 * nb;
        const int nn = n0 & 511;
        t.W = A.in[I_WEI] + ((size_t)l * NEXP + e) * DM * 1024; t.K = DM; t.N = 1024; t.WT = (bf16*)(ws + WS_WEI) + ((size_t)l * NEXP + e) * 1024 * DM; t.k0 = 64 * kb; t.n0 = n0; t.drow0 = (nn >> 7) * 256 + (n0 >= 512 ? 128 : 0) + (nn & 127); return t; }
    r -= NEXP * I_EI;
    { const int e = r / I_EO, rr = r % I_EO, nblk = DM / 32, kb = rr / nblk, nb = rr % nblk;
        t.W = A.in[I_WEO] + ((size_t)l * NEXP + e) * FF * DM; t.K = FF; t.N = DM; t.WT = (bf16*)(ws + WS_WEO) + ((size_t)l * NEXP + e) * DM * FF; t.k0 = 64 * kb; t.n0 = 32 * nb; t.drow0 = 32 * nb; return t; }
}
__device__ __forceinline__ void phase_prologue(const Frame& F0, CArgs& A) {
    const Frame F = fresh(F0);
    float* scr = (float*)(F.lds + F.wave * 16384);
    const int gw = F.bid * 8 + F.wave, NGW = F.G * 8;
    constexpr int I_IN = (DM / 64) * (NCOL / 32), I_BR = (512 / 64) * (DM / 32), I_OUT = (DM / 64) * (DM / 32), I_EI = (DM / 64) * (1024 / 32), I_EO = (FF / 64) * (DM / 32);
    constexpr int NIT = DEPTH * (I_IN + 3 * I_BR + I_OUT + NEXP * I_EI + NEXP * I_EO);
    if (gw >= NIT) return;
    float cur[32], nxt[32];
    TItem tc = titem_decode(A, F.ws, gw);
    titem_load(tc, F.lane, cur);
    for (int it = gw; it < NIT; it += NGW) {
        TItem tn = tc; const bool more = (it + NGW < NIT);
        if (more) { tn = titem_decode(A, F.ws, it + NGW); titem_load(tn, F.lane, nxt); }
        titem_emit(tc, F.lane, cur, scr);
        if (more) {
#pragma unroll
            for (int i = 0; i < 32; ++i) cur[i] = nxt[i];
            tc = tn; }
    }
}

__device__ __forceinline__ void phase_norm(const Frame& F0, const float* x, const float* gain, bf16* out) {
    const Frame F = fresh(F0);
    const int gw = F.bid * 8 + F.wave, NGW = F.G * 8;
    f32x4 g[4];
#pragma unroll
    for (int j = 0; j < 4; ++j) g[j] = *(const f32x4*)(gain + 4 * F.lane + 256 * j);
    const int RPW = (T + NGW - 1) / NGW, mbase = (xcd_order(F.bid, F.G) * 8 + F.wave) * RPW;
    for (int r0 = 0; r0 < RPW; r0 += 4) {
        f32x4 v[4][4];
#pragma unroll
        for (int q = 0; q < 4; ++q) { const int m = (r0 + q < RPW) ? mbase + r0 + q : T; if (m < T) { const f32x4* xr = (const f32x4*)(x + (size_t)m * DM) + F.lane;
#pragma unroll
                for (int j = 0; j < 4; ++j) v[q][j] = xr[64 * j]; } }
#pragma unroll
        for (int q = 0; q < 4; ++q) { const int m = (r0 + q < RPW) ? mbase + r0 + q : T; if (m < T) { float s = 0.f;
#pragma unroll
                for (int j = 0; j < 4; ++j) s += (v[q][j].x * v[q][j].x + v[q][j].y * v[q][j].y) + (v[q][j].z * v[q][j].z + v[q][j].w * v[q][j].w);
                const float r = rsqrtf(wave_sum(s) * (1.f / DM) + RMS_EPS);
                v2u* o8 = (v2u*)(out + (size_t)m * DM) + F.lane;
#pragma unroll
                for (int j = 0; j < 4; ++j) { v2u w; w.x = pk2(v[q][j].x * r * g[j].x, v[q][j].y * r * g[j].y); w.y = pk2(v[q][j].z * r * g[j].z, v[q][j].w * r * g[j].w); o8[64 * j] = w; } } }
    }
}

__device__ __forceinline__ void phase_qkprep(const Frame& F0, const bf16* proj, const float* qg, const float* kg, bf16* Q, bf16* Kb, float* kmean) {
    const Frame F = fresh(F0);
    float* red = (float*)F.lds;
    float* red2 = red + 256 * 65;
    const int tok = F.tid >> 1, hf = F.tid & 1;
    float qgv[32], kgv[32];
#pragma unroll
    for (int i = 0; i < 8; ++i) { const f32x4 a = *(const f32x4*)(qg + hf * 32 + 4 * i), c = *(const f32x4*)(kg + hf * 32 + 4 * i);
        qgv[4 * i] = a.x; qgv[4 * i + 1] = a.y; qgv[4 * i + 2] = a.z; qgv[4 * i + 3] = a.w; kgv[4 * i] = c.x; kgv[4 * i + 1] = c.y; kgv[4 * i + 2] = c.z; kgv[4 * i + 3] = c.w; }
    for (int u = xcd_order(F.bid, F.G); u < 512; u += F.G) {
        const int b = u >> 6, blk = (u >> 3) & 7, h = u & 7;
        const size_t row = (size_t)b * SEQ + blk * 256 + tok;
        const bf16* pq = proj + row * NCOL + C_AQ + h * 64 + hf * 32;
        const bf16* pk = proj + row * NCOL + C_AK + h * 64 + hf * 32;
        float qv[32], kv[32];
#pragma unroll
        for (int i = 0; i < 4; ++i) { const v4u a = *(const v4u*)(pq + 8 * i), c = *(const v4u*)(pk + 8 * i);
            qv[8 * i + 0] = bflo(a.x); qv[8 * i + 1] = bfhi(a.x); qv[8 * i + 2] = bflo(a.y); qv[8 * i + 3] = bfhi(a.y); qv[8 * i + 4] = bflo(a.z); qv[8 * i + 5] = bfhi(a.z); qv[8 * i + 6] = bflo(a.w); qv[8 * i + 7] = bfhi(a.w);
            kv[8 * i + 0] = bflo(c.x); kv[8 * i + 1] = bfhi(c.x); kv[8 * i + 2] = bflo(c.y); kv[8 * i + 3] = bfhi(c.y); kv[8 * i + 4] = bflo(c.z); kv[8 * i + 5] = bfhi(c.z); kv[8 * i + 6] = bflo(c.w); kv[8 * i + 7] = bfhi(c.w); }
        float sq = 0.f, sk = 0.f;
#pragma unroll
        for (int i = 0; i < 32; ++i) { sq += qv[i] * qv[i]; sk += kv[i] * kv[i]; }
        sq += __shfl_xor(sq, 1); sk += __shfl_xor(sk, 1);
        const float rq = rsqrtf(sq * (1.f / 64.f) + RMS_EPS) * QSCALE, rk = rsqrtf(sk * (1.f / 64.f) + RMS_EPS);
#pragma unroll
        for (int i = 0; i < 32; ++i) { qv[i] = qv[i] * rq * qgv[i]; kv[i] = kv[i] * rk * kgv[i]; }
        bf16* oq = Q + row * 512 + h * 64 + hf * 32; bf16* ok = Kb + row * 512 + h * 64 + hf * 32;
#pragma unroll
        for (int i = 0; i < 4; ++i) { v4u a, c;
            a.x = pk2(qv[8 * i], qv[8 * i + 1]); a.y = pk2(qv[8 * i + 2], qv[8 * i + 3]); a.z = pk2(qv[8 * i + 4], qv[8 * i + 5]); a.w = pk2(qv[8 * i + 6], qv[8 * i + 7]);
            c.x = pk2(kv[8 * i], kv[8 * i + 1]); c.y = pk2(kv[8 * i + 2], kv[8 * i + 3]); c.z = pk2(kv[8 * i + 4], kv[8 * i + 5]); c.w = pk2(kv[8 * i + 6], kv[8 * i + 7]);
            *(v4u*)(oq + 8 * i) = a; *(v4u*)(ok + 8 * i) = c; }
        __syncthreads();
#pragma unroll
        for (int i = 0; i < 32; ++i) red[tok * 65 + hf * 32 + i] = kv[i];
        __syncthreads();
        { const int d = F.tid & 63, part = F.tid >> 6; float s = 0.f;
            for (int tk = 0; tk < 32; ++tk) s += red[(part * 32 + tk) * 65 + d];
            red2[part * 64 + d] = s; }
        __syncthreads();
        if (F.tid < 64) { float s = 0.f;
#pragma unroll
            for (int p = 0; p < 8; ++p) s += red2[p * 64 + F.tid];
            kmean[(((size_t)b * 8 + h) * 8 + blk) * 64 + F.tid] = s * (1.f / 256.f); }
    }
    __syncthreads();
}

__device__ __forceinline__ void phase_conv(const Frame& F0, const bf16* proj, const float* cw, const float* cb, const float* lng, const float* lnb, bf16* cat) {
    const Frame F = fresh(F0);
    float* ut = (float*)F.lds;
    const int c = F.tid;
    float w[31];
#pragma unroll
    for (int j = 0; j < 31; ++j) w[j] = cw[j * 512 + c];
    const float bias = cb[c];
    const f32x4 g0 = *(const f32x4*)(lng + 8 * F.lane), g1 = *(const f32x4*)(lng + 8 * F.lane + 4), b0 = *(const f32x4*)(lnb + 8 * F.lane), b1 = *(const f32x4*)(lnb + 8 * F.lane + 4);
    for (int u = xcd_order(F.bid, F.G); u < 512; u += F.G) {
        const int b = u >> 6, t0 = (u & 63) * 32;
        __syncthreads();
        {
            v4u av[8], gv[8];
#pragma unroll
            for (int i = 0; i < 8; ++i) { const int idx = F.tid + 512 * i, r = idx >> 6, ch = (idx & 63) * 8, t = t0 - 30 + r;
                if (r < 62 && t >= 0) { const bf16* p = proj + ((size_t)b * SEQ + t) * NCOL + ch; av[i] = *(const v4u*)(p + C_CA); gv[i] = *(const v4u*)(p + C_CB); }
                else { av[i] = (v4u){0u, 0u, 0u, 0u}; gv[i] = (v4u){0u, 0u, 0u, 0u}; } }
#pragma unroll
            for (int i = 0; i < 8; ++i) { const int idx = F.tid + 512 * i, r = idx >> 6, ch = (idx & 63) * 8;
                if (r < 62) {
                    f32x4 u0, u1;
                    u0.x = bflo(av[i].x) * sigmoidf_(bflo(gv[i].x)); u0.y = bfhi(av[i].x) * sigmoidf_(bfhi(gv[i].x)); u0.z = bflo(av[i].y) * sigmoidf_(bflo(gv[i].y)); u0.w = bfhi(av[i].y) * sigmoidf_(bfhi(gv[i].y));
                    u1.x = bflo(av[i].z) * sigmoidf_(bflo(gv[i].z)); u1.y = bfhi(av[i].z) * sigmoidf_(bfhi(gv[i].z)); u1.z = bflo(av[i].w) * sigmoidf_(bflo(gv[i].w)); u1.w = bfhi(av[i].w) * sigmoidf_(bfhi(gv[i].w));
                    *(f32x4*)(ut + r * 512 + ch) = u0; *(f32x4*)(ut + r * 512 + ch + 4) = u1; } }
        }
        __syncthreads();
        float uu[62];
#pragma unroll
        for (int i = 0; i < 62; ++i) uu[i] = ut[i * 512 + c];
#pragma unroll
        for (int t = 0; t < 32; ++t) { float a = bias;
#pragma unroll
            for (int j = 0; j < 31; ++j) a += w[j] * uu[t + j];
            ut[t * 512 + c] = a; }
        __syncthreads();
#pragma unroll
        for (int q = 0; q < 4; ++q) { const int t = F.wave * 4 + q;
            const f32x4 v0 = *(const f32x4*)(ut + t * 512 + 8 * F.lane), v1 = *(const f32x4*)(ut + t * 512 + 8 * F.lane + 4);
            const float mu = wave_sum((v0.x + v0.y) + (v0.z + v0.w) + (v1.x + v1.y) + (v1.z + v1.w)) * (1.f / 512.f);
            const f32x4 d0 = v0 - mu, d1 = v1 - mu;
            const float var = wave_sum((d0.x * d0.x + d0.y * d0.y) + (d0.z * d0.z + d0.w * d0.w) + (d1.x * d1.x + d1.y * d1.y) + (d1.z * d1.z + d1.w * d1.w)) * (1.f / 512.f);
            const float rs = rsqrtf(var + LN_EPS);
            f32x4 y0 = d0 * rs * g0 + b0, y1 = d1 * rs * g1 + b1;
            y0.x *= sigmoidf_(y0.x); y0.y *= sigmoidf_(y0.y); y0.z *= sigmoidf_(y0.z); y0.w *= sigmoidf_(y0.w);
            y1.x *= sigmoidf_(y1.x); y1.y *= sigmoidf_(y1.y); y1.z *= sigmoidf_(y1.z); y1.w *= sigmoidf_(y1.w);
            v4u o; o.x = pk2(y0.x, y0.y); o.y = pk2(y0.z, y0.w); o.z = pk2(y1.x, y1.y); o.w = pk2(y1.z, y1.w);
            *(v4u*)(cat + ((size_t)b * SEQ + t0 + t) * 1536 + 1024 + 8 * F.lane) = o; }
    }
    __syncthreads();
}

typedef float f32x16 __attribute__((ext_vector_type(16)));
typedef short bf16x8 __attribute__((ext_vector_type(8)));
typedef short v4i16_t __attribute__((ext_vector_type(4)));
constexpr int AT_KROW = 144, AT_VROW = 192, AT_KBUF = 64 * AT_KROW, AT_VBUF = 64 * AT_VROW, AT_BUF = AT_KBUF + AT_VBUF;
constexpr int AT_WSF = 2 * AT_BUF, AT_STG = AT_WSF + 8 * 256, AT_LDS = AT_STG + 8 * 4096;
__device__ __forceinline__ int crow16(int r, int hi) { return (r & 3) + 8 * (r >> 2) + 4 * hi; }
__device__ __forceinline__ void attn_mfma_unit(const Frame& F, LAS unsigned char* L, int b, int h, int qb, const bf16* Q, const bf16* Kb, const bf16* proj, const float* kmean, bf16* cat) {
    int lane_ = F.lane; asm volatile("" : "+v"(lane_));
    const int lane = lane_, r32 = lane & 31, hi = lane >> 5, wid = F.wave;
    const size_t row0 = (size_t)b * SEQ + qb * 256;
    const int qi = wid * 32 + r32;
    bf16x8 qf[4];
    { const bf16* pq = Q + (row0 + qi) * 512 + h * 64 + hi * 8;
#pragma unroll
        for (int d0 = 0; d0 < 4; ++d0) qf[d0] = *(const bf16x8*)(pq + d0 * 16); }
    unsigned selmask;
    if (qb <= 3) selmask = (1u << qb) - 1u;
    else {
        float b0 = -3.0e38f, b1 = -3.0e38f, b2 = -3.0e38f; int i0 = 0, i1 = 0, i2 = 0;
        float qv[32];
#pragma unroll
        for (int d0 = 0; d0 < 4; ++d0)
#pragma unroll
            for (int e = 0; e < 8; ++e) qv[d0 * 8 + e] = bf2f((bf16)qf[d0][e]);
#pragma unroll 1
        for (int j = 0; j < qb; ++j) { const float* km = kmean + (((size_t)b * 8 + h) * 8 + j) * 64 + hi * 8; float sacc = 0.f;
#pragma unroll
            for (int d0 = 0; d0 < 4; ++d0) { const f32x4 k0 = *(const f32x4*)(km + d0 * 16), k1 = *(const f32x4*)(km + d0 * 16 + 4);
                sacc += qv[d0 * 8 + 0] * k0.x + qv[d0 * 8 + 1] * k0.y + qv[d0 * 8 + 2] * k0.z + qv[d0 * 8 + 3] * k0.w + qv[d0 * 8 + 4] * k1.x + qv[d0 * 8 + 5] * k1.y + qv[d0 * 8 + 6] * k1.z + qv[d0 * 8 + 7] * k1.w; }
            sacc += __shfl_xor(sacc, 32);
            if (sacc > b0) { b2 = b1; i2 = i1; b1 = b0; i1 = i0; b0 = sacc; i0 = j; }
            else if (sacc > b1) { b2 = b1; i2 = i1; b1 = sacc; i1 = j; }
            else if (sacc > b2) { b2 = sacc; i2 = j; } }
        selmask = (1u << i0) | (1u << i1) | (1u << i2);
    }
    const int tid_l = wid * 64 + lane, srow = tid_l >> 3, sch = tid_l & 7;
    const bf16* kg = Kb + ((size_t)b * SEQ + srow) * 512 + h * 64 + sch * 8;
    const bf16* vg = proj + ((size_t)b * SEQ + srow) * NCOL + C_AV + h * 64 + sch * 8;
    const int kst = srow * AT_KROW + sch * 16, vst = AT_KBUF + srow * AT_VROW + sch * 16;
    const int kfo = r32 * AT_KROW + hi * 16;
    const int g16 = lane >> 4, idx = lane & 15;
    const int vfo = AT_KBUF + (4 * (g16 >> 1) + (idx >> 2)) * AT_VROW + ((g16 & 1) * 16 + 4 * (idx & 3)) * 2;
    const int NT = 4 * (qb + 1);
    f32x16 o0 = {}, o1 = {};
    float lsum = 0.f;
    v4u kA = {}, vA = {}, kB, vB;
    { const v4u kk = *(const v4u*)kg, vv = *(const v4u*)vg;
        kB = *(const v4u*)(kg + (size_t)64 * 512); vB = *(const v4u*)(vg + (size_t)64 * NCOL);
        *(LAS v4u*)(L + kst) = kk; *(LAS v4u*)(L + vst) = vv; }
    lds_barrier();
#define AT_TILE(OWN, TT, PAR, KL, VL, KW, VW) do { \
        const int t_ = (TT); constexpr int cb = (PAR) * AT_BUF, nb = AT_BUF - cb;        \
        if (t_ + 2 < NT) { KL = *(const v4u*)(kg + (size_t)(t_ + 2) * 64 * 512); VL = *(const v4u*)(vg + (size_t)(t_ + 2) * 64 * NCOL); } \
        const int j = t_ >> 2, kt = t_ & 3; \
        const bool active = !(OWN) || (kt * 64 <= wid * 32 + 31); \
        if (active) { \
            f32x16 s0, s1; \
            { const float bias = ((OWN) || (((selmask >> j) & 1u) != 0u)) ? 0.f : -1.0e30f; \
                _Pragma("unroll") for (int r = 0; r < 16; ++r) { s0[r] = bias; s1[r] = bias; } } \
            bf16x8 kf[8]; \
            _Pragma("unroll") for (int d0 = 0; d0 < 4; ++d0) { kf[d0] = *(const LAS bf16x8*)(L + cb + kfo + d0 * 32); kf[4 + d0] = *(const LAS bf16x8*)(L + cb + kfo + 32 * AT_KROW + d0 * 32); } \
            _Pragma("unroll") for (int d0 = 0; d0 < 4; ++d0) { \
                s0 = __builtin_amdgcn_mfma_f32_32x32x16_bf16(kf[d0], qf[d0], s0, 0, 0, 0); \
                s1 = __builtin_amdgcn_mfma_f32_32x32x16_bf16(kf[4 + d0], qf[d0], s1, 0, 0, 0); } \
            v4i16_t va[16]; \
            _Pragma("unroll") for (int sub = 0; sub < 2; ++sub) \
                _Pragma("unroll") for (int sI = 0; sI < 2; ++sI) { const int vb = cb + vfo + (sub * 32 + 16 * sI) * AT_VROW, q4 = (sub * 2 + sI) * 4; \
                    va[q4 + 0] = __builtin_amdgcn_ds_read_tr16_b64_v4i16((LAS v4i16_t*)(L + vb)); va[q4 + 1] = __builtin_amdgcn_ds_read_tr16_b64_v4i16((LAS v4i16_t*)(L + vb + 8 * AT_VROW)); \
                    va[q4 + 2] = __builtin_amdgcn_ds_read_tr16_b64_v4i16((LAS v4i16_t*)(L + vb + 64)); va[q4 + 3] = __builtin_amdgcn_ds_read_tr16_b64_v4i16((LAS v4i16_t*)(L + vb + 8 * AT_VROW + 64)); } \
            __builtin_amdgcn_sched_barrier(0); \
            float ps = 0.f; \
            if (OWN) { const int lim = qi - kt * 64; \
                _Pragma("unroll") for (int r = 0; r < 16; ++r) { const int kv = crow16(r, hi); \
                    const float p0 = (kv <= lim) ? __builtin_amdgcn_exp2f(s0[r]) : 0.f, p1 = (kv + 32 <= lim) ? __builtin_amdgcn_exp2f(s1[r]) : 0.f; \
                    s0[r] = p0; s1[r] = p1; ps += p0 + p1; } \
            } else { \
                _Pragma("unroll") for (int r = 0; r < 16; ++r) { const float p0 = __builtin_amdgcn_exp2f(s0[r]), p1 = __builtin_amdgcn_exp2f(s1[r]); s0[r] = p0; s1[r] = p1; ps += p0 + p1; } } \
            lsum += ps; \
            bf16x8 pa[4]; \
            _Pragma("unroll") for (int sI = 0; sI < 2; ++sI) { v4u w0, w1; \
                w0.x = pg8::cvt_pk_bf16(s0[8 * sI + 0], s0[8 * sI + 1]); w0.y = pg8::cvt_pk_bf16(s0[8 * sI + 2], s0[8 * sI + 3]); w0.z = pg8::cvt_pk_bf16(s0[8 * sI + 4], s0[8 * sI + 5]); w0.w = pg8::cvt_pk_bf16(s0[8 * sI + 6], s0[8 * sI + 7]); \
                w1.x = pg8::cvt_pk_bf16(s1[8 * sI + 0], s1[8 * sI + 1]); w1.y = pg8::cvt_pk_bf16(s1[8 * sI + 2], s1[8 * sI + 3]); w1.z = pg8::cvt_pk_bf16(s1[8 * sI + 4], s1[8 * sI + 5]); w1.w = pg8::cvt_pk_bf16(s1[8 * sI + 6], s1[8 * sI + 7]); \
                pa[sI] = __builtin_bit_cast(bf16x8, w0); pa[2 + sI] = __builtin_bit_cast(bf16x8, w1); } \
            _Pragma("unroll") for (int q = 0; q < 4; ++q) { \
                const bf16x8 v0 = (bf16x8){va[4 * q][0], va[4 * q][1], va[4 * q][2], va[4 * q][3], va[4 * q + 1][0], va[4 * q + 1][1], va[4 * q + 1][2], va[4 * q + 1][3]}; \
                const bf16x8 v1 = (bf16x8){va[4 * q + 2][0], va[4 * q + 2][1], va[4 * q + 2][2], va[4 * q + 2][3], va[4 * q + 3][0], va[4 * q + 3][1], va[4 * q + 3][2], va[4 * q + 3][3]}; \
                o0 = __builtin_amdgcn_mfma_f32_32x32x16_bf16(pa[q], v0, o0, 0, 0, 0); \
                o1 = __builtin_amdgcn_mfma_f32_32x32x16_bf16(pa[q], v1, o1, 0, 0, 0); } \
        } \
        if (t_ + 1 < NT) { *(LAS v4u*)(L + nb + kst) = KW; *(LAS v4u*)(L + nb + vst) = VW; } \
        lds_barrier(); \
    } while (0)
    int t = 0;
#pragma unroll 1
    for (; t < NT - 4; t += 2) { AT_TILE(false, t, 0, kA, vA, kB, vB); AT_TILE(false, t + 1, 1, kB, vB, kA, vA); }
#pragma unroll 1
    for (; t < NT; t += 2) { AT_TILE(true, t, 0, kA, vA, kB, vB); AT_TILE(true, t + 1, 1, kB, vB, kA, vA); }
#undef AT_TILE
    lsum += __shfl_xor(lsum, 32);
    LAS float* wsf = (LAS float*)(L + AT_WSF + wid * 256);
    if (hi == 0) wsf[r32] = lsum;
    asm volatile("s_waitcnt lgkmcnt(0)" ::: "memory");
    LAS bf16* stg = (LAS bf16*)(L + AT_STG + wid * 4096);
#pragma unroll
    for (int r = 0; r < 16; ++r) { const int orow = crow16(r, hi); const float rl = 1.f / wsf[orow];
        stg[orow * 64 + r32] = (bf16)f2bf(o0[r] * rl); stg[orow * 64 + 32 + r32] = (bf16)f2bf(o1[r] * rl); }
    asm volatile("s_waitcnt lgkmcnt(0)" ::: "memory");
    bf16* po = cat + (row0 + wid * 32) * 1536 + h * 64;
#pragma unroll
    for (int i = 0; i < 4; ++i) { const int row = i * 8 + (lane >> 3), ch = lane & 7; const v4u v = *(const LAS v4u*)(stg + row * 64 + ch * 8); *(v4u*)(po + (size_t)row * 1536 + ch * 8) = v; }
    lds_barrier();
}
__device__ __forceinline__ void phase_attn_mfma(const Frame& F0, const bf16* Q, const bf16* Kb, const bf16* proj, const float* kmean, bf16* cat) {
    const Frame F = fresh(F0);
    LAS unsigned char* L = (LAS unsigned char*)F.lds;
    for (int p = xcd_order(F.bid, F.G); p < 256; p += F.G) {
        const int bh = p >> 2, s = p & 3;
#pragma unroll 1
        for (int i = 0; i < 2; ++i) attn_mfma_unit(F, L, bh >> 3, bh & 7, i ? s : 7 - s, Q, Kb, proj, kmean, cat);
    }
}

template <bool PERM> __device__ __forceinline__ bf16x8 tr_frag(LAS unsigned char* tile, int pitch, int rbase, int cbase, int lane) {
    const int g16 = lane >> 4, idx = lane & 15, h = g16 >> 1;
    LAS unsigned char* p = tile + (rbase + (PERM ? 4 : 8) * h + (idx >> 2)) * pitch + (cbase + (g16 & 1) * 16 + 4 * (idx & 3)) * 2;
    const v4i16_t a0 = __builtin_amdgcn_ds_read_tr16_b64_v4i16((LAS v4i16_t*)p), a1 = __builtin_amdgcn_ds_read_tr16_b64_v4i16((LAS v4i16_t*)(p + (PERM ? 8 : 4) * pitch));
    return (bf16x8){a0[0], a0[1], a0[2], a0[3], a1[0], a1[1], a1[2], a1[3]};
}
constexpr int H1_G = 0, H1_QD = 32768, H1_KD = H1_QD + 64 * 272, H1_KE = H1_KD + 64 * 272, H1_VT = H1_KE + 64 * 320, H1_SP = H1_VT + 64 * 320, H1_TOT = H1_SP + 128 * 320, H1_BO = H1_TOT + 2048, H1_LB = H1_BO + 512, H1_CK = H1_LB + 512, H1_END = H1_CK + 2048;
static_assert(H1_END <= LDS_SCRATCH, "hgrn pass 1 lds");
__device__ __forceinline__ void hgrn_pass1_unit(const Frame& F, LAS unsigned char* L, int u, const bf16* proj, const float* lbl, int layer, float* Lg, float* Dg, float* OL, bf16* Qb) {
    const int b = u >> 5, h = (u >> 3) & 3, blk = u & 7;
    const int lane = F.lane, r32 = lane & 31, hi = lane >> 5, wid = F.wave, tid = F.tid;
    const int tt = tid >> 3, cg = tid & 7, ch = cg * 16;
    LAS float* G = (LAS float*)(L + H1_G); LAS float* TOT = (LAS float*)(L + H1_TOT);
    LAS float* BO = (LAS float*)(L + H1_BO); LAS float* LB = (LAS float*)(L + H1_LB); LAS float* CK = (LAS float*)(L + H1_CK);
    if (tid < 128) { float lb = 0.f;
        if (layer > 0) { const float l0 = lbl[h * 128 + tid], l1 = lbl[512 + h * 128 + tid]; lb = 1.f / (1.f + __expf(l0 - l1)); }
        LB[tid] = lb; BO[tid] = 0.f; }
    lds_barrier();
    f32x16 S[2]; S[0] = (f32x16){}; S[1] = (f32x16){};
    const size_t rowb = (size_t)b * SEQ + blk * 256;
    const int tt2 = wid >> 2, vt = wid & 3;
    v4u nx[6];
    { const bf16* pr = proj + (rowb + tt) * NCOL + h * 128 + ch;
        nx[0] = *(const v4u*)(pr + C_HF); nx[1] = *(const v4u*)(pr + C_HF + 8); nx[2] = *(const v4u*)(pr + C_HQ); nx[3] = *(const v4u*)(pr + C_HQ + 8); nx[4] = *(const v4u*)(pr + C_HI); nx[5] = *(const v4u*)(pr + C_HI + 8); }
    for (int c = 0; c < 4; ++c) {
        const size_t row = rowb + c * 64 + tt;
        float kk[16], qa[16];
        {
            const v4u f0 = nx[0], f1 = nx[1], q0 = nx[2], q1 = nx[3], v0 = nx[4], v1 = nx[5];
            if (c < 3) { const bf16* pr = proj + (row + 64) * NCOL + h * 128 + ch;
                nx[0] = *(const v4u*)(pr + C_HF); nx[1] = *(const v4u*)(pr + C_HF + 8); nx[2] = *(const v4u*)(pr + C_HQ); nx[3] = *(const v4u*)(pr + C_HQ + 8); nx[4] = *(const v4u*)(pr + C_HI); nx[5] = *(const v4u*)(pr + C_HI + 8); }
            const unsigned fw[8] = {f0.x, f0.y, f0.z, f0.w, f1.x, f1.y, f1.z, f1.w}, qw[8] = {q0.x, q0.y, q0.z, q0.w, q1.x, q1.y, q1.z, q1.w};
            float gl[16], lbv[16];
#pragma unroll
            for (int i = 0; i < 4; ++i) { const f32x4 x = *(const LAS f32x4*)(LB + ch + 4 * i); lbv[4 * i] = x.x; lbv[4 * i + 1] = x.y; lbv[4 * i + 2] = x.z; lbv[4 * i + 3] = x.w; }
#pragma unroll
            for (int i = 0; i < 16; ++i) { const float fr = (i & 1) ? bfhi(fw[i >> 1]) : bflo(fw[i >> 1]); const float sig = sigmoidf_(fr);
                gl[i] = __logf(lbv[i] + (1.f - lbv[i]) * sig); kk[i] = (1.f - lbv[i]) * (1.f - sig);
                const float qv = (i & 1) ? bfhi(qw[i >> 1]) : bflo(qw[i >> 1]); qa[i] = qv * sigmoidf_(qv); }
#pragma unroll
            for (int i = 0; i < 4; ++i) *(LAS f32x4*)(G + tt * 128 + ch + 4 * i) = (f32x4){gl[4 * i], gl[4 * i + 1], gl[4 * i + 2], gl[4 * i + 3]};
            *(LAS v4u*)(L + H1_VT + tt * 320 + ch * 2) = v0; *(LAS v4u*)(L + H1_VT + tt * 320 + ch * 2 + 16) = v1;
        }
        lds_barrier();
        {
            const int k = tid & 127, part = tid >> 7; float a[16];
#pragma unroll
            for (int i = 0; i < 16; ++i) a[i] = G[(part * 16 + i) * 128 + k];
#pragma unroll
            for (int i = 1; i < 16; ++i) a[i] += a[i - 1];
            TOT[part * 128 + k] = a[15];
            lds_barrier();
            float pre = 0.f;
#pragma unroll
            for (int p = 0; p < 3; ++p) if (p < part) pre += TOT[p * 128 + k];
#pragma unroll
            for (int i = 0; i < 16; ++i) G[(part * 16 + i) * 128 + k] = a[i] + pre;
            if (part == 3) {
                const float bmk = TOT[k] + TOT[128 + k], bek = pre + a[15];
                CK[k] = __expf(bmk); CK[128 + k] = __expf(bek); CK[256 + k] = __expf(bek - bmk); CK[384 + k] = __expf(BO[k] + bmk); }
        }
        lds_barrier();
        {
#pragma unroll
            for (int hh = 0; hh < 2; ++hh) {
                float bb[8], bm[8], cem[8], com[8];
#pragma unroll
                for (int i = 0; i < 2; ++i) { const f32x4 x = *(const LAS f32x4*)(G + tt * 128 + ch + 8 * hh + 4 * i), y = *(const LAS f32x4*)(G + 31 * 128 + ch + 8 * hh + 4 * i), z = *(const LAS f32x4*)(CK + 256 + ch + 8 * hh + 4 * i), o4 = *(const LAS f32x4*)(CK + 384 + ch + 8 * hh + 4 * i);
                    bb[4 * i] = x.x; bb[4 * i + 1] = x.y; bb[4 * i + 2] = x.z; bb[4 * i + 3] = x.w; bm[4 * i] = y.x; bm[4 * i + 1] = y.y; bm[4 * i + 2] = y.z; bm[4 * i + 3] = y.w;
                    cem[4 * i] = z.x; cem[4 * i + 1] = z.y; cem[4 * i + 2] = z.z; cem[4 * i + 3] = z.w; com[4 * i] = o4.x; com[4 * i + 1] = o4.y; com[4 * i + 2] = o4.z; com[4 * i + 3] = o4.w; }
                float ex[8], rex[8], t8[8]; v4u w;
#pragma unroll
                for (int i = 0; i < 8; ++i) { ex[i] = __expf(bb[i] - bm[i]); rex[i] = __builtin_amdgcn_rcpf(ex[i]); }
#pragma unroll
                for (int i = 0; i < 8; ++i) t8[i] = kk[8 * hh + i] * rex[i] * cem[i];
                w.x = pk2(t8[0], t8[1]); w.y = pk2(t8[2], t8[3]); w.z = pk2(t8[4], t8[5]); w.w = pk2(t8[6], t8[7]); *(LAS v4u*)(L + H1_KE + tt * 320 + ch * 2 + 16 * hh) = w;
#pragma unroll
                for (int i = 0; i < 8; ++i) t8[i] = qa[8 * hh + i] * ex[i];
                w.x = pk2(t8[0], t8[1]); w.y = pk2(t8[2], t8[3]); w.z = pk2(t8[4], t8[5]); w.w = pk2(t8[6], t8[7]); *(LAS v4u*)(L + H1_QD + tt * 272 + ch * 2 + 16 * hh) = w;
#pragma unroll
                for (int i = 0; i < 8; ++i) t8[i] = kk[8 * hh + i] * rex[i];
                w.x = pk2(t8[0], t8[1]); w.y = pk2(t8[2], t8[3]); w.z = pk2(t8[4], t8[5]); w.w = pk2(t8[6], t8[7]); *(LAS v4u*)(L + H1_KD + tt * 272 + ch * 2 + 16 * hh) = w;
#pragma unroll
                for (int i = 0; i < 8; ++i) t8[i] = qa[8 * hh + i] * ex[i] * com[i];
                w.x = pk2(t8[0], t8[1]); w.y = pk2(t8[2], t8[3]); w.z = pk2(t8[4], t8[5]); w.w = pk2(t8[6], t8[7]); *(v4u*)(Qb + row * 512 + h * 128 + ch + 8 * hh) = w;
                __builtin_amdgcn_sched_barrier(0);
            }
#pragma unroll
            for (int i = 0; i < 2; ++i) { const int id = 2 * wid + i, kt = id >> 2, v2 = id & 3;
#pragma unroll
                for (int r = 0; r < 16; ++r) { const int k = kt * 32 + crow16(r, hi); *(LAS bf16*)(L + H1_SP + k * 320 + (v2 * 32 + r32) * 2) = (bf16)(pk2(S[i][r] * CK[k], 0.f) & 0xffffu); } }
        }
        lds_barrier();
        {
            if (tid < 128) BO[tid] += G[63 * 128 + tid];
            f32x16 o = {};
            bf16x8 qf[8];
#pragma unroll
            for (int k0 = 0; k0 < 8; ++k0) qf[k0] = *(const LAS bf16x8*)(L + H1_QD + (tt2 * 32 + r32) * 272 + (k0 * 16 + 8 * hi) * 2);
#pragma unroll
            for (int k0 = 0; k0 < 8; ++k0) o = __builtin_amdgcn_mfma_f32_32x32x16_bf16(qf[k0], tr_frag<false>(L + H1_SP, 320, k0 * 16, vt * 32, lane), o, 0, 0, 0);
#pragma unroll
            for (int sg = 0; sg < 2; ++sg) if (sg <= tt2) {
                f32x16 sc = {};
#pragma unroll
                for (int k0 = 0; k0 < 8; ++k0) { const bf16x8 kf = *(const LAS bf16x8*)(L + H1_KD + (sg * 32 + r32) * 272 + (k0 * 16 + 8 * hi) * 2); sc = __builtin_amdgcn_mfma_f32_32x32x16_bf16(kf, qf[k0], sc, 0, 0, 0); }
                if (sg == tt2) {
#pragma unroll
                    for (int r = 0; r < 16; ++r) sc[r] = (crow16(r, hi) <= r32) ? sc[r] : 0.f; }
#pragma unroll
                for (int sI = 0; sI < 2; ++sI) { v4u w; w.x = pg8::cvt_pk_bf16(sc[8 * sI + 0], sc[8 * sI + 1]); w.y = pg8::cvt_pk_bf16(sc[8 * sI + 2], sc[8 * sI + 3]); w.z = pg8::cvt_pk_bf16(sc[8 * sI + 4], sc[8 * sI + 5]); w.w = pg8::cvt_pk_bf16(sc[8 * sI + 6], sc[8 * sI + 7]);
                    o = __builtin_amdgcn_mfma_f32_32x32x16_bf16(__builtin_bit_cast(bf16x8, w), tr_frag<true>(L + H1_VT, 320, sg * 32 + 16 * sI, vt * 32, lane), o, 0, 0, 0); }
            }
            float* po = OL + (rowb + c * 64 + tt2 * 32) * 512 + h * 128 + vt * 32 + r32;
#pragma unroll
            for (int r = 0; r < 16; ++r) po[(size_t)crow16(r, hi) * 512] = o[r];
#pragma unroll
            for (int i = 0; i < 2; ++i) { const int id = 2 * wid + i, kt = id >> 2, v2 = id & 3;
#pragma unroll
                for (int r = 0; r < 16; ++r) S[i][r] *= CK[128 + kt * 32 + crow16(r, hi)];
#pragma unroll
                for (int s4 = 0; s4 < 4; ++s4) S[i] = __builtin_amdgcn_mfma_f32_32x32x16_bf16(tr_frag<true>(L + H1_KE, 320, 16 * s4, kt * 32, lane), tr_frag<true>(L + H1_VT, 320, 16 * s4, v2 * 32, lane), S[i], 0, 0, 0); }
        }
        lds_barrier();
    }
#pragma unroll
    for (int i = 0; i < 2; ++i) { const int id = 2 * wid + i, kt = id >> 2, v2 = id & 3;
#pragma unroll
        for (int r = 0; r < 16; ++r) Lg[(size_t)u * 16384 + (kt * 32 + crow16(r, hi)) * 128 + v2 * 32 + r32] = S[i][r]; }
    if (tid < 128) Dg[(size_t)u * 128 + tid] = __expf(BO[tid]);
}
constexpr int H2_SL = 0, H2_OB = 128 * 320, H2_END = H2_OB + 128 * 128 * 4;
__device__ __forceinline__ void hgrn_pass2_unit(const Frame& F, LAS unsigned char* L, int u, const bf16* proj, const float* gnorm, const float* Lg, const float* Dg, const float* OL, const bf16* Qb, bf16* cat, int dry) {
    const int b = u >> 5, h = (u >> 3) & 3, blk = u & 7;
    const int lane = F.lane, r32 = lane & 31, hi = lane >> 5, wid = F.wave, tid = F.tid;
    const size_t rowb = (size_t)b * SEQ + blk * 256;
    LAS float* OB = (LAS float*)(L + H2_OB);
    if (blk > 0 && dry != 1) {
#pragma unroll 1
        for (int jh = 0; jh < 4; ++jh) {
            f32x4 l4[7][2]; float dd[7][2];
#pragma unroll
            for (int pb = 0; pb < 7; ++pb)
#pragma unroll
                for (int j = 0; j < 2; ++j) { const int e4 = tid + 512 * (2 * jh + j), k = e4 >> 5;
                    if (pb < blk) { dd[pb][j] = *(const float*)((const char*)(Dg + (size_t)(u - blk + pb) * 128) + (unsigned)k * 4u); l4[pb][j] = *(const f32x4*)((const char*)(Lg + (size_t)(u - blk + pb) * 16384) + (unsigned)e4 * 16u); }
                    else { dd[pb][j] = 0.f; l4[pb][j] = (f32x4){0.f, 0.f, 0.f, 0.f}; } }
#pragma unroll
            for (int j = 0; j < 2; ++j) { const int e4 = tid + 512 * (2 * jh + j), k = e4 >> 5, v4 = (e4 & 31) * 4; f32x4 S = {0.f, 0.f, 0.f, 0.f};
#pragma unroll
                for (int pb = 0; pb < 7; ++pb) if (pb < blk) S = S * dd[pb][j] + l4[pb][j];
                v2u w; w.x = pk2(S.x, S.y); w.y = pk2(S.z, S.w); *(LAS v2u*)(L + H2_SL + k * 320 + v4 * 2) = w; } } }
    lds_barrier();
    const int ttp = tid >> 2, cq = tid & 3, vt = wid & 3;
    float gn[32];
#pragma unroll
    for (int i = 0; i < 8; ++i) { const f32x4 g = *(const f32x4*)(gnorm + cq * 32 + 4 * i); gn[4 * i] = g.x; gn[4 * i + 1] = g.y; gn[4 * i + 2] = g.z; gn[4 * i + 3] = g.w; }
    for (int hf = 0; hf < 2; ++hf) {
        const size_t rowp = rowb + hf * 128 + ttp;
        v4u hg[4];
#pragma unroll
        for (int i = 0; i < 4; ++i) hg[i] = *(const v4u*)(proj + rowp * NCOL + C_HG + h * 128 + cq * 32 + 8 * i);
#pragma unroll
        for (int j = 0; j < 2; ++j) { const int tl = (wid >> 2) + 2 * j;
            const size_t trow = rowb + hf * 128 + tl * 32;
            f32x16 o = {};
            bf16x8 af[8]; float olv[16];
            const float* pl = OL + trow * 512 + h * 128 + vt * 32 + r32;
            if (blk > 0) {
#pragma unroll
                for (int k0 = 0; k0 < 8; ++k0) af[k0] = *(const bf16x8*)(Qb + (trow + r32) * 512 + h * 128 + k0 * 16 + 8 * hi); }
#pragma unroll
            for (int r = 0; r < 16; ++r) olv[r] = pl[(size_t)crow16(r, hi) * 512];
            __builtin_amdgcn_sched_barrier(0);
            if (blk > 0 && dry != 2) {
#pragma unroll
                for (int k0 = 0; k0 < 8; ++k0) o = __builtin_amdgcn_mfma_f32_32x32x16_bf16(af[k0], tr_frag<false>(L + H2_SL, 320, k0 * 16, vt * 32, lane), o, 0, 0, 0); }
#pragma unroll
            for (int r = 0; r < 16; ++r) { const int t = crow16(r, hi); OB[(tl * 32 + t) * 128 + vt * 32 + r32] = o[r] + olv[r]; } }
        lds_barrier();
        {
            float ov[32]; float ss = 0.f;
#pragma unroll
            for (int i = 0; i < 8; ++i) { const f32x4 x = *(const LAS f32x4*)(OB + ttp * 128 + cq * 32 + 4 * i); ov[4 * i] = x.x; ov[4 * i + 1] = x.y; ov[4 * i + 2] = x.z; ov[4 * i + 3] = x.w; ss += (x.x * x.x + x.y * x.y) + (x.z * x.z + x.w * x.w); }
            ss += __shfl_xor(ss, 1); ss += __shfl_xor(ss, 2);
            const float rn = rsqrtf(ss * (1.f / 128.f) + RMS_EPS);
#pragma unroll
            for (int i = 0; i < 4; ++i) { const unsigned gw[4] = {hg[i].x, hg[i].y, hg[i].z, hg[i].w}; float y[8];
#pragma unroll
                for (int e = 0; e < 8; ++e) { const float gv = (e & 1) ? bfhi(gw[e >> 1]) : bflo(gw[e >> 1]); y[e] = ov[8 * i + e] * rn * gn[8 * i + e] * (gv * sigmoidf_(gv)); }
                v4u w; w.x = pk2(y[0], y[1]); w.y = pk2(y[2], y[3]); w.z = pk2(y[4], y[5]); w.w = pk2(y[6], y[7]);
                *(v4u*)(cat + rowp * 1536 + 512 + h * 128 + cq * 32 + 8 * i) = w; }
        }
        lds_barrier();
    }
}
__device__ __forceinline__ void phase_hgrn1(const Frame& F0, const bf16* proj, const float* lbl, int layer, float* Lg, float* Dg, float* OL, bf16* Qb) {
    const Frame F = fresh(F0);
    LAS unsigned char* L = (LAS unsigned char*)F.lds;
    for (int u = xcd_order(F.bid, F.G); u < 256; u += F.G) { hgrn_pass1_unit(F, L, u, proj, lbl, layer, Lg, Dg, OL, Qb); __syncthreads(); }
}
__device__ __forceinline__ void phase_hgrn2(const Frame& F0, const bf16* proj, const float* gnorm, const float* Lg, const float* Dg, const float* OL, const bf16* Qb, bf16* cat, int dry) {
    const Frame F = fresh(F0);
    LAS unsigned char* L = (LAS unsigned char*)F.lds;
    for (int u = xcd_order(F.bid, F.G); u < 256; u += F.G) { hgrn_pass2_unit(F, L, u, proj, gnorm, Lg, Dg, OL, Qb, cat, dry); __syncthreads(); }
}

struct SchedDense {
    const char* A; const char* B; int nM, nN, G, c; size_t ta, tb;
    __device__ __forceinline__ bool next(int i, pg8::Unit& u) const {
        int pm, pn; if (!pg8::static_tile(nM, nN, (long)i * G + c, pm, pn)) return false;
        u.pm = pm; u.pn = pn; u.aux = 0; u.pad = 0; u.a = A + (size_t)pm * ta; u.b = B + (size_t)pn * tb; return true; }
};
struct SchedBranch {
    const char* A; const char* B; int G, c;
    __device__ __forceinline__ bool next(int i, pg8::Unit& u) const {
        int pm, pn; if (!pg8::static_tile(T / 256, DM / 256, (long)(i / 3) * G + c, pm, pn)) return false;
        const int seg = i % 3;
        u.pm = pm; u.pn = pn; u.aux = seg; u.pad = 0; u.a = A + ((size_t)pm * 256 * 1536 + seg * 512) * 2; u.b = B + ((size_t)seg * DM * 512 + (size_t)pn * 256 * 512) * 2; return true; }
};
struct SchedMoe {
    const char* A; const char* B; const unsigned* ntp; const unsigned* tile_e; int G, c; size_t ta, tb_e, tb_n;
    __device__ __forceinline__ bool next(int i, pg8::Unit& u) const {
        const int nt = (int)__builtin_amdgcn_readfirstlane(*ntp);
        const int cx = (G % 8 == 0) ? (c % 8) * (G / 8) + c / 8 : c;
        const long L = (long)i * G + cx; if (L >= (long)nt * 4) return false;
        const int tile = (int)(L >> 2), pn = (int)(L & 3); const int e = (int)__builtin_amdgcn_readfirstlane(tile_e[tile]);
        u.pm = tile; u.pn = pn; u.aux = e; u.pad = 0; u.a = A + (size_t)tile * ta; u.b = B + (size_t)e * tb_e + (size_t)pn * tb_n; return true; }
};

typedef pg8::f32x4 af4;
struct EpiStoreBf16 {
    static constexpr bool PERM = true;
    bf16* O; int ldc; int gate_col0; const float* bgate; v4u* GT;
    __device__ __forceinline__ bool operator()(af4 (&acc)[2][2][4][2], const pg8::Unit& u, int wr, int wc, int fr, int fq) const {
        const int row0 = u.pm * 256 + wr * 64 + fr, col0 = u.pn * 256 + wc * 32 + 8 * fq;
        const bool gate = (u.pn * 256 >= gate_col0);
#pragma unroll
        for (int bj = 0; bj < 2; ++bj) {
            af4 b0 = {0.f, 0.f, 0.f, 0.f}, b1 = {0.f, 0.f, 0.f, 0.f};
            if (gate) { b0 = *(const af4*)(bgate + col0 + bj * 128 - gate_col0); b1 = *(const af4*)(bgate + col0 + bj * 128 - gate_col0 + 4); }
#pragma unroll
            for (int ai = 0; ai < 2; ++ai)
#pragma unroll
                for (int m = 0; m < 4; ++m) { af4 v0 = acc[ai][bj][m][0], v1 = acc[ai][bj][m][1];
                    if (gate) {
#pragma unroll
                        for (int i = 0; i < 4; ++i) { v0[i] = __builtin_amdgcn_rcpf(1.f + __expf(-fminf(fmaxf(v0[i] + b0[i], -30.f), 30.f))); v1[i] = __builtin_amdgcn_rcpf(1.f + __expf(-fminf(fmaxf(v1[i] + b1[i], -30.f), 30.f))); } }
                    v4u w; w.x = pg8::cvt_pk_bf16(v0[0], v0[1]); w.y = pg8::cvt_pk_bf16(v0[2], v0[3]); w.z = pg8::cvt_pk_bf16(v1[0], v1[1]); w.w = pg8::cvt_pk_bf16(v1[2], v1[3]);
                    if (gate) { const int gt = u.pn - gate_col0 / 256;
                        GT[((((size_t)((gt >> 2) * 64 + u.pm) * 4 + (gt & 3)) * 8 + (wr * 4 + wc)) * 16 + (ai * 4 + m) * 2 + bj) * 64 + (fq * 16 + fr)] = w; }
                    else *(v4u*)(O + (size_t)(row0 + ai * 128 + m * 16) * ldc + col0 + bj * 128) = w; } }
        return true;
    }
};
struct EpiBranch {
    static constexpr bool PERM = true;
    const v4u* GT; bf16* merged;
    __device__ __forceinline__ bool operator()(af4 (&acc)[2][2][4][2], const pg8::Unit& u, int wr, int wc, int fr, int fq) const {
        const int seg = u.aux, row0 = u.pm * 256 + wr * 64 + fr, col0 = u.pn * 256 + wc * 32 + 8 * fq;
        const bool last = (seg == 2); const int sn = last ? seg : seg + 1;
#pragma unroll
        for (int bj = 0; bj < 2; ++bj) { const int col = col0 + bj * 128;
#pragma unroll
            for (int ai = 0; ai < 2; ++ai) { v4u gcv[4], gnv[4];
#pragma unroll
                for (int m = 0; m < 4; ++m) { const size_t row = (size_t)(row0 + ai * 128 + m * 16);
                    gcv[m] = GT[((((size_t)(seg * 64 + u.pm) * 4 + u.pn) * 8 + (wr * 4 + wc)) * 16 + (ai * 4 + m) * 2 + bj) * 64 + (fq * 16 + fr)];
                    gnv[m] = GT[((((size_t)(sn * 64 + u.pm) * 4 + u.pn) * 8 + (wr * 4 + wc)) * 16 + (ai * 4 + m) * 2 + bj) * 64 + (fq * 16 + fr)]; }
#pragma unroll
                for (int m = 0; m < 4; ++m) { const size_t row = (size_t)(row0 + ai * 128 + m * 16);
                    const unsigned gcw[4] = {gcv[m].x, gcv[m].y, gcv[m].z, gcv[m].w}, gnw[4] = {gnv[m].x, gnv[m].y, gnv[m].z, gnv[m].w};
                    float f[8];
#pragma unroll
                    for (int i = 0; i < 8; ++i) { const float gc = (i & 1) ? bfhi(gcw[i >> 1]) : bflo(gcw[i >> 1]), gn = (i & 1) ? bfhi(gnw[i >> 1]) : bflo(gnw[i >> 1]);
                        f[i] = last ? gc : gc * __builtin_amdgcn_rcpf(gn); }
                    af4& v0 = acc[ai][bj][m][0]; af4& v1 = acc[ai][bj][m][1];
                    v0[0] *= f[0]; v0[1] *= f[1]; v0[2] *= f[2]; v0[3] *= f[3]; v1[0] *= f[4]; v1[1] *= f[5]; v1[2] *= f[6]; v1[3] *= f[7];
                    if (last) { v4u w; w.x = pg8::cvt_pk_bf16(v0[0], v0[1]); w.y = pg8::cvt_pk_bf16(v0[2], v0[3]); w.z = pg8::cvt_pk_bf16(v1[0], v1[1]); w.w = pg8::cvt_pk_bf16(v1[2], v1[3]);
                        *(v4u*)(merged + row * DM + col) = w; } } } }
        return last;
    }
};
struct EpiResidual {
    static constexpr bool PERM = true;
    const float* xin32; const bf16* xin16; bf16* xout;
    __device__ __forceinline__ bool operator()(af4 (&acc)[2][2][4][2], const pg8::Unit& u, int wr, int wc, int fr, int fq) const {
        const int row0 = u.pm * 256 + wr * 64 + fr, col0 = u.pn * 256 + wc * 32 + 8 * fq;
#pragma unroll
        for (int ai = 0; ai < 2; ++ai)
#pragma unroll
            for (int mh = 0; mh < 2; ++mh) { af4 r[2][2][2];
#pragma unroll
                for (int mm = 0; mm < 2; ++mm) { const size_t off = (size_t)(row0 + ai * 128 + (mh * 2 + mm) * 16) * DM + col0;
#pragma unroll
                    for (int bj = 0; bj < 2; ++bj) {
                        if (xin32) { r[mm][bj][0] = *(const af4*)(xin32 + off + bj * 128); r[mm][bj][1] = *(const af4*)(xin32 + off + bj * 128 + 4); }
                        else { const v4u w = *(const v4u*)(xin16 + off + bj * 128); r[mm][bj][0] = (af4){bflo(w.x), bfhi(w.x), bflo(w.y), bfhi(w.y)}; r[mm][bj][1] = (af4){bflo(w.z), bfhi(w.z), bflo(w.w), bfhi(w.w)}; } } }
#pragma unroll
                for (int mm = 0; mm < 2; ++mm) { const size_t off = (size_t)(row0 + ai * 128 + (mh * 2 + mm) * 16) * DM + col0;
#pragma unroll
                    for (int bj = 0; bj < 2; ++bj) { const af4 v0 = r[mm][bj][0] + acc[ai][bj][mh * 2 + mm][0], v1 = r[mm][bj][1] + acc[ai][bj][mh * 2 + mm][1]; v4u w;
                        w.x = pg8::cvt_pk_bf16(v0[0], v0[1]); w.y = pg8::cvt_pk_bf16(v0[2], v0[3]); w.z = pg8::cvt_pk_bf16(v1[0], v1[1]); w.w = pg8::cvt_pk_bf16(v1[2], v1[3]);
                        *(v4u*)(xout + off + bj * 128) = w; } } }
        return true;
    }
};
struct EpiSwiglu {
    static constexpr bool PERM = true;
    bf16* act; const float* rrow;
    __device__ __forceinline__ bool operator()(af4 (&acc)[2][2][4][2], const pg8::Unit& u, int wr, int wc, int fr, int fq) const {
        const int row0 = u.pm * 256 + wr * 64 + fr, col0 = u.pn * 128 + wc * 32 + 8 * fq;
        float rs[2][4];
#pragma unroll
        for (int ai = 0; ai < 2; ++ai)
#pragma unroll
            for (int m = 0; m < 4; ++m) rs[ai][m] = rrow[row0 + ai * 128 + m * 16];
#pragma unroll
        for (int ai = 0; ai < 2; ++ai)
#pragma unroll
            for (int m = 0; m < 4; ++m) { const float rr = rs[ai][m]; const af4 g0 = acc[ai][0][m][0] * rr, g1 = acc[ai][0][m][1] * rr, u0 = acc[ai][1][m][0] * rr, u1 = acc[ai][1][m][1] * rr;
                float o[8];
#pragma unroll
                for (int i = 0; i < 4; ++i) { o[i] = g0[i] * sigmoidf_(g0[i]) * u0[i]; o[4 + i] = g1[i] * sigmoidf_(g1[i]) * u1[i]; }
                v4u w; w.x = pg8::cvt_pk_bf16(o[0], o[1]); w.y = pg8::cvt_pk_bf16(o[2], o[3]); w.z = pg8::cvt_pk_bf16(o[4], o[5]); w.w = pg8::cvt_pk_bf16(o[6], o[7]);
                *(v4u*)(act + (size_t)(row0 + ai * 128 + m * 16) * FF + col0) = w; }
        return true;
    }
};
struct EpiScaleRows {
    static constexpr bool PERM = true;
    bf16* ys; const float* wrow;
    __device__ __forceinline__ bool operator()(af4 (&acc)[2][2][4][2], const pg8::Unit& u, int wr, int wc, int fr, int fq) const {
        const int row0 = u.pm * 256 + wr * 64 + fr, col0 = u.pn * 256 + wc * 32 + 8 * fq;
        float sc[2][4];
#pragma unroll
        for (int ai = 0; ai < 2; ++ai)
#pragma unroll
            for (int m = 0; m < 4; ++m) sc[ai][m] = wrow[row0 + ai * 128 + m * 16];
#pragma unroll
        for (int ai = 0; ai < 2; ++ai)
#pragma unroll
            for (int m = 0; m < 4; ++m) { const int row = row0 + ai * 128 + m * 16; const float s = sc[ai][m]; bf16* rowp = ys + (size_t)row * DM + col0;
#pragma unroll
                for (int bj = 0; bj < 2; ++bj) { const af4 v0 = acc[ai][bj][m][0] * s, v1 = acc[ai][bj][m][1] * s; v4u w;
                    w.x = pg8::cvt_pk_bf16(v0[0], v0[1]); w.y = pg8::cvt_pk_bf16(v0[2], v0[3]); w.z = pg8::cvt_pk_bf16(v1[0], v1[1]); w.w = pg8::cvt_pk_bf16(v1[2], v1[3]);
                    *(v4u*)(rowp + bj * 128) = w; } }
        return true;
    }
};

constexpr int RT_PITCH = 2064, RT_HI = 0, RT_LO = 36 * RT_PITCH, RT_END = 72 * RT_PITCH;
static_assert(RT_END + 4096 <= LDS_SCRATCH, "router lds");
__device__ __forceinline__ void phase_router2(const Frame& F0, const bf16* x, const float* gain, const float* wco, const float* bco, const float* wfi, const float* bfi,
                                              bf16* hout, unsigned* route, unsigned* cnt, float* LG, bool commit) {
    const Frame F = fresh(F0);
    LAS unsigned char* L = (LAS unsigned char*)F.lds;
    {
        f32x4 wv[18];
#pragma unroll
        for (int i = 0; i < 2; ++i) wv[i] = *(const f32x4*)(wco + 4 * (F.tid + 512 * i));
#pragma unroll
        for (int i = 0; i < 16; ++i) wv[2 + i] = *(const f32x4*)(wfi + 4 * (F.tid + 512 * i));
#pragma unroll
        for (int i = 0; i < 18; ++i) { int k, c0; if (i < 2) { k = F.tid + 512 * i; c0 = 32; } else { const int f = F.tid + 512 * (i - 2); k = f >> 3; c0 = (f & 7) * 4; }
            const float w4[4] = {wv[i].x, wv[i].y, wv[i].z, wv[i].w};
#pragma unroll
            for (int e = 0; e < 4; ++e) { const unsigned hi = f2bf(w4[e]); const unsigned lo = f2bf(w4[e] - __uint_as_float(hi << 16));
                *(LAS bf16*)(L + RT_HI + (c0 + e) * RT_PITCH + k * 2) = (bf16)hi; *(LAS bf16*)(L + RT_LO + (c0 + e) * RT_PITCH + k * 2) = (bf16)lo; } }
    }
    LAS float* GL = (LAS float*)(L + RT_END);
    GL[F.tid] = gain[F.tid]; GL[F.tid + 512] = gain[F.tid + 512];
    __syncthreads();
    {
        const int lane = F.lane, rl = lane & 15, kg = lane >> 4, kh = F.wave >> 2;
        const int NITER = (T / 16 + 4 * F.G - 1) / (4 * F.G);
        for (int it = 0; it < NITER; ++it) {
            const int tile = (it * F.G + xcd_order(F.bid, F.G)) * 4 + (F.wave & 3); const bool tvalid = tile < T / 16;
            const size_t row = (size_t)(tvalid ? tile : 0) * 16 + rl;
            const bf16* xr = x + row * DM + 8 * kg + 512 * kh;
            pg8::f32x4 acc[3]; acc[0] = (pg8::f32x4){0.f, 0.f, 0.f, 0.f}; acc[1] = acc[0]; acc[2] = acc[0];
            float ss = 0.f;
            const int bro[3] = {rl * RT_PITCH + 16 * kg + 1024 * kh, (16 + rl) * RT_PITCH + 16 * kg + 1024 * kh, (32 + (rl & 3)) * RT_PITCH + 16 * kg + 1024 * kh};
            v4u xa[8];
#pragma unroll
            for (int q = 0; q < 8; ++q) xa[q] = *(const v4u*)(xr + 32 * q);
            for (int s0 = 0; s0 < 16; s0 += 8) {
                v4u xn[8];
                if (s0 + 8 < 16) {
#pragma unroll
                    for (int q = 0; q < 8; ++q) xn[q] = *(const v4u*)(xr + 32 * (s0 + 8 + q)); }
#pragma unroll
                for (int q = 0; q < 8; ++q) { const int s = s0 + q;
                    const f32x4 g0 = *(const LAS f32x4*)(GL + 512 * kh + 32 * s + 8 * kg), g1 = *(const LAS f32x4*)(GL + 512 * kh + 32 * s + 8 * kg + 4);
                    const float xv[8] = {bflo(xa[q].x), bfhi(xa[q].x), bflo(xa[q].y), bfhi(xa[q].y), bflo(xa[q].z), bfhi(xa[q].z), bflo(xa[q].w), bfhi(xa[q].w)};
                    ss += (xv[0] * xv[0] + xv[1] * xv[1]) + (xv[2] * xv[2] + xv[3] * xv[3]) + (xv[4] * xv[4] + xv[5] * xv[5]) + (xv[6] * xv[6] + xv[7] * xv[7]);
                    const float y[8] = {xv[0] * g0.x, xv[1] * g0.y, xv[2] * g0.z, xv[3] * g0.w, xv[4] * g1.x, xv[5] * g1.y, xv[6] * g1.z, xv[7] * g1.w};
                    v4u ah, al; ah.x = pk2(y[0], y[1]); ah.y = pk2(y[2], y[3]); ah.z = pk2(y[4], y[5]); ah.w = pk2(y[6], y[7]);
                    al.x = pk2(y[0] - bflo(ah.x), y[1] - bfhi(ah.x)); al.y = pk2(y[2] - bflo(ah.y), y[3] - bfhi(ah.y)); al.z = pk2(y[4] - bflo(ah.z), y[5] - bfhi(ah.z)); al.w = pk2(y[6] - bflo(ah.w), y[7] - bfhi(ah.w));
                    if (tvalid) *(v4u*)(hout + row * DM + 512 * kh + 32 * s + 8 * kg) = ah;
                    const bf16x8 Ah = __builtin_bit_cast(bf16x8, ah), Al = __builtin_bit_cast(bf16x8, al);
#pragma unroll
                    for (int ct = 0; ct < 3; ++ct) { const bf16x8 Bh = *(const LAS bf16x8*)(L + RT_HI + bro[ct] + 64 * s), Bl = *(const LAS bf16x8*)(L + RT_LO + bro[ct] + 64 * s);
                        acc[ct] = __builtin_amdgcn_mfma_f32_16x16x32_bf16(Ah, Bh, acc[ct], 0, 0, 0);
                        acc[ct] = __builtin_amdgcn_mfma_f32_16x16x32_bf16(Ah, Bl, acc[ct], 0, 0, 0);
                        acc[ct] = __builtin_amdgcn_mfma_f32_16x16x32_bf16(Al, Bh, acc[ct], 0, 0, 0); } }
#pragma unroll
                for (int q = 0; q < 8; ++q) xa[q] = xn[q];
            }
            ss += __shfl_xor(ss, 16); ss += __shfl_xor(ss, 32);
            float* LGh = LG + (size_t)kh * T * 48;
            if (tvalid) {
#pragma unroll
                for (int ct = 0; ct < 3; ++ct)
#pragma unroll
                    for (int rg = 0; rg < 4; ++rg) if (ct < 2 || rl < 4) LGh[((size_t)tile * 16 + 4 * kg + rg) * 48 + ct * 16 + rl] = acc[ct][rg];
                if (lane < 16) LGh[((size_t)tile * 16 + lane) * 48 + 47] = ss; }
            asm volatile("s_waitcnt vmcnt(0)" ::: "memory");
            __syncthreads();
            if (kh == 0 && lane < 16 && tvalid) {
                const size_t m = (size_t)tile * 16 + lane;
                const float* l0 = LG + m * 48; const float* l1 = LG + (size_t)T * 48 + m * 48;
                const float sst = __uint_as_float(__hip_atomic_load((const unsigned*)(l0 + 47), RLX_AGENT)) + __uint_as_float(__hip_atomic_load((const unsigned*)(l1 + 47), RLX_AGENT));
                const float r = rsqrtf(sst * (1.f / DM) + RMS_EPS);
                float lg[36];
#pragma unroll
                for (int c = 0; c < 36; ++c) lg[c] = r * (__uint_as_float(__hip_atomic_load((const unsigned*)(l0 + c), RLX_AGENT)) + __uint_as_float(__hip_atomic_load((const unsigned*)(l1 + c), RLX_AGENT)));
                float c0 = lg[32] + bco[0], c1 = lg[33] + bco[1], c2 = lg[34] + bco[2], c3 = lg[35] + bco[3];
                int grp = 0; float cm = c0;
                if (c1 > cm) { cm = c1; grp = 1; } if (c2 > cm) { cm = c2; grp = 2; } if (c3 > cm) { cm = c3; grp = 3; }
                const float ptop = 1.f / (__expf(c0 - cm) + __expf(c1 - cm) + __expf(c2 - cm) + __expf(c3 - cm));
                float fs[8];
#pragma unroll
                for (int i = 0; i < 8; ++i) { float a = lg[i] + bfi[i], b = lg[8 + i] + bfi[8 + i], c = lg[16 + i] + bfi[16 + i], d = lg[24 + i] + bfi[24 + i]; fs[i] = grp == 0 ? a : (grp == 1 ? b : (grp == 2 ? c : d)); }
                int i1 = 0; float v1 = fs[0];
#pragma unroll
                for (int i = 1; i < 8; ++i) if (fs[i] > v1) { v1 = fs[i]; i1 = i; }
                int i2 = -1; float v2 = -3.0e38f;
#pragma unroll
                for (int i = 0; i < 8; ++i) if (i != i1 && fs[i] > v2) { v2 = fs[i]; i2 = i; }
                const float e2 = __expf(v2 - v1), w1 = ptop / (1.f + e2), w2 = ptop * e2 / (1.f + e2);
                if (commit) {
                    const int ea = grp * 8 + i1, eb = grp * 8 + i2;
                    const unsigned ra = __hip_atomic_fetch_add(cnt + 64 * ea, 1u, RLX_AGENT), rb = __hip_atomic_fetch_add(cnt + 64 * eb, 1u, RLX_AGENT);
                    v4u o; o.x = (unsigned)ea; o.y = (unsigned)eb; o.z = ra; o.w = rb; *(v4u*)(route + m * 8) = o;
                    *(f32x4*)(route + m * 8 + 4) = (f32x4){w1, w2, r, 0.f};
                }
            }
        }
    }
    __syncthreads();
}

__device__ __forceinline__ void phase_scatter(const Frame& F0, const bf16* hin, const unsigned* route, const unsigned* cnt, unsigned* ntp, unsigned* tile_e, bf16* hs, float* wrow, float* rrow, unsigned* pos) {
    const Frame F = fresh(F0);
    unsigned* off = (unsigned*)F.lds;
    if (F.tid == 0) { unsigned o = 0;
        for (int e = 0; e < NEXP; ++e) { off[e] = o; const unsigned c = __hip_atomic_load(cnt + 64 * e, RLX_AGENT); const unsigned p = (c + 255u) & ~255u;
            if (F.bid == 0) for (unsigned tI = o >> 8; tI < ((o + p) >> 8); ++tI) tile_e[tI] = (unsigned)e;
            o += p; }
        off[NEXP] = o; if (F.bid == 0) *ntp = o >> 8; }
    __syncthreads();
    const int gw = F.bid * 8 + F.wave, NGW = F.G * 8;
    const int RPW = (T + NGW - 1) / NGW, mbase = (xcd_order(F.bid, F.G) * 8 + F.wave) * RPW;
    for (int r0 = 0; r0 < RPW; r0 += 4) {
        v4u ri[4], a[4], b[4]; f32x4 ww[4];
#pragma unroll
        for (int q = 0; q < 4; ++q) { const int m = (r0 + q < RPW) ? mbase + r0 + q : T; if (m < T) { ri[q] = *(const v4u*)(route + (size_t)m * 8); ww[q] = *(const f32x4*)(route + (size_t)m * 8 + 4);
                const v4u* src = (const v4u*)(hin + (size_t)m * DM) + F.lane; a[q] = src[0]; b[q] = src[64]; } }
#pragma unroll
        for (int q = 0; q < 4; ++q) { const int m = (r0 + q < RPW) ? mbase + r0 + q : T; if (m < T) {
                const unsigned d0 = off[ri[q].x] + ri[q].z, d1 = off[ri[q].y] + ri[q].w;
                v4u* p0 = (v4u*)(hs + (size_t)d0 * DM) + F.lane; v4u* p1 = (v4u*)(hs + (size_t)d1 * DM) + F.lane;
                p0[0] = a[q]; p0[64] = b[q]; p1[0] = a[q]; p1[64] = b[q];
                if (F.lane == 0) { wrow[d0] = ww[q].x; wrow[d1] = ww[q].y; rrow[d0] = ww[q].z; rrow[d1] = ww[q].z; *(v2u*)(pos + (size_t)m * 2) = (v2u){d0, d1}; } } }
    }
    __syncthreads();
}

__device__ __forceinline__ void phase_combine(const Frame& F0, const bf16* x, bf16* xdst16, float* xdst32, const bf16* ys, const unsigned* pos, const float* ngain, bf16* hout) {
    const Frame F = fresh(F0);
    const int gw = F.bid * 8 + F.wave, NGW = F.G * 8;
    f32x4 g[4];
#pragma unroll
    for (int j = 0; j < 4; ++j) g[j] = ngain ? *(const f32x4*)(ngain + 4 * F.lane + 256 * j) : (f32x4){0.f, 0.f, 0.f, 0.f};
    const int RPW = (T + NGW - 1) / NGW, mbase = (xcd_order(F.bid, F.G) * 8 + F.wave) * RPW;
    for (int r0 = 0; r0 < RPW; r0 += 2) {
        v2u pp[2];
#pragma unroll
        for (int q = 0; q < 2; ++q) { const int m = (r0 + q < RPW) ? mbase + r0 + q : T; pp[q] = (m < T) ? *(const v2u*)(pos + (size_t)m * 2) : (v2u){0u, 0u}; }
        v2u xv[2][4], ya[2][4], yb[2][4];
#pragma unroll
        for (int q = 0; q < 2; ++q) { const int m = (r0 + q < RPW) ? mbase + r0 + q : T; if (m < T) {
                const v2u* xr = (const v2u*)(x + (size_t)m * DM) + F.lane; const v2u* y0 = (const v2u*)(ys + (size_t)pp[q].x * DM) + F.lane; const v2u* y1 = (const v2u*)(ys + (size_t)pp[q].y * DM) + F.lane;
#pragma unroll
                for (int j = 0; j < 4; ++j) { xv[q][j] = xr[64 * j]; ya[q][j] = y0[64 * j]; yb[q][j] = y1[64 * j]; } } }
#pragma unroll
        for (int q = 0; q < 2; ++q) { const int m = (r0 + q < RPW) ? mbase + r0 + q : T; if (m < T) {
                float s = 0.f; f32x4 v[4];
#pragma unroll
                for (int j = 0; j < 4; ++j) { const v2u c = xv[q][j], a = ya[q][j], b = yb[q][j]; f32x4 t;
                    t.x = bflo(c.x) + bflo(a.x) + bflo(b.x); t.y = bfhi(c.x) + bfhi(a.x) + bfhi(b.x); t.z = bflo(c.y) + bflo(a.y) + bflo(b.y); t.w = bfhi(c.y) + bfhi(a.y) + bfhi(b.y);
                    v[j] = t; s += (t.x * t.x + t.y * t.y) + (t.z * t.z + t.w * t.w); }
                if (xdst32) { f32x4* xw = (f32x4*)(xdst32 + (size_t)m * DM) + F.lane;
#pragma unroll
                    for (int j = 0; j < 4; ++j) xw[64 * j] = v[j]; }
                else { v2u* xw = (v2u*)(xdst16 + (size_t)m * DM) + F.lane;
#pragma unroll
                    for (int j = 0; j < 4; ++j) { v2u w; w.x = pk2(v[j].x, v[j].y); w.y = pk2(v[j].z, v[j].w); xw[64 * j] = w; } }
                if (ngain) {
                    const float r = rsqrtf(wave_sum(s) * (1.f / DM) + RMS_EPS);
                    v2u* o8 = (v2u*)(hout + (size_t)m * DM) + F.lane;
#pragma unroll
                    for (int j = 0; j < 4; ++j) { v2u w; w.x = pk2(v[j].x * r * g[j].x, v[j].y * r * g[j].y); w.y = pk2(v[j].z * r * g[j].z, v[j].w * r * g[j].w); o8[64 * j] = w; }
                } } }
    }
}

constexpr int PH_PER_LAYER = 11, N_PHASES = 1 + DEPTH * PH_PER_LAYER;
__device__ __forceinline__ CArgs& kargs() { CArgs* p = (CArgs*)__builtin_amdgcn_kernarg_segment_ptr(); asm volatile("" : "+s"(p)); return *p; }
__global__ void __launch_bounds__(512, 2) mk_fwd(Args args_unused) {
    extern __shared__ __attribute__((aligned(16))) unsigned char lds[];
    LAS unsigned char* lds3 = (LAS unsigned char*)lds;
    const int wave_s = __builtin_amdgcn_readfirstlane(threadIdx.x >> 6);
    for (int u = threadIdx.x; u < (LDS_BYTES - LDSCTL_OFF) / 4; u += 512) ((LAS unsigned*)(lds3 + LDSCTL_OFF))[u] = 0u;
    __syncthreads();
#if MK_SPLIT
#define GRID_BAR() do { } while (0)
#else
    (void)xcd_barrier_post((unsigned*)(kargs().ws + WS_CTL) + CW_BAR, (volatile LAS unsigned*)(lds3 + LDSCTL_OFF));
#define GRID_BAR() do { XcdBarrier b_; b_.bar = (unsigned*)(kargs().ws + WS_CTL) + CW_BAR; b_.x = xb_xcc_id(); b_.st = (volatile LAS unsigned*)(lds3 + LDSCTL_OFF); xcd_barrier(b_); } while (0)
#endif
#define IN(k) (kargs().ph_lo <= (k) && (k) < kargs().ph_hi)
#define SEAM(k) do { if (IN(k) && IN((k) + 1)) GRID_BAR(); } while (0)
#define FRAME() CArgs& A = kargs(); Frame F; F.lds = lds; F.lane = lane_id_asm(); { int w_ = wave_s; asm volatile("" : "+s"(w_)); F.wave = w_; } F.tid = F.wave * 64 + F.lane; { int g_ = gridDim.x, b_ = blockIdx.x; asm volatile("" : "+s"(g_), "+s"(b_)); F.G = g_; F.bid = b_; } \
    unsigned char* ws = A.ws; F.ws = ws; F.ctl = (unsigned*)(ws + WS_CTL); (void)F;
#define WSP(T_, off) ((T_*)(ws + (off)))

#ifdef EXTRA_BARS
    for (int eb_ = 0; eb_ < EXTRA_BARS; ++eb_) GRID_BAR();
#endif
    if (IN(0) && PHON(11)) { for (int rep_ = 0; rep_ < REPN(11); ++rep_) { if (rep_) GRID_BAR(); { FRAME(); phase_prologue(F, A); }
        { FRAME(); phase_norm(F, A.in[I_X], A.in[I_MIXG], WSP(bf16, WS_H)); } } }
    SEAM(0);
#pragma unroll 1
    for (int l = 0; l < DEPTH; ++l) {
        const int p0 = 1 + l * PH_PER_LAYER;
        if (IN(p0 + 1) && PHON(1)) { for (int rep_ = 0; rep_ < REPN(1); ++rep_) { if (rep_) GRID_BAR(); { FRAME();
            pg8::Gemm g{DM, DM, DM};
            SchedDense S{(const char*)(ws + WS_H), (const char*)(ws + WS_WIN) + (size_t)l * NCOL * DM * 2, T / 256, NCOL / 256, F.G, F.bid, (size_t)256 * DM * 2, (size_t)256 * DM * 2};
            EpiStoreBf16 E{WSP(bf16, WS_PROJ), NCOL, C_GL, A.in[I_BGATE] + l * 3 * DM, WSP(v4u, WS_GT)};
            pg8::gemm_phase<EpiStoreBf16, SchedDense, true, true>(lds3, g, S, E, F.tid);
        } } }
        SEAM(p0 + 1);
        if (IN(p0 + 2) && PHON(2)) { for (int rep_ = 0; rep_ < REPN(2); ++rep_) { if (rep_) GRID_BAR(); {
            for (int r2_ = 0; r2_ < REPN(14); ++r2_) { FRAME(); phase_qkprep(F, WSP(bf16, WS_PROJ), A.in[I_QG] + l * 64, A.in[I_KG] + l * 64, WSP(bf16, WS_Q), WSP(bf16, WS_K), WSP(float, WS_KMEAN)); }
            for (int r2_ = 0; r2_ < REPN(15); ++r2_) { FRAME(); phase_conv(F, WSP(bf16, WS_PROJ), A.in[I_CONVW] + (size_t)l * 31 * 512, A.in[I_CONVB] + l * 512, A.in[I_CLNG] + l * 512, A.in[I_CLNB] + l * 512, WSP(bf16, WS_CAT)); }
            for (int r2_ = 0; r2_ < REPN(16); ++r2_) { FRAME(); phase_hgrn1(F, WSP(bf16, WS_PROJ), A.in[I_LBL], l, WSP(float, WS_HS), WSP(float, WS_HS + 16 * MiB), WSP(float, WS_ORAW), WSP(bf16, WS_HS + 17 * MiB)); }
        } } }
        SEAM(p0 + 2);
        if (IN(p0 + 3) && PHON(3)) { for (int rep_ = 0; rep_ < REPN(3); ++rep_) { if (rep_) GRID_BAR(); {
            for (int r2_ = 0; r2_ < REPN(12); ++r2_) { FRAME(); phase_attn_mfma(F, WSP(bf16, WS_Q), WSP(bf16, WS_K), WSP(bf16, WS_PROJ), WSP(float, WS_KMEAN), WSP(bf16, WS_CAT)); }
            for (int r2_ = 0; r2_ < REPN(13); ++r2_) { FRAME(); phase_hgrn2(F, WSP(bf16, WS_PROJ), A.in[I_HGG] + l * 128, WSP(float, WS_HS), WSP(float, WS_HS + 16 * MiB), WSP(float, WS_ORAW), WSP(bf16, WS_HS + 17 * MiB), WSP(bf16, WS_CAT), (r2_ + 1 < REPN(13)) ? PROBE_DRY : 0); }
        } } }
        SEAM(p0 + 3);
        if (IN(p0 + 4) && PHON(4)) { for (int rep_ = 0; rep_ < REPN(4); ++rep_) { if (rep_) GRID_BAR(); { FRAME();
            pg8::Gemm g{1536, 512, 512};
            SchedBranch S{(const char*)(ws + WS_CAT), (const char*)(ws + WS_WCAT) + (size_t)l * 3 * DM * 512 * 2, F.G, F.bid};
            EpiBranch E{WSP(const v4u, WS_GT), WSP(bf16, WS_MERGED)};
            pg8::gemm_phase<EpiBranch, SchedBranch, true, true>(lds3, g, S, E, F.tid);
        } } }
        SEAM(p0 + 4);
        if (IN(p0 + 5) && PHON(5)) { for (int rep_ = 0; rep_ < REPN(5); ++rep_) { if (rep_) GRID_BAR(); { FRAME();
            pg8::Gemm g{DM, DM, DM};
            SchedDense S{(const char*)(ws + WS_MERGED), (const char*)(ws + WS_WOUT) + (size_t)l * DM * DM * 2, T / 256, DM / 256, F.G, F.bid, (size_t)256 * DM * 2, (size_t)256 * DM * 2};
            EpiResidual E{(l == 0) ? A.in[I_X] : (const float*)nullptr, (l == 0) ? (const bf16*)nullptr : WSP(const bf16, WS_XB), (rep_ + 1 >= REPN(5)) ? WSP(bf16, WS_XB) : WSP(bf16, WS_HS)};
            pg8::gemm_phase<EpiResidual, SchedDense, true, true>(lds3, g, S, E, F.tid);
        } } }
        SEAM(p0 + 5);
        if (IN(p0 + 6) && PHON(6)) { for (int rep_ = 0; rep_ < REPN(6); ++rep_) { if (rep_) GRID_BAR(); { FRAME(); phase_router2(F, WSP(const bf16, WS_XB), A.in[I_FFNG] + l * DM, A.in[I_WCO] + (size_t)l * DM * 4, A.in[I_BCO] + l * 4, A.in[I_WFI] + (size_t)l * DM * 32, A.in[I_BFI] + l * 32, WSP(bf16, WS_H), WSP(unsigned, WS_ROUTE), F.ctl + CW_CNT + l * 32 * 64, WSP(float, WS_Q), rep_ + 1 >= REPN(6)); } } }
        SEAM(p0 + 6);
        if (IN(p0 + 7) && PHON(7)) { for (int rep_ = 0; rep_ < REPN(7); ++rep_) { if (rep_) GRID_BAR(); { FRAME(); phase_scatter(F, WSP(bf16, WS_H), WSP(unsigned, WS_ROUTE), F.ctl + CW_CNT + l * 32 * 64, F.ctl + CW_NT + l * 64, F.ctl + CW_TILE + l * 256, WSP(bf16, WS_HS), WSP(float, WS_POS + 512 * 1024), WSP(float, WS_POS + 768 * 1024), WSP(unsigned, WS_POS)); } } }
        SEAM(p0 + 7);
        if (IN(p0 + 8) && PHON(8)) { for (int rep_ = 0; rep_ < REPN(8); ++rep_) { if (rep_) GRID_BAR(); { FRAME();
            pg8::Gemm g{DM, DM, DM};
            SchedMoe S{(const char*)(ws + WS_HS), (const char*)(ws + WS_WEI) + (size_t)l * NEXP * 1024 * DM * 2, F.ctl + CW_NT + l * 64, F.ctl + CW_TILE + l * 256, F.G, F.bid, (size_t)256 * DM * 2, (size_t)1024 * DM * 2, (size_t)256 * DM * 2};
            EpiSwiglu E{WSP(bf16, WS_ACT), WSP(float, WS_POS + 768 * 1024)};
            pg8::gemm_phase<EpiSwiglu, SchedMoe, true, true>(lds3, g, S, E, F.tid);
        } } }
        SEAM(p0 + 8);
        if (IN(p0 + 9) && PHON(9)) { for (int rep_ = 0; rep_ < REPN(9); ++rep_) { if (rep_) GRID_BAR(); { FRAME();
            pg8::Gemm g{FF, FF, FF};
            SchedMoe S{(const char*)(ws + WS_ACT), (const char*)(ws + WS_WEO) + (size_t)l * NEXP * DM * FF * 2, F.ctl + CW_NT + l * 64, F.ctl + CW_TILE + l * 256, F.G, F.bid, (size_t)256 * FF * 2, (size_t)DM * FF * 2, (size_t)256 * FF * 2};
            EpiScaleRows E{WSP(bf16, WS_YS), WSP(float, WS_POS + 512 * 1024)};
            pg8::gemm_phase<EpiScaleRows, SchedMoe, true, true>(lds3, g, S, E, F.tid);
        } } }
        SEAM(p0 + 9);
        if (IN(p0 + 10) && PHON(10)) { for (int rep_ = 0; rep_ < REPN(10); ++rep_) { if (rep_) GRID_BAR(); { FRAME(); const bool real_ = (rep_ + 1 >= REPN(10)), lastl_ = (l + 1 >= DEPTH); phase_combine(F, WSP(const bf16, WS_XB), (real_ && !lastl_) ? WSP(bf16, WS_XB) : WSP(bf16, WS_HS), (real_ && lastl_) ? A.out : (float*)nullptr, WSP(bf16, WS_YS), WSP(unsigned, WS_POS), lastl_ ? (const float*)nullptr : A.in[I_MIXG] + (l + 1) * DM, WSP(bf16, WS_H)); } } }
        SEAM(p0 + 10);
    }
#undef IN
#undef SEAM
#undef FRAME
#undef WSP
}

extern "C" void kernel_launch(void* const* d_in, const int* in_sizes, int n_in, void* d_out, int out_size, void* d_ws, size_t ws_size, hipStream_t stream) {
    static int grid = 0;
    if (grid == 0) {
        if (n_in != 23 || out_size != T * DM || ws_size < WS_END) { fprintf(stderr, "kernel_launch: unexpected shapes (n_in %d out %d ws %zu)\n", n_in, out_size, ws_size); grid = -1; return; }
        int dev = 0, cus = 0, per_cu = 0;
        if (hipGetDevice(&dev) != hipSuccess || hipDeviceGetAttribute(&cus, hipDeviceAttributeMultiprocessorCount, dev) != hipSuccess) { grid = -1; return; }
        if (hipFuncSetAttribute((const void*)mk_fwd, hipFuncAttributeMaxDynamicSharedMemorySize, LDS_BYTES) != hipSuccess) { fprintf(stderr, "kernel_launch: hipFuncSetAttribute failed\n"); grid = -1; return; }
        if (hipOccupancyMaxActiveBlocksPerMultiprocessor(&per_cu, (const void*)mk_fwd, 512, LDS_BYTES) != hipSuccess || per_cu < 1) fprintf(stderr, "kernel_launch: occupancy query says %d\n", per_cu);
        (void)hipGetLastError();
        grid = cus;
    }
    if (grid < 0) return;
    (void)hipMemsetAsync((char*)d_ws + WS_CTL, 0, CTL_ZERO_BYTES, stream);
    Args a{};
    for (int i = 0; i < 23; ++i) a.in[i] = (const float*)d_in[i];
    a.out = (float*)d_out; a.ws = (unsigned char*)d_ws;
#if MK_SPLIT
    for (int p = 0; p < N_PHASES; ++p) {
        if (p == 1 + PH_PER_LAYER) continue;
        a.ph_lo = p; a.ph_hi = p + 1;
        hipLaunchKernelGGL(mk_fwd, dim3(grid), dim3(512), LDS_BYTES, stream, a);
    }
#else
    a.ph_lo = 0; a.ph_hi = N_PHASES;
    hipLaunchKernelGGL(mk_fwd, dim3(grid), dim3(512), LDS_BYTES, stream, a);
#endif
}
```

```cpp
#include <hip/hip_runtime.h>
#include <cstdio>
#include <cstdint>

#ifndef MK_SPLIT
#define MK_SPLIT 0
#endif
#ifndef DBG_MASK
#define DBG_MASK 0xFFFFu
#endif
#define PHON(j) (((DBG_MASK) >> (j)) & 1u)
#ifndef REP_MASK
#define REP_MASK 0u
#endif
#ifndef REP_EXTRA
#define REP_EXTRA 1
#endif
#ifndef PROBE_DRY
#define PROBE_DRY 0
#endif
#define REPN(j) ((((REP_MASK) >> (j)) & 1u) ? (1 + REP_EXTRA) : 1)

constexpr int DM = 1024, NB = 8, SEQ = 2048, T = NB * SEQ, DEPTH = 2;
constexpr int NCOL = 7680;
constexpr int C_AQ = 0, C_AK = 512, C_AV = 1024, C_HQ = 1536, C_HF = 2048, C_HI = 2560, C_HG = 3072, C_CA = 3584, C_CB = 4096, C_GL = 4608;
constexpr int NEXP = 32, FF = 512;
constexpr int MOE_ROWS = 2 * T + NEXP * 256;
constexpr float RMS_EPS = 1e-6f, LN_EPS = 1e-5f;
constexpr float QSCALE = 0.125f * 1.4426950408889634f;

namespace pg8 {
#define PG8_LAS __attribute__((address_space(3)))
typedef unsigned short bf16_t;
typedef short bf16x8 __attribute__((ext_vector_type(8)));
typedef float f32x4 __attribute__((ext_vector_type(4)));
typedef unsigned u32x4 __attribute__((ext_vector_type(4)));
constexpr int BM = 256, BK = 64, HALF = 128, HTB = HALF * BK * 2, STAGE_BYTES = 8 * HTB, NXCD = 8, WGM = 8;

__host__ __device__ __forceinline__ int lds_byte(int r, int c) { const int st = (r >> 4) * 2 + (c >> 5), rr = r & 15, cc = c & 31, ob = rr * 64 + cc * 2; return st * 1024 + (ob ^ (((ob >> 9) & 1) << 5)); }
__host__ __device__ __forceinline__ void stage_rc(int b, int& R, int& C) { const int st = b / 1024, sb = b % 1024, swz = sb ^ (((sb >> 9) & 1) << 5); R = (st >> 1) * 16 + swz / 64; C = (st & 1) * 32 + (swz % 64) / 2; }
__host__ __device__ __forceinline__ int perm32(int rho) { const int n = rho >> 4, i = rho & 15; return 8 * (i >> 2) + 4 * n + (i & 3); }

struct Unit { int pm, pn, aux, pad; const char* a; const char* b; const unsigned* gidx; };
struct Gemm { int lda, ldb, K; };

__device__ __forceinline__ bool static_tile(int nM, int nN, long L, int& pm, int& pn) {
    const int nwg = nM * nN; if (L >= nwg) return false;
    int wgid = (int)L; { const int q = nwg / NXCD, r = nwg % NXCD, xcd = wgid % NXCD, off = wgid / NXCD; wgid = (xcd < r ? xcd * (q + 1) : r * (q + 1) + (xcd - r) * q) + off; }
    const int nig = WGM * nN, gid = wgid / nig, fm = gid * WGM, gsz = (nM - fm) < WGM ? (nM - fm) : WGM;
    pm = fm + ((wgid % nig) % gsz); pn = (wgid % nig) / gsz; return true;
}

__device__ __forceinline__ unsigned cvt_pk_bf16(float lo, float hi) { unsigned r; asm volatile("v_cvt_pk_bf16_f32 %0, %1, %2" : "=v"(r) : "v"(lo), "v"(hi)); return r; }

template <class Epi, class Sched, bool ALIGN_EPI = false, bool SP2 = false, bool GATHER = false>
__device__ __forceinline__ void gemm_phase(PG8_LAS unsigned char* lds, const Gemm g, const Sched& S, const Epi& E, int tid_in) {
    int tid_ = tid_in; asm volatile("" : "+v"(tid_));
    const int tid = tid_, wid = __builtin_amdgcn_readfirstlane(tid >> 6), lane = tid & 63, wr = wid >> 2, wc = wid & 3, fr = lane & 15, fq = lane >> 4;
    const int K = g.K, nt = K / BK;
    unsigned voffA[2], voffB[2];
#pragma unroll
    for (int i = 0; i < 2; ++i) { int R, C; stage_rc(tid * 16 + i * 8192, R, C); const int Rb = Epi::PERM ? ((R & ~31) + perm32(R & 31)) : R;
        voffA[i] = (unsigned)(R * g.lda + C) * 2u; voffB[i] = (unsigned)(Rb * g.ldb + C) * 2u; }
    const size_t kstep = (size_t)(BK * 2);
    unsigned gvo[2][2] = {{0u, 0u}, {0u, 0u}}, gnx[2][2] = {{0u, 0u}, {0u, 0u}}; int grow[2] = {0, 0}; unsigned gcol[2] = {0u, 0u};
    if constexpr (GATHER) {
#pragma unroll
        for (int i = 0; i < 2; ++i) { int R, C; stage_rc(tid * 16 + i * 8192, R, C); grow[i] = R; gcol[i] = (unsigned)C * 2u; } }
#define PG8_GCONV(dst, src) do { _Pragma("unroll") for (int h_ = 0; h_ < 2; ++h_) _Pragma("unroll") for (int i_ = 0; i_ < 2; ++i_) dst[h_][i_] = src[h_][i_] * (unsigned)(g.lda * 2) + gcol[i_]; } while (0)
#define PG8_GLOAD(dst, u_) do { _Pragma("unroll") for (int h_ = 0; h_ < 2; ++h_) _Pragma("unroll") for (int i_ = 0; i_ < 2; ++i_) dst[h_][i_] = (u_).gidx[h_ * HALF + grow[i_]]; } while (0)
    const size_t hstepA = (size_t)HALF * g.lda * 2, hstepB = (size_t)HALF * g.ldb * 2;
    const unsigned ldsw = (unsigned)wid * 1024u;
    const int aoff = lds_byte(wr * 64 + fr, fq * 8), boff = lds_byte(wc * 32 + fr, fq * 8);
#define PG8_SA(b, h) (((b) * 2 + (h)) * HTB)
#define PG8_SB(b, h) ((4 + (b) * 2 + (h)) * HTB)
#define PG8_STAGE(bufoff, gbase, voff) do { _Pragma("unroll") for (int _i = 0; _i < 2; ++_i) \
        __builtin_amdgcn_global_load_lds((const unsigned*)((const char*)(gbase) + (voff)[_i]), (PG8_LAS unsigned*)(lds + (bufoff) + ldsw + _i * 8192), 16, 0, 0); } while (0)
#define PG8_LDA(dst, b, h) do { _Pragma("unroll") for (int m = 0; m < 4; ++m) _Pragma("unroll") for (int k = 0; k < 2; ++k) dst[m][k] = *(const PG8_LAS bf16x8*)(lds + PG8_SA(b, h) + aoff + m * 2048 + k * 1024); } while (0)
#define PG8_LDB(dst, b, h) do { _Pragma("unroll") for (int n = 0; n < 2; ++n) _Pragma("unroll") for (int k = 0; k < 2; ++k) dst[n][k] = *(const PG8_LAS bf16x8*)(lds + PG8_SB(b, h) + boff + n * 2048 + k * 1024); } while (0)
#define PG8_MMA(ai, bj, At, Bt) do { __builtin_amdgcn_s_setprio(1); _Pragma("unroll") for (int m = 0; m < 4; ++m) _Pragma("unroll") for (int n = 0; n < 2; ++n) _Pragma("unroll") for (int k = 0; k < 2; ++k) \
        acc[ai][bj][m][n] = __builtin_amdgcn_mfma_f32_16x16x32_bf16(Bt[n][k], At[m][k], acc[ai][bj][m][n], 0, 0, 0); __builtin_amdgcn_s_setprio(0); } while (0)
#define PG8_WAIT_V(n) asm volatile("s_waitcnt vmcnt(" #n ")" ::: "memory")
#define PG8_WAIT_L(n) asm volatile("s_waitcnt lgkmcnt(" #n ")" ::: "memory")
#define PG8_BAR __builtin_amdgcn_s_barrier()
#define PG8_SCHED __builtin_amdgcn_sched_barrier(0)
    Unit cur, nxt; int ui = 0;
    if (!S.next(0, cur)) return;
    f32x4 acc[2][2][4][2];
#pragma unroll
    for (int a = 0; a < 2; ++a)
#pragma unroll
        for (int b = 0; b < 2; ++b)
#pragma unroll
            for (int m = 0; m < 4; ++m)
#pragma unroll
                for (int n = 0; n < 2; ++n) acc[a][b][m][n] = (f32x4){0.f, 0.f, 0.f, 0.f};
    bf16x8 At[4][2], B0[2][2], B1[2][2];
    const char* cA = cur.a; const char* cB = cur.b;
    if constexpr (GATHER) { PG8_GLOAD(gnx, cur); PG8_GCONV(gvo, gnx); }
#define PG8_STAGE_A(bufoff, kbase, half, nextu) do { if constexpr (GATHER) { unsigned vo_[2]; if (nextu) { vo_[0] = gnx[half][0] * (unsigned)(g.lda * 2) + gcol[0]; vo_[1] = gnx[half][1] * (unsigned)(g.lda * 2) + gcol[1]; } \
        else { vo_[0] = gvo[half][0]; vo_[1] = gvo[half][1]; } PG8_STAGE(bufoff, kbase, vo_); } else { PG8_STAGE(bufoff, (kbase) + (half) * hstepA, voffA); } } while (0)
    if constexpr (SP2) {
        PG8_STAGE(PG8_SB(0, 0), cB, voffB); PG8_STAGE(PG8_SB(0, 1), cB + hstepB, voffB); PG8_STAGE_A(PG8_SA(0, 0), cA, 0, false); PG8_STAGE_A(PG8_SA(0, 1), cA, 1, false);
        if (wr == 1) PG8_BAR;
        PG8_WAIT_V(2); PG8_BAR;
        PG8_STAGE(PG8_SB(1, 0), cB + kstep, voffB); PG8_STAGE_A(PG8_SA(1, 0), cA + kstep, 0, false); PG8_STAGE(PG8_SB(1, 1), cB + hstepB + kstep, voffB);
        PG8_WAIT_V(6); PG8_BAR;
    } else {
        PG8_STAGE(PG8_SB(0, 0), cB, voffB); PG8_STAGE(PG8_SA(0, 0), cA, voffA); PG8_STAGE(PG8_SB(0, 1), cB + hstepB, voffB); PG8_STAGE(PG8_SA(0, 1), cA + hstepA, voffA);
        if (wr == 1) PG8_BAR;
        PG8_WAIT_V(4); PG8_BAR;
        PG8_STAGE(PG8_SB(1, 0), cB + kstep, voffB); PG8_STAGE(PG8_SA(1, 0), cA + kstep, voffA); PG8_STAGE(PG8_SB(1, 1), cB + hstepB + kstep, voffB);
        PG8_WAIT_V(6); PG8_BAR;
    }
    for (;;) {
        const bool has_next = S.next(ui + 1, nxt);
        const char* nA = has_next ? nxt.a : cA; const char* nB = has_next ? nxt.b : cB;
        if constexpr (GATHER) { if (has_next) PG8_GLOAD(gnx, nxt); }
        for (int t = 0; t < nt; t += 2) {
            const bool last = (t == nt - 2);
            const char* a1 = cA + (size_t)(t + 1) * kstep;
            const char* a2 = last ? nA : cA + (size_t)(t + 2) * kstep; const char* b2 = last ? nB : cB + (size_t)(t + 2) * kstep;
            const char* a3 = a2 + kstep; const char* b3 = b2 + kstep;
            if constexpr (SP2) {
            PG8_LDB(B0, 0, 0); PG8_LDB(B1, 0, 1); PG8_SCHED; PG8_LDA(At, 0, 0); PG8_STAGE_A(PG8_SA(1, 1), a1, 1, false);
            PG8_WAIT_V(8); PG8_WAIT_L(0); PG8_BAR; PG8_MMA(0, 0, At, B0); PG8_MMA(0, 1, At, B1); PG8_BAR; PG8_SCHED;
            PG8_LDA(At, 0, 1); PG8_STAGE(PG8_SB(0, 0), b2, voffB); PG8_STAGE(PG8_SB(0, 1), b2 + hstepB, voffB); PG8_STAGE_A(PG8_SA(0, 0), a2, 0, last);
            PG8_WAIT_V(8); PG8_WAIT_L(0); PG8_BAR; PG8_MMA(1, 0, At, B0); PG8_MMA(1, 1, At, B1); PG8_BAR; PG8_SCHED;
            PG8_LDB(B0, 1, 0); PG8_LDB(B1, 1, 1); PG8_SCHED; PG8_LDA(At, 1, 0); PG8_STAGE_A(PG8_SA(0, 1), a2, 1, last);
            PG8_WAIT_V(8); PG8_WAIT_L(0); PG8_BAR; PG8_MMA(0, 0, At, B0); PG8_MMA(0, 1, At, B1); PG8_BAR; PG8_SCHED;
            PG8_LDA(At, 1, 1); PG8_STAGE(PG8_SB(1, 0), b3, voffB); PG8_STAGE(PG8_SB(1, 1), b3 + hstepB, voffB); PG8_STAGE_A(PG8_SA(1, 0), a3, 0, last);
            PG8_WAIT_V(8); PG8_WAIT_L(0); PG8_BAR; PG8_MMA(1, 0, At, B0); PG8_MMA(1, 1, At, B1); PG8_BAR; PG8_SCHED;
            } else {
            PG8_LDB(B0, 0, 0); PG8_SCHED; PG8_LDA(At, 0, 0); PG8_STAGE(PG8_SA(1, 1), a1 + hstepA, voffA);
            PG8_WAIT_L(8); PG8_BAR; PG8_WAIT_L(0); PG8_MMA(0, 0, At, B0); PG8_BAR; PG8_SCHED;
            PG8_LDB(B1, 0, 1); PG8_STAGE(PG8_SB(0, 0), b2, voffB);
            PG8_BAR; PG8_WAIT_L(0); PG8_MMA(0, 1, At, B1); PG8_BAR;
            PG8_LDA(At, 0, 1); PG8_STAGE(PG8_SA(0, 0), a2, voffA);
            PG8_BAR; PG8_WAIT_L(0); PG8_MMA(1, 0, At, B0); PG8_BAR; PG8_SCHED;
            PG8_STAGE(PG8_SB(0, 1), b2 + hstepB, voffB);
            PG8_WAIT_V(6); PG8_BAR; PG8_MMA(1, 1, At, B1); PG8_BAR;
            PG8_LDB(B0, 1, 0); PG8_SCHED; PG8_LDA(At, 1, 0); PG8_STAGE(PG8_SA(0, 1), a2 + hstepA, voffA);
            PG8_WAIT_L(8); PG8_BAR; PG8_WAIT_L(0); PG8_MMA(0, 0, At, B0); PG8_BAR; PG8_SCHED;
            PG8_LDB(B1, 1, 1); PG8_STAGE(PG8_SB(1, 0), b3, voffB);
            PG8_BAR; PG8_WAIT_L(0); PG8_MMA(0, 1, At, B1); PG8_BAR;
            PG8_LDA(At, 1, 1); PG8_STAGE(PG8_SA(1, 0), a3, voffA);
            PG8_BAR; PG8_WAIT_L(0); PG8_MMA(1, 0, At, B0); PG8_BAR; PG8_SCHED;
            PG8_STAGE(PG8_SB(1, 1), b3 + hstepB, voffB);
            PG8_WAIT_V(6); PG8_BAR; PG8_MMA(1, 1, At, B1); PG8_BAR;
            }
        }
        if constexpr (ALIGN_EPI) { if (wr == 0) PG8_BAR; }
        const bool reset_acc = E(acc, cur, wr, wc, fr, fq);
        if (!has_next) break;
        if (reset_acc) {
#pragma unroll
        for (int a = 0; a < 2; ++a)
#pragma unroll
            for (int b = 0; b < 2; ++b)
#pragma unroll
                for (int m = 0; m < 4; ++m)
#pragma unroll
                    for (int n = 0; n < 2; ++n) acc[a][b][m][n] = (f32x4){0.f, 0.f, 0.f, 0.f};
        }
        cur = nxt; cA = nA; cB = nB; ++ui;
        if constexpr (GATHER) PG8_GCONV(gvo, gnx);
        if constexpr (ALIGN_EPI) { if (wr == 1) PG8_BAR; }
    }
    PG8_WAIT_V(0);
    if constexpr (!ALIGN_EPI) { if (wr == 0) PG8_BAR; }
    PG8_BAR;
#undef PG8_SA
#undef PG8_SB
#undef PG8_STAGE
#undef PG8_STAGE_A
#undef PG8_GCONV
#undef PG8_GLOAD
#undef PG8_LDA
#undef PG8_LDB
#undef PG8_MMA
#undef PG8_WAIT_V
#undef PG8_WAIT_L
#undef PG8_BAR
#undef PG8_SCHED
}
}

constexpr size_t MiB = 1u << 20;
constexpr size_t WS_CTL = 0, CTL_ZERO_BYTES = 1 * MiB;
constexpr size_t WS_WIN = 2 * MiB;
constexpr size_t WS_WCAT = WS_WIN + 30 * MiB;
constexpr size_t WS_WOUT = WS_WCAT + 6 * MiB;
constexpr size_t WS_WEI = WS_WOUT + 4 * MiB;
constexpr size_t WS_WEO = WS_WEI + 128 * MiB;
constexpr size_t WS_H = WS_WEO + 64 * MiB;
constexpr size_t WS_PROJ = WS_H + 32 * MiB;
constexpr size_t WS_Q = WS_PROJ + 240 * MiB;
constexpr size_t WS_K = WS_Q + 16 * MiB;
constexpr size_t WS_KMEAN = WS_K + 16 * MiB;
constexpr size_t WS_CAT = WS_KMEAN + 1 * MiB;
constexpr size_t WS_MERGED = WS_CAT + 48 * MiB;
constexpr size_t WS_ORAW = WS_MERGED + 32 * MiB;
constexpr size_t WS_ROUTE = WS_ORAW + 32 * MiB;
constexpr size_t WS_POS = WS_ROUTE + 1 * MiB;
constexpr size_t WS_HS = WS_POS + 1 * MiB;
constexpr size_t WS_ACT = WS_HS + 80 * MiB;
constexpr size_t WS_YS = WS_ACT + 40 * MiB;
constexpr size_t WS_XB = WS_YS + 80 * MiB;
constexpr size_t WS_GT = WS_XB + 32 * MiB;
constexpr size_t WS_END = WS_GT + 96 * MiB;
static_assert(WS_END <= 1000 * MiB, "workspace map");
constexpr int CW_BAR = 4096;
constexpr int CW_CNT = 16384;
constexpr int CW_NT = CW_CNT + 2 * 32 * 64;
constexpr int CW_TILE = CW_NT + 2 * 64;
static_assert((CW_TILE + 2 * 256) * 4 <= (int)CTL_ZERO_BYTES, "ctl");

constexpr int LDS_SCRATCH = 155136, LDSCTL_OFF = LDS_SCRATCH, LDS_BYTES = 155648;

#define GAS __attribute__((address_space(1)))
#define LAS __attribute__((address_space(3)))
typedef unsigned short bf16;
typedef unsigned v4u __attribute__((ext_vector_type(4)));
typedef unsigned v2u __attribute__((ext_vector_type(2)));
typedef float f32x4 __attribute__((ext_vector_type(4)));
typedef float f32x2 __attribute__((ext_vector_type(2)));
#define RLX_AGENT __ATOMIC_RELAXED, __HIP_MEMORY_SCOPE_AGENT
__device__ __forceinline__ unsigned f2bf(float f) { unsigned u = __builtin_bit_cast(unsigned, f); return (u + 0x7fffu + ((u >> 16) & 1u)) >> 16; }
__device__ __forceinline__ unsigned pk2(float lo, float hi) { unsigned r; asm("v_cvt_pk_bf16_f32 %0, %1, %2" : "=v"(r) : "v"(lo), "v"(hi)); return r; }
__device__ __forceinline__ float bflo(unsigned w) { return __uint_as_float(w << 16); }
__device__ __forceinline__ float bfhi(unsigned w) { return __uint_as_float(w & 0xffff0000u); }
__device__ __forceinline__ float bf2f(bf16 v) { return __uint_as_float((unsigned)v << 16); }
__device__ __forceinline__ float sigmoidf_(float x) { return __builtin_amdgcn_rcpf(1.0f + __expf(-x)); }
__device__ __forceinline__ float wave_sum(float v) {
    v += __int_as_float(__builtin_amdgcn_update_dpp(0, __float_as_int(v), 0xB1, 0xf, 0xf, true));
    v += __int_as_float(__builtin_amdgcn_update_dpp(0, __float_as_int(v), 0x4E, 0xf, 0xf, true));
    v += __int_as_float(__builtin_amdgcn_update_dpp(0, __float_as_int(v), 0x141, 0xf, 0xf, true));
    v += __int_as_float(__builtin_amdgcn_update_dpp(0, __float_as_int(v), 0x140, 0xf, 0xf, true));
    { auto r = __builtin_amdgcn_permlane16_swap(__float_as_uint(v), __float_as_uint(v), false, false); v = __uint_as_float(r[0]) + __uint_as_float(r[1]); }
    { auto r = __builtin_amdgcn_permlane32_swap(__float_as_uint(v), __float_as_uint(v), false, false); v = __uint_as_float(r[0]) + __uint_as_float(r[1]); }
    return v;
}

__device__ __forceinline__ void lds_barrier() { asm volatile("s_waitcnt lgkmcnt(0)\n\ts_barrier" ::: "memory"); }

#define XB_TMO      128
#define XB_XCNT(j)  (256  + 64 * (j))
#define XB_XSUB(j)  (1280 + 64 * (j))
#define XB_XGEN(j)  (2304 + 64 * (j))
#define XB_TOP      3328
#define XB_TOPGEN   3392
#define XCD_BAR_WORDS 3456
#define XB_SPIN_CAP (1u << 18)
__device__ __forceinline__ unsigned xb_ld(unsigned* p)              { return __hip_atomic_load(p, __ATOMIC_RELAXED, __HIP_MEMORY_SCOPE_AGENT); }
__device__ __forceinline__ unsigned xb_add(unsigned* p, unsigned v) { return __hip_atomic_fetch_add(p, v, __ATOMIC_RELAXED, __HIP_MEMORY_SCOPE_AGENT); }
__device__ __forceinline__ unsigned xb_xcc_id() { return (unsigned)__builtin_amdgcn_s_getreg((3 << 11) | 20) & 0xFu; }
#define XB_SPIN(cond, bar) do { unsigned _sp = 0; while (cond) { __builtin_amdgcn_s_sleep(1); \
    if ((++_sp & 255u) == 0u) { if (xb_ld(&(bar)[XB_TMO])) break; if (_sp > XB_SPIN_CAP) { atomicAdd(&(bar)[XB_TMO], 1u); break; } } } } while (0)
struct XcdBarrier { unsigned* bar; unsigned x; volatile LAS unsigned* st; };
__device__ __forceinline__ XcdBarrier xcd_barrier_post(unsigned* bar, volatile LAS unsigned* st) {
    XcdBarrier b; b.bar = bar; b.x = xb_xcc_id(); b.st = st;
    if (threadIdx.x == 0) (void)xb_add(&bar[XB_XCNT(b.x)], 1u);
    return b;
}
__device__ __forceinline__ void xcd_barrier_complete(unsigned* bar, unsigned x, unsigned& nloc, unsigned& nx) {
    const unsigned G = gridDim.x * gridDim.y * gridDim.z;
    unsigned sum, cnt, mine, sp = 0u;
    for (;;) {
        sum = 0u; cnt = 0u; mine = 0u;
#pragma unroll
        for (unsigned j = 0; j < 16; ++j) { const unsigned c = xb_ld(&bar[XB_XCNT(j)]); sum += c; cnt += (c > 0u) ? 1u : 0u; mine = (j == x) ? c : mine; }
        if (sum == G) break;
        __builtin_amdgcn_s_sleep(1);
        if ((++sp & 255u) == 0u) { if (xb_ld(&bar[XB_TMO])) break; if (sp > XB_SPIN_CAP) { atomicAdd(&bar[XB_TMO], 1u); break; } }
    }
    nloc = mine > 0u ? mine : 1u; nx = cnt > 0u ? cnt : 1u;
}
__device__ __forceinline__ void xcd_barrier(const XcdBarrier& b) {
    asm volatile("s_waitcnt vmcnt(0)" ::: "memory");
    __syncthreads();
    if (threadIdx.x == 0) {
        unsigned* bar = b.bar;
        __builtin_amdgcn_s_waitcnt(0);
        unsigned nloc = b.st[0], nx = b.st[1];
        if (nloc == 0u) { xcd_barrier_complete(bar, b.x, nloc, nx); b.st[0] = nloc; b.st[1] = nx; }
        const unsigned old = xb_add(&bar[XB_XSUB(b.x)], 1u);
        const unsigned gen = old / nloc;
        if (old + 1u == (gen + 1u) * nloc) {
            __builtin_amdgcn_fence(__ATOMIC_RELEASE, "agent");
            asm volatile("s_waitcnt vmcnt(0)" ::: "memory");
            const unsigned og = xb_add(&bar[XB_TOP], 1u);
            const unsigned tg = og / nx;
            if (og + 1u == (tg + 1u) * nx) xb_add(&bar[XB_TOPGEN], 1u);
            else XB_SPIN(xb_ld(&bar[XB_TOPGEN]) == tg, bar);
            __builtin_amdgcn_fence(__ATOMIC_ACQUIRE, "agent");
            xb_add(&bar[XB_XGEN(b.x)], 1u);
            asm volatile("s_waitcnt vmcnt(0)" ::: "memory");
        } else {
            XB_SPIN(xb_ld(&bar[XB_XGEN(b.x)]) == gen, bar);
            __builtin_amdgcn_fence(__ATOMIC_ACQUIRE, "agent");
            asm volatile("s_waitcnt vmcnt(0)" ::: "memory");
        }
    }
    __syncthreads();
}

struct Args { const float* in[23]; float* out; unsigned char* ws; int ph_lo, ph_hi; };
typedef const Args __attribute__((address_space(4))) CArgs;
enum InIdx { I_X = 0, I_MIXG, I_WIN, I_BGATE, I_QG, I_KG, I_LBL, I_HGG, I_CONVW, I_CONVB, I_CLNG, I_CLNB, I_WATT, I_WHGRN, I_WCONV, I_WOUT, I_FFNG, I_WCO, I_BCO, I_WFI, I_BFI, I_WEI, I_WEO };

struct Frame {
    unsigned char* lds;
    int tid, lane, wave, G, bid;
    unsigned char* ws; unsigned* ctl;
};
__device__ __forceinline__ int xcd_order(int bid, int G) { return (G % 8 == 0) ? (bid % 8) * (G / 8) + bid / 8 : bid; }
__device__ __forceinline__ int lane_id_asm() { int l; asm volatile("v_mbcnt_lo_u32_b32 %0, -1, 0\n\tv_mbcnt_hi_u32_b32 %0, -1, %0" : "=v"(l)); return l; }
__device__ __forceinline__ Frame fresh(Frame F) { asm volatile("" : "+v"(F.tid)); F.lane = F.tid & 63; return F; }

struct TItem { const float* W; bf16* WT; int K, N, k0, n0, drow0; };
__device__ __forceinline__ void titem_load(const TItem& t, int lane, float (&v)[32]) {
#pragma unroll
    for (int i = 0; i < 32; ++i) { const int kk = 2 * i + (lane >> 5); v[i] = __builtin_nontemporal_load(t.W + (size_t)(t.k0 + kk) * t.N + t.n0 + (lane & 31)); }
}
__device__ __forceinline__ void titem_emit(const TItem& t, int lane, const float (&v)[32], float* scr) {
#pragma unroll
    for (int i = 0; i < 32; ++i) { const int kk = 2 * i + (lane >> 5); scr[kk * 33 + (lane & 31)] = v[i]; }
    asm volatile("s_waitcnt lgkmcnt(0)" ::: "memory");
    const int c = lane & 7;
#pragma unroll
    for (int j = 0; j < 4; ++j) { const int n = (lane >> 3) + 8 * j; const float* s = scr + (8 * c) * 33 + n;
        v4u o; o.x = pk2(s[0 * 33], s[1 * 33]); o.y = pk2(s[2 * 33], s[3 * 33]); o.z = pk2(s[4 * 33], s[5 * 33]); o.w = pk2(s[6 * 33], s[7 * 33]);
        *(v4u*)(t.WT + (size_t)(t.drow0 + n) * t.K + t.k0 + 8 * c) = o; }
    asm volatile("s_waitcnt lgkmcnt(0)" ::: "memory");
}
__device__ __forceinline__ TItem titem_decode(CArgs& A, unsigned char* ws, int it) {
    constexpr int I_IN = (DM / 64) * (NCOL / 32), I_BR = (512 / 64) * (DM / 32), I_OUT = (DM / 64) * (DM / 32), I_EI = (DM / 64) * (1024 / 32), I_EO = (FF / 64) * (DM / 32);
    constexpr int PER_L = I_IN + 3 * I_BR + I_OUT + NEXP * I_EI + NEXP * I_EO;
    TItem t; const int l = it / PER_L; int r = it % PER_L;
    if (r < I_IN) { const int nblk = NCOL / 32, kb = r / nblk, nb = r % nblk;
        t.W = A.in[I_WIN] + (size_t)l * DM * NCOL; t.K = DM; t.N = NCOL; t.WT = (bf16*)(ws + WS_WIN) + (size_t)l * NCOL * DM; t.k0 = 64 * kb; t.n0 = 32 * nb; t.drow0 = 32 * nb; return t; }
    r -= I_IN;
    if (r < 3 * I_BR) { const int br = r / I_BR, rr = r % I_BR, nblk = DM / 32, kb = rr / nblk, nb = rr % nblk;
        t.W = A.in[br == 0 ? I_WATT : (br == 1 ? I_WHGRN : I_WCONV)] + (size_t)l * 512 * DM; t.K = 512; t.N = DM; t.WT = (bf16*)(ws + WS_WCAT) + ((size_t)l * 3 + br) * DM * 512; t.k0 = 64 * kb; t.n0 = 32 * nb; t.drow0 = 32 * nb; return t; }
    r -= 3 * I_BR;
    if (r < I_OUT) { const int nblk = DM / 32, kb = r / nblk, nb = r % nblk;
        t.W = A.in[I_WOUT] + (size_t)l * DM * DM; t.K = DM; t.N = DM; t.WT = (bf16*)(ws + WS_WOUT) + (size_t)l * DM * DM; t.k0 = 64 * kb; t.n0 = 32 * nb; t.drow0 = 32 * nb; return t; }
    r -= I_OUT;
    if (r < NEXP * I_EI) { const int e = r / I_EI, rr = r % I_EI, nblk = 1024 / 32, kb = rr / nblk, nb = rr % nblk, n0 = 32 * nb;
        const int nn = n0 & 511;
        t.W = A.in[I_WEI] + ((size_t)l * NEXP + e) * DM * 1024; t.K = DM; t.N = 1024; t.WT = (bf16*)(ws + WS_WEI) + ((size_t)l * NEXP + e) * 1024 * DM; t.k0 = 64 * kb; t.n0 = n0; t.drow0 = (nn >> 7) * 256 + (n0 >= 512 ? 128 : 0) + (nn & 127); return t; }
    r -= NEXP * I_EI;
    { const int e = r / I_EO, rr = r % I_EO, nblk = DM / 32, kb = rr / nblk, nb = rr % nblk;
        t.W = A.in[I_WEO] + ((size_t)l * NEXP + e) * FF * DM; t.K = FF; t.N = DM; t.WT = (bf16*)(ws + WS_WEO) + ((size_t)l * NEXP + e) * DM * FF; t.k0 = 64 * kb; t.n0 = 32 * nb; t.drow0 = 32 * nb; return t; }
}
__device__ __forceinline__ void phase_prologue(const Frame& F0, CArgs& A) {
    const Frame F = fresh(F0);
    float* scr = (float*)(F.lds + F.wave * 16384);
    const int gw = F.bid * 8 + F.wave, NGW = F.G * 8;
    constexpr int I_IN = (DM / 64) * (NCOL / 32), I_BR = (512 / 64) * (DM / 32), I_OUT = (DM / 64) * (DM / 32), I_EI = (DM / 64) * (1024 / 32), I_EO = (FF / 64) * (DM / 32);
    constexpr int NIT = DEPTH * (I_IN + 3 * I_BR + I_OUT + NEXP * I_EI + NEXP * I_EO);
    if (gw >= NIT) return;
    float cur[32], nxt[32];
    TItem tc = titem_decode(A, F.ws, gw);
    titem_load(tc, F.lane, cur);
    for (int it = gw; it < NIT; it += NGW) {
        TItem tn = tc; const bool more = (it + NGW < NIT);
        if (more) { tn = titem_decode(A, F.ws, it + NGW); titem_load(tn, F.lane, nxt); }
        titem_emit(tc, F.lane, cur, scr);
        if (more) {
#pragma unroll
            for (int i = 0; i < 32; ++i) cur[i] = nxt[i];
            tc = tn; }
    }
}

__device__ __forceinline__ void phase_norm(const Frame& F0, const float* x, const float* gain, bf16* out) {
    const Frame F = fresh(F0);
    const int gw = F.bid * 8 + F.wave, NGW = F.G * 8;
    f32x4 g[4];
#pragma unroll
    for (int j = 0; j < 4; ++j) g[j] = *(const f32x4*)(gain + 4 * F.lane + 256 * j);
    const int RPW = (T + NGW - 1) / NGW, mbase = (xcd_order(F.bid, F.G) * 8 + F.wave) * RPW;
    for (int r0 = 0; r0 < RPW; r0 += 4) {
        f32x4 v[4][4];
#pragma unroll
        for (int q = 0; q < 4; ++q) { const int m = (r0 + q < RPW) ? mbase + r0 + q : T; if (m < T) { const f32x4* xr = (const f32x4*)(x + (size_t)m * DM) + F.lane;
#pragma unroll
                for (int j = 0; j < 4; ++j) v[q][j] = xr[64 * j]; } }
#pragma unroll
        for (int q = 0; q < 4; ++q) { const int m = (r0 + q < RPW) ? mbase + r0 + q : T; if (m < T) { float s = 0.f;
#pragma unroll
                for (int j = 0; j < 4; ++j) s += (v[q][j].x * v[q][j].x + v[q][j].y * v[q][j].y) + (v[q][j].z * v[q][j].z + v[q][j].w * v[q][j].w);
                const float r = rsqrtf(wave_sum(s) * (1.f / DM) + RMS_EPS);
                v2u* o8 = (v2u*)(out + (size_t)m * DM) + F.lane;
#pragma unroll
                for (int j = 0; j < 4; ++j) { v2u w; w.x = pk2(v[q][j].x * r * g[j].x, v[q][j].y * r * g[j].y); w.y = pk2(v[q][j].z * r * g[j].z, v[q][j].w * r * g[j].w); o8[64 * j] = w; } } }
    }
}

__device__ __forceinline__ void phase_qkprep(const Frame& F0, const bf16* proj, const float* qg, const float* kg, bf16* Q, bf16* Kb, float* kmean) {
    const Frame F = fresh(F0);
    float* red = (float*)F.lds;
    float* red2 = red + 256 * 65;
    const int tok = F.tid >> 1, hf = F.tid & 1;
    float qgv[32], kgv[32];
#pragma unroll
    for (int i = 0; i < 8; ++i) { const f32x4 a = *(const f32x4*)(qg + hf * 32 + 4 * i), c = *(const f32x4*)(kg + hf * 32 + 4 * i);
        qgv[4 * i] = a.x; qgv[4 * i + 1] = a.y; qgv[4 * i + 2] = a.z; qgv[4 * i + 3] = a.w; kgv[4 * i] = c.x; kgv[4 * i + 1] = c.y; kgv[4 * i + 2] = c.z; kgv[4 * i + 3] = c.w; }
    for (int u = xcd_order(F.bid, F.G); u < 512; u += F.G) {
        const int b = u >> 6, blk = (u >> 3) & 7, h = u & 7;
        const size_t row = (size_t)b * SEQ + blk * 256 + tok;
        const bf16* pq = proj + row * NCOL + C_AQ + h * 64 + hf * 32;
        const bf16* pk = proj + row * NCOL + C_AK + h * 64 + hf * 32;
        float qv[32], kv[32];
#pragma unroll
        for (int i = 0; i < 4; ++i) { const v4u a = *(const v4u*)(pq + 8 * i), c = *(const v4u*)(pk + 8 * i);
            qv[8 * i + 0] = bflo(a.x); qv[8 * i + 1] = bfhi(a.x); qv[8 * i + 2] = bflo(a.y); qv[8 * i + 3] = bfhi(a.y); qv[8 * i + 4] = bflo(a.z); qv[8 * i + 5] = bfhi(a.z); qv[8 * i + 6] = bflo(a.w); qv[8 * i + 7] = bfhi(a.w);
            kv[8 * i + 0] = bflo(c.x); kv[8 * i + 1] = bfhi(c.x); kv[8 * i + 2] = bflo(c.y); kv[8 * i + 3] = bfhi(c.y); kv[8 * i + 4] = bflo(c.z); kv[8 * i + 5] = bfhi(c.z); kv[8 * i + 6] = bflo(c.w); kv[8 * i + 7] = bfhi(c.w); }
        float sq = 0.f, sk = 0.f;
#pragma unroll
        for (int i = 0; i < 32; ++i) { sq += qv[i] * qv[i]; sk += kv[i] * kv[i]; }
        sq += __shfl_xor(sq, 1); sk += __shfl_xor(sk, 1);
        const float rq = rsqrtf(sq * (1.f / 64.f) + RMS_EPS) * QSCALE, rk = rsqrtf(sk * (1.f / 64.f) + RMS_EPS);
#pragma unroll
        for (int i = 0; i < 32; ++i) { qv[i] = qv[i] * rq * qgv[i]; kv[i] = kv[i] * rk * kgv[i]; }
        bf16* oq = Q + row * 512 + h * 64 + hf * 32; bf16* ok = Kb + row * 512 + h * 64 + hf * 32;
#pragma unroll
        for (int i = 0; i < 4; ++i) { v4u a, c;
            a.x = pk2(qv[8 * i], qv[8 * i + 1]); a.y = pk2(qv[8 * i + 2], qv[8 * i + 3]); a.z = pk2(qv[8 * i + 4], qv[8 * i + 5]); a.w = pk2(qv[8 * i + 6], qv[8 * i + 7]);
            c.x = pk2(kv[8 * i], kv[8 * i + 1]); c.y = pk2(kv[8 * i + 2], kv[8 * i + 3]); c.z = pk2(kv[8 * i + 4], kv[8 * i + 5]); c.w = pk2(kv[8 * i + 6], kv[8 * i + 7]);
            *(v4u*)(oq + 8 * i) = a; *(v4u*)(ok + 8 * i) = c; }
        __syncthreads();
#pragma unroll
        for (int i = 0; i < 32; ++i) red[tok * 65 + hf * 32 + i] = kv[i];
        __syncthreads();
        { const int d = F.tid & 63, part = F.tid >> 6; float s = 0.f;
            for (int tk = 0; tk < 32; ++tk) s += red[(part * 32 + tk) * 65 + d];
            red2[part * 64 + d] = s; }
        __syncthreads();
        if (F.tid < 64) { float s = 0.f;
#pragma unroll
            for (int p = 0; p < 8; ++p) s += red2[p * 64 + F.tid];
            kmean[(((size_t)b * 8 + h) * 8 + blk) * 64 + F.tid] = s * (1.f / 256.f); }
    }
    __syncthreads();
}

__device__ __forceinline__ void phase_conv(const Frame& F0, const bf16* proj, const float* cw, const float* cb, const float* lng, const float* lnb, bf16* cat) {
    const Frame F = fresh(F0);
    float* ut = (float*)F.lds;
    const int c = F.tid;
    float w[31];
#pragma unroll
    for (int j = 0; j < 31; ++j) w[j] = cw[j * 512 + c];
    const float bias = cb[c];
    const f32x4 g0 = *(const f32x4*)(lng + 8 * F.lane), g1 = *(const f32x4*)(lng + 8 * F.lane + 4), b0 = *(const f32x4*)(lnb + 8 * F.lane), b1 = *(const f32x4*)(lnb + 8 * F.lane + 4);
    for (int u = xcd_order(F.bid, F.G); u < 512; u += F.G) {
        const int b = u >> 6, t0 = (u & 63) * 32;
        __syncthreads();
        {
            v4u av[8], gv[8];
#pragma unroll
            for (int i = 0; i < 8; ++i) { const int idx = F.tid + 512 * i, r = idx >> 6, ch = (idx & 63) * 8, t = t0 - 30 + r;
                if (r < 62 && t >= 0) { const bf16* p = proj + ((size_t)b * SEQ + t) * NCOL + ch; av[i] = *(const v4u*)(p + C_CA); gv[i] = *(const v4u*)(p + C_CB); }
                else { av[i] = (v4u){0u, 0u, 0u, 0u}; gv[i] = (v4u){0u, 0u, 0u, 0u}; } }
#pragma unroll
            for (int i = 0; i < 8; ++i) { const int idx = F.tid + 512 * i, r = idx >> 6, ch = (idx & 63) * 8;
                if (r < 62) {
                    f32x4 u0, u1;
                    u0.x = bflo(av[i].x) * sigmoidf_(bflo(gv[i].x)); u0.y = bfhi(av[i].x) * sigmoidf_(bfhi(gv[i].x)); u0.z = bflo(av[i].y) * sigmoidf_(bflo(gv[i].y)); u0.w = bfhi(av[i].y) * sigmoidf_(bfhi(gv[i].y));
                    u1.x = bflo(av[i].z) * sigmoidf_(bflo(gv[i].z)); u1.y = bfhi(av[i].z) * sigmoidf_(bfhi(gv[i].z)); u1.z = bflo(av[i].w) * sigmoidf_(bflo(gv[i].w)); u1.w = bfhi(av[i].w) * sigmoidf_(bfhi(gv[i].w));
                    *(f32x4*)(ut + r * 512 + ch) = u0; *(f32x4*)(ut + r * 512 + ch + 4) = u1; } }
        }
        __syncthreads();
        float uu[62];
#pragma unroll
        for (int i = 0; i < 62; ++i) uu[i] = ut[i * 512 + c];
#pragma unroll
        for (int t = 0; t < 32; ++t) { float a = bias;
#pragma unroll
            for (int j = 0; j < 31; ++j) a += w[j] * uu[t + j];
            ut[t * 512 + c] = a; }
        __syncthreads();
#pragma unroll
        for (int q = 0; q < 4; ++q) { const int t = F.wave * 4 + q;
            const f32x4 v0 = *(const f32x4*)(ut + t * 512 + 8 * F.lane), v1 = *(const f32x4*)(ut + t * 512 + 8 * F.lane + 4);
            const float mu = wave_sum((v0.x + v0.y) + (v0.z + v0.w) + (v1.x + v1.y) + (v1.z + v1.w)) * (1.f / 512.f);
            const f32x4 d0 = v0 - mu, d1 = v1 - mu;
            const float var = wave_sum((d0.x * d0.x + d0.y * d0.y) + (d0.z * d0.z + d0.w * d0.w) + (d1.x * d1.x + d1.y * d1.y) + (d1.z * d1.z + d1.w * d1.w)) * (1.f / 512.f);
            const float rs = rsqrtf(var + LN_EPS);
            f32x4 y0 = d0 * rs * g0 + b0, y1 = d1 * rs * g1 + b1;
            y0.x *= sigmoidf_(y0.x); y0.y *= sigmoidf_(y0.y); y0.z *= sigmoidf_(y0.z); y0.w *= sigmoidf_(y0.w);
            y1.x *= sigmoidf_(y1.x); y1.y *= sigmoidf_(y1.y); y1.z *= sigmoidf_(y1.z); y1.w *= sigmoidf_(y1.w);
            v4u o; o.x = pk2(y0.x, y0.y); o.y = pk2(y0.z, y0.w); o.z = pk2(y1.x, y1.y); o.w = pk2(y1.z, y1.w);
            *(v4u*)(cat + ((size_t)b * SEQ + t0 + t) * 1536 + 1024 + 8 * F.lane) = o; }
    }
    __syncthreads();
}

typedef float f32x16 __attribute__((ext_vector_type(16)));
typedef short bf16x8 __attribute__((ext_vector_type(8)));
typedef short v4i16_t __attribute__((ext_vector_type(4)));
constexpr int AT_KROW = 144, AT_VROW = 192, AT_KBUF = 64 * AT_KROW, AT_VBUF = 64 * AT_VROW, AT_BUF = AT_KBUF + AT_VBUF;
constexpr int AT_WSF = 2 * AT_BUF, AT_STG = AT_WSF + 8 * 256, AT_LDS = AT_STG + 8 * 4096;
__device__ __forceinline__ int crow16(int r, int hi) { return (r & 3) + 8 * (r >> 2) + 4 * hi; }
__device__ __forceinline__ void attn_mfma_unit(const Frame& F, LAS unsigned char* L, int b, int h, int qb, const bf16* Q, const bf16* Kb, const bf16* proj, const float* kmean, bf16* cat) {
    int lane_ = F.lane; asm volatile("" : "+v"(lane_));
    const int lane = lane_, r32 = lane & 31, hi = lane >> 5, wid = F.wave;
    const size_t row0 = (size_t)b * SEQ + qb * 256;
    const int qi = wid * 32 + r32;
    bf16x8 qf[4];
    { const bf16* pq = Q + (row0 + qi) * 512 + h * 64 + hi * 8;
#pragma unroll
        for (int d0 = 0; d0 < 4; ++d0) qf[d0] = *(const bf16x8*)(pq + d0 * 16); }
    unsigned selmask;
    if (qb <= 3) selmask = (1u << qb) - 1u;
    else {
        float b0 = -3.0e38f, b1 = -3.0e38f, b2 = -3.0e38f; int i0 = 0, i1 = 0, i2 = 0;
        float qv[32];
#pragma unroll
        for (int d0 = 0; d0 < 4; ++d0)
#pragma unroll
            for (int e = 0; e < 8; ++e) qv[d0 * 8 + e] = bf2f((bf16)qf[d0][e]);
#pragma unroll 1
        for (int j = 0; j < qb; ++j) { const float* km = kmean + (((size_t)b * 8 + h) * 8 + j) * 64 + hi * 8; float sacc = 0.f;
#pragma unroll
            for (int d0 = 0; d0 < 4; ++d0) { const f32x4 k0 = *(const f32x4*)(km + d0 * 16), k1 = *(const f32x4*)(km + d0 * 16 + 4);
                sacc += qv[d0 * 8 + 0] * k0.x + qv[d0 * 8 + 1] * k0.y + qv[d0 * 8 + 2] * k0.z + qv[d0 * 8 + 3] * k0.w + qv[d0 * 8 + 4] * k1.x + qv[d0 * 8 + 5] * k1.y + qv[d0 * 8 + 6] * k1.z + qv[d0 * 8 + 7] * k1.w; }
            sacc += __shfl_xor(sacc, 32);
            if (sacc > b0) { b2 = b1; i2 = i1; b1 = b0; i1 = i0; b0 = sacc; i0 = j; }
            else if (sacc > b1) { b2 = b1; i2 = i1; b1 = sacc; i1 = j; }
            else if (sacc > b2) { b2 = sacc; i2 = j; } }
        selmask = (1u << i0) | (1u << i1) | (1u << i2);
    }
    const int tid_l = wid * 64 + lane, srow = tid_l >> 3, sch = tid_l & 7;
    const bf16* kg = Kb + ((size_t)b * SEQ + srow) * 512 + h * 64 + sch * 8;
    const bf16* vg = proj + ((size_t)b * SEQ + srow) * NCOL + C_AV + h * 64 + sch * 8;
    const int kst = srow * AT_KROW + sch * 16, vst = AT_KBUF + srow * AT_VROW + sch * 16;
    const int kfo = r32 * AT_KROW + hi * 16;
    const int g16 = lane >> 4, idx = lane & 15;
    const int vfo = AT_KBUF + (4 * (g16 >> 1) + (idx >> 2)) * AT_VROW + ((g16 & 1) * 16 + 4 * (idx & 3)) * 2;
    const int NT = 4 * (qb + 1);
    f32x16 o0 = {}, o1 = {};
    float lsum = 0.f;
    v4u kA = {}, vA = {}, kB, vB;
    { const v4u kk = *(const v4u*)kg, vv = *(const v4u*)vg;
        kB = *(const v4u*)(kg + (size_t)64 * 512); vB = *(const v4u*)(vg + (size_t)64 * NCOL);
        *(LAS v4u*)(L + kst) = kk; *(LAS v4u*)(L + vst) = vv; }
    lds_barrier();
#define AT_TILE(OWN, TT, PAR, KL, VL, KW, VW) do { \
        const int t_ = (TT); constexpr int cb = (PAR) * AT_BUF, nb = AT_BUF - cb;        \
        if (t_ + 2 < NT) { KL = *(const v4u*)(kg + (size_t)(t_ + 2) * 64 * 512); VL = *(const v4u*)(vg + (size_t)(t_ + 2) * 64 * NCOL); } \
        const int j = t_ >> 2, kt = t_ & 3; \
        const bool active = !(OWN) || (kt * 64 <= wid * 32 + 31); \
        if (active) { \
            f32x16 s0, s1; \
            { const float bias = ((OWN) || (((selmask >> j) & 1u) != 0u)) ? 0.f : -1.0e30f; \
                _Pragma("unroll") for (int r = 0; r < 16; ++r) { s0[r] = bias; s1[r] = bias; } } \
            bf16x8 kf[8]; \
            _Pragma("unroll") for (int d0 = 0; d0 < 4; ++d0) { kf[d0] = *(const LAS bf16x8*)(L + cb + kfo + d0 * 32); kf[4 + d0] = *(const LAS bf16x8*)(L + cb + kfo + 32 * AT_KROW + d0 * 32); } \
            _Pragma("unroll") for (int d0 = 0; d0 < 4; ++d0) { \
                s0 = __builtin_amdgcn_mfma_f32_32x32x16_bf16(kf[d0], qf[d0], s0, 0, 0, 0); \
                s1 = __builtin_amdgcn_mfma_f32_32x32x16_bf16(kf[4 + d0], qf[d0], s1, 0, 0, 0); } \
            v4i16_t va[16]; \
            _Pragma("unroll") for (int sub = 0; sub < 2; ++sub) \
                _Pragma("unroll") for (int sI = 0; sI < 2; ++sI) { const int vb = cb + vfo + (sub * 32 + 16 * sI) * AT_VROW, q4 = (sub * 2 + sI) * 4; \
                    va[q4 + 0] = __builtin_amdgcn_ds_read_tr16_b64_v4i16((LAS v4i16_t*)(L + vb)); va[q4 + 1] = __builtin_amdgcn_ds_read_tr16_b64_v4i16((LAS v4i16_t*)(L + vb + 8 * AT_VROW)); \
                    va[q4 + 2] = __builtin_amdgcn_ds_read_tr16_b64_v4i16((LAS v4i16_t*)(L + vb + 64)); va[q4 + 3] = __builtin_amdgcn_ds_read_tr16_b64_v4i16((LAS v4i16_t*)(L + vb + 8 * AT_VROW + 64)); } \
            __builtin_amdgcn_sched_barrier(0); \
            float ps = 0.f; \
            if (OWN) { const int lim = qi - kt * 64; \
                _Pragma("unroll") for (int r = 0; r < 16; ++r) { const int kv = crow16(r, hi); \
                    const float p0 = (kv <= lim) ? __builtin_amdgcn_exp2f(s0[r]) : 0.f, p1 = (kv + 32 <= lim) ? __builtin_amdgcn_exp2f(s1[r]) : 0.f; \
                    s0[r] = p0; s1[r] = p1; ps += p0 + p1; } \
            } else { \
                _Pragma("unroll") for (int r = 0; r < 16; ++r) { const float p0 = __builtin_amdgcn_exp2f(s0[r]), p1 = __builtin_amdgcn_exp2f(s1[r]); s0[r] = p0; s1[r] = p1; ps += p0 + p1; } } \
            lsum += ps; \
            bf16x8 pa[4]; \
            _Pragma("unroll") for (int sI = 0; sI < 2; ++sI) { v4u w0, w1; \
                w0.x = pg8::cvt_pk_bf16(s0[8 * sI + 0], s0[8 * sI + 1]); w0.y = pg8::cvt_pk_bf16(s0[8 * sI + 2], s0[8 * sI + 3]); w0.z = pg8::cvt_pk_bf16(s0[8 * sI + 4], s0[8 * sI + 5]); w0.w = pg8::cvt_pk_bf16(s0[8 * sI + 6], s0[8 * sI + 7]); \
                w1.x = pg8::cvt_pk_bf16(s1[8 * sI + 0], s1[8 * sI + 1]); w1.y = pg8::cvt_pk_bf16(s1[8 * sI + 2], s1[8 * sI + 3]); w1.z = pg8::cvt_pk_bf16(s1[8 * sI + 4], s1[8 * sI + 5]); w1.w = pg8::cvt_pk_bf16(s1[8 * sI + 6], s1[8 * sI + 7]); \
                pa[sI] = __builtin_bit_cast(bf16x8, w0); pa[2 + sI] = __builtin_bit_cast(bf16x8, w1); } \
            _Pragma("unroll") for (int q = 0; q < 4; ++q) { \
                const bf16x8 v0 = (bf16x8){va[4 * q][0], va[4 * q][1], va[4 * q][2], va[4 * q][3], va[4 * q + 1][0], va[4 * q + 1][1], va[4 * q + 1][2], va[4 * q + 1][3]}; \
                const bf16x8 v1 = (bf16x8){va[4 * q + 2][0], va[4 * q + 2][1], va[4 * q + 2][2], va[4 * q + 2][3], va[4 * q + 3][0], va[4 * q + 3][1], va[4 * q + 3][2], va[4 * q + 3][3]}; \
                o0 = __builtin_amdgcn_mfma_f32_32x32x16_bf16(pa[q], v0, o0, 0, 0, 0); \
                o1 = __builtin_amdgcn_mfma_f32_32x32x16_bf16(pa[q], v1, o1, 0, 0, 0); } \
        } \
        if (t_ + 1 < NT) { *(LAS v4u*)(L + nb + kst) = KW; *(LAS v4u*)(L + nb + vst) = VW; } \
        lds_barrier(); \
    } while (0)
    int t = 0;
#pragma unroll 1
    for (; t < NT - 4; t += 2) { AT_TILE(false, t, 0, kA, vA, kB, vB); AT_TILE(false, t + 1, 1, kB, vB, kA, vA); }
#pragma unroll 1
    for (; t < NT; t += 2) { AT_TILE(true, t, 0, kA, vA, kB, vB); AT_TILE(true, t + 1, 1, kB, vB, kA, vA); }
#undef AT_TILE
    lsum += __shfl_xor(lsum, 32);
    LAS float* wsf = (LAS float*)(L + AT_WSF + wid * 256);
    if (hi == 0) wsf[r32] = lsum;
    asm volatile("s_waitcnt lgkmcnt(0)" ::: "memory");
    LAS bf16* stg = (LAS bf16*)(L + AT_STG + wid * 4096);
#pragma unroll
    for (int r = 0; r < 16; ++r) { const int orow = crow16(r, hi); const float rl = 1.f / wsf[orow];
        stg[orow * 64 + r32] = (bf16)f2bf(o0[r] * rl); stg[orow * 64 + 32 + r32] = (bf16)f2bf(o1[r] * rl); }
    asm volatile("s_waitcnt lgkmcnt(0)" ::: "memory");
    bf16* po = cat + (row0 + wid * 32) * 1536 + h * 64;
#pragma unroll
    for (int i = 0; i < 4; ++i) { const int row = i * 8 + (lane >> 3), ch = lane & 7; const v4u v = *(const LAS v4u*)(stg + row * 64 + ch * 8); *(v4u*)(po + (size_t)row * 1536 + ch * 8) = v; }
    lds_barrier();
}
__device__ __forceinline__ void phase_attn_mfma(const Frame& F0, const bf16* Q, const bf16* Kb, const bf16* proj, const float* kmean, bf16* cat) {
    const Frame F = fresh(F0);
    LAS unsigned char* L = (LAS unsigned char*)F.lds;
    for (int p = xcd_order(F.bid, F.G); p < 256; p += F.G) {
        const int bh = p >> 2, s = p & 3;
#pragma unroll 1
        for (int i = 0; i < 2; ++i) attn_mfma_unit(F, L, bh >> 3, bh & 7, i ? s : 7 - s, Q, Kb, proj, kmean, cat);
    }
}

template <bool PERM> __device__ __forceinline__ bf16x8 tr_frag(LAS unsigned char* tile, int pitch, int rbase, int cbase, int lane) {
    const int g16 = lane >> 4, idx = lane & 15, h = g16 >> 1;
    LAS unsigned char* p = tile + (rbase + (PERM ? 4 : 8) * h + (idx >> 2)) * pitch + (cbase + (g16 & 1) * 16 + 4 * (idx & 3)) * 2;
    const v4i16_t a0 = __builtin_amdgcn_ds_read_tr16_b64_v4i16((LAS v4i16_t*)p), a1 = __builtin_amdgcn_ds_read_tr16_b64_v4i16((LAS v4i16_t*)(p + (PERM ? 8 : 4) * pitch));
    return (bf16x8){a0[0], a0[1], a0[2], a0[3], a1[0], a1[1], a1[2], a1[3]};
}
constexpr int H1_G = 0, H1_QD = 32768, H1_KD = H1_QD + 64 * 272, H1_KE = H1_KD + 64 * 272, H1_VT = H1_KE + 64 * 320, H1_SP = H1_VT + 64 * 320, H1_TOT = H1_SP + 128 * 320, H1_BO = H1_TOT + 2048, H1_LB = H1_BO + 512, H1_CK = H1_LB + 512, H1_END = H1_CK + 2048;
static_assert(H1_END <= LDS_SCRATCH, "hgrn pass 1 lds");
__device__ __forceinline__ void hgrn_pass1_unit(const Frame& F, LAS unsigned char* L, int u, const bf16* proj, const float* lbl, int layer, float* Lg, float* Dg, float* OL, bf16* Qb) {
    const int b = u >> 5, h = (u >> 3) & 3, blk = u & 7;
    const int lane = F.lane, r32 = lane & 31, hi = lane >> 5, wid = F.wave, tid = F.tid;
    const int tt = tid >> 3, cg = tid & 7, ch = cg * 16;
    LAS float* G = (LAS float*)(L + H1_G); LAS float* TOT = (LAS float*)(L + H1_TOT);
    LAS float* BO = (LAS float*)(L + H1_BO); LAS float* LB = (LAS float*)(L + H1_LB); LAS float* CK = (LAS float*)(L + H1_CK);
    if (tid < 128) { float lb = 0.f;
        if (layer > 0) { const float l0 = lbl[h * 128 + tid], l1 = lbl[512 + h * 128 + tid]; lb = 1.f / (1.f + __expf(l0 - l1)); }
        LB[tid] = lb; BO[tid] = 0.f; }
    lds_barrier();
    f32x16 S[2]; S[0] = (f32x16){}; S[1] = (f32x16){};
    const size_t rowb = (size_t)b * SEQ + blk * 256;
    const int tt2 = wid >> 2, vt = wid & 3;
    v4u nx[6];
    { const bf16* pr = proj + (rowb + tt) * NCOL + h * 128 + ch;
        nx[0] = *(const v4u*)(pr + C_HF); nx[1] = *(const v4u*)(pr + C_HF + 8); nx[2] = *(const v4u*)(pr + C_HQ); nx[3] = *(const v4u*)(pr + C_HQ + 8); nx[4] = *(const v4u*)(pr + C_HI); nx[5] = *(const v4u*)(pr + C_HI + 8); }
    for (int c = 0; c < 4; ++c) {
        const size_t row = rowb + c * 64 + tt;
        float kk[16], qa[16];
        {
            const v4u f0 = nx[0], f1 = nx[1], q0 = nx[2], q1 = nx[3], v0 = nx[4], v1 = nx[5];
            if (c < 3) { const bf16* pr = proj + (row + 64) * NCOL + h * 128 + ch;
                nx[0] = *(const v4u*)(pr + C_HF); nx[1] = *(const v4u*)(pr + C_HF + 8); nx[2] = *(const v4u*)(pr + C_HQ); nx[3] = *(const v4u*)(pr + C_HQ + 8); nx[4] = *(const v4u*)(pr + C_HI); nx[5] = *(const v4u*)(pr + C_HI + 8); }
            const unsigned fw[8] = {f0.x, f0.y, f0.z, f0.w, f1.x, f1.y, f1.z, f1.w}, qw[8] = {q0.x, q0.y, q0.z, q0.w, q1.x, q1.y, q1.z, q1.w};
            float gl[16], lbv[16];
#pragma unroll
            for (int i = 0; i < 4; ++i) { const f32x4 x = *(const LAS f32x4*)(LB + ch + 4 * i); lbv[4 * i] = x.x; lbv[4 * i + 1] = x.y; lbv[4 * i + 2] = x.z; lbv[4 * i + 3] = x.w; }
#pragma unroll
            for (int i = 0; i < 16; ++i) { const float fr = (i & 1) ? bfhi(fw[i >> 1]) : bflo(fw[i >> 1]); const float sig = sigmoidf_(fr);
                gl[i] = __logf(lbv[i] + (1.f - lbv[i]) * sig); kk[i] = (1.f - lbv[i]) * (1.f - sig);
                const float qv = (i & 1) ? bfhi(qw[i >> 1]) : bflo(qw[i >> 1]); qa[i] = qv * sigmoidf_(qv); }
#pragma unroll
            for (int i = 0; i < 4; ++i) *(LAS f32x4*)(G + tt * 128 + ch + 4 * i) = (f32x4){gl[4 * i], gl[4 * i + 1], gl[4 * i + 2], gl[4 * i + 3]};
            *(LAS v4u*)(L + H1_VT + tt * 320 + ch * 2) = v0; *(LAS v4u*)(L + H1_VT + tt * 320 + ch * 2 + 16) = v1;
        }
        lds_barrier();
        {
            const int k = tid & 127, part = tid >> 7; float a[16];
#pragma unroll
            for (int i = 0; i < 16; ++i) a[i] = G[(part * 16 + i) * 128 + k];
#pragma unroll
            for (int i = 1; i < 16; ++i) a[i] += a[i - 1];
            TOT[part * 128 + k] = a[15];
            lds_barrier();
            float pre = 0.f;
#pragma unroll
            for (int p = 0; p < 3; ++p) if (p < part) pre += TOT[p * 128 + k];
#pragma unroll
            for (int i = 0; i < 16; ++i) G[(part * 16 + i) * 128 + k] = a[i] + pre;
            if (part == 3) {
                const float bmk = TOT[k] + TOT[128 + k], bek = pre + a[15];
                CK[k] = __expf(bmk); CK[128 + k] = __expf(bek); CK[256 + k] = __expf(bek - bmk); CK[384 + k] = __expf(BO[k] + bmk); }
        }
        lds_barrier();
        {
#pragma unroll
            for (int hh = 0; hh < 2; ++hh) {
                float bb[8], bm[8], cem[8], com[8];
#pragma unroll
                for (int i = 0; i < 2; ++i) { const f32x4 x = *(const LAS f32x4*)(G + tt * 128 + ch + 8 * hh + 4 * i), y = *(const LAS f32x4*)(G + 31 * 128 + ch + 8 * hh + 4 * i), z = *(const LAS f32x4*)(CK + 256 + ch + 8 * hh + 4 * i), o4 = *(const LAS f32x4*)(CK + 384 + ch + 8 * hh + 4 * i);
                    bb[4 * i] = x.x; bb[4 * i + 1] = x.y; bb[4 * i + 2] = x.z; bb[4 * i + 3] = x.w; bm[4 * i] = y.x; bm[4 * i + 1] = y.y; bm[4 * i + 2] = y.z; bm[4 * i + 3] = y.w;
                    cem[4 * i] = z.x; cem[4 * i + 1] = z.y; cem[4 * i + 2] = z.z; cem[4 * i + 3] = z.w; com[4 * i] = o4.x; com[4 * i + 1] = o4.y; com[4 * i + 2] = o4.z; com[4 * i + 3] = o4.w; }
                float ex[8], rex[8], t8[8]; v4u w;
#pragma unroll
                for (int i = 0; i < 8; ++i) { ex[i] = __expf(bb[i] - bm[i]); rex[i] = __builtin_amdgcn_rcpf(ex[i]); }
#pragma unroll
                for (int i = 0; i < 8; ++i) t8[i] = kk[8 * hh + i] * rex[i] * cem[i];
                w.x = pk2(t8[0], t8[1]); w.y = pk2(t8[2], t8[3]); w.z = pk2(t8[4], t8[5]); w.w = pk2(t8[6], t8[7]); *(LAS v4u*)(L + H1_KE + tt * 320 + ch * 2 + 16 * hh) = w;
#pragma unroll
                for (int i = 0; i < 8; ++i) t8[i] = qa[8 * hh + i] * ex[i];
                w.x = pk2(t8[0], t8[1]); w.y = pk2(t8[2], t8[3]); w.z = pk2(t8[4], t8[5]); w.w = pk2(t8[6], t8[7]); *(LAS v4u*)(L + H1_QD + tt * 272 + ch * 2 + 16 * hh) = w;
#pragma unroll
                for (int i = 0; i < 8; ++i) t8[i] = kk[8 * hh + i] * rex[i];
                w.x = pk2(t8[0], t8[1]); w.y = pk2(t8[2], t8[3]); w.z = pk2(t8[4], t8[5]); w.w = pk2(t8[6], t8[7]); *(LAS v4u*)(L + H1_KD + tt * 272 + ch * 2 + 16 * hh) = w;
#pragma unroll
                for (int i = 0; i < 8; ++i) t8[i] = qa[8 * hh + i] * ex[i] * com[i];
                w.x = pk2(t8[0], t8[1]); w.y = pk2(t8[2], t8[3]); w.z = pk2(t8[4], t8[5]); w.w = pk2(t8[6], t8[7]); *(v4u*)(Qb + row * 512 + h * 128 + ch + 8 * hh) = w;
                __builtin_amdgcn_sched_barrier(0);
            }
#pragma unroll
            for (int i = 0; i < 2; ++i) { const int id = 2 * wid + i, kt = id >> 2, v2 = id & 3;
#pragma unroll
                for (int r = 0; r < 16; ++r) { const int k = kt * 32 + crow16(r, hi); *(LAS bf16*)(L + H1_SP + k * 320 + (v2 * 32 + r32) * 2) = (bf16)(pk2(S[i][r] * CK[k], 0.f) & 0xffffu); } }
        }
        lds_barrier();
        {
            if (tid < 128) BO[tid] += G[63 * 128 + tid];
            f32x16 o = {};
            bf16x8 qf[8];
#pragma unroll
            for (int k0 = 0; k0 < 8; ++k0) qf[k0] = *(const LAS bf16x8*)(L + H1_QD + (tt2 * 32 + r32) * 272 + (k0 * 16 + 8 * hi) * 2);
#pragma unroll
            for (int k0 = 0; k0 < 8; ++k0) o = __builtin_amdgcn_mfma_f32_32x32x16_bf16(qf[k0], tr_frag<false>(L + H1_SP, 320, k0 * 16, vt * 32, lane), o, 0, 0, 0);
#pragma unroll
            for (int sg = 0; sg < 2; ++sg) if (sg <= tt2) {
                f32x16 sc = {};
#pragma unroll
                for (int k0 = 0; k0 < 8; ++k0) { const bf16x8 kf = *(const LAS bf16x8*)(L + H1_KD + (sg * 32 + r32) * 272 + (k0 * 16 + 8 * hi) * 2); sc = __builtin_amdgcn_mfma_f32_32x32x16_bf16(kf, qf[k0], sc, 0, 0, 0); }
                if (sg == tt2) {
#pragma unroll
                    for (int r = 0; r < 16; ++r) sc[r] = (crow16(r, hi) <= r32) ? sc[r] : 0.f; }
#pragma unroll
                for (int sI = 0; sI < 2; ++sI) { v4u w; w.x = pg8::cvt_pk_bf16(sc[8 * sI + 0], sc[8 * sI + 1]); w.y = pg8::cvt_pk_bf16(sc[8 * sI + 2], sc[8 * sI + 3]); w.z = pg8::cvt_pk_bf16(sc[8 * sI + 4], sc[8 * sI + 5]); w.w = pg8::cvt_pk_bf16(sc[8 * sI + 6], sc[8 * sI + 7]);
                    o = __builtin_amdgcn_mfma_f32_32x32x16_bf16(__builtin_bit_cast(bf16x8, w), tr_frag<true>(L + H1_VT, 320, sg * 32 + 16 * sI, vt * 32, lane), o, 0, 0, 0); }
            }
            float* po = OL + (rowb + c * 64 + tt2 * 32) * 512 + h * 128 + vt * 32 + r32;
#pragma unroll
            for (int r = 0; r < 16; ++r) po[(size_t)crow16(r, hi) * 512] = o[r];
#pragma unroll
            for (int i = 0; i < 2; ++i) { const int id = 2 * wid + i, kt = id >> 2, v2 = id & 3;
#pragma unroll
                for (int r = 0; r < 16; ++r) S[i][r] *= CK[128 + kt * 32 + crow16(r, hi)];
#pragma unroll
                for (int s4 = 0; s4 < 4; ++s4) S[i] = __builtin_amdgcn_mfma_f32_32x32x16_bf16(tr_frag<true>(L + H1_KE, 320, 16 * s4, kt * 32, lane), tr_frag<true>(L + H1_VT, 320, 16 * s4, v2 * 32, lane), S[i], 0, 0, 0); }
        }
        lds_barrier();
    }
#pragma unroll
    for (int i = 0; i < 2; ++i) { const int id = 2 * wid + i, kt = id >> 2, v2 = id & 3;
#pragma unroll
        for (int r = 0; r < 16; ++r) Lg[(size_t)u * 16384 + (kt * 32 + crow16(r, hi)) * 128 + v2 * 32 + r32] = S[i][r]; }
    if (tid < 128) Dg[(size_t)u * 128 + tid] = __expf(BO[tid]);
}
constexpr int H2_SL = 0, H2_OB = 128 * 320, H2_END = H2_OB + 128 * 128 * 4;
__device__ __forceinline__ void hgrn_pass2_unit(const Frame& F, LAS unsigned char* L, int u, const bf16* proj, const float* gnorm, const float* Lg, const float* Dg, const float* OL, const bf16* Qb, bf16* cat, int dry) {
    const int b = u >> 5, h = (u >> 3) & 3, blk = u & 7;
    const int lane = F.lane, r32 = lane & 31, hi = lane >> 5, wid = F.wave, tid = F.tid;
    const size_t rowb = (size_t)b * SEQ + blk * 256;
    LAS float* OB = (LAS float*)(L + H2_OB);
    if (blk > 0 && dry != 1) {
#pragma unroll 1
        for (int jh = 0; jh < 4; ++jh) {
            f32x4 l4[7][2]; float dd[7][2];
#pragma unroll
            for (int pb = 0; pb < 7; ++pb)
#pragma unroll
                for (int j = 0; j < 2; ++j) { const int e4 = tid + 512 * (2 * jh + j), k = e4 >> 5;
                    if (pb < blk) { dd[pb][j] = *(const float*)((const char*)(Dg + (size_t)(u - blk + pb) * 128) + (unsigned)k * 4u); l4[pb][j] = *(const f32x4*)((const char*)(Lg + (size_t)(u - blk + pb) * 16384) + (unsigned)e4 * 16u); }
                    else { dd[pb][j] = 0.f; l4[pb][j] = (f32x4){0.f, 0.f, 0.f, 0.f}; } }
#pragma unroll
            for (int j = 0; j < 2; ++j) { const int e4 = tid + 512 * (2 * jh + j), k = e4 >> 5, v4 = (e4 & 31) * 4; f32x4 S = {0.f, 0.f, 0.f, 0.f};
#pragma unroll
                for (int pb = 0; pb < 7; ++pb) if (pb < blk) S = S * dd[pb][j] + l4[pb][j];
                v2u w; w.x = pk2(S.x, S.y); w.y = pk2(S.z, S.w); *(LAS v2u*)(L + H2_SL + k * 320 + v4 * 2) = w; } } }
    lds_barrier();
    const int ttp = tid >> 2, cq = tid & 3, vt = wid & 3;
    float gn[32];
#pragma unroll
    for (int i = 0; i < 8; ++i) { const f32x4 g = *(const f32x4*)(gnorm + cq * 32 + 4 * i); gn[4 * i] = g.x; gn[4 * i + 1] = g.y; gn[4 * i + 2] = g.z; gn[4 * i + 3] = g.w; }
    for (int hf = 0; hf < 2; ++hf) {
        const size_t rowp = rowb + hf * 128 + ttp;
        v4u hg[4];
#pragma unroll
        for (int i = 0; i < 4; ++i) hg[i] = *(const v4u*)(proj + rowp * NCOL + C_HG + h * 128 + cq * 32 + 8 * i);
#pragma unroll
        for (int j = 0; j < 2; ++j) { const int tl = (wid >> 2) + 2 * j;
            const size_t trow = rowb + hf * 128 + tl * 32;
            f32x16 o = {};
            bf16x8 af[8]; float olv[16];
            const float* pl = OL + trow * 512 + h * 128 + vt * 32 + r32;
            if (blk > 0) {
#pragma unroll
                for (int k0 = 0; k0 < 8; ++k0) af[k0] = *(const bf16x8*)(Qb + (trow + r32) * 512 + h * 128 + k0 * 16 + 8 * hi); }
#pragma unroll
            for (int r = 0; r < 16; ++r) olv[r] = pl[(size_t)crow16(r, hi) * 512];
            __builtin_amdgcn_sched_barrier(0);
            if (blk > 0 && dry != 2) {
#pragma unroll
                for (int k0 = 0; k0 < 8; ++k0) o = __builtin_amdgcn_mfma_f32_32x32x16_bf16(af[k0], tr_frag<false>(L + H2_SL, 320, k0 * 16, vt * 32, lane), o, 0, 0, 0); }
#pragma unroll
            for (int r = 0; r < 16; ++r) { const int t = crow16(r, hi); OB[(tl * 32 + t) * 128 + vt * 32 + r32] = o[r] + olv[r]; } }
        lds_barrier();
        {
            float ov[32]; float ss = 0.f;
#pragma unroll
            for (int i = 0; i < 8; ++i) { const f32x4 x = *(const LAS f32x4*)(OB + ttp * 128 + cq * 32 + 4 * i); ov[4 * i] = x.x; ov[4 * i + 1] = x.y; ov[4 * i + 2] = x.z; ov[4 * i + 3] = x.w; ss += (x.x * x.x + x.y * x.y) + (x.z * x.z + x.w * x.w); }
            ss += __shfl_xor(ss, 1); ss += __shfl_xor(ss, 2);
            const float rn = rsqrtf(ss * (1.f / 128.f) + RMS_EPS);
#pragma unroll
            for (int i = 0; i < 4; ++i) { const unsigned gw[4] = {hg[i].x, hg[i].y, hg[i].z, hg[i].w}; float y[8];
#pragma unroll
                for (int e = 0; e < 8; ++e) { const float gv = (e & 1) ? bfhi(gw[e >> 1]) : bflo(gw[e >> 1]); y[e] = ov[8 * i + e] * rn * gn[8 * i + e] * (gv * sigmoidf_(gv)); }
                v4u w; w.x = pk2(y[0], y[1]); w.y = pk2(y[2], y[3]); w.z = pk2(y[4], y[5]); w.w = pk2(y[6], y[7]);
                *(v4u*)(cat + rowp * 1536 + 512 + h * 128 + cq * 32 + 8 * i) = w; }
        }
        lds_barrier();
    }
}
__device__ __forceinline__ void phase_hgrn1(const Frame& F0, const bf16* proj, const float* lbl, int layer, float* Lg, float* Dg, float* OL, bf16* Qb) {
    const Frame F = fresh(F0);
    LAS unsigned char* L = (LAS unsigned char*)F.lds;
    for (int u = xcd_order(F.bid, F.G); u < 256; u += F.G) { hgrn_pass1_unit(F, L, u, proj, lbl, layer, Lg, Dg, OL, Qb); __syncthreads(); }
}
__device__ __forceinline__ void phase_hgrn2(const Frame& F0, const bf16* proj, const float* gnorm, const float* Lg, const float* Dg, const float* OL, const bf16* Qb, bf16* cat, int dry) {
    const Frame F = fresh(F0);
    LAS unsigned char* L = (LAS unsigned char*)F.lds;
    for (int u = xcd_order(F.bid, F.G); u < 256; u += F.G) { hgrn_pass2_unit(F, L, u, proj, gnorm, Lg, Dg, OL, Qb, cat, dry); __syncthreads(); }
}

struct SchedDense {
    const char* A; const char* B; int nM, nN, G, c; size_t ta, tb;
    __device__ __forceinline__ bool next(int i, pg8::Unit& u) const {
        int pm, pn; if (!pg8::static_tile(nM, nN, (long)i * G + c, pm, pn)) return false;
        u.pm = pm; u.pn = pn; u.aux = 0; u.pad = 0; u.a = A + (size_t)pm * ta; u.b = B + (size_t)pn * tb; u.gidx = nullptr; return true; }
};
struct SchedBranch {
    const char* A; const char* B; int G, c;
    __device__ __forceinline__ bool next(int i, pg8::Unit& u) const {
        int pm, pn; if (!pg8::static_tile(T / 256, DM / 256, (long)(i / 3) * G + c, pm, pn)) return false;
        const int seg = i % 3;
        u.pm = pm; u.pn = pn; u.aux = seg; u.pad = 0; u.a = A + ((size_t)pm * 256 * 1536 + seg * 512) * 2; u.b = B + ((size_t)seg * DM * 512 + (size_t)pn * 256 * 512) * 2; u.gidx = nullptr; return true; }
};
struct SchedMoe {
    const char* A; const char* B; const unsigned* ntp; const unsigned* tile_e; int G, c; size_t ta, tb_e, tb_n; const unsigned* tok;
    __device__ __forceinline__ bool next(int i, pg8::Unit& u) const {
        const int nt = (int)__builtin_amdgcn_readfirstlane(*ntp);
        const int cx = (G % 8 == 0) ? (c % 8) * (G / 8) + c / 8 : c;
        const long L = (long)i * G + cx; if (L >= (long)nt * 4) return false;
        const int tile = (int)(L >> 2), pn = (int)(L & 3); const int e = (int)__builtin_amdgcn_readfirstlane(tile_e[tile]);
        u.pm = tile; u.pn = pn; u.aux = e; u.pad = 0; u.a = tok ? A : A + (size_t)tile * ta; u.b = B + (size_t)e * tb_e + (size_t)pn * tb_n; u.gidx = tok ? tok + (size_t)tile * 256 : nullptr; return true; }
};

typedef pg8::f32x4 af4;
struct EpiStoreBf16 {
    static constexpr bool PERM = true;
    bf16* O; int ldc; int gate_col0; const float* bgate; v4u* GT;
    __device__ __forceinline__ bool operator()(af4 (&acc)[2][2][4][2], const pg8::Unit& u, int wr, int wc, int fr, int fq) const {
        const int row0 = u.pm * 256 + wr * 64 + fr, col0 = u.pn * 256 + wc * 32 + 8 * fq;
        const bool gate = (u.pn * 256 >= gate_col0);
#pragma unroll
        for (int bj = 0; bj < 2; ++bj) {
            af4 b0 = {0.f, 0.f, 0.f, 0.f}, b1 = {0.f, 0.f, 0.f, 0.f};
            if (gate) { b0 = *(const af4*)(bgate + col0 + bj * 128 - gate_col0); b1 = *(const af4*)(bgate + col0 + bj * 128 - gate_col0 + 4); }
#pragma unroll
            for (int ai = 0; ai < 2; ++ai)
#pragma unroll
                for (int m = 0; m < 4; ++m) { af4 v0 = acc[ai][bj][m][0], v1 = acc[ai][bj][m][1];
                    if (gate) {
#pragma unroll
                        for (int i = 0; i < 4; ++i) { v0[i] = __builtin_amdgcn_rcpf(1.f + __expf(-fminf(fmaxf(v0[i] + b0[i], -30.f), 30.f))); v1[i] = __builtin_amdgcn_rcpf(1.f + __expf(-fminf(fmaxf(v1[i] + b1[i], -30.f), 30.f))); } }
                    v4u w; w.x = pg8::cvt_pk_bf16(v0[0], v0[1]); w.y = pg8::cvt_pk_bf16(v0[2], v0[3]); w.z = pg8::cvt_pk_bf16(v1[0], v1[1]); w.w = pg8::cvt_pk_bf16(v1[2], v1[3]);
                    if (gate) { const int gt = u.pn - gate_col0 / 256;
                        GT[((((size_t)((gt >> 2) * 64 + u.pm) * 4 + (gt & 3)) * 8 + (wr * 4 + wc)) * 16 + (ai * 4 + m) * 2 + bj) * 64 + (fq * 16 + fr)] = w; }
                    else *(v4u*)(O + (size_t)(row0 + ai * 128 + m * 16) * ldc + col0 + bj * 128) = w; } }
        return true;
    }
};
struct EpiBranch {
    static constexpr bool PERM = true;
    const v4u* GT; bf16* merged;
    __device__ __forceinline__ bool operator()(af4 (&acc)[2][2][4][2], const pg8::Unit& u, int wr, int wc, int fr, int fq) const {
        const int seg = u.aux, row0 = u.pm * 256 + wr * 64 + fr, col0 = u.pn * 256 + wc * 32 + 8 * fq;
        const bool last = (seg == 2); const int sn = last ? seg : seg + 1;
#pragma unroll
        for (int bj = 0; bj < 2; ++bj) { const int col = col0 + bj * 128;
#pragma unroll
            for (int ai = 0; ai < 2; ++ai) { v4u gcv[4], gnv[4];
#pragma unroll
                for (int m = 0; m < 4; ++m) { const size_t row = (size_t)(row0 + ai * 128 + m * 16);
                    gcv[m] = GT[((((size_t)(seg * 64 + u.pm) * 4 + u.pn) * 8 + (wr * 4 + wc)) * 16 + (ai * 4 + m) * 2 + bj) * 64 + (fq * 16 + fr)];
                    gnv[m] = GT[((((size_t)(sn * 64 + u.pm) * 4 + u.pn) * 8 + (wr * 4 + wc)) * 16 + (ai * 4 + m) * 2 + bj) * 64 + (fq * 16 + fr)]; }
#pragma unroll
                for (int m = 0; m < 4; ++m) { const size_t row = (size_t)(row0 + ai * 128 + m * 16);
                    const unsigned gcw[4] = {gcv[m].x, gcv[m].y, gcv[m].z, gcv[m].w}, gnw[4] = {gnv[m].x, gnv[m].y, gnv[m].z, gnv[m].w};
                    float f[8];
#pragma unroll
                    for (int i = 0; i < 8; ++i) { const float gc = (i & 1) ? bfhi(gcw[i >> 1]) : bflo(gcw[i >> 1]), gn = (i & 1) ? bfhi(gnw[i >> 1]) : bflo(gnw[i >> 1]);
                        f[i] = last ? gc : gc * __builtin_amdgcn_rcpf(gn); }
                    af4& v0 = acc[ai][bj][m][0]; af4& v1 = acc[ai][bj][m][1];
                    v0[0] *= f[0]; v0[1] *= f[1]; v0[2] *= f[2]; v0[3] *= f[3]; v1[0] *= f[4]; v1[1] *= f[5]; v1[2] *= f[6]; v1[3] *= f[7];
                    if (last) { v4u w; w.x = pg8::cvt_pk_bf16(v0[0], v0[1]); w.y = pg8::cvt_pk_bf16(v0[2], v0[3]); w.z = pg8::cvt_pk_bf16(v1[0], v1[1]); w.w = pg8::cvt_pk_bf16(v1[2], v1[3]);
                        *(v4u*)(merged + row * DM + col) = w; } } } }
        return last;
    }
};
struct EpiResidual {
    static constexpr bool PERM = true;
    const float* xin32; const bf16* xin16; bf16* xout;
    __device__ __forceinline__ bool operator()(af4 (&acc)[2][2][4][2], const pg8::Unit& u, int wr, int wc, int fr, int fq) const {
        const int row0 = u.pm * 256 + wr * 64 + fr, col0 = u.pn * 256 + wc * 32 + 8 * fq;
#pragma unroll
        for (int ai = 0; ai < 2; ++ai)
#pragma unroll
            for (int mh = 0; mh < 2; ++mh) { af4 r[2][2][2];
#pragma unroll
                for (int mm = 0; mm < 2; ++mm) { const size_t off = (size_t)(row0 + ai * 128 + (mh * 2 + mm) * 16) * DM + col0;
#pragma unroll
                    for (int bj = 0; bj < 2; ++bj) {
                        if (xin32) { r[mm][bj][0] = *(const af4*)(xin32 + off + bj * 128); r[mm][bj][1] = *(const af4*)(xin32 + off + bj * 128 + 4); }
                        else { const v4u w = *(const v4u*)(xin16 + off + bj * 128); r[mm][bj][0] = (af4){bflo(w.x), bfhi(w.x), bflo(w.y), bfhi(w.y)}; r[mm][bj][1] = (af4){bflo(w.z), bfhi(w.z), bflo(w.w), bfhi(w.w)}; } } }
#pragma unroll
                for (int mm = 0; mm < 2; ++mm) { const size_t off = (size_t)(row0 + ai * 128 + (mh * 2 + mm) * 16) * DM + col0;
#pragma unroll
                    for (int bj = 0; bj < 2; ++bj) { const af4 v0 = r[mm][bj][0] + acc[ai][bj][mh * 2 + mm][0], v1 = r[mm][bj][1] + acc[ai][bj][mh * 2 + mm][1]; v4u w;
                        w.x = pg8::cvt_pk_bf16(v0[0], v0[1]); w.y = pg8::cvt_pk_bf16(v0[2], v0[3]); w.z = pg8::cvt_pk_bf16(v1[0], v1[1]); w.w = pg8::cvt_pk_bf16(v1[2], v1[3]);
                        *(v4u*)(xout + off + bj * 128) = w; } } }
        return true;
    }
};
struct EpiSwiglu {
    static constexpr bool PERM = true;
    bf16* act; const float* rrow;
    __device__ __forceinline__ bool operator()(af4 (&acc)[2][2][4][2], const pg8::Unit& u, int wr, int wc, int fr, int fq) const {
        const int row0 = u.pm * 256 + wr * 64 + fr, col0 = u.pn * 128 + wc * 32 + 8 * fq;
        float rs[2][4];
#pragma unroll
        for (int ai = 0; ai < 2; ++ai)
#pragma unroll
            for (int m = 0; m < 4; ++m) rs[ai][m] = rrow[row0 + ai * 128 + m * 16];
#pragma unroll
        for (int ai = 0; ai < 2; ++ai)
#pragma unroll
            for (int m = 0; m < 4; ++m) { const float rr = rs[ai][m]; const af4 g0 = acc[ai][0][m][0] * rr, g1 = acc[ai][0][m][1] * rr, u0 = acc[ai][1][m][0] * rr, u1 = acc[ai][1][m][1] * rr;
                float o[8];
#pragma unroll
                for (int i = 0; i < 4; ++i) { o[i] = g0[i] * sigmoidf_(g0[i]) * u0[i]; o[4 + i] = g1[i] * sigmoidf_(g1[i]) * u1[i]; }
                v4u w; w.x = pg8::cvt_pk_bf16(o[0], o[1]); w.y = pg8::cvt_pk_bf16(o[2], o[3]); w.z = pg8::cvt_pk_bf16(o[4], o[5]); w.w = pg8::cvt_pk_bf16(o[6], o[7]);
                *(v4u*)(act + (size_t)(row0 + ai * 128 + m * 16) * FF + col0) = w; }
        return true;
    }
};
struct EpiScaleRows {
    static constexpr bool PERM = true;
    bf16* ys; const float* wrow;
    __device__ __forceinline__ bool operator()(af4 (&acc)[2][2][4][2], const pg8::Unit& u, int wr, int wc, int fr, int fq) const {
        const int row0 = u.pm * 256 + wr * 64 + fr, col0 = u.pn * 256 + wc * 32 + 8 * fq;
        float sc[2][4];
#pragma unroll
        for (int ai = 0; ai < 2; ++ai)
#pragma unroll
            for (int m = 0; m < 4; ++m) sc[ai][m] = wrow[row0 + ai * 128 + m * 16];
#pragma unroll
        for (int ai = 0; ai < 2; ++ai)
#pragma unroll
            for (int m = 0; m < 4; ++m) { const int row = row0 + ai * 128 + m * 16; const float s = sc[ai][m]; bf16* rowp = ys + (size_t)row * DM + col0;
#pragma unroll
                for (int bj = 0; bj < 2; ++bj) { const af4 v0 = acc[ai][bj][m][0] * s, v1 = acc[ai][bj][m][1] * s; v4u w;
                    w.x = pg8::cvt_pk_bf16(v0[0], v0[1]); w.y = pg8::cvt_pk_bf16(v0[2], v0[3]); w.z = pg8::cvt_pk_bf16(v1[0], v1[1]); w.w = pg8::cvt_pk_bf16(v1[2], v1[3]);
                    *(v4u*)(rowp + bj * 128) = w; } }
        return true;
    }
};

constexpr int RT_PITCH = 2064, RT_HI = 0, RT_LO = 36 * RT_PITCH, RT_END = 72 * RT_PITCH;
static_assert(RT_END + 4096 <= LDS_SCRATCH, "router lds");
__device__ __forceinline__ void phase_router2(const Frame& F0, const bf16* x, const float* gain, const float* wco, const float* bco, const float* wfi, const float* bfi,
                                              bf16* hout, unsigned* route, unsigned* cnt, float* LG, bool commit) {
    const Frame F = fresh(F0);
    LAS unsigned char* L = (LAS unsigned char*)F.lds;
    {
        f32x4 wv[18];
#pragma unroll
        for (int i = 0; i < 2; ++i) wv[i] = *(const f32x4*)(wco + 4 * (F.tid + 512 * i));
#pragma unroll
        for (int i = 0; i < 16; ++i) wv[2 + i] = *(const f32x4*)(wfi + 4 * (F.tid + 512 * i));
#pragma unroll
        for (int i = 0; i < 18; ++i) { int k, c0; if (i < 2) { k = F.tid + 512 * i; c0 = 32; } else { const int f = F.tid + 512 * (i - 2); k = f >> 3; c0 = (f & 7) * 4; }
            const float w4[4] = {wv[i].x, wv[i].y, wv[i].z, wv[i].w};
#pragma unroll
            for (int e = 0; e < 4; ++e) { const unsigned hi = f2bf(w4[e]); const unsigned lo = f2bf(w4[e] - __uint_as_float(hi << 16));
                *(LAS bf16*)(L + RT_HI + (c0 + e) * RT_PITCH + k * 2) = (bf16)hi; *(LAS bf16*)(L + RT_LO + (c0 + e) * RT_PITCH + k * 2) = (bf16)lo; } }
    }
    LAS float* GL = (LAS float*)(L + RT_END);
    GL[F.tid] = gain[F.tid]; GL[F.tid + 512] = gain[F.tid + 512];
    __syncthreads();
    {
        const int lane = F.lane, rl = lane & 15, kg = lane >> 4, kh = F.wave >> 2;
        const int NITER = (T / 16 + 4 * F.G - 1) / (4 * F.G);
        for (int it = 0; it < NITER; ++it) {
            const int tile = (it * F.G + xcd_order(F.bid, F.G)) * 4 + (F.wave & 3); const bool tvalid = tile < T / 16;
            const size_t row = (size_t)(tvalid ? tile : 0) * 16 + rl;
            const bf16* xr = x + row * DM + 8 * kg + 512 * kh;
            pg8::f32x4 acc[3]; acc[0] = (pg8::f32x4){0.f, 0.f, 0.f, 0.f}; acc[1] = acc[0]; acc[2] = acc[0];
            float ss = 0.f;
            const int bro[3] = {rl * RT_PITCH + 16 * kg + 1024 * kh, (16 + rl) * RT_PITCH + 16 * kg + 1024 * kh, (32 + (rl & 3)) * RT_PITCH + 16 * kg + 1024 * kh};
            v4u xa[8];
#pragma unroll
            for (int q = 0; q < 8; ++q) xa[q] = *(const v4u*)(xr + 32 * q);
            for (int s0 = 0; s0 < 16; s0 += 8) {
                v4u xn[8];
                if (s0 + 8 < 16) {
#pragma unroll
                    for (int q = 0; q < 8; ++q) xn[q] = *(const v4u*)(xr + 32 * (s0 + 8 + q)); }
#pragma unroll
                for (int q = 0; q < 8; ++q) { const int s = s0 + q;
                    const f32x4 g0 = *(const LAS f32x4*)(GL + 512 * kh + 32 * s + 8 * kg), g1 = *(const LAS f32x4*)(GL + 512 * kh + 32 * s + 8 * kg + 4);
                    const float xv[8] = {bflo(xa[q].x), bfhi(xa[q].x), bflo(xa[q].y), bfhi(xa[q].y), bflo(xa[q].z), bfhi(xa[q].z), bflo(xa[q].w), bfhi(xa[q].w)};
                    ss += (xv[0] * xv[0] + xv[1] * xv[1]) + (xv[2] * xv[2] + xv[3] * xv[3]) + (xv[4] * xv[4] + xv[5] * xv[5]) + (xv[6] * xv[6] + xv[7] * xv[7]);
                    const float y[8] = {xv[0] * g0.x, xv[1] * g0.y, xv[2] * g0.z, xv[3] * g0.w, xv[4] * g1.x, xv[5] * g1.y, xv[6] * g1.z, xv[7] * g1.w};
                    v4u ah, al; ah.x = pk2(y[0], y[1]); ah.y = pk2(y[2], y[3]); ah.z = pk2(y[4], y[5]); ah.w = pk2(y[6], y[7]);
                    al.x = pk2(y[0] - bflo(ah.x), y[1] - bfhi(ah.x)); al.y = pk2(y[2] - bflo(ah.y), y[3] - bfhi(ah.y)); al.z = pk2(y[4] - bflo(ah.z), y[5] - bfhi(ah.z)); al.w = pk2(y[6] - bflo(ah.w), y[7] - bfhi(ah.w));
                    if (tvalid) *(v4u*)(hout + row * DM + 512 * kh + 32 * s + 8 * kg) = ah;
                    const bf16x8 Ah = __builtin_bit_cast(bf16x8, ah), Al = __builtin_bit_cast(bf16x8, al);
#pragma unroll
                    for (int ct = 0; ct < 3; ++ct) { const bf16x8 Bh = *(const LAS bf16x8*)(L + RT_HI + bro[ct] + 64 * s), Bl = *(const LAS bf16x8*)(L + RT_LO + bro[ct] + 64 * s);
                        acc[ct] = __builtin_amdgcn_mfma_f32_16x16x32_bf16(Ah, Bh, acc[ct], 0, 0, 0);
                        acc[ct] = __builtin_amdgcn_mfma_f32_16x16x32_bf16(Ah, Bl, acc[ct], 0, 0, 0);
                        acc[ct] = __builtin_amdgcn_mfma_f32_16x16x32_bf16(Al, Bh, acc[ct], 0, 0, 0); } }
#pragma unroll
                for (int q = 0; q < 8; ++q) xa[q] = xn[q];
            }
            ss += __shfl_xor(ss, 16); ss += __shfl_xor(ss, 32);
            float* LGh = LG + (size_t)kh * T * 48;
            if (tvalid) {
#pragma unroll
                for (int ct = 0; ct < 3; ++ct)
#pragma unroll
                    for (int rg = 0; rg < 4; ++rg) if (ct < 2 || rl < 4) LGh[((size_t)tile * 16 + 4 * kg + rg) * 48 + ct * 16 + rl] = acc[ct][rg];
                if (lane < 16) LGh[((size_t)tile * 16 + lane) * 48 + 47] = ss; }
            asm volatile("s_waitcnt vmcnt(0)" ::: "memory");
            __syncthreads();
            if (kh == 0 && lane < 16 && tvalid) {
                const size_t m = (size_t)tile * 16 + lane;
                const float* l0 = LG + m * 48; const float* l1 = LG + (size_t)T * 48 + m * 48;
                const float sst = __uint_as_float(__hip_atomic_load((const unsigned*)(l0 + 47), RLX_AGENT)) + __uint_as_float(__hip_atomic_load((const unsigned*)(l1 + 47), RLX_AGENT));
                const float r = rsqrtf(sst * (1.f / DM) + RMS_EPS);
                float lg[36];
#pragma unroll
                for (int c = 0; c < 36; ++c) lg[c] = r * (__uint_as_float(__hip_atomic_load((const unsigned*)(l0 + c), RLX_AGENT)) + __uint_as_float(__hip_atomic_load((const unsigned*)(l1 + c), RLX_AGENT)));
                float c0 = lg[32] + bco[0], c1 = lg[33] + bco[1], c2 = lg[34] + bco[2], c3 = lg[35] + bco[3];
                int grp = 0; float cm = c0;
                if (c1 > cm) { cm = c1; grp = 1; } if (c2 > cm) { cm = c2; grp = 2; } if (c3 > cm) { cm = c3; grp = 3; }
                const float ptop = 1.f / (__expf(c0 - cm) + __expf(c1 - cm) + __expf(c2 - cm) + __expf(c3 - cm));
                float fs[8];
#pragma unroll
                for (int i = 0; i < 8; ++i) { float a = lg[i] + bfi[i], b = lg[8 + i] + bfi[8 + i], c = lg[16 + i] + bfi[16 + i], d = lg[24 + i] + bfi[24 + i]; fs[i] = grp == 0 ? a : (grp == 1 ? b : (grp == 2 ? c : d)); }
                int i1 = 0; float v1 = fs[0];
#pragma unroll
                for (int i = 1; i < 8; ++i) if (fs[i] > v1) { v1 = fs[i]; i1 = i; }
                int i2 = -1; float v2 = -3.0e38f;
#pragma unroll
                for (int i = 0; i < 8; ++i) if (i != i1 && fs[i] > v2) { v2 = fs[i]; i2 = i; }
                const float e2 = __expf(v2 - v1), w1 = ptop / (1.f + e2), w2 = ptop * e2 / (1.f + e2);
                if (commit) {
                    const int ea = grp * 8 + i1, eb = grp * 8 + i2;
                    const unsigned ra = __hip_atomic_fetch_add(cnt + 64 * ea, 1u, RLX_AGENT), rb = __hip_atomic_fetch_add(cnt + 64 * eb, 1u, RLX_AGENT);
                    v4u o; o.x = (unsigned)ea; o.y = (unsigned)eb; o.z = ra; o.w = rb; *(v4u*)(route + m * 8) = o;
                    *(f32x4*)(route + m * 8 + 4) = (f32x4){w1, w2, r, 0.f};
                }
            }
        }
    }
    __syncthreads();
}

__device__ __forceinline__ void phase_index(const Frame& F0, const unsigned* route, const unsigned* cnt, unsigned* ntp, unsigned* tile_e, unsigned* tok, float* wrow, float* rrow, unsigned* pos) {
    const Frame F = fresh(F0);
    unsigned* off = (unsigned*)F.lds;
    if (F.tid == 0) { unsigned o = 0;
        for (int e = 0; e < NEXP; ++e) { off[e] = o; const unsigned c = __hip_atomic_load(cnt + 64 * e, RLX_AGENT); off[64 + e] = c; const unsigned p = (c + 255u) & ~255u;
            if (F.bid == 0) for (unsigned tI = o >> 8; tI < ((o + p) >> 8); ++tI) tile_e[tI] = (unsigned)e;
            o += p; }
        off[NEXP] = o; if (F.bid == 0) *ntp = o >> 8; }
    __syncthreads();
    for (int m = F.bid * 512 + F.tid; m < T; m += F.G * 512) {
        const v4u ri = *(const v4u*)(route + (size_t)m * 8); const f32x4 ww = *(const f32x4*)(route + (size_t)m * 8 + 4);
        const unsigned d0 = off[ri.x] + ri.z, d1 = off[ri.y] + ri.w;
        tok[d0] = (unsigned)m; tok[d1] = (unsigned)m; wrow[d0] = ww.x; wrow[d1] = ww.y; rrow[d0] = ww.z; rrow[d1] = ww.z; *(v2u*)(pos + (size_t)m * 2) = (v2u){d0, d1}; }
    for (int e = F.bid; e < NEXP; e += F.G) {
        const unsigned c = off[64 + e], b0 = off[e] + c, b1 = off[e + 1];
        for (unsigned i = b0 + F.tid; i < b1; i += 512) { tok[i] = 0u; wrow[i] = 0.f; rrow[i] = 0.f; } }
    __syncthreads();
}

__device__ __forceinline__ void phase_combine(const Frame& F0, const bf16* x, bf16* xdst16, float* xdst32, const bf16* ys, const unsigned* pos, const float* ngain, bf16* hout) {
    const Frame F = fresh(F0);
    const int gw = F.bid * 8 + F.wave, NGW = F.G * 8;
    f32x4 g[4];
#pragma unroll
    for (int j = 0; j < 4; ++j) g[j] = ngain ? *(const f32x4*)(ngain + 4 * F.lane + 256 * j) : (f32x4){0.f, 0.f, 0.f, 0.f};
    const int RPW = (T + NGW - 1) / NGW, mbase = (xcd_order(F.bid, F.G) * 8 + F.wave) * RPW;
    for (int r0 = 0; r0 < RPW; r0 += 2) {
        v2u pp[2];
#pragma unroll
        for (int q = 0; q < 2; ++q) { const int m = (r0 + q < RPW) ? mbase + r0 + q : T; pp[q] = (m < T) ? *(const v2u*)(pos + (size_t)m * 2) : (v2u){0u, 0u}; }
        v2u xv[2][4], ya[2][4], yb[2][4];
#pragma unroll
        for (int q = 0; q < 2; ++q) { const int m = (r0 + q < RPW) ? mbase + r0 + q : T; if (m < T) {
                const v2u* xr = (const v2u*)(x + (size_t)m * DM) + F.lane; const v2u* y0 = (const v2u*)(ys + (size_t)pp[q].x * DM) + F.lane; const v2u* y1 = (const v2u*)(ys + (size_t)pp[q].y * DM) + F.lane;
#pragma unroll
                for (int j = 0; j < 4; ++j) { xv[q][j] = xr[64 * j]; ya[q][j] = y0[64 * j]; yb[q][j] = y1[64 * j]; } } }
#pragma unroll
        for (int q = 0; q < 2; ++q) { const int m = (r0 + q < RPW) ? mbase + r0 + q : T; if (m < T) {
                float s = 0.f; f32x4 v[4];
#pragma unroll
                for (int j = 0; j < 4; ++j) { const v2u c = xv[q][j], a = ya[q][j], b = yb[q][j]; f32x4 t;
                    t.x = bflo(c.x) + bflo(a.x) + bflo(b.x); t.y = bfhi(c.x) + bfhi(a.x) + bfhi(b.x); t.z = bflo(c.y) + bflo(a.y) + bflo(b.y); t.w = bfhi(c.y) + bfhi(a.y) + bfhi(b.y);
                    v[j] = t; s += (t.x * t.x + t.y * t.y) + (t.z * t.z + t.w * t.w); }
                if (xdst32) { f32x4* xw = (f32x4*)(xdst32 + (size_t)m * DM) + F.lane;
#pragma unroll
                    for (int j = 0; j < 4; ++j) xw[64 * j] = v[j]; }
                else { v2u* xw = (v2u*)(xdst16 + (size_t)m * DM) + F.lane;
#pragma unroll
                    for (int j = 0; j < 4; ++j) { v2u w; w.x = pk2(v[j].x, v[j].y); w.y = pk2(v[j].z, v[j].w); xw[64 * j] = w; } }
                if (ngain) {
                    const float r = rsqrtf(wave_sum(s) * (1.f / DM) + RMS_EPS);
                    v2u* o8 = (v2u*)(hout + (size_t)m * DM) + F.lane;
#pragma unroll
                    for (int j = 0; j < 4; ++j) { v2u w; w.x = pk2(v[j].x * r * g[j].x, v[j].y * r * g[j].y); w.y = pk2(v[j].z * r * g[j].z, v[j].w * r * g[j].w); o8[64 * j] = w; }
                } } }
    }
}

constexpr int PH_PER_LAYER = 11, N_PHASES = 1 + DEPTH * PH_PER_LAYER;
__device__ __forceinline__ CArgs& kargs() { CArgs* p = (CArgs*)__builtin_amdgcn_kernarg_segment_ptr(); asm volatile("" : "+s"(p)); return *p; }
__global__ void __launch_bounds__(512, 2) mk_fwd(Args args_unused) {
    extern __shared__ __attribute__((aligned(16))) unsigned char lds[];
    LAS unsigned char* lds3 = (LAS unsigned char*)lds;
    const int wave_s = __builtin_amdgcn_readfirstlane(threadIdx.x >> 6);
    for (int u = threadIdx.x; u < (LDS_BYTES - LDSCTL_OFF) / 4; u += 512) ((LAS unsigned*)(lds3 + LDSCTL_OFF))[u] = 0u;
    __syncthreads();
#if MK_SPLIT
#define GRID_BAR() do { } while (0)
#else
    (void)xcd_barrier_post((unsigned*)(kargs().ws + WS_CTL) + CW_BAR, (volatile LAS unsigned*)(lds3 + LDSCTL_OFF));
#define GRID_BAR() do { XcdBarrier b_; b_.bar = (unsigned*)(kargs().ws + WS_CTL) + CW_BAR; b_.x = xb_xcc_id(); b_.st = (volatile LAS unsigned*)(lds3 + LDSCTL_OFF); xcd_barrier(b_); } while (0)
#endif
#define IN(k) (kargs().ph_lo <= (k) && (k) < kargs().ph_hi)
#define SEAM(k) do { if (IN(k) && IN((k) + 1)) GRID_BAR(); } while (0)
#define FRAME() CArgs& A = kargs(); Frame F; F.lds = lds; F.lane = lane_id_asm(); { int w_ = wave_s; asm volatile("" : "+s"(w_)); F.wave = w_; } F.tid = F.wave * 64 + F.lane; { int g_ = gridDim.x, b_ = blockIdx.x; asm volatile("" : "+s"(g_), "+s"(b_)); F.G = g_; F.bid = b_; } \
    unsigned char* ws = A.ws; F.ws = ws; F.ctl = (unsigned*)(ws + WS_CTL); (void)F;
#define WSP(T_, off) ((T_*)(ws + (off)))

#ifdef EXTRA_BARS
    for (int eb_ = 0; eb_ < EXTRA_BARS; ++eb_) GRID_BAR();
#endif
    if (IN(0) && PHON(11)) { for (int rep_ = 0; rep_ < REPN(11); ++rep_) { if (rep_) GRID_BAR(); { FRAME(); phase_prologue(F, A); }
        { FRAME(); phase_norm(F, A.in[I_X], A.in[I_MIXG], WSP(bf16, WS_H)); } } }
    SEAM(0);
#pragma unroll 1
    for (int l = 0; l < DEPTH; ++l) {
        const int p0 = 1 + l * PH_PER_LAYER;
        if (IN(p0 + 1) && PHON(1)) { for (int rep_ = 0; rep_ < REPN(1); ++rep_) { if (rep_) GRID_BAR(); { FRAME();
            pg8::Gemm g{DM, DM, DM};
            SchedDense S{(const char*)(ws + WS_H), (const char*)(ws + WS_WIN) + (size_t)l * NCOL * DM * 2, T / 256, NCOL / 256, F.G, F.bid, (size_t)256 * DM * 2, (size_t)256 * DM * 2};
            EpiStoreBf16 E{WSP(bf16, WS_PROJ), NCOL, C_GL, A.in[I_BGATE] + l * 3 * DM, WSP(v4u, WS_GT)};
            pg8::gemm_phase<EpiStoreBf16, SchedDense, true, true>(lds3, g, S, E, F.tid);
        } } }
        SEAM(p0 + 1);
        if (IN(p0 + 2) && PHON(2)) { for (int rep_ = 0; rep_ < REPN(2); ++rep_) { if (rep_) GRID_BAR(); {
            for (int r2_ = 0; r2_ < REPN(14); ++r2_) { FRAME(); phase_qkprep(F, WSP(bf16, WS_PROJ), A.in[I_QG] + l * 64, A.in[I_KG] + l * 64, WSP(bf16, WS_Q), WSP(bf16, WS_K), WSP(float, WS_KMEAN)); }
            for (int r2_ = 0; r2_ < REPN(15); ++r2_) { FRAME(); phase_conv(F, WSP(bf16, WS_PROJ), A.in[I_CONVW] + (size_t)l * 31 * 512, A.in[I_CONVB] + l * 512, A.in[I_CLNG] + l * 512, A.in[I_CLNB] + l * 512, WSP(bf16, WS_CAT)); }
            for (int r2_ = 0; r2_ < REPN(16); ++r2_) { FRAME(); phase_hgrn1(F, WSP(bf16, WS_PROJ), A.in[I_LBL], l, WSP(float, WS_HS), WSP(float, WS_HS + 16 * MiB), WSP(float, WS_ORAW), WSP(bf16, WS_HS + 17 * MiB)); }
        } } }
        SEAM(p0 + 2);
        if (IN(p0 + 3) && PHON(3)) { for (int rep_ = 0; rep_ < REPN(3); ++rep_) { if (rep_) GRID_BAR(); {
            for (int r2_ = 0; r2_ < REPN(12); ++r2_) { FRAME(); phase_attn_mfma(F, WSP(bf16, WS_Q), WSP(bf16, WS_K), WSP(bf16, WS_PROJ), WSP(float, WS_KMEAN), WSP(bf16, WS_CAT)); }
            for (int r2_ = 0; r2_ < REPN(13); ++r2_) { FRAME(); phase_hgrn2(F, WSP(bf16, WS_PROJ), A.in[I_HGG] + l * 128, WSP(float, WS_HS), WSP(float, WS_HS + 16 * MiB), WSP(float, WS_ORAW), WSP(bf16, WS_HS + 17 * MiB), WSP(bf16, WS_CAT), (r2_ + 1 < REPN(13)) ? PROBE_DRY : 0); }
        } } }
        SEAM(p0 + 3);
        if (IN(p0 + 4) && PHON(4)) { for (int rep_ = 0; rep_ < REPN(4); ++rep_) { if (rep_) GRID_BAR(); { FRAME();
            pg8::Gemm g{1536, 512, 512};
            SchedBranch S{(const char*)(ws + WS_CAT), (const char*)(ws + WS_WCAT) + (size_t)l * 3 * DM * 512 * 2, F.G, F.bid};
            EpiBranch E{WSP(const v4u, WS_GT), WSP(bf16, WS_MERGED)};
            pg8::gemm_phase<EpiBranch, SchedBranch, true, true>(lds3, g, S, E, F.tid);
        } } }
        SEAM(p0 + 4);
        if (IN(p0 + 5) && PHON(5)) { for (int rep_ = 0; rep_ < REPN(5); ++rep_) { if (rep_) GRID_BAR(); { FRAME();
            pg8::Gemm g{DM, DM, DM};
            SchedDense S{(const char*)(ws + WS_MERGED), (const char*)(ws + WS_WOUT) + (size_t)l * DM * DM * 2, T / 256, DM / 256, F.G, F.bid, (size_t)256 * DM * 2, (size_t)256 * DM * 2};
            EpiResidual E{(l == 0) ? A.in[I_X] : (const float*)nullptr, (l == 0) ? (const bf16*)nullptr : WSP(const bf16, WS_XB), (rep_ + 1 >= REPN(5)) ? WSP(bf16, WS_XB) : WSP(bf16, WS_HS)};
            pg8::gemm_phase<EpiResidual, SchedDense, true, true>(lds3, g, S, E, F.tid);
        } } }
        SEAM(p0 + 5);
        if (IN(p0 + 6) && PHON(6)) { for (int rep_ = 0; rep_ < REPN(6); ++rep_) { if (rep_) GRID_BAR(); { FRAME(); phase_router2(F, WSP(const bf16, WS_XB), A.in[I_FFNG] + l * DM, A.in[I_WCO] + (size_t)l * DM * 4, A.in[I_BCO] + l * 4, A.in[I_WFI] + (size_t)l * DM * 32, A.in[I_BFI] + l * 32, WSP(bf16, WS_H), WSP(unsigned, WS_ROUTE), F.ctl + CW_CNT + l * 32 * 64, WSP(float, WS_Q), rep_ + 1 >= REPN(6)); } } }
        SEAM(p0 + 6);
        if (IN(p0 + 7) && PHON(7)) { for (int rep_ = 0; rep_ < REPN(7); ++rep_) { if (rep_) GRID_BAR(); { FRAME(); phase_index(F, WSP(unsigned, WS_ROUTE), F.ctl + CW_CNT + l * 32 * 64, F.ctl + CW_NT + l * 64, F.ctl + CW_TILE + l * 256, WSP(unsigned, WS_POS + 256 * 1024), WSP(float, WS_POS + 512 * 1024), WSP(float, WS_POS + 768 * 1024), WSP(unsigned, WS_POS)); } } }
        SEAM(p0 + 7);
        if (IN(p0 + 8) && PHON(8)) { for (int rep_ = 0; rep_ < REPN(8); ++rep_) { if (rep_) GRID_BAR(); { FRAME();
            pg8::Gemm g{DM, DM, DM};
            SchedMoe S{(const char*)(ws + WS_H), (const char*)(ws + WS_WEI) + (size_t)l * NEXP * 1024 * DM * 2, F.ctl + CW_NT + l * 64, F.ctl + CW_TILE + l * 256, F.G, F.bid, (size_t)256 * DM * 2, (size_t)1024 * DM * 2, (size_t)256 * DM * 2, WSP(const unsigned, WS_POS + 256 * 1024)};
            EpiSwiglu E{WSP(bf16, WS_ACT), WSP(float, WS_POS + 768 * 1024)};
            pg8::gemm_phase<EpiSwiglu, SchedMoe, true, true, true>(lds3, g, S, E, F.tid);
        } } }
        SEAM(p0 + 8);
        if (IN(p0 + 9) && PHON(9)) { for (int rep_ = 0; rep_ < REPN(9); ++rep_) { if (rep_) GRID_BAR(); { FRAME();
            pg8::Gemm g{FF, FF, FF};
            SchedMoe S{(const char*)(ws + WS_ACT), (const char*)(ws + WS_WEO) + (size_t)l * NEXP * DM * FF * 2, F.ctl + CW_NT + l * 64, F.ctl + CW_TILE + l * 256, F.G, F.bid, (size_t)256 * FF * 2, (size_t)DM * FF * 2, (size_t)256 * FF * 2, nullptr};
            EpiScaleRows E{WSP(bf16, WS_YS), WSP(float, WS_POS + 512 * 1024)};
            pg8::gemm_phase<EpiScaleRows, SchedMoe, true, true>(lds3, g, S, E, F.tid);
        } } }
        SEAM(p0 + 9);
        if (IN(p0 + 10) && PHON(10)) { for (int rep_ = 0; rep_ < REPN(10); ++rep_) { if (rep_) GRID_BAR(); { FRAME(); const bool real_ = (rep_ + 1 >= REPN(10)), lastl_ = (l + 1 >= DEPTH); phase_combine(F, WSP(const bf16, WS_XB), (real_ && !lastl_) ? WSP(bf16, WS_XB) : WSP(bf16, WS_HS), (real_ && lastl_) ? A.out : (float*)nullptr, WSP(bf16, WS_YS), WSP(unsigned, WS_POS), lastl_ ? (const float*)nullptr : A.in[I_MIXG] + (l + 1) * DM, WSP(bf16, WS_H)); } } }
        SEAM(p0 + 10);
    }
#undef IN
#undef SEAM
#undef FRAME
#undef WSP
}

extern "C" void kernel_launch(void* const* d_in, const int* in_sizes, int n_in, void* d_out, int out_size, void* d_ws, size_t ws_size, hipStream_t stream) {
    static int grid = 0;
    if (grid == 0) {
        if (n_in != 23 || out_size != T * DM || ws_size < WS_END) { fprintf(stderr, "kernel_launch: unexpected shapes (n_in %d out %d ws %zu)\n", n_in, out_size, ws_size); grid = -1; return; }
        int dev = 0, cus = 0, per_cu = 0;
        if (hipGetDevice(&dev) != hipSuccess || hipDeviceGetAttribute(&cus, hipDeviceAttributeMultiprocessorCount, dev) != hipSuccess) { grid = -1; return; }
        if (hipFuncSetAttribute((const void*)mk_fwd, hipFuncAttributeMaxDynamicSharedMemorySize, LDS_BYTES) != hipSuccess) { fprintf(stderr, "kernel_launch: hipFuncSetAttribute failed\n"); grid = -1; return; }
        if (hipOccupancyMaxActiveBlocksPerMultiprocessor(&per_cu, (const void*)mk_fwd, 512, LDS_BYTES) != hipSuccess || per_cu < 1) fprintf(stderr, "kernel_launch: occupancy query says %d\n", per_cu);
        (void)hipGetLastError();
        grid = cus;
    }
    if (grid < 0) return;
    (void)hipMemsetAsync((char*)d_ws + WS_CTL, 0, CTL_ZERO_BYTES, stream);
    Args a{};
    for (int i = 0; i < 23; ++i) a.in[i] = (const float*)d_in[i];
    a.out = (float*)d_out; a.ws = (unsigned char*)d_ws;
#if MK_SPLIT
    for (int p = 0; p < N_PHASES; ++p) {
        if (p == 1 + PH_PER_LAYER) continue;
        a.ph_lo = p; a.ph_hi = p + 1;
        hipLaunchKernelGGL(mk_fwd, dim3(grid), dim3(512), LDS_BYTES, stream, a);
    }
#else
    a.ph_lo = 0; a.ph_hi = N_PHASES;
    hipLaunchKernelGGL(mk_fwd, dim3(grid), dim3(512), LDS_BYTES, stream, a);
#endif
}
```

```cpp
#include <hip/hip_runtime.h>
#include <cstdio>
#include <cstdint>

#ifndef MK_SPLIT
#define MK_SPLIT 0
#endif
#ifndef DBG_MASK
#define DBG_MASK 0xFFFFu
#endif
#define PHON(j) (((DBG_MASK) >> (j)) & 1u)
#ifndef REP_MASK
#define REP_MASK 0u
#endif
#ifndef REP_EXTRA
#define REP_EXTRA 1
#endif
#ifndef PROBE_DRY
#define PROBE_DRY 0
#endif
#define REPN(j) ((((REP_MASK) >> (j)) & 1u) ? (1 + REP_EXTRA) : 1)

constexpr int DM = 1024, NB = 8, SEQ = 2048, T = NB * SEQ, DEPTH = 2;
constexpr int NCOL = 7680;
constexpr int C_AQ = 0, C_AK = 512, C_AV = 1024, C_HQ = 1536, C_HF = 2048, C_HI = 2560, C_HG = 3072, C_CA = 3584, C_CB = 4096, C_GL = 4608;
constexpr int NEXP = 32, FF = 512;
constexpr int MOE_ROWS = 2 * T + NEXP * 256;
constexpr float RMS_EPS = 1e-6f, LN_EPS = 1e-5f;
constexpr float QSCALE = 0.125f * 1.4426950408889634f;

namespace pg8 {
#define PG8_LAS __attribute__((address_space(3)))
typedef unsigned short bf16_t;
typedef short bf16x8 __attribute__((ext_vector_type(8)));
typedef float f32x4 __attribute__((ext_vector_type(4)));
typedef unsigned u32x4 __attribute__((ext_vector_type(4)));
constexpr int BM = 256, BK = 64, HALF = 128, HTB = HALF * BK * 2, STAGE_BYTES = 8 * HTB, NXCD = 8, WGM = 8;

__host__ __device__ __forceinline__ int lds_byte(int r, int c) { const int st = (r >> 4) * 2 + (c >> 5), rr = r & 15, cc = c & 31, ob = rr * 64 + cc * 2; return st * 1024 + (ob ^ (((ob >> 9) & 1) << 5)); }
__host__ __device__ __forceinline__ void stage_rc(int b, int& R, int& C) { const int st = b / 1024, sb = b % 1024, swz = sb ^ (((sb >> 9) & 1) << 5); R = (st >> 1) * 16 + swz / 64; C = (st & 1) * 32 + (swz % 64) / 2; }
__host__ __device__ __forceinline__ int perm32(int rho) { const int n = rho >> 4, i = rho & 15; return 8 * (i >> 2) + 4 * n + (i & 3); }

struct Unit { int pm, pn, aux, pad; const char* a; const char* b; const unsigned* gidx; };
struct Gemm { int lda, ldb, K; };

__device__ __forceinline__ bool static_tile(int nM, int nN, long L, int& pm, int& pn) {
    const int nwg = nM * nN; if (L >= nwg) return false;
    int wgid = (int)L; { const int q = nwg / NXCD, r = nwg % NXCD, xcd = wgid % NXCD, off = wgid / NXCD; wgid = (xcd < r ? xcd * (q + 1) : r * (q + 1) + (xcd - r) * q) + off; }
    const int nig = WGM * nN, gid = wgid / nig, fm = gid * WGM, gsz = (nM - fm) < WGM ? (nM - fm) : WGM;
    pm = fm + ((wgid % nig) % gsz); pn = (wgid % nig) / gsz; return true;
}

__device__ __forceinline__ unsigned cvt_pk_bf16(float lo, float hi) { unsigned r; asm volatile("v_cvt_pk_bf16_f32 %0, %1, %2" : "=v"(r) : "v"(lo), "v"(hi)); return r; }

template <class Epi, class Sched, bool ALIGN_EPI = false, bool SP2 = false, bool GATHER = false>
__device__ __forceinline__ void gemm_phase(PG8_LAS unsigned char* lds, const Gemm g, const Sched& S, const Epi& E, int tid_in) {
    int tid_ = tid_in; asm volatile("" : "+v"(tid_));
    const int tid = tid_, wid = __builtin_amdgcn_readfirstlane(tid >> 6), lane = tid & 63, wr = wid >> 2, wc = wid & 3, fr = lane & 15, fq = lane >> 4;
    const int K = g.K, nt = K / BK;
    unsigned voffA[2], voffB[2];
#pragma unroll
    for (int i = 0; i < 2; ++i) { int R, C; stage_rc(tid * 16 + i * 8192, R, C); const int Rb = Epi::PERM ? ((R & ~31) + perm32(R & 31)) : R;
        voffA[i] = (unsigned)(R * g.lda + C) * 2u; voffB[i] = (unsigned)(Rb * g.ldb + C) * 2u; }
    const size_t kstep = (size_t)(BK * 2);
    unsigned gvo[2][2] = {{0u, 0u}, {0u, 0u}}, gnx[2][2] = {{0u, 0u}, {0u, 0u}}; int grow[2] = {0, 0}; unsigned gcol[2] = {0u, 0u};
    if constexpr (GATHER) {
#pragma unroll
        for (int i = 0; i < 2; ++i) { int R, C; stage_rc(tid * 16 + i * 8192, R, C); grow[i] = R; gcol[i] = (unsigned)C * 2u; } }
#define PG8_GCONV(dst, src) do { _Pragma("unroll") for (int h_ = 0; h_ < 2; ++h_) _Pragma("unroll") for (int i_ = 0; i_ < 2; ++i_) dst[h_][i_] = src[h_][i_] * (unsigned)(g.lda * 2) + gcol[i_]; } while (0)
#define PG8_GLOAD(dst, u_) do { _Pragma("unroll") for (int h_ = 0; h_ < 2; ++h_) _Pragma("unroll") for (int i_ = 0; i_ < 2; ++i_) dst[h_][i_] = (u_).gidx[h_ * HALF + grow[i_]]; } while (0)
    const size_t hstepA = (size_t)HALF * g.lda * 2, hstepB = (size_t)HALF * g.ldb * 2;
    const unsigned ldsw = (unsigned)wid * 1024u;
    const int aoff = lds_byte(wr * 64 + fr, fq * 8), boff = lds_byte(wc * 32 + fr, fq * 8);
#define PG8_SA(b, h) (((b) * 2 + (h)) * HTB)
#define PG8_SB(b, h) ((4 + (b) * 2 + (h)) * HTB)
#define PG8_STAGE(bufoff, gbase, voff) do { _Pragma("unroll") for (int _i = 0; _i < 2; ++_i) \
        __builtin_amdgcn_global_load_lds((const unsigned*)((const char*)(gbase) + (voff)[_i]), (PG8_LAS unsigned*)(lds + (bufoff) + ldsw + _i * 8192), 16, 0, 0); } while (0)
#define PG8_LDA(dst, b, h) do { _Pragma("unroll") for (int m = 0; m < 4; ++m) _Pragma("unroll") for (int k = 0; k < 2; ++k) dst[m][k] = *(const PG8_LAS bf16x8*)(lds + PG8_SA(b, h) + aoff + m * 2048 + k * 1024); } while (0)
#define PG8_LDB(dst, b, h) do { _Pragma("unroll") for (int n = 0; n < 2; ++n) _Pragma("unroll") for (int k = 0; k < 2; ++k) dst[n][k] = *(const PG8_LAS bf16x8*)(lds + PG8_SB(b, h) + boff + n * 2048 + k * 1024); } while (0)
#define PG8_MMA(ai, bj, At, Bt) do { __builtin_amdgcn_s_setprio(1); _Pragma("unroll") for (int m = 0; m < 4; ++m) _Pragma("unroll") for (int n = 0; n < 2; ++n) _Pragma("unroll") for (int k = 0; k < 2; ++k) \
        acc[ai][bj][m][n] = __builtin_amdgcn_mfma_f32_16x16x32_bf16(Bt[n][k], At[m][k], acc[ai][bj][m][n], 0, 0, 0); __builtin_amdgcn_s_setprio(0); } while (0)
#define PG8_WAIT_V(n) asm volatile("s_waitcnt vmcnt(" #n ")" ::: "memory")
#define PG8_WAIT_L(n) asm volatile("s_waitcnt lgkmcnt(" #n ")" ::: "memory")
#define PG8_BAR __builtin_amdgcn_s_barrier()
#define PG8_SCHED __builtin_amdgcn_sched_barrier(0)
    Unit cur, nxt; int ui = 0;
    if (!S.next(0, cur)) return;
    f32x4 acc[2][2][4][2];
#pragma unroll
    for (int a = 0; a < 2; ++a)
#pragma unroll
        for (int b = 0; b < 2; ++b)
#pragma unroll
            for (int m = 0; m < 4; ++m)
#pragma unroll
                for (int n = 0; n < 2; ++n) acc[a][b][m][n] = (f32x4){0.f, 0.f, 0.f, 0.f};
    bf16x8 At[4][2], B0[2][2], B1[2][2];
    const char* cA = cur.a; const char* cB = cur.b;
    if constexpr (GATHER) { PG8_GLOAD(gnx, cur); PG8_GCONV(gvo, gnx); }
#define PG8_STAGE_A(bufoff, kbase, half, nextu) do { if constexpr (GATHER) { unsigned vo_[2]; if (nextu) { vo_[0] = gnx[half][0] * (unsigned)(g.lda * 2) + gcol[0]; vo_[1] = gnx[half][1] * (unsigned)(g.lda * 2) + gcol[1]; } \
        else { vo_[0] = gvo[half][0]; vo_[1] = gvo[half][1]; } PG8_STAGE(bufoff, kbase, vo_); } else { PG8_STAGE(bufoff, (kbase) + (half) * hstepA, voffA); } } while (0)
    if constexpr (SP2) {
        PG8_STAGE(PG8_SB(0, 0), cB, voffB); PG8_STAGE(PG8_SB(0, 1), cB + hstepB, voffB); PG8_STAGE_A(PG8_SA(0, 0), cA, 0, false); PG8_STAGE_A(PG8_SA(0, 1), cA, 1, false);
        if (wr == 1) PG8_BAR;
        PG8_WAIT_V(2); PG8_BAR;
        PG8_STAGE(PG8_SB(1, 0), cB + kstep, voffB); PG8_STAGE_A(PG8_SA(1, 0), cA + kstep, 0, false); PG8_STAGE(PG8_SB(1, 1), cB + hstepB + kstep, voffB);
        PG8_WAIT_V(6); PG8_BAR;
    } else {
        PG8_STAGE(PG8_SB(0, 0), cB, voffB); PG8_STAGE(PG8_SA(0, 0), cA, voffA); PG8_STAGE(PG8_SB(0, 1), cB + hstepB, voffB); PG8_STAGE(PG8_SA(0, 1), cA + hstepA, voffA);
        if (wr == 1) PG8_BAR;
        PG8_WAIT_V(4); PG8_BAR;
        PG8_STAGE(PG8_SB(1, 0), cB + kstep, voffB); PG8_STAGE(PG8_SA(1, 0), cA + kstep, voffA); PG8_STAGE(PG8_SB(1, 1), cB + hstepB + kstep, voffB);
        PG8_WAIT_V(6); PG8_BAR;
    }
    for (;;) {
        const bool has_next = S.next(ui + 1, nxt);
        const char* nA = has_next ? nxt.a : cA; const char* nB = has_next ? nxt.b : cB;
        if constexpr (GATHER) { if (has_next) PG8_GLOAD(gnx, nxt); }
        for (int t = 0; t < nt; t += 2) {
            const bool last = (t == nt - 2);
            const char* a1 = cA + (size_t)(t + 1) * kstep;
            const char* a2 = last ? nA : cA + (size_t)(t + 2) * kstep; const char* b2 = last ? nB : cB + (size_t)(t + 2) * kstep;
            const char* a3 = a2 + kstep; const char* b3 = b2 + kstep;
            if constexpr (SP2) {
            PG8_LDB(B0, 0, 0); PG8_LDB(B1, 0, 1); PG8_SCHED; PG8_LDA(At, 0, 0); PG8_STAGE_A(PG8_SA(1, 1), a1, 1, false);
            PG8_WAIT_V(8); PG8_WAIT_L(0); PG8_BAR; PG8_MMA(0, 0, At, B0); PG8_MMA(0, 1, At, B1); PG8_BAR; PG8_SCHED;
            PG8_LDA(At, 0, 1); PG8_STAGE(PG8_SB(0, 0), b2, voffB); PG8_STAGE(PG8_SB(0, 1), b2 + hstepB, voffB); PG8_STAGE_A(PG8_SA(0, 0), a2, 0, last);
            PG8_WAIT_V(8); PG8_WAIT_L(0); PG8_BAR; PG8_MMA(1, 0, At, B0); PG8_MMA(1, 1, At, B1); PG8_BAR; PG8_SCHED;
            PG8_LDB(B0, 1, 0); PG8_LDB(B1, 1, 1); PG8_SCHED; PG8_LDA(At, 1, 0); PG8_STAGE_A(PG8_SA(0, 1), a2, 1, last);
            PG8_WAIT_V(8); PG8_WAIT_L(0); PG8_BAR; PG8_MMA(0, 0, At, B0); PG8_MMA(0, 1, At, B1); PG8_BAR; PG8_SCHED;
            PG8_LDA(At, 1, 1); PG8_STAGE(PG8_SB(1, 0), b3, voffB); PG8_STAGE(PG8_SB(1, 1), b3 + hstepB, voffB); PG8_STAGE_A(PG8_SA(1, 0), a3, 0, last);
            PG8_WAIT_V(8); PG8_WAIT_L(0); PG8_BAR; PG8_MMA(1, 0, At, B0); PG8_MMA(1, 1, At, B1); PG8_BAR; PG8_SCHED;
            } else {
            PG8_LDB(B0, 0, 0); PG8_SCHED; PG8_LDA(At, 0, 0); PG8_STAGE(PG8_SA(1, 1), a1 + hstepA, voffA);
            PG8_WAIT_L(8); PG8_BAR; PG8_WAIT_L(0); PG8_MMA(0, 0, At, B0); PG8_BAR; PG8_SCHED;
            PG8_LDB(B1, 0, 1); PG8_STAGE(PG8_SB(0, 0), b2, voffB);
            PG8_BAR; PG8_WAIT_L(0); PG8_MMA(0, 1, At, B1); PG8_BAR;
            PG8_LDA(At, 0, 1); PG8_STAGE(PG8_SA(0, 0), a2, voffA);
            PG8_BAR; PG8_WAIT_L(0); PG8_MMA(1, 0, At, B0); PG8_BAR; PG8_SCHED;
            PG8_STAGE(PG8_SB(0, 1), b2 + hstepB, voffB);
            PG8_WAIT_V(6); PG8_BAR; PG8_MMA(1, 1, At, B1); PG8_BAR;
            PG8_LDB(B0, 1, 0); PG8_SCHED; PG8_LDA(At, 1, 0); PG8_STAGE(PG8_SA(0, 1), a2 + hstepA, voffA);
            PG8_WAIT_L(8); PG8_BAR; PG8_WAIT_L(0); PG8_MMA(0, 0, At, B0); PG8_BAR; PG8_SCHED;
            PG8_LDB(B1, 1, 1); PG8_STAGE(PG8_SB(1, 0), b3, voffB);
            PG8_BAR; PG8_WAIT_L(0); PG8_MMA(0, 1, At, B1); PG8_BAR;
            PG8_LDA(At, 1, 1); PG8_STAGE(PG8_SA(1, 0), a3, voffA);
            PG8_BAR; PG8_WAIT_L(0); PG8_MMA(1, 0, At, B0); PG8_BAR; PG8_SCHED;
            PG8_STAGE(PG8_SB(1, 1), b3 + hstepB, voffB);
            PG8_WAIT_V(6); PG8_BAR; PG8_MMA(1, 1, At, B1); PG8_BAR;
            }
        }
        if constexpr (ALIGN_EPI) { if (wr == 0) PG8_BAR; }
        const bool reset_acc = E(acc, cur, wr, wc, fr, fq);
        if (!has_next) break;
        if (reset_acc) {
#pragma unroll
        for (int a = 0; a < 2; ++a)
#pragma unroll
            for (int b = 0; b < 2; ++b)
#pragma unroll
                for (int m = 0; m < 4; ++m)
#pragma unroll
                    for (int n = 0; n < 2; ++n) acc[a][b][m][n] = (f32x4){0.f, 0.f, 0.f, 0.f};
        }
        cur = nxt; cA = nA; cB = nB; ++ui;
        if constexpr (GATHER) PG8_GCONV(gvo, gnx);
        if constexpr (ALIGN_EPI) { if (wr == 1) PG8_BAR; }
    }
    PG8_WAIT_V(0);
    if constexpr (!ALIGN_EPI) { if (wr == 0) PG8_BAR; }
    PG8_BAR;
#undef PG8_SA
#undef PG8_SB
#undef PG8_STAGE
#undef PG8_STAGE_A
#undef PG8_GCONV
#undef PG8_GLOAD
#undef PG8_LDA
#undef PG8_LDB
#undef PG8_MMA
#undef PG8_WAIT_V
#undef PG8_WAIT_L
#undef PG8_BAR
#undef PG8_SCHED
}
}

constexpr size_t MiB = 1u << 20;
constexpr size_t WS_CTL = 0, CTL_ZERO_BYTES = 1 * MiB;
constexpr size_t WS_WIN = 2 * MiB;
constexpr size_t WS_WCAT = WS_WIN + 30 * MiB;
constexpr size_t WS_WOUT = WS_WCAT + 6 * MiB;
constexpr size_t WS_WEI = WS_WOUT + 4 * MiB;
constexpr size_t WS_WEO = WS_WEI + 128 * MiB;
constexpr size_t WS_H = WS_WEO + 64 * MiB;
constexpr size_t WS_PROJ = WS_H + 32 * MiB;
constexpr size_t WS_Q = WS_PROJ + 240 * MiB;
constexpr size_t WS_K = WS_Q + 16 * MiB;
constexpr size_t WS_KMEAN = WS_K + 16 * MiB;
constexpr size_t WS_CAT = WS_KMEAN + 1 * MiB;
constexpr size_t WS_MERGED = WS_CAT + 48 * MiB;
constexpr size_t WS_ORAW = WS_MERGED + 32 * MiB;
constexpr size_t WS_ROUTE = WS_ORAW + 32 * MiB;
constexpr size_t WS_POS = WS_ROUTE + 1 * MiB;
constexpr size_t WS_HS = WS_POS + 1 * MiB;
constexpr size_t WS_ACT = WS_HS + 80 * MiB;
constexpr size_t WS_YS = WS_ACT + 40 * MiB;
constexpr size_t WS_XB = WS_YS + 80 * MiB;
constexpr size_t WS_GT = WS_XB + 32 * MiB;
constexpr size_t WS_END = WS_GT + 96 * MiB;
static_assert(WS_END <= 1000 * MiB, "workspace map");
constexpr int CW_BAR = 4096;
constexpr int CW_CNT = 16384;
constexpr int CW_NT = CW_CNT + 2 * 32 * 64;
constexpr int CW_TILE = CW_NT + 2 * 64;
static_assert((CW_TILE + 2 * 256) * 4 <= (int)CTL_ZERO_BYTES, "ctl");

constexpr int LDS_SCRATCH = 155136, LDSCTL_OFF = LDS_SCRATCH, LDS_BYTES = 155648;

#define GAS __attribute__((address_space(1)))
#define LAS __attribute__((address_space(3)))
typedef unsigned short bf16;
typedef unsigned v4u __attribute__((ext_vector_type(4)));
typedef unsigned v2u __attribute__((ext_vector_type(2)));
typedef float f32x4 __attribute__((ext_vector_type(4)));
typedef float f32x2 __attribute__((ext_vector_type(2)));
#define RLX_AGENT __ATOMIC_RELAXED, __HIP_MEMORY_SCOPE_AGENT
__device__ __forceinline__ unsigned f2bf(float f) { unsigned u = __builtin_bit_cast(unsigned, f); return (u + 0x7fffu + ((u >> 16) & 1u)) >> 16; }
__device__ __forceinline__ unsigned pk2(float lo, float hi) { unsigned r; asm("v_cvt_pk_bf16_f32 %0, %1, %2" : "=v"(r) : "v"(lo), "v"(hi)); return r; }
__device__ __forceinline__ float bflo(unsigned w) { return __uint_as_float(w << 16); }
__device__ __forceinline__ float bfhi(unsigned w) { return __uint_as_float(w & 0xffff0000u); }
__device__ __forceinline__ float bf2f(bf16 v) { return __uint_as_float((unsigned)v << 16); }
__device__ __forceinline__ float sigmoidf_(float x) { return __builtin_amdgcn_rcpf(1.0f + __expf(-x)); }
__device__ __forceinline__ float wave_sum(float v) {
    v += __int_as_float(__builtin_amdgcn_update_dpp(0, __float_as_int(v), 0xB1, 0xf, 0xf, true));
    v += __int_as_float(__builtin_amdgcn_update_dpp(0, __float_as_int(v), 0x4E, 0xf, 0xf, true));
    v += __int_as_float(__builtin_amdgcn_update_dpp(0, __float_as_int(v), 0x141, 0xf, 0xf, true));
    v += __int_as_float(__builtin_amdgcn_update_dpp(0, __float_as_int(v), 0x140, 0xf, 0xf, true));
    { auto r = __builtin_amdgcn_permlane16_swap(__float_as_uint(v), __float_as_uint(v), false, false); v = __uint_as_float(r[0]) + __uint_as_float(r[1]); }
    { auto r = __builtin_amdgcn_permlane32_swap(__float_as_uint(v), __float_as_uint(v), false, false); v = __uint_as_float(r[0]) + __uint_as_float(r[1]); }
    return v;
}

__device__ __forceinline__ void lds_barrier() { asm volatile("s_waitcnt lgkmcnt(0)\n\ts_barrier" ::: "memory"); }

#define XB_TMO      128
#define XB_XCNT(j)  (256  + 64 * (j))
#define XB_XSUB(j)  (1280 + 64 * (j))
#define XB_XGEN(j)  (2304 + 64 * (j))
#define XB_TOP      3328
#define XB_TOPGEN   3392
#define XCD_BAR_WORDS 3456
#define XB_SPIN_CAP (1u << 18)
__device__ __forceinline__ unsigned xb_ld(unsigned* p)              { return __hip_atomic_load(p, __ATOMIC_RELAXED, __HIP_MEMORY_SCOPE_AGENT); }
__device__ __forceinline__ unsigned xb_add(unsigned* p, unsigned v) { return __hip_atomic_fetch_add(p, v, __ATOMIC_RELAXED, __HIP_MEMORY_SCOPE_AGENT); }
__device__ __forceinline__ unsigned xb_xcc_id() { return (unsigned)__builtin_amdgcn_s_getreg((3 << 11) | 20) & 0xFu; }
#define XB_SPIN(cond, bar) do { unsigned _sp = 0; while (cond) { __builtin_amdgcn_s_sleep(1); \
    if ((++_sp & 255u) == 0u) { if (xb_ld(&(bar)[XB_TMO])) break; if (_sp > XB_SPIN_CAP) { atomicAdd(&(bar)[XB_TMO], 1u); break; } } } } while (0)
struct XcdBarrier { unsigned* bar; unsigned x; volatile LAS unsigned* st; };
__device__ __forceinline__ XcdBarrier xcd_barrier_post(unsigned* bar, volatile LAS unsigned* st) {
    XcdBarrier b; b.bar = bar; b.x = xb_xcc_id(); b.st = st;
    if (threadIdx.x == 0) (void)xb_add(&bar[XB_XCNT(b.x)], 1u);
    return b;
}
__device__ __forceinline__ void xcd_barrier_complete(unsigned* bar, unsigned x, unsigned& nloc, unsigned& nx) {
    const unsigned G = gridDim.x * gridDim.y * gridDim.z;
    unsigned sum, cnt, mine, sp = 0u;
    for (;;) {
        sum = 0u; cnt = 0u; mine = 0u;
#pragma unroll
        for (unsigned j = 0; j < 16; ++j) { const unsigned c = xb_ld(&bar[XB_XCNT(j)]); sum += c; cnt += (c > 0u) ? 1u : 0u; mine = (j == x) ? c : mine; }
        if (sum == G) break;
        __builtin_amdgcn_s_sleep(1);
        if ((++sp & 255u) == 0u) { if (xb_ld(&bar[XB_TMO])) break; if (sp > XB_SPIN_CAP) { atomicAdd(&bar[XB_TMO], 1u); break; } }
    }
    nloc = mine > 0u ? mine : 1u; nx = cnt > 0u ? cnt : 1u;
}
__device__ __forceinline__ void xcd_barrier(const XcdBarrier& b) {
    asm volatile("s_waitcnt vmcnt(0)" ::: "memory");
    __syncthreads();
    if (threadIdx.x == 0) {
        unsigned* bar = b.bar;
        __builtin_amdgcn_s_waitcnt(0);
        unsigned nloc = b.st[0], nx = b.st[1];
        if (nloc == 0u) { xcd_barrier_complete(bar, b.x, nloc, nx); b.st[0] = nloc; b.st[1] = nx; }
        const unsigned old = xb_add(&bar[XB_XSUB(b.x)], 1u);
        const unsigned gen = old / nloc;
        if (old + 1u == (gen + 1u) * nloc) {
            __builtin_amdgcn_fence(__ATOMIC_RELEASE, "agent");
            asm volatile("s_waitcnt vmcnt(0)" ::: "memory");
            const unsigned og = xb_add(&bar[XB_TOP], 1u);
            const unsigned tg = og / nx;
            if (og + 1u == (tg + 1u) * nx) xb_add(&bar[XB_TOPGEN], 1u);
            else XB_SPIN(xb_ld(&bar[XB_TOPGEN]) == tg, bar);
            __builtin_amdgcn_fence(__ATOMIC_ACQUIRE, "agent");
            xb_add(&bar[XB_XGEN(b.x)], 1u);
            asm volatile("s_waitcnt vmcnt(0)" ::: "memory");
        } else {
            XB_SPIN(xb_ld(&bar[XB_XGEN(b.x)]) == gen, bar);
            __builtin_amdgcn_fence(__ATOMIC_ACQUIRE, "agent");
            asm volatile("s_waitcnt vmcnt(0)" ::: "memory");
        }
    }
    __syncthreads();
}

struct Args { const float* in[23]; float* out; unsigned char* ws; int ph_lo, ph_hi; };
typedef const Args __attribute__((address_space(4))) CArgs;
enum InIdx { I_X = 0, I_MIXG, I_WIN, I_BGATE, I_QG, I_KG, I_LBL, I_HGG, I_CONVW, I_CONVB, I_CLNG, I_CLNB, I_WATT, I_WHGRN, I_WCONV, I_WOUT, I_FFNG, I_WCO, I_BCO, I_WFI, I_BFI, I_WEI, I_WEO };

struct Frame {
    unsigned char* lds;
    int tid, lane, wave, G, bid;
    unsigned char* ws; unsigned* ctl;
};
__device__ __forceinline__ int xcd_order(int bid, int G) { return (G % 8 == 0) ? (bid % 8) * (G / 8) + bid / 8 : bid; }
__device__ __forceinline__ int lane_id_asm() { int l; asm volatile("v_mbcnt_lo_u32_b32 %0, -1, 0\n\tv_mbcnt_hi_u32_b32 %0, -1, %0" : "=v"(l)); return l; }
__device__ __forceinline__ Frame fresh(Frame F) { asm volatile("" : "+v"(F.tid)); F.lane = F.tid & 63; return F; }

struct TItem { const float* W; bf16* WT; int K, N, k0, n0, drow0; };
__device__ __forceinline__ void titem_load(const TItem& t, int lane, float (&v)[32]) {
#pragma unroll
    for (int i = 0; i < 32; ++i) { const int kk = 2 * i + (lane >> 5); v[i] = __builtin_nontemporal_load(t.W + (size_t)(t.k0 + kk) * t.N + t.n0 + (lane & 31)); }
}
__device__ __forceinline__ void titem_emit(const TItem& t, int lane, const float (&v)[32], float* scr) {
#pragma unroll
    for (int i = 0; i < 32; ++i) { const int kk = 2 * i + (lane >> 5); scr[kk * 33 + (lane & 31)] = v[i]; }
    asm volatile("s_waitcnt lgkmcnt(0)" ::: "memory");
    const int c = lane & 7;
#pragma unroll
    for (int j = 0; j < 4; ++j) { const int n = (lane >> 3) + 8 * j; const float* s = scr + (8 * c) * 33 + n;
        v4u o; o.x = pk2(s[0 * 33], s[1 * 33]); o.y = pk2(s[2 * 33], s[3 * 33]); o.z = pk2(s[4 * 33], s[5 * 33]); o.w = pk2(s[6 * 33], s[7 * 33]);
        *(v4u*)(t.WT + (size_t)(t.drow0 + n) * t.K + t.k0 + 8 * c) = o; }
    asm volatile("s_waitcnt lgkmcnt(0)" ::: "memory");
}
__device__ __forceinline__ TItem titem_decode(CArgs& A, unsigned char* ws, int it) {
    constexpr int I_IN = (DM / 64) * (NCOL / 32), I_BR = (512 / 64) * (DM / 32), I_OUT = (DM / 64) * (DM / 32), I_EI = (DM / 64) * (1024 / 32), I_EO = (FF / 64) * (DM / 32);
    constexpr int PER_L = I_IN + 3 * I_BR + I_OUT + NEXP * I_EI + NEXP * I_EO;
    TItem t; const int l = it / PER_L; int r = it % PER_L;
    if (r < I_IN) { const int nblk = NCOL / 32, kb = r / nblk, nb = r % nblk;
        t.W = A.in[I_WIN] + (size_t)l * DM * NCOL; t.K = DM; t.N = NCOL; t.WT = (bf16*)(ws + WS_WIN) + (size_t)l * NCOL * DM; t.k0 = 64 * kb; t.n0 = 32 * nb; t.drow0 = 32 * nb; return t; }
    r -= I_IN;
    if (r < 3 * I_BR) { const int br = r / I_BR, rr = r % I_BR, nblk = DM / 32, kb = rr / nblk, nb = rr % nblk;
        t.W = A.in[br == 0 ? I_WATT : (br == 1 ? I_WHGRN : I_WCONV)] + (size_t)l * 512 * DM; t.K = 512; t.N = DM; t.WT = (bf16*)(ws + WS_WCAT) + ((size_t)l * 3 + br) * DM * 512; t.k0 = 64 * kb; t.n0 = 32 * nb; t.drow0 = 32 * nb; return t; }
    r -= 3 * I_BR;
    if (r < I_OUT) { const int nblk = DM / 32, kb = r / nblk, nb = r % nblk;
        t.W = A.in[I_WOUT] + (size_t)l * DM * DM; t.K = DM; t.N = DM; t.WT = (bf16*)(ws + WS_WOUT) + (size_t)l * DM * DM; t.k0 = 64 * kb; t.n0 = 32 * nb; t.drow0 = 32 * nb; return t; }
    r -= I_OUT;
    if (r < NEXP * I_EI) { const int e = r / I_EI, rr = r % I_EI, nblk = 1024 / 32, kb = rr / nblk, nb = rr % nblk, n0 = 32 * nb;
        const int nn = n0 & 511;
        t.W = A.in[I_WEI] + ((size_t)l * NEXP + e) * DM * 1024; t.K = DM; t.N = 1024; t.WT = (bf16*)(ws + WS_WEI) + ((size_t)l * NEXP + e) * 1024 * DM; t.k0 = 64 * kb; t.n0 = n0; t.drow0 = (nn >> 7) * 256 + (n0 >= 512 ? 128 : 0) + (nn & 127); return t; }
    r -= NEXP * I_EI;
    { const int e = r / I_EO, rr = r % I_EO, nblk = DM / 32, kb = rr / nblk, nb = rr % nblk;
        t.W = A.in[I_WEO] + ((size_t)l * NEXP + e) * FF * DM; t.K = FF; t.N = DM; t.WT = (bf16*)(ws + WS_WEO) + ((size_t)l * NEXP + e) * DM * FF; t.k0 = 64 * kb; t.n0 = 32 * nb; t.drow0 = 32 * nb; return t; }
}
__device__ __forceinline__ void phase_prologue(const Frame& F0, CArgs& A) {
    const Frame F = fresh(F0);
    float* scr = (float*)(F.lds + F.wave * 16384);
    const int gw = F.bid * 8 + F.wave, NGW = F.G * 8;
    constexpr int I_IN = (DM / 64) * (NCOL / 32), I_BR = (512 / 64) * (DM / 32), I_OUT = (DM / 64) * (DM / 32), I_EI = (DM / 64) * (1024 / 32), I_EO = (FF / 64) * (DM / 32);
    constexpr int NIT = DEPTH * (I_IN + 3 * I_BR + I_OUT + NEXP * I_EI + NEXP * I_EO);
    if (gw >= NIT) return;
    float cur[32], nxt[32];
    TItem tc = titem_decode(A, F.ws, gw);
    titem_load(tc, F.lane, cur);
    for (int it = gw; it < NIT; it += NGW) {
        TItem tn = tc; const bool more = (it + NGW < NIT);
        if (more) { tn = titem_decode(A, F.ws, it + NGW); titem_load(tn, F.lane, nxt); }
        titem_emit(tc, F.lane, cur, scr);
        if (more) {
#pragma unroll
            for (int i = 0; i < 32; ++i) cur[i] = nxt[i];
            tc = tn; }
    }
}

__device__ __forceinline__ void phase_norm(const Frame& F0, const float* x, const float* gain, bf16* out) {
    const Frame F = fresh(F0);
    const int gw = F.bid * 8 + F.wave, NGW = F.G * 8;
    f32x4 g[4];
#pragma unroll
    for (int j = 0; j < 4; ++j) g[j] = *(const f32x4*)(gain + 4 * F.lane + 256 * j);
    const int RPW = (T + NGW - 1) / NGW, mbase = (xcd_order(F.bid, F.G) * 8 + F.wave) * RPW;
    for (int r0 = 0; r0 < RPW; r0 += 4) {
        f32x4 v[4][4];
#pragma unroll
        for (int q = 0; q < 4; ++q) { const int m = (r0 + q < RPW) ? mbase + r0 + q : T; if (m < T) { const f32x4* xr = (const f32x4*)(x + (size_t)m * DM) + F.lane;
#pragma unroll
                for (int j = 0; j < 4; ++j) v[q][j] = xr[64 * j]; } }
#pragma unroll
        for (int q = 0; q < 4; ++q) { const int m = (r0 + q < RPW) ? mbase + r0 + q : T; if (m < T) { float s = 0.f;
#pragma unroll
                for (int j = 0; j < 4; ++j) s += (v[q][j].x * v[q][j].x + v[q][j].y * v[q][j].y) + (v[q][j].z * v[q][j].z + v[q][j].w * v[q][j].w);
                const float r = rsqrtf(wave_sum(s) * (1.f / DM) + RMS_EPS);
                v2u* o8 = (v2u*)(out + (size_t)m * DM) + F.lane;
#pragma unroll
                for (int j = 0; j < 4; ++j) { v2u w; w.x = pk2(v[q][j].x * r * g[j].x, v[q][j].y * r * g[j].y); w.y = pk2(v[q][j].z * r * g[j].z, v[q][j].w * r * g[j].w); o8[64 * j] = w; } } }
    }
}

__device__ __forceinline__ void phase_qkprep(const Frame& F0, const bf16* proj, const float* qg, const float* kg, bf16* Q, bf16* Kb, float* kmean) {
    const Frame F = fresh(F0);
    float* red = (float*)F.lds;
    float* red2 = red + 256 * 65;
    const int tok = F.tid >> 1, hf = F.tid & 1;
    float qgv[32], kgv[32];
#pragma unroll
    for (int i = 0; i < 8; ++i) { const f32x4 a = *(const f32x4*)(qg + hf * 32 + 4 * i), c = *(const f32x4*)(kg + hf * 32 + 4 * i);
        qgv[4 * i] = a.x; qgv[4 * i + 1] = a.y; qgv[4 * i + 2] = a.z; qgv[4 * i + 3] = a.w; kgv[4 * i] = c.x; kgv[4 * i + 1] = c.y; kgv[4 * i + 2] = c.z; kgv[4 * i + 3] = c.w; }
    for (int u = xcd_order(F.bid, F.G); u < 512; u += F.G) {
        const int b = u >> 6, blk = (u >> 3) & 7, h = u & 7;
        const size_t row = (size_t)b * SEQ + blk * 256 + tok;
        const bf16* pq = proj + row * NCOL + C_AQ + h * 64 + hf * 32;
        const bf16* pk = proj + row * NCOL + C_AK + h * 64 + hf * 32;
        float qv[32], kv[32];
#pragma unroll
        for (int i = 0; i < 4; ++i) { const v4u a = *(const v4u*)(pq + 8 * i), c = *(const v4u*)(pk + 8 * i);
            qv[8 * i + 0] = bflo(a.x); qv[8 * i + 1] = bfhi(a.x); qv[8 * i + 2] = bflo(a.y); qv[8 * i + 3] = bfhi(a.y); qv[8 * i + 4] = bflo(a.z); qv[8 * i + 5] = bfhi(a.z); qv[8 * i + 6] = bflo(a.w); qv[8 * i + 7] = bfhi(a.w);
            kv[8 * i + 0] = bflo(c.x); kv[8 * i + 1] = bfhi(c.x); kv[8 * i + 2] = bflo(c.y); kv[8 * i + 3] = bfhi(c.y); kv[8 * i + 4] = bflo(c.z); kv[8 * i + 5] = bfhi(c.z); kv[8 * i + 6] = bflo(c.w); kv[8 * i + 7] = bfhi(c.w); }
        float sq = 0.f, sk = 0.f;
#pragma unroll
        for (int i = 0; i < 32; ++i) { sq += qv[i] * qv[i]; sk += kv[i] * kv[i]; }
        sq += __shfl_xor(sq, 1); sk += __shfl_xor(sk, 1);
        const float rq = rsqrtf(sq * (1.f / 64.f) + RMS_EPS) * QSCALE, rk = rsqrtf(sk * (1.f / 64.f) + RMS_EPS);
#pragma unroll
        for (int i = 0; i < 32; ++i) { qv[i] = qv[i] * rq * qgv[i]; kv[i] = kv[i] * rk * kgv[i]; }
        bf16* oq = Q + row * 512 + h * 64 + hf * 32; bf16* ok = Kb + row * 512 + h * 64 + hf * 32;
#pragma unroll
        for (int i = 0; i < 4; ++i) { v4u a, c;
            a.x = pk2(qv[8 * i], qv[8 * i + 1]); a.y = pk2(qv[8 * i + 2], qv[8 * i + 3]); a.z = pk2(qv[8 * i + 4], qv[8 * i + 5]); a.w = pk2(qv[8 * i + 6], qv[8 * i + 7]);
            c.x = pk2(kv[8 * i], kv[8 * i + 1]); c.y = pk2(kv[8 * i + 2], kv[8 * i + 3]); c.z = pk2(kv[8 * i + 4], kv[8 * i + 5]); c.w = pk2(kv[8 * i + 6], kv[8 * i + 7]);
            *(v4u*)(oq + 8 * i) = a; *(v4u*)(ok + 8 * i) = c; }
        __syncthreads();
#pragma unroll
        for (int i = 0; i < 32; ++i) red[tok * 65 + hf * 32 + i] = kv[i];
        __syncthreads();
        { const int d = F.tid & 63, part = F.tid >> 6; float s = 0.f;
            for (int tk = 0; tk < 32; ++tk) s += red[(part * 32 + tk) * 65 + d];
            red2[part * 64 + d] = s; }
        __syncthreads();
        if (F.tid < 64) { float s = 0.f;
#pragma unroll
            for (int p = 0; p < 8; ++p) s += red2[p * 64 + F.tid];
            kmean[(((size_t)b * 8 + h) * 8 + blk) * 64 + F.tid] = s * (1.f / 256.f); }
    }
    __syncthreads();
}

__device__ __forceinline__ void phase_conv(const Frame& F0, const bf16* proj, const float* cw, const float* cb, const float* lng, const float* lnb, bf16* cat) {
    const Frame F = fresh(F0);
    float* ut = (float*)F.lds;
    const int c = F.tid;
    float w[31];
#pragma unroll
    for (int j = 0; j < 31; ++j) w[j] = cw[j * 512 + c];
    const float bias = cb[c];
    const f32x4 g0 = *(const f32x4*)(lng + 8 * F.lane), g1 = *(const f32x4*)(lng + 8 * F.lane + 4), b0 = *(const f32x4*)(lnb + 8 * F.lane), b1 = *(const f32x4*)(lnb + 8 * F.lane + 4);
    for (int u = xcd_order(F.bid, F.G); u < 512; u += F.G) {
        const int b = u >> 6, t0 = (u & 63) * 32;
        __syncthreads();
        {
            v4u av[8], gv[8];
#pragma unroll
            for (int i = 0; i < 8; ++i) { const int idx = F.tid + 512 * i, r = idx >> 6, ch = (idx & 63) * 8, t = t0 - 30 + r;
                if (r < 62 && t >= 0) { const bf16* p = proj + ((size_t)b * SEQ + t) * NCOL + ch; av[i] = *(const v4u*)(p + C_CA); gv[i] = *(const v4u*)(p + C_CB); }
                else { av[i] = (v4u){0u, 0u, 0u, 0u}; gv[i] = (v4u){0u, 0u, 0u, 0u}; } }
#pragma unroll
            for (int i = 0; i < 8; ++i) { const int idx = F.tid + 512 * i, r = idx >> 6, ch = (idx & 63) * 8;
                if (r < 62) {
                    f32x4 u0, u1;
                    u0.x = bflo(av[i].x) * sigmoidf_(bflo(gv[i].x)); u0.y = bfhi(av[i].x) * sigmoidf_(bfhi(gv[i].x)); u0.z = bflo(av[i].y) * sigmoidf_(bflo(gv[i].y)); u0.w = bfhi(av[i].y) * sigmoidf_(bfhi(gv[i].y));
                    u1.x = bflo(av[i].z) * sigmoidf_(bflo(gv[i].z)); u1.y = bfhi(av[i].z) * sigmoidf_(bfhi(gv[i].z)); u1.z = bflo(av[i].w) * sigmoidf_(bflo(gv[i].w)); u1.w = bfhi(av[i].w) * sigmoidf_(bfhi(gv[i].w));
                    *(f32x4*)(ut + r * 512 + ch) = u0; *(f32x4*)(ut + r * 512 + ch + 4) = u1; } }
        }
        __syncthreads();
        float uu[62];
#pragma unroll
        for (int i = 0; i < 62; ++i) uu[i] = ut[i * 512 + c];
#pragma unroll
        for (int t = 0; t < 32; ++t) { float a = bias;
#pragma unroll
            for (int j = 0; j < 31; ++j) a += w[j] * uu[t + j];
            ut[t * 512 + c] = a; }
        __syncthreads();
#pragma unroll
        for (int q = 0; q < 4; ++q) { const int t = F.wave * 4 + q;
            const f32x4 v0 = *(const f32x4*)(ut + t * 512 + 8 * F.lane), v1 = *(const f32x4*)(ut + t * 512 + 8 * F.lane + 4);
            const float mu = wave_sum((v0.x + v0.y) + (v0.z + v0.w) + (v1.x + v1.y) + (v1.z + v1.w)) * (1.f / 512.f);
            const f32x4 d0 = v0 - mu, d1 = v1 - mu;
            const float var = wave_sum((d0.x * d0.x + d0.y * d0.y) + (d0.z * d0.z + d0.w * d0.w) + (d1.x * d1.x + d1.y * d1.y) + (d1.z * d1.z + d1.w * d1.w)) * (1.f / 512.f);
            const float rs = rsqrtf(var + LN_EPS);
            f32x4 y0 = d0 * rs * g0 + b0, y1 = d1 * rs * g1 + b1;
            y0.x *= sigmoidf_(y0.x); y0.y *= sigmoidf_(y0.y); y0.z *= sigmoidf_(y0.z); y0.w *= sigmoidf_(y0.w);
            y1.x *= sigmoidf_(y1.x); y1.y *= sigmoidf_(y1.y); y1.z *= sigmoidf_(y1.z); y1.w *= sigmoidf_(y1.w);
            v4u o; o.x = pk2(y0.x, y0.y); o.y = pk2(y0.z, y0.w); o.z = pk2(y1.x, y1.y); o.w = pk2(y1.z, y1.w);
            *(v4u*)(cat + ((size_t)b * SEQ + t0 + t) * 1536 + 1024 + 8 * F.lane) = o; }
    }
    __syncthreads();
}

typedef float f32x16 __attribute__((ext_vector_type(16)));
typedef short bf16x8 __attribute__((ext_vector_type(8)));
typedef short v4i16_t __attribute__((ext_vector_type(4)));
constexpr int AT_KROW = 144, AT_VROW = 192, AT_KBUF = 64 * AT_KROW, AT_VBUF = 64 * AT_VROW, AT_BUF = AT_KBUF + AT_VBUF;
constexpr int AT_WSF = 2 * AT_BUF, AT_STG = AT_WSF + 8 * 256, AT_LDS = AT_STG + 8 * 4096;
__device__ __forceinline__ int crow16(int r, int hi) { return (r & 3) + 8 * (r >> 2) + 4 * hi; }
__device__ __forceinline__ void attn_mfma_unit(const Frame& F, LAS unsigned char* L, int b, int h, int qb, const bf16* Q, const bf16* Kb, const bf16* proj, const float* kmean, bf16* cat) {
    int lane_ = F.lane; asm volatile("" : "+v"(lane_));
    const int lane = lane_, r32 = lane & 31, hi = lane >> 5, wid = F.wave;
    const size_t row0 = (size_t)b * SEQ + qb * 256;
    const int qi = wid * 32 + r32;
    bf16x8 qf[4];
    { const bf16* pq = Q + (row0 + qi) * 512 + h * 64 + hi * 8;
#pragma unroll
        for (int d0 = 0; d0 < 4; ++d0) qf[d0] = *(const bf16x8*)(pq + d0 * 16); }
    unsigned selmask;
    if (qb <= 3) selmask = (1u << qb) - 1u;
    else {
        float b0 = -3.0e38f, b1 = -3.0e38f, b2 = -3.0e38f; int i0 = 0, i1 = 0, i2 = 0;
        float qv[32];
#pragma unroll
        for (int d0 = 0; d0 < 4; ++d0)
#pragma unroll
            for (int e = 0; e < 8; ++e) qv[d0 * 8 + e] = bf2f((bf16)qf[d0][e]);
#pragma unroll 1
        for (int j = 0; j < qb; ++j) { const float* km = kmean + (((size_t)b * 8 + h) * 8 + j) * 64 + hi * 8; float sacc = 0.f;
#pragma unroll
            for (int d0 = 0; d0 < 4; ++d0) { const f32x4 k0 = *(const f32x4*)(km + d0 * 16), k1 = *(const f32x4*)(km + d0 * 16 + 4);
                sacc += qv[d0 * 8 + 0] * k0.x + qv[d0 * 8 + 1] * k0.y + qv[d0 * 8 + 2] * k0.z + qv[d0 * 8 + 3] * k0.w + qv[d0 * 8 + 4] * k1.x + qv[d0 * 8 + 5] * k1.y + qv[d0 * 8 + 6] * k1.z + qv[d0 * 8 + 7] * k1.w; }
            sacc += __shfl_xor(sacc, 32);
            if (sacc > b0) { b2 = b1; i2 = i1; b1 = b0; i1 = i0; b0 = sacc; i0 = j; }
            else if (sacc > b1) { b2 = b1; i2 = i1; b1 = sacc; i1 = j; }
            else if (sacc > b2) { b2 = sacc; i2 = j; } }
        selmask = (1u << i0) | (1u << i1) | (1u << i2);
    }
    const int tid_l = wid * 64 + lane, srow = tid_l >> 3, sch = tid_l & 7;
    const bf16* kg = Kb + ((size_t)b * SEQ + srow) * 512 + h * 64 + sch * 8;
    const bf16* vg = proj + ((size_t)b * SEQ + srow) * NCOL + C_AV + h * 64 + sch * 8;
    const int kst = srow * AT_KROW + sch * 16, vst = AT_KBUF + srow * AT_VROW + sch * 16;
    const int kfo = r32 * AT_KROW + hi * 16;
    const int g16 = lane >> 4, idx = lane & 15;
    const int vfo = AT_KBUF + (4 * (g16 >> 1) + (idx >> 2)) * AT_VROW + ((g16 & 1) * 16 + 4 * (idx & 3)) * 2;
    const int NT = 4 * (qb + 1);
    f32x16 o0 = {}, o1 = {};
    float lsum = 0.f;
    v4u kA = {}, vA = {}, kB, vB;
    { const v4u kk = *(const v4u*)kg, vv = *(const v4u*)vg;
        kB = *(const v4u*)(kg + (size_t)64 * 512); vB = *(const v4u*)(vg + (size_t)64 * NCOL);
        *(LAS v4u*)(L + kst) = kk; *(LAS v4u*)(L + vst) = vv; }
    lds_barrier();
#define AT_TILE(OWN, TT, PAR, KL, VL, KW, VW) do { \
        const int t_ = (TT); constexpr int cb = (PAR) * AT_BUF, nb = AT_BUF - cb;        \
        if (t_ + 2 < NT) { KL = *(const v4u*)(kg + (size_t)(t_ + 2) * 64 * 512); VL = *(const v4u*)(vg + (size_t)(t_ + 2) * 64 * NCOL); } \
        const int j = t_ >> 2, kt = t_ & 3; \
        const bool active = !(OWN) || (kt * 64 <= wid * 32 + 31); \
        if (active) { \
            f32x16 s0, s1; \
            { const float bias = ((OWN) || (((selmask >> j) & 1u) != 0u)) ? 0.f : -1.0e30f; \
                _Pragma("unroll") for (int r = 0; r < 16; ++r) { s0[r] = bias; s1[r] = bias; } } \
            bf16x8 kf[8]; \
            _Pragma("unroll") for (int d0 = 0; d0 < 4; ++d0) { kf[d0] = *(const LAS bf16x8*)(L + cb + kfo + d0 * 32); kf[4 + d0] = *(const LAS bf16x8*)(L + cb + kfo + 32 * AT_KROW + d0 * 32); } \
            _Pragma("unroll") for (int d0 = 0; d0 < 4; ++d0) { \
                s0 = __builtin_amdgcn_mfma_f32_32x32x16_bf16(kf[d0], qf[d0], s0, 0, 0, 0); \
                s1 = __builtin_amdgcn_mfma_f32_32x32x16_bf16(kf[4 + d0], qf[d0], s1, 0, 0, 0); } \
            v4i16_t va[16]; \
            _Pragma("unroll") for (int sub = 0; sub < 2; ++sub) \
                _Pragma("unroll") for (int sI = 0; sI < 2; ++sI) { const int vb = cb + vfo + (sub * 32 + 16 * sI) * AT_VROW, q4 = (sub * 2 + sI) * 4; \
                    va[q4 + 0] = __builtin_amdgcn_ds_read_tr16_b64_v4i16((LAS v4i16_t*)(L + vb)); va[q4 + 1] = __builtin_amdgcn_ds_read_tr16_b64_v4i16((LAS v4i16_t*)(L + vb + 8 * AT_VROW)); \
                    va[q4 + 2] = __builtin_amdgcn_ds_read_tr16_b64_v4i16((LAS v4i16_t*)(L + vb + 64)); va[q4 + 3] = __builtin_amdgcn_ds_read_tr16_b64_v4i16((LAS v4i16_t*)(L + vb + 8 * AT_VROW + 64)); } \
            __builtin_amdgcn_sched_barrier(0); \
            float ps = 0.f; \
            if (OWN) { const int lim = qi - kt * 64; \
                _Pragma("unroll") for (int r = 0; r < 16; ++r) { const int kv = crow16(r, hi); \
                    const float p0 = (kv <= lim) ? __builtin_amdgcn_exp2f(s0[r]) : 0.f, p1 = (kv + 32 <= lim) ? __builtin_amdgcn_exp2f(s1[r]) : 0.f; \
                    s0[r] = p0; s1[r] = p1; ps += p0 + p1; } \
            } else { \
                _Pragma("unroll") for (int r = 0; r < 16; ++r) { const float p0 = __builtin_amdgcn_exp2f(s0[r]), p1 = __builtin_amdgcn_exp2f(s1[r]); s0[r] = p0; s1[r] = p1; ps += p0 + p1; } } \
            lsum += ps; \
            bf16x8 pa[4]; \
            _Pragma("unroll") for (int sI = 0; sI < 2; ++sI) { v4u w0, w1; \
                w0.x = pg8::cvt_pk_bf16(s0[8 * sI + 0], s0[8 * sI + 1]); w0.y = pg8::cvt_pk_bf16(s0[8 * sI + 2], s0[8 * sI + 3]); w0.z = pg8::cvt_pk_bf16(s0[8 * sI + 4], s0[8 * sI + 5]); w0.w = pg8::cvt_pk_bf16(s0[8 * sI + 6], s0[8 * sI + 7]); \
                w1.x = pg8::cvt_pk_bf16(s1[8 * sI + 0], s1[8 * sI + 1]); w1.y = pg8::cvt_pk_bf16(s1[8 * sI + 2], s1[8 * sI + 3]); w1.z = pg8::cvt_pk_bf16(s1[8 * sI + 4], s1[8 * sI + 5]); w1.w = pg8::cvt_pk_bf16(s1[8 * sI + 6], s1[8 * sI + 7]); \
                pa[sI] = __builtin_bit_cast(bf16x8, w0); pa[2 + sI] = __builtin_bit_cast(bf16x8, w1); } \
            _Pragma("unroll") for (int q = 0; q < 4; ++q) { \
                const bf16x8 v0 = (bf16x8){va[4 * q][0], va[4 * q][1], va[4 * q][2], va[4 * q][3], va[4 * q + 1][0], va[4 * q + 1][1], va[4 * q + 1][2], va[4 * q + 1][3]}; \
                const bf16x8 v1 = (bf16x8){va[4 * q + 2][0], va[4 * q + 2][1], va[4 * q + 2][2], va[4 * q + 2][3], va[4 * q + 3][0], va[4 * q + 3][1], va[4 * q + 3][2], va[4 * q + 3][3]}; \
                o0 = __builtin_amdgcn_mfma_f32_32x32x16_bf16(pa[q], v0, o0, 0, 0, 0); \
                o1 = __builtin_amdgcn_mfma_f32_32x32x16_bf16(pa[q], v1, o1, 0, 0, 0); } \
        } \
        if (t_ + 1 < NT) { *(LAS v4u*)(L + nb + kst) = KW; *(LAS v4u*)(L + nb + vst) = VW; } \
        lds_barrier(); \
    } while (0)
    int t = 0;
#pragma unroll 1
    for (; t < NT - 4; t += 2) { AT_TILE(false, t, 0, kA, vA, kB, vB); AT_TILE(false, t + 1, 1, kB, vB, kA, vA); }
#pragma unroll 1
    for (; t < NT; t += 2) { AT_TILE(true, t, 0, kA, vA, kB, vB); AT_TILE(true, t + 1, 1, kB, vB, kA, vA); }
#undef AT_TILE
    lsum += __shfl_xor(lsum, 32);
    LAS float* wsf = (LAS float*)(L + AT_WSF + wid * 256);
    if (hi == 0) wsf[r32] = lsum;
    asm volatile("s_waitcnt lgkmcnt(0)" ::: "memory");
    LAS bf16* stg = (LAS bf16*)(L + AT_STG + wid * 4096);
#pragma unroll
    for (int r = 0; r < 16; ++r) { const int orow = crow16(r, hi); const float rl = 1.f / wsf[orow];
        stg[orow * 64 + r32] = (bf16)f2bf(o0[r] * rl); stg[orow * 64 + 32 + r32] = (bf16)f2bf(o1[r] * rl); }
    asm volatile("s_waitcnt lgkmcnt(0)" ::: "memory");
    bf16* po = cat + (row0 + wid * 32) * 1536 + h * 64;
#pragma unroll
    for (int i = 0; i < 4; ++i) { const int row = i * 8 + (lane >> 3), ch = lane & 7; const v4u v = *(const LAS v4u*)(stg + row * 64 + ch * 8); *(v4u*)(po + (size_t)row * 1536 + ch * 8) = v; }
    lds_barrier();
}
__device__ __forceinline__ void phase_attn_mfma(const Frame& F0, const bf16* Q, const bf16* Kb, const bf16* proj, const float* kmean, bf16* cat) {
    const Frame F = fresh(F0);
    LAS unsigned char* L = (LAS unsigned char*)F.lds;
    for (int p = xcd_order(F.bid, F.G); p < 256; p += F.G) {
        const int bh = p >> 2, s = p & 3;
#pragma unroll 1
        for (int i = 0; i < 2; ++i) attn_mfma_unit(F, L, bh >> 3, bh & 7, i ? s : 7 - s, Q, Kb, proj, kmean, cat);
    }
}

template <bool PERM> __device__ __forceinline__ bf16x8 tr_frag(LAS unsigned char* tile, int pitch, int rbase, int cbase, int lane) {
    const int g16 = lane >> 4, idx = lane & 15, h = g16 >> 1;
    LAS unsigned char* p = tile + (rbase + (PERM ? 4 : 8) * h + (idx >> 2)) * pitch + (cbase + (g16 & 1) * 16 + 4 * (idx & 3)) * 2;
    const v4i16_t a0 = __builtin_amdgcn_ds_read_tr16_b64_v4i16((LAS v4i16_t*)p), a1 = __builtin_amdgcn_ds_read_tr16_b64_v4i16((LAS v4i16_t*)(p + (PERM ? 8 : 4) * pitch));
    return (bf16x8){a0[0], a0[1], a0[2], a0[3], a1[0], a1[1], a1[2], a1[3]};
}
constexpr int H1_G = 0, H1_QD = 32768, H1_KD = H1_QD + 64 * 272, H1_KE = H1_KD + 64 * 272, H1_VT = H1_KE + 64 * 320, H1_SP = H1_VT + 64 * 320, H1_TOT = H1_SP + 128 * 320, H1_BO = H1_TOT + 2048, H1_LB = H1_BO + 512, H1_CK = H1_LB + 512, H1_END = H1_CK + 2048;
static_assert(H1_END <= LDS_SCRATCH, "hgrn pass 1 lds");
__device__ __forceinline__ void hgrn_pass1_unit(const Frame& F, LAS unsigned char* L, int u, const bf16* proj, const float* lbl, int layer, float* Lg, float* Dg, float* OL, bf16* Qb) {
    const int b = u >> 5, h = (u >> 3) & 3, blk = u & 7;
    const int lane = F.lane, r32 = lane & 31, hi = lane >> 5, wid = F.wave, tid = F.tid;
    const int tt = tid >> 3, cg = tid & 7, ch = cg * 16;
    LAS float* G = (LAS float*)(L + H1_G); LAS float* TOT = (LAS float*)(L + H1_TOT);
    LAS float* BO = (LAS float*)(L + H1_BO); LAS float* LB = (LAS float*)(L + H1_LB); LAS float* CK = (LAS float*)(L + H1_CK);
    if (tid < 128) { float lb = 0.f;
        if (layer > 0) { const float l0 = lbl[h * 128 + tid], l1 = lbl[512 + h * 128 + tid]; lb = 1.f / (1.f + __expf(l0 - l1)); }
        LB[tid] = lb; BO[tid] = 0.f; }
    lds_barrier();
    f32x16 S[2]; S[0] = (f32x16){}; S[1] = (f32x16){};
    const size_t rowb = (size_t)b * SEQ + blk * 256;
    const int tt2 = wid >> 2, vt = wid & 3;
    v4u nx[6];
    { const bf16* pr = proj + (rowb + tt) * NCOL + h * 128 + ch;
        nx[0] = *(const v4u*)(pr + C_HF); nx[1] = *(const v4u*)(pr + C_HF + 8); nx[2] = *(const v4u*)(pr + C_HQ); nx[3] = *(const v4u*)(pr + C_HQ + 8); nx[4] = *(const v4u*)(pr + C_HI); nx[5] = *(const v4u*)(pr + C_HI + 8); }
    for (int c = 0; c < 4; ++c) {
        const size_t row = rowb + c * 64 + tt;
        float kk[16], qa[16];
        {
            const v4u f0 = nx[0], f1 = nx[1], q0 = nx[2], q1 = nx[3], v0 = nx[4], v1 = nx[5];
            if (c < 3) { const bf16* pr = proj + (row + 64) * NCOL + h * 128 + ch;
                nx[0] = *(const v4u*)(pr + C_HF); nx[1] = *(const v4u*)(pr + C_HF + 8); nx[2] = *(const v4u*)(pr + C_HQ); nx[3] = *(const v4u*)(pr + C_HQ + 8); nx[4] = *(const v4u*)(pr + C_HI); nx[5] = *(const v4u*)(pr + C_HI + 8); }
            const unsigned fw[8] = {f0.x, f0.y, f0.z, f0.w, f1.x, f1.y, f1.z, f1.w}, qw[8] = {q0.x, q0.y, q0.z, q0.w, q1.x, q1.y, q1.z, q1.w};
            float gl[16], lbv[16];
#pragma unroll
            for (int i = 0; i < 4; ++i) { const f32x4 x = *(const LAS f32x4*)(LB + ch + 4 * i); lbv[4 * i] = x.x; lbv[4 * i + 1] = x.y; lbv[4 * i + 2] = x.z; lbv[4 * i + 3] = x.w; }
#pragma unroll
            for (int i = 0; i < 16; ++i) { const float fr = (i & 1) ? bfhi(fw[i >> 1]) : bflo(fw[i >> 1]); const float sig = sigmoidf_(fr);
                gl[i] = __logf(lbv[i] + (1.f - lbv[i]) * sig); kk[i] = (1.f - lbv[i]) * (1.f - sig);
                const float qv = (i & 1) ? bfhi(qw[i >> 1]) : bflo(qw[i >> 1]); qa[i] = qv * sigmoidf_(qv); }
#pragma unroll
            for (int i = 0; i < 4; ++i) *(LAS f32x4*)(G + tt * 128 + ch + 4 * i) = (f32x4){gl[4 * i], gl[4 * i + 1], gl[4 * i + 2], gl[4 * i + 3]};
            *(LAS v4u*)(L + H1_VT + tt * 320 + ch * 2) = v0; *(LAS v4u*)(L + H1_VT + tt * 320 + ch * 2 + 16) = v1;
        }
        lds_barrier();
        {
            const int k = tid & 127, part = tid >> 7; float a[16];
#pragma unroll
            for (int i = 0; i < 16; ++i) a[i] = G[(part * 16 + i) * 128 + k];
#pragma unroll
            for (int i = 1; i < 16; ++i) a[i] += a[i - 1];
            TOT[part * 128 + k] = a[15];
            lds_barrier();
            float pre = 0.f;
#pragma unroll
            for (int p = 0; p < 3; ++p) if (p < part) pre += TOT[p * 128 + k];
#pragma unroll
            for (int i = 0; i < 16; ++i) G[(part * 16 + i) * 128 + k] = a[i] + pre;
            if (part == 3) {
                const float bmk = TOT[k] + TOT[128 + k], bek = pre + a[15];
                CK[k] = __expf(bmk); CK[128 + k] = __expf(bek); CK[256 + k] = __expf(bek - bmk); CK[384 + k] = __expf(BO[k] + bmk); }
        }
        lds_barrier();
        {
#pragma unroll
            for (int hh = 0; hh < 2; ++hh) {
                float bb[8], bm[8], cem[8], com[8];
#pragma unroll
                for (int i = 0; i < 2; ++i) { const f32x4 x = *(const LAS f32x4*)(G + tt * 128 + ch + 8 * hh + 4 * i), y = *(const LAS f32x4*)(G + 31 * 128 + ch + 8 * hh + 4 * i), z = *(const LAS f32x4*)(CK + 256 + ch + 8 * hh + 4 * i), o4 = *(const LAS f32x4*)(CK + 384 + ch + 8 * hh + 4 * i);
                    bb[4 * i] = x.x; bb[4 * i + 1] = x.y; bb[4 * i + 2] = x.z; bb[4 * i + 3] = x.w; bm[4 * i] = y.x; bm[4 * i + 1] = y.y; bm[4 * i + 2] = y.z; bm[4 * i + 3] = y.w;
                    cem[4 * i] = z.x; cem[4 * i + 1] = z.y; cem[4 * i + 2] = z.z; cem[4 * i + 3] = z.w; com[4 * i] = o4.x; com[4 * i + 1] = o4.y; com[4 * i + 2] = o4.z; com[4 * i + 3] = o4.w; }
                float ex[8], rex[8], t8[8]; v4u w;
#pragma unroll
                for (int i = 0; i < 8; ++i) { ex[i] = __expf(bb[i] - bm[i]); rex[i] = __builtin_amdgcn_rcpf(ex[i]); }
#pragma unroll
                for (int i = 0; i < 8; ++i) t8[i] = kk[8 * hh + i] * rex[i] * cem[i];
                w.x = pk2(t8[0], t8[1]); w.y = pk2(t8[2], t8[3]); w.z = pk2(t8[4], t8[5]); w.w = pk2(t8[6], t8[7]); *(LAS v4u*)(L + H1_KE + tt * 320 + ch * 2 + 16 * hh) = w;
#pragma unroll
                for (int i = 0; i < 8; ++i) t8[i] = qa[8 * hh + i] * ex[i];
                w.x = pk2(t8[0], t8[1]); w.y = pk2(t8[2], t8[3]); w.z = pk2(t8[4], t8[5]); w.w = pk2(t8[6], t8[7]); *(LAS v4u*)(L + H1_QD + tt * 272 + ch * 2 + 16 * hh) = w;
#pragma unroll
                for (int i = 0; i < 8; ++i) t8[i] = kk[8 * hh + i] * rex[i];
                w.x = pk2(t8[0], t8[1]); w.y = pk2(t8[2], t8[3]); w.z = pk2(t8[4], t8[5]); w.w = pk2(t8[6], t8[7]); *(LAS v4u*)(L + H1_KD + tt * 272 + ch * 2 + 16 * hh) = w;
#pragma unroll
                for (int i = 0; i < 8; ++i) t8[i] = qa[8 * hh + i] * ex[i] * com[i];
                w.x = pk2(t8[0], t8[1]); w.y = pk2(t8[2], t8[3]); w.z = pk2(t8[4], t8[5]); w.w = pk2(t8[6], t8[7]); *(v4u*)(Qb + row * 512 + h * 128 + ch + 8 * hh) = w;
                __builtin_amdgcn_sched_barrier(0);
            }
#pragma unroll
            for (int i = 0; i < 2; ++i) { const int id = 2 * wid + i, kt = id >> 2, v2 = id & 3;
#pragma unroll
                for (int r = 0; r < 16; ++r) { const int k = kt * 32 + crow16(r, hi); *(LAS bf16*)(L + H1_SP + k * 320 + (v2 * 32 + r32) * 2) = (bf16)(pk2(S[i][r] * CK[k], 0.f) & 0xffffu); } }
        }
        lds_barrier();
        {
            if (tid < 128) BO[tid] += G[63 * 128 + tid];
            f32x16 o = {};
            bf16x8 qf[8];
#pragma unroll
            for (int k0 = 0; k0 < 8; ++k0) qf[k0] = *(const LAS bf16x8*)(L + H1_QD + (tt2 * 32 + r32) * 272 + (k0 * 16 + 8 * hi) * 2);
#pragma unroll
            for (int k0 = 0; k0 < 8; ++k0) o = __builtin_amdgcn_mfma_f32_32x32x16_bf16(qf[k0], tr_frag<false>(L + H1_SP, 320, k0 * 16, vt * 32, lane), o, 0, 0, 0);
#pragma unroll
            for (int sg = 0; sg < 2; ++sg) if (sg <= tt2) {
                f32x16 sc = {};
#pragma unroll
                for (int k0 = 0; k0 < 8; ++k0) { const bf16x8 kf = *(const LAS bf16x8*)(L + H1_KD + (sg * 32 + r32) * 272 + (k0 * 16 + 8 * hi) * 2); sc = __builtin_amdgcn_mfma_f32_32x32x16_bf16(kf, qf[k0], sc, 0, 0, 0); }
                if (sg == tt2) {
#pragma unroll
                    for (int r = 0; r < 16; ++r) sc[r] = (crow16(r, hi) <= r32) ? sc[r] : 0.f; }
#pragma unroll
                for (int sI = 0; sI < 2; ++sI) { v4u w; w.x = pg8::cvt_pk_bf16(sc[8 * sI + 0], sc[8 * sI + 1]); w.y = pg8::cvt_pk_bf16(sc[8 * sI + 2], sc[8 * sI + 3]); w.z = pg8::cvt_pk_bf16(sc[8 * sI + 4], sc[8 * sI + 5]); w.w = pg8::cvt_pk_bf16(sc[8 * sI + 6], sc[8 * sI + 7]);
                    o = __builtin_amdgcn_mfma_f32_32x32x16_bf16(__builtin_bit_cast(bf16x8, w), tr_frag<true>(L + H1_VT, 320, sg * 32 + 16 * sI, vt * 32, lane), o, 0, 0, 0); }
            }
            float* po = OL + (rowb + c * 64 + tt2 * 32) * 512 + h * 128 + vt * 32 + r32;
#pragma unroll
            for (int r = 0; r < 16; ++r) po[(size_t)crow16(r, hi) * 512] = o[r];
#pragma unroll
            for (int i = 0; i < 2; ++i) { const int id = 2 * wid + i, kt = id >> 2, v2 = id & 3;
#pragma unroll
                for (int r = 0; r < 16; ++r) S[i][r] *= CK[128 + kt * 32 + crow16(r, hi)];
#pragma unroll
                for (int s4 = 0; s4 < 4; ++s4) S[i] = __builtin_amdgcn_mfma_f32_32x32x16_bf16(tr_frag<true>(L + H1_KE, 320, 16 * s4, kt * 32, lane), tr_frag<true>(L + H1_VT, 320, 16 * s4, v2 * 32, lane), S[i], 0, 0, 0); }
        }
        lds_barrier();
    }
#pragma unroll
    for (int i = 0; i < 2; ++i) { const int id = 2 * wid + i, kt = id >> 2, v2 = id & 3;
#pragma unroll
        for (int r = 0; r < 16; ++r) Lg[(size_t)u * 16384 + (kt * 32 + crow16(r, hi)) * 128 + v2 * 32 + r32] = S[i][r]; }
    if (tid < 128) Dg[(size_t)u * 128 + tid] = __expf(BO[tid]);
}
constexpr int H2_SL = 0, H2_OB = 128 * 320, H2_END = H2_OB + 128 * 128 * 4;
__device__ __forceinline__ void hgrn_pass2_unit(const Frame& F, LAS unsigned char* L, int u, const bf16* proj, const float* gnorm, const float* Lg, const float* Dg, const float* OL, const bf16* Qb, bf16* cat, int dry) {
    const int b = u >> 5, h = (u >> 3) & 3, blk = u & 7;
    const int lane = F.lane, r32 = lane & 31, hi = lane >> 5, wid = F.wave, tid = F.tid;
    const size_t rowb = (size_t)b * SEQ + blk * 256;
    LAS float* OB = (LAS float*)(L + H2_OB);
    if (blk > 0 && dry != 1) {
#pragma unroll 1
        for (int jh = 0; jh < 4; ++jh) {
            f32x4 l4[7][2]; float dd[7][2];
#pragma unroll
            for (int pb = 0; pb < 7; ++pb)
#pragma unroll
                for (int j = 0; j < 2; ++j) { const int e4 = tid + 512 * (2 * jh + j), k = e4 >> 5;
                    if (pb < blk) { dd[pb][j] = *(const float*)((const char*)(Dg + (size_t)(u - blk + pb) * 128) + (unsigned)k * 4u); l4[pb][j] = *(const f32x4*)((const char*)(Lg + (size_t)(u - blk + pb) * 16384) + (unsigned)e4 * 16u); }
                    else { dd[pb][j] = 0.f; l4[pb][j] = (f32x4){0.f, 0.f, 0.f, 0.f}; } }
#pragma unroll
            for (int j = 0; j < 2; ++j) { const int e4 = tid + 512 * (2 * jh + j), k = e4 >> 5, v4 = (e4 & 31) * 4; f32x4 S = {0.f, 0.f, 0.f, 0.f};
#pragma unroll
                for (int pb = 0; pb < 7; ++pb) if (pb < blk) S = S * dd[pb][j] + l4[pb][j];
                v2u w; w.x = pk2(S.x, S.y); w.y = pk2(S.z, S.w); *(LAS v2u*)(L + H2_SL + k * 320 + v4 * 2) = w; } } }
    lds_barrier();
    const int ttp = tid >> 2, cq = tid & 3, vt = wid & 3;
    float gn[32];
#pragma unroll
    for (int i = 0; i < 8; ++i) { const f32x4 g = *(const f32x4*)(gnorm + cq * 32 + 4 * i); gn[4 * i] = g.x; gn[4 * i + 1] = g.y; gn[4 * i + 2] = g.z; gn[4 * i + 3] = g.w; }
    for (int hf = 0; hf < 2; ++hf) {
        const size_t rowp = rowb + hf * 128 + ttp;
        v4u hg[4];
#pragma unroll
        for (int i = 0; i < 4; ++i) hg[i] = *(const v4u*)(proj + rowp * NCOL + C_HG + h * 128 + cq * 32 + 8 * i);
#pragma unroll
        for (int j = 0; j < 2; ++j) { const int tl = (wid >> 2) + 2 * j;
            const size_t trow = rowb + hf * 128 + tl * 32;
            f32x16 o = {};
            bf16x8 af[8]; float olv[16];
            const float* pl = OL + trow * 512 + h * 128 + vt * 32 + r32;
            if (blk > 0) {
#pragma unroll
                for (int k0 = 0; k0 < 8; ++k0) af[k0] = *(const bf16x8*)(Qb + (trow + r32) * 512 + h * 128 + k0 * 16 + 8 * hi); }
#pragma unroll
            for (int r = 0; r < 16; ++r) olv[r] = pl[(size_t)crow16(r, hi) * 512];
            __builtin_amdgcn_sched_barrier(0);
            if (blk > 0 && dry != 2) {
#pragma unroll
                for (int k0 = 0; k0 < 8; ++k0) o = __builtin_amdgcn_mfma_f32_32x32x16_bf16(af[k0], tr_frag<false>(L + H2_SL, 320, k0 * 16, vt * 32, lane), o, 0, 0, 0); }
#pragma unroll
            for (int r = 0; r < 16; ++r) { const int t = crow16(r, hi); OB[(tl * 32 + t) * 128 + vt * 32 + r32] = o[r] + olv[r]; } }
        lds_barrier();
        {
            float ov[32]; float ss = 0.f;
#pragma unroll
            for (int i = 0; i < 8; ++i) { const f32x4 x = *(const LAS f32x4*)(OB + ttp * 128 + cq * 32 + 4 * i); ov[4 * i] = x.x; ov[4 * i + 1] = x.y; ov[4 * i + 2] = x.z; ov[4 * i + 3] = x.w; ss += (x.x * x.x + x.y * x.y) + (x.z * x.z + x.w * x.w); }
            ss += __shfl_xor(ss, 1); ss += __shfl_xor(ss, 2);
            const float rn = rsqrtf(ss * (1.f / 128.f) + RMS_EPS);
#pragma unroll
            for (int i = 0; i < 4; ++i) { const unsigned gw[4] = {hg[i].x, hg[i].y, hg[i].z, hg[i].w}; float y[8];
#pragma unroll
                for (int e = 0; e < 8; ++e) { const float gv = (e & 1) ? bfhi(gw[e >> 1]) : bflo(gw[e >> 1]); y[e] = ov[8 * i + e] * rn * gn[8 * i + e] * (gv * sigmoidf_(gv)); }
                v4u w; w.x = pk2(y[0], y[1]); w.y = pk2(y[2], y[3]); w.z = pk2(y[4], y[5]); w.w = pk2(y[6], y[7]);
                *(v4u*)(cat + rowp * 1536 + 512 + h * 128 + cq * 32 + 8 * i) = w; }
        }
        lds_barrier();
    }
}
__device__ __forceinline__ void phase_hgrn1(const Frame& F0, const bf16* proj, const float* lbl, int layer, float* Lg, float* Dg, float* OL, bf16* Qb) {
    const Frame F = fresh(F0);
    LAS unsigned char* L = (LAS unsigned char*)F.lds;
    for (int u = xcd_order(F.bid, F.G); u < 256; u += F.G) { hgrn_pass1_unit(F, L, u, proj, lbl, layer, Lg, Dg, OL, Qb); __syncthreads(); }
}
__device__ __forceinline__ void phase_hgrn2(const Frame& F0, const bf16* proj, const float* gnorm, const float* Lg, const float* Dg, const float* OL, const bf16* Qb, bf16* cat, int dry) {
    const Frame F = fresh(F0);
    LAS unsigned char* L = (LAS unsigned char*)F.lds;
    for (int u = xcd_order(F.bid, F.G); u < 256; u += F.G) { hgrn_pass2_unit(F, L, u, proj, gnorm, Lg, Dg, OL, Qb, cat, dry); __syncthreads(); }
}

struct SchedDense {
    const char* A; const char* B; int nM, nN, G, c; size_t ta, tb;
    __device__ __forceinline__ bool next(int i, pg8::Unit& u) const {
        int pm, pn; if (!pg8::static_tile(nM, nN, (long)i * G + c, pm, pn)) return false;
        u.pm = pm; u.pn = pn; u.aux = 0; u.pad = 0; u.a = A + (size_t)pm * ta; u.b = B + (size_t)pn * tb; u.gidx = nullptr; return true; }
};
struct SchedBranch {
    const char* A; const char* B; int G, c;
    __device__ __forceinline__ bool next(int i, pg8::Unit& u) const {
        int pm, pn; if (!pg8::static_tile(T / 256, DM / 256, (long)(i / 3) * G + c, pm, pn)) return false;
        const int seg = i % 3;
        u.pm = pm; u.pn = pn; u.aux = seg; u.pad = 0; u.a = A + ((size_t)pm * 256 * 1536 + seg * 512) * 2; u.b = B + ((size_t)seg * DM * 512 + (size_t)pn * 256 * 512) * 2; u.gidx = nullptr; return true; }
};
struct SchedMoe {
    const char* A; const char* B; const unsigned* ntp; const unsigned* tile_e; int G, c; size_t ta, tb_e, tb_n; const unsigned* tok;
    __device__ __forceinline__ bool next(int i, pg8::Unit& u) const {
        const int nt = (int)__builtin_amdgcn_readfirstlane(*ntp);
        const int cx = (G % 8 == 0) ? (c % 8) * (G / 8) + c / 8 : c;
        const long L = (long)i * G + cx; if (L >= (long)nt * 4) return false;
        const int tile = (int)(L >> 2), pn = (int)(L & 3); const int e = (int)__builtin_amdgcn_readfirstlane(tile_e[tile]);
        u.pm = tile; u.pn = pn; u.aux = e; u.pad = 0; u.a = tok ? A : A + (size_t)tile * ta; u.b = B + (size_t)e * tb_e + (size_t)pn * tb_n; u.gidx = tok ? tok + (size_t)tile * 256 : nullptr; return true; }
};

typedef pg8::f32x4 af4;
struct EpiStoreBf16 {
    static constexpr bool PERM = true;
    bf16* O; int ldc; int gate_col0; const float* bgate; v2u* GT;
    __device__ __forceinline__ bool operator()(af4 (&acc)[2][2][4][2], const pg8::Unit& u, int wr, int wc, int fr, int fq) const {
        const int row0 = u.pm * 256 + wr * 64 + fr, col0 = u.pn * 256 + wc * 32 + 8 * fq;
        const bool gate = (u.pn * 256 >= gate_col0);
#pragma unroll
        for (int bj = 0; bj < 2; ++bj) {
            af4 b0 = {0.f, 0.f, 0.f, 0.f}, b1 = {0.f, 0.f, 0.f, 0.f};
            if (gate) { b0 = *(const af4*)(bgate + col0 + bj * 128 - gate_col0); b1 = *(const af4*)(bgate + col0 + bj * 128 - gate_col0 + 4); }
#pragma unroll
            for (int ai = 0; ai < 2; ++ai)
#pragma unroll
                for (int m = 0; m < 4; ++m) { af4 v0 = acc[ai][bj][m][0], v1 = acc[ai][bj][m][1];
                    if (gate) {
                        unsigned qlo = 0u, qhi = 0u;
#pragma unroll
                        for (int i = 0; i < 4; ++i) { const float a0 = fmaxf(255.f * __builtin_amdgcn_rcpf(1.f + __expf(-fmaxf(v0[i] + b0[i], -30.f))), 1.f), a1 = fmaxf(255.f * __builtin_amdgcn_rcpf(1.f + __expf(-fmaxf(v1[i] + b1[i], -30.f))), 1.f);
                            qlo = __builtin_amdgcn_cvt_pk_u8_f32(a0, i, qlo); qhi = __builtin_amdgcn_cvt_pk_u8_f32(a1, i, qhi); }
                        const int gt = u.pn - gate_col0 / 256;
                        GT[((((size_t)((gt >> 2) * 64 + u.pm) * 4 + (gt & 3)) * 8 + (wr * 4 + wc)) * 16 + (ai * 4 + m) * 2 + bj) * 64 + (fq * 16 + fr)] = (v2u){qlo, qhi}; }
                    else { v4u w; w.x = pg8::cvt_pk_bf16(v0[0], v0[1]); w.y = pg8::cvt_pk_bf16(v0[2], v0[3]); w.z = pg8::cvt_pk_bf16(v1[0], v1[1]); w.w = pg8::cvt_pk_bf16(v1[2], v1[3]);
                        *(v4u*)(O + (size_t)(row0 + ai * 128 + m * 16) * ldc + col0 + bj * 128) = w; } } }
        return true;
    }
};
struct EpiBranch {
    static constexpr bool PERM = true;
    const v2u* GT; bf16* merged;
    __device__ __forceinline__ bool operator()(af4 (&acc)[2][2][4][2], const pg8::Unit& u, int wr, int wc, int fr, int fq) const {
        const int seg = u.aux, row0 = u.pm * 256 + wr * 64 + fr, col0 = u.pn * 256 + wc * 32 + 8 * fq;
        const bool last = (seg == 2); const int sn = last ? seg : seg + 1;
#pragma unroll
        for (int bj = 0; bj < 2; ++bj) { const int col = col0 + bj * 128;
#pragma unroll
            for (int ai = 0; ai < 2; ++ai) { v2u gcv[4], gnv[4];
#pragma unroll
                for (int m = 0; m < 4; ++m) {
                    gcv[m] = GT[((((size_t)(seg * 64 + u.pm) * 4 + u.pn) * 8 + (wr * 4 + wc)) * 16 + (ai * 4 + m) * 2 + bj) * 64 + (fq * 16 + fr)];
                    gnv[m] = GT[((((size_t)(sn * 64 + u.pm) * 4 + u.pn) * 8 + (wr * 4 + wc)) * 16 + (ai * 4 + m) * 2 + bj) * 64 + (fq * 16 + fr)]; }
#pragma unroll
                for (int m = 0; m < 4; ++m) { const size_t row = (size_t)(row0 + ai * 128 + m * 16);
                    const unsigned gcw[2] = {gcv[m].x, gcv[m].y}, gnw[2] = {gnv[m].x, gnv[m].y};
                    float f[8];
#pragma unroll
                    for (int i = 0; i < 8; ++i) { const float gc = (float)((gcw[i >> 2] >> (8 * (i & 3))) & 0xffu), gn = (float)((gnw[i >> 2] >> (8 * (i & 3))) & 0xffu);
                        f[i] = last ? gc * (1.f / 255.f) : gc * __builtin_amdgcn_rcpf(gn); }
                    af4& v0 = acc[ai][bj][m][0]; af4& v1 = acc[ai][bj][m][1];
                    v0[0] *= f[0]; v0[1] *= f[1]; v0[2] *= f[2]; v0[3] *= f[3]; v1[0] *= f[4]; v1[1] *= f[5]; v1[2] *= f[6]; v1[3] *= f[7];
                    if (last) { v4u w; w.x = pg8::cvt_pk_bf16(v0[0], v0[1]); w.y = pg8::cvt_pk_bf16(v0[2], v0[3]); w.z = pg8::cvt_pk_bf16(v1[0], v1[1]); w.w = pg8::cvt_pk_bf16(v1[2], v1[3]);
                        *(v4u*)(merged + row * DM + col) = w; } } } }
        return last;
    }
};
struct EpiResidual {
    static constexpr bool PERM = true;
    const float* xin32; const bf16* xin16; bf16* xout;
    __device__ __forceinline__ bool operator()(af4 (&acc)[2][2][4][2], const pg8::Unit& u, int wr, int wc, int fr, int fq) const {
        const int row0 = u.pm * 256 + wr * 64 + fr, col0 = u.pn * 256 + wc * 32 + 8 * fq;
#pragma unroll
        for (int ai = 0; ai < 2; ++ai)
#pragma unroll
            for (int mh = 0; mh < 2; ++mh) { af4 r[2][2][2];
#pragma unroll
                for (int mm = 0; mm < 2; ++mm) { const size_t off = (size_t)(row0 + ai * 128 + (mh * 2 + mm) * 16) * DM + col0;
#pragma unroll
                    for (int bj = 0; bj < 2; ++bj) {
                        if (xin32) { r[mm][bj][0] = *(const af4*)(xin32 + off + bj * 128); r[mm][bj][1] = *(const af4*)(xin32 + off + bj * 128 + 4); }
                        else { const v4u w = *(const v4u*)(xin16 + off + bj * 128); r[mm][bj][0] = (af4){bflo(w.x), bfhi(w.x), bflo(w.y), bfhi(w.y)}; r[mm][bj][1] = (af4){bflo(w.z), bfhi(w.z), bflo(w.w), bfhi(w.w)}; } } }
#pragma unroll
                for (int mm = 0; mm < 2; ++mm) { const size_t off = (size_t)(row0 + ai * 128 + (mh * 2 + mm) * 16) * DM + col0;
#pragma unroll
                    for (int bj = 0; bj < 2; ++bj) { const af4 v0 = r[mm][bj][0] + acc[ai][bj][mh * 2 + mm][0], v1 = r[mm][bj][1] + acc[ai][bj][mh * 2 + mm][1]; v4u w;
                        w.x = pg8::cvt_pk_bf16(v0[0], v0[1]); w.y = pg8::cvt_pk_bf16(v0[2], v0[3]); w.z = pg8::cvt_pk_bf16(v1[0], v1[1]); w.w = pg8::cvt_pk_bf16(v1[2], v1[3]);
                        *(v4u*)(xout + off + bj * 128) = w; } } }
        return true;
    }
};
struct EpiSwiglu {
    static constexpr bool PERM = true;
    bf16* act; const float* rrow;
    __device__ __forceinline__ bool operator()(af4 (&acc)[2][2][4][2], const pg8::Unit& u, int wr, int wc, int fr, int fq) const {
        const int row0 = u.pm * 256 + wr * 64 + fr, col0 = u.pn * 128 + wc * 32 + 8 * fq;
        float rs[2][4];
#pragma unroll
        for (int ai = 0; ai < 2; ++ai)
#pragma unroll
            for (int m = 0; m < 4; ++m) rs[ai][m] = rrow[row0 + ai * 128 + m * 16];
#pragma unroll
        for (int ai = 0; ai < 2; ++ai)
#pragma unroll
            for (int m = 0; m < 4; ++m) { const float rr = rs[ai][m]; const af4 g0 = acc[ai][0][m][0] * rr, g1 = acc[ai][0][m][1] * rr, u0 = acc[ai][1][m][0] * rr, u1 = acc[ai][1][m][1] * rr;
                float o[8];
#pragma unroll
                for (int i = 0; i < 4; ++i) { o[i] = g0[i] * sigmoidf_(g0[i]) * u0[i]; o[4 + i] = g1[i] * sigmoidf_(g1[i]) * u1[i]; }
                v4u w; w.x = pg8::cvt_pk_bf16(o[0], o[1]); w.y = pg8::cvt_pk_bf16(o[2], o[3]); w.z = pg8::cvt_pk_bf16(o[4], o[5]); w.w = pg8::cvt_pk_bf16(o[6], o[7]);
                *(v4u*)(act + (size_t)(row0 + ai * 128 + m * 16) * FF + col0) = w; }
        return true;
    }
};
struct EpiScaleRows {
    static constexpr bool PERM = true;
    bf16* ys; const float* wrow;
    __device__ __forceinline__ bool operator()(af4 (&acc)[2][2][4][2], const pg8::Unit& u, int wr, int wc, int fr, int fq) const {
        const int row0 = u.pm * 256 + wr * 64 + fr, col0 = u.pn * 256 + wc * 32 + 8 * fq;
        float sc[2][4];
#pragma unroll
        for (int ai = 0; ai < 2; ++ai)
#pragma unroll
            for (int m = 0; m < 4; ++m) sc[ai][m] = wrow[row0 + ai * 128 + m * 16];
#pragma unroll
        for (int ai = 0; ai < 2; ++ai)
#pragma unroll
            for (int m = 0; m < 4; ++m) { const int row = row0 + ai * 128 + m * 16; const float s = sc[ai][m]; bf16* rowp = ys + (size_t)row * DM + col0;
#pragma unroll
                for (int bj = 0; bj < 2; ++bj) { const af4 v0 = acc[ai][bj][m][0] * s, v1 = acc[ai][bj][m][1] * s; v4u w;
                    w.x = pg8::cvt_pk_bf16(v0[0], v0[1]); w.y = pg8::cvt_pk_bf16(v0[2], v0[3]); w.z = pg8::cvt_pk_bf16(v1[0], v1[1]); w.w = pg8::cvt_pk_bf16(v1[2], v1[3]);
                    *(v4u*)(rowp + bj * 128) = w; } }
        return true;
    }
};

constexpr int RT_PITCH = 2064, RT_HI = 0, RT_LO = 36 * RT_PITCH, RT_END = 72 * RT_PITCH;
static_assert(RT_END + 4096 <= LDS_SCRATCH, "router lds");
__device__ __forceinline__ void phase_router2(const Frame& F0, const bf16* x, const float* gain, const float* wco, const float* bco, const float* wfi, const float* bfi,
                                              bf16* hout, unsigned* route, unsigned* cnt, float* LG, bool commit) {
    const Frame F = fresh(F0);
    LAS unsigned char* L = (LAS unsigned char*)F.lds;
    {
        f32x4 wv[18];
#pragma unroll
        for (int i = 0; i < 2; ++i) wv[i] = *(const f32x4*)(wco + 4 * (F.tid + 512 * i));
#pragma unroll
        for (int i = 0; i < 16; ++i) wv[2 + i] = *(const f32x4*)(wfi + 4 * (F.tid + 512 * i));
#pragma unroll
        for (int i = 0; i < 18; ++i) { int k, c0; if (i < 2) { k = F.tid + 512 * i; c0 = 32; } else { const int f = F.tid + 512 * (i - 2); k = f >> 3; c0 = (f & 7) * 4; }
            const float w4[4] = {wv[i].x, wv[i].y, wv[i].z, wv[i].w};
#pragma unroll
            for (int e = 0; e < 4; ++e) { const unsigned hi = f2bf(w4[e]); const unsigned lo = f2bf(w4[e] - __uint_as_float(hi << 16));
                *(LAS bf16*)(L + RT_HI + (c0 + e) * RT_PITCH + k * 2) = (bf16)hi; *(LAS bf16*)(L + RT_LO + (c0 + e) * RT_PITCH + k * 2) = (bf16)lo; } }
    }
    LAS float* GL = (LAS float*)(L + RT_END);
    GL[F.tid] = gain[F.tid]; GL[F.tid + 512] = gain[F.tid + 512];
    __syncthreads();
    {
        const int lane = F.lane, rl = lane & 15, kg = lane >> 4, kh = F.wave >> 2;
        const int NITER = (T / 16 + 4 * F.G - 1) / (4 * F.G);
        for (int it = 0; it < NITER; ++it) {
            const int tile = (it * F.G + xcd_order(F.bid, F.G)) * 4 + (F.wave & 3); const bool tvalid = tile < T / 16;
            const size_t row = (size_t)(tvalid ? tile : 0) * 16 + rl;
            const bf16* xr = x + row * DM + 8 * kg + 512 * kh;
            pg8::f32x4 acc[3]; acc[0] = (pg8::f32x4){0.f, 0.f, 0.f, 0.f}; acc[1] = acc[0]; acc[2] = acc[0];
            float ss = 0.f;
            const int bro[3] = {rl * RT_PITCH + 16 * kg + 1024 * kh, (16 + rl) * RT_PITCH + 16 * kg + 1024 * kh, (32 + (rl & 3)) * RT_PITCH + 16 * kg + 1024 * kh};
            v4u xa[8];
#pragma unroll
            for (int q = 0; q < 8; ++q) xa[q] = *(const v4u*)(xr + 32 * q);
            for (int s0 = 0; s0 < 16; s0 += 8) {
                v4u xn[8];
                if (s0 + 8 < 16) {
#pragma unroll
                    for (int q = 0; q < 8; ++q) xn[q] = *(const v4u*)(xr + 32 * (s0 + 8 + q)); }
#pragma unroll
                for (int q = 0; q < 8; ++q) { const int s = s0 + q;
                    const f32x4 g0 = *(const LAS f32x4*)(GL + 512 * kh + 32 * s + 8 * kg), g1 = *(const LAS f32x4*)(GL + 512 * kh + 32 * s + 8 * kg + 4);
                    const float xv[8] = {bflo(xa[q].x), bfhi(xa[q].x), bflo(xa[q].y), bfhi(xa[q].y), bflo(xa[q].z), bfhi(xa[q].z), bflo(xa[q].w), bfhi(xa[q].w)};
                    ss += (xv[0] * xv[0] + xv[1] * xv[1]) + (xv[2] * xv[2] + xv[3] * xv[3]) + (xv[4] * xv[4] + xv[5] * xv[5]) + (xv[6] * xv[6] + xv[7] * xv[7]);
                    const float y[8] = {xv[0] * g0.x, xv[1] * g0.y, xv[2] * g0.z, xv[3] * g0.w, xv[4] * g1.x, xv[5] * g1.y, xv[6] * g1.z, xv[7] * g1.w};
                    v4u ah, al; ah.x = pk2(y[0], y[1]); ah.y = pk2(y[2], y[3]); ah.z = pk2(y[4], y[5]); ah.w = pk2(y[6], y[7]);
                    al.x = pk2(y[0] - bflo(ah.x), y[1] - bfhi(ah.x)); al.y = pk2(y[2] - bflo(ah.y), y[3] - bfhi(ah.y)); al.z = pk2(y[4] - bflo(ah.z), y[5] - bfhi(ah.z)); al.w = pk2(y[6] - bflo(ah.w), y[7] - bfhi(ah.w));
                    if (tvalid) *(v4u*)(hout + row * DM + 512 * kh + 32 * s + 8 * kg) = ah;
                    const bf16x8 Ah = __builtin_bit_cast(bf16x8, ah), Al = __builtin_bit_cast(bf16x8, al);
#pragma unroll
                    for (int ct = 0; ct < 3; ++ct) { const bf16x8 Bh = *(const LAS bf16x8*)(L + RT_HI + bro[ct] + 64 * s), Bl = *(const LAS bf16x8*)(L + RT_LO + bro[ct] + 64 * s);
                        acc[ct] = __builtin_amdgcn_mfma_f32_16x16x32_bf16(Ah, Bh, acc[ct], 0, 0, 0);
                        acc[ct] = __builtin_amdgcn_mfma_f32_16x16x32_bf16(Ah, Bl, acc[ct], 0, 0, 0);
                        acc[ct] = __builtin_amdgcn_mfma_f32_16x16x32_bf16(Al, Bh, acc[ct], 0, 0, 0); } }
#pragma unroll
                for (int q = 0; q < 8; ++q) xa[q] = xn[q];
            }
            ss += __shfl_xor(ss, 16); ss += __shfl_xor(ss, 32);
            float* LGh = LG + (size_t)kh * T * 48;
            if (tvalid) {
#pragma unroll
                for (int ct = 0; ct < 3; ++ct)
#pragma unroll
                    for (int rg = 0; rg < 4; ++rg) if (ct < 2 || rl < 4) LGh[((size_t)tile * 16 + 4 * kg + rg) * 48 + ct * 16 + rl] = acc[ct][rg];
                if (lane < 16) LGh[((size_t)tile * 16 + lane) * 48 + 47] = ss; }
            asm volatile("s_waitcnt vmcnt(0)" ::: "memory");
            __syncthreads();
            if (kh == 0 && lane < 16 && tvalid) {
                const size_t m = (size_t)tile * 16 + lane;
                const float* l0 = LG + m * 48; const float* l1 = LG + (size_t)T * 48 + m * 48;
                const float sst = __uint_as_float(__hip_atomic_load((const unsigned*)(l0 + 47), RLX_AGENT)) + __uint_as_float(__hip_atomic_load((const unsigned*)(l1 + 47), RLX_AGENT));
                const float r = rsqrtf(sst * (1.f / DM) + RMS_EPS);
                float lg[36];
#pragma unroll
                for (int c = 0; c < 36; ++c) lg[c] = r * (__uint_as_float(__hip_atomic_load((const unsigned*)(l0 + c), RLX_AGENT)) + __uint_as_float(__hip_atomic_load((const unsigned*)(l1 + c), RLX_AGENT)));
                float c0 = lg[32] + bco[0], c1 = lg[33] + bco[1], c2 = lg[34] + bco[2], c3 = lg[35] + bco[3];
                int grp = 0; float cm = c0;
                if (c1 > cm) { cm = c1; grp = 1; } if (c2 > cm) { cm = c2; grp = 2; } if (c3 > cm) { cm = c3; grp = 3; }
                const float ptop = 1.f / (__expf(c0 - cm) + __expf(c1 - cm) + __expf(c2 - cm) + __expf(c3 - cm));
                float fs[8];
#pragma unroll
                for (int i = 0; i < 8; ++i) { float a = lg[i] + bfi[i], b = lg[8 + i] + bfi[8 + i], c = lg[16 + i] + bfi[16 + i], d = lg[24 + i] + bfi[24 + i]; fs[i] = grp == 0 ? a : (grp == 1 ? b : (grp == 2 ? c : d)); }
                int i1 = 0; float v1 = fs[0];
#pragma unroll
                for (int i = 1; i < 8; ++i) if (fs[i] > v1) { v1 = fs[i]; i1 = i; }
                int i2 = -1; float v2 = -3.0e38f;
#pragma unroll
                for (int i = 0; i < 8; ++i) if (i != i1 && fs[i] > v2) { v2 = fs[i]; i2 = i; }
                const float e2 = __expf(v2 - v1), w1 = ptop / (1.f + e2), w2 = ptop * e2 / (1.f + e2);
                if (commit) {
                    const int ea = grp * 8 + i1, eb = grp * 8 + i2;
                    const unsigned ra = __hip_atomic_fetch_add(cnt + 64 * ea, 1u, RLX_AGENT), rb = __hip_atomic_fetch_add(cnt + 64 * eb, 1u, RLX_AGENT);
                    v4u o; o.x = (unsigned)ea; o.y = (unsigned)eb; o.z = ra; o.w = rb; *(v4u*)(route + m * 8) = o;
                    *(f32x4*)(route + m * 8 + 4) = (f32x4){w1, w2, r, 0.f};
                }
            }
        }
    }
    __syncthreads();
}

__device__ __forceinline__ void phase_index(const Frame& F0, const unsigned* route, const unsigned* cnt, unsigned* ntp, unsigned* tile_e, unsigned* tok, float* wrow, float* rrow, unsigned* pos) {
    const Frame F = fresh(F0);
    unsigned* off = (unsigned*)F.lds;
    if (F.tid == 0) { unsigned o = 0;
        for (int e = 0; e < NEXP; ++e) { off[e] = o; const unsigned c = __hip_atomic_load(cnt + 64 * e, RLX_AGENT); off[64 + e] = c; const unsigned p = (c + 255u) & ~255u;
            if (F.bid == 0) for (unsigned tI = o >> 8; tI < ((o + p) >> 8); ++tI) tile_e[tI] = (unsigned)e;
            o += p; }
        off[NEXP] = o; if (F.bid == 0) *ntp = o >> 8; }
    __syncthreads();
    for (int m = F.bid * 512 + F.tid; m < T; m += F.G * 512) {
        const v4u ri = *(const v4u*)(route + (size_t)m * 8); const f32x4 ww = *(const f32x4*)(route + (size_t)m * 8 + 4);
        const unsigned d0 = off[ri.x] + ri.z, d1 = off[ri.y] + ri.w;
        tok[d0] = (unsigned)m; tok[d1] = (unsigned)m; wrow[d0] = ww.x; wrow[d1] = ww.y; rrow[d0] = ww.z; rrow[d1] = ww.z; *(v2u*)(pos + (size_t)m * 2) = (v2u){d0, d1}; }
    for (int e = F.bid; e < NEXP; e += F.G) {
        const unsigned c = off[64 + e], b0 = off[e] + c, b1 = off[e + 1];
        for (unsigned i = b0 + F.tid; i < b1; i += 512) { tok[i] = 0u; wrow[i] = 0.f; rrow[i] = 0.f; } }
    __syncthreads();
}

__device__ __forceinline__ void phase_combine(const Frame& F0, const bf16* x, bf16* xdst16, float* xdst32, const bf16* ys, const unsigned* pos, const float* ngain, bf16* hout) {
    const Frame F = fresh(F0);
    const int gw = F.bid * 8 + F.wave, NGW = F.G * 8;
    f32x4 g[4];
#pragma unroll
    for (int j = 0; j < 4; ++j) g[j] = ngain ? *(const f32x4*)(ngain + 4 * F.lane + 256 * j) : (f32x4){0.f, 0.f, 0.f, 0.f};
    const int RPW = (T + NGW - 1) / NGW, mbase = (xcd_order(F.bid, F.G) * 8 + F.wave) * RPW;
    for (int r0 = 0; r0 < RPW; r0 += 2) {
        v2u pp[2];
#pragma unroll
        for (int q = 0; q < 2; ++q) { const int m = (r0 + q < RPW) ? mbase + r0 + q : T; pp[q] = (m < T) ? *(const v2u*)(pos + (size_t)m * 2) : (v2u){0u, 0u}; }
        v2u xv[2][4], ya[2][4], yb[2][4];
#pragma unroll
        for (int q = 0; q < 2; ++q) { const int m = (r0 + q < RPW) ? mbase + r0 + q : T; if (m < T) {
                const v2u* xr = (const v2u*)(x + (size_t)m * DM) + F.lane; const v2u* y0 = (const v2u*)(ys + (size_t)pp[q].x * DM) + F.lane; const v2u* y1 = (const v2u*)(ys + (size_t)pp[q].y * DM) + F.lane;
#pragma unroll
                for (int j = 0; j < 4; ++j) { xv[q][j] = xr[64 * j]; ya[q][j] = y0[64 * j]; yb[q][j] = y1[64 * j]; } } }
#pragma unroll
        for (int q = 0; q < 2; ++q) { const int m = (r0 + q < RPW) ? mbase + r0 + q : T; if (m < T) {
                float s = 0.f; f32x4 v[4];
#pragma unroll
                for (int j = 0; j < 4; ++j) { const v2u c = xv[q][j], a = ya[q][j], b = yb[q][j]; f32x4 t;
                    t.x = bflo(c.x) + bflo(a.x) + bflo(b.x); t.y = bfhi(c.x) + bfhi(a.x) + bfhi(b.x); t.z = bflo(c.y) + bflo(a.y) + bflo(b.y); t.w = bfhi(c.y) + bfhi(a.y) + bfhi(b.y);
                    v[j] = t; s += (t.x * t.x + t.y * t.y) + (t.z * t.z + t.w * t.w); }
                if (xdst32) { f32x4* xw = (f32x4*)(xdst32 + (size_t)m * DM) + F.lane;
#pragma unroll
                    for (int j = 0; j < 4; ++j) xw[64 * j] = v[j]; }
                else { v2u* xw = (v2u*)(xdst16 + (size_t)m * DM) + F.lane;
#pragma unroll
                    for (int j = 0; j < 4; ++j) { v2u w; w.x = pk2(v[j].x, v[j].y); w.y = pk2(v[j].z, v[j].w); xw[64 * j] = w; } }
                if (ngain) {
                    const float r = rsqrtf(wave_sum(s) * (1.f / DM) + RMS_EPS);
                    v2u* o8 = (v2u*)(hout + (size_t)m * DM) + F.lane;
#pragma unroll
                    for (int j = 0; j < 4; ++j) { v2u w; w.x = pk2(v[j].x * r * g[j].x, v[j].y * r * g[j].y); w.y = pk2(v[j].z * r * g[j].z, v[j].w * r * g[j].w); o8[64 * j] = w; }
                } } }
    }
}

constexpr int PH_PER_LAYER = 11, N_PHASES = 1 + DEPTH * PH_PER_LAYER;
__device__ __forceinline__ CArgs& kargs() { CArgs* p = (CArgs*)__builtin_amdgcn_kernarg_segment_ptr(); asm volatile("" : "+s"(p)); return *p; }
__global__ void __launch_bounds__(512, 2) mk_fwd(Args args_unused) {
    extern __shared__ __attribute__((aligned(16))) unsigned char lds[];
    LAS unsigned char* lds3 = (LAS unsigned char*)lds;
    const int wave_s = __builtin_amdgcn_readfirstlane(threadIdx.x >> 6);
    for (int u = threadIdx.x; u < (LDS_BYTES - LDSCTL_OFF) / 4; u += 512) ((LAS unsigned*)(lds3 + LDSCTL_OFF))[u] = 0u;
    __syncthreads();
#if MK_SPLIT
#define GRID_BAR() do { } while (0)
#else
    (void)xcd_barrier_post((unsigned*)(kargs().ws + WS_CTL) + CW_BAR, (volatile LAS unsigned*)(lds3 + LDSCTL_OFF));
#define GRID_BAR() do { XcdBarrier b_; b_.bar = (unsigned*)(kargs().ws + WS_CTL) + CW_BAR; b_.x = xb_xcc_id(); b_.st = (volatile LAS unsigned*)(lds3 + LDSCTL_OFF); xcd_barrier(b_); } while (0)
#endif
#define IN(k) (kargs().ph_lo <= (k) && (k) < kargs().ph_hi)
#define SEAM(k) do { if (IN(k) && IN((k) + 1)) GRID_BAR(); } while (0)
#define FRAME() CArgs& A = kargs(); Frame F; F.lds = lds; F.lane = lane_id_asm(); { int w_ = wave_s; asm volatile("" : "+s"(w_)); F.wave = w_; } F.tid = F.wave * 64 + F.lane; { int g_ = gridDim.x, b_ = blockIdx.x; asm volatile("" : "+s"(g_), "+s"(b_)); F.G = g_; F.bid = b_; } \
    unsigned char* ws = A.ws; F.ws = ws; F.ctl = (unsigned*)(ws + WS_CTL); (void)F;
#define WSP(T_, off) ((T_*)(ws + (off)))

#ifdef EXTRA_BARS
    for (int eb_ = 0; eb_ < EXTRA_BARS; ++eb_) GRID_BAR();
#endif
    if (IN(0) && PHON(11)) { for (int rep_ = 0; rep_ < REPN(11); ++rep_) { if (rep_) GRID_BAR(); { FRAME(); phase_prologue(F, A); }
        { FRAME(); phase_norm(F, A.in[I_X], A.in[I_MIXG], WSP(bf16, WS_H)); } } }
    SEAM(0);
#pragma unroll 1
    for (int l = 0; l < DEPTH; ++l) {
        const int p0 = 1 + l * PH_PER_LAYER;
        if (IN(p0 + 1) && PHON(1)) { for (int rep_ = 0; rep_ < REPN(1); ++rep_) { if (rep_) GRID_BAR(); { FRAME();
            pg8::Gemm g{DM, DM, DM};
            SchedDense S{(const char*)(ws + WS_H), (const char*)(ws + WS_WIN) + (size_t)l * NCOL * DM * 2, T / 256, NCOL / 256, F.G, F.bid, (size_t)256 * DM * 2, (size_t)256 * DM * 2};
            EpiStoreBf16 E{WSP(bf16, WS_PROJ), NCOL, C_GL, A.in[I_BGATE] + l * 3 * DM, WSP(v2u, WS_GT)};
            pg8::gemm_phase<EpiStoreBf16, SchedDense, true, true>(lds3, g, S, E, F.tid);
        } } }
        SEAM(p0 + 1);
        if (IN(p0 + 2) && PHON(2)) { for (int rep_ = 0; rep_ < REPN(2); ++rep_) { if (rep_) GRID_BAR(); {
            for (int r2_ = 0; r2_ < REPN(14); ++r2_) { FRAME(); phase_qkprep(F, WSP(bf16, WS_PROJ), A.in[I_QG] + l * 64, A.in[I_KG] + l * 64, WSP(bf16, WS_Q), WSP(bf16, WS_K), WSP(float, WS_KMEAN)); }
            for (int r2_ = 0; r2_ < REPN(15); ++r2_) { FRAME(); phase_conv(F, WSP(bf16, WS_PROJ), A.in[I_CONVW] + (size_t)l * 31 * 512, A.in[I_CONVB] + l * 512, A.in[I_CLNG] + l * 512, A.in[I_CLNB] + l * 512, WSP(bf16, WS_CAT)); }
            for (int r2_ = 0; r2_ < REPN(16); ++r2_) { FRAME(); phase_hgrn1(F, WSP(bf16, WS_PROJ), A.in[I_LBL], l, WSP(float, WS_HS), WSP(float, WS_HS + 16 * MiB), WSP(float, WS_ORAW), WSP(bf16, WS_HS + 17 * MiB)); }
        } } }
        SEAM(p0 + 2);
        if (IN(p0 + 3) && PHON(3)) { for (int rep_ = 0; rep_ < REPN(3); ++rep_) { if (rep_) GRID_BAR(); {
            for (int r2_ = 0; r2_ < REPN(12); ++r2_) { FRAME(); phase_attn_mfma(F, WSP(bf16, WS_Q), WSP(bf16, WS_K), WSP(bf16, WS_PROJ), WSP(float, WS_KMEAN), WSP(bf16, WS_CAT)); }
            for (int r2_ = 0; r2_ < REPN(13); ++r2_) { FRAME(); phase_hgrn2(F, WSP(bf16, WS_PROJ), A.in[I_HGG] + l * 128, WSP(float, WS_HS), WSP(float, WS_HS + 16 * MiB), WSP(float, WS_ORAW), WSP(bf16, WS_HS + 17 * MiB), WSP(bf16, WS_CAT), (r2_ + 1 < REPN(13)) ? PROBE_DRY : 0); }
        } } }
        SEAM(p0 + 3);
        if (IN(p0 + 4) && PHON(4)) { for (int rep_ = 0; rep_ < REPN(4); ++rep_) { if (rep_) GRID_BAR(); { FRAME();
            pg8::Gemm g{1536, 512, 512};
            SchedBranch S{(const char*)(ws + WS_CAT), (const char*)(ws + WS_WCAT) + (size_t)l * 3 * DM * 512 * 2, F.G, F.bid};
            EpiBranch E{WSP(const v2u, WS_GT), WSP(bf16, WS_MERGED)};
            pg8::gemm_phase<EpiBranch, SchedBranch, true, true>(lds3, g, S, E, F.tid);
        } } }
        SEAM(p0 + 4);
        if (IN(p0 + 5) && PHON(5)) { for (int rep_ = 0; rep_ < REPN(5); ++rep_) { if (rep_) GRID_BAR(); { FRAME();
            pg8::Gemm g{DM, DM, DM};
            SchedDense S{(const char*)(ws + WS_MERGED), (const char*)(ws + WS_WOUT) + (size_t)l * DM * DM * 2, T / 256, DM / 256, F.G, F.bid, (size_t)256 * DM * 2, (size_t)256 * DM * 2};
            EpiResidual E{(l == 0) ? A.in[I_X] : (const float*)nullptr, (l == 0) ? (const bf16*)nullptr : WSP(const bf16, WS_XB), (rep_ + 1 >= REPN(5)) ? WSP(bf16, WS_XB) : WSP(bf16, WS_HS)};
            pg8::gemm_phase<EpiResidual, SchedDense, true, true>(lds3, g, S, E, F.tid);
        } } }
        SEAM(p0 + 5);
        if (IN(p0 + 6) && PHON(6)) { for (int rep_ = 0; rep_ < REPN(6); ++rep_) { if (rep_) GRID_BAR(); { FRAME(); phase_router2(F, WSP(const bf16, WS_XB), A.in[I_FFNG] + l * DM, A.in[I_WCO] + (size_t)l * DM * 4, A.in[I_BCO] + l * 4, A.in[I_WFI] + (size_t)l * DM * 32, A.in[I_BFI] + l * 32, WSP(bf16, WS_H), WSP(unsigned, WS_ROUTE), F.ctl + CW_CNT + l * 32 * 64, WSP(float, WS_Q), rep_ + 1 >= REPN(6)); } } }
        SEAM(p0 + 6);
        if (IN(p0 + 7) && PHON(7)) { for (int rep_ = 0; rep_ < REPN(7); ++rep_) { if (rep_) GRID_BAR(); { FRAME(); phase_index(F, WSP(unsigned, WS_ROUTE), F.ctl + CW_CNT + l * 32 * 64, F.ctl + CW_NT + l * 64, F.ctl + CW_TILE + l * 256, WSP(unsigned, WS_POS + 256 * 1024), WSP(float, WS_POS + 512 * 1024), WSP(float, WS_POS + 768 * 1024), WSP(unsigned, WS_POS)); } } }
        SEAM(p0 + 7);
        if (IN(p0 + 8) && PHON(8)) { for (int rep_ = 0; rep_ < REPN(8); ++rep_) { if (rep_) GRID_BAR(); { FRAME();
            pg8::Gemm g{DM, DM, DM};
            SchedMoe S{(const char*)(ws + WS_H), (const char*)(ws + WS_WEI) + (size_t)l * NEXP * 1024 * DM * 2, F.ctl + CW_NT + l * 64, F.ctl + CW_TILE + l * 256, F.G, F.bid, (size_t)256 * DM * 2, (size_t)1024 * DM * 2, (size_t)256 * DM * 2, WSP(const unsigned, WS_POS + 256 * 1024)};
            EpiSwiglu E{WSP(bf16, WS_ACT), WSP(float, WS_POS + 768 * 1024)};
            pg8::gemm_phase<EpiSwiglu, SchedMoe, true, true, true>(lds3, g, S, E, F.tid);
        } } }
        SEAM(p0 + 8);
        if (IN(p0 + 9) && PHON(9)) { for (int rep_ = 0; rep_ < REPN(9); ++rep_) { if (rep_) GRID_BAR(); { FRAME();
            pg8::Gemm g{FF, FF, FF};
            SchedMoe S{(const char*)(ws + WS_ACT), (const char*)(ws + WS_WEO) + (size_t)l * NEXP * DM * FF * 2, F.ctl + CW_NT + l * 64, F.ctl + CW_TILE + l * 256, F.G, F.bid, (size_t)256 * FF * 2, (size_t)DM * FF * 2, (size_t)256 * FF * 2, nullptr};
            EpiScaleRows E{WSP(bf16, WS_YS), WSP(float, WS_POS + 512 * 1024)};
            pg8::gemm_phase<EpiScaleRows, SchedMoe, true, true>(lds3, g, S, E, F.tid);
        } } }
        SEAM(p0 + 9);
        if (IN(p0 + 10) && PHON(10)) { for (int rep_ = 0; rep_ < REPN(10); ++rep_) { if (rep_) GRID_BAR(); { FRAME(); const bool real_ = (rep_ + 1 >= REPN(10)), lastl_ = (l + 1 >= DEPTH); phase_combine(F, WSP(const bf16, WS_XB), (real_ && !lastl_) ? WSP(bf16, WS_XB) : WSP(bf16, WS_HS), (real_ && lastl_) ? A.out : (float*)nullptr, WSP(bf16, WS_YS), WSP(unsigned, WS_POS), lastl_ ? (const float*)nullptr : A.in[I_MIXG] + (l + 1) * DM, WSP(bf16, WS_H)); } } }
        SEAM(p0 + 10);
    }
#undef IN
#undef SEAM
#undef FRAME
#undef WSP
}

extern "C" void kernel_launch(void* const* d_in, const int* in_sizes, int n_in, void* d_out, int out_size, void* d_ws, size_t ws_size, hipStream_t stream) {
    static int grid = 0;
    if (grid == 0) {
        if (n_in != 23 || out_size != T * DM || ws_size < WS_END) { fprintf(stderr, "kernel_launch: unexpected shapes (n_in %d out %d ws %zu)\n", n_in, out_size, ws_size); grid = -1; return; }
        int dev = 0, cus = 0, per_cu = 0;
        if (hipGetDevice(&dev) != hipSuccess || hipDeviceGetAttribute(&cus, hipDeviceAttributeMultiprocessorCount, dev) != hipSuccess) { grid = -1; return; }
        if (hipFuncSetAttribute((const void*)mk_fwd, hipFuncAttributeMaxDynamicSharedMemorySize, LDS_BYTES) != hipSuccess) { fprintf(stderr, "kernel_launch: hipFuncSetAttribute failed\n"); grid = -1; return; }
        if (hipOccupancyMaxActiveBlocksPerMultiprocessor(&per_cu, (const void*)mk_fwd, 512, LDS_BYTES) != hipSuccess || per_cu < 1) fprintf(stderr, "kernel_launch: occupancy query says %d\n", per_cu);
        (void)hipGetLastError();
        grid = cus;
    }
    if (grid < 0) return;
    (void)hipMemsetAsync((char*)d_ws + WS_CTL, 0, CTL_ZERO_BYTES, stream);
    Args a{};
    for (int i = 0; i < 23; ++i) a.in[i] = (const float*)d_in[i];
    a.out = (float*)d_out; a.ws = (unsigned char*)d_ws;
#if MK_SPLIT
    for (int p = 0; p < N_PHASES; ++p) {
        if (p == 1 + PH_PER_LAYER) continue;
        a.ph_lo = p; a.ph_hi = p + 1;
        hipLaunchKernelGGL(mk_fwd, dim3(grid), dim3(512), LDS_BYTES, stream, a);
    }
#else
    a.ph_lo = 0; a.ph_hi = N_PHASES;
    hipLaunchKernelGGL(mk_fwd, dim3(grid), dim3(512), LDS_BYTES, stream, a);
#endif
}
```

```cpp
#include <hip/hip_runtime.h>
#include <cstdio>
#include <cstdint>

#ifndef MK_SPLIT
#define MK_SPLIT 0
#endif
#ifndef DBG_MASK
#define DBG_MASK 0xFFFFu
#endif
#define PHON(j) (((DBG_MASK) >> (j)) & 1u)
#ifndef REP_MASK
#define REP_MASK 0u
#endif
#ifndef REP_EXTRA
#define REP_EXTRA 1
#endif
#ifndef PROBE_DRY
#define PROBE_DRY 0
#endif
#define REPN(j) ((((REP_MASK) >> (j)) & 1u) ? (1 + REP_EXTRA) : 1)

constexpr int DM = 1024, NB = 8, SEQ = 2048, T = NB * SEQ, DEPTH = 2;
constexpr int NCOL = 7680;
constexpr int C_AQ = 0, C_AK = 512, C_AV = 1024, C_HQ = 1536, C_HF = 2048, C_HI = 2560, C_HG = 3072, C_CA = 3584, C_CB = 4096, C_GL = 4608;
constexpr int NEXP = 32, FF = 512;
constexpr int MOE_ROWS = 2 * T + NEXP * 256;
constexpr float RMS_EPS = 1e-6f, LN_EPS = 1e-5f;
constexpr float QSCALE = 0.125f * 1.4426950408889634f;

namespace pg8 {
#define PG8_LAS __attribute__((address_space(3)))
typedef unsigned short bf16_t;
typedef short bf16x8 __attribute__((ext_vector_type(8)));
typedef float f32x4 __attribute__((ext_vector_type(4)));
typedef unsigned u32x4 __attribute__((ext_vector_type(4)));
constexpr int BM = 256, BK = 64, HALF = 128, HTB = HALF * BK * 2, STAGE_BYTES = 8 * HTB, NXCD = 8, WGM = 8;

__host__ __device__ __forceinline__ int lds_byte(int r, int c) { const int st = (r >> 4) * 2 + (c >> 5), rr = r & 15, cc = c & 31, ob = rr * 64 + cc * 2; return st * 1024 + (ob ^ (((ob >> 9) & 1) << 5)); }
__host__ __device__ __forceinline__ void stage_rc(int b, int& R, int& C) { const int st = b / 1024, sb = b % 1024, swz = sb ^ (((sb >> 9) & 1) << 5); R = (st >> 1) * 16 + swz / 64; C = (st & 1) * 32 + (swz % 64) / 2; }
__host__ __device__ __forceinline__ int perm32(int rho) { const int n = rho >> 4, i = rho & 15; return 8 * (i >> 2) + 4 * n + (i & 3); }

struct Unit { int pm, pn, aux, pad; const char* a; const char* b; const unsigned* gidx; };
struct Gemm { int lda, ldb, K; };

__device__ __forceinline__ bool static_tile(int nM, int nN, long L, int& pm, int& pn) {
    const int nwg = nM * nN; if (L >= nwg) return false;
    int wgid = (int)L; { const int q = nwg / NXCD, r = nwg % NXCD, xcd = wgid % NXCD, off = wgid / NXCD; wgid = (xcd < r ? xcd * (q + 1) : r * (q + 1) + (xcd - r) * q) + off; }
    const int nig = WGM * nN, gid = wgid / nig, fm = gid * WGM, gsz = (nM - fm) < WGM ? (nM - fm) : WGM;
    pm = fm + ((wgid % nig) % gsz); pn = (wgid % nig) / gsz; return true;
}

__device__ __forceinline__ unsigned cvt_pk_bf16(float lo, float hi) { unsigned r; asm volatile("v_cvt_pk_bf16_f32 %0, %1, %2" : "=v"(r) : "v"(lo), "v"(hi)); return r; }

template <class Epi, class Sched, bool ALIGN_EPI = false, bool SP2 = false, bool GATHER = false>
__device__ __forceinline__ void gemm_phase(PG8_LAS unsigned char* lds, const Gemm g, const Sched& S, const Epi& E, int tid_in) {
    int tid_ = tid_in; asm volatile("" : "+v"(tid_));
    const int tid = tid_, wid = __builtin_amdgcn_readfirstlane(tid >> 6), lane = tid & 63, wr = wid >> 2, wc = wid & 3, fr = lane & 15, fq = lane >> 4;
    const int K = g.K, nt = K / BK;
    unsigned voffA[2], voffB[2];
#pragma unroll
    for (int i = 0; i < 2; ++i) { int R, C; stage_rc(tid * 16 + i * 8192, R, C); const int Rb = Epi::PERM ? ((R & ~31) + perm32(R & 31)) : R;
        voffA[i] = (unsigned)(R * g.lda + C) * 2u; voffB[i] = (unsigned)(Rb * g.ldb + C) * 2u; }
    const size_t kstep = (size_t)(BK * 2);
    unsigned gvo[2][2] = {{0u, 0u}, {0u, 0u}}, gnx[2][2] = {{0u, 0u}, {0u, 0u}}; int grow[2] = {0, 0}; unsigned gcol[2] = {0u, 0u};
    if constexpr (GATHER) {
#pragma unroll
        for (int i = 0; i < 2; ++i) { int R, C; stage_rc(tid * 16 + i * 8192, R, C); grow[i] = R; gcol[i] = (unsigned)C * 2u; } }
#define PG8_GCONV(dst, src) do { _Pragma("unroll") for (int h_ = 0; h_ < 2; ++h_) _Pragma("unroll") for (int i_ = 0; i_ < 2; ++i_) dst[h_][i_] = src[h_][i_] * (unsigned)(g.lda * 2) + gcol[i_]; } while (0)
#define PG8_GLOAD(dst, u_) do { _Pragma("unroll") for (int h_ = 0; h_ < 2; ++h_) _Pragma("unroll") for (int i_ = 0; i_ < 2; ++i_) dst[h_][i_] = (u_).gidx[h_ * HALF + grow[i_]]; } while (0)
    const size_t hstepA = (size_t)HALF * g.lda * 2, hstepB = (size_t)HALF * g.ldb * 2;
    const unsigned ldsw = (unsigned)wid * 1024u;
    const int aoff = lds_byte(wr * 64 + fr, fq * 8), boff = lds_byte(wc * 32 + fr, fq * 8);
#define PG8_SA(b, h) (((b) * 2 + (h)) * HTB)
#define PG8_SB(b, h) ((4 + (b) * 2 + (h)) * HTB)
#define PG8_STAGE(bufoff, gbase, voff) do { _Pragma("unroll") for (int _i = 0; _i < 2; ++_i) \
        __builtin_amdgcn_global_load_lds((const unsigned*)((const char*)(gbase) + (voff)[_i]), (PG8_LAS unsigned*)(lds + (bufoff) + ldsw + _i * 8192), 16, 0, 0); } while (0)
#define PG8_LDA(dst, b, h) do { _Pragma("unroll") for (int m = 0; m < 4; ++m) _Pragma("unroll") for (int k = 0; k < 2; ++k) dst[m][k] = *(const PG8_LAS bf16x8*)(lds + PG8_SA(b, h) + aoff + m * 2048 + k * 1024); } while (0)
#define PG8_LDB(dst, b, h) do { _Pragma("unroll") for (int n = 0; n < 2; ++n) _Pragma("unroll") for (int k = 0; k < 2; ++k) dst[n][k] = *(const PG8_LAS bf16x8*)(lds + PG8_SB(b, h) + boff + n * 2048 + k * 1024); } while (0)
#define PG8_MMA(ai, bj, At, Bt) do { __builtin_amdgcn_s_setprio(1); _Pragma("unroll") for (int m = 0; m < 4; ++m) _Pragma("unroll") for (int n = 0; n < 2; ++n) _Pragma("unroll") for (int k = 0; k < 2; ++k) \
        acc[ai][bj][m][n] = __builtin_amdgcn_mfma_f32_16x16x32_bf16(Bt[n][k], At[m][k], acc[ai][bj][m][n], 0, 0, 0); __builtin_amdgcn_s_setprio(0); } while (0)
#define PG8_WAIT_V(n) asm volatile("s_waitcnt vmcnt(" #n ")" ::: "memory")
#define PG8_WAIT_L(n) asm volatile("s_waitcnt lgkmcnt(" #n ")" ::: "memory")
#define PG8_BAR __builtin_amdgcn_s_barrier()
#define PG8_SCHED __builtin_amdgcn_sched_barrier(0)
    Unit cur, nxt; int ui = 0;
    if (!S.next(0, cur)) return;
    f32x4 acc[2][2][4][2];
#pragma unroll
    for (int a = 0; a < 2; ++a)
#pragma unroll
        for (int b = 0; b < 2; ++b)
#pragma unroll
            for (int m = 0; m < 4; ++m)
#pragma unroll
                for (int n = 0; n < 2; ++n) acc[a][b][m][n] = (f32x4){0.f, 0.f, 0.f, 0.f};
    bf16x8 At[4][2], B0[2][2], B1[2][2];
    const char* cA = cur.a; const char* cB = cur.b;
    if constexpr (GATHER) { PG8_GLOAD(gnx, cur); PG8_GCONV(gvo, gnx); }
#define PG8_STAGE_A(bufoff, kbase, half, nextu) do { if constexpr (GATHER) { unsigned vo_[2]; if (nextu) { vo_[0] = gnx[half][0] * (unsigned)(g.lda * 2) + gcol[0]; vo_[1] = gnx[half][1] * (unsigned)(g.lda * 2) + gcol[1]; } \
        else { vo_[0] = gvo[half][0]; vo_[1] = gvo[half][1]; } PG8_STAGE(bufoff, kbase, vo_); } else { PG8_STAGE(bufoff, (kbase) + (half) * hstepA, voffA); } } while (0)
    if constexpr (SP2) {
        PG8_STAGE(PG8_SB(0, 0), cB, voffB); PG8_STAGE(PG8_SB(0, 1), cB + hstepB, voffB); PG8_STAGE_A(PG8_SA(0, 0), cA, 0, false); PG8_STAGE_A(PG8_SA(0, 1), cA, 1, false);
        if (wr == 1) PG8_BAR;
        PG8_WAIT_V(2); PG8_BAR;
        PG8_STAGE(PG8_SB(1, 0), cB + kstep, voffB); PG8_STAGE_A(PG8_SA(1, 0), cA + kstep, 0, false); PG8_STAGE(PG8_SB(1, 1), cB + hstepB + kstep, voffB);
        PG8_WAIT_V(6); PG8_BAR;
    } else {
        PG8_STAGE(PG8_SB(0, 0), cB, voffB); PG8_STAGE(PG8_SA(0, 0), cA, voffA); PG8_STAGE(PG8_SB(0, 1), cB + hstepB, voffB); PG8_STAGE(PG8_SA(0, 1), cA + hstepA, voffA);
        if (wr == 1) PG8_BAR;
        PG8_WAIT_V(4); PG8_BAR;
        PG8_STAGE(PG8_SB(1, 0), cB + kstep, voffB); PG8_STAGE(PG8_SA(1, 0), cA + kstep, voffA); PG8_STAGE(PG8_SB(1, 1), cB + hstepB + kstep, voffB);
        PG8_WAIT_V(6); PG8_BAR;
    }
    for (;;) {
        const bool has_next = S.next(ui + 1, nxt);
        const char* nA = has_next ? nxt.a : cA; const char* nB = has_next ? nxt.b : cB;
        if constexpr (GATHER) { if (has_next) PG8_GLOAD(gnx, nxt); }
        for (int t = 0; t < nt; t += 2) {
            const bool last = (t == nt - 2);
            const char* a1 = cA + (size_t)(t + 1) * kstep;
            const char* a2 = last ? nA : cA + (size_t)(t + 2) * kstep; const char* b2 = last ? nB : cB + (size_t)(t + 2) * kstep;
            const char* a3 = a2 + kstep; const char* b3 = b2 + kstep;
            if constexpr (SP2) {
            PG8_LDB(B0, 0, 0); PG8_LDB(B1, 0, 1); PG8_SCHED; PG8_LDA(At, 0, 0); PG8_STAGE_A(PG8_SA(1, 1), a1, 1, false);
            PG8_WAIT_V(8); PG8_WAIT_L(0); PG8_BAR; PG8_MMA(0, 0, At, B0); PG8_MMA(0, 1, At, B1); PG8_BAR; PG8_SCHED;
            PG8_LDA(At, 0, 1); PG8_STAGE(PG8_SB(0, 0), b2, voffB); PG8_STAGE(PG8_SB(0, 1), b2 + hstepB, voffB); PG8_STAGE_A(PG8_SA(0, 0), a2, 0, last);
            PG8_WAIT_V(8); PG8_WAIT_L(0); PG8_BAR; PG8_MMA(1, 0, At, B0); PG8_MMA(1, 1, At, B1); PG8_BAR; PG8_SCHED;
            PG8_LDB(B0, 1, 0); PG8_LDB(B1, 1, 1); PG8_SCHED; PG8_LDA(At, 1, 0); PG8_STAGE_A(PG8_SA(0, 1), a2, 1, last);
            PG8_WAIT_V(8); PG8_WAIT_L(0); PG8_BAR; PG8_MMA(0, 0, At, B0); PG8_MMA(0, 1, At, B1); PG8_BAR; PG8_SCHED;
            PG8_LDA(At, 1, 1); PG8_STAGE(PG8_SB(1, 0), b3, voffB); PG8_STAGE(PG8_SB(1, 1), b3 + hstepB, voffB); PG8_STAGE_A(PG8_SA(1, 0), a3, 0, last);
            PG8_WAIT_V(8); PG8_WAIT_L(0); PG8_BAR; PG8_MMA(1, 0, At, B0); PG8_MMA(1, 1, At, B1); PG8_BAR; PG8_SCHED;
            } else {
            PG8_LDB(B0, 0, 0); PG8_SCHED; PG8_LDA(At, 0, 0); PG8_STAGE(PG8_SA(1, 1), a1 + hstepA, voffA);
            PG8_WAIT_L(8); PG8_BAR; PG8_WAIT_L(0); PG8_MMA(0, 0, At, B0); PG8_BAR; PG8_SCHED;
            PG8_LDB(B1, 0, 1); PG8_STAGE(PG8_SB(0, 0), b2, voffB);
            PG8_BAR; PG8_WAIT_L(0); PG8_MMA(0, 1, At, B1); PG8_BAR;
            PG8_LDA(At, 0, 1); PG8_STAGE(PG8_SA(0, 0), a2, voffA);
            PG8_BAR; PG8_WAIT_L(0); PG8_MMA(1, 0, At, B0); PG8_BAR; PG8_SCHED;
            PG8_STAGE(PG8_SB(0, 1), b2 + hstepB, voffB);
            PG8_WAIT_V(6); PG8_BAR; PG8_MMA(1, 1, At, B1); PG8_BAR;
            PG8_LDB(B0, 1, 0); PG8_SCHED; PG8_LDA(At, 1, 0); PG8_STAGE(PG8_SA(0, 1), a2 + hstepA, voffA);
            PG8_WAIT_L(8); PG8_BAR; PG8_WAIT_L(0); PG8_MMA(0, 0, At, B0); PG8_BAR; PG8_SCHED;
            PG8_LDB(B1, 1, 1); PG8_STAGE(PG8_SB(1, 0), b3, voffB);
            PG8_BAR; PG8_WAIT_L(0); PG8_MMA(0, 1, At, B1); PG8_BAR;
            PG8_LDA(At, 1, 1); PG8_STAGE(PG8_SA(1, 0), a3, voffA);
            PG8_BAR; PG8_WAIT_L(0); PG8_MMA(1, 0, At, B0); PG8_BAR; PG8_SCHED;
            PG8_STAGE(PG8_SB(1, 1), b3 + hstepB, voffB);
            PG8_WAIT_V(6); PG8_BAR; PG8_MMA(1, 1, At, B1); PG8_BAR;
            }
        }
        if constexpr (ALIGN_EPI) { if (wr == 0) PG8_BAR; }
        const bool reset_acc = E(acc, cur, wr, wc, fr, fq);
        if (!has_next) break;
        if (reset_acc) {
#pragma unroll
        for (int a = 0; a < 2; ++a)
#pragma unroll
            for (int b = 0; b < 2; ++b)
#pragma unroll
                for (int m = 0; m < 4; ++m)
#pragma unroll
                    for (int n = 0; n < 2; ++n) acc[a][b][m][n] = (f32x4){0.f, 0.f, 0.f, 0.f};
        }
        cur = nxt; cA = nA; cB = nB; ++ui;
        if constexpr (GATHER) PG8_GCONV(gvo, gnx);
        if constexpr (ALIGN_EPI) { if (wr == 1) PG8_BAR; }
    }
    PG8_WAIT_V(0);
    if constexpr (!ALIGN_EPI) { if (wr == 0) PG8_BAR; }
    PG8_BAR;
#undef PG8_SA
#undef PG8_SB
#undef PG8_STAGE
#undef PG8_STAGE_A
#undef PG8_GCONV
#undef PG8_GLOAD
#undef PG8_LDA
#undef PG8_LDB
#undef PG8_MMA
#undef PG8_WAIT_V
#undef PG8_WAIT_L
#undef PG8_BAR
#undef PG8_SCHED
}
}

constexpr size_t MiB = 1u << 20;
constexpr size_t WS_CTL = 0, CTL_ZERO_BYTES = 1 * MiB;
constexpr size_t WS_WIN = 2 * MiB;
constexpr size_t WS_WCAT = WS_WIN + 30 * MiB;
constexpr size_t WS_WOUT = WS_WCAT + 6 * MiB;
constexpr size_t WS_WEI = WS_WOUT + 4 * MiB;
constexpr size_t WS_WEO = WS_WEI + 128 * MiB;
constexpr size_t WS_H = WS_WEO + 64 * MiB;
constexpr size_t WS_PROJ = WS_H + 32 * MiB;
constexpr size_t WS_Q = WS_PROJ + 240 * MiB;
constexpr size_t WS_K = WS_Q + 16 * MiB;
constexpr size_t WS_KMEAN = WS_K + 16 * MiB;
constexpr size_t WS_CAT = WS_KMEAN + 1 * MiB;
constexpr size_t WS_MERGED = WS_CAT + 48 * MiB;
constexpr size_t WS_ORAW = WS_MERGED + 32 * MiB;
constexpr size_t WS_ROUTE = WS_ORAW + 32 * MiB;
constexpr size_t WS_POS = WS_ROUTE + 1 * MiB;
constexpr size_t WS_HS = WS_POS + 1 * MiB;
constexpr size_t WS_ACT = WS_HS + 80 * MiB;
constexpr size_t WS_YS = WS_ACT + 40 * MiB;
constexpr size_t WS_XB = WS_YS + 80 * MiB;
constexpr size_t WS_GT = WS_XB + 32 * MiB;
constexpr size_t WS_END = WS_GT + 96 * MiB;
static_assert(WS_END <= 1000 * MiB, "workspace map");
constexpr int CW_BAR = 4096;
constexpr int CW_CNT = 16384;
constexpr int CW_NT = CW_CNT + 2 * 32 * 64;
constexpr int CW_TILE = CW_NT + 2 * 64;
static_assert((CW_TILE + 2 * 256) * 4 <= (int)CTL_ZERO_BYTES, "ctl");

constexpr int LDS_SCRATCH = 155136, LDSCTL_OFF = LDS_SCRATCH, LDS_BYTES = 155648;

#define GAS __attribute__((address_space(1)))
#define LAS __attribute__((address_space(3)))
typedef unsigned short bf16;
typedef unsigned v4u __attribute__((ext_vector_type(4)));
typedef unsigned v2u __attribute__((ext_vector_type(2)));
typedef float f32x4 __attribute__((ext_vector_type(4)));
typedef float f32x2 __attribute__((ext_vector_type(2)));
#define RLX_AGENT __ATOMIC_RELAXED, __HIP_MEMORY_SCOPE_AGENT
__device__ __forceinline__ unsigned f2bf(float f) { unsigned u = __builtin_bit_cast(unsigned, f); return (u + 0x7fffu + ((u >> 16) & 1u)) >> 16; }
__device__ __forceinline__ unsigned pk2(float lo, float hi) { unsigned r; asm("v_cvt_pk_bf16_f32 %0, %1, %2" : "=v"(r) : "v"(lo), "v"(hi)); return r; }
__device__ __forceinline__ float bflo(unsigned w) { return __uint_as_float(w << 16); }
__device__ __forceinline__ float bfhi(unsigned w) { return __uint_as_float(w & 0xffff0000u); }
__device__ __forceinline__ float bf2f(bf16 v) { return __uint_as_float((unsigned)v << 16); }
__device__ __forceinline__ float sigmoidf_(float x) { return __builtin_amdgcn_rcpf(1.0f + __expf(-x)); }
__device__ __forceinline__ float wave_sum(float v) {
    v += __int_as_float(__builtin_amdgcn_update_dpp(0, __float_as_int(v), 0xB1, 0xf, 0xf, true));
    v += __int_as_float(__builtin_amdgcn_update_dpp(0, __float_as_int(v), 0x4E, 0xf, 0xf, true));
    v += __int_as_float(__builtin_amdgcn_update_dpp(0, __float_as_int(v), 0x141, 0xf, 0xf, true));
    v += __int_as_float(__builtin_amdgcn_update_dpp(0, __float_as_int(v), 0x140, 0xf, 0xf, true));
    { auto r = __builtin_amdgcn_permlane16_swap(__float_as_uint(v), __float_as_uint(v), false, false); v = __uint_as_float(r[0]) + __uint_as_float(r[1]); }
    { auto r = __builtin_amdgcn_permlane32_swap(__float_as_uint(v), __float_as_uint(v), false, false); v = __uint_as_float(r[0]) + __uint_as_float(r[1]); }
    return v;
}

__device__ __forceinline__ void lds_barrier() { asm volatile("s_waitcnt lgkmcnt(0)\n\ts_barrier" ::: "memory"); }

#define XB_TMO      128
#define XB_XCNT(j)  (256  + 64 * (j))
#define XB_XSUB(j)  (1280 + 64 * (j))
#define XB_XGEN(j)  (2304 + 64 * (j))
#define XB_TOP      3328
#define XB_TOPGEN   3392
#define XCD_BAR_WORDS 3456
#define XB_SPIN_CAP (1u << 18)
__device__ __forceinline__ unsigned xb_ld(unsigned* p)              { return __hip_atomic_load(p, __ATOMIC_RELAXED, __HIP_MEMORY_SCOPE_AGENT); }
__device__ __forceinline__ unsigned xb_add(unsigned* p, unsigned v) { return __hip_atomic_fetch_add(p, v, __ATOMIC_RELAXED, __HIP_MEMORY_SCOPE_AGENT); }
__device__ __forceinline__ unsigned xb_xcc_id() { return (unsigned)__builtin_amdgcn_s_getreg((3 << 11) | 20) & 0xFu; }
#define XB_SPIN(cond, bar) do { unsigned _sp = 0; while (cond) { __builtin_amdgcn_s_sleep(1); \
    if ((++_sp & 255u) == 0u) { if (xb_ld(&(bar)[XB_TMO])) break; if (_sp > XB_SPIN_CAP) { atomicAdd(&(bar)[XB_TMO], 1u); break; } } } } while (0)
struct XcdBarrier { unsigned* bar; unsigned x; volatile LAS unsigned* st; };
__device__ __forceinline__ XcdBarrier xcd_barrier_post(unsigned* bar, volatile LAS unsigned* st) {
    XcdBarrier b; b.bar = bar; b.x = xb_xcc_id(); b.st = st;
    if (threadIdx.x == 0) (void)xb_add(&bar[XB_XCNT(b.x)], 1u);
    return b;
}
__device__ __forceinline__ void xcd_barrier_complete(unsigned* bar, unsigned x, unsigned& nloc, unsigned& nx) {
    const unsigned G = gridDim.x * gridDim.y * gridDim.z;
    unsigned sum, cnt, mine, sp = 0u;
    for (;;) {
        sum = 0u; cnt = 0u; mine = 0u;
#pragma unroll
        for (unsigned j = 0; j < 16; ++j) { const unsigned c = xb_ld(&bar[XB_XCNT(j)]); sum += c; cnt += (c > 0u) ? 1u : 0u; mine = (j == x) ? c : mine; }
        if (sum == G) break;
        __builtin_amdgcn_s_sleep(1);
        if ((++sp & 255u) == 0u) { if (xb_ld(&bar[XB_TMO])) break; if (sp > XB_SPIN_CAP) { atomicAdd(&bar[XB_TMO], 1u); break; } }
    }
    nloc = mine > 0u ? mine : 1u; nx = cnt > 0u ? cnt : 1u;
}
__device__ __forceinline__ void xcd_barrier(const XcdBarrier& b) {
    asm volatile("s_waitcnt vmcnt(0)" ::: "memory");
    __syncthreads();
    if (threadIdx.x == 0) {
        unsigned* bar = b.bar;
        __builtin_amdgcn_s_waitcnt(0);
        unsigned nloc = b.st[0], nx = b.st[1];
        if (nloc == 0u) { xcd_barrier_complete(bar, b.x, nloc, nx); b.st[0] = nloc; b.st[1] = nx; }
        const unsigned old = xb_add(&bar[XB_XSUB(b.x)], 1u);
        const unsigned gen = old / nloc;
        if (old + 1u == (gen + 1u) * nloc) {
            __builtin_amdgcn_fence(__ATOMIC_RELEASE, "agent");
            asm volatile("s_waitcnt vmcnt(0)" ::: "memory");
            const unsigned og = xb_add(&bar[XB_TOP], 1u);
            const unsigned tg = og / nx;
            if (og + 1u == (tg + 1u) * nx) xb_add(&bar[XB_TOPGEN], 1u);
            else XB_SPIN(xb_ld(&bar[XB_TOPGEN]) == tg, bar);
            __builtin_amdgcn_fence(__ATOMIC_ACQUIRE, "agent");
            xb_add(&bar[XB_XGEN(b.x)], 1u);
            asm volatile("s_waitcnt vmcnt(0)" ::: "memory");
        } else {
            XB_SPIN(xb_ld(&bar[XB_XGEN(b.x)]) == gen, bar);
            __builtin_amdgcn_fence(__ATOMIC_ACQUIRE, "agent");
            asm volatile("s_waitcnt vmcnt(0)" ::: "memory");
        }
    }
    __syncthreads();
}

struct Args { const float* in[23]; float* out; unsigned char* ws; int ph_lo, ph_hi; };
typedef const Args __attribute__((address_space(4))) CArgs;
enum InIdx { I_X = 0, I_MIXG, I_WIN, I_BGATE, I_QG, I_KG, I_LBL, I_HGG, I_CONVW, I_CONVB, I_CLNG, I_CLNB, I_WATT, I_WHGRN, I_WCONV, I_WOUT, I_FFNG, I_WCO, I_BCO, I_WFI, I_BFI, I_WEI, I_WEO };

struct Frame {
    unsigned char* lds;
    int tid, lane, wave, G, bid;
    unsigned char* ws; unsigned* ctl;
};
__device__ __forceinline__ int xcd_order(int bid, int G) { return (G % 8 == 0) ? (bid % 8) * (G / 8) + bid / 8 : bid; }
__device__ __forceinline__ int lane_id_asm() { int l; asm volatile("v_mbcnt_lo_u32_b32 %0, -1, 0\n\tv_mbcnt_hi_u32_b32 %0, -1, %0" : "=v"(l)); return l; }
__device__ __forceinline__ Frame fresh(Frame F) { asm volatile("" : "+v"(F.tid)); F.lane = F.tid & 63; return F; }

struct TItem { const float* W; bf16* WT; int K, N, k0, n0, drow0; };
__device__ __forceinline__ void titem_load(const TItem& t, int lane, float (&v)[32]) {
#pragma unroll
    for (int i = 0; i < 32; ++i) { const int kk = 2 * i + (lane >> 5); v[i] = __builtin_nontemporal_load(t.W + (size_t)(t.k0 + kk) * t.N + t.n0 + (lane & 31)); }
}
__device__ __forceinline__ void titem_emit(const TItem& t, int lane, const float (&v)[32], float* scr) {
#pragma unroll
    for (int i = 0; i < 32; ++i) { const int kk = 2 * i + (lane >> 5); scr[kk * 33 + (lane & 31)] = v[i]; }
    asm volatile("s_waitcnt lgkmcnt(0)" ::: "memory");
    const int c = lane & 7;
#pragma unroll
    for (int j = 0; j < 4; ++j) { const int n = (lane >> 3) + 8 * j; const float* s = scr + (8 * c) * 33 + n;
        v4u o; o.x = pk2(s[0 * 33], s[1 * 33]); o.y = pk2(s[2 * 33], s[3 * 33]); o.z = pk2(s[4 * 33], s[5 * 33]); o.w = pk2(s[6 * 33], s[7 * 33]);
        *(v4u*)(t.WT + (size_t)(t.drow0 + n) * t.K + t.k0 + 8 * c) = o; }
    asm volatile("s_waitcnt lgkmcnt(0)" ::: "memory");
}
__device__ __forceinline__ TItem titem_decode(CArgs& A, unsigned char* ws, int it) {
    constexpr int I_IN = (DM / 64) * (NCOL / 32), I_BR = (512 / 64) * (DM / 32), I_OUT = (DM / 64) * (DM / 32), I_EI = (DM / 64) * (1024 / 32), I_EO = (FF / 64) * (DM / 32);
    constexpr int PER_L = I_IN + 3 * I_BR + I_OUT + NEXP * I_EI + NEXP * I_EO;
    TItem t; const int l = it / PER_L; int r = it % PER_L;
    if (r < I_IN) { const int nblk = NCOL / 32, kb = r / nblk, nb = r % nblk;
        t.W = A.in[I_WIN] + (size_t)l * DM * NCOL; t.K = DM; t.N = NCOL; t.WT = (bf16*)(ws + WS_WIN) + (size_t)l * NCOL * DM; t.k0 = 64 * kb; t.n0 = 32 * nb; t.drow0 = 32 * nb; return t; }
    r -= I_IN;
    if (r < 3 * I_BR) { const int br = r / I_BR, rr = r % I_BR, nblk = DM / 32, kb = rr / nblk, nb = rr % nblk;
        t.W = A.in[br == 0 ? I_WATT : (br == 1 ? I_WHGRN : I_WCONV)] + (size_t)l * 512 * DM; t.K = 512; t.N = DM; t.WT = (bf16*)(ws + WS_WCAT) + ((size_t)l * 3 + br) * DM * 512; t.k0 = 64 * kb; t.n0 = 32 * nb; t.drow0 = 32 * nb; return t; }
    r -= 3 * I_BR;
    if (r < I_OUT) { const int nblk = DM / 32, kb = r / nblk, nb = r % nblk;
        t.W = A.in[I_WOUT] + (size_t)l * DM * DM; t.K = DM; t.N = DM; t.WT = (bf16*)(ws + WS_WOUT) + (size_t)l * DM * DM; t.k0 = 64 * kb; t.n0 = 32 * nb; t.drow0 = 32 * nb; return t; }
    r -= I_OUT;
    if (r < NEXP * I_EI) { const int e = r / I_EI, rr = r % I_EI, nblk = 1024 / 32, kb = rr / nblk, nb = rr % nblk, n0 = 32 * nb;
        const int nn = n0 & 511;
        t.W = A.in[I_WEI] + ((size_t)l * NEXP + e) * DM * 1024; t.K = DM; t.N = 1024; t.WT = (bf16*)(ws + WS_WEI) + ((size_t)l * NEXP + e) * 1024 * DM; t.k0 = 64 * kb; t.n0 = n0; t.drow0 = (nn >> 7) * 256 + (n0 >= 512 ? 128 : 0) + (nn & 127); return t; }
    r -= NEXP * I_EI;
    { const int e = r / I_EO, rr = r % I_EO, nblk = DM / 32, kb = rr / nblk, nb = rr % nblk;
        t.W = A.in[I_WEO] + ((size_t)l * NEXP + e) * FF * DM; t.K = FF; t.N = DM; t.WT = (bf16*)(ws + WS_WEO) + ((size_t)l * NEXP + e) * DM * FF; t.k0 = 64 * kb; t.n0 = 32 * nb; t.drow0 = 32 * nb; return t; }
}
__device__ __forceinline__ void phase_prologue(const Frame& F0, CArgs& A) {
    const Frame F = fresh(F0);
    float* scr = (float*)(F.lds + F.wave * 16384);
    const int gw = F.bid * 8 + F.wave, NGW = F.G * 8;
    constexpr int I_IN = (DM / 64) * (NCOL / 32), I_BR = (512 / 64) * (DM / 32), I_OUT = (DM / 64) * (DM / 32), I_EI = (DM / 64) * (1024 / 32), I_EO = (FF / 64) * (DM / 32);
    constexpr int NIT = DEPTH * (I_IN + 3 * I_BR + I_OUT + NEXP * I_EI + NEXP * I_EO);
    if (gw >= NIT) return;
    float cur[32], nxt[32];
    TItem tc = titem_decode(A, F.ws, NIT - 1 - gw);
    titem_load(tc, F.lane, cur);
    for (int it = gw; it < NIT; it += NGW) {
        TItem tn = tc; const bool more = (it + NGW < NIT);
        if (more) { tn = titem_decode(A, F.ws, NIT - 1 - (it + NGW)); titem_load(tn, F.lane, nxt); }
        titem_emit(tc, F.lane, cur, scr);
        if (more) {
#pragma unroll
            for (int i = 0; i < 32; ++i) cur[i] = nxt[i];
            tc = tn; }
    }
}

__device__ __forceinline__ void phase_norm(const Frame& F0, const float* x, const float* gain, bf16* out) {
    const Frame F = fresh(F0);
    const int gw = F.bid * 8 + F.wave, NGW = F.G * 8;
    f32x4 g[4];
#pragma unroll
    for (int j = 0; j < 4; ++j) g[j] = *(const f32x4*)(gain + 4 * F.lane + 256 * j);
    const int RPW = (T + NGW - 1) / NGW, mbase = (xcd_order(F.bid, F.G) * 8 + F.wave) * RPW;
    for (int r0 = 0; r0 < RPW; r0 += 4) {
        f32x4 v[4][4];
#pragma unroll
        for (int q = 0; q < 4; ++q) { const int m = (r0 + q < RPW) ? mbase + r0 + q : T; if (m < T) { const f32x4* xr = (const f32x4*)(x + (size_t)m * DM) + F.lane;
#pragma unroll
                for (int j = 0; j < 4; ++j) v[q][j] = xr[64 * j]; } }
#pragma unroll
        for (int q = 0; q < 4; ++q) { const int m = (r0 + q < RPW) ? mbase + r0 + q : T; if (m < T) { float s = 0.f;
#pragma unroll
                for (int j = 0; j < 4; ++j) s += (v[q][j].x * v[q][j].x + v[q][j].y * v[q][j].y) + (v[q][j].z * v[q][j].z + v[q][j].w * v[q][j].w);
                const float r = rsqrtf(wave_sum(s) * (1.f / DM) + RMS_EPS);
                v2u* o8 = (v2u*)(out + (size_t)m * DM) + F.lane;
#pragma unroll
                for (int j = 0; j < 4; ++j) { v2u w; w.x = pk2(v[q][j].x * r * g[j].x, v[q][j].y * r * g[j].y); w.y = pk2(v[q][j].z * r * g[j].z, v[q][j].w * r * g[j].w); o8[64 * j] = w; } } }
    }
}

__device__ __forceinline__ void phase_qkprep(const Frame& F0, const bf16* proj, const float* qg, const float* kg, bf16* Q, bf16* Kb, float* kmean) {
    const Frame F = fresh(F0);
    float* red = (float*)F.lds;
    float* red2 = red + 256 * 65;
    const int tok = F.tid >> 1, hf = F.tid & 1;
    float qgv[32], kgv[32];
#pragma unroll
    for (int i = 0; i < 8; ++i) { const f32x4 a = *(const f32x4*)(qg + hf * 32 + 4 * i), c = *(const f32x4*)(kg + hf * 32 + 4 * i);
        qgv[4 * i] = a.x; qgv[4 * i + 1] = a.y; qgv[4 * i + 2] = a.z; qgv[4 * i + 3] = a.w; kgv[4 * i] = c.x; kgv[4 * i + 1] = c.y; kgv[4 * i + 2] = c.z; kgv[4 * i + 3] = c.w; }
    for (int u = xcd_order(F.bid, F.G); u < 512; u += F.G) {
        const int b = u >> 6, blk = (u >> 3) & 7, h = u & 7;
        const size_t row = (size_t)b * SEQ + blk * 256 + tok;
        const bf16* pq = proj + row * NCOL + C_AQ + h * 64 + hf * 32;
        const bf16* pk = proj + row * NCOL + C_AK + h * 64 + hf * 32;
        float qv[32], kv[32];
#pragma unroll
        for (int i = 0; i < 4; ++i) { const v4u a = *(const v4u*)(pq + 8 * i), c = *(const v4u*)(pk + 8 * i);
            qv[8 * i + 0] = bflo(a.x); qv[8 * i + 1] = bfhi(a.x); qv[8 * i + 2] = bflo(a.y); qv[8 * i + 3] = bfhi(a.y); qv[8 * i + 4] = bflo(a.z); qv[8 * i + 5] = bfhi(a.z); qv[8 * i + 6] = bflo(a.w); qv[8 * i + 7] = bfhi(a.w);
            kv[8 * i + 0] = bflo(c.x); kv[8 * i + 1] = bfhi(c.x); kv[8 * i + 2] = bflo(c.y); kv[8 * i + 3] = bfhi(c.y); kv[8 * i + 4] = bflo(c.z); kv[8 * i + 5] = bfhi(c.z); kv[8 * i + 6] = bflo(c.w); kv[8 * i + 7] = bfhi(c.w); }
        float sq = 0.f, sk = 0.f;
#pragma unroll
        for (int i = 0; i < 32; ++i) { sq += qv[i] * qv[i]; sk += kv[i] * kv[i]; }
        sq += __shfl_xor(sq, 1); sk += __shfl_xor(sk, 1);
        const float rq = rsqrtf(sq * (1.f / 64.f) + RMS_EPS) * QSCALE, rk = rsqrtf(sk * (1.f / 64.f) + RMS_EPS);
#pragma unroll
        for (int i = 0; i < 32; ++i) { qv[i] = qv[i] * rq * qgv[i]; kv[i] = kv[i] * rk * kgv[i]; }
        bf16* oq = Q + row * 512 + h * 64 + hf * 32; bf16* ok = Kb + row * 512 + h * 64 + hf * 32;
#pragma unroll
        for (int i = 0; i < 4; ++i) { v4u a, c;
            a.x = pk2(qv[8 * i], qv[8 * i + 1]); a.y = pk2(qv[8 * i + 2], qv[8 * i + 3]); a.z = pk2(qv[8 * i + 4], qv[8 * i + 5]); a.w = pk2(qv[8 * i + 6], qv[8 * i + 7]);
            c.x = pk2(kv[8 * i], kv[8 * i + 1]); c.y = pk2(kv[8 * i + 2], kv[8 * i + 3]); c.z = pk2(kv[8 * i + 4], kv[8 * i + 5]); c.w = pk2(kv[8 * i + 6], kv[8 * i + 7]);
            *(v4u*)(oq + 8 * i) = a; *(v4u*)(ok + 8 * i) = c; }
        __syncthreads();
#pragma unroll
        for (int i = 0; i < 32; ++i) red[tok * 65 + hf * 32 + i] = kv[i];
        __syncthreads();
        { const int d = F.tid & 63, part = F.tid >> 6; float s = 0.f;
            for (int tk = 0; tk < 32; ++tk) s += red[(part * 32 + tk) * 65 + d];
            red2[part * 64 + d] = s; }
        __syncthreads();
        if (F.tid < 64) { float s = 0.f;
#pragma unroll
            for (int p = 0; p < 8; ++p) s += red2[p * 64 + F.tid];
            kmean[(((size_t)b * 8 + h) * 8 + blk) * 64 + F.tid] = s * (1.f / 256.f); }
    }
    __syncthreads();
}

__device__ __forceinline__ void phase_conv(const Frame& F0, const bf16* proj, const float* cw, const float* cb, const float* lng, const float* lnb, bf16* cat) {
    const Frame F = fresh(F0);
    float* ut = (float*)F.lds;
    const int c = F.tid;
    float w[31];
#pragma unroll
    for (int j = 0; j < 31; ++j) w[j] = cw[j * 512 + c];
    const float bias = cb[c];
    const f32x4 g0 = *(const f32x4*)(lng + 8 * F.lane), g1 = *(const f32x4*)(lng + 8 * F.lane + 4), b0 = *(const f32x4*)(lnb + 8 * F.lane), b1 = *(const f32x4*)(lnb + 8 * F.lane + 4);
    for (int u = xcd_order(F.bid, F.G); u < 512; u += F.G) {
        const int b = u >> 6, t0 = (u & 63) * 32;
        __syncthreads();
        {
            v4u av[8], gv[8];
#pragma unroll
            for (int i = 0; i < 8; ++i) { const int idx = F.tid + 512 * i, r = idx >> 6, ch = (idx & 63) * 8, t = t0 - 30 + r;
                if (r < 62 && t >= 0) { const bf16* p = proj + ((size_t)b * SEQ + t) * NCOL + ch; av[i] = *(const v4u*)(p + C_CA); gv[i] = *(const v4u*)(p + C_CB); }
                else { av[i] = (v4u){0u, 0u, 0u, 0u}; gv[i] = (v4u){0u, 0u, 0u, 0u}; } }
#pragma unroll
            for (int i = 0; i < 8; ++i) { const int idx = F.tid + 512 * i, r = idx >> 6, ch = (idx & 63) * 8;
                if (r < 62) {
                    f32x4 u0, u1;
                    u0.x = bflo(av[i].x) * sigmoidf_(bflo(gv[i].x)); u0.y = bfhi(av[i].x) * sigmoidf_(bfhi(gv[i].x)); u0.z = bflo(av[i].y) * sigmoidf_(bflo(gv[i].y)); u0.w = bfhi(av[i].y) * sigmoidf_(bfhi(gv[i].y));
                    u1.x = bflo(av[i].z) * sigmoidf_(bflo(gv[i].z)); u1.y = bfhi(av[i].z) * sigmoidf_(bfhi(gv[i].z)); u1.z = bflo(av[i].w) * sigmoidf_(bflo(gv[i].w)); u1.w = bfhi(av[i].w) * sigmoidf_(bfhi(gv[i].w));
                    *(f32x4*)(ut + r * 512 + ch) = u0; *(f32x4*)(ut + r * 512 + ch + 4) = u1; } }
        }
        __syncthreads();
        float uu[62];
#pragma unroll
        for (int i = 0; i < 62; ++i) uu[i] = ut[i * 512 + c];
#pragma unroll
        for (int t = 0; t < 32; ++t) { float a = bias;
#pragma unroll
            for (int j = 0; j < 31; ++j) a += w[j] * uu[t + j];
            ut[t * 512 + c] = a; }
        __syncthreads();
#pragma unroll
        for (int q = 0; q < 4; ++q) { const int t = F.wave * 4 + q;
            const f32x4 v0 = *(const f32x4*)(ut + t * 512 + 8 * F.lane), v1 = *(const f32x4*)(ut + t * 512 + 8 * F.lane + 4);
            const float mu = wave_sum((v0.x + v0.y) + (v0.z + v0.w) + (v1.x + v1.y) + (v1.z + v1.w)) * (1.f / 512.f);
            const f32x4 d0 = v0 - mu, d1 = v1 - mu;
            const float var = wave_sum((d0.x * d0.x + d0.y * d0.y) + (d0.z * d0.z + d0.w * d0.w) + (d1.x * d1.x + d1.y * d1.y) + (d1.z * d1.z + d1.w * d1.w)) * (1.f / 512.f);
            const float rs = rsqrtf(var + LN_EPS);
            f32x4 y0 = d0 * rs * g0 + b0, y1 = d1 * rs * g1 + b1;
            y0.x *= sigmoidf_(y0.x); y0.y *= sigmoidf_(y0.y); y0.z *= sigmoidf_(y0.z); y0.w *= sigmoidf_(y0.w);
            y1.x *= sigmoidf_(y1.x); y1.y *= sigmoidf_(y1.y); y1.z *= sigmoidf_(y1.z); y1.w *= sigmoidf_(y1.w);
            v4u o; o.x = pk2(y0.x, y0.y); o.y = pk2(y0.z, y0.w); o.z = pk2(y1.x, y1.y); o.w = pk2(y1.z, y1.w);
            *(v4u*)(cat + ((size_t)b * SEQ + t0 + t) * 1536 + 1024 + 8 * F.lane) = o; }
    }
    __syncthreads();
}

typedef float f32x16 __attribute__((ext_vector_type(16)));
typedef short bf16x8 __attribute__((ext_vector_type(8)));
typedef short v4i16_t __attribute__((ext_vector_type(4)));
constexpr int AT_KROW = 144, AT_VROW = 192, AT_KBUF = 64 * AT_KROW, AT_VBUF = 64 * AT_VROW, AT_BUF = AT_KBUF + AT_VBUF;
constexpr int AT_WSF = 2 * AT_BUF, AT_STG = AT_WSF + 8 * 256, AT_LDS = AT_STG + 8 * 4096;
__device__ __forceinline__ int crow16(int r, int hi) { return (r & 3) + 8 * (r >> 2) + 4 * hi; }
__device__ __forceinline__ void attn_mfma_unit(const Frame& F, LAS unsigned char* L, int b, int h, int qb, const bf16* Q, const bf16* Kb, const bf16* proj, const float* kmean, bf16* cat) {
    int lane_ = F.lane; asm volatile("" : "+v"(lane_));
    const int lane = lane_, r32 = lane & 31, hi = lane >> 5, wid = F.wave;
    const size_t row0 = (size_t)b * SEQ + qb * 256;
    const int qi = wid * 32 + r32;
    bf16x8 qf[4];
    { const bf16* pq = Q + (row0 + qi) * 512 + h * 64 + hi * 8;
#pragma unroll
        for (int d0 = 0; d0 < 4; ++d0) qf[d0] = *(const bf16x8*)(pq + d0 * 16); }
    unsigned selmask;
    if (qb <= 3) selmask = (1u << qb) - 1u;
    else {
        float b0 = -3.0e38f, b1 = -3.0e38f, b2 = -3.0e38f; int i0 = 0, i1 = 0, i2 = 0;
        float qv[32];
#pragma unroll
        for (int d0 = 0; d0 < 4; ++d0)
#pragma unroll
            for (int e = 0; e < 8; ++e) qv[d0 * 8 + e] = bf2f((bf16)qf[d0][e]);
#pragma unroll 1
        for (int j = 0; j < qb; ++j) { const float* km = kmean + (((size_t)b * 8 + h) * 8 + j) * 64 + hi * 8; float sacc = 0.f;
#pragma unroll
            for (int d0 = 0; d0 < 4; ++d0) { const f32x4 k0 = *(const f32x4*)(km + d0 * 16), k1 = *(const f32x4*)(km + d0 * 16 + 4);
                sacc += qv[d0 * 8 + 0] * k0.x + qv[d0 * 8 + 1] * k0.y + qv[d0 * 8 + 2] * k0.z + qv[d0 * 8 + 3] * k0.w + qv[d0 * 8 + 4] * k1.x + qv[d0 * 8 + 5] * k1.y + qv[d0 * 8 + 6] * k1.z + qv[d0 * 8 + 7] * k1.w; }
            sacc += __shfl_xor(sacc, 32);
            if (sacc > b0) { b2 = b1; i2 = i1; b1 = b0; i1 = i0; b0 = sacc; i0 = j; }
            else if (sacc > b1) { b2 = b1; i2 = i1; b1 = sacc; i1 = j; }
            else if (sacc > b2) { b2 = sacc; i2 = j; } }
        selmask = (1u << i0) | (1u << i1) | (1u << i2);
    }
    const int tid_l = wid * 64 + lane, srow = tid_l >> 3, sch = tid_l & 7;
    const bf16* kg = Kb + ((size_t)b * SEQ + srow) * 512 + h * 64 + sch * 8;
    const bf16* vg = proj + ((size_t)b * SEQ + srow) * NCOL + C_AV + h * 64 + sch * 8;
    const int kst = srow * AT_KROW + sch * 16, vst = AT_KBUF + srow * AT_VROW + sch * 16;
    const int kfo = r32 * AT_KROW + hi * 16;
    const int g16 = lane >> 4, idx = lane & 15;
    const int vfo = AT_KBUF + (4 * (g16 >> 1) + (idx >> 2)) * AT_VROW + ((g16 & 1) * 16 + 4 * (idx & 3)) * 2;
    const int NT = 4 * (qb + 1);
    f32x16 o0 = {}, o1 = {};
    float lsum = 0.f;
    v4u kA = {}, vA = {}, kB, vB;
    { const v4u kk = *(const v4u*)kg, vv = *(const v4u*)vg;
        kB = *(const v4u*)(kg + (size_t)64 * 512); vB = *(const v4u*)(vg + (size_t)64 * NCOL);
        *(LAS v4u*)(L + kst) = kk; *(LAS v4u*)(L + vst) = vv; }
    lds_barrier();
#define AT_TILE(OWN, TT, PAR, KL, VL, KW, VW) do { \
        const int t_ = (TT); constexpr int cb = (PAR) * AT_BUF, nb = AT_BUF - cb;        \
        if (t_ + 2 < NT) { KL = *(const v4u*)(kg + (size_t)(t_ + 2) * 64 * 512); VL = *(const v4u*)(vg + (size_t)(t_ + 2) * 64 * NCOL); } \
        const int j = t_ >> 2, kt = t_ & 3; \
        const bool active = !(OWN) || (kt * 64 <= wid * 32 + 31); \
        if (active) { \
            f32x16 s0, s1; \
            { const float bias = ((OWN) || (((selmask >> j) & 1u) != 0u)) ? 0.f : -1.0e30f; \
                _Pragma("unroll") for (int r = 0; r < 16; ++r) { s0[r] = bias; s1[r] = bias; } } \
            bf16x8 kf[8]; \
            _Pragma("unroll") for (int d0 = 0; d0 < 4; ++d0) { kf[d0] = *(const LAS bf16x8*)(L + cb + kfo + d0 * 32); kf[4 + d0] = *(const LAS bf16x8*)(L + cb + kfo + 32 * AT_KROW + d0 * 32); } \
            _Pragma("unroll") for (int d0 = 0; d0 < 4; ++d0) { \
                s0 = __builtin_amdgcn_mfma_f32_32x32x16_bf16(kf[d0], qf[d0], s0, 0, 0, 0); \
                s1 = __builtin_amdgcn_mfma_f32_32x32x16_bf16(kf[4 + d0], qf[d0], s1, 0, 0, 0); } \
            v4i16_t va[16]; \
            _Pragma("unroll") for (int sub = 0; sub < 2; ++sub) \
                _Pragma("unroll") for (int sI = 0; sI < 2; ++sI) { const int vb = cb + vfo + (sub * 32 + 16 * sI) * AT_VROW, q4 = (sub * 2 + sI) * 4; \
                    va[q4 + 0] = __builtin_amdgcn_ds_read_tr16_b64_v4i16((LAS v4i16_t*)(L + vb)); va[q4 + 1] = __builtin_amdgcn_ds_read_tr16_b64_v4i16((LAS v4i16_t*)(L + vb + 8 * AT_VROW)); \
                    va[q4 + 2] = __builtin_amdgcn_ds_read_tr16_b64_v4i16((LAS v4i16_t*)(L + vb + 64)); va[q4 + 3] = __builtin_amdgcn_ds_read_tr16_b64_v4i16((LAS v4i16_t*)(L + vb + 8 * AT_VROW + 64)); } \
            __builtin_amdgcn_sched_barrier(0); \
            float ps = 0.f; \
            if (OWN) { const int lim = qi - kt * 64; \
                _Pragma("unroll") for (int r = 0; r < 16; ++r) { const int kv = crow16(r, hi); \
                    const float p0 = (kv <= lim) ? __builtin_amdgcn_exp2f(s0[r]) : 0.f, p1 = (kv + 32 <= lim) ? __builtin_amdgcn_exp2f(s1[r]) : 0.f; \
                    s0[r] = p0; s1[r] = p1; ps += p0 + p1; } \
            } else { \
                _Pragma("unroll") for (int r = 0; r < 16; ++r) { const float p0 = __builtin_amdgcn_exp2f(s0[r]), p1 = __builtin_amdgcn_exp2f(s1[r]); s0[r] = p0; s1[r] = p1; ps += p0 + p1; } } \
            lsum += ps; \
            bf16x8 pa[4]; \
            _Pragma("unroll") for (int sI = 0; sI < 2; ++sI) { v4u w0, w1; \
                w0.x = pg8::cvt_pk_bf16(s0[8 * sI + 0], s0[8 * sI + 1]); w0.y = pg8::cvt_pk_bf16(s0[8 * sI + 2], s0[8 * sI + 3]); w0.z = pg8::cvt_pk_bf16(s0[8 * sI + 4], s0[8 * sI + 5]); w0.w = pg8::cvt_pk_bf16(s0[8 * sI + 6], s0[8 * sI + 7]); \
                w1.x = pg8::cvt_pk_bf16(s1[8 * sI + 0], s1[8 * sI + 1]); w1.y = pg8::cvt_pk_bf16(s1[8 * sI + 2], s1[8 * sI + 3]); w1.z = pg8::cvt_pk_bf16(s1[8 * sI + 4], s1[8 * sI + 5]); w1.w = pg8::cvt_pk_bf16(s1[8 * sI + 6], s1[8 * sI + 7]); \
                pa[sI] = __builtin_bit_cast(bf16x8, w0); pa[2 + sI] = __builtin_bit_cast(bf16x8, w1); } \
            _Pragma("unroll") for (int q = 0; q < 4; ++q) { \
                const bf16x8 v0 = (bf16x8){va[4 * q][0], va[4 * q][1], va[4 * q][2], va[4 * q][3], va[4 * q + 1][0], va[4 * q + 1][1], va[4 * q + 1][2], va[4 * q + 1][3]}; \
                const bf16x8 v1 = (bf16x8){va[4 * q + 2][0], va[4 * q + 2][1], va[4 * q + 2][2], va[4 * q + 2][3], va[4 * q + 3][0], va[4 * q + 3][1], va[4 * q + 3][2], va[4 * q + 3][3]}; \
                o0 = __builtin_amdgcn_mfma_f32_32x32x16_bf16(pa[q], v0, o0, 0, 0, 0); \
                o1 = __builtin_amdgcn_mfma_f32_32x32x16_bf16(pa[q], v1, o1, 0, 0, 0); } \
        } \
        if (t_ + 1 < NT) { *(LAS v4u*)(L + nb + kst) = KW; *(LAS v4u*)(L + nb + vst) = VW; } \
        lds_barrier(); \
    } while (0)
    int t = 0;
#pragma unroll 1
    for (; t < NT - 4; t += 2) { AT_TILE(false, t, 0, kA, vA, kB, vB); AT_TILE(false, t + 1, 1, kB, vB, kA, vA); }
#pragma unroll 1
    for (; t < NT; t += 2) { AT_TILE(true, t, 0, kA, vA, kB, vB); AT_TILE(true, t + 1, 1, kB, vB, kA, vA); }
#undef AT_TILE
    lsum += __shfl_xor(lsum, 32);
    LAS float* wsf = (LAS float*)(L + AT_WSF + wid * 256);
    if (hi == 0) wsf[r32] = lsum;
    asm volatile("s_waitcnt lgkmcnt(0)" ::: "memory");
    LAS bf16* stg = (LAS bf16*)(L + AT_STG + wid * 4096);
#pragma unroll
    for (int r = 0; r < 16; ++r) { const int orow = crow16(r, hi); const float rl = 1.f / wsf[orow];
        stg[orow * 64 + r32] = (bf16)f2bf(o0[r] * rl); stg[orow * 64 + 32 + r32] = (bf16)f2bf(o1[r] * rl); }
    asm volatile("s_waitcnt lgkmcnt(0)" ::: "memory");
    bf16* po = cat + (row0 + wid * 32) * 1536 + h * 64;
#pragma unroll
    for (int i = 0; i < 4; ++i) { const int row = i * 8 + (lane >> 3), ch = lane & 7; const v4u v = *(const LAS v4u*)(stg + row * 64 + ch * 8); *(v4u*)(po + (size_t)row * 1536 + ch * 8) = v; }
    lds_barrier();
}
__device__ __forceinline__ void phase_attn_mfma(const Frame& F0, const bf16* Q, const bf16* Kb, const bf16* proj, const float* kmean, bf16* cat) {
    const Frame F = fresh(F0);
    LAS unsigned char* L = (LAS unsigned char*)F.lds;
    for (int p = xcd_order(F.bid, F.G); p < 256; p += F.G) {
        const int bh = p >> 2, s = p & 3;
#pragma unroll 1
        for (int i = 0; i < 2; ++i) attn_mfma_unit(F, L, bh >> 3, bh & 7, i ? s : 7 - s, Q, Kb, proj, kmean, cat);
    }
}

template <bool PERM> __device__ __forceinline__ bf16x8 tr_frag(LAS unsigned char* tile, int pitch, int rbase, int cbase, int lane) {
    const int g16 = lane >> 4, idx = lane & 15, h = g16 >> 1;
    LAS unsigned char* p = tile + (rbase + (PERM ? 4 : 8) * h + (idx >> 2)) * pitch + (cbase + (g16 & 1) * 16 + 4 * (idx & 3)) * 2;
    const v4i16_t a0 = __builtin_amdgcn_ds_read_tr16_b64_v4i16((LAS v4i16_t*)p), a1 = __builtin_amdgcn_ds_read_tr16_b64_v4i16((LAS v4i16_t*)(p + (PERM ? 8 : 4) * pitch));
    return (bf16x8){a0[0], a0[1], a0[2], a0[3], a1[0], a1[1], a1[2], a1[3]};
}
constexpr int H1_G = 0, H1_QD = 32768, H1_KD = H1_QD + 64 * 272, H1_KE = H1_KD + 64 * 272, H1_VT = H1_KE + 64 * 320, H1_SP = H1_VT + 64 * 320, H1_TOT = H1_SP + 128 * 320, H1_BO = H1_TOT + 2048, H1_LB = H1_BO + 512, H1_CK = H1_LB + 512, H1_END = H1_CK + 2048;
static_assert(H1_END <= LDS_SCRATCH, "hgrn pass 1 lds");
__device__ __forceinline__ void hgrn_pass1_unit(const Frame& F, LAS unsigned char* L, int u, const bf16* proj, const float* lbl, int layer, float* Lg, float* Dg, float* OL, bf16* Qb) {
    const int b = u >> 5, h = (u >> 3) & 3, blk = u & 7;
    const int lane = F.lane, r32 = lane & 31, hi = lane >> 5, wid = F.wave, tid = F.tid;
    const int tt = tid >> 3, cg = tid & 7, ch = cg * 16;
    LAS float* G = (LAS float*)(L + H1_G); LAS float* TOT = (LAS float*)(L + H1_TOT);
    LAS float* BO = (LAS float*)(L + H1_BO); LAS float* LB = (LAS float*)(L + H1_LB); LAS float* CK = (LAS float*)(L + H1_CK);
    if (tid < 128) { float lb = 0.f;
        if (layer > 0) { const float l0 = lbl[h * 128 + tid], l1 = lbl[512 + h * 128 + tid]; lb = 1.f / (1.f + __expf(l0 - l1)); }
        LB[tid] = lb; BO[tid] = 0.f; }
    lds_barrier();
    f32x16 S[2]; S[0] = (f32x16){}; S[1] = (f32x16){};
    const size_t rowb = (size_t)b * SEQ + blk * 256;
    const int tt2 = wid >> 2, vt = wid & 3;
    v4u nx[6];
    { const bf16* pr = proj + (rowb + tt) * NCOL + h * 128 + ch;
        nx[0] = *(const v4u*)(pr + C_HF); nx[1] = *(const v4u*)(pr + C_HF + 8); nx[2] = *(const v4u*)(pr + C_HQ); nx[3] = *(const v4u*)(pr + C_HQ + 8); nx[4] = *(const v4u*)(pr + C_HI); nx[5] = *(const v4u*)(pr + C_HI + 8); }
    for (int c = 0; c < 4; ++c) {
        const size_t row = rowb + c * 64 + tt;
        float kk[16], qa[16];
        {
            const v4u f0 = nx[0], f1 = nx[1], q0 = nx[2], q1 = nx[3], v0 = nx[4], v1 = nx[5];
            if (c < 3) { const bf16* pr = proj + (row + 64) * NCOL + h * 128 + ch;
                nx[0] = *(const v4u*)(pr + C_HF); nx[1] = *(const v4u*)(pr + C_HF + 8); nx[2] = *(const v4u*)(pr + C_HQ); nx[3] = *(const v4u*)(pr + C_HQ + 8); nx[4] = *(const v4u*)(pr + C_HI); nx[5] = *(const v4u*)(pr + C_HI + 8); }
            const unsigned fw[8] = {f0.x, f0.y, f0.z, f0.w, f1.x, f1.y, f1.z, f1.w}, qw[8] = {q0.x, q0.y, q0.z, q0.w, q1.x, q1.y, q1.z, q1.w};
            float gl[16], lbv[16];
#pragma unroll
            for (int i = 0; i < 4; ++i) { const f32x4 x = *(const LAS f32x4*)(LB + ch + 4 * i); lbv[4 * i] = x.x; lbv[4 * i + 1] = x.y; lbv[4 * i + 2] = x.z; lbv[4 * i + 3] = x.w; }
#pragma unroll
            for (int i = 0; i < 16; ++i) { const float fr = (i & 1) ? bfhi(fw[i >> 1]) : bflo(fw[i >> 1]); const float sig = sigmoidf_(fr);
                gl[i] = __logf(lbv[i] + (1.f - lbv[i]) * sig); kk[i] = (1.f - lbv[i]) * (1.f - sig);
                const float qv = (i & 1) ? bfhi(qw[i >> 1]) : bflo(qw[i >> 1]); qa[i] = qv * sigmoidf_(qv); }
#pragma unroll
            for (int i = 0; i < 4; ++i) *(LAS f32x4*)(G + tt * 128 + ch + 4 * i) = (f32x4){gl[4 * i], gl[4 * i + 1], gl[4 * i + 2], gl[4 * i + 3]};
            *(LAS v4u*)(L + H1_VT + tt * 320 + ch * 2) = v0; *(LAS v4u*)(L + H1_VT + tt * 320 + ch * 2 + 16) = v1;
        }
        lds_barrier();
        {
            const int k = tid & 127, part = tid >> 7; float a[16];
#pragma unroll
            for (int i = 0; i < 16; ++i) a[i] = G[(part * 16 + i) * 128 + k];
#pragma unroll
            for (int i = 1; i < 16; ++i) a[i] += a[i - 1];
            TOT[part * 128 + k] = a[15];
            lds_barrier();
            float pre = 0.f;
#pragma unroll
            for (int p = 0; p < 3; ++p) if (p < part) pre += TOT[p * 128 + k];
#pragma unroll
            for (int i = 0; i < 16; ++i) G[(part * 16 + i) * 128 + k] = a[i] + pre;
            if (part == 3) {
                const float bmk = TOT[k] + TOT[128 + k], bek = pre + a[15];
                CK[k] = __expf(bmk); CK[128 + k] = __expf(bek); CK[256 + k] = __expf(bek - bmk); CK[384 + k] = __expf(BO[k] + bmk); }
        }
        lds_barrier();
        {
#pragma unroll
            for (int hh = 0; hh < 2; ++hh) {
                float bb[8], bm[8], cem[8], com[8];
#pragma unroll
                for (int i = 0; i < 2; ++i) { const f32x4 x = *(const LAS f32x4*)(G + tt * 128 + ch + 8 * hh + 4 * i), y = *(const LAS f32x4*)(G + 31 * 128 + ch + 8 * hh + 4 * i), z = *(const LAS f32x4*)(CK + 256 + ch + 8 * hh + 4 * i), o4 = *(const LAS f32x4*)(CK + 384 + ch + 8 * hh + 4 * i);
                    bb[4 * i] = x.x; bb[4 * i + 1] = x.y; bb[4 * i + 2] = x.z; bb[4 * i + 3] = x.w; bm[4 * i] = y.x; bm[4 * i + 1] = y.y; bm[4 * i + 2] = y.z; bm[4 * i + 3] = y.w;
                    cem[4 * i] = z.x; cem[4 * i + 1] = z.y; cem[4 * i + 2] = z.z; cem[4 * i + 3] = z.w; com[4 * i] = o4.x; com[4 * i + 1] = o4.y; com[4 * i + 2] = o4.z; com[4 * i + 3] = o4.w; }
                float ex[8], rex[8], t8[8]; v4u w;
#pragma unroll
                for (int i = 0; i < 8; ++i) { ex[i] = __expf(bb[i] - bm[i]); rex[i] = __builtin_amdgcn_rcpf(ex[i]); }
#pragma unroll
                for (int i = 0; i < 8; ++i) t8[i] = kk[8 * hh + i] * rex[i] * cem[i];
                w.x = pk2(t8[0], t8[1]); w.y = pk2(t8[2], t8[3]); w.z = pk2(t8[4], t8[5]); w.w = pk2(t8[6], t8[7]); *(LAS v4u*)(L + H1_KE + tt * 320 + ch * 2 + 16 * hh) = w;
#pragma unroll
                for (int i = 0; i < 8; ++i) t8[i] = qa[8 * hh + i] * ex[i];
                w.x = pk2(t8[0], t8[1]); w.y = pk2(t8[2], t8[3]); w.z = pk2(t8[4], t8[5]); w.w = pk2(t8[6], t8[7]); *(LAS v4u*)(L + H1_QD + tt * 272 + ch * 2 + 16 * hh) = w;
#pragma unroll
                for (int i = 0; i < 8; ++i) t8[i] = kk[8 * hh + i] * rex[i];
                w.x = pk2(t8[0], t8[1]); w.y = pk2(t8[2], t8[3]); w.z = pk2(t8[4], t8[5]); w.w = pk2(t8[6], t8[7]); *(LAS v4u*)(L + H1_KD + tt * 272 + ch * 2 + 16 * hh) = w;
#pragma unroll
                for (int i = 0; i < 8; ++i) t8[i] = qa[8 * hh + i] * ex[i] * com[i];
                w.x = pk2(t8[0], t8[1]); w.y = pk2(t8[2], t8[3]); w.z = pk2(t8[4], t8[5]); w.w = pk2(t8[6], t8[7]); *(v4u*)(Qb + row * 512 + h * 128 + ch + 8 * hh) = w;
                __builtin_amdgcn_sched_barrier(0);
            }
#pragma unroll
            for (int i = 0; i < 2; ++i) { const int id = 2 * wid + i, kt = id >> 2, v2 = id & 3;
#pragma unroll
                for (int r = 0; r < 16; ++r) { const int k = kt * 32 + crow16(r, hi); *(LAS bf16*)(L + H1_SP + k * 320 + (v2 * 32 + r32) * 2) = (bf16)(pk2(S[i][r] * CK[k], 0.f) & 0xffffu); } }
        }
        lds_barrier();
        {
            if (tid < 128) BO[tid] += G[63 * 128 + tid];
            f32x16 o = {};
            bf16x8 qf[8];
#pragma unroll
            for (int k0 = 0; k0 < 8; ++k0) qf[k0] = *(const LAS bf16x8*)(L + H1_QD + (tt2 * 32 + r32) * 272 + (k0 * 16 + 8 * hi) * 2);
#pragma unroll
            for (int k0 = 0; k0 < 8; ++k0) o = __builtin_amdgcn_mfma_f32_32x32x16_bf16(qf[k0], tr_frag<false>(L + H1_SP, 320, k0 * 16, vt * 32, lane), o, 0, 0, 0);
#pragma unroll
            for (int sg = 0; sg < 2; ++sg) if (sg <= tt2) {
                f32x16 sc = {};
#pragma unroll
                for (int k0 = 0; k0 < 8; ++k0) { const bf16x8 kf = *(const LAS bf16x8*)(L + H1_KD + (sg * 32 + r32) * 272 + (k0 * 16 + 8 * hi) * 2); sc = __builtin_amdgcn_mfma_f32_32x32x16_bf16(kf, qf[k0], sc, 0, 0, 0); }
                if (sg == tt2) {
#pragma unroll
                    for (int r = 0; r < 16; ++r) sc[r] = (crow16(r, hi) <= r32) ? sc[r] : 0.f; }
#pragma unroll
                for (int sI = 0; sI < 2; ++sI) { v4u w; w.x = pg8::cvt_pk_bf16(sc[8 * sI + 0], sc[8 * sI + 1]); w.y = pg8::cvt_pk_bf16(sc[8 * sI + 2], sc[8 * sI + 3]); w.z = pg8::cvt_pk_bf16(sc[8 * sI + 4], sc[8 * sI + 5]); w.w = pg8::cvt_pk_bf16(sc[8 * sI + 6], sc[8 * sI + 7]);
                    o = __builtin_amdgcn_mfma_f32_32x32x16_bf16(__builtin_bit_cast(bf16x8, w), tr_frag<true>(L + H1_VT, 320, sg * 32 + 16 * sI, vt * 32, lane), o, 0, 0, 0); }
            }
            float* po = OL + (rowb + c * 64 + tt2 * 32) * 512 + h * 128 + vt * 32 + r32;
#pragma unroll
            for (int r = 0; r < 16; ++r) po[(size_t)crow16(r, hi) * 512] = o[r];
#pragma unroll
            for (int i = 0; i < 2; ++i) { const int id = 2 * wid + i, kt = id >> 2, v2 = id & 3;
#pragma unroll
                for (int r = 0; r < 16; ++r) S[i][r] *= CK[128 + kt * 32 + crow16(r, hi)];
#pragma unroll
                for (int s4 = 0; s4 < 4; ++s4) S[i] = __builtin_amdgcn_mfma_f32_32x32x16_bf16(tr_frag<true>(L + H1_KE, 320, 16 * s4, kt * 32, lane), tr_frag<true>(L + H1_VT, 320, 16 * s4, v2 * 32, lane), S[i], 0, 0, 0); }
        }
        lds_barrier();
    }
#pragma unroll
    for (int i = 0; i < 2; ++i) { const int id = 2 * wid + i, kt = id >> 2, v2 = id & 3;
#pragma unroll
        for (int r = 0; r < 16; ++r) Lg[(size_t)u * 16384 + (kt * 32 + crow16(r, hi)) * 128 + v2 * 32 + r32] = S[i][r]; }
    if (tid < 128) Dg[(size_t)u * 128 + tid] = __expf(BO[tid]);
}
constexpr int H2_SL = 0, H2_OB = 128 * 320, H2_END = H2_OB + 128 * 128 * 4;
__device__ __forceinline__ void hgrn_pass2_unit(const Frame& F, LAS unsigned char* L, int u, const bf16* proj, const float* gnorm, const float* Lg, const float* Dg, const float* OL, const bf16* Qb, bf16* cat, int dry) {
    const int b = u >> 5, h = (u >> 3) & 3, blk = u & 7;
    const int lane = F.lane, r32 = lane & 31, hi = lane >> 5, wid = F.wave, tid = F.tid;
    const size_t rowb = (size_t)b * SEQ + blk * 256;
    LAS float* OB = (LAS float*)(L + H2_OB);
    if (blk > 0 && dry != 1) {
#pragma unroll 1
        for (int jh = 0; jh < 4; ++jh) {
            f32x4 l4[7][2]; float dd[7][2];
#pragma unroll
            for (int pb = 0; pb < 7; ++pb)
#pragma unroll
                for (int j = 0; j < 2; ++j) { const int e4 = tid + 512 * (2 * jh + j), k = e4 >> 5;
                    if (pb < blk) { dd[pb][j] = *(const float*)((const char*)(Dg + (size_t)(u - blk + pb) * 128) + (unsigned)k * 4u); l4[pb][j] = *(const f32x4*)((const char*)(Lg + (size_t)(u - blk + pb) * 16384) + (unsigned)e4 * 16u); }
                    else { dd[pb][j] = 0.f; l4[pb][j] = (f32x4){0.f, 0.f, 0.f, 0.f}; } }
#pragma unroll
            for (int j = 0; j < 2; ++j) { const int e4 = tid + 512 * (2 * jh + j), k = e4 >> 5, v4 = (e4 & 31) * 4; f32x4 S = {0.f, 0.f, 0.f, 0.f};
#pragma unroll
                for (int pb = 0; pb < 7; ++pb) if (pb < blk) S = S * dd[pb][j] + l4[pb][j];
                v2u w; w.x = pk2(S.x, S.y); w.y = pk2(S.z, S.w); *(LAS v2u*)(L + H2_SL + k * 320 + v4 * 2) = w; } } }
    lds_barrier();
    const int ttp = tid >> 2, cq = tid & 3, vt = wid & 3;
    float gn[32];
#pragma unroll
    for (int i = 0; i < 8; ++i) { const f32x4 g = *(const f32x4*)(gnorm + cq * 32 + 4 * i); gn[4 * i] = g.x; gn[4 * i + 1] = g.y; gn[4 * i + 2] = g.z; gn[4 * i + 3] = g.w; }
    for (int hf = 0; hf < 2; ++hf) {
        const size_t rowp = rowb + hf * 128 + ttp;
        v4u hg[4];
#pragma unroll
        for (int i = 0; i < 4; ++i) hg[i] = *(const v4u*)(proj + rowp * NCOL + C_HG + h * 128 + cq * 32 + 8 * i);
#pragma unroll
        for (int j = 0; j < 2; ++j) { const int tl = (wid >> 2) + 2 * j;
            const size_t trow = rowb + hf * 128 + tl * 32;
            f32x16 o = {};
            bf16x8 af[8]; float olv[16];
            const float* pl = OL + trow * 512 + h * 128 + vt * 32 + r32;
            if (blk > 0) {
#pragma unroll
                for (int k0 = 0; k0 < 8; ++k0) af[k0] = *(const bf16x8*)(Qb + (trow + r32) * 512 + h * 128 + k0 * 16 + 8 * hi); }
#pragma unroll
            for (int r = 0; r < 16; ++r) olv[r] = pl[(size_t)crow16(r, hi) * 512];
            __builtin_amdgcn_sched_barrier(0);
            if (blk > 0 && dry != 2) {
#pragma unroll
                for (int k0 = 0; k0 < 8; ++k0) o = __builtin_amdgcn_mfma_f32_32x32x16_bf16(af[k0], tr_frag<false>(L + H2_SL, 320, k0 * 16, vt * 32, lane), o, 0, 0, 0); }
#pragma unroll
            for (int r = 0; r < 16; ++r) { const int t = crow16(r, hi); OB[(tl * 32 + t) * 128 + vt * 32 + r32] = o[r] + olv[r]; } }
        lds_barrier();
        {
            float ov[32]; float ss = 0.f;
#pragma unroll
            for (int i = 0; i < 8; ++i) { const f32x4 x = *(const LAS f32x4*)(OB + ttp * 128 + cq * 32 + 4 * i); ov[4 * i] = x.x; ov[4 * i + 1] = x.y; ov[4 * i + 2] = x.z; ov[4 * i + 3] = x.w; ss += (x.x * x.x + x.y * x.y) + (x.z * x.z + x.w * x.w); }
            ss += __shfl_xor(ss, 1); ss += __shfl_xor(ss, 2);
            const float rn = rsqrtf(ss * (1.f / 128.f) + RMS_EPS);
#pragma unroll
            for (int i = 0; i < 4; ++i) { const unsigned gw[4] = {hg[i].x, hg[i].y, hg[i].z, hg[i].w}; float y[8];
#pragma unroll
                for (int e = 0; e < 8; ++e) { const float gv = (e & 1) ? bfhi(gw[e >> 1]) : bflo(gw[e >> 1]); y[e] = ov[8 * i + e] * rn * gn[8 * i + e] * (gv * sigmoidf_(gv)); }
                v4u w; w.x = pk2(y[0], y[1]); w.y = pk2(y[2], y[3]); w.z = pk2(y[4], y[5]); w.w = pk2(y[6], y[7]);
                *(v4u*)(cat + rowp * 1536 + 512 + h * 128 + cq * 32 + 8 * i) = w; }
        }
        lds_barrier();
    }
}
__device__ __forceinline__ void phase_hgrn1(const Frame& F0, const bf16* proj, const float* lbl, int layer, float* Lg, float* Dg, float* OL, bf16* Qb) {
    const Frame F = fresh(F0);
    LAS unsigned char* L = (LAS unsigned char*)F.lds;
    for (int u = xcd_order(F.bid, F.G); u < 256; u += F.G) { hgrn_pass1_unit(F, L, u, proj, lbl, layer, Lg, Dg, OL, Qb); __syncthreads(); }
}
__device__ __forceinline__ void phase_hgrn2(const Frame& F0, const bf16* proj, const float* gnorm, const float* Lg, const float* Dg, const float* OL, const bf16* Qb, bf16* cat, int dry) {
    const Frame F = fresh(F0);
    LAS unsigned char* L = (LAS unsigned char*)F.lds;
    for (int u = xcd_order(F.bid, F.G); u < 256; u += F.G) { hgrn_pass2_unit(F, L, u, proj, gnorm, Lg, Dg, OL, Qb, cat, dry); __syncthreads(); }
}

struct SchedDense {
    const char* A; const char* B; int nM, nN, G, c; size_t ta, tb;
    __device__ __forceinline__ bool next(int i, pg8::Unit& u) const {
        int pm, pn; if (!pg8::static_tile(nM, nN, (long)i * G + c, pm, pn)) return false;
        u.pm = pm; u.pn = pn; u.aux = 0; u.pad = 0; u.a = A + (size_t)pm * ta; u.b = B + (size_t)pn * tb; u.gidx = nullptr; return true; }
};
struct SchedBranch {
    const char* A; const char* B; int G, c;
    __device__ __forceinline__ bool next(int i, pg8::Unit& u) const {
        int pm, pn; if (!pg8::static_tile(T / 256, DM / 256, (long)(i / 3) * G + c, pm, pn)) return false;
        const int seg = i % 3;
        u.pm = pm; u.pn = pn; u.aux = seg; u.pad = 0; u.a = A + ((size_t)pm * 256 * 1536 + seg * 512) * 2; u.b = B + ((size_t)seg * DM * 512 + (size_t)pn * 256 * 512) * 2; u.gidx = nullptr; return true; }
};
struct SchedMoe {
    const char* A; const char* B; const unsigned* ntp; const unsigned* tile_e; int G, c; size_t ta, tb_e, tb_n; const unsigned* tok;
    __device__ __forceinline__ bool next(int i, pg8::Unit& u) const {
        const int nt = (int)__builtin_amdgcn_readfirstlane(*ntp);
        const int cx = (G % 8 == 0) ? (c % 8) * (G / 8) + c / 8 : c;
        const long L = (long)i * G + cx; if (L >= (long)nt * 4) return false;
        const int tile = (int)(L >> 2), pn = (int)(L & 3); const int e = (int)__builtin_amdgcn_readfirstlane(tile_e[tile]);
        u.pm = tile; u.pn = pn; u.aux = e; u.pad = 0; u.a = tok ? A : A + (size_t)tile * ta; u.b = B + (size_t)e * tb_e + (size_t)pn * tb_n; u.gidx = tok ? tok + (size_t)tile * 256 : nullptr; return true; }
};

typedef pg8::f32x4 af4;
struct EpiStoreBf16 {
    static constexpr bool PERM = true;
    bf16* O; int ldc; int gate_col0; const float* bgate; v2u* GT;
    __device__ __forceinline__ bool operator()(af4 (&acc)[2][2][4][2], const pg8::Unit& u, int wr, int wc, int fr, int fq) const {
        const int row0 = u.pm * 256 + wr * 64 + fr, col0 = u.pn * 256 + wc * 32 + 8 * fq;
        const bool gate = (u.pn * 256 >= gate_col0);
#pragma unroll
        for (int bj = 0; bj < 2; ++bj) {
            af4 b0 = {0.f, 0.f, 0.f, 0.f}, b1 = {0.f, 0.f, 0.f, 0.f};
            if (gate) { b0 = *(const af4*)(bgate + col0 + bj * 128 - gate_col0); b1 = *(const af4*)(bgate + col0 + bj * 128 - gate_col0 + 4); }
#pragma unroll
            for (int ai = 0; ai < 2; ++ai)
#pragma unroll
                for (int m = 0; m < 4; ++m) { af4 v0 = acc[ai][bj][m][0], v1 = acc[ai][bj][m][1];
                    if (gate) {
                        unsigned qlo = 0u, qhi = 0u;
#pragma unroll
                        for (int i = 0; i < 4; ++i) { const float a0 = fmaxf(255.f * __builtin_amdgcn_rcpf(1.f + __expf(-fmaxf(v0[i] + b0[i], -30.f))), 1.f), a1 = fmaxf(255.f * __builtin_amdgcn_rcpf(1.f + __expf(-fmaxf(v1[i] + b1[i], -30.f))), 1.f);
                            qlo = __builtin_amdgcn_cvt_pk_u8_f32(a0, i, qlo); qhi = __builtin_amdgcn_cvt_pk_u8_f32(a1, i, qhi); }
                        const int gt = u.pn - gate_col0 / 256;
                        GT[((((size_t)((gt >> 2) * 64 + u.pm) * 4 + (gt & 3)) * 8 + (wr * 4 + wc)) * 16 + (ai * 4 + m) * 2 + bj) * 64 + (fq * 16 + fr)] = (v2u){qlo, qhi}; }
                    else { v4u w; w.x = pg8::cvt_pk_bf16(v0[0], v0[1]); w.y = pg8::cvt_pk_bf16(v0[2], v0[3]); w.z = pg8::cvt_pk_bf16(v1[0], v1[1]); w.w = pg8::cvt_pk_bf16(v1[2], v1[3]);
                        *(v4u*)(O + (size_t)(row0 + ai * 128 + m * 16) * ldc + col0 + bj * 128) = w; } } }
        return true;
    }
};
struct EpiBranch {
    static constexpr bool PERM = true;
    const v2u* GT; bf16* merged;
    __device__ __forceinline__ bool operator()(af4 (&acc)[2][2][4][2], const pg8::Unit& u, int wr, int wc, int fr, int fq) const {
        const int seg = u.aux, row0 = u.pm * 256 + wr * 64 + fr, col0 = u.pn * 256 + wc * 32 + 8 * fq;
        const bool last = (seg == 2); const int sn = last ? seg : seg + 1;
#pragma unroll
        for (int bj = 0; bj < 2; ++bj) { const int col = col0 + bj * 128;
#pragma unroll
            for (int ai = 0; ai < 2; ++ai) { v2u gcv[4], gnv[4];
#pragma unroll
                for (int m = 0; m < 4; ++m) {
                    gcv[m] = GT[((((size_t)(seg * 64 + u.pm) * 4 + u.pn) * 8 + (wr * 4 + wc)) * 16 + (ai * 4 + m) * 2 + bj) * 64 + (fq * 16 + fr)];
                    gnv[m] = GT[((((size_t)(sn * 64 + u.pm) * 4 + u.pn) * 8 + (wr * 4 + wc)) * 16 + (ai * 4 + m) * 2 + bj) * 64 + (fq * 16 + fr)]; }
#pragma unroll
                for (int m = 0; m < 4; ++m) { const size_t row = (size_t)(row0 + ai * 128 + m * 16);
                    const unsigned gcw[2] = {gcv[m].x, gcv[m].y}, gnw[2] = {gnv[m].x, gnv[m].y};
                    float f[8];
#pragma unroll
                    for (int i = 0; i < 8; ++i) { const float gc = (float)((gcw[i >> 2] >> (8 * (i & 3))) & 0xffu), gn = (float)((gnw[i >> 2] >> (8 * (i & 3))) & 0xffu);
                        f[i] = last ? gc * (1.f / 255.f) : gc * __builtin_amdgcn_rcpf(gn); }
                    af4& v0 = acc[ai][bj][m][0]; af4& v1 = acc[ai][bj][m][1];
                    v0[0] *= f[0]; v0[1] *= f[1]; v0[2] *= f[2]; v0[3] *= f[3]; v1[0] *= f[4]; v1[1] *= f[5]; v1[2] *= f[6]; v1[3] *= f[7];
                    if (last) { v4u w; w.x = pg8::cvt_pk_bf16(v0[0], v0[1]); w.y = pg8::cvt_pk_bf16(v0[2], v0[3]); w.z = pg8::cvt_pk_bf16(v1[0], v1[1]); w.w = pg8::cvt_pk_bf16(v1[2], v1[3]);
                        *(v4u*)(merged + row * DM + col) = w; } } } }
        return last;
    }
};
struct EpiResidual {
    static constexpr bool PERM = true;
    const float* xin32; const bf16* xin16; bf16* xout;
    __device__ __forceinline__ bool operator()(af4 (&acc)[2][2][4][2], const pg8::Unit& u, int wr, int wc, int fr, int fq) const {
        const int row0 = u.pm * 256 + wr * 64 + fr, col0 = u.pn * 256 + wc * 32 + 8 * fq;
#pragma unroll
        for (int ai = 0; ai < 2; ++ai)
#pragma unroll
            for (int mh = 0; mh < 2; ++mh) { af4 r[2][2][2];
#pragma unroll
                for (int mm = 0; mm < 2; ++mm) { const size_t off = (size_t)(row0 + ai * 128 + (mh * 2 + mm) * 16) * DM + col0;
#pragma unroll
                    for (int bj = 0; bj < 2; ++bj) {
                        if (xin32) { r[mm][bj][0] = *(const af4*)(xin32 + off + bj * 128); r[mm][bj][1] = *(const af4*)(xin32 + off + bj * 128 + 4); }
                        else { const v4u w = *(const v4u*)(xin16 + off + bj * 128); r[mm][bj][0] = (af4){bflo(w.x), bfhi(w.x), bflo(w.y), bfhi(w.y)}; r[mm][bj][1] = (af4){bflo(w.z), bfhi(w.z), bflo(w.w), bfhi(w.w)}; } } }
#pragma unroll
                for (int mm = 0; mm < 2; ++mm) { const size_t off = (size_t)(row0 + ai * 128 + (mh * 2 + mm) * 16) * DM + col0;
#pragma unroll
                    for (int bj = 0; bj < 2; ++bj) { const af4 v0 = r[mm][bj][0] + acc[ai][bj][mh * 2 + mm][0], v1 = r[mm][bj][1] + acc[ai][bj][mh * 2 + mm][1]; v4u w;
                        w.x = pg8::cvt_pk_bf16(v0[0], v0[1]); w.y = pg8::cvt_pk_bf16(v0[2], v0[3]); w.z = pg8::cvt_pk_bf16(v1[0], v1[1]); w.w = pg8::cvt_pk_bf16(v1[2], v1[3]);
                        *(v4u*)(xout + off + bj * 128) = w; } } }
        return true;
    }
};
struct EpiSwiglu {
    static constexpr bool PERM = true;
    bf16* act; const float* rrow;
    __device__ __forceinline__ bool operator()(af4 (&acc)[2][2][4][2], const pg8::Unit& u, int wr, int wc, int fr, int fq) const {
        const int row0 = u.pm * 256 + wr * 64 + fr, col0 = u.pn * 128 + wc * 32 + 8 * fq;
        float rs[2][4];
#pragma unroll
        for (int ai = 0; ai < 2; ++ai)
#pragma unroll
            for (int m = 0; m < 4; ++m) rs[ai][m] = rrow[row0 + ai * 128 + m * 16];
#pragma unroll
        for (int ai = 0; ai < 2; ++ai)
#pragma unroll
            for (int m = 0; m < 4; ++m) { const float rr = rs[ai][m]; const af4 g0 = acc[ai][0][m][0] * rr, g1 = acc[ai][0][m][1] * rr, u0 = acc[ai][1][m][0] * rr, u1 = acc[ai][1][m][1] * rr;
                float o[8];
#pragma unroll
                for (int i = 0; i < 4; ++i) { o[i] = g0[i] * sigmoidf_(g0[i]) * u0[i]; o[4 + i] = g1[i] * sigmoidf_(g1[i]) * u1[i]; }
                v4u w; w.x = pg8::cvt_pk_bf16(o[0], o[1]); w.y = pg8::cvt_pk_bf16(o[2], o[3]); w.z = pg8::cvt_pk_bf16(o[4], o[5]); w.w = pg8::cvt_pk_bf16(o[6], o[7]);
                *(v4u*)(act + (size_t)(row0 + ai * 128 + m * 16) * FF + col0) = w; }
        return true;
    }
};
struct EpiScaleRows {
    static constexpr bool PERM = true;
    bf16* ys; const float* wrow;
    __device__ __forceinline__ bool operator()(af4 (&acc)[2][2][4][2], const pg8::Unit& u, int wr, int wc, int fr, int fq) const {
        const int row0 = u.pm * 256 + wr * 64 + fr, col0 = u.pn * 256 + wc * 32 + 8 * fq;
        float sc[2][4];
#pragma unroll
        for (int ai = 0; ai < 2; ++ai)
#pragma unroll
            for (int m = 0; m < 4; ++m) sc[ai][m] = wrow[row0 + ai * 128 + m * 16];
#pragma unroll
        for (int ai = 0; ai < 2; ++ai)
#pragma unroll
            for (int m = 0; m < 4; ++m) { const int row = row0 + ai * 128 + m * 16; const float s = sc[ai][m]; bf16* rowp = ys + (size_t)row * DM + col0;
#pragma unroll
                for (int bj = 0; bj < 2; ++bj) { const af4 v0 = acc[ai][bj][m][0] * s, v1 = acc[ai][bj][m][1] * s; v4u w;
                    w.x = pg8::cvt_pk_bf16(v0[0], v0[1]); w.y = pg8::cvt_pk_bf16(v0[2], v0[3]); w.z = pg8::cvt_pk_bf16(v1[0], v1[1]); w.w = pg8::cvt_pk_bf16(v1[2], v1[3]);
                    *(v4u*)(rowp + bj * 128) = w; } }
        return true;
    }
};

constexpr int RT_PITCH = 2064, RT_HI = 0, RT_LO = 36 * RT_PITCH, RT_END = 72 * RT_PITCH;
static_assert(RT_END + 4096 <= LDS_SCRATCH, "router lds");
__device__ __forceinline__ void phase_router2(const Frame& F0, const bf16* x, const float* gain, const float* wco, const float* bco, const float* wfi, const float* bfi,
                                              bf16* hout, unsigned* route, unsigned* cnt, float* LG, bool commit) {
    const Frame F = fresh(F0);
    LAS unsigned char* L = (LAS unsigned char*)F.lds;
    {
        f32x4 wv[18];
#pragma unroll
        for (int i = 0; i < 2; ++i) wv[i] = *(const f32x4*)(wco + 4 * (F.tid + 512 * i));
#pragma unroll
        for (int i = 0; i < 16; ++i) wv[2 + i] = *(const f32x4*)(wfi + 4 * (F.tid + 512 * i));
#pragma unroll
        for (int i = 0; i < 18; ++i) { int k, c0; if (i < 2) { k = F.tid + 512 * i; c0 = 32; } else { const int f = F.tid + 512 * (i - 2); k = f >> 3; c0 = (f & 7) * 4; }
            const float w4[4] = {wv[i].x, wv[i].y, wv[i].z, wv[i].w};
#pragma unroll
            for (int e = 0; e < 4; ++e) { const unsigned hi = f2bf(w4[e]); const unsigned lo = f2bf(w4[e] - __uint_as_float(hi << 16));
                *(LAS bf16*)(L + RT_HI + (c0 + e) * RT_PITCH + k * 2) = (bf16)hi; *(LAS bf16*)(L + RT_LO + (c0 + e) * RT_PITCH + k * 2) = (bf16)lo; } }
    }
    LAS float* GL = (LAS float*)(L + RT_END);
    GL[F.tid] = gain[F.tid]; GL[F.tid + 512] = gain[F.tid + 512];
    __syncthreads();
    {
        const int lane = F.lane, rl = lane & 15, kg = lane >> 4, kh = F.wave >> 2;
        const int NITER = (T / 16 + 4 * F.G - 1) / (4 * F.G);
        for (int it = 0; it < NITER; ++it) {
            const int tile = (it * F.G + xcd_order(F.bid, F.G)) * 4 + (F.wave & 3); const bool tvalid = tile < T / 16;
            const size_t row = (size_t)(tvalid ? tile : 0) * 16 + rl;
            const bf16* xr = x + row * DM + 8 * kg + 512 * kh;
            pg8::f32x4 acc[3]; acc[0] = (pg8::f32x4){0.f, 0.f, 0.f, 0.f}; acc[1] = acc[0]; acc[2] = acc[0];
            float ss = 0.f;
            const int bro[3] = {rl * RT_PITCH + 16 * kg + 1024 * kh, (16 + rl) * RT_PITCH + 16 * kg + 1024 * kh, (32 + (rl & 3)) * RT_PITCH + 16 * kg + 1024 * kh};
            v4u xa[8];
#pragma unroll
            for (int q = 0; q < 8; ++q) xa[q] = *(const v4u*)(xr + 32 * q);
            for (int s0 = 0; s0 < 16; s0 += 8) {
                v4u xn[8];
                if (s0 + 8 < 16) {
#pragma unroll
                    for (int q = 0; q < 8; ++q) xn[q] = *(const v4u*)(xr + 32 * (s0 + 8 + q)); }
#pragma unroll
                for (int q = 0; q < 8; ++q) { const int s = s0 + q;
                    const f32x4 g0 = *(const LAS f32x4*)(GL + 512 * kh + 32 * s + 8 * kg), g1 = *(const LAS f32x4*)(GL + 512 * kh + 32 * s + 8 * kg + 4);
                    const float xv[8] = {bflo(xa[q].x), bfhi(xa[q].x), bflo(xa[q].y), bfhi(xa[q].y), bflo(xa[q].z), bfhi(xa[q].z), bflo(xa[q].w), bfhi(xa[q].w)};
                    ss += (xv[0] * xv[0] + xv[1] * xv[1]) + (xv[2] * xv[2] + xv[3] * xv[3]) + (xv[4] * xv[4] + xv[5] * xv[5]) + (xv[6] * xv[6] + xv[7] * xv[7]);
                    const float y[8] = {xv[0] * g0.x, xv[1] * g0.y, xv[2] * g0.z, xv[3] * g0.w, xv[4] * g1.x, xv[5] * g1.y, xv[6] * g1.z, xv[7] * g1.w};
                    v4u ah, al; ah.x = pk2(y[0], y[1]); ah.y = pk2(y[2], y[3]); ah.z = pk2(y[4], y[5]); ah.w = pk2(y[6], y[7]);
                    al.x = pk2(y[0] - bflo(ah.x), y[1] - bfhi(ah.x)); al.y = pk2(y[2] - bflo(ah.y), y[3] - bfhi(ah.y)); al.z = pk2(y[4] - bflo(ah.z), y[5] - bfhi(ah.z)); al.w = pk2(y[6] - bflo(ah.w), y[7] - bfhi(ah.w));
                    if (tvalid) *(v4u*)(hout + row * DM + 512 * kh + 32 * s + 8 * kg) = ah;
                    const bf16x8 Ah = __builtin_bit_cast(bf16x8, ah), Al = __builtin_bit_cast(bf16x8, al);
#pragma unroll
                    for (int ct = 0; ct < 3; ++ct) { const bf16x8 Bh = *(const LAS bf16x8*)(L + RT_HI + bro[ct] + 64 * s), Bl = *(const LAS bf16x8*)(L + RT_LO + bro[ct] + 64 * s);
                        acc[ct] = __builtin_amdgcn_mfma_f32_16x16x32_bf16(Ah, Bh, acc[ct], 0, 0, 0);
                        acc[ct] = __builtin_amdgcn_mfma_f32_16x16x32_bf16(Ah, Bl, acc[ct], 0, 0, 0);
                        acc[ct] = __builtin_amdgcn_mfma_f32_16x16x32_bf16(Al, Bh, acc[ct], 0, 0, 0); } }
#pragma unroll
                for (int q = 0; q < 8; ++q) xa[q] = xn[q];
            }
            ss += __shfl_xor(ss, 16); ss += __shfl_xor(ss, 32);
            float* LGh = LG + (size_t)kh * T * 48;
            if (tvalid) {
#pragma unroll
                for (int ct = 0; ct < 3; ++ct)
#pragma unroll
                    for (int rg = 0; rg < 4; ++rg) if (ct < 2 || rl < 4) LGh[((size_t)tile * 16 + 4 * kg + rg) * 48 + ct * 16 + rl] = acc[ct][rg];
                if (lane < 16) LGh[((size_t)tile * 16 + lane) * 48 + 47] = ss; }
            asm volatile("s_waitcnt vmcnt(0)" ::: "memory");
            __syncthreads();
            if (kh == 0 && lane < 16 && tvalid) {
                const size_t m = (size_t)tile * 16 + lane;
                const float* l0 = LG + m * 48; const float* l1 = LG + (size_t)T * 48 + m * 48;
                const float sst = __uint_as_float(__hip_atomic_load((const unsigned*)(l0 + 47), RLX_AGENT)) + __uint_as_float(__hip_atomic_load((const unsigned*)(l1 + 47), RLX_AGENT));
                const float r = rsqrtf(sst * (1.f / DM) + RMS_EPS);
                float lg[36];
#pragma unroll
                for (int c = 0; c < 36; ++c) lg[c] = r * (__uint_as_float(__hip_atomic_load((const unsigned*)(l0 + c), RLX_AGENT)) + __uint_as_float(__hip_atomic_load((const unsigned*)(l1 + c), RLX_AGENT)));
                float c0 = lg[32] + bco[0], c1 = lg[33] + bco[1], c2 = lg[34] + bco[2], c3 = lg[35] + bco[3];
                int grp = 0; float cm = c0;
                if (c1 > cm) { cm = c1; grp = 1; } if (c2 > cm) { cm = c2; grp = 2; } if (c3 > cm) { cm = c3; grp = 3; }
                const float ptop = 1.f / (__expf(c0 - cm) + __expf(c1 - cm) + __expf(c2 - cm) + __expf(c3 - cm));
                float fs[8];
#pragma unroll
                for (int i = 0; i < 8; ++i) { float a = lg[i] + bfi[i], b = lg[8 + i] + bfi[8 + i], c = lg[16 + i] + bfi[16 + i], d = lg[24 + i] + bfi[24 + i]; fs[i] = grp == 0 ? a : (grp == 1 ? b : (grp == 2 ? c : d)); }
                int i1 = 0; float v1 = fs[0];
#pragma unroll
                for (int i = 1; i < 8; ++i) if (fs[i] > v1) { v1 = fs[i]; i1 = i; }
                int i2 = -1; float v2 = -3.0e38f;
#pragma unroll
                for (int i = 0; i < 8; ++i) if (i != i1 && fs[i] > v2) { v2 = fs[i]; i2 = i; }
                const float e2 = __expf(v2 - v1), w1 = ptop / (1.f + e2), w2 = ptop * e2 / (1.f + e2);
                if (commit) {
                    const int ea = grp * 8 + i1, eb = grp * 8 + i2;
                    const unsigned ra = __hip_atomic_fetch_add(cnt + 64 * ea, 1u, RLX_AGENT), rb = __hip_atomic_fetch_add(cnt + 64 * eb, 1u, RLX_AGENT);
                    v4u o; o.x = (unsigned)ea; o.y = (unsigned)eb; o.z = ra; o.w = rb; *(v4u*)(route + m * 8) = o;
                    *(f32x4*)(route + m * 8 + 4) = (f32x4){w1, w2, r, 0.f};
                }
            }
        }
    }
    __syncthreads();
}

__device__ __forceinline__ void phase_index(const Frame& F0, const unsigned* route, const unsigned* cnt, unsigned* ntp, unsigned* tile_e, unsigned* tok, float* wrow, float* rrow, unsigned* pos) {
    const Frame F = fresh(F0);
    unsigned* off = (unsigned*)F.lds;
    if (F.tid == 0) { unsigned o = 0;
        for (int e = 0; e < NEXP; ++e) { off[e] = o; const unsigned c = __hip_atomic_load(cnt + 64 * e, RLX_AGENT); off[64 + e] = c; const unsigned p = (c + 255u) & ~255u;
            if (F.bid == 0) for (unsigned tI = o >> 8; tI < ((o + p) >> 8); ++tI) tile_e[tI] = (unsigned)e;
            o += p; }
        off[NEXP] = o; if (F.bid == 0) *ntp = o >> 8; }
    __syncthreads();
    for (int m = F.bid * 512 + F.tid; m < T; m += F.G * 512) {
        const v4u ri = *(const v4u*)(route + (size_t)m * 8); const f32x4 ww = *(const f32x4*)(route + (size_t)m * 8 + 4);
        const unsigned d0 = off[ri.x] + ri.z, d1 = off[ri.y] + ri.w;
        tok[d0] = (unsigned)m; tok[d1] = (unsigned)m; wrow[d0] = ww.x; wrow[d1] = ww.y; rrow[d0] = ww.z; rrow[d1] = ww.z; *(v2u*)(pos + (size_t)m * 2) = (v2u){d0, d1}; }
    for (int e = F.bid; e < NEXP; e += F.G) {
        const unsigned c = off[64 + e], b0 = off[e] + c, b1 = off[e + 1];
        for (unsigned i = b0 + F.tid; i < b1; i += 512) { tok[i] = 0u; wrow[i] = 0.f; rrow[i] = 0.f; } }
    __syncthreads();
}

__device__ __forceinline__ void phase_combine(const Frame& F0, const bf16* x, bf16* xdst16, float* xdst32, const bf16* ys, const unsigned* pos, const float* ngain, bf16* hout) {
    const Frame F = fresh(F0);
    const int gw = F.bid * 8 + F.wave, NGW = F.G * 8;
    f32x4 g[4];
#pragma unroll
    for (int j = 0; j < 4; ++j) g[j] = ngain ? *(const f32x4*)(ngain + 4 * F.lane + 256 * j) : (f32x4){0.f, 0.f, 0.f, 0.f};
    const int RPW = (T + NGW - 1) / NGW, mbase = (xcd_order(F.bid, F.G) * 8 + F.wave) * RPW;
    for (int r0 = 0; r0 < RPW; r0 += 2) {
        v2u pp[2];
#pragma unroll
        for (int q = 0; q < 2; ++q) { const int m = (r0 + q < RPW) ? mbase + r0 + q : T; pp[q] = (m < T) ? *(const v2u*)(pos + (size_t)m * 2) : (v2u){0u, 0u}; }
        v2u xv[2][4], ya[2][4], yb[2][4];
#pragma unroll
        for (int q = 0; q < 2; ++q) { const int m = (r0 + q < RPW) ? mbase + r0 + q : T; if (m < T) {
                const v2u* xr = (const v2u*)(x + (size_t)m * DM) + F.lane; const v2u* y0 = (const v2u*)(ys + (size_t)pp[q].x * DM) + F.lane; const v2u* y1 = (const v2u*)(ys + (size_t)pp[q].y * DM) + F.lane;
#pragma unroll
                for (int j = 0; j < 4; ++j) { xv[q][j] = xr[64 * j]; ya[q][j] = y0[64 * j]; yb[q][j] = y1[64 * j]; } } }
#pragma unroll
        for (int q = 0; q < 2; ++q) { const int m = (r0 + q < RPW) ? mbase + r0 + q : T; if (m < T) {
                float s = 0.f; f32x4 v[4];
#pragma unroll
                for (int j = 0; j < 4; ++j) { const v2u c = xv[q][j], a = ya[q][j], b = yb[q][j]; f32x4 t;
                    t.x = bflo(c.x) + bflo(a.x) + bflo(b.x); t.y = bfhi(c.x) + bfhi(a.x) + bfhi(b.x); t.z = bflo(c.y) + bflo(a.y) + bflo(b.y); t.w = bfhi(c.y) + bfhi(a.y) + bfhi(b.y);
                    v[j] = t; s += (t.x * t.x + t.y * t.y) + (t.z * t.z + t.w * t.w); }
                if (xdst32) { f32x4* xw = (f32x4*)(xdst32 + (size_t)m * DM) + F.lane;
#pragma unroll
                    for (int j = 0; j < 4; ++j) xw[64 * j] = v[j]; }
                else { v2u* xw = (v2u*)(xdst16 + (size_t)m * DM) + F.lane;
#pragma unroll
                    for (int j = 0; j < 4; ++j) { v2u w; w.x = pk2(v[j].x, v[j].y); w.y = pk2(v[j].z, v[j].w); xw[64 * j] = w; } }
                if (ngain) {
                    const float r = rsqrtf(wave_sum(s) * (1.f / DM) + RMS_EPS);
                    v2u* o8 = (v2u*)(hout + (size_t)m * DM) + F.lane;
#pragma unroll
                    for (int j = 0; j < 4; ++j) { v2u w; w.x = pk2(v[j].x * r * g[j].x, v[j].y * r * g[j].y); w.y = pk2(v[j].z * r * g[j].z, v[j].w * r * g[j].w); o8[64 * j] = w; }
                } } }
    }
}

constexpr int PH_PER_LAYER = 11, N_PHASES = 1 + DEPTH * PH_PER_LAYER;
__device__ __forceinline__ CArgs& kargs() { CArgs* p = (CArgs*)__builtin_amdgcn_kernarg_segment_ptr(); asm volatile("" : "+s"(p)); return *p; }
__global__ void __launch_bounds__(512, 2) mk_fwd(Args args_unused) {
    extern __shared__ __attribute__((aligned(16))) unsigned char lds[];
    LAS unsigned char* lds3 = (LAS unsigned char*)lds;
    const int wave_s = __builtin_amdgcn_readfirstlane(threadIdx.x >> 6);
    for (int u = threadIdx.x; u < (LDS_BYTES - LDSCTL_OFF) / 4; u += 512) ((LAS unsigned*)(lds3 + LDSCTL_OFF))[u] = 0u;
    __syncthreads();
#if MK_SPLIT
#define GRID_BAR() do { } while (0)
#else
    (void)xcd_barrier_post((unsigned*)(kargs().ws + WS_CTL) + CW_BAR, (volatile LAS unsigned*)(lds3 + LDSCTL_OFF));
#define GRID_BAR() do { XcdBarrier b_; b_.bar = (unsigned*)(kargs().ws + WS_CTL) + CW_BAR; b_.x = xb_xcc_id(); b_.st = (volatile LAS unsigned*)(lds3 + LDSCTL_OFF); xcd_barrier(b_); } while (0)
#endif
#define IN(k) (kargs().ph_lo <= (k) && (k) < kargs().ph_hi)
#define SEAM(k) do { if (IN(k) && IN((k) + 1)) GRID_BAR(); } while (0)
#define FRAME() CArgs& A = kargs(); Frame F; F.lds = lds; F.lane = lane_id_asm(); { int w_ = wave_s; asm volatile("" : "+s"(w_)); F.wave = w_; } F.tid = F.wave * 64 + F.lane; { int g_ = gridDim.x, b_ = blockIdx.x; asm volatile("" : "+s"(g_), "+s"(b_)); F.G = g_; F.bid = b_; } \
    unsigned char* ws = A.ws; F.ws = ws; F.ctl = (unsigned*)(ws + WS_CTL); (void)F;
#define WSP(T_, off) ((T_*)(ws + (off)))

#ifdef EXTRA_BARS
    for (int eb_ = 0; eb_ < EXTRA_BARS; ++eb_) GRID_BAR();
#endif
    if (IN(0) && PHON(11)) { for (int rep_ = 0; rep_ < REPN(11); ++rep_) { if (rep_) GRID_BAR(); { FRAME(); phase_prologue(F, A); }
        { FRAME(); phase_norm(F, A.in[I_X], A.in[I_MIXG], WSP(bf16, WS_H)); } } }
    SEAM(0);
#pragma unroll 1
    for (int l = 0; l < DEPTH; ++l) {
        const int p0 = 1 + l * PH_PER_LAYER;
        if (IN(p0 + 1) && PHON(1)) { for (int rep_ = 0; rep_ < REPN(1); ++rep_) { if (rep_) GRID_BAR(); { FRAME();
            pg8::Gemm g{DM, DM, DM};
            SchedDense S{(const char*)(ws + WS_H), (const char*)(ws + WS_WIN) + (size_t)l * NCOL * DM * 2, T / 256, NCOL / 256, F.G, F.bid, (size_t)256 * DM * 2, (size_t)256 * DM * 2};
            EpiStoreBf16 E{WSP(bf16, WS_PROJ), NCOL, C_GL, A.in[I_BGATE] + l * 3 * DM, WSP(v2u, WS_GT)};
            pg8::gemm_phase<EpiStoreBf16, SchedDense, true, true>(lds3, g, S, E, F.tid);
        } } }
        SEAM(p0 + 1);
        if (IN(p0 + 2) && PHON(2)) { for (int rep_ = 0; rep_ < REPN(2); ++rep_) { if (rep_) GRID_BAR(); {
            for (int r2_ = 0; r2_ < REPN(14); ++r2_) { FRAME(); phase_qkprep(F, WSP(bf16, WS_PROJ), A.in[I_QG] + l * 64, A.in[I_KG] + l * 64, WSP(bf16, WS_Q), WSP(bf16, WS_K), WSP(float, WS_KMEAN)); }
            for (int r2_ = 0; r2_ < REPN(15); ++r2_) { FRAME(); phase_conv(F, WSP(bf16, WS_PROJ), A.in[I_CONVW] + (size_t)l * 31 * 512, A.in[I_CONVB] + l * 512, A.in[I_CLNG] + l * 512, A.in[I_CLNB] + l * 512, WSP(bf16, WS_CAT)); }
            for (int r2_ = 0; r2_ < REPN(16); ++r2_) { FRAME(); phase_hgrn1(F, WSP(bf16, WS_PROJ), A.in[I_LBL], l, WSP(float, WS_HS), WSP(float, WS_HS + 16 * MiB), WSP(float, WS_ORAW), WSP(bf16, WS_HS + 17 * MiB)); }
        } } }
        SEAM(p0 + 2);
        if (IN(p0 + 3) && PHON(3)) { for (int rep_ = 0; rep_ < REPN(3); ++rep_) { if (rep_) GRID_BAR(); {
            for (int r2_ = 0; r2_ < REPN(12); ++r2_) { FRAME(); phase_attn_mfma(F, WSP(bf16, WS_Q), WSP(bf16, WS_K), WSP(bf16, WS_PROJ), WSP(float, WS_KMEAN), WSP(bf16, WS_CAT)); }
            for (int r2_ = 0; r2_ < REPN(13); ++r2_) { FRAME(); phase_hgrn2(F, WSP(bf16, WS_PROJ), A.in[I_HGG] + l * 128, WSP(float, WS_HS), WSP(float, WS_HS + 16 * MiB), WSP(float, WS_ORAW), WSP(bf16, WS_HS + 17 * MiB), WSP(bf16, WS_CAT), (r2_ + 1 < REPN(13)) ? PROBE_DRY : 0); }
        } } }
        SEAM(p0 + 3);
        if (IN(p0 + 4) && PHON(4)) { for (int rep_ = 0; rep_ < REPN(4); ++rep_) { if (rep_) GRID_BAR(); { FRAME();
            pg8::Gemm g{1536, 512, 512};
            SchedBranch S{(const char*)(ws + WS_CAT), (const char*)(ws + WS_WCAT) + (size_t)l * 3 * DM * 512 * 2, F.G, F.bid};
            EpiBranch E{WSP(const v2u, WS_GT), WSP(bf16, WS_MERGED)};
            pg8::gemm_phase<EpiBranch, SchedBranch, true, true>(lds3, g, S, E, F.tid);
        } } }
        SEAM(p0 + 4);
        if (IN(p0 + 5) && PHON(5)) { for (int rep_ = 0; rep_ < REPN(5); ++rep_) { if (rep_) GRID_BAR(); { FRAME();
            pg8::Gemm g{DM, DM, DM};
            SchedDense S{(const char*)(ws + WS_MERGED), (const char*)(ws + WS_WOUT) + (size_t)l * DM * DM * 2, T / 256, DM / 256, F.G, F.bid, (size_t)256 * DM * 2, (size_t)256 * DM * 2};
            EpiResidual E{(l == 0) ? A.in[I_X] : (const float*)nullptr, (l == 0) ? (const bf16*)nullptr : WSP(const bf16, WS_XB), (rep_ + 1 >= REPN(5)) ? WSP(bf16, WS_XB) : WSP(bf16, WS_HS)};
            pg8::gemm_phase<EpiResidual, SchedDense, true, true>(lds3, g, S, E, F.tid);
        } } }
        SEAM(p0 + 5);
        if (IN(p0 + 6) && PHON(6)) { for (int rep_ = 0; rep_ < REPN(6); ++rep_) { if (rep_) GRID_BAR(); { FRAME(); phase_router2(F, WSP(const bf16, WS_XB), A.in[I_FFNG] + l * DM, A.in[I_WCO] + (size_t)l * DM * 4, A.in[I_BCO] + l * 4, A.in[I_WFI] + (size_t)l * DM * 32, A.in[I_BFI] + l * 32, WSP(bf16, WS_H), WSP(unsigned, WS_ROUTE), F.ctl + CW_CNT + l * 32 * 64, WSP(float, WS_Q), rep_ + 1 >= REPN(6)); } } }
        SEAM(p0 + 6);
        if (IN(p0 + 7) && PHON(7)) { for (int rep_ = 0; rep_ < REPN(7); ++rep_) { if (rep_) GRID_BAR(); { FRAME(); phase_index(F, WSP(unsigned, WS_ROUTE), F.ctl + CW_CNT + l * 32 * 64, F.ctl + CW_NT + l * 64, F.ctl + CW_TILE + l * 256, WSP(unsigned, WS_POS + 256 * 1024), WSP(float, WS_POS + 512 * 1024), WSP(float, WS_POS + 768 * 1024), WSP(unsigned, WS_POS)); } } }
        SEAM(p0 + 7);
        if (IN(p0 + 8) && PHON(8)) { for (int rep_ = 0; rep_ < REPN(8); ++rep_) { if (rep_) GRID_BAR(); { FRAME();
            pg8::Gemm g{DM, DM, DM};
            SchedMoe S{(const char*)(ws + WS_H), (const char*)(ws + WS_WEI) + (size_t)l * NEXP * 1024 * DM * 2, F.ctl + CW_NT + l * 64, F.ctl + CW_TILE + l * 256, F.G, F.bid, (size_t)256 * DM * 2, (size_t)1024 * DM * 2, (size_t)256 * DM * 2, WSP(const unsigned, WS_POS + 256 * 1024)};
            EpiSwiglu E{WSP(bf16, WS_ACT), WSP(float, WS_POS + 768 * 1024)};
            pg8::gemm_phase<EpiSwiglu, SchedMoe, true, true, true>(lds3, g, S, E, F.tid);
        } } }
        SEAM(p0 + 8);
        if (IN(p0 + 9) && PHON(9)) { for (int rep_ = 0; rep_ < REPN(9); ++rep_) { if (rep_) GRID_BAR(); { FRAME();
            pg8::Gemm g{FF, FF, FF};
            SchedMoe S{(const char*)(ws + WS_ACT), (const char*)(ws + WS_WEO) + (size_t)l * NEXP * DM * FF * 2, F.ctl + CW_NT + l * 64, F.ctl + CW_TILE + l * 256, F.G, F.bid, (size_t)256 * FF * 2, (size_t)DM * FF * 2, (size_t)256 * FF * 2, nullptr};
            EpiScaleRows E{WSP(bf16, WS_YS), WSP(float, WS_POS + 512 * 1024)};
            pg8::gemm_phase<EpiScaleRows, SchedMoe, true, true>(lds3, g, S, E, F.tid);
        } } }
        SEAM(p0 + 9);
        if (IN(p0 + 10) && PHON(10)) { for (int rep_ = 0; rep_ < REPN(10); ++rep_) { if (rep_) GRID_BAR(); { FRAME(); const bool real_ = (rep_ + 1 >= REPN(10)), lastl_ = (l + 1 >= DEPTH); phase_combine(F, WSP(const bf16, WS_XB), (real_ && !lastl_) ? WSP(bf16, WS_XB) : WSP(bf16, WS_HS), (real_ && lastl_) ? A.out : (float*)nullptr, WSP(bf16, WS_YS), WSP(unsigned, WS_POS), lastl_ ? (const float*)nullptr : A.in[I_MIXG] + (l + 1) * DM, WSP(bf16, WS_H)); } } }
        SEAM(p0 + 10);
    }
#undef IN
#undef SEAM
#undef FRAME
#undef WSP
}

extern "C" void kernel_launch(void* const* d_in, const int* in_sizes, int n_in, void* d_out, int out_size, void* d_ws, size_t ws_size, hipStream_t stream) {
    static int grid = 0;
    if (grid == 0) {
        if (n_in != 23 || out_size != T * DM || ws_size < WS_END) { fprintf(stderr, "kernel_launch: unexpected shapes (n_in %d out %d ws %zu)\n", n_in, out_size, ws_size); grid = -1; return; }
        int dev = 0, cus = 0, per_cu = 0;
        if (hipGetDevice(&dev) != hipSuccess || hipDeviceGetAttribute(&cus, hipDeviceAttributeMultiprocessorCount, dev) != hipSuccess) { grid = -1; return; }
        if (hipFuncSetAttribute((const void*)mk_fwd, hipFuncAttributeMaxDynamicSharedMemorySize, LDS_BYTES) != hipSuccess) { fprintf(stderr, "kernel_launch: hipFuncSetAttribute failed\n"); grid = -1; return; }
        if (hipOccupancyMaxActiveBlocksPerMultiprocessor(&per_cu, (const void*)mk_fwd, 512, LDS_BYTES) != hipSuccess || per_cu < 1) fprintf(stderr, "kernel_launch: occupancy query says %d\n", per_cu);
        (void)hipGetLastError();
        grid = cus;
    }
    if (grid < 0) return;
    (void)hipMemsetAsync((char*)d_ws + WS_CTL, 0, CTL_ZERO_BYTES, stream);
    Args a{};
    for (int i = 0; i < 23; ++i) a.in[i] = (const float*)d_in[i];
    a.out = (float*)d_out; a.ws = (unsigned char*)d_ws;
#if MK_SPLIT
    for (int p = 0; p < N_PHASES; ++p) {
        if (p == 1 + PH_PER_LAYER) continue;
        a.ph_lo = p; a.ph_hi = p + 1;
        hipLaunchKernelGGL(mk_fwd, dim3(grid), dim3(512), LDS_BYTES, stream, a);
    }
#else
    a.ph_lo = 0; a.ph_hi = N_PHASES;
    hipLaunchKernelGGL(mk_fwd, dim3(grid), dim3(512), LDS_BYTES, stream, a);
#endif
}
```
